# Optimizing an MI355X kernel written in HIP

```python
import math
import jax
import jax.numpy as jnp
from jax import lax
import numpy as np

D_MODEL = 1024
BATCH = 16
SEQ = 2048
DEPTH = 4

HEAD_DIM = 64
MOBA_HEADS = 4
MOBA_BLOCK = 256
MOBA_TOPK = 3
MOBA_Q_CHUNK = 32
DIFF_HEADS = 4
DIFF_QK_DIM = HEAD_DIM // 2
DIFF_V_DIM = HEAD_DIM
NSA_HEADS = 8
NSA_KV_HEADS = 2
NSA_GROUP = NSA_HEADS // NSA_KV_HEADS
NSA_CMP_BLOCK = 32
NSA_CMP_STRIDE = 16
NSA_CMP_HIDDEN = 256
NSA_SLC_BLOCK = 64
NSA_SLC_TOPK = 16
NSA_LOCAL_BLOCKS = 2
NSA_WINDOW = 512
NSA_Q_CHUNK = 32
ATTN_Q_BLOCK = 128
REL_BUCKETS = 32
REL_MAX_DIST = 128
N_BIAS_HEADS = MOBA_HEADS + DIFF_HEADS + NSA_HEADS
D_FF = 2816
RMS_EPS = 1e-6
NEG_INF = -1e30
FORCE_SCORE = 1e4

MOBA_W = MOBA_HEADS * HEAD_DIM
DIFF_QK_W = DIFF_HEADS * 2 * DIFF_QK_DIM
DIFF_V_W = DIFF_HEADS * DIFF_V_DIM
NSA_Q_W = NSA_HEADS * HEAD_DIM
NSA_KV_W = NSA_KV_HEADS * HEAD_DIM
NSA_GATE_W = 3 * NSA_HEADS
IN_SPLITS = (MOBA_W, MOBA_W, MOBA_W, DIFF_QK_W, DIFF_QK_W, DIFF_V_W, NSA_Q_W, NSA_KV_W, NSA_KV_W, NSA_KV_W, NSA_KV_W, NSA_KV_W, NSA_KV_W, NSA_GATE_W)
IN_WIDTH = 3 * MOBA_W + 2 * DIFF_QK_W + DIFF_V_W + NSA_Q_W + 6 * NSA_KV_W + NSA_GATE_W
MIX_WIDTH = MOBA_W + DIFF_V_W + NSA_Q_W

kernel_name = 'hybrid_moba_diff_nsa_macaron'


def rms_norm(x, g):
    xf = x.astype(jnp.float32)
    y = xf * lax.rsqrt(jnp.mean(xf * xf, axis=-1, keepdims=True) + RMS_EPS)
    return (y * g.astype(jnp.float32)).astype(x.dtype)


def swiglu(x, w_gate, w_up, w_down):
    return (jax.nn.silu(x @ w_gate) * (x @ w_up)) @ w_down


def rel_bucket(dist):
    n = jnp.maximum(dist, 0)
    max_exact = REL_BUCKETS // 2
    n_f = jnp.maximum(n, max_exact).astype(jnp.float32)
    large = max_exact + (jnp.log(n_f / max_exact) / math.log(REL_MAX_DIST / max_exact) * (REL_BUCKETS - max_exact)).astype(jnp.int32)
    return jnp.where(n < max_exact, n, jnp.minimum(large, REL_BUCKETS - 1))


def moba_attention(q, k, v, bias_table):
    B, H, S, dh = q.shape
    n_blk = -(-S // MOBA_BLOCK)
    pad = n_blk * MOBA_BLOCK - S
    kp = jnp.pad(k, ((0, 0), (0, 0), (0, pad), (0, 0)))
    vp = jnp.pad(v, ((0, 0), (0, 0), (0, pad), (0, 0)))
    k_blk = kp.reshape(B, H, n_blk, MOBA_BLOCK, dh)
    v_blk = vp.reshape(B, H, n_blk, MOBA_BLOCK, dh)
    k_mean = jnp.mean(k_blk.astype(jnp.float32), axis=3)
    top = min(MOBA_TOPK, max(n_blk - 1, 1))
    scale = dh ** -0.5
    bi = jnp.arange(B)[:, None, None, None]
    hi = jnp.arange(H)[None, :, None, None]
    blk_ids = jnp.arange(n_blk)
    offs = jnp.arange(MOBA_BLOCK)
    n_sel = top * MOBA_BLOCK

    def chunk(c):
        q0 = c * MOBA_Q_CHUNK
        own = q0 // MOBA_BLOCK
        q_pos = q0 + jnp.arange(MOBA_Q_CHUNK)
        qc = lax.dynamic_slice_in_dim(q, q0, MOBA_Q_CHUNK, axis=2).astype(jnp.float32)
        gate = jnp.einsum('bhqd,bhnd->bhqn', qc, k_mean)
        gate = jnp.where(blk_ids < own, gate, NEG_INF)
        _, idx = lax.top_k(gate, top)
        k_sel = k_blk[bi, hi, idx]
        v_sel = v_blk[bi, hi, idx]
        s_sel = jnp.einsum('bhqd,bhqnkd->bhqnk', qc, k_sel) * scale
        dist_sel = q_pos[None, None, :, None, None] - (idx[..., None] * MOBA_BLOCK + offs)
        s_sel = s_sel + bias_table[rel_bucket(dist_sel), hi[..., None]]
        s_sel = jnp.where((idx < own)[..., None], s_sel, NEG_INF)
        k_own = lax.dynamic_slice_in_dim(kp, own * MOBA_BLOCK, MOBA_BLOCK, axis=2)
        v_own = lax.dynamic_slice_in_dim(vp, own * MOBA_BLOCK, MOBA_BLOCK, axis=2)
        dist_own = q_pos[:, None] - (own * MOBA_BLOCK + offs)[None, :]
        s_own = jnp.einsum('bhqd,bhkd->bhqk', qc, k_own) * scale + jnp.moveaxis(bias_table[rel_bucket(dist_own)], -1, 0)
        s_own = jnp.where(dist_own >= 0, s_own, NEG_INF)
        p = jax.nn.softmax(jnp.concatenate([s_sel.reshape(B, H, MOBA_Q_CHUNK, n_sel), s_own], axis=-1), axis=-1)
        p_sel = p[..., :n_sel].reshape(B, H, MOBA_Q_CHUNK, top, MOBA_BLOCK)
        return jnp.einsum('bhqnk,bhqnkd->bhqd', p_sel, v_sel) + jnp.einsum('bhqk,bhkd->bhqd', p[..., n_sel:], v_own)

    o = lax.map(chunk, jnp.arange(S // MOBA_Q_CHUNK))
    return jnp.moveaxis(o, 0, 2).reshape(B, H, S, dh)


def diff_attention(q, k, v, bias_table, lam_params, subln_g, lambda_init):
    B, S, _ = q.shape
    H = DIFF_HEADS
    qh = q.reshape(B, S, H, 2, DIFF_QK_DIM).transpose(0, 2, 3, 1, 4).astype(jnp.float32)
    kh = k.reshape(B, S, H, 2, DIFF_QK_DIM).transpose(0, 2, 3, 1, 4)
    vh = v.reshape(B, S, H, DIFF_V_DIM).transpose(0, 2, 1, 3)
    lp = lam_params.astype(jnp.float32)
    lam = jnp.exp(jnp.sum(lp[0] * lp[1])) - jnp.exp(jnp.sum(lp[2] * lp[3])) + lambda_init
    scale = DIFF_QK_DIM ** -0.5
    k_pos = jnp.arange(S)

    def chunk(c):
        q0 = c * ATTN_Q_BLOCK
        qc = lax.dynamic_slice_in_dim(qh, q0, ATTN_Q_BLOCK, axis=3)
        dist = (q0 + jnp.arange(ATTN_Q_BLOCK))[:, None] - k_pos[None, :]
        bias = jnp.moveaxis(bias_table[rel_bucket(dist)], -1, 0)
        s = jnp.einsum('bhmqd,bhmkd->bhmqk', qc, kh) * scale + bias[None, :, None]
        p = jax.nn.softmax(jnp.where(dist >= 0, s, NEG_INF), axis=-1)
        a = p[:, :, 0] - lam * p[:, :, 1]
        return jnp.einsum('bhqk,bhkd->bhqd', a, vh)

    o = lax.map(chunk, jnp.arange(S // ATTN_Q_BLOCK))
    o = jnp.moveaxis(o, 0, 2).reshape(B, H, S, DIFF_V_DIM)
    o = rms_norm(o, subln_g) * (1.0 - lambda_init)
    return o.transpose(0, 2, 1, 3).reshape(B, S, H * DIFF_V_DIM)


def nsa_attention(q, kc, vc, ks, vs, kw, vw, gate_logits, bias_table, cmp_pe, cmp_w1, cmp_w2):
    B, S, _ = q.shape
    G, R, dh = NSA_KV_HEADS, NSA_GROUP, HEAD_DIM
    scale = dh ** -0.5
    qg = q.reshape(B, S, G, R, dh).transpose(0, 2, 3, 1, 4).astype(jnp.float32)

    def kv_heads(t):
        return t.reshape(B, S, G, dh).transpose(0, 2, 1, 3)

    kc, vc, ks, vs, kw, vw = (kv_heads(t) for t in (kc, vc, ks, vs, kw, vw))
    tbl = bias_table.reshape(REL_BUCKETS, G, R)
    pos = jnp.arange(S)

    n_cmp = (S - NSA_CMP_BLOCK) // NSA_CMP_STRIDE + 1
    cmp_start = np.arange(n_cmp) * NSA_CMP_STRIDE
    win_idx = cmp_start[:, None] + np.arange(NSA_CMP_BLOCK)[None, :]

    def compress(t, i):
        blocks = t[:, :, win_idx] + cmp_pe[i]
        flat = blocks.reshape(B, G, n_cmp, NSA_CMP_BLOCK * dh)
        return jax.nn.gelu(flat @ cmp_w1[i]) @ cmp_w2[i]

    k_cmp = compress(kc, 0)
    v_cmp = compress(vc, 1)
    cmp_valid = jnp.asarray(cmp_start + NSA_CMP_BLOCK - 1)[None, :] <= pos[:, None]
    s_cmp = jnp.einsum('bgrsd,bgnd->bgrsn', qg, k_cmp) * scale
    p_cmp = jnp.where(cmp_valid, jax.nn.softmax(jnp.where(cmp_valid, s_cmp, NEG_INF), axis=-1), 0.0)
    o_cmp = jnp.einsum('bgrsn,bgnd->bgrsd', p_cmp, v_cmp)

    n_slc = S // NSA_SLC_BLOCK
    slc_start = np.arange(n_slc) * NSA_SLC_BLOCK
    overlap = np.clip(np.minimum(cmp_start[:, None] + NSA_CMP_BLOCK, slc_start[None, :] + NSA_SLC_BLOCK) - np.maximum(cmp_start[:, None], slc_start[None, :]), 0, None) / NSA_CMP_BLOCK
    imp = jnp.einsum('bgrsn,nj->bgsj', p_cmp, jnp.asarray(overlap, jnp.float32))
    blk = jnp.arange(n_slc)[None, :]
    cur = (pos // NSA_SLC_BLOCK)[:, None]
    forced = (blk == 0) | (blk > cur - NSA_LOCAL_BLOCKS)
    score = jnp.where(blk <= cur, jnp.where(forced, FORCE_SCORE, imp), NEG_INF)
    top = min(NSA_SLC_TOPK, n_slc)
    _, sel_idx = lax.top_k(score, top)
    ks_blk = ks.reshape(B, G, n_slc, NSA_SLC_BLOCK, dh)
    vs_blk = vs.reshape(B, G, n_slc, NSA_SLC_BLOCK, dh)
    bi = jnp.arange(B)[:, None, None, None]
    gi = jnp.arange(G)[None, :, None, None]
    gi6 = jnp.arange(G)[None, :, None, None, None, None]
    ri6 = jnp.arange(R)[None, None, :, None, None, None]
    offs = jnp.arange(NSA_SLC_BLOCK)
    n_key = top * NSA_SLC_BLOCK

    def slc_chunk(c):
        q0 = c * NSA_Q_CHUNK
        qc = lax.dynamic_slice_in_dim(qg, q0, NSA_Q_CHUNK, axis=3)
        idx = lax.dynamic_slice_in_dim(sel_idx, q0, NSA_Q_CHUNK, axis=2)
        k_sel = ks_blk[bi, gi, idx]
        v_sel = vs_blk[bi, gi, idx]
        dist = (q0 + jnp.arange(NSA_Q_CHUNK))[None, None, :, None, None] - (idx[..., None] * NSA_SLC_BLOCK + offs)
        s = jnp.einsum('bgrqd,bgqnkd->bgrqnk', qc, k_sel) * scale + tbl[rel_bucket(dist)[:, :, None], gi6, ri6]
        s = jnp.where((dist >= 0)[:, :, None], s, NEG_INF)
        p = jax.nn.softmax(s.reshape(B, G, R, NSA_Q_CHUNK, n_key), axis=-1).reshape(s.shape)
        return jnp.einsum('bgrqnk,bgqnkd->bgrqd', p, v_sel)

    o_slc = lax.map(slc_chunk, jnp.arange(S // NSA_Q_CHUNK))
    o_slc = jnp.moveaxis(o_slc, 0, 3).reshape(B, G, R, S, dh)

    n_k = NSA_WINDOW + ATTN_Q_BLOCK
    kw_p = jnp.pad(kw, ((0, 0), (0, 0), (NSA_WINDOW, 0), (0, 0)))
    vw_p = jnp.pad(vw, ((0, 0), (0, 0), (NSA_WINDOW, 0), (0, 0)))

    def win_chunk(c):
        q0 = c * ATTN_Q_BLOCK
        qc = lax.dynamic_slice_in_dim(qg, q0, ATTN_Q_BLOCK, axis=3)
        kb = lax.dynamic_slice_in_dim(kw_p, q0, n_k, axis=2)
        vb = lax.dynamic_slice_in_dim(vw_p, q0, n_k, axis=2)
        k_pos = q0 - NSA_WINDOW + jnp.arange(n_k)
        dist = (q0 + jnp.arange(ATTN_Q_BLOCK))[:, None] - k_pos[None, :]
        bias = jnp.transpose(tbl[rel_bucket(dist)], (2, 3, 0, 1))
        s = jnp.einsum('bgrqd,bgkd->bgrqk', qc, kb) * scale + bias
        valid = (dist >= 0) & (dist < NSA_WINDOW) & (k_pos >= 0)[None, :]
        p = jax.nn.softmax(jnp.where(valid, s, NEG_INF), axis=-1)
        return jnp.einsum('bgrqk,bgkd->bgrqd', p, vb)

    o_win = lax.map(win_chunk, jnp.arange(S // ATTN_Q_BLOCK))
    o_win = jnp.moveaxis(o_win, 0, 3).reshape(B, G, R, S, dh)

    g = jax.nn.sigmoid(gate_logits.astype(jnp.float32)).reshape(B, S, G, R, 3).transpose(0, 2, 3, 1, 4)
    o = g[..., 0:1] * o_cmp + g[..., 1:2] * o_slc + g[..., 2:3] * o_win
    return o.transpose(0, 3, 1, 2, 4).reshape(B, S, NSA_HEADS * dh)


def hybrid_mixer(h, w_in, w_out, rel_bias, diff_lambda, diff_subln, lambda_init, cmp_pe, cmp_w1, cmp_w2):
    B, S, _ = h.shape
    proj = h @ w_in
    split_points = np.cumsum(IN_SPLITS)[:-1].tolist()
    (mq, mk, mv, dq, dk, dv, nq, nkc, nvc, nks, nvs, nkw, nvw, ng) = jnp.split(proj, split_points, axis=-1)

    def heads(t):
        return t.reshape(B, S, MOBA_HEADS, HEAD_DIM).transpose(0, 2, 1, 3)

    h0, h1 = MOBA_HEADS, MOBA_HEADS + DIFF_HEADS
    o_moba = moba_attention(heads(mq), heads(mk), heads(mv), rel_bias[:, :h0])
    o_moba = o_moba.transpose(0, 2, 1, 3).reshape(B, S, MOBA_W)
    o_diff = diff_attention(dq, dk, dv, rel_bias[:, h0:h1], diff_lambda, diff_subln, lambda_init)
    o_nsa = nsa_attention(nq, nkc, nvc, nks, nvs, nkw, nvw, ng, rel_bias[:, h1:], cmp_pe, cmp_w1, cmp_w2)
    o = jnp.concatenate([o_moba, o_diff, o_nsa], axis=-1).astype(h.dtype)
    return o @ w_out


def setup_inputs(seed: int = 0) -> dict:
    key = jax.random.key(seed)
    ks = jax.random.split(key, 20)

    def nrm(k, shape, scale):
        return jax.random.normal(k, shape, jnp.float32) * scale

    L, HD = NSA_CMP_BLOCK, HEAD_DIM
    return {
        'x': nrm(ks[0], (BATCH, SEQ, D_MODEL), 1.0),
        'rel_bias': nrm(ks[1], (REL_BUCKETS, N_BIAS_HEADS), 0.5),
        'norm_ffn1': 1.0 + nrm(ks[2], (DEPTH, D_MODEL), 0.02),
        'ffn1_gate': nrm(ks[3], (DEPTH, D_MODEL, D_FF), D_MODEL ** -0.5),
        'ffn1_up': nrm(ks[4], (DEPTH, D_MODEL, D_FF), D_MODEL ** -0.5),
        'ffn1_down': nrm(ks[5], (DEPTH, D_FF, D_MODEL), D_FF ** -0.5),
        'norm_mix': 1.0 + nrm(ks[6], (DEPTH, D_MODEL), 0.02),
        'w_in': nrm(ks[7], (DEPTH, D_MODEL, IN_WIDTH), D_MODEL ** -0.5),
        'diff_lambda': nrm(ks[8], (DEPTH, 4, DIFF_QK_DIM), 0.1),
        'diff_subln': 1.0 + nrm(ks[9], (DEPTH, DIFF_V_DIM), 0.02),
        'nsa_cmp_pe': nrm(ks[10], (DEPTH, 2, L, HD), 0.1),
        'nsa_cmp_w1': nrm(ks[11], (DEPTH, 2, L * HD, NSA_CMP_HIDDEN), (L * HD) ** -0.5),
        'nsa_cmp_w2': nrm(ks[12], (DEPTH, 2, NSA_CMP_HIDDEN, HD), NSA_CMP_HIDDEN ** -0.5),
        'w_out': nrm(ks[13], (DEPTH, MIX_WIDTH, D_MODEL), MIX_WIDTH ** -0.5),
        'norm_ffn2': 1.0 + nrm(ks[14], (DEPTH, D_MODEL), 0.02),
        'ffn2_gate': nrm(ks[15], (DEPTH, D_MODEL, D_FF), D_MODEL ** -0.5),
        'ffn2_up': nrm(ks[16], (DEPTH, D_MODEL, D_FF), D_MODEL ** -0.5),
        'ffn2_down': nrm(ks[17], (DEPTH, D_FF, D_MODEL), D_FF ** -0.5),
        'final_norm': 1.0 + nrm(ks[18], (D_MODEL,), 0.02),
    }


def reference(x, rel_bias, norm_ffn1, ffn1_gate, ffn1_up, ffn1_down, norm_mix, w_in, diff_lambda, diff_subln, nsa_cmp_pe, nsa_cmp_w1, nsa_cmp_w2, w_out, norm_ffn2, ffn2_gate, ffn2_up, ffn2_down, final_norm):
    for l in range(DEPTH):
        lambda_init = 0.8 - 0.6 * math.exp(-0.3 * l)
        x = x + 0.5 * swiglu(rms_norm(x, norm_ffn1[l]), ffn1_gate[l], ffn1_up[l], ffn1_down[l])
        x = x + hybrid_mixer(rms_norm(x, norm_mix[l]), w_in[l], w_out[l], rel_bias, diff_lambda[l], diff_subln[l], lambda_init, nsa_cmp_pe[l], nsa_cmp_w1[l], nsa_cmp_w2[l])
        x = x + 0.5 * swiglu(rms_norm(x, norm_ffn2[l]), ffn2_gate[l], ffn2_up[l], ffn2_down[l])
    return rms_norm(x, final_norm)
```

```cpp
#include <hip/hip_runtime.h>
#include <hip/hip_cooperative_groups.h>
#include <cstdio>
#include <cstdint>
#include <cmath>
namespace cg = cooperative_groups;
#define COOP 1
namespace pg8 {
#define PG8_LAS __attribute__((address_space(3)))
typedef unsigned short bf16_t;
typedef short bf16x8 __attribute__((ext_vector_type(8)));
typedef float f32x4 __attribute__((ext_vector_type(4)));
typedef unsigned u32x4 __attribute__((ext_vector_type(4)));
constexpr int BM = 256, BK = 64, HALF = 128, HTB = HALF * BK * 2  , STAGE_BYTES = 8 * HTB, NXCD = 8, WGM = 8;

__host__ __device__ __forceinline__ int lds_byte(int r, int c) { const int st = (r >> 4) * 2 + (c >> 5), rr = r & 15, cc = c & 31, ob = rr * 64 + cc * 2; return st * 1024 + (ob ^ (((ob >> 9) & 1) << 5)); }
__host__ __device__ __forceinline__ void stage_rc(int b, int& R, int& C) { const int st = b / 1024, sb = b % 1024, swz = sb ^ (((sb >> 9) & 1) << 5); R = (st >> 1) * 16 + swz / 64; C = (st & 1) * 32 + (swz % 64) / 2; }
__host__ __device__ __forceinline__ int perm32(int rho) { const int n = rho >> 4, i = rho & 15; return 8 * (i >> 2) + 4 * n + (i & 3); }

struct Unit { int pm, pn; };
struct Gemm { const bf16_t* A; const bf16_t* Bt; int M, N, K; };

struct StaticOrder {
    int nM, nN, nwg, G, c;
    __host__ __device__ void init(int M, int N, int G_, int c_) { nM = M / BM; nN = N / BM; nwg = nM * nN; G = G_; c = c_; }
    __host__ __device__ bool next(int i, Unit& u) const {
        const long L = (long)i * G + c; if (L >= nwg) return false;
        int wgid = (int)L; { const int q = nwg / NXCD, r = nwg % NXCD, xcd = wgid % NXCD, off = wgid / NXCD; wgid = (xcd < r ? xcd * (q + 1) : r * (q + 1) + (xcd - r) * q) + off; }
        const int nig = WGM * nN, gid = wgid / nig, fm = gid * WGM, gsz = (nM - fm) < WGM ? (nM - fm) : WGM;
        u.pm = fm + ((wgid % nig) % gsz); u.pn = (wgid % nig) / gsz; return true;
    }
    __device__ __forceinline__ void a_ready(const Unit&) const {}
    __device__ __forceinline__ void done(const Unit&) const {}
};

__device__ __forceinline__ unsigned cvt_pk_bf16(float lo, float hi) { unsigned r; asm volatile("v_cvt_pk_bf16_f32 %0, %1, %2" : "=v"(r) : "v"(lo), "v"(hi)); return r; }

__device__ __forceinline__ float ex2(float x) { return __builtin_amdgcn_exp2f(x); }
__device__ __forceinline__ float rcpf_(float x) { return __builtin_amdgcn_rcpf(x); }
__device__ __forceinline__ float silu_f(float x) { return x * rcpf_(1.0f + ex2(-1.4426950408889634f * x)); }
__device__ __forceinline__ float gelu_tanh_f(float x) { const float y2 = 2.0f * 0.7978845608028654f * (x + 0.044715f * x * x * x); return x * (1.0f - rcpf_(1.0f + ex2(1.4426950408889634f * y2))); }

struct EpiSwiGLU {
    static constexpr bool PERM = true, AFTER_DRAIN = false;
    bf16_t* O; int ldc;
    __device__ __forceinline__ void operator()(const f32x4 (&acc)[2][2][4][2], const Unit& u, int wr, int wc, int fr, int fq) const {
        const int row0 = u.pm * BM + wr * 64 + fr; const int col0 = u.pn * HALF + wc * 32 + 8 * fq;
#pragma unroll
        for (int ai = 0; ai < 2; ++ai)
#pragma unroll
            for (int m = 0; m < 4; ++m) { bf16_t* rowp = O + (size_t)(row0 + ai * HALF + m * 16) * ldc + col0;
                const f32x4 g0 = acc[ai][0][m][0], g1 = acc[ai][0][m][1], u0 = acc[ai][1][m][0], u1 = acc[ai][1][m][1];
                u32x4 w; w.x = cvt_pk_bf16(silu_f(g0[0]) * u0[0], silu_f(g0[1]) * u0[1]); w.y = cvt_pk_bf16(silu_f(g0[2]) * u0[2], silu_f(g0[3]) * u0[3]);
                w.z = cvt_pk_bf16(silu_f(g1[0]) * u1[0], silu_f(g1[1]) * u1[1]); w.w = cvt_pk_bf16(silu_f(g1[2]) * u1[2], silu_f(g1[3]) * u1[3]);
                *(u32x4*)rowp = w; asm volatile("" ::: "memory"); }
    }
};
template <int ACT> struct EpiBf16 {
    static constexpr bool PERM = true, AFTER_DRAIN = false;
    bf16_t* O; int ldc;
    __device__ __forceinline__ void operator()(const f32x4 (&acc)[2][2][4][2], const Unit& u, int wr, int wc, int fr, int fq) const {
        const int row0 = u.pm * BM + wr * 64 + fr; const int col0 = u.pn * BM + wc * 32 + 8 * fq;
#pragma unroll
        for (int ai = 0; ai < 2; ++ai)
#pragma unroll
            for (int m = 0; m < 4; ++m) { bf16_t* rowp = O + (size_t)(row0 + ai * HALF + m * 16) * ldc + col0;
#pragma unroll
                for (int bj = 0; bj < 2; ++bj) { f32x4 v0 = acc[ai][bj][m][0], v1 = acc[ai][bj][m][1];
                    if (ACT == 1) { v0 = (f32x4){gelu_tanh_f(v0[0]), gelu_tanh_f(v0[1]), gelu_tanh_f(v0[2]), gelu_tanh_f(v0[3])}; v1 = (f32x4){gelu_tanh_f(v1[0]), gelu_tanh_f(v1[1]), gelu_tanh_f(v1[2]), gelu_tanh_f(v1[3])}; }
                    u32x4 w; w.x = cvt_pk_bf16(v0[0], v0[1]); w.y = cvt_pk_bf16(v0[2], v0[3]); w.z = cvt_pk_bf16(v1[0], v1[1]); w.w = cvt_pk_bf16(v1[2], v1[3]);
                    *(u32x4*)(rowp + bj * HALF) = w; } asm volatile("" ::: "memory"); }
    }
};
struct EpiResid {
    static constexpr bool PERM = false, AFTER_DRAIN = false;
    const float* base; float* out; int ldc; float alpha;
    __device__ __forceinline__ void operator()(const f32x4 (&acc)[2][2][4][2], const Unit& u, int wr, int wc, int fr, int fq) const {
        const int row0 = u.pm * BM + wr * 64 + fr; const int col0 = u.pn * BM + wc * 32 + 4 * fq;
#pragma unroll
        for (int ai = 0; ai < 2; ++ai)
#pragma unroll
            for (int m = 0; m < 4; ++m) { const size_t off = (size_t)(row0 + ai * HALF + m * 16) * ldc + col0;
#pragma unroll
                for (int bj = 0; bj < 2; ++bj)
#pragma unroll
                    for (int n = 0; n < 2; ++n) { const f32x4 bs = *(const f32x4*)(base + off + bj * HALF + n * 16); *(f32x4*)(out + off + bj * HALF + n * 16) = bs + acc[ai][bj][m][n] * alpha; } asm volatile("" ::: "memory"); }
    }
};
template <class Epi, class Sched, bool ALIGN_EPI = false, bool SP2 = false>
__device__ __forceinline__ void gemm_phase(PG8_LAS unsigned char* lds, const Gemm g, const Sched& S, const Epi& E, const int wave_in) {
    int tid_l; asm volatile("v_mbcnt_lo_u32_b32 %0, -1, 0\n\tv_mbcnt_hi_u32_b32 %0, -1, %0" : "=v"(tid_l)); tid_l += wave_in * 64;
    const int tid = tid_l, wid = __builtin_amdgcn_readfirstlane(tid >> 6), lane = tid & 63, wr = wid >> 2, wc = wid & 3, fr = lane & 15, fq = lane >> 4;
    const int K = g.K, nt = K / BK;
    unsigned voffA[2], voffB[2];
#pragma unroll
    for (int i = 0; i < 2; ++i) { int R, C; stage_rc(tid * 16 + i * 8192, R, C); const int Rb = Epi::PERM ? ((R & ~31) + perm32(R & 31)) : R;
        voffA[i] = (unsigned)(R * K + C) * 2u; voffB[i] = (unsigned)(Rb * K + C) * 2u; }
    const size_t kstep = (size_t)(BK * 2);
    const size_t hstep = (size_t)HALF * K * 2;
    const size_t tstep = 2 * hstep;
    const unsigned ldsw = (unsigned)wid * 1024u;
    const int aoff = lds_byte(wr * 64 + fr, fq * 8), boff = lds_byte(wc * 32 + fr, fq * 8);
#define PG8_SA(b, h) (((b) * 2 + (h)) * HTB)
#define PG8_SB(b, h) ((4 + (b) * 2 + (h)) * HTB)
#define PG8_STAGE(bufoff, gbase, voff) do { _Pragma("unroll") for (int _i = 0; _i < 2; ++_i) \
        __builtin_amdgcn_global_load_lds((const unsigned*)((const char*)(gbase) + (voff)[_i]), (PG8_LAS unsigned*)(lds + (bufoff) + ldsw + _i * 8192), 16, 0, 0); } while (0)
#define PG8_LDA(dst, b, h) do { _Pragma("unroll") for (int m = 0; m < 4; ++m) _Pragma("unroll") for (int k = 0; k < 2; ++k) dst[m][k] = *(const PG8_LAS bf16x8*)(lds + PG8_SA(b, h) + aoff + m * 2048 + k * 1024); } while (0)
#define PG8_LDB(dst, b, h) do { _Pragma("unroll") for (int n = 0; n < 2; ++n) _Pragma("unroll") for (int k = 0; k < 2; ++k) dst[n][k] = *(const PG8_LAS bf16x8*)(lds + PG8_SB(b, h) + boff + n * 2048 + k * 1024); } while (0)
#define PG8_MMA(ai, bj, At, Bt) do { __builtin_amdgcn_s_setprio(1); _Pragma("unroll") for (int m = 0; m < 4; ++m) _Pragma("unroll") for (int n = 0; n < 2; ++n) _Pragma("unroll") for (int k = 0; k < 2; ++k) \
        acc[ai][bj][m][n] = __builtin_amdgcn_mfma_f32_16x16x32_bf16(Bt[n][k], At[m][k], acc[ai][bj][m][n], 0, 0, 0); __builtin_amdgcn_s_setprio(0); } while (0)
#define PG8_WAIT_V(n) asm volatile("s_waitcnt vmcnt(" #n ")" ::: "memory")
#define PG8_WAIT_L(n) asm volatile("s_waitcnt lgkmcnt(" #n ")" ::: "memory")
#define PG8_BAR __builtin_amdgcn_s_barrier()
#define PG8_SCHED __builtin_amdgcn_sched_barrier(0)
    Unit cur, nxt; int ui = 0;
    if (!S.next(0, cur)) return;
    f32x4 acc[2][2][4][2];
#pragma unroll
    for (int a = 0; a < 2; ++a)
#pragma unroll
        for (int b = 0; b < 2; ++b)
#pragma unroll
            for (int m = 0; m < 4; ++m)
#pragma unroll
                for (int n = 0; n < 2; ++n) acc[a][b][m][n] = (f32x4){0.f, 0.f, 0.f, 0.f};
    bf16x8 At[4][2], B0[2][2], B1[2][2];
    const char* cA = (const char*)g.A + (size_t)cur.pm * tstep; const char* cB = (const char*)g.Bt + (size_t)cur.pn * tstep;
    S.a_ready(cur);
    if constexpr (SP2) {
        PG8_STAGE(PG8_SB(0, 0), cB, voffB); PG8_STAGE(PG8_SB(0, 1), cB + hstep, voffB); PG8_STAGE(PG8_SA(0, 0), cA, voffA); PG8_STAGE(PG8_SA(0, 1), cA + hstep, voffA);
        if (wr == 1) PG8_BAR;
        PG8_WAIT_V(2); PG8_BAR;
        PG8_STAGE(PG8_SB(1, 0), cB + kstep, voffB); PG8_STAGE(PG8_SA(1, 0), cA + kstep, voffA); PG8_STAGE(PG8_SB(1, 1), cB + hstep + kstep, voffB);
        PG8_WAIT_V(6); PG8_BAR;
    } else {
        PG8_STAGE(PG8_SB(0, 0), cB, voffB); PG8_STAGE(PG8_SA(0, 0), cA, voffA); PG8_STAGE(PG8_SB(0, 1), cB + hstep, voffB); PG8_STAGE(PG8_SA(0, 1), cA + hstep, voffA);
        if (wr == 1) PG8_BAR;
        PG8_WAIT_V(4); PG8_BAR;
        PG8_STAGE(PG8_SB(1, 0), cB + kstep, voffB); PG8_STAGE(PG8_SA(1, 0), cA + kstep, voffA); PG8_STAGE(PG8_SB(1, 1), cB + hstep + kstep, voffB);
        PG8_WAIT_V(6); PG8_BAR;
    }
    for (;;) {
        const bool has_next = S.next(ui + 1, nxt);
        const char* nA = has_next ? (const char*)g.A + (size_t)nxt.pm * tstep : cA; const char* nB = has_next ? (const char*)g.Bt + (size_t)nxt.pn * tstep : cB;
        for (int t = 0; t < nt; t += 2) {
            const bool last = (t == nt - 2);
            const char* a1 = cA + (size_t)(t + 1) * kstep;
            const char* a2 = last ? nA : cA + (size_t)(t + 2) * kstep; const char* b2 = last ? nB : cB + (size_t)(t + 2) * kstep;
            const char* a3 = a2 + kstep; const char* b3 = b2 + kstep;
            if (last && has_next) S.a_ready(nxt);
            if constexpr (SP2) {
            PG8_LDB(B0, 0, 0); PG8_LDB(B1, 0, 1); PG8_SCHED; PG8_LDA(At, 0, 0); PG8_STAGE(PG8_SA(1, 1), a1 + hstep, voffA);
            PG8_WAIT_V(8); PG8_WAIT_L(0); PG8_BAR; PG8_MMA(0, 0, At, B0); PG8_MMA(0, 1, At, B1); PG8_BAR; PG8_SCHED;
            PG8_LDA(At, 0, 1); PG8_STAGE(PG8_SB(0, 0), b2, voffB); PG8_STAGE(PG8_SB(0, 1), b2 + hstep, voffB); PG8_STAGE(PG8_SA(0, 0), a2, voffA);
            PG8_WAIT_V(8); PG8_WAIT_L(0); PG8_BAR; PG8_MMA(1, 0, At, B0); PG8_MMA(1, 1, At, B1); PG8_BAR; PG8_SCHED;
            PG8_LDB(B0, 1, 0); PG8_LDB(B1, 1, 1); PG8_SCHED; PG8_LDA(At, 1, 0); PG8_STAGE(PG8_SA(0, 1), a2 + hstep, voffA);
            PG8_WAIT_V(8); PG8_WAIT_L(0); PG8_BAR; PG8_MMA(0, 0, At, B0); PG8_MMA(0, 1, At, B1); PG8_BAR; PG8_SCHED;
            PG8_LDA(At, 1, 1); PG8_STAGE(PG8_SB(1, 0), b3, voffB); PG8_STAGE(PG8_SB(1, 1), b3 + hstep, voffB); PG8_STAGE(PG8_SA(1, 0), a3, voffA);
            PG8_WAIT_V(8); PG8_WAIT_L(0); PG8_BAR; PG8_MMA(1, 0, At, B0); PG8_MMA(1, 1, At, B1); PG8_BAR; PG8_SCHED;
            } else {
            PG8_LDB(B0, 0, 0); PG8_SCHED; PG8_LDA(At, 0, 0); PG8_STAGE(PG8_SA(1, 1), a1 + hstep, voffA);
            PG8_WAIT_L(8); PG8_BAR; PG8_WAIT_L(0); PG8_MMA(0, 0, At, B0); PG8_BAR; PG8_SCHED;
            PG8_LDB(B1, 0, 1); PG8_STAGE(PG8_SB(0, 0), b2, voffB);
            PG8_BAR; PG8_WAIT_L(0); PG8_MMA(0, 1, At, B1); PG8_BAR;
            PG8_LDA(At, 0, 1); PG8_STAGE(PG8_SA(0, 0), a2, voffA);
            PG8_BAR; PG8_WAIT_L(0); PG8_MMA(1, 0, At, B0); PG8_BAR; PG8_SCHED;
            PG8_STAGE(PG8_SB(0, 1), b2 + hstep, voffB);
            PG8_WAIT_V(6); PG8_BAR; PG8_MMA(1, 1, At, B1); PG8_BAR;
            PG8_LDB(B0, 1, 0); PG8_SCHED; PG8_LDA(At, 1, 0); PG8_STAGE(PG8_SA(0, 1), a2 + hstep, voffA);
            PG8_WAIT_L(8); PG8_BAR; PG8_WAIT_L(0); PG8_MMA(0, 0, At, B0); PG8_BAR; PG8_SCHED;
            PG8_LDB(B1, 1, 1); PG8_STAGE(PG8_SB(1, 0), b3, voffB);
            PG8_BAR; PG8_WAIT_L(0); PG8_MMA(0, 1, At, B1); PG8_BAR;
            PG8_LDA(At, 1, 1); PG8_STAGE(PG8_SA(1, 0), a3, voffA);
            PG8_BAR; PG8_WAIT_L(0); PG8_MMA(1, 0, At, B0); PG8_BAR; PG8_SCHED;
            PG8_STAGE(PG8_SB(1, 1), b3 + hstep, voffB);
            PG8_WAIT_V(6); PG8_BAR; PG8_MMA(1, 1, At, B1); PG8_BAR;
            }
        }
        if constexpr (ALIGN_EPI) { if (wr == 0) PG8_BAR; }
        if constexpr (!Epi::AFTER_DRAIN) { E(acc, cur, wr, wc, fr, fq); S.done(cur); }
        if (!has_next) break;
#pragma unroll
        for (int a = 0; a < 2; ++a)
#pragma unroll
            for (int b = 0; b < 2; ++b)
#pragma unroll
                for (int m = 0; m < 4; ++m)
#pragma unroll
                    for (int n = 0; n < 2; ++n) acc[a][b][m][n] = (f32x4){0.f, 0.f, 0.f, 0.f};
        cur = nxt; cA = nA; cB = nB; ++ui;
        if constexpr (ALIGN_EPI) { if (wr == 1) PG8_BAR; }
    }
    PG8_WAIT_V(0);
    if constexpr (!ALIGN_EPI) { if (wr == 0) PG8_BAR; }
    PG8_BAR;
    if constexpr (Epi::AFTER_DRAIN) { E.fused(acc, cur, wr, wc, fr, fq, lds, wid, lane); S.done(cur); }
#undef PG8_SA
#undef PG8_SB
#undef PG8_STAGE
#undef PG8_LDA
#undef PG8_LDB
#undef PG8_MMA
#undef PG8_WAIT_V
#undef PG8_WAIT_L
#undef PG8_BAR
#undef PG8_SCHED
}
}

#define LAS __attribute__((address_space(3)))
using pg8::ex2; using pg8::rcpf_;
typedef unsigned short u16;
typedef short bf16x8 __attribute__((ext_vector_type(8)));
typedef float f32x4 __attribute__((ext_vector_type(4)));
typedef float f32x16 __attribute__((ext_vector_type(16)));
typedef unsigned u32x4 __attribute__((ext_vector_type(4)));
typedef unsigned u32x2 __attribute__((ext_vector_type(2)));

constexpr int DM = 1024, NB = 16, SEQ = 2048, MTOK = NB * SEQ, DEPTH = 4, DFF = 2816, INW = 2840, PW = 3072;
constexpr int C_MQ = 0, C_MK = 256, C_MV = 512, C_DQ = 768, C_DK = 1024, C_DV = 1280, C_NQ = 1536, C_NKC = 2048, C_NVC = 2176, C_NKS = 2304, C_NVS = 2432, C_NKW = 2560, C_NVW = 2688, C_NG = 2816;
constexpr int NVH = 12;
constexpr float LOG2E = 1.4426950408889634f, NEGF = -1e30f;
constexpr int NPH_L = 14, NPH = NPH_L * DEPTH + 1;
constexpr size_t MiB = 1u << 20;
constexpr size_t WS_GU1 = 1 * MiB, WS_DN1 = 12 * MiB, WS_GU2 = WS_DN1 + 5 * MiB + MiB / 2, WS_DN2 = WS_GU2 + 11 * MiB, WS_WIN = 34 * MiB, WS_WOUT = 40 * MiB, WS_W1 = 42 * MiB;
constexpr size_t WS_PROJ = 44 * MiB, WS_XN = 236 * MiB, WS_VT = 300 * MiB, WS_HID = 348 * MiB, WS_KCMP = 352 * MiB, WS_VCMPT = WS_KCMP + MiB / 2, WS_KMEAN = 353 * MiB, WS_SEL = WS_KMEAN + MiB / 4, WS_END = 354 * MiB;
static_assert(WS_DN2 + 5 * MiB + MiB / 2 == WS_WIN, "ws map");
constexpr int LDS_BYTES = 147456;
constexpr int ATT_K = 0, ATT_V = 9216, ATT_LUT = 18432;
constexpr int CMP_K = 0, CMP_V = 18432, CMP_P = 36864, CMP_IMP = CMP_P + 32768, CMP_MASK = CMP_IMP + 64 * 33 * 4;

struct Params {
    const float* x; const float* rel_bias; const float* norm_ffn1; const float* ffn1_gate; const float* ffn1_up; const float* ffn1_down;
    const float* norm_mix; const float* w_in; const float* diff_lambda; const float* diff_subln; const float* cmp_pe; const float* cmp_w1; const float* cmp_w2;
    const float* w_out; const float* norm_ffn2; const float* ffn2_gate; const float* ffn2_up; const float* ffn2_down; const float* final_norm;
    float* out; unsigned char* ws;
    float lam_init[4];
    int ph_lo, ph_hi;
};
typedef const __attribute__((address_space(4))) Params* KParamsPtr;

__device__ __forceinline__ float bf2f(unsigned v) { return __uint_as_float(v << 16); }
typedef float f32x2_t __attribute__((ext_vector_type(2))); typedef __bf16 bf16x2_t __attribute__((ext_vector_type(2)));
__device__ __forceinline__ unsigned pkbf(float lo, float hi) { f32x2_t v = {lo, hi}; bf16x2_t b = __builtin_convertvector(v, bf16x2_t); return __builtin_bit_cast(unsigned, b); }
__device__ __forceinline__ int lane_opaque() { int l; asm volatile("v_mbcnt_lo_u32_b32 %0, -1, 0\n\tv_mbcnt_hi_u32_b32 %0, -1, %0" : "=v"(l)); return l; }
__device__ __forceinline__ float wave_sum(float v, int lane) {
#pragma unroll
    for (int o = 1; o < 64; o <<= 1) v += __int_as_float(__builtin_amdgcn_ds_bpermute((lane ^ o) << 2, __float_as_int(v)));
    return v;
}
__device__ __forceinline__ float xhalf_max(float v) { auto rr = __builtin_amdgcn_permlane32_swap(__float_as_uint(v), __float_as_uint(v), false, false); return fmaxf(__uint_as_float(rr[0]), __uint_as_float(rr[1])); }
__device__ __forceinline__ float xhalf_sum(float v) { auto rr = __builtin_amdgcn_permlane32_swap(__float_as_uint(v), __float_as_uint(v), false, false); return __uint_as_float(rr[0]) + __uint_as_float(rr[1]); }
__device__ __forceinline__ float sigmoid_f(float x) { return rcpf_(1.0f + ex2(-LOG2E * x)); }
__device__ __forceinline__ int crow(int r, int hi) { return (r & 3) + 8 * (r >> 2) + 4 * hi; }
__device__ __forceinline__ int kperm(int p) { const int h = p >> 3, j = p & 7; return 8 * (j >> 2) + 4 * h + (j & 3); }
__device__ __forceinline__ int pperm(int k) { return ((k >> 2) & 1) * 8 + (k >> 3) * 4 + (k & 3); }

__device__ __forceinline__ void tr_item(const float* W, int K, int N, u16* WT, int kb, int n0, int dst_row0, LAS float* scr, int lane) {
    const int k0 = 64 * kb; const int n = n0 + (lane & 31); const bool ok = n < N;
#pragma unroll 8
    for (int i = 0; i < 32; ++i) { const int kk = 2 * i + (lane >> 5); scr[kk * 33 + (lane & 31)] = ok ? W[(size_t)(k0 + kk) * N + n] : 0.f; }
    asm volatile("s_waitcnt lgkmcnt(0)" ::: "memory");
    const int c = lane & 7;
#pragma unroll
    for (int j = 0; j < 4; ++j) { const int nn = (lane >> 3) + 8 * j; const LAS float* s = scr + (8 * c) * 33 + nn;
        u32x4 o; o.x = pkbf(s[0 * 33], s[1 * 33]); o.y = pkbf(s[2 * 33], s[3 * 33]); o.z = pkbf(s[4 * 33], s[5 * 33]); o.w = pkbf(s[6 * 33], s[7 * 33]);
        *(u32x4*)(WT + (size_t)(dst_row0 + nn) * K + k0 + 8 * c) = o; }
    asm volatile("s_waitcnt lgkmcnt(0)" ::: "memory");
}

__device__ __forceinline__ void norm_row(const float* xrow, const float* g, u16* dst16, float* dst32, int lane) {
    const f32x4* xr = (const f32x4*)xrow + lane; const f32x4* gr = (const f32x4*)g + lane;
    f32x4 v[4]; float s = 0.f;
#pragma unroll
    for (int j = 0; j < 4; ++j) { v[j] = xr[64 * j]; s += (v[j].x * v[j].x + v[j].y * v[j].y) + (v[j].z * v[j].z + v[j].w * v[j].w); }
    const float rstd = 1.0f / sqrtf(wave_sum(s, lane) * (1.0f / 1024.0f) + 1e-6f);
#pragma unroll
    for (int j = 0; j < 4; ++j) { const f32x4 gg = gr[64 * j]; const f32x4 y = v[j] * rstd * gg;
        if (dst16) { u32x2 o; o.x = pkbf(y.x, y.y); o.y = pkbf(y.z, y.w); *((u32x2*)dst16 + lane + 64 * j) = o; }
        else *((f32x4*)dst32 + lane + 64 * j) = y; }
}

struct AState { f32x16 o0, o1; float m, l; };
__device__ __forceinline__ void astate_init(AState& s) {
#pragma unroll
    for (int r = 0; r < 16; ++r) { s.o0[r] = 0.f; s.o1[r] = 0.f; }
    s.m = NEGF; s.l = 0.f;
}
template <int KS0, int NKS>
__device__ __forceinline__ void attn_tile(const LAS unsigned char* Kl, const LAS unsigned char* Vl, const bf16x8 (&qr)[4], float scale2, bool lutmode,
                                          const LAS float* lut1, int dbase, float lane_c, AState& st, int r32, int hi) {
    f32x16 s0, s1;
#pragma unroll
    for (int r = 0; r < 16; ++r) { s0[r] = 0.f; s1[r] = 0.f; }
    const LAS unsigned char* kp = Kl + r32 * 144 + hi * 16;
#pragma unroll
    for (int ks = 0; ks < NKS; ++ks) {
        const bf16x8 a0 = *(const LAS bf16x8*)(kp + (KS0 + ks) * 32);
        const bf16x8 a1 = *(const LAS bf16x8*)(kp + 32 * 144 + (KS0 + ks) * 32);
        s0 = __builtin_amdgcn_mfma_f32_32x32x16_bf16(a0, qr[KS0 + ks], s0, 0, 0, 0);
        s1 = __builtin_amdgcn_mfma_f32_32x32x16_bf16(a1, qr[KS0 + ks], s1, 0, 0, 0);
    }
    if (lutmode) {
#pragma unroll
        for (int r = 0; r < 16; ++r) { const int d0 = dbase - ((r & 3) + 8 * (r >> 2)); const int d1 = d0 - 32;
            const int i0 = min(max(d0, -1), 512), i1 = min(max(d1, -1), 512);
            s0[r] = fmaf(s0[r], scale2, lut1[i0]) + lane_c; s1[r] = fmaf(s1[r], scale2, lut1[i1]) + lane_c; }
    } else {
#pragma unroll
        for (int r = 0; r < 16; ++r) { s0[r] = fmaf(s0[r], scale2, lane_c); s1[r] = fmaf(s1[r], scale2, lane_c); }
    }
    float mx = fmaxf(s0[0], s1[0]);
#pragma unroll
    for (int r = 1; r < 16; ++r) mx = fmaxf(mx, fmaxf(s0[r], s1[r]));
    mx = xhalf_max(mx);
    const float mn = fmaxf(st.m, mx); const float alpha = ex2(st.m - mn); st.m = mn;
    float sum = 0.f;
#pragma unroll
    for (int r = 0; r < 16; ++r) { s0[r] = ex2(s0[r] - mn); s1[r] = ex2(s1[r] - mn); sum += s0[r] + s1[r]; }
    st.l = st.l * alpha + sum;
#pragma unroll
    for (int r = 0; r < 16; ++r) { st.o0[r] *= alpha; st.o1[r] *= alpha; }
    u32x4 pk[4];
    pk[0] = (u32x4){pkbf(s0[0], s0[1]), pkbf(s0[2], s0[3]), pkbf(s0[4], s0[5]), pkbf(s0[6], s0[7])};
    pk[1] = (u32x4){pkbf(s0[8], s0[9]), pkbf(s0[10], s0[11]), pkbf(s0[12], s0[13]), pkbf(s0[14], s0[15])};
    pk[2] = (u32x4){pkbf(s1[0], s1[1]), pkbf(s1[2], s1[3]), pkbf(s1[4], s1[5]), pkbf(s1[6], s1[7])};
    pk[3] = (u32x4){pkbf(s1[8], s1[9]), pkbf(s1[10], s1[11]), pkbf(s1[12], s1[13]), pkbf(s1[14], s1[15])};
    const LAS unsigned char* vp = Vl + r32 * 144 + hi * 16;
#pragma unroll
    for (int c = 0; c < 4; ++c) {
        const bf16x8 v0 = *(const LAS bf16x8*)(vp + c * 32);
        const bf16x8 v1 = *(const LAS bf16x8*)(vp + 32 * 144 + c * 32);
        const bf16x8 pb = __builtin_bit_cast(bf16x8, pk[c]);
        st.o0 = __builtin_amdgcn_mfma_f32_32x32x16_bf16(v0, pb, st.o0, 0, 0, 0);
        st.o1 = __builtin_amdgcn_mfma_f32_32x32x16_bf16(v1, pb, st.o1, 0, 0, 0);
    }
}

template <bool DIFF, bool WINDOW, int MODE>
__device__ __forceinline__ void run_tiles(LAS unsigned char* lds, int t0, int t1, const u16* Kg, const u16* Vtg, const bf16x8 (&qr)[4], float scale2, float c31,
                                          int q0w, unsigned mask, int qb, AState& A, AState& B2, int tid, int r32, int hi) {
    LAS unsigned char* Kl = lds + ATT_K; LAS unsigned char* Vl = lds + ATT_V; const LAS float* lut1 = (const LAS float*)(lds + ATT_LUT) + 1;
    const int srow = tid >> 3, sch = tid & 7;
    const u16* kg = Kg + (size_t)srow * PW + sch * 8;
    const u16* vg = Vtg + (size_t)srow * SEQ + sch * 8;
    u32x4 kreg = *(const u32x4*)(kg + (size_t)t0 * 64 * PW), vreg = *(const u32x4*)(vg + t0 * 64);
    for (int t = t0; t <= t1; ++t) {
        if (t > t0) __syncthreads();
        *(LAS u32x4*)(Kl + srow * 144 + sch * 16) = kreg; *(LAS u32x4*)(Vl + srow * 144 + sch * 16) = vreg;
        __syncthreads();
        if (t < t1) { kreg = *(const u32x4*)(kg + (size_t)(t + 1) * 64 * PW); vreg = *(const u32x4*)(vg + (t + 1) * 64); }
        const int k0 = t * 64, dmin = q0w - (k0 + 63), dmax = q0w + 31 - k0;
        const bool skip = dmax < 0 || (WINDOW && dmin >= 512);
        int sel = 1;
        if (MODE == 1) { const int blk = t >> 2; if (blk < qb) sel = (mask >> blk) & 1; }
        if (MODE == 2) sel = (mask >> t) & 1;
        if (!skip && __any(sel)) {
            const bool lutmode = dmin < 128 || (WINDOW && dmax >= 512);
            const float lane_c = sel ? (lutmode ? 0.f : c31) : NEGF;
            const int dbase = q0w + r32 - k0 - 4 * hi;
            if (DIFF) { attn_tile<0, 2>(Kl, Vl, qr, scale2, lutmode, lut1, dbase, lane_c, A, r32, hi); __builtin_amdgcn_sched_barrier(0); attn_tile<2, 2>(Kl, Vl, qr, scale2, lutmode, lut1, dbase, lane_c, B2, r32, hi); }
            else attn_tile<0, 4>(Kl, Vl, qr, scale2, lutmode, lut1, dbase, lane_c, A, r32, hi);
        }
    }
    __syncthreads();
}

__device__ __forceinline__ void build_lut(LAS unsigned char* lds, const float* rel_bias, int head, bool window, int tid) {
    LAS float* lut = (LAS float*)(lds + ATT_LUT);
    for (int i = tid; i < 514; i += 512) {
        float v;
        if (i == 0) v = NEGF;
        else if (i == 513) v = window ? NEGF : rel_bias[31 * 16 + head] * LOG2E;
        else { const int d = i - 1; int bk;
            if (d < 16) bk = d; else if (d >= 128) bk = 31; else { bk = 16 + (int)(log2f((float)d * (1.0f / 16.0f)) * (16.0f / 3.0f)); bk = bk > 31 ? 31 : bk; }
            v = rel_bias[bk * 16 + head] * LOG2E; }
        lut[i] = v;
    }
}
__device__ __forceinline__ void load_q(bf16x8 (&qr)[4], const u16* qrow, int hi) {
#pragma unroll
    for (int ks = 0; ks < 4; ++ks) qr[ks] = *(const bf16x8*)(qrow + ks * 16 + hi * 8);
}
__device__ __forceinline__ void store_o(u16* dst, const f32x16& v0, const f32x16& v1, int hi) {
#pragma unroll
    for (int g = 0; g < 4; ++g) {
        u32x2 a; a.x = pkbf(v0[4 * g], v0[4 * g + 1]); a.y = pkbf(v0[4 * g + 2], v0[4 * g + 3]); *(u32x2*)(dst + 8 * g + 4 * hi) = a;
        u32x2 b; b.x = pkbf(v1[4 * g], v1[4 * g + 1]); b.y = pkbf(v1[4 * g + 2], v1[4 * g + 3]); *(u32x2*)(dst + 32 + 8 * g + 4 * hi) = b;
    }
}

struct Ctx { LAS unsigned char* lds; int tid, lane, wave, r32, hi, G, bx; u16* proj; u16* obuf; u16* vt; };

__device__ __forceinline__ void moba_unit(const Ctx& C0, KParamsPtr P, int b, int h, int qb) {
    Ctx C = C0; C.lane = lane_opaque(); C.tid = C.wave * 64 + C.lane; C.r32 = C.lane & 31; C.hi = C.lane >> 5;
    const int q0w = __builtin_amdgcn_readfirstlane(qb * 256 + C.wave * 32); const int qpos = q0w + C.r32; const size_t tok = (size_t)b * SEQ + qpos;
    build_lut(C.lds, P->rel_bias, h, false, C.tid);
    const u16* qrow = C.proj + tok * PW + C_MQ + h * 64;
    bf16x8 qr[4]; load_q(qr, qrow, C.hi);
    unsigned mask = 0;
    if (qb > 0) {
        float g[7];
#pragma unroll
        for (int j = 0; j < 7; ++j) g[j] = 0.f;
        const float* km = (const float*)(P->ws + WS_KMEAN) + (size_t)((b * 4 + h) * 8) * 64;
#pragma unroll
        for (int dc = 0; dc < 8; ++dc) {
            const u32x4 qv = *(const u32x4*)(qrow + dc * 8);
            float qf[8]; qf[0] = bf2f(qv.x & 0xffffu); qf[1] = bf2f(qv.x >> 16); qf[2] = bf2f(qv.y & 0xffffu); qf[3] = bf2f(qv.y >> 16);
            qf[4] = bf2f(qv.z & 0xffffu); qf[5] = bf2f(qv.z >> 16); qf[6] = bf2f(qv.w & 0xffffu); qf[7] = bf2f(qv.w >> 16);
#pragma unroll
            for (int j = 0; j < 7; ++j) if (j < qb) { const float* kmj = km + j * 64 + dc * 8;
#pragma unroll
                for (int e = 0; e < 8; ++e) g[j] = fmaf(qf[e], kmj[e], g[j]); }
        }
#pragma unroll
        for (int j = 0; j < 7; ++j) if (j < qb) { int rank = 0;
#pragma unroll
            for (int i = 0; i < 7; ++i) if (i != j && i < qb) rank += (g[i] > g[j] || (g[i] == g[j] && i < j)) ? 1 : 0;
            if (rank < 3) mask |= 1u << j; }
    }
    AState A, B2; astate_init(A);
    const float c31 = P->rel_bias[31 * 16 + h] * LOG2E;
    run_tiles<false, false, 1>(C.lds, 0, 4 * qb + 3, C.proj + (size_t)b * SEQ * PW + C_MK + h * 64, C.vt + (size_t)((b * NVH + h) * 64) * SEQ, qr, 0.125f * LOG2E, c31, q0w, mask, qb, A, B2, C.tid, C.r32, C.hi);
    const float L = xhalf_sum(A.l); const float inv = 1.0f / L;
    A.o0 *= inv; A.o1 *= inv;
    store_o(C.obuf + tok * DM + h * 64, A.o0, A.o1, C.hi);
}

__device__ __forceinline__ void diff_unit(const Ctx& C0, KParamsPtr P, int layer, int b, int h, int qb) {
    Ctx C = C0; C.lane = lane_opaque(); C.tid = C.wave * 64 + C.lane; C.r32 = C.lane & 31; C.hi = C.lane >> 5;
    const int q0w = __builtin_amdgcn_readfirstlane(qb * 256 + C.wave * 32); const int qpos = q0w + C.r32; const size_t tok = (size_t)b * SEQ + qpos;
    build_lut(C.lds, P->rel_bias, 4 + h, false, C.tid);
    bf16x8 qr[4]; load_q(qr, C.proj + tok * PW + C_DQ + h * 64, C.hi);
    AState A, B2; astate_init(A); astate_init(B2);
    const float c31 = P->rel_bias[31 * 16 + 4 + h] * LOG2E;
    run_tiles<true, false, 0>(C.lds, 0, 4 * qb + 3, C.proj + (size_t)b * SEQ * PW + C_DK + h * 64, C.vt + (size_t)((b * NVH + 4 + h) * 64) * SEQ, qr, 0.17677669529663687f * LOG2E, c31, q0w, 0u, 0, A, B2, C.tid, C.r32, C.hi);
    const float* lp = P->diff_lambda + (size_t)layer * 128; float d01 = 0.f, d23 = 0.f;
    for (int i = 0; i < 32; ++i) { d01 = fmaf(lp[i], lp[32 + i], d01); d23 = fmaf(lp[64 + i], lp[96 + i], d23); }
    const float li = P->lam_init[layer]; const float lam = expf(d01) - expf(d23) + li;
    const float L0 = xhalf_sum(A.l), L1 = xhalf_sum(B2.l); const float i0 = 1.0f / L0, i1 = lam / L1;
    float ss = 0.f;
#pragma unroll
    for (int r = 0; r < 16; ++r) { A.o0[r] = A.o0[r] * i0 - B2.o0[r] * i1; A.o1[r] = A.o1[r] * i0 - B2.o1[r] * i1; ss += A.o0[r] * A.o0[r] + A.o1[r] * A.o1[r]; }
    ss = xhalf_sum(ss);
    const float rstd = (1.0f / sqrtf(ss * (1.0f / 64.0f) + 1e-6f)) * (1.0f - li);
    const float* sg = P->diff_subln + (size_t)layer * 64;
#pragma unroll
    for (int r = 0; r < 16; ++r) { const int d = crow(r, C.hi); A.o0[r] *= rstd * sg[d]; A.o1[r] *= rstd * sg[32 + d]; }
    { const int l2 = lane_opaque(); const size_t tok2 = (size_t)b * SEQ + q0w + (l2 & 31);
      store_o(C.obuf + tok2 * DM + 256 + h * 64, A.o0, A.o1, l2 >> 5); }
}

__device__ __forceinline__ void nsa_unit(const Ctx& C0, KParamsPtr P, int b, int hq, int qb) {
    Ctx C = C0; C.lane = lane_opaque(); C.tid = C.wave * 64 + C.lane; C.r32 = C.lane & 31; C.hi = C.lane >> 5;
    const int g = hq >> 2;
    const int q0w = __builtin_amdgcn_readfirstlane(qb * 256 + C.wave * 32); const int qpos = q0w + C.r32; const size_t tok = (size_t)b * SEQ + qpos;
    build_lut(C.lds, P->rel_bias, 8 + hq, false, C.tid);
    bf16x8 qr[4]; load_q(qr, C.proj + tok * PW + C_NQ + hq * 64, C.hi);
    const u16* gl = C.proj + tok * PW + C_NG + hq * 3;
    const float g1 = sigmoid_f(bf2f(gl[1])), g2 = sigmoid_f(bf2f(gl[2]));
    const unsigned mask = ((const unsigned*)(P->ws + WS_SEL))[(size_t)(b * 2 + g) * SEQ + qpos];
    const float c31 = P->rel_bias[31 * 16 + 8 + hq] * LOG2E;
    f32x16 r0, r1;
    AState A, B2; astate_init(A);
    run_tiles<false, false, 2>(C.lds, 0, 4 * qb + 3, C.proj + (size_t)b * SEQ * PW + C_NKS + g * 64, C.vt + (size_t)((b * NVH + 8 + g) * 64) * SEQ, qr, 0.125f * LOG2E, c31, q0w, mask, qb, A, B2, C.tid, C.r32, C.hi);
    { const float L = xhalf_sum(A.l); const float f = g1 / L; r0 = A.o0 * f; r1 = A.o1 * f; }
    if (C.tid == 0) ((LAS float*)(C.lds + ATT_LUT))[513] = NEGF;
    astate_init(A);
    const int tw0 = 4 * qb - 8 < 0 ? 0 : 4 * qb - 8;
    run_tiles<false, true, 0>(C.lds, tw0, 4 * qb + 3, C.proj + (size_t)b * SEQ * PW + C_NKW + g * 64, C.vt + (size_t)((b * NVH + 10 + g) * 64) * SEQ, qr, 0.125f * LOG2E, c31, q0w, 0u, qb, A, B2, C.tid, C.r32, C.hi);
    { const float L = xhalf_sum(A.l); const float f = g2 / L; r0 += A.o0 * f; r1 += A.o1 * f; }
    u16* dst = C.obuf + tok * DM + 512 + hq * 64;
#pragma unroll
    for (int gg = 0; gg < 4; ++gg) {
        const u32x2 a = *(const u32x2*)(dst + 8 * gg + 4 * C.hi), bq = *(const u32x2*)(dst + 32 + 8 * gg + 4 * C.hi);
        r0[4 * gg] += bf2f(a.x & 0xffffu); r0[4 * gg + 1] += bf2f(a.x >> 16); r0[4 * gg + 2] += bf2f(a.y & 0xffffu); r0[4 * gg + 3] += bf2f(a.y >> 16);
        r1[4 * gg] += bf2f(bq.x & 0xffffu); r1[4 * gg + 1] += bf2f(bq.x >> 16); r1[4 * gg + 2] += bf2f(bq.y & 0xffffu); r1[4 * gg + 3] += bf2f(bq.y >> 16);
    }
    store_o(dst, r0, r1, C.hi);
}

__device__ __forceinline__ void cmp_unit(const Ctx& C0, KParamsPtr P, int b, int g, int qblk) {
    Ctx C = C0; C.lane = lane_opaque(); C.tid = C.wave * 64 + C.lane; C.r32 = C.lane & 31; C.hi = C.lane >> 5;
    LAS unsigned char* lds = C.lds; const int tid = C.tid, r32 = C.r32, hi = C.hi;
    const u16* kc = (const u16*)(P->ws + WS_KCMP) + (size_t)(b * 2 + g) * 128 * 64;
    const u16* vc = (const u16*)(P->ws + WS_VCMPT) + (size_t)(b * 2 + g) * 64 * 128;
#pragma unroll
    for (int i = 0; i < 2; ++i) { const int e = tid + 512 * i;
        { const int row = e >> 3, ch = e & 7; *(LAS u32x4*)(lds + CMP_K + row * 144 + ch * 16) = *(const u32x4*)(kc + row * 64 + ch * 8); }
        { const int row = e >> 4, ch = e & 15; *(LAS u32x4*)(lds + CMP_V + row * 272 + ch * 16) = *(const u32x4*)(vc + row * 128 + ch * 8); } }
    for (int i = tid; i < 64 * 128; i += 512) ((LAS float*)(lds + CMP_P))[i] = 0.f;
    if (tid < 64) ((LAS unsigned*)(lds + CMP_MASK))[tid] = 0u;
    const int rh = C.wave >> 1, sub = C.wave & 1, hq = g * 4 + rh;
    const int ql = sub * 32 + r32, qpos = qblk * 64 + ql; const size_t tok = (size_t)b * SEQ + qpos;
    bf16x8 qr[4]; load_q(qr, C.proj + tok * PW + C_NQ + hq * 64, hi);
    const float g0 = sigmoid_f(bf2f(C.proj[tok * PW + C_NG + hq * 3]));
    __syncthreads();
    f32x16 s[4];
    const LAS unsigned char* kp = lds + CMP_K + r32 * 144 + hi * 16;
#pragma unroll
    for (int kb = 0; kb < 4; ++kb) {
#pragma unroll
        for (int r = 0; r < 16; ++r) s[kb][r] = 0.f;
#pragma unroll
        for (int ks = 0; ks < 4; ++ks) { const bf16x8 a = *(const LAS bf16x8*)(kp + kb * 32 * 144 + ks * 32); s[kb] = __builtin_amdgcn_mfma_f32_32x32x16_bf16(a, qr[ks], s[kb], 0, 0, 0); }
    }
    const int nmax = (qpos - 31) >> 4;
    float mx = NEGF;
#pragma unroll
    for (int kb = 0; kb < 4; ++kb)
#pragma unroll
        for (int r = 0; r < 16; ++r) { const int n = 32 * kb + crow(r, hi); const float v = (n <= nmax) ? s[kb][r] * (0.125f * LOG2E) : NEGF; s[kb][r] = v; mx = fmaxf(mx, v); }
    mx = xhalf_max(mx);
    float sum = 0.f;
#pragma unroll
    for (int kb = 0; kb < 4; ++kb)
#pragma unroll
        for (int r = 0; r < 16; ++r) { const int n = 32 * kb + crow(r, hi); const float pv = (n <= nmax) ? ex2(s[kb][r] - mx) : 0.f; s[kb][r] = pv; sum += pv; }
    sum = xhalf_sum(sum);
    const float inv = nmax >= 0 ? 1.0f / sum : 0.f;
    LAS float* Ps = (LAS float*)(lds + CMP_P) + ql * 128;
#pragma unroll
    for (int kb = 0; kb < 4; ++kb)
#pragma unroll
        for (int r = 0; r < 16; ++r) { const float pn = s[kb][r] * inv; s[kb][r] = pn; if (pn != 0.f) (void)__hip_atomic_fetch_add(Ps + 32 * kb + crow(r, hi), pn, __ATOMIC_RELAXED, __HIP_MEMORY_SCOPE_WORKGROUP); }
    f32x16 o0, o1;
#pragma unroll
    for (int r = 0; r < 16; ++r) { o0[r] = 0.f; o1[r] = 0.f; }
    const LAS unsigned char* vp = lds + CMP_V + r32 * 272 + hi * 16;
#pragma unroll
    for (int kb = 0; kb < 4; ++kb)
#pragma unroll
        for (int c = 0; c < 2; ++c) {
            const u32x4 pk = (u32x4){pkbf(s[kb][8 * c], s[kb][8 * c + 1]), pkbf(s[kb][8 * c + 2], s[kb][8 * c + 3]), pkbf(s[kb][8 * c + 4], s[kb][8 * c + 5]), pkbf(s[kb][8 * c + 6], s[kb][8 * c + 7])};
            const bf16x8 pb = __builtin_bit_cast(bf16x8, pk);
            const bf16x8 v0 = *(const LAS bf16x8*)(vp + (kb * 2 + c) * 32);
            const bf16x8 v1 = *(const LAS bf16x8*)(vp + 32 * 272 + (kb * 2 + c) * 32);
            o0 = __builtin_amdgcn_mfma_f32_32x32x16_bf16(v0, pb, o0, 0, 0, 0);
            o1 = __builtin_amdgcn_mfma_f32_32x32x16_bf16(v1, pb, o1, 0, 0, 0);
        }
    o0 *= g0; o1 *= g0;
    store_o(C.obuf + tok * DM + 512 + hq * 64, o0, o1, hi);
    __syncthreads();
    { const int q = tid >> 3, jj = tid & 7; const LAS float* Pq = (const LAS float*)(lds + CMP_P) + q * 128; LAS float* imp = (LAS float*)(lds + CMP_IMP) + q * 33;
#pragma unroll
        for (int e = 0; e < 4; ++e) { const int j = jj * 4 + e; float v = Pq[4 * j] + Pq[4 * j + 1] + Pq[4 * j + 2] + 0.5f * Pq[4 * j + 3]; if (j > 0) v += 0.5f * Pq[4 * j - 1]; imp[j] = v; } }
    __syncthreads();
    { const int q = tid & 63, part = tid >> 6; const int qp = qblk * 64 + q; const int cur = qp >> 6; const LAS float* imp = (const LAS float*)(lds + CMP_IMP) + q * 33;
        unsigned bits = 0;
        for (int e = 0; e < 4; ++e) { const int j = part * 4 + e;
            if (j <= cur) { const float sj = (j == 0 || j > cur - 2) ? 1e4f : imp[j]; int rank = 0;
                for (int i = 0; i <= cur; ++i) { const float si = (i == 0 || i > cur - 2) ? 1e4f : imp[i]; rank += (si > sj || (si == sj && i < j)) ? 1 : 0; }
                if (rank < 16) bits |= 1u << j; } }
        if (bits) (void)__hip_atomic_fetch_or((LAS unsigned*)(lds + CMP_MASK) + q, bits, __ATOMIC_RELAXED, __HIP_MEMORY_SCOPE_WORKGROUP); }
    __syncthreads();
    if (tid < 64) ((unsigned*)(P->ws + WS_SEL))[(size_t)(b * 2 + g) * SEQ + qblk * 64 + tid] = ((LAS unsigned*)(lds + CMP_MASK))[tid];
    __syncthreads();
}

__device__ __forceinline__ void prep_a(const Ctx& C, KParamsPtr P, int layer) {
    const int G = C.G, tid = C.tid, lane = C.lane;
    for (int it = C.bx; it < NB * NVH * 32; it += G) {
        const int tb = it & 31, hv = (it >> 5) % NVH, b = it / (32 * NVH);
        const int vcol = hv < 4 ? C_MV + hv * 64 : hv < 8 ? C_DV + (hv - 4) * 64 : hv < 10 ? C_NVS + (hv - 8) * 64 : C_NVW + (hv - 10) * 64;
        { const int row = tid >> 3, ch = tid & 7; *(LAS u32x4*)(C.lds + row * 144 + ch * 16) = *(const u32x4*)(C.proj + ((size_t)b * SEQ + tb * 64 + row) * PW + vcol + ch * 8); }
        __syncthreads();
        { const int d = tid >> 3, pc = tid & 7; unsigned w[4];
#pragma unroll
            for (int e = 0; e < 4; ++e) { const int p0 = pc * 8 + 2 * e, p1 = p0 + 1; const int k0 = (p0 & ~15) + kperm(p0 & 15), k1 = (p1 & ~15) + kperm(p1 & 15);
                const unsigned a = *(const LAS u16*)(C.lds + k0 * 144 + d * 2), bb = *(const LAS u16*)(C.lds + k1 * 144 + d * 2); w[e] = a | (bb << 16); }
            *(u32x4*)(C.vt + ((size_t)(b * NVH + hv) * 64 + d) * SEQ + tb * 64 + pc * 8) = (u32x4){w[0], w[1], w[2], w[3]}; }
        __syncthreads();
    }
    const int gw = C.bx * 8 + C.wave, NGW = G * 8;
    for (int it = gw; it < NB * 4 * 8; it += NGW) {
        const int blk = it & 7, h = (it >> 3) & 3, b = it >> 5;
        const u16* kp = C.proj + ((size_t)b * SEQ + blk * 256) * PW + C_MK + h * 64 + lane; float s = 0.f;
        for (int k = 0; k < 256; ++k) s += bf2f(kp[(size_t)k * PW]);
        ((float*)(P->ws + WS_KMEAN))[(size_t)it * 64 + lane] = s * (1.0f / 256.0f);
    }
    u16* acmp = (u16*)(P->ws + WS_XN);
    for (int it = gw; it < 2 * 4096; it += NGW) {
        const int i = it >> 12, row = it & 4095, n = row & 127, bg = row >> 7, b = bg >> 1, g = bg & 1;
        u16* dst = acmp + (size_t)it * 2048; const float* pe = P->cmp_pe + (size_t)(layer * 2 + i) * 2048;
        const int col = (i == 0 ? C_NKC : C_NVC) + g * 64;
#pragma unroll
        for (int pass = 0; pass < 4; ++pass) { const int l = pass * 8 + (lane >> 3), d0 = (lane & 7) * 8;
            unsigned z0 = 0u; asm volatile("" : "+v"(z0)); u32x4 o = (u32x4){z0, z0, z0, z0};
            if (n < 127) { const u32x4 v = *(const u32x4*)(C.proj + ((size_t)b * SEQ + 16 * n + l) * PW + col + d0); const f32x4 e0 = *(const f32x4*)(pe + l * 64 + d0), e1 = *(const f32x4*)(pe + l * 64 + d0 + 4);
                o.x = pkbf(bf2f(v.x & 0xffffu) + e0.x, bf2f(v.x >> 16) + e0.y); o.y = pkbf(bf2f(v.y & 0xffffu) + e0.z, bf2f(v.y >> 16) + e0.w);
                o.z = pkbf(bf2f(v.z & 0xffffu) + e1.x, bf2f(v.z >> 16) + e1.y); o.w = pkbf(bf2f(v.w & 0xffffu) + e1.z, bf2f(v.w >> 16) + e1.w); }
            *(u32x4*)(dst + l * 64 + d0) = o; }
    }
}
__device__ __forceinline__ void prep_c(const Ctx& C, KParamsPtr P, int layer) {
    const int gw = C.bx * 8 + C.wave, NGW = C.G * 8, lane = C.lane;
    for (int it = gw; it < 2 * 4096; it += NGW) {
        const int i = it >> 12, row = it & 4095;
        const u16* hrow = (const u16*)(P->ws + WS_HID) + (size_t)it * 256; const float* w2 = P->cmp_w2 + (size_t)(layer * 2 + i) * 256 * 64 + lane;
        float acc = 0.f;
        for (int j = 0; j < 256; j += 8) { const u32x4 hv = *(const u32x4*)(hrow + j);
            acc = fmaf(bf2f(hv.x & 0xffffu), w2[(j + 0) * 64], acc); acc = fmaf(bf2f(hv.x >> 16), w2[(j + 1) * 64], acc);
            acc = fmaf(bf2f(hv.y & 0xffffu), w2[(j + 2) * 64], acc); acc = fmaf(bf2f(hv.y >> 16), w2[(j + 3) * 64], acc);
            acc = fmaf(bf2f(hv.z & 0xffffu), w2[(j + 4) * 64], acc); acc = fmaf(bf2f(hv.z >> 16), w2[(j + 5) * 64], acc);
            acc = fmaf(bf2f(hv.w & 0xffffu), w2[(j + 6) * 64], acc); acc = fmaf(bf2f(hv.w >> 16), w2[(j + 7) * 64], acc); }
        const unsigned bits = pkbf(acc, 0.f) & 0xffffu;
        if (i == 0) ((u16*)(P->ws + WS_KCMP))[(size_t)row * 64 + lane] = (u16)bits;
        else { const int bg = row >> 7, n = row & 127; ((u16*)(P->ws + WS_VCMPT))[((size_t)bg * 64 + lane) * 128 + (n & ~15) + pperm(n & 15)] = (u16)bits; }
    }
}

__device__ __forceinline__ void convert_weights(const Ctx& C, KParamsPtr P, int layer) {
    LAS float* scr = (LAS float*)(C.lds + C.wave * 16384);
    const int gw = C.bx * 8 + C.wave, NGW = C.G * 8, lane = C.lane;
    constexpr int I_G = 16 * 88, I_D = 44 * 32, I_IN = 16 * 96, I_O = 16 * 32, I_W1 = 32 * 8;
    constexpr int NIT = 4 * I_G + 2 * I_D + I_IN + I_O + 2 * I_W1;
    unsigned char* ws = P->ws;
    for (int it = gw; it < NIT; it += NGW) {
        int r = it;
        if (r < 4 * I_G) { const int which = r / I_G; r -= which * I_G; const int kb = r / 88, nb = r % 88, n0 = nb * 32;
            const float* W = (which == 0 ? P->ffn1_gate : which == 1 ? P->ffn1_up : which == 2 ? P->ffn2_gate : P->ffn2_up) + (size_t)layer * DM * DFF;
            u16* WT = (u16*)(ws + (which < 2 ? WS_GU1 : WS_GU2));
            tr_item(W, DM, DFF, WT, kb, n0, (n0 >> 7) * 256 + (which & 1) * 128 + (n0 & 127), scr, lane); continue; }
        r -= 4 * I_G;
        if (r < 2 * I_D) { const int which = r / I_D; r -= which * I_D; const int kb = r / 32, nb = r % 32;
            const float* W = (which == 0 ? P->ffn1_down : P->ffn2_down) + (size_t)layer * DFF * DM;
            tr_item(W, DFF, DM, (u16*)(ws + (which == 0 ? WS_DN1 : WS_DN2)), kb, nb * 32, nb * 32, scr, lane); continue; }
        r -= 2 * I_D;
        if (r < I_IN) { const int kb = r / 96, nb = r % 96; tr_item(P->w_in + (size_t)layer * DM * INW, DM, INW, (u16*)(ws + WS_WIN), kb, nb * 32, nb * 32, scr, lane); continue; }
        r -= I_IN;
        if (r < I_O) { const int kb = r / 32, nb = r % 32; tr_item(P->w_out + (size_t)layer * DM * DM, DM, DM, (u16*)(ws + WS_WOUT), kb, nb * 32, nb * 32, scr, lane); continue; }
        r -= I_O;
        { const int i = r / I_W1; r -= i * I_W1; const int kb = r / 8, nb = r % 8;
            tr_item(P->cmp_w1 + (size_t)(layer * 2 + i) * 2048 * 256, 2048, 256, (u16*)(ws + WS_W1) + (size_t)i * 256 * 2048, kb, nb * 32, nb * 32, scr, lane); }
    }
}
__device__ __forceinline__ void norm_phase(const Ctx& C, const float* src, const float* g, u16* dst16, float* dst32) {
    const int gw = C.bx * 8 + C.wave, NGW = C.G * 8;
    for (int m = gw; m < MTOK; m += NGW) norm_row(src + (size_t)m * DM, g, dst16 ? dst16 + (size_t)m * DM : nullptr, dst32 ? dst32 + (size_t)m * DM : nullptr, C.lane);
}

__global__ void __launch_bounds__(512, 2) hybrid_fwd(Params P0) {
    extern __shared__ __attribute__((aligned(16))) unsigned char lds_raw[];
    const KParamsPtr kp0 = (KParamsPtr)__builtin_amdgcn_kernarg_segment_ptr();
    cg::grid_group grid = cg::this_grid();
    const int ph_lo = P0.ph_lo, ph_hi = P0.ph_hi; const int wave_s = __builtin_amdgcn_readfirstlane(threadIdx.x >> 6);
    for (int ph = ph_lo; ph < ph_hi; ++ph) {
        KParamsPtr kpl = kp0; asm volatile("" : "+s"(kpl));
        const KParamsPtr P = kpl; unsigned char* ws = P->ws;
        u16* XN = (u16*)(ws + WS_XN); u16* HB = (u16*)(ws + WS_PROJ);
        int G = gridDim.x, bx = blockIdx.x; asm volatile("" : "+s"(G), "+s"(bx));
        Ctx C; C.G = G; C.bx = bx; C.lds = (LAS unsigned char*)lds_raw; C.wave = wave_s; C.lane = lane_opaque(); C.tid = wave_s * 64 + C.lane; C.r32 = C.lane & 31; C.hi = C.lane >> 5;
        C.proj = (u16*)(ws + WS_PROJ); C.obuf = (u16*)(ws + WS_XN); C.vt = (u16*)(ws + WS_VT);
        const int layer = ph / NPH_L, s = ph % NPH_L;
        if (ph == NPH - 1) { norm_phase(C, P->out, P->final_norm, nullptr, P->out); }
        else switch (s) {
        case 0: { convert_weights(C, P, layer); __syncthreads(); norm_phase(C, layer == 0 ? P->x : P->out, P->norm_ffn1 + (size_t)layer * DM, XN, nullptr); } break;
        case 3: { norm_phase(C, P->out, P->norm_mix + (size_t)layer * DM, XN, nullptr); } break;
        case 11: { norm_phase(C, P->out, P->norm_ffn2 + (size_t)layer * DM, XN, nullptr); } break;
#ifndef NO_GEMM
#ifndef NO_G1
        case 1: case 12: {
            pg8::Gemm g{XN, (const u16*)(ws + (s == 1 ? WS_GU1 : WS_GU2)), MTOK, 2 * DFF, DM}; pg8::StaticOrder S; S.init(MTOK, 2 * DFF, G, bx);
            pg8::EpiSwiGLU E{HB, DFF};
            pg8::gemm_phase<pg8::EpiSwiGLU, pg8::StaticOrder, true, true>(C.lds, g, S, E, C.wave); } break;
#endif
#ifndef NO_G2
        case 2: case 13: case 10: {
            const u16* A = (s == 10) ? (const u16*)XN : (const u16*)HB; const u16* Bt = (const u16*)(ws + (s == 2 ? WS_DN1 : s == 13 ? WS_DN2 : WS_WOUT));
            pg8::Gemm g{A, Bt, MTOK, DM, s == 10 ? DM : DFF}; pg8::StaticOrder S; S.init(MTOK, DM, G, bx);
            pg8::EpiResid E{(layer == 0 && s == 2) ? P->x : (const float*)P->out, P->out, DM, s == 10 ? 1.0f : 0.5f};
            pg8::gemm_phase<pg8::EpiResid, pg8::StaticOrder, true, true>(C.lds, g, S, E, C.wave); } break;
#endif
#ifndef NO_G4
        case 4: {
            pg8::Gemm g{XN, (const u16*)(ws + WS_WIN), MTOK, PW, DM}; pg8::StaticOrder S; S.init(MTOK, PW, G, bx);
            pg8::EpiBf16<0> E{C.proj, PW};
            pg8::gemm_phase<pg8::EpiBf16<0>, pg8::StaticOrder, true, true>(C.lds, g, S, E, C.wave); } break;
#endif
#endif
#ifndef NO_PREP
        case 5: prep_a(C, P, layer); break;
#endif
#if !defined(NO_GEMM) && !defined(NO_G6)
        case 6: {
            for (int i = 0; i < 2; ++i) {
                pg8::Gemm g{(const u16*)XN + (size_t)i * 4096 * 2048, (const u16*)(ws + WS_W1) + (size_t)i * 256 * 2048, 4096, 256, 2048}; pg8::StaticOrder S; S.init(4096, 256, G, (bx + G - 16 * i) % G);
                pg8::EpiBf16<1> E{(u16*)(ws + WS_HID) + (size_t)i * 4096 * 256, 256};
                pg8::gemm_phase<pg8::EpiBf16<1>, pg8::StaticOrder, true, true>(C.lds, g, S, E, C.wave); } } break;
#endif
#ifndef NO_PREP
        case 7: prep_c(C, P, layer); break;
#endif
#ifndef NO_ATT1
        case 8: {
            for (int u0 = bx; u0 < 2048; u0 += G) {
                if (u0 < 1024) { const int rnd = u0 >> 8, pos = ((u0 & 255) + 64 * rnd) & 255, grp = pos >> 6, bh = pos & 63, b = bh >> 2, h = bh & 3;
                    const int qb = ((grp & 2) ? 6 : 7) - 2 * rnd;
                    if (grp & 1) {
#ifndef NO_MOBA
                        moba_unit(C, P, b, h, qb);
#endif
                    } else {
#ifndef NO_DIFF
                        diff_unit(C, P, layer, b, h, qb);
#endif
                    } }
                else { const int c = u0 - 1024;
#ifndef NO_CMP
                    cmp_unit(C, P, c >> 6, (c >> 5) & 1, c & 31);
#endif
                }
            } } break;
#endif
#ifndef NO_ATT2
        case 9: {
            for (int u0 = bx, rnd = 0; u0 < 1024; u0 += G, ++rnd) {
                const int base = u0 - bx; int pos = bx; if ((rnd & 1) && base + G <= 1024) pos = G - 1 - bx; const int u = base + pos;
                nsa_unit(C, P, (u & 127) >> 3, u & 7, 7 - (u >> 7)); }
            } break;
#endif
        default: break;
        }
        if (ph + 1 < ph_hi) grid.sync();
    }
}

#ifndef COOP
#define COOP 1
#endif
extern "C" void kernel_launch(void* const* d_in, const int* in_sizes, int n_in, void* d_out, int out_size, void* d_ws, size_t ws_size, hipStream_t stream) {
    static int grid = 0;
    if (grid == 0) {
        if (n_in != 19 || out_size != MTOK * DM || ws_size < WS_END) { fprintf(stderr, "kernel_launch: unexpected shapes (n_in %d out %d ws %zu)\n", n_in, out_size, ws_size); grid = -1; return; }
        int dev = 0, cus = 0, per_cu = 0;
        (void)hipGetDevice(&dev); (void)hipDeviceGetAttribute(&cus, hipDeviceAttributeMultiprocessorCount, dev);
        if (hipFuncSetAttribute((const void*)hybrid_fwd, hipFuncAttributeMaxDynamicSharedMemorySize, LDS_BYTES) != hipSuccess) { fprintf(stderr, "kernel_launch: hipFuncSetAttribute failed\n"); grid = -1; return; }
        if (hipOccupancyMaxActiveBlocksPerMultiprocessor(&per_cu, (const void*)hybrid_fwd, 512, LDS_BYTES) != hipSuccess || per_cu < 1) { fprintf(stderr, "kernel_launch: occupancy query says %d\n", per_cu); per_cu = 1; }
        (void)hipGetLastError();
        grid = cus * per_cu;
    }
    if (grid < 0) return;
    Params p{};
    p.x = (const float*)d_in[0]; p.rel_bias = (const float*)d_in[1]; p.norm_ffn1 = (const float*)d_in[2]; p.ffn1_gate = (const float*)d_in[3]; p.ffn1_up = (const float*)d_in[4]; p.ffn1_down = (const float*)d_in[5];
    p.norm_mix = (const float*)d_in[6]; p.w_in = (const float*)d_in[7]; p.diff_lambda = (const float*)d_in[8]; p.diff_subln = (const float*)d_in[9]; p.cmp_pe = (const float*)d_in[10]; p.cmp_w1 = (const float*)d_in[11];
    p.cmp_w2 = (const float*)d_in[12]; p.w_out = (const float*)d_in[13]; p.norm_ffn2 = (const float*)d_in[14]; p.ffn2_gate = (const float*)d_in[15]; p.ffn2_up = (const float*)d_in[16]; p.ffn2_down = (const float*)d_in[17];
    p.final_norm = (const float*)d_in[18]; p.out = (float*)d_out; p.ws = (unsigned char*)d_ws;
    for (int l = 0; l < 4; ++l) p.lam_init[l] = (float)(0.8 - 0.6 * exp(-0.3 * (double)l));
#if COOP
    p.ph_lo = 0; p.ph_hi = NPH;
    void* args[] = {&p};
    hipError_t e = hipLaunchCooperativeKernel((const void*)hybrid_fwd, dim3(grid), dim3(512), args, LDS_BYTES, stream);
    if (e != hipSuccess) fprintf(stderr, "cooperative launch failed: %s (grid %d)\n", hipGetErrorString(e), grid);
#else
    for (int ph = 0; ph < NPH; ++ph) { p.ph_lo = ph; p.ph_hi = ph + 1; hipLaunchKernelGGL(hybrid_fwd, dim3(grid), dim3(512), LDS_BYTES, stream, p); }
#endif
}
```

```cpp
#include <hip/hip_runtime.h>
#include <hip/hip_cooperative_groups.h>
#include <cstdio>
#include <cstdint>
#include <cmath>
namespace cg = cooperative_groups;
#define COOP 1
namespace pg8 {
#define PG8_LAS __attribute__((address_space(3)))
typedef unsigned short bf16_t;
typedef short bf16x8 __attribute__((ext_vector_type(8)));
typedef float f32x4 __attribute__((ext_vector_type(4)));
typedef unsigned u32x4 __attribute__((ext_vector_type(4)));
constexpr int BM = 256, BK = 64, HALF = 128, HTB = HALF * BK * 2  , STAGE_BYTES = 8 * HTB, NXCD = 8, WGM = 8;

__host__ __device__ __forceinline__ int lds_byte(int r, int c) { const int st = (r >> 4) * 2 + (c >> 5), rr = r & 15, cc = c & 31, ob = rr * 64 + cc * 2; return st * 1024 + (ob ^ (((ob >> 9) & 1) << 5)); }
__host__ __device__ __forceinline__ void stage_rc(int b, int& R, int& C) { const int st = b / 1024, sb = b % 1024, swz = sb ^ (((sb >> 9) & 1) << 5); R = (st >> 1) * 16 + swz / 64; C = (st & 1) * 32 + (swz % 64) / 2; }
__host__ __device__ __forceinline__ int perm32(int rho) { const int n = rho >> 4, i = rho & 15; return 8 * (i >> 2) + 4 * n + (i & 3); }

struct Unit { int pm, pn; };
struct Gemm { const bf16_t* A; const bf16_t* Bt; int M, N, K; };

struct StaticOrder {
    int nM, nN, nwg, G, c;
    __host__ __device__ void init(int M, int N, int G_, int c_) { nM = M / BM; nN = N / BM; nwg = nM * nN; G = G_; c = c_; }
    __host__ __device__ bool next(int i, Unit& u) const {
        const long L = (long)i * G + c; if (L >= nwg) return false;
        int wgid = (int)L; { const int q = nwg / NXCD, r = nwg % NXCD, xcd = wgid % NXCD, off = wgid / NXCD; wgid = (xcd < r ? xcd * (q + 1) : r * (q + 1) + (xcd - r) * q) + off; }
        const int nig = WGM * nN, gid = wgid / nig, fm = gid * WGM, gsz = (nM - fm) < WGM ? (nM - fm) : WGM;
        u.pm = fm + ((wgid % nig) % gsz); u.pn = (wgid % nig) / gsz; return true;
    }
    __device__ __forceinline__ void a_ready(const Unit&) const {}
    __device__ __forceinline__ void done(const Unit&) const {}
};

__device__ __forceinline__ unsigned cvt_pk_bf16(float lo, float hi) { unsigned r; asm volatile("v_cvt_pk_bf16_f32 %0, %1, %2" : "=v"(r) : "v"(lo), "v"(hi)); return r; }

__device__ __forceinline__ float ex2(float x) { return __builtin_amdgcn_exp2f(x); }
__device__ __forceinline__ float rcpf_(float x) { return __builtin_amdgcn_rcpf(x); }
__device__ __forceinline__ float silu_f(float x) { return x * rcpf_(1.0f + ex2(-1.4426950408889634f * x)); }
__device__ __forceinline__ float gelu_tanh_f(float x) { const float y2 = 2.0f * 0.7978845608028654f * (x + 0.044715f * x * x * x); return x * (1.0f - rcpf_(1.0f + ex2(1.4426950408889634f * y2))); }

struct EpiSwiGLU {
    static constexpr bool PERM = true, AFTER_DRAIN = false;
    bf16_t* O; int ldc;
    __device__ __forceinline__ void operator()(const f32x4 (&acc)[2][2][4][2], const Unit& u, int wr, int wc, int fr, int fq) const {
        const int row0 = u.pm * BM + wr * 64 + fr; const int col0 = u.pn * HALF + wc * 32 + 8 * fq;
#pragma unroll
        for (int ai = 0; ai < 2; ++ai)
#pragma unroll
            for (int m = 0; m < 4; ++m) { bf16_t* rowp = O + (size_t)(row0 + ai * HALF + m * 16) * ldc + col0;
                const f32x4 g0 = acc[ai][0][m][0], g1 = acc[ai][0][m][1], u0 = acc[ai][1][m][0], u1 = acc[ai][1][m][1];
                u32x4 w; w.x = cvt_pk_bf16(silu_f(g0[0]) * u0[0], silu_f(g0[1]) * u0[1]); w.y = cvt_pk_bf16(silu_f(g0[2]) * u0[2], silu_f(g0[3]) * u0[3]);
                w.z = cvt_pk_bf16(silu_f(g1[0]) * u1[0], silu_f(g1[1]) * u1[1]); w.w = cvt_pk_bf16(silu_f(g1[2]) * u1[2], silu_f(g1[3]) * u1[3]);
                *(u32x4*)rowp = w; asm volatile("" ::: "memory"); }
    }
};
template <int ACT> struct EpiBf16 {
    static constexpr bool PERM = true, AFTER_DRAIN = false;
    bf16_t* O; int ldc;
    __device__ __forceinline__ void operator()(const f32x4 (&acc)[2][2][4][2], const Unit& u, int wr, int wc, int fr, int fq) const {
        const int row0 = u.pm * BM + wr * 64 + fr; const int col0 = u.pn * BM + wc * 32 + 8 * fq;
#pragma unroll
        for (int ai = 0; ai < 2; ++ai)
#pragma unroll
            for (int m = 0; m < 4; ++m) { bf16_t* rowp = O + (size_t)(row0 + ai * HALF + m * 16) * ldc + col0;
#pragma unroll
                for (int bj = 0; bj < 2; ++bj) { f32x4 v0 = acc[ai][bj][m][0], v1 = acc[ai][bj][m][1];
                    if (ACT == 1) { v0 = (f32x4){gelu_tanh_f(v0[0]), gelu_tanh_f(v0[1]), gelu_tanh_f(v0[2]), gelu_tanh_f(v0[3])}; v1 = (f32x4){gelu_tanh_f(v1[0]), gelu_tanh_f(v1[1]), gelu_tanh_f(v1[2]), gelu_tanh_f(v1[3])}; }
                    u32x4 w; w.x = cvt_pk_bf16(v0[0], v0[1]); w.y = cvt_pk_bf16(v0[2], v0[3]); w.z = cvt_pk_bf16(v1[0], v1[1]); w.w = cvt_pk_bf16(v1[2], v1[3]);
                    *(u32x4*)(rowp + bj * HALF) = w; } asm volatile("" ::: "memory"); }
    }
};
struct EpiResid {
    static constexpr bool PERM = false, AFTER_DRAIN = false;
    const float* base; float* out; int ldc; float alpha;
    __device__ __forceinline__ void operator()(const f32x4 (&acc)[2][2][4][2], const Unit& u, int wr, int wc, int fr, int fq) const {
        const int row0 = u.pm * BM + wr * 64 + fr; const int col0 = u.pn * BM + wc * 32 + 4 * fq;
#pragma unroll
        for (int ai = 0; ai < 2; ++ai)
#pragma unroll
            for (int m = 0; m < 4; ++m) { const size_t off = (size_t)(row0 + ai * HALF + m * 16) * ldc + col0;
#pragma unroll
                for (int bj = 0; bj < 2; ++bj)
#pragma unroll
                    for (int n = 0; n < 2; ++n) { const f32x4 bs = *(const f32x4*)(base + off + bj * HALF + n * 16); *(f32x4*)(out + off + bj * HALF + n * 16) = bs + acc[ai][bj][m][n] * alpha; } asm volatile("" ::: "memory"); }
    }
};
template <class Epi, class Sched, bool ALIGN_EPI = false, bool SP2 = false>
__device__ __forceinline__ void gemm_phase(PG8_LAS unsigned char* lds, const Gemm g, const Sched& S, const Epi& E, const int wave_in) {
    int tid_l; asm volatile("v_mbcnt_lo_u32_b32 %0, -1, 0\n\tv_mbcnt_hi_u32_b32 %0, -1, %0" : "=v"(tid_l)); tid_l += wave_in * 64;
    const int tid = tid_l, wid = __builtin_amdgcn_readfirstlane(tid >> 6), lane = tid & 63, wr = wid >> 2, wc = wid & 3, fr = lane & 15, fq = lane >> 4;
    const int K = g.K, nt = K / BK;
    unsigned voffA[2], voffB[2];
#pragma unroll
    for (int i = 0; i < 2; ++i) { int R, C; stage_rc(tid * 16 + i * 8192, R, C); const int Rb = Epi::PERM ? ((R & ~31) + perm32(R & 31)) : R;
        voffA[i] = (unsigned)(R * K + C) * 2u; voffB[i] = (unsigned)(Rb * K + C) * 2u; }
    const size_t kstep = (size_t)(BK * 2);
    const size_t hstep = (size_t)HALF * K * 2;
    const size_t tstep = 2 * hstep;
    const unsigned ldsw = (unsigned)wid * 1024u;
    const int aoff = lds_byte(wr * 64 + fr, fq * 8), boff = lds_byte(wc * 32 + fr, fq * 8);
#define PG8_SA(b, h) (((b) * 2 + (h)) * HTB)
#define PG8_SB(b, h) ((4 + (b) * 2 + (h)) * HTB)
#define PG8_STAGE(bufoff, gbase, voff) do { _Pragma("unroll") for (int _i = 0; _i < 2; ++_i) \
        __builtin_amdgcn_global_load_lds((const unsigned*)((const char*)(gbase) + (voff)[_i]), (PG8_LAS unsigned*)(lds + (bufoff) + ldsw + _i * 8192), 16, 0, 0); } while (0)
#define PG8_LDA(dst, b, h) do { _Pragma("unroll") for (int m = 0; m < 4; ++m) _Pragma("unroll") for (int k = 0; k < 2; ++k) dst[m][k] = *(const PG8_LAS bf16x8*)(lds + PG8_SA(b, h) + aoff + m * 2048 + k * 1024); } while (0)
#define PG8_LDB(dst, b, h) do { _Pragma("unroll") for (int n = 0; n < 2; ++n) _Pragma("unroll") for (int k = 0; k < 2; ++k) dst[n][k] = *(const PG8_LAS bf16x8*)(lds + PG8_SB(b, h) + boff + n * 2048 + k * 1024); } while (0)
#define PG8_MMA(ai, bj, At, Bt) do { __builtin_amdgcn_s_setprio(1); _Pragma("unroll") for (int m = 0; m < 4; ++m) _Pragma("unroll") for (int n = 0; n < 2; ++n) _Pragma("unroll") for (int k = 0; k < 2; ++k) \
        acc[ai][bj][m][n] = __builtin_amdgcn_mfma_f32_16x16x32_bf16(Bt[n][k], At[m][k], acc[ai][bj][m][n], 0, 0, 0); __builtin_amdgcn_s_setprio(0); } while (0)
#define PG8_WAIT_V(n) asm volatile("s_waitcnt vmcnt(" #n ")" ::: "memory")
#define PG8_WAIT_L(n) asm volatile("s_waitcnt lgkmcnt(" #n ")" ::: "memory")
#define PG8_BAR __builtin_amdgcn_s_barrier()
#define PG8_SCHED __builtin_amdgcn_sched_barrier(0)
    Unit cur, nxt; int ui = 0;
    if (!S.next(0, cur)) return;
    f32x4 acc[2][2][4][2];
#pragma unroll
    for (int a = 0; a < 2; ++a)
#pragma unroll
        for (int b = 0; b < 2; ++b)
#pragma unroll
            for (int m = 0; m < 4; ++m)
#pragma unroll
                for (int n = 0; n < 2; ++n) acc[a][b][m][n] = (f32x4){0.f, 0.f, 0.f, 0.f};
    bf16x8 At[4][2], B0[2][2], B1[2][2];
    const char* cA = (const char*)g.A + (size_t)cur.pm * tstep; const char* cB = (const char*)g.Bt + (size_t)cur.pn * tstep;
    S.a_ready(cur);
    if constexpr (SP2) {
        PG8_STAGE(PG8_SB(0, 0), cB, voffB); PG8_STAGE(PG8_SB(0, 1), cB + hstep, voffB); PG8_STAGE(PG8_SA(0, 0), cA, voffA); PG8_STAGE(PG8_SA(0, 1), cA + hstep, voffA);
        if (wr == 1) PG8_BAR;
        PG8_WAIT_V(2); PG8_BAR;
        PG8_STAGE(PG8_SB(1, 0), cB + kstep, voffB); PG8_STAGE(PG8_SA(1, 0), cA + kstep, voffA); PG8_STAGE(PG8_SB(1, 1), cB + hstep + kstep, voffB);
        PG8_WAIT_V(6); PG8_BAR;
    } else {
        PG8_STAGE(PG8_SB(0, 0), cB, voffB); PG8_STAGE(PG8_SA(0, 0), cA, voffA); PG8_STAGE(PG8_SB(0, 1), cB + hstep, voffB); PG8_STAGE(PG8_SA(0, 1), cA + hstep, voffA);
        if (wr == 1) PG8_BAR;
        PG8_WAIT_V(4); PG8_BAR;
        PG8_STAGE(PG8_SB(1, 0), cB + kstep, voffB); PG8_STAGE(PG8_SA(1, 0), cA + kstep, voffA); PG8_STAGE(PG8_SB(1, 1), cB + hstep + kstep, voffB);
        PG8_WAIT_V(6); PG8_BAR;
    }
    for (;;) {
        const bool has_next = S.next(ui + 1, nxt);
        const char* nA = has_next ? (const char*)g.A + (size_t)nxt.pm * tstep : cA; const char* nB = has_next ? (const char*)g.Bt + (size_t)nxt.pn * tstep : cB;
        for (int t = 0; t < nt; t += 2) {
            const bool last = (t == nt - 2);
            const char* a1 = cA + (size_t)(t + 1) * kstep;
            const char* a2 = last ? nA : cA + (size_t)(t + 2) * kstep; const char* b2 = last ? nB : cB + (size_t)(t + 2) * kstep;
            const char* a3 = a2 + kstep; const char* b3 = b2 + kstep;
            if (last && has_next) S.a_ready(nxt);
            if constexpr (SP2) {
            PG8_LDB(B0, 0, 0); PG8_LDB(B1, 0, 1); PG8_SCHED; PG8_LDA(At, 0, 0); PG8_STAGE(PG8_SA(1, 1), a1 + hstep, voffA);
            PG8_WAIT_V(8); PG8_WAIT_L(0); PG8_BAR; PG8_MMA(0, 0, At, B0); PG8_MMA(0, 1, At, B1); PG8_BAR; PG8_SCHED;
            PG8_LDA(At, 0, 1); PG8_STAGE(PG8_SB(0, 0), b2, voffB); PG8_STAGE(PG8_SB(0, 1), b2 + hstep, voffB); PG8_STAGE(PG8_SA(0, 0), a2, voffA);
            PG8_WAIT_V(8); PG8_WAIT_L(0); PG8_BAR; PG8_MMA(1, 0, At, B0); PG8_MMA(1, 1, At, B1); PG8_BAR; PG8_SCHED;
            PG8_LDB(B0, 1, 0); PG8_LDB(B1, 1, 1); PG8_SCHED; PG8_LDA(At, 1, 0); PG8_STAGE(PG8_SA(0, 1), a2 + hstep, voffA);
            PG8_WAIT_V(8); PG8_WAIT_L(0); PG8_BAR; PG8_MMA(0, 0, At, B0); PG8_MMA(0, 1, At, B1); PG8_BAR; PG8_SCHED;
            PG8_LDA(At, 1, 1); PG8_STAGE(PG8_SB(1, 0), b3, voffB); PG8_STAGE(PG8_SB(1, 1), b3 + hstep, voffB); PG8_STAGE(PG8_SA(1, 0), a3, voffA);
            PG8_WAIT_V(8); PG8_WAIT_L(0); PG8_BAR; PG8_MMA(1, 0, At, B0); PG8_MMA(1, 1, At, B1); PG8_BAR; PG8_SCHED;
            } else {
            PG8_LDB(B0, 0, 0); PG8_SCHED; PG8_LDA(At, 0, 0); PG8_STAGE(PG8_SA(1, 1), a1 + hstep, voffA);
            PG8_WAIT_L(8); PG8_BAR; PG8_WAIT_L(0); PG8_MMA(0, 0, At, B0); PG8_BAR; PG8_SCHED;
            PG8_LDB(B1, 0, 1); PG8_STAGE(PG8_SB(0, 0), b2, voffB);
            PG8_BAR; PG8_WAIT_L(0); PG8_MMA(0, 1, At, B1); PG8_BAR;
            PG8_LDA(At, 0, 1); PG8_STAGE(PG8_SA(0, 0), a2, voffA);
            PG8_BAR; PG8_WAIT_L(0); PG8_MMA(1, 0, At, B0); PG8_BAR; PG8_SCHED;
            PG8_STAGE(PG8_SB(0, 1), b2 + hstep, voffB);
            PG8_WAIT_V(6); PG8_BAR; PG8_MMA(1, 1, At, B1); PG8_BAR;
            PG8_LDB(B0, 1, 0); PG8_SCHED; PG8_LDA(At, 1, 0); PG8_STAGE(PG8_SA(0, 1), a2 + hstep, voffA);
            PG8_WAIT_L(8); PG8_BAR; PG8_WAIT_L(0); PG8_MMA(0, 0, At, B0); PG8_BAR; PG8_SCHED;
            PG8_LDB(B1, 1, 1); PG8_STAGE(PG8_SB(1, 0), b3, voffB);
            PG8_BAR; PG8_WAIT_L(0); PG8_MMA(0, 1, At, B1); PG8_BAR;
            PG8_LDA(At, 1, 1); PG8_STAGE(PG8_SA(1, 0), a3, voffA);
            PG8_BAR; PG8_WAIT_L(0); PG8_MMA(1, 0, At, B0); PG8_BAR; PG8_SCHED;
            PG8_STAGE(PG8_SB(1, 1), b3 + hstep, voffB);
            PG8_WAIT_V(6); PG8_BAR; PG8_MMA(1, 1, At, B1); PG8_BAR;
            }
        }
        if constexpr (ALIGN_EPI) { if (wr == 0) PG8_BAR; }
        if constexpr (!Epi::AFTER_DRAIN) { E(acc, cur, wr, wc, fr, fq); S.done(cur); }
        if (!has_next) break;
#pragma unroll
        for (int a = 0; a < 2; ++a)
#pragma unroll
            for (int b = 0; b < 2; ++b)
#pragma unroll
                for (int m = 0; m < 4; ++m)
#pragma unroll
                    for (int n = 0; n < 2; ++n) acc[a][b][m][n] = (f32x4){0.f, 0.f, 0.f, 0.f};
        cur = nxt; cA = nA; cB = nB; ++ui;
        if constexpr (ALIGN_EPI) { if (wr == 1) PG8_BAR; }
    }
    PG8_WAIT_V(0);
    if constexpr (!ALIGN_EPI) { if (wr == 0) PG8_BAR; }
    PG8_BAR;
    if constexpr (Epi::AFTER_DRAIN) { E.fused(acc, cur, wr, wc, fr, fq, lds, wid, lane); S.done(cur); }
#undef PG8_SA
#undef PG8_SB
#undef PG8_STAGE
#undef PG8_LDA
#undef PG8_LDB
#undef PG8_MMA
#undef PG8_WAIT_V
#undef PG8_WAIT_L
#undef PG8_BAR
#undef PG8_SCHED
}
}

#define LAS __attribute__((address_space(3)))
using pg8::ex2; using pg8::rcpf_;
typedef unsigned short u16;
typedef short bf16x8 __attribute__((ext_vector_type(8)));
typedef float f32x4 __attribute__((ext_vector_type(4)));
typedef float f32x16 __attribute__((ext_vector_type(16)));
typedef unsigned u32x4 __attribute__((ext_vector_type(4)));
typedef unsigned u32x2 __attribute__((ext_vector_type(2)));

constexpr int DM = 1024, NB = 16, SEQ = 2048, MTOK = NB * SEQ, DEPTH = 4, DFF = 2816, INW = 2840, PW = 3072;
constexpr int C_MQ = 0, C_MK = 256, C_MV = 512, C_DQ = 768, C_DK = 1024, C_DV = 1280, C_NQ = 1536, C_NKC = 2048, C_NVC = 2176, C_NKS = 2304, C_NVS = 2432, C_NKW = 2560, C_NVW = 2688, C_NG = 2816;
constexpr int NVH = 12;
constexpr float LOG2E = 1.4426950408889634f, NEGF = -1e30f;
constexpr int NPH_L = 14, NPH = NPH_L * DEPTH + 1;
constexpr size_t MiB = 1u << 20;
constexpr size_t WS_GU1 = 1 * MiB, WS_DN1 = 12 * MiB, WS_GU2 = WS_DN1 + 5 * MiB + MiB / 2, WS_DN2 = WS_GU2 + 11 * MiB, WS_WIN = 34 * MiB, WS_WOUT = 40 * MiB, WS_W1 = 42 * MiB;
constexpr size_t WS_PROJ = 44 * MiB, WS_XN = 236 * MiB, WS_VT = 300 * MiB, WS_HID = 348 * MiB, WS_KCMP = 352 * MiB, WS_VCMPT = WS_KCMP + MiB / 2, WS_KMEAN = 353 * MiB, WS_SEL = WS_KMEAN + MiB / 4, WS_END = 354 * MiB;
static_assert(WS_DN2 + 5 * MiB + MiB / 2 == WS_WIN, "ws map");
constexpr int LDS_BYTES = 147456, MISC_OFF = 131072 + 1024;
constexpr size_t WS_CTL = 0, CTL_ZERO_BYTES = 65536;
constexpr int ATT_K = 0, ATT_V = 27648, ATT_LUT = 55296, ATT_PARK = 57600;
constexpr int CMP_K = 0, CMP_V = 18432, CMP_A = 36864, CMP_H = CMP_A + 256 * 33 * 4;

struct Params {
    const float* x; const float* rel_bias; const float* norm_ffn1; const float* ffn1_gate; const float* ffn1_up; const float* ffn1_down;
    const float* norm_mix; const float* w_in; const float* diff_lambda; const float* diff_subln; const float* cmp_pe; const float* cmp_w1; const float* cmp_w2;
    const float* w_out; const float* norm_ffn2; const float* ffn2_gate; const float* ffn2_up; const float* ffn2_down; const float* final_norm;
    float* out; unsigned char* ws;
    float lam_init[4];
    int ph_lo, ph_hi;
};
typedef const __attribute__((address_space(4))) Params* KParamsPtr;

__device__ __forceinline__ float bf2f(unsigned v) { return __uint_as_float(v << 16); }
typedef float f32x2_t __attribute__((ext_vector_type(2))); typedef __bf16 bf16x2_t __attribute__((ext_vector_type(2)));
__device__ __forceinline__ unsigned pkbf(float lo, float hi) { f32x2_t v = {lo, hi}; bf16x2_t b = __builtin_convertvector(v, bf16x2_t); return __builtin_bit_cast(unsigned, b); }
__device__ __forceinline__ int lane_opaque() { int l; asm volatile("v_mbcnt_lo_u32_b32 %0, -1, 0\n\tv_mbcnt_hi_u32_b32 %0, -1, %0" : "=v"(l)); return l; }
__device__ __forceinline__ float wave_sum(float v, int lane) {
#pragma unroll
    for (int o = 1; o < 64; o <<= 1) v += __int_as_float(__builtin_amdgcn_ds_bpermute((lane ^ o) << 2, __float_as_int(v)));
    return v;
}
__device__ __forceinline__ float xhalf_max(float v) { auto rr = __builtin_amdgcn_permlane32_swap(__float_as_uint(v), __float_as_uint(v), false, false); return fmaxf(__uint_as_float(rr[0]), __uint_as_float(rr[1])); }
__device__ __forceinline__ float xhalf_sum(float v) { auto rr = __builtin_amdgcn_permlane32_swap(__float_as_uint(v), __float_as_uint(v), false, false); return __uint_as_float(rr[0]) + __uint_as_float(rr[1]); }
__device__ __forceinline__ float sigmoid_f(float x) { return rcpf_(1.0f + ex2(-LOG2E * x)); }
__device__ __forceinline__ int crow(int r, int hi) { return (r & 3) + 8 * (r >> 2) + 4 * hi; }
__device__ __forceinline__ int kperm(int p) { const int h = p >> 3, j = p & 7; return 8 * (j >> 2) + 4 * h + (j & 3); }
__device__ __forceinline__ int pperm(int k) { return ((k >> 2) & 1) * 8 + (k >> 3) * 4 + (k & 3); }

__device__ __forceinline__ void tr_item(const float* W, int K, int N, u16* WT, int kb, int n0, int dst_row0, LAS float* scr, int lane, float cs = 1.0f) {
    const int k0 = 64 * kb; const int n = n0 + (lane & 31); const bool ok = n < N;
#pragma unroll 8
    for (int i = 0; i < 32; ++i) { const int kk = 2 * i + (lane >> 5); scr[kk * 33 + (lane & 31)] = ok ? W[(size_t)(k0 + kk) * N + n] * cs : 0.f; }
    asm volatile("s_waitcnt lgkmcnt(0)" ::: "memory");
    const int c = lane & 7;
#pragma unroll
    for (int j = 0; j < 4; ++j) { const int nn = (lane >> 3) + 8 * j; const LAS float* s = scr + (8 * c) * 33 + nn;
        u32x4 o; o.x = pkbf(s[0 * 33], s[1 * 33]); o.y = pkbf(s[2 * 33], s[3 * 33]); o.z = pkbf(s[4 * 33], s[5 * 33]); o.w = pkbf(s[6 * 33], s[7 * 33]);
        *(u32x4*)(WT + (size_t)(dst_row0 + nn) * K + k0 + 8 * c) = o; }
    asm volatile("s_waitcnt lgkmcnt(0)" ::: "memory");
}

__device__ __forceinline__ void norm_row(const float* xrow, const float* g, u16* dst16, float* dst32, int lane) {
    const f32x4* xr = (const f32x4*)xrow + lane; const f32x4* gr = (const f32x4*)g + lane;
    f32x4 v[4]; float s = 0.f;
#pragma unroll
    for (int j = 0; j < 4; ++j) { v[j] = xr[64 * j]; s += (v[j].x * v[j].x + v[j].y * v[j].y) + (v[j].z * v[j].z + v[j].w * v[j].w); }
    const float rstd = 1.0f / sqrtf(wave_sum(s, lane) * (1.0f / 1024.0f) + 1e-6f);
#pragma unroll
    for (int j = 0; j < 4; ++j) { const f32x4 gg = gr[64 * j]; const f32x4 y = v[j] * rstd * gg;
        if (dst16) { u32x2 o; o.x = pkbf(y.x, y.y); o.y = pkbf(y.z, y.w); *((u32x2*)dst16 + lane + 64 * j) = o; }
        else *((f32x4*)dst32 + lane + 64 * j) = y; }
}

struct AState { f32x16 o0, o1; float m, l; };
__device__ __forceinline__ void astate_init(AState& s) {
#pragma unroll
    for (int r = 0; r < 16; ++r) { s.o0[r] = 0.f; s.o1[r] = 0.f; }
    s.m = 0.f; s.l = 0.f;
}
constexpr float ATT_THR = 8.0f;
constexpr int ATT_SLOT = 9216, ATT_NSLOT = 3;
template <int KS0, int NKS>
__device__ __forceinline__ void qk_block(const LAS unsigned char* Ks, const bf16x8 (&qr)[4], int r32, int hi, f32x16& s0, f32x16& s1) {
    f32x16 ci;
#pragma unroll
    for (int r = 0; r < 16; ++r) ci[r] = 0.f;
    const LAS unsigned char* kp = Ks + r32 * 144 + hi * 16;
#pragma unroll
    for (int ks = 0; ks < NKS; ++ks) {
        const bf16x8 a0 = *(const LAS bf16x8*)(kp + (KS0 + ks) * 32);
        const bf16x8 a1 = *(const LAS bf16x8*)(kp + 32 * 144 + (KS0 + ks) * 32);
        s0 = __builtin_amdgcn_mfma_f32_32x32x16_bf16(a0, qr[KS0 + ks], ks == 0 ? ci : s0, 0, 0, 0);
        s1 = __builtin_amdgcn_mfma_f32_32x32x16_bf16(a1, qr[KS0 + ks], ks == 0 ? ci : s1, 0, 0, 0);
    }
}
__device__ __forceinline__ void pv_block(const LAS unsigned char* Vs, const u32x4 (&pk)[4], int r32, int hi, AState& st) {
    const LAS unsigned char* vp = Vs + r32 * 144 + hi * 16;
#pragma unroll
    for (int c = 0; c < 4; ++c) {
        const bf16x8 v0 = *(const LAS bf16x8*)(vp + c * 32);
        const bf16x8 v1 = *(const LAS bf16x8*)(vp + 32 * 144 + c * 32);
        const bf16x8 pb = __builtin_bit_cast(bf16x8, pk[c]);
        st.o0 = __builtin_amdgcn_mfma_f32_32x32x16_bf16(v0, pb, st.o0, 0, 0, 0);
        st.o1 = __builtin_amdgcn_mfma_f32_32x32x16_bf16(v1, pb, st.o1, 0, 0, 0);
    }
}
__device__ __forceinline__ void lut_add(f32x16& s0, f32x16& s1, const LAS float* lut1, int dbase, float cc) {
#pragma unroll
    for (int r = 0; r < 16; ++r) { const int d0 = dbase - ((r & 3) + 8 * (r >> 2)); const int d1 = d0 - 32;
        s0[r] += lut1[min(max(d0, -1), 512)] + cc; s1[r] += lut1[min(max(d1, -1), 512)] + cc;
        if ((r & 3) == 3) __builtin_amdgcn_sched_barrier(0); }
}
__device__ __forceinline__ void const_add(f32x16& s0, f32x16& s1, float cc) {
#pragma unroll
    for (int r = 0; r < 16; ++r) { s0[r] += cc; s1[r] += cc; }
}
__device__ __forceinline__ float row_max(const f32x16& s0, const f32x16& s1) {
    float mx = fmaxf(s0[0], s1[0]);
#pragma unroll
    for (int r = 1; r < 16; ++r) mx = fmaxf(mx, fmaxf(s0[r], s1[r]));
    return xhalf_max(mx);
}
__device__ __forceinline__ void rescale(AState& st, f32x16& s0, f32x16& s1, float mx) {
    const float dl = fmaxf(mx, 0.f); const float f = ex2(-dl); st.m += dl; st.l *= f;
#pragma unroll
    for (int r = 0; r < 16; ++r) { st.o0[r] *= f; st.o1[r] *= f; s0[r] -= dl; s1[r] -= dl; }
}
__device__ __forceinline__ void exp_pack(f32x16& s0, f32x16& s1, u32x4 (&pk)[4], AState& st) {
    float sum = 0.f;
#pragma unroll
    for (int r = 0; r < 16; ++r) { s0[r] = ex2(s0[r]); s1[r] = ex2(s1[r]); sum += s0[r] + s1[r]; }
    st.l += sum;
    pk[0] = (u32x4){pkbf(s0[0], s0[1]), pkbf(s0[2], s0[3]), pkbf(s0[4], s0[5]), pkbf(s0[6], s0[7])};
    pk[1] = (u32x4){pkbf(s0[8], s0[9]), pkbf(s0[10], s0[11]), pkbf(s0[12], s0[13]), pkbf(s0[14], s0[15])};
    pk[2] = (u32x4){pkbf(s1[0], s1[1]), pkbf(s1[2], s1[3]), pkbf(s1[4], s1[5]), pkbf(s1[6], s1[7])};
    pk[3] = (u32x4){pkbf(s1[8], s1[9]), pkbf(s1[10], s1[11]), pkbf(s1[12], s1[13]), pkbf(s1[14], s1[15])};
}

template <int KS0, int NKS, bool WINDOW, int MODE>
__device__ __forceinline__ void run_tiles(LAS unsigned char* lds, int t0, int t1, const u16* Kg, const u16* Vtg, const bf16x8 (&qr)[4], float c31,
                                          int q0w, unsigned mask, int qb, AState& A, int tid, int r32, int hi) {
    LAS unsigned char* Kr = lds + ATT_K; LAS unsigned char* Vr = lds + ATT_V; const LAS float* lut1 = (const LAS float*)(lds + ATT_LUT) + 1;
    const int srow = tid >> 3, sch = tid & 7; const int soff = srow * 144 + sch * 16;
    const u16* kg = Kg + (size_t)srow * PW + sch * 8;
    const u16* vg = Vtg + (size_t)srow * SEQ + sch * 8;
#define LDK(t) (*(const u32x4*)(kg + (size_t)(t) * 64 * PW))
#define LDV(t) (*(const u32x4*)(vg + (t) * 64))
#define KSLOT(t) (Kr + ((t) % ATT_NSLOT) * ATT_SLOT)
#define VSLOT(t) (Vr + ((t) % ATT_NSLOT) * ATT_SLOT)
#define T_ACTIVE(t) (!((q0w + 31 - (t) * 64) < 0 || (WINDOW && (q0w - ((t) * 64 + 63)) >= 512)))
#define T_LUTMODE(t) (((q0w - ((t) * 64 + 63)) < 128) || (WINDOW && (q0w + 31 - (t) * 64) >= 512))
    auto tile_sel = [&](int t) -> int { if (MODE == 1) { const int blk = t >> 2; return blk < qb ? (int)((mask >> blk) & 1u) : 1; } if (MODE == 2) return (int)((mask >> t) & 1u); return 1; };
    u32x4 kreg = LDK(t0), vreg = LDV(t0);
    *(LAS u32x4*)(KSLOT(t0) + soff) = kreg; *(LAS u32x4*)(VSLOT(t0) + soff) = vreg;
    if (t0 + 1 <= t1) { kreg = LDK(t0 + 1); *(LAS u32x4*)(KSLOT(t0 + 1) + soff) = kreg; }
    __syncthreads();
    if (t0 + 2 <= t1) kreg = LDK(t0 + 2);
    if (t0 + 1 <= t1) vreg = LDV(t0 + 1);
    f32x16 sn0, sn1, sc0, sc1; u32x4 pk[4];
#pragma unroll
    for (int r = 0; r < 16; ++r) { sn0[r] = 0.f; sn1[r] = 0.f; }
#pragma unroll
    for (int i = 0; i < 4; ++i) pk[i] = (u32x4){0u, 0u, 0u, 0u};
    bool act_n = T_ACTIVE(t0), act_c = false, act_p = false;
    if (act_n) qk_block<KS0, NKS>(KSLOT(t0), qr, r32, hi, sn0, sn1);
    for (int c = t0; c <= t1 + 1; ++c) {
        act_p = act_c; act_c = act_n; sc0 = sn0; sc1 = sn1;
        if (c + 2 <= t1) *(LAS u32x4*)(KSLOT(c + 2) + soff) = kreg;
        if (c + 1 <= t1) *(LAS u32x4*)(VSLOT(c + 1) + soff) = vreg;
        if (c + 3 <= t1) kreg = LDK(c + 3);
        if (c + 2 <= t1) vreg = LDV(c + 2);
        act_n = (c + 1 <= t1) && T_ACTIVE(c + 1);
        const bool lm_c = T_LUTMODE(c);
        const int dbase = q0w + r32 - c * 64 - 4 * hi;
        const float selc = tile_sel(c) ? (lm_c ? 0.f : c31) : NEGF;
        if (act_p) pv_block(VSLOT(c - 1), pk, r32, hi, A);
        if (act_c) {
            if (lm_c) lut_add(sc0, sc1, lut1, dbase, selc - A.m); else const_add(sc0, sc1, selc - A.m);
            const float mx = row_max(sc0, sc1);
            if (__any(mx > ATT_THR)) rescale(A, sc0, sc1, mx);
        }
        if (act_n) qk_block<KS0, NKS>(KSLOT(c + 1), qr, r32, hi, sn0, sn1);
        if (act_c) exp_pack(sc0, sc1, pk, A);
        __syncthreads();
    }
#undef LDK
#undef LDV
#undef KSLOT
#undef VSLOT
#undef T_ACTIVE
#undef T_LUTMODE
}

__device__ __forceinline__ void build_lut(LAS unsigned char* lds, const float* rel_bias, int head, bool window, int tid) {
    LAS float* lut = (LAS float*)(lds + ATT_LUT);
    for (int i = tid; i < 514; i += 512) {
        float v;
        if (i == 0) v = NEGF;
        else if (i == 513) v = window ? NEGF : rel_bias[31 * 16 + head] * LOG2E;
        else { const int d = i - 1; int bk;
            if (d < 16) bk = d; else if (d >= 128) bk = 31; else { bk = 16 + (int)(log2f((float)d * (1.0f / 16.0f)) * (16.0f / 3.0f)); bk = bk > 31 ? 31 : bk; }
            v = rel_bias[bk * 16 + head] * LOG2E; }
        lut[i] = v;
    }
}
__device__ __forceinline__ void load_q(bf16x8 (&qr)[4], const u16* qrow, int hi) {
#pragma unroll
    for (int ks = 0; ks < 4; ++ks) qr[ks] = *(const bf16x8*)(qrow + ks * 16 + hi * 8);
}
__device__ __forceinline__ void store_o(u16* dst, const f32x16& v0, const f32x16& v1, int hi) {
#pragma unroll
    for (int g = 0; g < 4; ++g) {
        u32x2 a; a.x = pkbf(v0[4 * g], v0[4 * g + 1]); a.y = pkbf(v0[4 * g + 2], v0[4 * g + 3]); *(u32x2*)(dst + 8 * g + 4 * hi) = a;
        u32x2 b; b.x = pkbf(v1[4 * g], v1[4 * g + 1]); b.y = pkbf(v1[4 * g + 2], v1[4 * g + 3]); *(u32x2*)(dst + 32 + 8 * g + 4 * hi) = b;
    }
}

struct Ctx { LAS unsigned char* lds; int tid, lane, wave, r32, hi, G, bx; u16* proj; u16* obuf; u16* vt; };

__device__ __forceinline__ void moba_unit(const Ctx& C0, KParamsPtr P, int b, int h, int qb) {
    Ctx C = C0; C.lane = lane_opaque(); C.tid = C.wave * 64 + C.lane; C.r32 = C.lane & 31; C.hi = C.lane >> 5;
    const int q0w = __builtin_amdgcn_readfirstlane(qb * 256 + C.wave * 32); const int qpos = q0w + C.r32; const size_t tok = (size_t)b * SEQ + qpos;
    build_lut(C.lds, P->rel_bias, h, false, C.tid);
    const u16* qrow = C.proj + tok * PW + C_MQ + h * 64;
    bf16x8 qr[4]; load_q(qr, qrow, C.hi);
    unsigned mask = 0;
    if (qb > 0) {
        float g[7];
#pragma unroll
        for (int j = 0; j < 7; ++j) g[j] = 0.f;
        const float* km = (const float*)(P->ws + WS_KMEAN) + (size_t)((b * 4 + h) * 8) * 64;
#pragma unroll
        for (int dc = 0; dc < 8; ++dc) {
            const u32x4 qv = *(const u32x4*)(qrow + dc * 8);
            float qf[8]; qf[0] = bf2f(qv.x & 0xffffu); qf[1] = bf2f(qv.x >> 16); qf[2] = bf2f(qv.y & 0xffffu); qf[3] = bf2f(qv.y >> 16);
            qf[4] = bf2f(qv.z & 0xffffu); qf[5] = bf2f(qv.z >> 16); qf[6] = bf2f(qv.w & 0xffffu); qf[7] = bf2f(qv.w >> 16);
#pragma unroll
            for (int j = 0; j < 7; ++j) if (j < qb) { const float* kmj = km + j * 64 + dc * 8;
#pragma unroll
                for (int e = 0; e < 8; ++e) g[j] = fmaf(qf[e], kmj[e], g[j]); }
        }
#pragma unroll
        for (int j = 0; j < 7; ++j) if (j < qb) { int rank = 0;
#pragma unroll
            for (int i = 0; i < 7; ++i) if (i != j && i < qb) rank += (g[i] > g[j] || (g[i] == g[j] && i < j)) ? 1 : 0;
            if (rank < 3) mask |= 1u << j; }
    }
    AState A; astate_init(A);
    const float c31 = P->rel_bias[31 * 16 + h] * LOG2E;
    run_tiles<0, 4, false, 1>(C.lds, 0, 4 * qb + 3, C.proj + (size_t)b * SEQ * PW + C_MK + h * 64, C.vt + (size_t)((b * NVH + h) * 64) * SEQ, qr, c31, q0w, mask, qb, A, C.tid, C.r32, C.hi);
    const float inv = rcpf_(xhalf_sum(A.l));
    A.o0 *= inv; A.o1 *= inv;
    { const int l2 = lane_opaque(); const size_t tok2 = (size_t)b * SEQ + q0w + (l2 & 31);
      store_o(C.obuf + tok2 * DM + h * 64, A.o0, A.o1, l2 >> 5); }
}

__device__ __forceinline__ void diff_unit(const Ctx& C0, KParamsPtr P, int layer, int b, int h, int qb) {
    Ctx C = C0; C.lane = lane_opaque(); C.tid = C.wave * 64 + C.lane; C.r32 = C.lane & 31; C.hi = C.lane >> 5;
    const int q0w = __builtin_amdgcn_readfirstlane(qb * 256 + C.wave * 32); const int qpos = q0w + C.r32; const size_t tok = (size_t)b * SEQ + qpos;
    build_lut(C.lds, P->rel_bias, 4 + h, false, C.tid);
    bf16x8 qr[4]; load_q(qr, C.proj + tok * PW + C_DQ + h * 64, C.hi);
    AState A; astate_init(A);
    const float c31 = P->rel_bias[31 * 16 + 4 + h] * LOG2E;
    const u16* Kg = C.proj + (size_t)b * SEQ * PW + C_DK + h * 64; const u16* Vg = C.vt + (size_t)((b * NVH + 4 + h) * 64) * SEQ;
    run_tiles<0, 2, false, 0>(C.lds, 0, 4 * qb + 3, Kg, Vg, qr, c31, q0w, 0u, 0, A, C.tid, C.r32, C.hi);
    LAS float* park = (LAS float*)(C.lds + ATT_PARK) + C.tid;
    { const float i0 = rcpf_(xhalf_sum(A.l));
#pragma unroll
      for (int r = 0; r < 16; ++r) { park[r * 512] = A.o0[r] * i0; park[(16 + r) * 512] = A.o1[r] * i0; } }
    astate_init(A);
    run_tiles<2, 2, false, 0>(C.lds, 0, 4 * qb + 3, Kg, Vg, qr, c31, q0w, 0u, 0, A, C.tid, C.r32, C.hi);
    const float* lp = P->diff_lambda + (size_t)layer * 128; float d01 = 0.f, d23 = 0.f;
    for (int i = 0; i < 32; ++i) { d01 = fmaf(lp[i], lp[32 + i], d01); d23 = fmaf(lp[64 + i], lp[96 + i], d23); }
    const float li = P->lam_init[layer]; const float lam = expf(d01) - expf(d23) + li;
    const float i1 = lam * rcpf_(xhalf_sum(A.l));
    float ss = 0.f;
#pragma unroll
    for (int r = 0; r < 16; ++r) { A.o0[r] = park[r * 512] - A.o0[r] * i1; A.o1[r] = park[(16 + r) * 512] - A.o1[r] * i1; ss += A.o0[r] * A.o0[r] + A.o1[r] * A.o1[r]; }
    ss = xhalf_sum(ss);
    const float rstd = (1.0f / sqrtf(ss * (1.0f / 64.0f) + 1e-6f)) * (1.0f - li);
    const float* sg = P->diff_subln + (size_t)layer * 64;
#pragma unroll
    for (int r = 0; r < 16; ++r) { const int d = crow(r, C.hi); A.o0[r] *= rstd * sg[d]; A.o1[r] *= rstd * sg[32 + d]; }
    { const int l2 = lane_opaque(); const size_t tok2 = (size_t)b * SEQ + q0w + (l2 & 31);
      store_o(C.obuf + tok2 * DM + 256 + h * 64, A.o0, A.o1, l2 >> 5); }
}

__device__ __forceinline__ void nsa_unit(const Ctx& C0, KParamsPtr P, int b, int hq, int qb) {
    Ctx C = C0; C.lane = lane_opaque(); C.tid = C.wave * 64 + C.lane; C.r32 = C.lane & 31; C.hi = C.lane >> 5;
    const int g = hq >> 2;
    const int q0w = __builtin_amdgcn_readfirstlane(qb * 256 + C.wave * 32); const int qpos = q0w + C.r32; const size_t tok = (size_t)b * SEQ + qpos;
    build_lut(C.lds, P->rel_bias, 8 + hq, false, C.tid);
    bf16x8 qr[4]; load_q(qr, C.proj + tok * PW + C_NQ + hq * 64, C.hi);
    const u16* gl = C.proj + tok * PW + C_NG + hq * 3;
    const float g1 = sigmoid_f(bf2f(gl[1])), g2 = sigmoid_f(bf2f(gl[2]));
    const unsigned mask = ((const unsigned*)(P->ws + WS_SEL))[(size_t)(b * 2 + g) * SEQ + qpos];
    const float c31 = P->rel_bias[31 * 16 + 8 + hq] * LOG2E;
    AState A; astate_init(A);
    run_tiles<0, 4, false, 2>(C.lds, 0, 4 * qb + 3, C.proj + (size_t)b * SEQ * PW + C_NKS + g * 64, C.vt + (size_t)((b * NVH + 8 + g) * 64) * SEQ, qr, c31, q0w, mask, qb, A, C.tid, C.r32, C.hi);
    LAS float* park = (LAS float*)(C.lds + ATT_PARK) + C.tid;
    { const float f = g1 * rcpf_(xhalf_sum(A.l));
#pragma unroll
      for (int r = 0; r < 16; ++r) { park[r * 512] = A.o0[r] * f; park[(16 + r) * 512] = A.o1[r] * f; } }
    if (C.tid == 0) ((LAS float*)(C.lds + ATT_LUT))[513] = NEGF;
    astate_init(A);
    const int tw0 = 4 * qb - 8 < 0 ? 0 : 4 * qb - 8;
    run_tiles<0, 4, true, 0>(C.lds, tw0, 4 * qb + 3, C.proj + (size_t)b * SEQ * PW + C_NKW + g * 64, C.vt + (size_t)((b * NVH + 10 + g) * 64) * SEQ, qr, c31, q0w, 0u, qb, A, C.tid, C.r32, C.hi);
    { const float f = g2 * rcpf_(xhalf_sum(A.l));
#pragma unroll
      for (int r = 0; r < 16; ++r) { A.o0[r] = A.o0[r] * f + park[r * 512]; A.o1[r] = A.o1[r] * f + park[(16 + r) * 512]; } }
    const int l2 = lane_opaque(); const int hi2 = l2 >> 5;
    u16* dst = C.obuf + ((size_t)b * SEQ + q0w + (l2 & 31)) * DM + 512 + hq * 64;
#pragma unroll
    for (int gg = 0; gg < 4; ++gg) {
        const u32x2 a = *(const u32x2*)(dst + 8 * gg + 4 * hi2), bq = *(const u32x2*)(dst + 32 + 8 * gg + 4 * hi2);
        A.o0[4 * gg] += bf2f(a.x & 0xffffu); A.o0[4 * gg + 1] += bf2f(a.x >> 16); A.o0[4 * gg + 2] += bf2f(a.y & 0xffffu); A.o0[4 * gg + 3] += bf2f(a.y >> 16);
        A.o1[4 * gg] += bf2f(bq.x & 0xffffu); A.o1[4 * gg + 1] += bf2f(bq.x >> 16); A.o1[4 * gg + 2] += bf2f(bq.y & 0xffffu); A.o1[4 * gg + 3] += bf2f(bq.y >> 16);
    }
    store_o(dst, A.o0, A.o1, hi2);
}

__device__ __forceinline__ void cmp_unit(const Ctx& C0, KParamsPtr P, int b, int g, int qblk) {
    Ctx C = C0; C.lane = lane_opaque(); C.tid = C.wave * 64 + C.lane; C.r32 = C.lane & 31; C.hi = C.lane >> 5;
    LAS unsigned char* lds = C.lds; const int tid = C.tid, r32 = C.r32, hi = C.hi;
    const u16* kc = (const u16*)(P->ws + WS_KCMP) + (size_t)(b * 2 + g) * 128 * 64;
    const u16* vc = (const u16*)(P->ws + WS_VCMPT) + (size_t)(b * 2 + g) * 64 * 128;
#pragma unroll
    for (int i = 0; i < 2; ++i) { const int e = tid + 512 * i;
        { const int row = e >> 3, ch = e & 7; *(LAS u32x4*)(lds + CMP_K + row * 144 + ch * 16) = *(const u32x4*)(kc + row * 64 + ch * 8); }
        { const int row = e >> 4, ch = e & 15; *(LAS u32x4*)(lds + CMP_V + row * 272 + ch * 16) = *(const u32x4*)(vc + row * 128 + ch * 8); } }
    const int q0w = __builtin_amdgcn_readfirstlane(qblk * 256 + C.wave * 32); const int qpos = q0w + r32; const size_t tok = (size_t)b * SEQ + qpos;
    const int nmax = (qpos - 31) >> 4;
    __syncthreads();
    float qa[16], qh[16];
#pragma unroll
    for (int i = 0; i < 16; ++i) { qa[i] = 0.f; qh[i] = 0.f; }
    const LAS unsigned char* kp = lds + CMP_K + r32 * 144 + hi * 16;
    const LAS unsigned char* vp = lds + CMP_V + r32 * 272 + hi * 16;
    for (int rh = 0; rh < 4; ++rh) {
        const int hq = g * 4 + rh;
        bf16x8 qr[4]; load_q(qr, C.proj + tok * PW + C_NQ + hq * 64, hi);
        const float g0 = sigmoid_f(bf2f(C.proj[tok * PW + C_NG + hq * 3]));
        f32x16 s[4];
#pragma unroll
        for (int kb = 0; kb < 4; ++kb) {
#pragma unroll
            for (int r = 0; r < 16; ++r) s[kb][r] = 0.f;
#pragma unroll
            for (int ks = 0; ks < 4; ++ks) { const bf16x8 a = *(const LAS bf16x8*)(kp + kb * 32 * 144 + ks * 32); s[kb] = __builtin_amdgcn_mfma_f32_32x32x16_bf16(a, qr[ks], s[kb], 0, 0, 0); }
        }
        float mx = NEGF;
#pragma unroll
        for (int kb = 0; kb < 4; ++kb)
#pragma unroll
            for (int r = 0; r < 16; ++r) { const int n = 32 * kb + crow(r, hi); const float v = (n <= nmax) ? s[kb][r] : NEGF; s[kb][r] = v; mx = fmaxf(mx, v); }
        mx = xhalf_max(mx);
        float sum = 0.f;
#pragma unroll
        for (int kb = 0; kb < 4; ++kb)
#pragma unroll
            for (int r = 0; r < 16; ++r) { const int n = 32 * kb + crow(r, hi); const float pv = (n <= nmax) ? ex2(s[kb][r] - mx) : 0.f; s[kb][r] = pv; sum += pv; }
        sum = xhalf_sum(sum);
        const float inv = nmax >= 0 ? rcpf_(sum) : 0.f;
        f32x16 o0, o1;
#pragma unroll
        for (int r = 0; r < 16; ++r) { o0[r] = 0.f; o1[r] = 0.f; }
#pragma unroll
        for (int kb = 0; kb < 4; ++kb) {
#pragma unroll
            for (int r = 0; r < 16; ++r) s[kb][r] *= inv;
#pragma unroll
            for (int g4 = 0; g4 < 4; ++g4) { const float h = 0.5f * s[kb][4 * g4 + 3]; qh[kb * 4 + g4] += h; qa[kb * 4 + g4] += (s[kb][4 * g4] + s[kb][4 * g4 + 1]) + (s[kb][4 * g4 + 2] + h); }
#pragma unroll
            for (int c = 0; c < 2; ++c) {
                const u32x4 pk = (u32x4){pkbf(s[kb][8 * c], s[kb][8 * c + 1]), pkbf(s[kb][8 * c + 2], s[kb][8 * c + 3]), pkbf(s[kb][8 * c + 4], s[kb][8 * c + 5]), pkbf(s[kb][8 * c + 6], s[kb][8 * c + 7])};
                const bf16x8 pb = __builtin_bit_cast(bf16x8, pk);
                const bf16x8 v0 = *(const LAS bf16x8*)(vp + (kb * 2 + c) * 32);
                const bf16x8 v1 = *(const LAS bf16x8*)(vp + 32 * 272 + (kb * 2 + c) * 32);
                o0 = __builtin_amdgcn_mfma_f32_32x32x16_bf16(v0, pb, o0, 0, 0, 0);
                o1 = __builtin_amdgcn_mfma_f32_32x32x16_bf16(v1, pb, o1, 0, 0, 0);
            }
            __builtin_amdgcn_sched_barrier(0);
        }
        o0 *= g0; o1 *= g0;
        store_o(C.obuf + tok * DM + 512 + hq * 64, o0, o1, hi);
    }
    LAS float* Aq = (LAS float*)(lds + CMP_A) + (C.wave * 32 + r32) * 33; LAS float* Hq = (LAS float*)(lds + CMP_H) + (C.wave * 32 + r32) * 33;
#pragma unroll
    for (int kb = 0; kb < 4; ++kb)
#pragma unroll
        for (int g4 = 0; g4 < 4; ++g4) { const int j = 8 * kb + 2 * g4 + hi; Aq[j] = qa[kb * 4 + g4]; Hq[j] = qh[kb * 4 + g4]; }
    __syncthreads();
    const int cur = q0w >> 6;
    unsigned bits = 0;
    if (cur < 16) bits = (2u << cur) - 1u;
    else {
        for (int e = 0; e < 16; ++e) { const int j = hi * 16 + e; if (j > 0 && j <= cur - 2) Aq[j] += Hq[j - 1]; }
        asm volatile("s_waitcnt lgkmcnt(0)" ::: "memory");
        for (int e = 0; e < 16; ++e) { const int j = hi * 16 + e;
            if (j <= cur) { const float sj = (j == 0 || j > cur - 2) ? 1e4f : Aq[j]; int rank = 0;
                for (int i = 0; i <= cur; ++i) { const float si = (i == 0 || i > cur - 2) ? 1e4f : Aq[i]; rank += (si > sj || (si == sj && i < j)) ? 1 : 0; }
                if (rank < 16) bits |= 1u << j; } }
        { auto rr = __builtin_amdgcn_permlane32_swap(bits, bits, false, false); bits = rr[0] | rr[1]; }
    }
    if (hi == 0) ((unsigned*)(P->ws + WS_SEL))[(size_t)(b * 2 + g) * SEQ + qpos] = bits;
    __syncthreads();
}

__device__ __forceinline__ void prep_a(const Ctx& C, KParamsPtr P, int layer) {
    const int G = C.G, tid = C.tid, lane = C.lane;
    for (int it = C.bx; it < NB * NVH * 32; it += G) {
        const int tb = it & 31, hv = (it >> 5) % NVH, b = it / (32 * NVH);
        const int vcol = hv < 4 ? C_MV + hv * 64 : hv < 8 ? C_DV + (hv - 4) * 64 : hv < 10 ? C_NVS + (hv - 8) * 64 : C_NVW + (hv - 10) * 64;
        { const int row = tid >> 3, ch = tid & 7; *(LAS u32x4*)(C.lds + row * 144 + ch * 16) = *(const u32x4*)(C.proj + ((size_t)b * SEQ + tb * 64 + row) * PW + vcol + ch * 8); }
        __syncthreads();
        { const int d = tid >> 3, pc = tid & 7; unsigned w[4];
#pragma unroll
            for (int e = 0; e < 4; ++e) { const int p0 = pc * 8 + 2 * e, p1 = p0 + 1; const int k0 = (p0 & ~15) + kperm(p0 & 15), k1 = (p1 & ~15) + kperm(p1 & 15);
                const unsigned a = *(const LAS u16*)(C.lds + k0 * 144 + d * 2), bb = *(const LAS u16*)(C.lds + k1 * 144 + d * 2); w[e] = a | (bb << 16); }
            *(u32x4*)(C.vt + ((size_t)(b * NVH + hv) * 64 + d) * SEQ + tb * 64 + pc * 8) = (u32x4){w[0], w[1], w[2], w[3]}; }
        __syncthreads();
    }
    const int gw = C.bx * 8 + C.wave, NGW = G * 8;
    for (int it = gw; it < NB * 4 * 8; it += NGW) {
        const int blk = it & 7, h = (it >> 3) & 3, b = it >> 5;
        const u16* kp = C.proj + ((size_t)b * SEQ + blk * 256) * PW + C_MK + h * 64 + lane; float s = 0.f;
        for (int k = 0; k < 256; ++k) s += bf2f(kp[(size_t)k * PW]);
        ((float*)(P->ws + WS_KMEAN))[(size_t)it * 64 + lane] = s * (1.0f / 256.0f);
    }
    u16* acmp = (u16*)(P->ws + WS_XN);
    for (int it = gw; it < 2 * 4096; it += NGW) {
        const int i = it >> 12, row = it & 4095, n = row & 127, bg = row >> 7, b = bg >> 1, g = bg & 1;
        u16* dst = acmp + (size_t)it * 2048; const float* pe = P->cmp_pe + (size_t)(layer * 2 + i) * 2048;
        const int col = (i == 0 ? C_NKC : C_NVC) + g * 64;
#pragma unroll
        for (int pass = 0; pass < 4; ++pass) { const int l = pass * 8 + (lane >> 3), d0 = (lane & 7) * 8;
            unsigned z0 = 0u; asm volatile("" : "+v"(z0)); u32x4 o = (u32x4){z0, z0, z0, z0};
            if (n < 127) { const u32x4 v = *(const u32x4*)(C.proj + ((size_t)b * SEQ + 16 * n + l) * PW + col + d0); const f32x4 e0 = *(const f32x4*)(pe + l * 64 + d0), e1 = *(const f32x4*)(pe + l * 64 + d0 + 4);
                o.x = pkbf(bf2f(v.x & 0xffffu) + e0.x, bf2f(v.x >> 16) + e0.y); o.y = pkbf(bf2f(v.y & 0xffffu) + e0.z, bf2f(v.y >> 16) + e0.w);
                o.z = pkbf(bf2f(v.z & 0xffffu) + e1.x, bf2f(v.z >> 16) + e1.y); o.w = pkbf(bf2f(v.w & 0xffffu) + e1.z, bf2f(v.w >> 16) + e1.w); }
            *(u32x4*)(dst + l * 64 + d0) = o; }
    }
}
__device__ __forceinline__ void prep_c(const Ctx& C, KParamsPtr P, int layer) {
    const int gw = C.bx * 8 + C.wave, NGW = C.G * 8, lane = C.lane;
    for (int it = gw; it < 2 * 4096; it += NGW) {
        const int i = it >> 12, row = it & 4095;
        const u16* hrow = (const u16*)(P->ws + WS_HID) + (size_t)it * 256; const float* w2 = P->cmp_w2 + (size_t)(layer * 2 + i) * 256 * 64 + lane;
        float acc = 0.f;
        for (int j = 0; j < 256; j += 8) { const u32x4 hv = *(const u32x4*)(hrow + j);
            acc = fmaf(bf2f(hv.x & 0xffffu), w2[(j + 0) * 64], acc); acc = fmaf(bf2f(hv.x >> 16), w2[(j + 1) * 64], acc);
            acc = fmaf(bf2f(hv.y & 0xffffu), w2[(j + 2) * 64], acc); acc = fmaf(bf2f(hv.y >> 16), w2[(j + 3) * 64], acc);
            acc = fmaf(bf2f(hv.z & 0xffffu), w2[(j + 4) * 64], acc); acc = fmaf(bf2f(hv.z >> 16), w2[(j + 5) * 64], acc);
            acc = fmaf(bf2f(hv.w & 0xffffu), w2[(j + 6) * 64], acc); acc = fmaf(bf2f(hv.w >> 16), w2[(j + 7) * 64], acc); }
        const unsigned bits = pkbf(acc, 0.f) & 0xffffu;
        if (i == 0) ((u16*)(P->ws + WS_KCMP))[(size_t)row * 64 + lane] = (u16)bits;
        else { const int bg = row >> 7, n = row & 127; ((u16*)(P->ws + WS_VCMPT))[((size_t)bg * 64 + lane) * 128 + (n & ~15) + pperm(n & 15)] = (u16)bits; }
    }
}

__device__ __forceinline__ void convert_weights(const Ctx& C, KParamsPtr P, int layer) {
    LAS float* scr = (LAS float*)(C.lds + C.wave * 16384);
    const int gw = C.bx * 8 + C.wave, NGW = C.G * 8, lane = C.lane;
    constexpr int I_G = 16 * 88, I_D = 44 * 32, I_IN = 16 * 96, I_O = 16 * 32, I_W1 = 32 * 8;
    constexpr int NIT = 4 * I_G + 2 * I_D + I_IN + I_O + 2 * I_W1;
    unsigned char* ws = P->ws;
    for (int it = gw; it < NIT; it += NGW) {
        int r = it;
        if (r < 4 * I_G) { const int which = r / I_G; r -= which * I_G; const int kb = r / 88, nb = r % 88, n0 = nb * 32;
            const float* W = (which == 0 ? P->ffn1_gate : which == 1 ? P->ffn1_up : which == 2 ? P->ffn2_gate : P->ffn2_up) + (size_t)layer * DM * DFF;
            u16* WT = (u16*)(ws + (which < 2 ? WS_GU1 : WS_GU2));
            tr_item(W, DM, DFF, WT, kb, n0, (n0 >> 7) * 256 + (which & 1) * 128 + (n0 & 127), scr, lane); continue; }
        r -= 4 * I_G;
        if (r < 2 * I_D) { const int which = r / I_D; r -= which * I_D; const int kb = r / 32, nb = r % 32;
            const float* W = (which == 0 ? P->ffn1_down : P->ffn2_down) + (size_t)layer * DFF * DM;
            tr_item(W, DFF, DM, (u16*)(ws + (which == 0 ? WS_DN1 : WS_DN2)), kb, nb * 32, nb * 32, scr, lane); continue; }
        r -= 2 * I_D;
        if (r < I_IN) { const int kb = r / 96, nb = r % 96, n0 = nb * 32;
            const float cs = (n0 < C_MK || (n0 >= C_NQ && n0 < C_NKC)) ? 0.125f * LOG2E : (n0 >= C_DQ && n0 < C_DK) ? 0.17677669529663687f * LOG2E : 1.0f;
            tr_item(P->w_in + (size_t)layer * DM * INW, DM, INW, (u16*)(ws + WS_WIN), kb, n0, n0, scr, lane, cs); continue; }
        r -= I_IN;
        if (r < I_O) { const int kb = r / 32, nb = r % 32; tr_item(P->w_out + (size_t)layer * DM * DM, DM, DM, (u16*)(ws + WS_WOUT), kb, nb * 32, nb * 32, scr, lane); continue; }
        r -= I_O;
        { const int i = r / I_W1; r -= i * I_W1; const int kb = r / 8, nb = r % 8;
            tr_item(P->cmp_w1 + (size_t)(layer * 2 + i) * 2048 * 256, 2048, 256, (u16*)(ws + WS_W1) + (size_t)i * 256 * 2048, kb, nb * 32, nb * 32, scr, lane); }
    }
}
__device__ __forceinline__ void norm_phase(const Ctx& C, const float* src, const float* g, u16* dst16, float* dst32) {
    const int gw = C.bx * 8 + C.wave, NGW = C.G * 8;
    for (int m = gw; m < MTOK; m += NGW) norm_row(src + (size_t)m * DM, g, dst16 ? dst16 + (size_t)m * DM : nullptr, dst32 ? dst32 + (size_t)m * DM : nullptr, C.lane);
}

#define XB_TMO      128
#define XB_XCNT(j)  (256  + 64 * (j))
#define XB_XSUB(j)  (1280 + 64 * (j))
#define XB_XGEN(j)  (2304 + 64 * (j))
#define XB_TOP      3328
#define XB_TOPGEN   3392
#define XCD_BAR_WORDS 3456
#define XB_SPIN_CAP (1u << 18)

__device__ __forceinline__ unsigned xb_ld(unsigned* p)              { return __hip_atomic_load(p, __ATOMIC_RELAXED, __HIP_MEMORY_SCOPE_AGENT); }
__device__ __forceinline__ unsigned xb_add(unsigned* p, unsigned v) { return __hip_atomic_fetch_add(p, v, __ATOMIC_RELAXED, __HIP_MEMORY_SCOPE_AGENT); }
__device__ __forceinline__ unsigned xb_xcc_id() { return (unsigned)__builtin_amdgcn_s_getreg((3 << 11) | 20) & 0xFu; }
#define XB_SPIN(cond, bar) do { unsigned _sp = 0; while (cond) { __builtin_amdgcn_s_sleep(1); \
    if ((++_sp & 255u) == 0u) { if (xb_ld(&(bar)[XB_TMO])) break; if (_sp > XB_SPIN_CAP) { atomicAdd(&(bar)[XB_TMO], 1u); break; } } } } while (0)

struct XcdBarrier {
    unsigned* bar; unsigned x;
    volatile LAS unsigned* st;
};

__device__ __forceinline__ XcdBarrier xcd_barrier_post(unsigned* bar, volatile LAS unsigned* st) {
    XcdBarrier b; b.bar = bar; b.x = xb_xcc_id(); b.st = st;
    if (threadIdx.x == 0) (void)xb_add(&bar[XB_XCNT(b.x)], 1u);
    return b;
}
__device__ __forceinline__ void xcd_barrier_complete(unsigned* bar, unsigned x, unsigned& nloc, unsigned& nx) {
    const unsigned G = gridDim.x * gridDim.y * gridDim.z;
    unsigned sum, cnt, mine, sp = 0u;
    for (;;) {
        sum = 0u; cnt = 0u; mine = 0u;
#pragma unroll
        for (unsigned j = 0; j < 16; ++j) { const unsigned c = xb_ld(&bar[XB_XCNT(j)]); sum += c; cnt += (c > 0u) ? 1u : 0u; mine = (j == x) ? c : mine; }
        if (sum == G) break;
        __builtin_amdgcn_s_sleep(1);
        if ((++sp & 255u) == 0u) { if (xb_ld(&bar[XB_TMO])) break; if (sp > XB_SPIN_CAP) { atomicAdd(&bar[XB_TMO], 1u); break; } }
    }
    nloc = mine > 0u ? mine : 1u; nx = cnt > 0u ? cnt : 1u;
}

__device__ __forceinline__ void xcd_barrier(const XcdBarrier& b) {
    asm volatile("s_waitcnt vmcnt(0)" ::: "memory");
    __syncthreads();
    if (threadIdx.x == 0) {
        unsigned* bar = b.bar;
        __builtin_amdgcn_s_waitcnt(0);
        unsigned nloc = b.st[0], nx = b.st[1];
        if (nloc == 0u) { xcd_barrier_complete(bar, b.x, nloc, nx); b.st[0] = nloc; b.st[1] = nx; }
        const unsigned old = xb_add(&bar[XB_XSUB(b.x)], 1u);
        const unsigned gen = old / nloc;
        if (old + 1u == (gen + 1u) * nloc) {
            __builtin_amdgcn_fence(__ATOMIC_RELEASE, "agent");
            asm volatile("s_waitcnt vmcnt(0)" ::: "memory");
            const unsigned og = xb_add(&bar[XB_TOP], 1u);
            const unsigned tg = og / nx;
            if (og + 1u == (tg + 1u) * nx) xb_add(&bar[XB_TOPGEN], 1u);
            else XB_SPIN(xb_ld(&bar[XB_TOPGEN]) == tg, bar);
            __builtin_amdgcn_fence(__ATOMIC_ACQUIRE, "agent");
            xb_add(&bar[XB_XGEN(b.x)], 1u);
            asm volatile("s_waitcnt vmcnt(0)" ::: "memory");
        } else {
            XB_SPIN(xb_ld(&bar[XB_XGEN(b.x)]) == gen, bar);
            __builtin_amdgcn_fence(__ATOMIC_ACQUIRE, "agent");
            asm volatile("s_waitcnt vmcnt(0)" ::: "memory");
        }
    }
    __syncthreads();
}


__global__ void __launch_bounds__(512, 2) hybrid_fwd(Params P0) {
    extern __shared__ __attribute__((aligned(16))) unsigned char lds_raw[];
    const KParamsPtr kp0 = (KParamsPtr)__builtin_amdgcn_kernarg_segment_ptr();
    cg::grid_group grid = cg::this_grid();
    { volatile LAS unsigned* misc = (volatile LAS unsigned*)((LAS unsigned char*)lds_raw + MISC_OFF); if (threadIdx.x < 2) misc[threadIdx.x] = 0u; }
    __syncthreads();
    XcdBarrier bar = xcd_barrier_post((unsigned*)(P0.ws + WS_CTL) + 1024, (volatile LAS unsigned*)((LAS unsigned char*)lds_raw + MISC_OFF));
    const int ph_lo = P0.ph_lo, ph_hi = P0.ph_hi; const int wave_s = __builtin_amdgcn_readfirstlane(threadIdx.x >> 6);
    bool redone = false; (void)redone;
    for (int ph = ph_lo; ph < ph_hi; ++ph) {
        KParamsPtr kpl = kp0; asm volatile("" : "+s"(kpl));
        const KParamsPtr P = kpl; unsigned char* ws = P->ws;
        u16* XN = (u16*)(ws + WS_XN); u16* HB = (u16*)(ws + WS_PROJ);
        int G = gridDim.x, bx = blockIdx.x; asm volatile("" : "+s"(G), "+s"(bx));
        Ctx C; C.G = G; C.bx = bx; C.lds = (LAS unsigned char*)lds_raw; C.wave = wave_s; C.lane = lane_opaque(); C.tid = wave_s * 64 + C.lane; C.r32 = C.lane & 31; C.hi = C.lane >> 5;
        C.proj = (u16*)(ws + WS_PROJ); C.obuf = (u16*)(ws + WS_XN); C.vt = (u16*)(ws + WS_VT);
        const int layer = ph / NPH_L, s = ph % NPH_L;
        if (ph == NPH - 1) { norm_phase(C, P->out, P->final_norm, nullptr, P->out); }
        else switch (s) {
        case 0: { convert_weights(C, P, layer); __syncthreads(); norm_phase(C, layer == 0 ? P->x : P->out, P->norm_ffn1 + (size_t)layer * DM, XN, nullptr); } break;
        case 3: { norm_phase(C, P->out, P->norm_mix + (size_t)layer * DM, XN, nullptr); } break;
        case 11: { norm_phase(C, P->out, P->norm_ffn2 + (size_t)layer * DM, XN, nullptr); } break;
#ifndef NO_GEMM
#ifndef NO_G1
        case 1: case 12: {
            pg8::Gemm g{XN, (const u16*)(ws + (s == 1 ? WS_GU1 : WS_GU2)), MTOK, 2 * DFF, DM}; pg8::StaticOrder S; S.init(MTOK, 2 * DFF, G, bx);
            pg8::EpiSwiGLU E{HB, DFF};
            pg8::gemm_phase<pg8::EpiSwiGLU, pg8::StaticOrder, true, true>(C.lds, g, S, E, C.wave); } break;
#endif
#ifndef NO_G2
        case 2: case 13: case 10: {
            const u16* A = (s == 10) ? (const u16*)XN : (const u16*)HB; const u16* Bt = (const u16*)(ws + (s == 2 ? WS_DN1 : s == 13 ? WS_DN2 : WS_WOUT));
            pg8::Gemm g{A, Bt, MTOK, DM, s == 10 ? DM : DFF}; pg8::StaticOrder S; S.init(MTOK, DM, G, bx);
            pg8::EpiResid E{(layer == 0 && s == 2) ? P->x : (const float*)P->out, P->out, DM, s == 10 ? 1.0f : 0.5f};
            pg8::gemm_phase<pg8::EpiResid, pg8::StaticOrder, true, true>(C.lds, g, S, E, C.wave); } break;
#endif
#ifndef NO_G4
        case 4: {
            pg8::Gemm g{XN, (const u16*)(ws + WS_WIN), MTOK, PW, DM}; pg8::StaticOrder S; S.init(MTOK, PW, G, bx);
            pg8::EpiBf16<0> E{C.proj, PW};
            pg8::gemm_phase<pg8::EpiBf16<0>, pg8::StaticOrder, true, true>(C.lds, g, S, E, C.wave); } break;
#endif
#endif
#ifndef NO_PREP
        case 5: prep_a(C, P, layer); break;
#endif
#if !defined(NO_GEMM) && !defined(NO_G6)
        case 6: {
            for (int i = 0; i < 2; ++i) {
                pg8::Gemm g{(const u16*)XN + (size_t)i * 4096 * 2048, (const u16*)(ws + WS_W1) + (size_t)i * 256 * 2048, 4096, 256, 2048}; pg8::StaticOrder S; S.init(4096, 256, G, (bx + G - 16 * i) % G);
                pg8::EpiBf16<1> E{(u16*)(ws + WS_HID) + (size_t)i * 4096 * 256, 256};
                pg8::gemm_phase<pg8::EpiBf16<1>, pg8::StaticOrder, true, true>(C.lds, g, S, E, C.wave); } } break;
#endif
#ifndef NO_PREP
        case 7: prep_c(C, P, layer); break;
#endif
#ifndef NO_ATT1
        case 8: {
            for (int u0 = bx; u0 < 1024 + 256; u0 += G) {
                if (u0 < 1024) { const int rnd = u0 >> 8, pos = ((u0 & 255) + 64 * rnd) & 255, grp = pos >> 6, bh = pos & 63, b = bh >> 2, h = bh & 3;
                    const int qb = ((grp & 2) ? 6 : 7) - 2 * rnd;
                    if (grp & 1) {
#ifndef NO_MOBA
                        moba_unit(C, P, b, h, qb);
#endif
                    } else {
#ifndef NO_DIFF
                        diff_unit(C, P, layer, b, h, qb);
#endif
                    } }
                else { const int c = u0 - 1024;
#ifndef NO_CMP
                    cmp_unit(C, P, c >> 4, (c >> 3) & 1, c & 7);
#endif
                }
            } } break;
#endif
#ifndef NO_ATT2
        case 9: {
            for (int u0 = bx, rnd = 0; u0 < 1024; u0 += G, ++rnd) {
                const int base = u0 - bx; int pos = bx; if ((rnd & 1) && base + G <= 1024) pos = G - 1 - bx; const int u = base + pos;
                nsa_unit(C, P, (u & 127) >> 3, u & 7, 7 - (u >> 7)); }
            } break;
#endif
        default: break;
        }
        if (ph + 1 < ph_hi) { if (ph == ph_lo) grid.sync(); else xcd_barrier(bar); }
#ifdef PROBE_LO
        if (ph != NPH - 1 && s == PROBE_HI) { if (!redone) { ph -= (PROBE_HI - PROBE_LO + 1); redone = true; } else redone = false; }
#endif
#ifdef PROBE_SYNC
        if (ph + 1 < ph_hi) xcd_barrier(bar);
#endif
    }
}

#ifndef COOP
#define COOP 1
#endif
extern "C" void kernel_launch(void* const* d_in, const int* in_sizes, int n_in, void* d_out, int out_size, void* d_ws, size_t ws_size, hipStream_t stream) {
    static int grid = 0;
    if (grid == 0) {
        if (n_in != 19 || out_size != MTOK * DM || ws_size < WS_END) { fprintf(stderr, "kernel_launch: unexpected shapes (n_in %d out %d ws %zu)\n", n_in, out_size, ws_size); grid = -1; return; }
        int dev = 0, cus = 0, per_cu = 0;
        (void)hipGetDevice(&dev); (void)hipDeviceGetAttribute(&cus, hipDeviceAttributeMultiprocessorCount, dev);
        if (hipFuncSetAttribute((const void*)hybrid_fwd, hipFuncAttributeMaxDynamicSharedMemorySize, LDS_BYTES) != hipSuccess) { fprintf(stderr, "kernel_launch: hipFuncSetAttribute failed\n"); grid = -1; return; }
        if (hipOccupancyMaxActiveBlocksPerMultiprocessor(&per_cu, (const void*)hybrid_fwd, 512, LDS_BYTES) != hipSuccess || per_cu < 1) { fprintf(stderr, "kernel_launch: occupancy query says %d\n", per_cu); per_cu = 1; }
        (void)hipGetLastError();
        grid = cus * per_cu;
    }
    if (grid < 0) return;
    Params p{};
    p.x = (const float*)d_in[0]; p.rel_bias = (const float*)d_in[1]; p.norm_ffn1 = (const float*)d_in[2]; p.ffn1_gate = (const float*)d_in[3]; p.ffn1_up = (const float*)d_in[4]; p.ffn1_down = (const float*)d_in[5];
    p.norm_mix = (const float*)d_in[6]; p.w_in = (const float*)d_in[7]; p.diff_lambda = (const float*)d_in[8]; p.diff_subln = (const float*)d_in[9]; p.cmp_pe = (const float*)d_in[10]; p.cmp_w1 = (const float*)d_in[11];
    p.cmp_w2 = (const float*)d_in[12]; p.w_out = (const float*)d_in[13]; p.norm_ffn2 = (const float*)d_in[14]; p.ffn2_gate = (const float*)d_in[15]; p.ffn2_up = (const float*)d_in[16]; p.ffn2_down = (const float*)d_in[17];
    p.final_norm = (const float*)d_in[18]; p.out = (float*)d_out; p.ws = (unsigned char*)d_ws;
    for (int l = 0; l < 4; ++l) p.lam_init[l] = (float)(0.8 - 0.6 * exp(-0.3 * (double)l));
#if COOP
    if (hipMemsetAsync((char*)d_ws + WS_CTL, 0, CTL_ZERO_BYTES, stream) != hipSuccess) { fprintf(stderr, "kernel_launch: memset of barrier words failed\n"); return; }
    p.ph_lo = 0; p.ph_hi = NPH;
    void* args[] = {&p};
    hipError_t e = hipLaunchCooperativeKernel((const void*)hybrid_fwd, dim3(grid), dim3(512), args, LDS_BYTES, stream);
    if (e != hipSuccess) fprintf(stderr, "cooperative launch failed: %s (grid %d)\n", hipGetErrorString(e), grid);
#else
    for (int ph = 0; ph < NPH; ++ph) { p.ph_lo = ph; p.ph_hi = ph + 1; hipLaunchKernelGGL(hybrid_fwd, dim3(grid), dim3(512), LDS_BYTES, stream, p); }
#endif
}
```

```cpp
#include <hip/hip_runtime.h>
#include <hip/hip_cooperative_groups.h>
#include <cstdio>
#include <cstdint>
#include <cmath>
namespace cg = cooperative_groups;
#define COOP 1
namespace pg8 {
#define PG8_LAS __attribute__((address_space(3)))
typedef unsigned short bf16_t;
typedef short bf16x8 __attribute__((ext_vector_type(8)));
typedef float f32x4 __attribute__((ext_vector_type(4)));
typedef unsigned u32x4 __attribute__((ext_vector_type(4)));
constexpr int BM = 256, BK = 64, HALF = 128, HTB = HALF * BK * 2  , STAGE_BYTES = 8 * HTB, NXCD = 8, WGM = 8;

__host__ __device__ __forceinline__ int lds_byte(int r, int c) { const int st = (r >> 4) * 2 + (c >> 5), rr = r & 15, cc = c & 31, ob = rr * 64 + cc * 2; return st * 1024 + (ob ^ (((ob >> 9) & 1) << 5)); }
__host__ __device__ __forceinline__ void stage_rc(int b, int& R, int& C) { const int st = b / 1024, sb = b % 1024, swz = sb ^ (((sb >> 9) & 1) << 5); R = (st >> 1) * 16 + swz / 64; C = (st & 1) * 32 + (swz % 64) / 2; }
__host__ __device__ __forceinline__ int perm32(int rho) { const int n = rho >> 4, i = rho & 15; return 8 * (i >> 2) + 4 * n + (i & 3); }

struct Unit { int pm, pn; };
struct Gemm { const bf16_t* A; const bf16_t* Bt; int M, N, K; };

struct StaticOrder {
    int nM, nN, nwg, G, c;
    __host__ __device__ void init(int M, int N, int G_, int c_) { nM = M / BM; nN = N / BM; nwg = nM * nN; G = G_; c = c_; }
    __host__ __device__ bool next(int i, Unit& u) const {
        const long L = (long)i * G + c; if (L >= nwg) return false;
        int wgid = (int)L; { const int q = nwg / NXCD, r = nwg % NXCD, xcd = wgid % NXCD, off = wgid / NXCD; wgid = (xcd < r ? xcd * (q + 1) : r * (q + 1) + (xcd - r) * q) + off; }
        const int nig = WGM * nN, gid = wgid / nig, fm = gid * WGM, gsz = (nM - fm) < WGM ? (nM - fm) : WGM;
        u.pm = fm + ((wgid % nig) % gsz); u.pn = (wgid % nig) / gsz; return true;
    }
    __device__ __forceinline__ void a_ready(const Unit&) const {}
    __device__ __forceinline__ void done(const Unit&) const {}
};

__device__ __forceinline__ unsigned cvt_pk_bf16(float lo, float hi) { unsigned r; asm volatile("v_cvt_pk_bf16_f32 %0, %1, %2" : "=v"(r) : "v"(lo), "v"(hi)); return r; }

__device__ __forceinline__ float ex2(float x) { return __builtin_amdgcn_exp2f(x); }
__device__ __forceinline__ float rcpf_(float x) { return __builtin_amdgcn_rcpf(x); }
__device__ __forceinline__ float silu_f(float x) { return x * rcpf_(1.0f + ex2(-1.4426950408889634f * x)); }
__device__ __forceinline__ float gelu_tanh_f(float x) { const float y2 = 2.0f * 0.7978845608028654f * (x + 0.044715f * x * x * x); return x * (1.0f - rcpf_(1.0f + ex2(1.4426950408889634f * y2))); }

struct EpiSwiGLU {
    static constexpr bool PERM = true, AFTER_DRAIN = false;
    bf16_t* O; int ldc;
    __device__ __forceinline__ void operator()(const f32x4 (&acc)[2][2][4][2], const Unit& u, int wr, int wc, int fr, int fq) const {
        const int row0 = u.pm * BM + wr * 64 + fr; const int col0 = u.pn * HALF + wc * 32 + 8 * fq;
#pragma unroll
        for (int ai = 0; ai < 2; ++ai)
#pragma unroll
            for (int m = 0; m < 4; ++m) { bf16_t* rowp = O + (size_t)(row0 + ai * HALF + m * 16) * ldc + col0;
                const f32x4 g0 = acc[ai][0][m][0], g1 = acc[ai][0][m][1], u0 = acc[ai][1][m][0], u1 = acc[ai][1][m][1];
                u32x4 w; w.x = cvt_pk_bf16(silu_f(g0[0]) * u0[0], silu_f(g0[1]) * u0[1]); w.y = cvt_pk_bf16(silu_f(g0[2]) * u0[2], silu_f(g0[3]) * u0[3]);
                w.z = cvt_pk_bf16(silu_f(g1[0]) * u1[0], silu_f(g1[1]) * u1[1]); w.w = cvt_pk_bf16(silu_f(g1[2]) * u1[2], silu_f(g1[3]) * u1[3]);
                *(u32x4*)rowp = w; asm volatile("" ::: "memory"); }
    }
};
template <int ACT> struct EpiBf16 {
    static constexpr bool PERM = true, AFTER_DRAIN = false;
    bf16_t* O; int ldc;
    __device__ __forceinline__ void operator()(const f32x4 (&acc)[2][2][4][2], const Unit& u, int wr, int wc, int fr, int fq) const {
        const int row0 = u.pm * BM + wr * 64 + fr; const int col0 = u.pn * BM + wc * 32 + 8 * fq;
#pragma unroll
        for (int ai = 0; ai < 2; ++ai)
#pragma unroll
            for (int m = 0; m < 4; ++m) { bf16_t* rowp = O + (size_t)(row0 + ai * HALF + m * 16) * ldc + col0;
#pragma unroll
                for (int bj = 0; bj < 2; ++bj) { f32x4 v0 = acc[ai][bj][m][0], v1 = acc[ai][bj][m][1];
                    if (ACT == 1) { v0 = (f32x4){gelu_tanh_f(v0[0]), gelu_tanh_f(v0[1]), gelu_tanh_f(v0[2]), gelu_tanh_f(v0[3])}; v1 = (f32x4){gelu_tanh_f(v1[0]), gelu_tanh_f(v1[1]), gelu_tanh_f(v1[2]), gelu_tanh_f(v1[3])}; }
                    u32x4 w; w.x = cvt_pk_bf16(v0[0], v0[1]); w.y = cvt_pk_bf16(v0[2], v0[3]); w.z = cvt_pk_bf16(v1[0], v1[1]); w.w = cvt_pk_bf16(v1[2], v1[3]);
                    *(u32x4*)(rowp + bj * HALF) = w; } asm volatile("" ::: "memory"); }
    }
};
struct EpiResid {
    static constexpr bool PERM = false, AFTER_DRAIN = false;
    const float* base; float* out; int ldc; float alpha;
    __device__ __forceinline__ void operator()(const f32x4 (&acc)[2][2][4][2], const Unit& u, int wr, int wc, int fr, int fq) const {
        const int row0 = u.pm * BM + wr * 64 + fr; const int col0 = u.pn * BM + wc * 32 + 4 * fq;
#pragma unroll
        for (int ai = 0; ai < 2; ++ai)
#pragma unroll
            for (int m = 0; m < 4; ++m) { const size_t off = (size_t)(row0 + ai * HALF + m * 16) * ldc + col0;
#pragma unroll
                for (int bj = 0; bj < 2; ++bj)
#pragma unroll
                    for (int n = 0; n < 2; ++n) { const f32x4 bs = *(const f32x4*)(base + off + bj * HALF + n * 16); *(f32x4*)(out + off + bj * HALF + n * 16) = bs + acc[ai][bj][m][n] * alpha; } asm volatile("" ::: "memory"); }
    }
};
template <class Epi, class Sched, bool ALIGN_EPI = false, bool SP2 = false>
__device__ __forceinline__ void gemm_phase(PG8_LAS unsigned char* lds, const Gemm g, const Sched& S, const Epi& E, const int wave_in) {
    int tid_l; asm volatile("v_mbcnt_lo_u32_b32 %0, -1, 0\n\tv_mbcnt_hi_u32_b32 %0, -1, %0" : "=v"(tid_l)); tid_l += wave_in * 64;
    const int tid = tid_l, wid = __builtin_amdgcn_readfirstlane(tid >> 6), lane = tid & 63, wr = wid >> 2, wc = wid & 3, fr = lane & 15, fq = lane >> 4;
    const int K = g.K, nt = K / BK;
    unsigned voffA[2], voffB[2];
#pragma unroll
    for (int i = 0; i < 2; ++i) { int R, C; stage_rc(tid * 16 + i * 8192, R, C); const int Rb = Epi::PERM ? ((R & ~31) + perm32(R & 31)) : R;
        voffA[i] = (unsigned)(R * K + C) * 2u; voffB[i] = (unsigned)(Rb * K + C) * 2u; }
    const size_t kstep = (size_t)(BK * 2);
    const size_t hstep = (size_t)HALF * K * 2;
    const size_t tstep = 2 * hstep;
    const unsigned ldsw = (unsigned)wid * 1024u;
    const int aoff = lds_byte(wr * 64 + fr, fq * 8), boff = lds_byte(wc * 32 + fr, fq * 8);
#define PG8_SA(b, h) (((b) * 2 + (h)) * HTB)
#define PG8_SB(b, h) ((4 + (b) * 2 + (h)) * HTB)
#define PG8_STAGE(bufoff, gbase, voff) do { _Pragma("unroll") for (int _i = 0; _i < 2; ++_i) \
        __builtin_amdgcn_global_load_lds((const unsigned*)((const char*)(gbase) + (voff)[_i]), (PG8_LAS unsigned*)(lds + (bufoff) + ldsw + _i * 8192), 16, 0, 0); } while (0)
#define PG8_LDA(dst, b, h) do { _Pragma("unroll") for (int m = 0; m < 4; ++m) _Pragma("unroll") for (int k = 0; k < 2; ++k) dst[m][k] = *(const PG8_LAS bf16x8*)(lds + PG8_SA(b, h) + aoff + m * 2048 + k * 1024); } while (0)
#define PG8_LDB(dst, b, h) do { _Pragma("unroll") for (int n = 0; n < 2; ++n) _Pragma("unroll") for (int k = 0; k < 2; ++k) dst[n][k] = *(const PG8_LAS bf16x8*)(lds + PG8_SB(b, h) + boff + n * 2048 + k * 1024); } while (0)
#define PG8_MMA(ai, bj, At, Bt) do { __builtin_amdgcn_s_setprio(1); _Pragma("unroll") for (int m = 0; m < 4; ++m) _Pragma("unroll") for (int n = 0; n < 2; ++n) _Pragma("unroll") for (int k = 0; k < 2; ++k) \
        acc[ai][bj][m][n] = __builtin_amdgcn_mfma_f32_16x16x32_bf16(Bt[n][k], At[m][k], acc[ai][bj][m][n], 0, 0, 0); __builtin_amdgcn_s_setprio(0); } while (0)
#define PG8_WAIT_V(n) asm volatile("s_waitcnt vmcnt(" #n ")" ::: "memory")
#define PG8_WAIT_L(n) asm volatile("s_waitcnt lgkmcnt(" #n ")" ::: "memory")
#define PG8_BAR __builtin_amdgcn_s_barrier()
#define PG8_SCHED __builtin_amdgcn_sched_barrier(0)
    Unit cur, nxt; int ui = 0;
    if (!S.next(0, cur)) return;
    f32x4 acc[2][2][4][2];
#pragma unroll
    for (int a = 0; a < 2; ++a)
#pragma unroll
        for (int b = 0; b < 2; ++b)
#pragma unroll
            for (int m = 0; m < 4; ++m)
#pragma unroll
                for (int n = 0; n < 2; ++n) acc[a][b][m][n] = (f32x4){0.f, 0.f, 0.f, 0.f};
    bf16x8 At[4][2], B0[2][2], B1[2][2];
    const char* cA = (const char*)g.A + (size_t)cur.pm * tstep; const char* cB = (const char*)g.Bt + (size_t)cur.pn * tstep;
    S.a_ready(cur);
    if constexpr (SP2) {
        PG8_STAGE(PG8_SB(0, 0), cB, voffB); PG8_STAGE(PG8_SB(0, 1), cB + hstep, voffB); PG8_STAGE(PG8_SA(0, 0), cA, voffA); PG8_STAGE(PG8_SA(0, 1), cA + hstep, voffA);
        if (wr == 1) PG8_BAR;
        PG8_WAIT_V(2); PG8_BAR;
        PG8_STAGE(PG8_SB(1, 0), cB + kstep, voffB); PG8_STAGE(PG8_SA(1, 0), cA + kstep, voffA); PG8_STAGE(PG8_SB(1, 1), cB + hstep + kstep, voffB);
        PG8_WAIT_V(6); PG8_BAR;
    } else {
        PG8_STAGE(PG8_SB(0, 0), cB, voffB); PG8_STAGE(PG8_SA(0, 0), cA, voffA); PG8_STAGE(PG8_SB(0, 1), cB + hstep, voffB); PG8_STAGE(PG8_SA(0, 1), cA + hstep, voffA);
        if (wr == 1) PG8_BAR;
        PG8_WAIT_V(4); PG8_BAR;
        PG8_STAGE(PG8_SB(1, 0), cB + kstep, voffB); PG8_STAGE(PG8_SA(1, 0), cA + kstep, voffA); PG8_STAGE(PG8_SB(1, 1), cB + hstep + kstep, voffB);
        PG8_WAIT_V(6); PG8_BAR;
    }
    for (;;) {
        const bool has_next = S.next(ui + 1, nxt);
        const char* nA = has_next ? (const char*)g.A + (size_t)nxt.pm * tstep : cA; const char* nB = has_next ? (const char*)g.Bt + (size_t)nxt.pn * tstep : cB;
        for (int t = 0; t < nt; t += 2) {
            const bool last = (t == nt - 2);
            const char* a1 = cA + (size_t)(t + 1) * kstep;
            const char* a2 = last ? nA : cA + (size_t)(t + 2) * kstep; const char* b2 = last ? nB : cB + (size_t)(t + 2) * kstep;
            const char* a3 = a2 + kstep; const char* b3 = b2 + kstep;
            if (last && has_next) S.a_ready(nxt);
            if constexpr (SP2) {
            PG8_LDB(B0, 0, 0); PG8_LDB(B1, 0, 1); PG8_SCHED; PG8_LDA(At, 0, 0); PG8_STAGE(PG8_SA(1, 1), a1 + hstep, voffA);
            PG8_WAIT_V(8); PG8_WAIT_L(0); PG8_BAR; PG8_MMA(0, 0, At, B0); PG8_MMA(0, 1, At, B1); PG8_BAR; PG8_SCHED;
            PG8_LDA(At, 0, 1); PG8_STAGE(PG8_SB(0, 0), b2, voffB); PG8_STAGE(PG8_SB(0, 1), b2 + hstep, voffB); PG8_STAGE(PG8_SA(0, 0), a2, voffA);
            PG8_WAIT_V(8); PG8_WAIT_L(0); PG8_BAR; PG8_MMA(1, 0, At, B0); PG8_MMA(1, 1, At, B1); PG8_BAR; PG8_SCHED;
            PG8_LDB(B0, 1, 0); PG8_LDB(B1, 1, 1); PG8_SCHED; PG8_LDA(At, 1, 0); PG8_STAGE(PG8_SA(0, 1), a2 + hstep, voffA);
            PG8_WAIT_V(8); PG8_WAIT_L(0); PG8_BAR; PG8_MMA(0, 0, At, B0); PG8_MMA(0, 1, At, B1); PG8_BAR; PG8_SCHED;
            PG8_LDA(At, 1, 1); PG8_STAGE(PG8_SB(1, 0), b3, voffB); PG8_STAGE(PG8_SB(1, 1), b3 + hstep, voffB); PG8_STAGE(PG8_SA(1, 0), a3, voffA);
            PG8_WAIT_V(8); PG8_WAIT_L(0); PG8_BAR; PG8_MMA(1, 0, At, B0); PG8_MMA(1, 1, At, B1); PG8_BAR; PG8_SCHED;
            } else {
            PG8_LDB(B0, 0, 0); PG8_SCHED; PG8_LDA(At, 0, 0); PG8_STAGE(PG8_SA(1, 1), a1 + hstep, voffA);
            PG8_WAIT_L(8); PG8_BAR; PG8_WAIT_L(0); PG8_MMA(0, 0, At, B0); PG8_BAR; PG8_SCHED;
            PG8_LDB(B1, 0, 1); PG8_STAGE(PG8_SB(0, 0), b2, voffB);
            PG8_BAR; PG8_WAIT_L(0); PG8_MMA(0, 1, At, B1); PG8_BAR;
            PG8_LDA(At, 0, 1); PG8_STAGE(PG8_SA(0, 0), a2, voffA);
            PG8_BAR; PG8_WAIT_L(0); PG8_MMA(1, 0, At, B0); PG8_BAR; PG8_SCHED;
            PG8_STAGE(PG8_SB(0, 1), b2 + hstep, voffB);
            PG8_WAIT_V(6); PG8_BAR; PG8_MMA(1, 1, At, B1); PG8_BAR;
            PG8_LDB(B0, 1, 0); PG8_SCHED; PG8_LDA(At, 1, 0); PG8_STAGE(PG8_SA(0, 1), a2 + hstep, voffA);
            PG8_WAIT_L(8); PG8_BAR; PG8_WAIT_L(0); PG8_MMA(0, 0, At, B0); PG8_BAR; PG8_SCHED;
            PG8_LDB(B1, 1, 1); PG8_STAGE(PG8_SB(1, 0), b3, voffB);
            PG8_BAR; PG8_WAIT_L(0); PG8_MMA(0, 1, At, B1); PG8_BAR;
            PG8_LDA(At, 1, 1); PG8_STAGE(PG8_SA(1, 0), a3, voffA);
            PG8_BAR; PG8_WAIT_L(0); PG8_MMA(1, 0, At, B0); PG8_BAR; PG8_SCHED;
            PG8_STAGE(PG8_SB(1, 1), b3 + hstep, voffB);
            PG8_WAIT_V(6); PG8_BAR; PG8_MMA(1, 1, At, B1); PG8_BAR;
            }
        }
        if constexpr (ALIGN_EPI) { if (wr == 0) PG8_BAR; }
        if constexpr (!Epi::AFTER_DRAIN) { E(acc, cur, wr, wc, fr, fq); S.done(cur); }
        if (!has_next) break;
#pragma unroll
        for (int a = 0; a < 2; ++a)
#pragma unroll
            for (int b = 0; b < 2; ++b)
#pragma unroll
                for (int m = 0; m < 4; ++m)
#pragma unroll
                    for (int n = 0; n < 2; ++n) acc[a][b][m][n] = (f32x4){0.f, 0.f, 0.f, 0.f};
        cur = nxt; cA = nA; cB = nB; ++ui;
        if constexpr (ALIGN_EPI) { if (wr == 1) PG8_BAR; }
    }
    PG8_WAIT_V(0);
    if constexpr (!ALIGN_EPI) { if (wr == 0) PG8_BAR; }
    PG8_BAR;
    if constexpr (Epi::AFTER_DRAIN) { E.fused(acc, cur, wr, wc, fr, fq, lds, wid, lane); S.done(cur); }
#undef PG8_SA
#undef PG8_SB
#undef PG8_STAGE
#undef PG8_LDA
#undef PG8_LDB
#undef PG8_MMA
#undef PG8_WAIT_V
#undef PG8_WAIT_L
#undef PG8_BAR
#undef PG8_SCHED
}
}

#define LAS __attribute__((address_space(3)))
using pg8::ex2; using pg8::rcpf_;
typedef unsigned short u16;
typedef short bf16x8 __attribute__((ext_vector_type(8)));
typedef float f32x4 __attribute__((ext_vector_type(4)));
typedef float f32x16 __attribute__((ext_vector_type(16)));
typedef unsigned u32x4 __attribute__((ext_vector_type(4)));
typedef unsigned u32x2 __attribute__((ext_vector_type(2)));

constexpr int DM = 1024, NB = 16, SEQ = 2048, MTOK = NB * SEQ, DEPTH = 4, DFF = 2816, INW = 2840, PW = 3072;
constexpr int C_MQ = 0, C_MK = 256, C_MV = 512, C_DQ = 768, C_DK = 1024, C_DV = 1280, C_NQ = 1536, C_NKC = 2048, C_NVC = 2176, C_NKS = 2304, C_NVS = 2432, C_NKW = 2560, C_NVW = 2688, C_NG = 2816;
constexpr int NVH = 12;
constexpr float LOG2E = 1.4426950408889634f, NEGF = -1e30f;
constexpr int NPH_L = 14, NPH = NPH_L * DEPTH + 1;
constexpr size_t MiB = 1u << 20;
constexpr size_t WS_GU1 = 1 * MiB, WS_DN1 = 12 * MiB, WS_GU2 = WS_DN1 + 5 * MiB + MiB / 2, WS_DN2 = WS_GU2 + 11 * MiB, WS_WIN = 34 * MiB, WS_WOUT = 40 * MiB, WS_W1 = 42 * MiB;
constexpr size_t WS_PROJ = 44 * MiB, WS_XN = 236 * MiB, WS_VT = 300 * MiB, WS_HID = 348 * MiB, WS_KCMP = 352 * MiB, WS_VCMPT = WS_KCMP + MiB / 2, WS_KMEAN = 353 * MiB, WS_SEL = WS_KMEAN + MiB / 4, WS_END = 354 * MiB;
static_assert(WS_DN2 + 5 * MiB + MiB / 2 == WS_WIN, "ws map");
constexpr int LDS_BYTES = 147456, MISC_OFF = 147456 - 64;
constexpr size_t WS_CTL = 0, CTL_ZERO_BYTES = 65536;
constexpr int ATT_K = 0, ATT_V = 32768, ATT_LUT = 65536, ATT_PARK = 68096;
constexpr int CMP_K = 0, CMP_V = 18432, CMP_A = 36864, CMP_H = CMP_A + 256 * 33 * 4;

struct Params {
    const float* x; const float* rel_bias; const float* norm_ffn1; const float* ffn1_gate; const float* ffn1_up; const float* ffn1_down;
    const float* norm_mix; const float* w_in; const float* diff_lambda; const float* diff_subln; const float* cmp_pe; const float* cmp_w1; const float* cmp_w2;
    const float* w_out; const float* norm_ffn2; const float* ffn2_gate; const float* ffn2_up; const float* ffn2_down; const float* final_norm;
    float* out; unsigned char* ws;
    float lam_init[4];
    int ph_lo, ph_hi;
};
typedef const __attribute__((address_space(4))) Params* KParamsPtr;

__device__ __forceinline__ float bf2f(unsigned v) { return __uint_as_float(v << 16); }
typedef float f32x2_t __attribute__((ext_vector_type(2))); typedef __bf16 bf16x2_t __attribute__((ext_vector_type(2)));
__device__ __forceinline__ unsigned pkbf(float lo, float hi) { f32x2_t v = {lo, hi}; bf16x2_t b = __builtin_convertvector(v, bf16x2_t); return __builtin_bit_cast(unsigned, b); }
__device__ __forceinline__ int lane_opaque() { int l; asm volatile("v_mbcnt_lo_u32_b32 %0, -1, 0\n\tv_mbcnt_hi_u32_b32 %0, -1, %0" : "=v"(l)); return l; }
__device__ __forceinline__ float wave_sum(float v, int lane) {
#pragma unroll
    for (int o = 1; o < 64; o <<= 1) v += __int_as_float(__builtin_amdgcn_ds_bpermute((lane ^ o) << 2, __float_as_int(v)));
    return v;
}
__device__ __forceinline__ float xhalf_max(float v) { auto rr = __builtin_amdgcn_permlane32_swap(__float_as_uint(v), __float_as_uint(v), false, false); return fmaxf(__uint_as_float(rr[0]), __uint_as_float(rr[1])); }
__device__ __forceinline__ float xhalf_sum(float v) { auto rr = __builtin_amdgcn_permlane32_swap(__float_as_uint(v), __float_as_uint(v), false, false); return __uint_as_float(rr[0]) + __uint_as_float(rr[1]); }
__device__ __forceinline__ float sigmoid_f(float x) { return rcpf_(1.0f + ex2(-LOG2E * x)); }
__device__ __forceinline__ int crow(int r, int hi) { return (r & 3) + 8 * (r >> 2) + 4 * hi; }
__device__ __forceinline__ int kperm(int p) { const int h = p >> 3, j = p & 7; return 8 * (j >> 2) + 4 * h + (j & 3); }
__device__ __forceinline__ int pperm(int k) { return ((k >> 2) & 1) * 8 + (k >> 3) * 4 + (k & 3); }

__device__ __forceinline__ void tr_item(const float* W, int K, int N, u16* WT, int kb, int n0, int dst_row0, LAS float* scr, int lane, float cs = 1.0f) {
    const int k0 = 64 * kb; const int n = n0 + (lane & 31); const bool ok = n < N;
#pragma unroll 8
    for (int i = 0; i < 32; ++i) { const int kk = 2 * i + (lane >> 5); scr[kk * 33 + (lane & 31)] = ok ? W[(size_t)(k0 + kk) * N + n] * cs : 0.f; }
    asm volatile("s_waitcnt lgkmcnt(0)" ::: "memory");
    const int c = lane & 7;
#pragma unroll
    for (int j = 0; j < 4; ++j) { const int nn = (lane >> 3) + 8 * j; const LAS float* s = scr + (8 * c) * 33 + nn;
        u32x4 o; o.x = pkbf(s[0 * 33], s[1 * 33]); o.y = pkbf(s[2 * 33], s[3 * 33]); o.z = pkbf(s[4 * 33], s[5 * 33]); o.w = pkbf(s[6 * 33], s[7 * 33]);
        *(u32x4*)(WT + (size_t)(dst_row0 + nn) * K + k0 + 8 * c) = o; }
    asm volatile("s_waitcnt lgkmcnt(0)" ::: "memory");
}

__device__ __forceinline__ void norm_row(const float* xrow, const float* g, u16* dst16, float* dst32, int lane) {
    const f32x4* xr = (const f32x4*)xrow + lane; const f32x4* gr = (const f32x4*)g + lane;
    f32x4 v[4]; float s = 0.f;
#pragma unroll
    for (int j = 0; j < 4; ++j) { v[j] = xr[64 * j]; s += (v[j].x * v[j].x + v[j].y * v[j].y) + (v[j].z * v[j].z + v[j].w * v[j].w); }
    const float rstd = 1.0f / sqrtf(wave_sum(s, lane) * (1.0f / 1024.0f) + 1e-6f);
#pragma unroll
    for (int j = 0; j < 4; ++j) { const f32x4 gg = gr[64 * j]; const f32x4 y = v[j] * rstd * gg;
        if (dst16) { u32x2 o; o.x = pkbf(y.x, y.y); o.y = pkbf(y.z, y.w); *((u32x2*)dst16 + lane + 64 * j) = o; }
        else *((f32x4*)dst32 + lane + 64 * j) = y; }
}

struct AState { f32x16 o0, o1; float m, l; };
__device__ __forceinline__ void astate_init(AState& s) {
#pragma unroll
    for (int r = 0; r < 16; ++r) { s.o0[r] = 0.f; s.o1[r] = 0.f; }
    s.m = 0.f; s.l = 0.f;
}
constexpr float ATT_THR = 8.0f;
constexpr int ATT_SLOT = 9216, ATT_NSLOT = 3;
template <int KS0, int NKS>
__device__ __forceinline__ void qk_block(const LAS unsigned char* Ks, const bf16x8 (&qr)[4], int r32, int hi, f32x16& s0, f32x16& s1) {
    f32x16 ci;
#pragma unroll
    for (int r = 0; r < 16; ++r) ci[r] = 0.f;
    const LAS unsigned char* kp = Ks + hi * 1024 + r32 * 16;
#pragma unroll
    for (int ks = 0; ks < NKS; ++ks) {
        const bf16x8 a0 = *(const LAS bf16x8*)(kp + (KS0 + ks) * 2048);
        const bf16x8 a1 = *(const LAS bf16x8*)(kp + (KS0 + ks) * 2048 + 512);
        s0 = __builtin_amdgcn_mfma_f32_32x32x16_bf16(a0, qr[KS0 + ks], ks == 0 ? ci : s0, 0, 0, 0);
        s1 = __builtin_amdgcn_mfma_f32_32x32x16_bf16(a1, qr[KS0 + ks], ks == 0 ? ci : s1, 0, 0, 0);
    }
    __builtin_amdgcn_sched_group_barrier(0x100, 2 * NKS, 0); __builtin_amdgcn_sched_group_barrier(0x008, 2 * NKS, 0);
}
__device__ __forceinline__ void pv_block(const LAS unsigned char* Vs, const u32x4 (&pk)[4], int r32, int hi, AState& st) {
    const LAS unsigned char* vp = Vs + hi * 1024 + r32 * 16;
#pragma unroll
    for (int c = 0; c < 4; ++c) {
        const bf16x8 v0 = *(const LAS bf16x8*)(vp + c * 2048);
        const bf16x8 v1 = *(const LAS bf16x8*)(vp + c * 2048 + 512);
        const bf16x8 pb = __builtin_bit_cast(bf16x8, pk[c]);
        st.o0 = __builtin_amdgcn_mfma_f32_32x32x16_bf16(v0, pb, st.o0, 0, 0, 0);
        st.o1 = __builtin_amdgcn_mfma_f32_32x32x16_bf16(v1, pb, st.o1, 0, 0, 0);
    }
    __builtin_amdgcn_sched_group_barrier(0x100, 8, 0); __builtin_amdgcn_sched_group_barrier(0x008, 8, 0);
}
__device__ __forceinline__ void glds16(const void* gsrc, unsigned lds_dst) { unsigned keep;
    asm volatile("s_mov_b32 %0, m0\n\ts_mov_b32 m0, %2\n\ts_nop 0\n\tglobal_load_lds_dwordx4 %1, off\n\ts_mov_b32 m0, %0" : "=&s"(keep) : "v"(gsrc), "s"(lds_dst) : "memory"); }
__device__ __forceinline__ void lut_add(f32x16& s0, f32x16& s1, const LAS float* lut1, int dbase, float cc) {
#pragma unroll
    for (int r = 0; r < 16; ++r) { const int d0 = dbase - ((r & 3) + 8 * (r >> 2)); const int d1 = d0 - 32;
        s0[r] += lut1[min(max(d0, -1), 512)] + cc; s1[r] += lut1[min(max(d1, -1), 512)] + cc;
        if ((r & 3) == 3) __builtin_amdgcn_sched_barrier(0); }
}
__device__ __forceinline__ void const_add(f32x16& s0, f32x16& s1, float cc) {
#pragma unroll
    for (int r = 0; r < 16; ++r) { s0[r] += cc; s1[r] += cc; }
}
__device__ __forceinline__ float row_max(const f32x16& s0, const f32x16& s1) {
    float mx = fmaxf(s0[0], s1[0]);
#pragma unroll
    for (int r = 1; r < 16; ++r) mx = fmaxf(mx, fmaxf(s0[r], s1[r]));
    return xhalf_max(mx);
}
__device__ __forceinline__ void rescale(AState& st, f32x16& s0, f32x16& s1, float mx) {
    const float dl = fmaxf(mx, 0.f); const float f = ex2(-dl); st.m += dl; st.l *= f;
#pragma unroll
    for (int r = 0; r < 16; ++r) { st.o0[r] *= f; st.o1[r] *= f; s0[r] -= dl; s1[r] -= dl; }
}
__device__ __forceinline__ void exp_pack(f32x16& s0, f32x16& s1, u32x4 (&pk)[4], AState& st) {
    float sum = 0.f;
#pragma unroll
    for (int r = 0; r < 16; ++r) { s0[r] = ex2(s0[r]); s1[r] = ex2(s1[r]); sum += s0[r] + s1[r]; }
    st.l += sum;
    pk[0] = (u32x4){pkbf(s0[0], s0[1]), pkbf(s0[2], s0[3]), pkbf(s0[4], s0[5]), pkbf(s0[6], s0[7])};
    pk[1] = (u32x4){pkbf(s0[8], s0[9]), pkbf(s0[10], s0[11]), pkbf(s0[12], s0[13]), pkbf(s0[14], s0[15])};
    pk[2] = (u32x4){pkbf(s1[0], s1[1]), pkbf(s1[2], s1[3]), pkbf(s1[4], s1[5]), pkbf(s1[6], s1[7])};
    pk[3] = (u32x4){pkbf(s1[8], s1[9]), pkbf(s1[10], s1[11]), pkbf(s1[12], s1[13]), pkbf(s1[14], s1[15])};
}

template <int KS0, int NKS, bool WINDOW, int MODE>
__device__ __forceinline__ void run_tiles(LAS unsigned char* lds, int t0, int t1, const u16* Kg, const u16* Vtg, const bf16x8 (&qr)[4], float c31,
                                          int q0w, unsigned mask, int qb, AState& A, int wave, int lane, int r32, int hi) {
    LAS unsigned char* Kr = lds + ATT_K; LAS unsigned char* Vr = lds + ATT_V; const LAS float* lut1 = (const LAS float*)(lds + ATT_LUT) + 1;
    const u16* ksrc = Kg + (size_t)lane * PW + wave * 8;
    const u16* vsrc = Vtg + (size_t)lane * SEQ + wave * 8;
    const unsigned kdst = (unsigned)(uintptr_t)Kr + wave * 1024, vdst = (unsigned)(uintptr_t)Vr + wave * 1024;
#define TCL(t) ((t) < t0 ? t0 : ((t) > t1 ? t1 : (t)))
#define DMA_K(tn) glds16(ksrc + (size_t)TCL(tn) * 64 * PW, (unsigned)__builtin_amdgcn_readfirstlane(kdst + ((tn) & 3) * 8192))
#define DMA_V(tn) glds16(vsrc + TCL(tn) * 64, (unsigned)__builtin_amdgcn_readfirstlane(vdst + ((tn) & 3) * 8192))
#define KS_(t) (Kr + ((t) & 3) * 8192)
#define VS_(t) (Vr + ((t) & 3) * 8192)
#define WAIT_BAR4() asm volatile("s_waitcnt vmcnt(4) lgkmcnt(0)\n\ts_barrier" ::: "memory")
#define T_ACTIVE(t) (!((q0w + 31 - (t) * 64) < 0 || (WINDOW && (q0w - ((t) * 64 + 63)) >= 512)))
#define T_LUTMODE(t) (((q0w - ((t) * 64 + 63)) < 128) || (WINDOW && (q0w + 31 - (t) * 64) >= 512))
    auto tile_sel = [&](int t) -> int { if (MODE == 1) { const int blk = t >> 2; return blk < qb ? (int)((mask >> blk) & 1u) : 1; } if (MODE == 2) return (int)((mask >> t) & 1u); return 1; };
    asm volatile("s_waitcnt vmcnt(0)" ::: "memory");
#pragma unroll
    for (int j = 0; j < 4; ++j) { DMA_K(t0 + j); DMA_V(t0 + j - 2); }
    WAIT_BAR4();
    f32x16 sn0, sn1, sc0, sc1; u32x4 pk[4];
#pragma unroll
    for (int r = 0; r < 16; ++r) { sn0[r] = 0.f; sn1[r] = 0.f; }
#pragma unroll
    for (int i = 0; i < 4; ++i) pk[i] = (u32x4){0u, 0u, 0u, 0u};
    bool act_n = T_ACTIVE(t0), act_c = false, act_p = false;
    if (act_n) qk_block<KS0, NKS>(KS_(t0), qr, r32, hi, sn0, sn1);
    asm volatile("s_waitcnt lgkmcnt(0)\n\ts_barrier" ::: "memory");
    for (int c = t0; c <= t1 + 1; ++c) {
        act_p = act_c; act_c = act_n; sc0 = sn0; sc1 = sn1;
        DMA_K(c + 4); DMA_V(c + 2);
        act_n = (c + 1 <= t1) && T_ACTIVE(c + 1);
        const bool lm_c = T_LUTMODE(c);
        const int dbase = q0w + r32 - c * 64 - 4 * hi;
        const float selc = tile_sel(c) ? (lm_c ? 0.f : c31) : NEGF;
        if (act_p) pv_block(VS_(c - 1), pk, r32, hi, A);
        if (act_c) {
            if (lm_c) lut_add(sc0, sc1, lut1, dbase, selc - A.m); else const_add(sc0, sc1, selc - A.m);
            const float mx = row_max(sc0, sc1);
            if (__any(mx > ATT_THR)) rescale(A, sc0, sc1, mx);
        }
        if (act_n) qk_block<KS0, NKS>(KS_(c + 1), qr, r32, hi, sn0, sn1);
        if (act_c) exp_pack(sc0, sc1, pk, A);
        WAIT_BAR4();
    }
    asm volatile("s_waitcnt vmcnt(0) lgkmcnt(0)\n\ts_barrier" ::: "memory");
#undef TCL
#undef DMA_K
#undef DMA_V
#undef KS_
#undef VS_
#undef WAIT_BAR4
#undef T_ACTIVE
#undef T_LUTMODE
}

__device__ __forceinline__ void build_lut(LAS unsigned char* lds, const float* rel_bias, int head, bool window, int tid) {
    LAS float* lut = (LAS float*)(lds + ATT_LUT);
    for (int i = tid; i < 514; i += 512) {
        float v;
        if (i == 0) v = NEGF;
        else if (i == 513) v = window ? NEGF : rel_bias[31 * 16 + head] * LOG2E;
        else { const int d = i - 1; int bk;
            if (d < 16) bk = d; else if (d >= 128) bk = 31; else { bk = 16 + (int)(log2f((float)d * (1.0f / 16.0f)) * (16.0f / 3.0f)); bk = bk > 31 ? 31 : bk; }
            v = rel_bias[bk * 16 + head] * LOG2E; }
        lut[i] = v;
    }
}
__device__ __forceinline__ void load_q(bf16x8 (&qr)[4], const u16* qrow, int hi) {
#pragma unroll
    for (int ks = 0; ks < 4; ++ks) qr[ks] = *(const bf16x8*)(qrow + ks * 16 + hi * 8);
}
__device__ __forceinline__ void store_o(u16* dst, const f32x16& v0, const f32x16& v1, int hi) {
#pragma unroll
    for (int g = 0; g < 4; ++g) {
        u32x2 a; a.x = pkbf(v0[4 * g], v0[4 * g + 1]); a.y = pkbf(v0[4 * g + 2], v0[4 * g + 3]); *(u32x2*)(dst + 8 * g + 4 * hi) = a;
        u32x2 b; b.x = pkbf(v1[4 * g], v1[4 * g + 1]); b.y = pkbf(v1[4 * g + 2], v1[4 * g + 3]); *(u32x2*)(dst + 32 + 8 * g + 4 * hi) = b;
    }
}

struct Ctx { LAS unsigned char* lds; int tid, lane, wave, r32, hi, G, bx; u16* proj; u16* obuf; u16* vt; };

__device__ __forceinline__ void moba_unit(const Ctx& C0, KParamsPtr P, int b, int h, int qb) {
    Ctx C = C0; C.lane = lane_opaque(); C.tid = C.wave * 64 + C.lane; C.r32 = C.lane & 31; C.hi = C.lane >> 5;
    const int q0w = __builtin_amdgcn_readfirstlane(qb * 256 + C.wave * 32); const int qpos = q0w + C.r32; const size_t tok = (size_t)b * SEQ + qpos;
    build_lut(C.lds, P->rel_bias, h, false, C.tid);
    const u16* qrow = C.proj + tok * PW + C_MQ + h * 64;
    bf16x8 qr[4]; load_q(qr, qrow, C.hi);
    unsigned mask = 0;
    if (qb > 0) {
        float g[7];
#pragma unroll
        for (int j = 0; j < 7; ++j) g[j] = 0.f;
        const float* km = (const float*)(P->ws + WS_KMEAN) + (size_t)((b * 4 + h) * 8) * 64;
#pragma unroll
        for (int dc = 0; dc < 8; ++dc) {
            const u32x4 qv = *(const u32x4*)(qrow + dc * 8);
            float qf[8]; qf[0] = bf2f(qv.x & 0xffffu); qf[1] = bf2f(qv.x >> 16); qf[2] = bf2f(qv.y & 0xffffu); qf[3] = bf2f(qv.y >> 16);
            qf[4] = bf2f(qv.z & 0xffffu); qf[5] = bf2f(qv.z >> 16); qf[6] = bf2f(qv.w & 0xffffu); qf[7] = bf2f(qv.w >> 16);
#pragma unroll
            for (int j = 0; j < 7; ++j) if (j < qb) { const float* kmj = km + j * 64 + dc * 8;
#pragma unroll
                for (int e = 0; e < 8; ++e) g[j] = fmaf(qf[e], kmj[e], g[j]); }
        }
#pragma unroll
        for (int j = 0; j < 7; ++j) if (j < qb) { int rank = 0;
#pragma unroll
            for (int i = 0; i < 7; ++i) if (i != j && i < qb) rank += (g[i] > g[j] || (g[i] == g[j] && i < j)) ? 1 : 0;
            if (rank < 3) mask |= 1u << j; }
    }
    AState A; astate_init(A);
    const float c31 = P->rel_bias[31 * 16 + h] * LOG2E;
    run_tiles<0, 4, false, 1>(C.lds, 0, 4 * qb + 3, C.proj + (size_t)b * SEQ * PW + C_MK + h * 64, C.vt + (size_t)((b * NVH + h) * 64) * SEQ, qr, c31, q0w, mask, qb, A, C.wave, C.lane, C.r32, C.hi);
    const float inv = rcpf_(xhalf_sum(A.l));
    A.o0 *= inv; A.o1 *= inv;
    { const int l2 = lane_opaque(); const size_t tok2 = (size_t)b * SEQ + q0w + (l2 & 31);
      store_o(C.obuf + tok2 * DM + h * 64, A.o0, A.o1, l2 >> 5); }
}

__device__ __forceinline__ void diff_unit(const Ctx& C0, KParamsPtr P, int layer, int b, int h, int qb) {
    Ctx C = C0; C.lane = lane_opaque(); C.tid = C.wave * 64 + C.lane; C.r32 = C.lane & 31; C.hi = C.lane >> 5;
    const int q0w = __builtin_amdgcn_readfirstlane(qb * 256 + C.wave * 32); const int qpos = q0w + C.r32; const size_t tok = (size_t)b * SEQ + qpos;
    build_lut(C.lds, P->rel_bias, 4 + h, false, C.tid);
    bf16x8 qr[4]; load_q(qr, C.proj + tok * PW + C_DQ + h * 64, C.hi);
    AState A; astate_init(A);
    const float c31 = P->rel_bias[31 * 16 + 4 + h] * LOG2E;
    const u16* Kg = C.proj + (size_t)b * SEQ * PW + C_DK + h * 64; const u16* Vg = C.vt + (size_t)((b * NVH + 4 + h) * 64) * SEQ;
    run_tiles<0, 2, false, 0>(C.lds, 0, 4 * qb + 3, Kg, Vg, qr, c31, q0w, 0u, 0, A, C.wave, C.lane, C.r32, C.hi);
    LAS float* park = (LAS float*)(C.lds + ATT_PARK) + C.tid;
    { const float i0 = rcpf_(xhalf_sum(A.l));
#pragma unroll
      for (int r = 0; r < 16; ++r) { park[r * 512] = A.o0[r] * i0; park[(16 + r) * 512] = A.o1[r] * i0; } }
    astate_init(A);
    run_tiles<2, 2, false, 0>(C.lds, 0, 4 * qb + 3, Kg, Vg, qr, c31, q0w, 0u, 0, A, C.wave, C.lane, C.r32, C.hi);
    const float* lp = P->diff_lambda + (size_t)layer * 128; float d01 = 0.f, d23 = 0.f;
    for (int i = 0; i < 32; ++i) { d01 = fmaf(lp[i], lp[32 + i], d01); d23 = fmaf(lp[64 + i], lp[96 + i], d23); }
    const float li = P->lam_init[layer]; const float lam = expf(d01) - expf(d23) + li;
    const float i1 = lam * rcpf_(xhalf_sum(A.l));
    float ss = 0.f;
#pragma unroll
    for (int r = 0; r < 16; ++r) { A.o0[r] = park[r * 512] - A.o0[r] * i1; A.o1[r] = park[(16 + r) * 512] - A.o1[r] * i1; ss += A.o0[r] * A.o0[r] + A.o1[r] * A.o1[r]; }
    ss = xhalf_sum(ss);
    const float rstd = (1.0f / sqrtf(ss * (1.0f / 64.0f) + 1e-6f)) * (1.0f - li);
    const float* sg = P->diff_subln + (size_t)layer * 64;
#pragma unroll
    for (int r = 0; r < 16; ++r) { const int d = crow(r, C.hi); A.o0[r] *= rstd * sg[d]; A.o1[r] *= rstd * sg[32 + d]; }
    { const int l2 = lane_opaque(); const size_t tok2 = (size_t)b * SEQ + q0w + (l2 & 31);
      store_o(C.obuf + tok2 * DM + 256 + h * 64, A.o0, A.o1, l2 >> 5); }
}

__device__ __forceinline__ void nsa_unit(const Ctx& C0, KParamsPtr P, int b, int hq, int qb) {
    Ctx C = C0; C.lane = lane_opaque(); C.tid = C.wave * 64 + C.lane; C.r32 = C.lane & 31; C.hi = C.lane >> 5;
    const int g = hq >> 2;
    const int q0w = __builtin_amdgcn_readfirstlane(qb * 256 + C.wave * 32); const int qpos = q0w + C.r32; const size_t tok = (size_t)b * SEQ + qpos;
    build_lut(C.lds, P->rel_bias, 8 + hq, false, C.tid);
    bf16x8 qr[4]; load_q(qr, C.proj + tok * PW + C_NQ + hq * 64, C.hi);
    const u16* gl = C.proj + tok * PW + C_NG + hq * 3;
    const float g1 = sigmoid_f(bf2f(gl[1])), g2 = sigmoid_f(bf2f(gl[2]));
    const unsigned mask = ((const unsigned*)(P->ws + WS_SEL))[(size_t)(b * 2 + g) * SEQ + qpos];
    const float c31 = P->rel_bias[31 * 16 + 8 + hq] * LOG2E;
    AState A; astate_init(A);
    run_tiles<0, 4, false, 2>(C.lds, 0, 4 * qb + 3, C.proj + (size_t)b * SEQ * PW + C_NKS + g * 64, C.vt + (size_t)((b * NVH + 8 + g) * 64) * SEQ, qr, c31, q0w, mask, qb, A, C.wave, C.lane, C.r32, C.hi);
    LAS float* park = (LAS float*)(C.lds + ATT_PARK) + C.tid;
    { const float f = g1 * rcpf_(xhalf_sum(A.l));
#pragma unroll
      for (int r = 0; r < 16; ++r) { park[r * 512] = A.o0[r] * f; park[(16 + r) * 512] = A.o1[r] * f; } }
    if (C.tid == 0) ((LAS float*)(C.lds + ATT_LUT))[513] = NEGF;
    astate_init(A);
    const int tw0 = 4 * qb - 8 < 0 ? 0 : 4 * qb - 8;
    run_tiles<0, 4, true, 0>(C.lds, tw0, 4 * qb + 3, C.proj + (size_t)b * SEQ * PW + C_NKW + g * 64, C.vt + (size_t)((b * NVH + 10 + g) * 64) * SEQ, qr, c31, q0w, 0u, qb, A, C.wave, C.lane, C.r32, C.hi);
    { const float f = g2 * rcpf_(xhalf_sum(A.l));
#pragma unroll
      for (int r = 0; r < 16; ++r) { A.o0[r] = A.o0[r] * f + park[r * 512]; A.o1[r] = A.o1[r] * f + park[(16 + r) * 512]; } }
    const int l2 = lane_opaque(); const int hi2 = l2 >> 5;
    u16* dst = C.obuf + ((size_t)b * SEQ + q0w + (l2 & 31)) * DM + 512 + hq * 64;
#pragma unroll
    for (int gg = 0; gg < 4; ++gg) {
        const u32x2 a = *(const u32x2*)(dst + 8 * gg + 4 * hi2), bq = *(const u32x2*)(dst + 32 + 8 * gg + 4 * hi2);
        A.o0[4 * gg] += bf2f(a.x & 0xffffu); A.o0[4 * gg + 1] += bf2f(a.x >> 16); A.o0[4 * gg + 2] += bf2f(a.y & 0xffffu); A.o0[4 * gg + 3] += bf2f(a.y >> 16);
        A.o1[4 * gg] += bf2f(bq.x & 0xffffu); A.o1[4 * gg + 1] += bf2f(bq.x >> 16); A.o1[4 * gg + 2] += bf2f(bq.y & 0xffffu); A.o1[4 * gg + 3] += bf2f(bq.y >> 16);
    }
    store_o(dst, A.o0, A.o1, hi2);
}

__device__ __forceinline__ void cmp_unit(const Ctx& C0, KParamsPtr P, int b, int g, int qblk) {
    Ctx C = C0; C.lane = lane_opaque(); C.tid = C.wave * 64 + C.lane; C.r32 = C.lane & 31; C.hi = C.lane >> 5;
    LAS unsigned char* lds = C.lds; const int tid = C.tid, r32 = C.r32, hi = C.hi;
    const u16* kc = (const u16*)(P->ws + WS_KCMP) + (size_t)(b * 2 + g) * 128 * 64;
    const u16* vc = (const u16*)(P->ws + WS_VCMPT) + (size_t)(b * 2 + g) * 64 * 128;
#pragma unroll
    for (int i = 0; i < 2; ++i) { const int e = tid + 512 * i;
        { const int row = e >> 3, ch = e & 7; *(LAS u32x4*)(lds + CMP_K + row * 144 + ch * 16) = *(const u32x4*)(kc + row * 64 + ch * 8); }
        { const int row = e >> 4, ch = e & 15; *(LAS u32x4*)(lds + CMP_V + row * 272 + ch * 16) = *(const u32x4*)(vc + row * 128 + ch * 8); } }
    const int q0w = __builtin_amdgcn_readfirstlane(qblk * 256 + C.wave * 32); const int qpos = q0w + r32; const size_t tok = (size_t)b * SEQ + qpos;
    const int nmax = (qpos - 31) >> 4;
    __syncthreads();
    float qa[16], qh[16];
#pragma unroll
    for (int i = 0; i < 16; ++i) { qa[i] = 0.f; qh[i] = 0.f; }
    const LAS unsigned char* kp = lds + CMP_K + r32 * 144 + hi * 16;
    const LAS unsigned char* vp = lds + CMP_V + r32 * 272 + hi * 16;
    for (int rh = 0; rh < 4; ++rh) {
        const int hq = g * 4 + rh;
        bf16x8 qr[4]; load_q(qr, C.proj + tok * PW + C_NQ + hq * 64, hi);
        const float g0 = sigmoid_f(bf2f(C.proj[tok * PW + C_NG + hq * 3]));
        f32x16 s[4];
#pragma unroll
        for (int kb = 0; kb < 4; ++kb) {
#pragma unroll
            for (int r = 0; r < 16; ++r) s[kb][r] = 0.f;
#pragma unroll
            for (int ks = 0; ks < 4; ++ks) { const bf16x8 a = *(const LAS bf16x8*)(kp + kb * 32 * 144 + ks * 32); s[kb] = __builtin_amdgcn_mfma_f32_32x32x16_bf16(a, qr[ks], s[kb], 0, 0, 0); }
        }
        float mx = NEGF;
#pragma unroll
        for (int kb = 0; kb < 4; ++kb)
#pragma unroll
            for (int r = 0; r < 16; ++r) { const int n = 32 * kb + crow(r, hi); const float v = (n <= nmax) ? s[kb][r] : NEGF; s[kb][r] = v; mx = fmaxf(mx, v); }
        mx = xhalf_max(mx);
        float sum = 0.f;
#pragma unroll
        for (int kb = 0; kb < 4; ++kb)
#pragma unroll
            for (int r = 0; r < 16; ++r) { const int n = 32 * kb + crow(r, hi); const float pv = (n <= nmax) ? ex2(s[kb][r] - mx) : 0.f; s[kb][r] = pv; sum += pv; }
        sum = xhalf_sum(sum);
        const float inv = nmax >= 0 ? rcpf_(sum) : 0.f;
        f32x16 o0, o1;
#pragma unroll
        for (int r = 0; r < 16; ++r) { o0[r] = 0.f; o1[r] = 0.f; }
#pragma unroll
        for (int kb = 0; kb < 4; ++kb) {
#pragma unroll
            for (int r = 0; r < 16; ++r) s[kb][r] *= inv;
#pragma unroll
            for (int g4 = 0; g4 < 4; ++g4) { const float h = 0.5f * s[kb][4 * g4 + 3]; qh[kb * 4 + g4] += h; qa[kb * 4 + g4] += (s[kb][4 * g4] + s[kb][4 * g4 + 1]) + (s[kb][4 * g4 + 2] + h); }
#pragma unroll
            for (int c = 0; c < 2; ++c) {
                const u32x4 pk = (u32x4){pkbf(s[kb][8 * c], s[kb][8 * c + 1]), pkbf(s[kb][8 * c + 2], s[kb][8 * c + 3]), pkbf(s[kb][8 * c + 4], s[kb][8 * c + 5]), pkbf(s[kb][8 * c + 6], s[kb][8 * c + 7])};
                const bf16x8 pb = __builtin_bit_cast(bf16x8, pk);
                const bf16x8 v0 = *(const LAS bf16x8*)(vp + (kb * 2 + c) * 32);
                const bf16x8 v1 = *(const LAS bf16x8*)(vp + 32 * 272 + (kb * 2 + c) * 32);
                o0 = __builtin_amdgcn_mfma_f32_32x32x16_bf16(v0, pb, o0, 0, 0, 0);
                o1 = __builtin_amdgcn_mfma_f32_32x32x16_bf16(v1, pb, o1, 0, 0, 0);
            }
            __builtin_amdgcn_sched_barrier(0);
        }
        o0 *= g0; o1 *= g0;
        store_o(C.obuf + tok * DM + 512 + hq * 64, o0, o1, hi);
    }
    LAS float* Aq = (LAS float*)(lds + CMP_A) + (C.wave * 32 + r32) * 33; LAS float* Hq = (LAS float*)(lds + CMP_H) + (C.wave * 32 + r32) * 33;
#pragma unroll
    for (int kb = 0; kb < 4; ++kb)
#pragma unroll
        for (int g4 = 0; g4 < 4; ++g4) { const int j = 8 * kb + 2 * g4 + hi; Aq[j] = qa[kb * 4 + g4]; Hq[j] = qh[kb * 4 + g4]; }
    __syncthreads();
    const int cur = q0w >> 6;
    unsigned bits = 0;
    if (cur < 16) bits = (2u << cur) - 1u;
    else {
        for (int e = 0; e < 16; ++e) { const int j = hi * 16 + e; if (j > 0 && j <= cur - 2) Aq[j] += Hq[j - 1]; }
        asm volatile("s_waitcnt lgkmcnt(0)" ::: "memory");
        for (int e = 0; e < 16; ++e) { const int j = hi * 16 + e;
            if (j <= cur) { const float sj = (j == 0 || j > cur - 2) ? 1e4f : Aq[j]; int rank = 0;
                for (int i = 0; i <= cur; ++i) { const float si = (i == 0 || i > cur - 2) ? 1e4f : Aq[i]; rank += (si > sj || (si == sj && i < j)) ? 1 : 0; }
                if (rank < 16) bits |= 1u << j; } }
        { auto rr = __builtin_amdgcn_permlane32_swap(bits, bits, false, false); bits = rr[0] | rr[1]; }
    }
    if (hi == 0) ((unsigned*)(P->ws + WS_SEL))[(size_t)(b * 2 + g) * SEQ + qpos] = bits;
    __syncthreads();
}

__device__ __forceinline__ void prep_vk(const Ctx& C, KParamsPtr P, int b0) {
    const int G = C.G - b0, bxr = C.bx - b0, tid = C.tid, lane = C.lane;
    if (bxr < 0) return;
    for (int it = bxr; it < NB * NVH * 32; it += G) {
        const int tb = it & 31, hv = (it >> 5) % NVH, b = it / (32 * NVH);
        const int vcol = hv < 4 ? C_MV + hv * 64 : hv < 8 ? C_DV + (hv - 4) * 64 : hv < 10 ? C_NVS + (hv - 8) * 64 : C_NVW + (hv - 10) * 64;
        { const int row = tid >> 3, ch = tid & 7; *(LAS u32x4*)(C.lds + row * 144 + ch * 16) = *(const u32x4*)(C.proj + ((size_t)b * SEQ + tb * 64 + row) * PW + vcol + ch * 8); }
        __syncthreads();
        { const int d = tid >> 3, pc = tid & 7; unsigned w[4];
#pragma unroll
            for (int e = 0; e < 4; ++e) { const int p0 = pc * 8 + 2 * e, p1 = p0 + 1; const int k0 = (p0 & ~15) + kperm(p0 & 15), k1 = (p1 & ~15) + kperm(p1 & 15);
                const unsigned a = *(const LAS u16*)(C.lds + k0 * 144 + d * 2), bb = *(const LAS u16*)(C.lds + k1 * 144 + d * 2); w[e] = a | (bb << 16); }
            *(u32x4*)(C.vt + ((size_t)(b * NVH + hv) * 64 + d) * SEQ + tb * 64 + pc * 8) = (u32x4){w[0], w[1], w[2], w[3]}; }
        __syncthreads();
    }
    const int gw = bxr * 8 + C.wave, NGW = G * 8;
    for (int it = gw; it < NB * 4 * 8; it += NGW) {
        const int blk = it & 7, h = (it >> 3) & 3, b = it >> 5;
        const u16* kp = C.proj + ((size_t)b * SEQ + blk * 256) * PW + C_MK + h * 64 + lane; float s = 0.f;
        for (int k = 0; k < 256; k += 8) { float t[8];
#pragma unroll
            for (int e = 0; e < 8; ++e) t[e] = bf2f(kp[(size_t)(k + e) * PW]);
            s += ((t[0] + t[1]) + (t[2] + t[3])) + ((t[4] + t[5]) + (t[6] + t[7])); }
        ((float*)(P->ws + WS_KMEAN))[(size_t)it * 64 + lane] = s * (1.0f / 256.0f);
    }
}
__device__ __forceinline__ void prep_a(const Ctx& C, KParamsPtr P, int layer) {
    const int G = C.G, lane = C.lane;
    const int gw = C.bx * 8 + C.wave, NGW = G * 8;
    u16* acmp = (u16*)(P->ws + WS_XN);
    for (int it = gw; it < 2 * 4096; it += NGW) {
        const int i = it >> 12, row = it & 4095, n = row & 127, bg = row >> 7, b = bg >> 1, g = bg & 1;
        u16* dst = acmp + (size_t)it * 2048; const float* pe = P->cmp_pe + (size_t)(layer * 2 + i) * 2048;
        const int col = (i == 0 ? C_NKC : C_NVC) + g * 64;
#pragma unroll
        for (int pass = 0; pass < 4; ++pass) { const int l = pass * 8 + (lane >> 3), d0 = (lane & 7) * 8;
            unsigned z0 = 0u; asm volatile("" : "+v"(z0)); u32x4 o = (u32x4){z0, z0, z0, z0};
            if (n < 127) { const u32x4 v = *(const u32x4*)(C.proj + ((size_t)b * SEQ + 16 * n + l) * PW + col + d0); const f32x4 e0 = *(const f32x4*)(pe + l * 64 + d0), e1 = *(const f32x4*)(pe + l * 64 + d0 + 4);
                o.x = pkbf(bf2f(v.x & 0xffffu) + e0.x, bf2f(v.x >> 16) + e0.y); o.y = pkbf(bf2f(v.y & 0xffffu) + e0.z, bf2f(v.y >> 16) + e0.w);
                o.z = pkbf(bf2f(v.z & 0xffffu) + e1.x, bf2f(v.z >> 16) + e1.y); o.w = pkbf(bf2f(v.w & 0xffffu) + e1.z, bf2f(v.w >> 16) + e1.w); }
            *(u32x4*)(dst + l * 64 + d0) = o; }
    }
}
__device__ __forceinline__ void prep_c(const Ctx& C, KParamsPtr P, int layer) {
    const int gw = C.bx * 8 + C.wave, NGW = C.G * 8, lane = C.lane;
    for (int it = gw; it < 2 * 4096; it += NGW) {
        const int i = it >> 12, row = it & 4095;
        const u16* hrow = (const u16*)(P->ws + WS_HID) + (size_t)it * 256; const float* w2 = P->cmp_w2 + (size_t)(layer * 2 + i) * 256 * 64 + lane;
        float acc = 0.f;
        for (int j = 0; j < 256; j += 8) { const u32x4 hv = *(const u32x4*)(hrow + j);
            acc = fmaf(bf2f(hv.x & 0xffffu), w2[(j + 0) * 64], acc); acc = fmaf(bf2f(hv.x >> 16), w2[(j + 1) * 64], acc);
            acc = fmaf(bf2f(hv.y & 0xffffu), w2[(j + 2) * 64], acc); acc = fmaf(bf2f(hv.y >> 16), w2[(j + 3) * 64], acc);
            acc = fmaf(bf2f(hv.z & 0xffffu), w2[(j + 4) * 64], acc); acc = fmaf(bf2f(hv.z >> 16), w2[(j + 5) * 64], acc);
            acc = fmaf(bf2f(hv.w & 0xffffu), w2[(j + 6) * 64], acc); acc = fmaf(bf2f(hv.w >> 16), w2[(j + 7) * 64], acc); }
        const unsigned bits = pkbf(acc, 0.f) & 0xffffu;
        if (i == 0) ((u16*)(P->ws + WS_KCMP))[(size_t)row * 64 + lane] = (u16)bits;
        else { const int bg = row >> 7, n = row & 127; ((u16*)(P->ws + WS_VCMPT))[((size_t)bg * 64 + lane) * 128 + (n & ~15) + pperm(n & 15)] = (u16)bits; }
    }
}

__device__ __forceinline__ void convert_weights(const Ctx& C, KParamsPtr P, int layer) {
    LAS float* scr = (LAS float*)(C.lds + C.wave * 16384);
    const int gw = C.bx * 8 + C.wave, NGW = C.G * 8, lane = C.lane;
    constexpr int I_G = 16 * 88, I_D = 44 * 32, I_IN = 16 * 96, I_O = 16 * 32, I_W1 = 32 * 8;
    constexpr int NIT = 4 * I_G + 2 * I_D + I_IN + I_O + 2 * I_W1;
    unsigned char* ws = P->ws;
    for (int it = gw; it < NIT; it += NGW) {
        int r = it;
        if (r < 4 * I_G) { const int which = r / I_G; r -= which * I_G; const int kb = r / 88, nb = r % 88, n0 = nb * 32;
            const float* W = (which == 0 ? P->ffn1_gate : which == 1 ? P->ffn1_up : which == 2 ? P->ffn2_gate : P->ffn2_up) + (size_t)layer * DM * DFF;
            u16* WT = (u16*)(ws + (which < 2 ? WS_GU1 : WS_GU2));
            tr_item(W, DM, DFF, WT, kb, n0, (n0 >> 7) * 256 + (which & 1) * 128 + (n0 & 127), scr, lane); continue; }
        r -= 4 * I_G;
        if (r < 2 * I_D) { const int which = r / I_D; r -= which * I_D; const int kb = r / 32, nb = r % 32;
            const float* W = (which == 0 ? P->ffn1_down : P->ffn2_down) + (size_t)layer * DFF * DM;
            tr_item(W, DFF, DM, (u16*)(ws + (which == 0 ? WS_DN1 : WS_DN2)), kb, nb * 32, nb * 32, scr, lane); continue; }
        r -= 2 * I_D;
        if (r < I_IN) { const int kb = r / 96, nb = r % 96, n0 = nb * 32;
            const float cs = (n0 < C_MK || (n0 >= C_NQ && n0 < C_NKC)) ? 0.125f * LOG2E : (n0 >= C_DQ && n0 < C_DK) ? 0.17677669529663687f * LOG2E : 1.0f;
            tr_item(P->w_in + (size_t)layer * DM * INW, DM, INW, (u16*)(ws + WS_WIN), kb, n0, n0, scr, lane, cs); continue; }
        r -= I_IN;
        if (r < I_O) { const int kb = r / 32, nb = r % 32; tr_item(P->w_out + (size_t)layer * DM * DM, DM, DM, (u16*)(ws + WS_WOUT), kb, nb * 32, nb * 32, scr, lane); continue; }
        r -= I_O;
        { const int i = r / I_W1; r -= i * I_W1; const int kb = r / 8, nb = r % 8;
            tr_item(P->cmp_w1 + (size_t)(layer * 2 + i) * 2048 * 256, 2048, 256, (u16*)(ws + WS_W1) + (size_t)i * 256 * 2048, kb, nb * 32, nb * 32, scr, lane); }
    }
}
__device__ __forceinline__ void norm_phase(const Ctx& C, const float* src, const float* g, u16* dst16, float* dst32) {
    const int gw = C.bx * 8 + C.wave, NGW = C.G * 8;
    for (int m = gw; m < MTOK; m += NGW) norm_row(src + (size_t)m * DM, g, dst16 ? dst16 + (size_t)m * DM : nullptr, dst32 ? dst32 + (size_t)m * DM : nullptr, C.lane);
}

#define XB_TMO      128
#define XB_XCNT(j)  (256  + 64 * (j))
#define XB_XSUB(j)  (1280 + 64 * (j))
#define XB_XGEN(j)  (2304 + 64 * (j))
#define XB_TOP      3328
#define XB_TOPGEN   3392
#define XCD_BAR_WORDS 3456
#define XB_SPIN_CAP (1u << 18)

__device__ __forceinline__ unsigned xb_ld(unsigned* p)              { return __hip_atomic_load(p, __ATOMIC_RELAXED, __HIP_MEMORY_SCOPE_AGENT); }
__device__ __forceinline__ unsigned xb_add(unsigned* p, unsigned v) { return __hip_atomic_fetch_add(p, v, __ATOMIC_RELAXED, __HIP_MEMORY_SCOPE_AGENT); }
__device__ __forceinline__ unsigned xb_xcc_id() { return (unsigned)__builtin_amdgcn_s_getreg((3 << 11) | 20) & 0xFu; }
#define XB_SPIN(cond, bar) do { unsigned _sp = 0; while (cond) { __builtin_amdgcn_s_sleep(1); \
    if ((++_sp & 255u) == 0u) { if (xb_ld(&(bar)[XB_TMO])) break; if (_sp > XB_SPIN_CAP) { atomicAdd(&(bar)[XB_TMO], 1u); break; } } } } while (0)

struct XcdBarrier {
    unsigned* bar; unsigned x;
    volatile LAS unsigned* st;
};

__device__ __forceinline__ XcdBarrier xcd_barrier_post(unsigned* bar, volatile LAS unsigned* st) {
    XcdBarrier b; b.bar = bar; b.x = xb_xcc_id(); b.st = st;
    if (threadIdx.x == 0) (void)xb_add(&bar[XB_XCNT(b.x)], 1u);
    return b;
}
__device__ __forceinline__ void xcd_barrier_complete(unsigned* bar, unsigned x, unsigned& nloc, unsigned& nx) {
    const unsigned G = gridDim.x * gridDim.y * gridDim.z;
    unsigned sum, cnt, mine, sp = 0u;
    for (;;) {
        sum = 0u; cnt = 0u; mine = 0u;
#pragma unroll
        for (unsigned j = 0; j < 16; ++j) { const unsigned c = xb_ld(&bar[XB_XCNT(j)]); sum += c; cnt += (c > 0u) ? 1u : 0u; mine = (j == x) ? c : mine; }
        if (sum == G) break;
        __builtin_amdgcn_s_sleep(1);
        if ((++sp & 255u) == 0u) { if (xb_ld(&bar[XB_TMO])) break; if (sp > XB_SPIN_CAP) { atomicAdd(&bar[XB_TMO], 1u); break; } }
    }
    nloc = mine > 0u ? mine : 1u; nx = cnt > 0u ? cnt : 1u;
}

__device__ __forceinline__ void xcd_barrier(const XcdBarrier& b) {
    asm volatile("s_waitcnt vmcnt(0)" ::: "memory");
    __syncthreads();
    if (threadIdx.x == 0) {
        unsigned* bar = b.bar;
        __builtin_amdgcn_s_waitcnt(0);
        unsigned nloc = b.st[0], nx = b.st[1];
        if (nloc == 0u) { xcd_barrier_complete(bar, b.x, nloc, nx); b.st[0] = nloc; b.st[1] = nx; }
        const unsigned old = xb_add(&bar[XB_XSUB(b.x)], 1u);
        const unsigned gen = old / nloc;
        if (old + 1u == (gen + 1u) * nloc) {
            __builtin_amdgcn_fence(__ATOMIC_RELEASE, "agent");
            asm volatile("s_waitcnt vmcnt(0)" ::: "memory");
            const unsigned og = xb_add(&bar[XB_TOP], 1u);
            const unsigned tg = og / nx;
            if (og + 1u == (tg + 1u) * nx) xb_add(&bar[XB_TOPGEN], 1u);
            else XB_SPIN(xb_ld(&bar[XB_TOPGEN]) == tg, bar);
            __builtin_amdgcn_fence(__ATOMIC_ACQUIRE, "agent");
            xb_add(&bar[XB_XGEN(b.x)], 1u);
            asm volatile("s_waitcnt vmcnt(0)" ::: "memory");
        } else {
            XB_SPIN(xb_ld(&bar[XB_XGEN(b.x)]) == gen, bar);
            __builtin_amdgcn_fence(__ATOMIC_ACQUIRE, "agent");
            asm volatile("s_waitcnt vmcnt(0)" ::: "memory");
        }
    }
    __syncthreads();
}


__global__ void __launch_bounds__(512, 2) hybrid_fwd(Params P0) {
    extern __shared__ __attribute__((aligned(16))) unsigned char lds_raw[];
    const KParamsPtr kp0 = (KParamsPtr)__builtin_amdgcn_kernarg_segment_ptr();
    cg::grid_group grid = cg::this_grid();
    { volatile LAS unsigned* misc = (volatile LAS unsigned*)((LAS unsigned char*)lds_raw + MISC_OFF); if (threadIdx.x < 2) misc[threadIdx.x] = 0u; }
    __syncthreads();
    XcdBarrier bar = xcd_barrier_post((unsigned*)(P0.ws + WS_CTL) + 1024, (volatile LAS unsigned*)((LAS unsigned char*)lds_raw + MISC_OFF));
    const int ph_lo = P0.ph_lo, ph_hi = P0.ph_hi; const int wave_s = __builtin_amdgcn_readfirstlane(threadIdx.x >> 6);
    bool redone = false; (void)redone;
    for (int ph = ph_lo; ph < ph_hi; ++ph) {
        KParamsPtr kpl = kp0; asm volatile("" : "+s"(kpl));
        const KParamsPtr P = kpl; unsigned char* ws = P->ws;
        u16* XN = (u16*)(ws + WS_XN); u16* HB = (u16*)(ws + WS_PROJ);
        int G = gridDim.x, bx = blockIdx.x; asm volatile("" : "+s"(G), "+s"(bx));
        Ctx C; C.G = G; C.bx = bx; C.lds = (LAS unsigned char*)lds_raw; C.wave = wave_s; C.lane = lane_opaque(); C.tid = wave_s * 64 + C.lane; C.r32 = C.lane & 31; C.hi = C.lane >> 5;
        C.proj = (u16*)(ws + WS_PROJ); C.obuf = (u16*)(ws + WS_XN); C.vt = (u16*)(ws + WS_VT);
        const int layer = ph / NPH_L, s = ph % NPH_L;
        if (ph == NPH - 1) { norm_phase(C, P->out, P->final_norm, nullptr, P->out); }
        else switch (s) {
        case 0: { convert_weights(C, P, layer); __syncthreads(); norm_phase(C, layer == 0 ? P->x : P->out, P->norm_ffn1 + (size_t)layer * DM, XN, nullptr); } break;
        case 3: { norm_phase(C, P->out, P->norm_mix + (size_t)layer * DM, XN, nullptr); } break;
        case 11: { norm_phase(C, P->out, P->norm_ffn2 + (size_t)layer * DM, XN, nullptr); } break;
#ifndef NO_GEMM
#ifndef NO_G1
        case 1: case 12: {
            pg8::Gemm g{XN, (const u16*)(ws + (s == 1 ? WS_GU1 : WS_GU2)), MTOK, 2 * DFF, DM}; pg8::StaticOrder S; S.init(MTOK, 2 * DFF, G, bx);
            pg8::EpiSwiGLU E{HB, DFF};
            pg8::gemm_phase<pg8::EpiSwiGLU, pg8::StaticOrder, true, true>(C.lds, g, S, E, C.wave); } break;
#endif
#ifndef NO_G2
        case 2: case 13: case 10: {
            const u16* A = (s == 10) ? (const u16*)XN : (const u16*)HB; const u16* Bt = (const u16*)(ws + (s == 2 ? WS_DN1 : s == 13 ? WS_DN2 : WS_WOUT));
            pg8::Gemm g{A, Bt, MTOK, DM, s == 10 ? DM : DFF}; pg8::StaticOrder S; S.init(MTOK, DM, G, bx);
            pg8::EpiResid E{(layer == 0 && s == 2) ? P->x : (const float*)P->out, P->out, DM, s == 10 ? 1.0f : 0.5f};
            pg8::gemm_phase<pg8::EpiResid, pg8::StaticOrder, true, true>(C.lds, g, S, E, C.wave); } break;
#endif
#ifndef NO_G4
        case 4: {
            pg8::Gemm g{XN, (const u16*)(ws + WS_WIN), MTOK, PW, DM}; pg8::StaticOrder S; S.init(MTOK, PW, G, bx);
            pg8::EpiBf16<0> E{C.proj, PW};
            pg8::gemm_phase<pg8::EpiBf16<0>, pg8::StaticOrder, true, true>(C.lds, g, S, E, C.wave); } break;
#endif
#endif
#ifndef NO_PREP
        case 5: prep_a(C, P, layer); break;
#endif
#if !defined(NO_GEMM) && !defined(NO_G6)
        case 6: {
            prep_vk(C, P, G > 64 ? 32 : 0); __syncthreads();
            for (int i = 0; i < 2; ++i) {
                pg8::Gemm g{(const u16*)XN + (size_t)i * 4096 * 2048, (const u16*)(ws + WS_W1) + (size_t)i * 256 * 2048, 4096, 256, 2048}; pg8::StaticOrder S; S.init(4096, 256, G, (bx + G - 16 * i) % G);
                pg8::EpiBf16<1> E{(u16*)(ws + WS_HID) + (size_t)i * 4096 * 256, 256};
                pg8::gemm_phase<pg8::EpiBf16<1>, pg8::StaticOrder, true, true>(C.lds, g, S, E, C.wave); } } break;
#endif
#ifndef NO_PREP
        case 7: prep_c(C, P, layer); break;
#endif
#ifndef NO_ATT1
        case 8: {
            for (int u0 = bx; u0 < 1024 + 256; u0 += G) {
                if (u0 < 1024) { const int rnd = u0 >> 8, pos = ((u0 & 255) + 64 * rnd) & 255, grp = pos >> 6, bh = pos & 63, b = bh >> 2, h = bh & 3;
                    const int qb = ((grp & 2) ? 6 : 7) - 2 * rnd;
                    if (grp & 1) {
#ifndef NO_MOBA
                        moba_unit(C, P, b, h, qb);
#endif
                    } else {
#ifndef NO_DIFF
                        diff_unit(C, P, layer, b, h, qb);
#endif
                    } }
                else { const int c = u0 - 1024;
#ifndef NO_CMP
                    cmp_unit(C, P, c >> 4, (c >> 3) & 1, c & 7);
#endif
                }
            } } break;
#endif
#ifndef NO_ATT2
        case 9: {
            for (int u0 = bx, rnd = 0; u0 < 1024; u0 += G, ++rnd) {
                const int base = u0 - bx; int pos = bx; if ((rnd & 1) && base + G <= 1024) pos = G - 1 - bx; const int u = base + pos;
                nsa_unit(C, P, (u & 127) >> 3, u & 7, 7 - (u >> 7)); }
            } break;
#endif
        default: break;
        }
        if (ph + 1 < ph_hi) { if (ph == ph_lo) grid.sync(); else xcd_barrier(bar); }
#ifdef PROBE_LO
        if (ph != NPH - 1 && s == PROBE_HI) { if (!redone) { ph -= (PROBE_HI - PROBE_LO + 1); redone = true; } else redone = false; }
#endif
#ifdef PROBE_SYNC
        if (ph + 1 < ph_hi) xcd_barrier(bar);
#endif
    }
}

#ifndef COOP
#define COOP 1
#endif
extern "C" void kernel_launch(void* const* d_in, const int* in_sizes, int n_in, void* d_out, int out_size, void* d_ws, size_t ws_size, hipStream_t stream) {
    static int grid = 0;
    if (grid == 0) {
        if (n_in != 19 || out_size != MTOK * DM || ws_size < WS_END) { fprintf(stderr, "kernel_launch: unexpected shapes (n_in %d out %d ws %zu)\n", n_in, out_size, ws_size); grid = -1; return; }
        int dev = 0, cus = 0, per_cu = 0;
        (void)hipGetDevice(&dev); (void)hipDeviceGetAttribute(&cus, hipDeviceAttributeMultiprocessorCount, dev);
        if (hipFuncSetAttribute((const void*)hybrid_fwd, hipFuncAttributeMaxDynamicSharedMemorySize, LDS_BYTES) != hipSuccess) { fprintf(stderr, "kernel_launch: hipFuncSetAttribute failed\n"); grid = -1; return; }
        if (hipOccupancyMaxActiveBlocksPerMultiprocessor(&per_cu, (const void*)hybrid_fwd, 512, LDS_BYTES) != hipSuccess || per_cu < 1) { fprintf(stderr, "kernel_launch: occupancy query says %d\n", per_cu); per_cu = 1; }
        (void)hipGetLastError();
        grid = cus * per_cu;
    }
    if (grid < 0) return;
    Params p{};
    p.x = (const float*)d_in[0]; p.rel_bias = (const float*)d_in[1]; p.norm_ffn1 = (const float*)d_in[2]; p.ffn1_gate = (const float*)d_in[3]; p.ffn1_up = (const float*)d_in[4]; p.ffn1_down = (const float*)d_in[5];
    p.norm_mix = (const float*)d_in[6]; p.w_in = (const float*)d_in[7]; p.diff_lambda = (const float*)d_in[8]; p.diff_subln = (const float*)d_in[9]; p.cmp_pe = (const float*)d_in[10]; p.cmp_w1 = (const float*)d_in[11];
    p.cmp_w2 = (const float*)d_in[12]; p.w_out = (const float*)d_in[13]; p.norm_ffn2 = (const float*)d_in[14]; p.ffn2_gate = (const float*)d_in[15]; p.ffn2_up = (const float*)d_in[16]; p.ffn2_down = (const float*)d_in[17];
    p.final_norm = (const float*)d_in[18]; p.out = (float*)d_out; p.ws = (unsigned char*)d_ws;
    for (int l = 0; l < 4; ++l) p.lam_init[l] = (float)(0.8 - 0.6 * exp(-0.3 * (double)l));
#if COOP
    if (hipMemsetAsync((char*)d_ws + WS_CTL, 0, CTL_ZERO_BYTES, stream) != hipSuccess) { fprintf(stderr, "kernel_launch: memset of barrier words failed\n"); return; }
    p.ph_lo = 0; p.ph_hi = NPH;
    void* args[] = {&p};
    hipError_t e = hipLaunchCooperativeKernel((const void*)hybrid_fwd, dim3(grid), dim3(512), args, LDS_BYTES, stream);
    if (e != hipSuccess) fprintf(stderr, "cooperative launch failed: %s (grid %d)\n", hipGetErrorString(e), grid);
#else
    for (int ph = 0; ph < NPH; ++ph) { p.ph_lo = ph; p.ph_hi = ph + 1; hipLaunchKernelGGL(hybrid_fwd, dim3(grid), dim3(512), LDS_BYTES, stream, p); }
#endif
}
```

```cpp
#include <hip/hip_runtime.h>
#include <hip/hip_cooperative_groups.h>
#include <cstdio>
#include <cstdint>
#include <cmath>
namespace cg = cooperative_groups;
#define COOP 1
namespace pg8 {
#define PG8_LAS __attribute__((address_space(3)))
typedef unsigned short bf16_t;
typedef short bf16x8 __attribute__((ext_vector_type(8)));
typedef float f32x4 __attribute__((ext_vector_type(4)));
typedef unsigned u32x4 __attribute__((ext_vector_type(4)));
constexpr int BM = 256, BK = 64, HALF = 128, HTB = HALF * BK * 2  , STAGE_BYTES = 8 * HTB, NXCD = 8, WGM = 8;

__host__ __device__ __forceinline__ int lds_byte(int r, int c) { const int st = (r >> 4) * 2 + (c >> 5), rr = r & 15, cc = c & 31, ob = rr * 64 + cc * 2; return st * 1024 + (ob ^ (((ob >> 9) & 1) << 5)); }
__host__ __device__ __forceinline__ void stage_rc(int b, int& R, int& C) { const int st = b / 1024, sb = b % 1024, swz = sb ^ (((sb >> 9) & 1) << 5); R = (st >> 1) * 16 + swz / 64; C = (st & 1) * 32 + (swz % 64) / 2; }
__host__ __device__ __forceinline__ int perm32(int rho) { const int n = rho >> 4, i = rho & 15; return 8 * (i >> 2) + 4 * n + (i & 3); }

struct Unit { int pm, pn; };
struct Gemm { const bf16_t* A; const bf16_t* Bt; int M, N, K; };

struct StaticOrder {
    int nM, nN, nwg, G, c;
    __host__ __device__ void init(int M, int N, int G_, int c_) { nM = M / BM; nN = N / BM; nwg = nM * nN; G = G_; c = c_; }
    __host__ __device__ bool next(int i, Unit& u) const {
        const long L = (long)i * G + c; if (L >= nwg) return false;
        int wgid = (int)L; { const int q = nwg / NXCD, r = nwg % NXCD, xcd = wgid % NXCD, off = wgid / NXCD; wgid = (xcd < r ? xcd * (q + 1) : r * (q + 1) + (xcd - r) * q) + off; }
        const int nig = WGM * nN, gid = wgid / nig, fm = gid * WGM, gsz = (nM - fm) < WGM ? (nM - fm) : WGM;
        u.pm = fm + ((wgid % nig) % gsz); u.pn = (wgid % nig) / gsz; return true;
    }
    __device__ __forceinline__ void a_ready(const Unit&) const {}
    __device__ __forceinline__ void done(const Unit&) const {}
};

__device__ __forceinline__ unsigned cvt_pk_bf16(float lo, float hi) { unsigned r; asm volatile("v_cvt_pk_bf16_f32 %0, %1, %2" : "=v"(r) : "v"(lo), "v"(hi)); return r; }

__device__ __forceinline__ float ex2(float x) { return __builtin_amdgcn_exp2f(x); }
__device__ __forceinline__ float rcpf_(float x) { return __builtin_amdgcn_rcpf(x); }
__device__ __forceinline__ float silu_f(float x) { return x * rcpf_(1.0f + ex2(-1.4426950408889634f * x)); }
__device__ __forceinline__ float gelu_tanh_f(float x) { const float y2 = 2.0f * 0.7978845608028654f * (x + 0.044715f * x * x * x); return x * (1.0f - rcpf_(1.0f + ex2(1.4426950408889634f * y2))); }

struct EpiSwiGLU {
    static constexpr bool PERM = true, AFTER_DRAIN = false;
    bf16_t* O; int ldc;
    __device__ __forceinline__ void operator()(const f32x4 (&acc)[2][2][4][2], const Unit& u, int wr, int wc, int fr, int fq) const {
        const int row0 = u.pm * BM + wr * 64 + fr; const int col0 = u.pn * HALF + wc * 32 + 8 * fq;
#pragma unroll
        for (int ai = 0; ai < 2; ++ai)
#pragma unroll
            for (int m = 0; m < 4; ++m) { bf16_t* rowp = O + (size_t)(row0 + ai * HALF + m * 16) * ldc + col0;
                const f32x4 g0 = acc[ai][0][m][0], g1 = acc[ai][0][m][1], u0 = acc[ai][1][m][0], u1 = acc[ai][1][m][1];
                u32x4 w; w.x = cvt_pk_bf16(silu_f(g0[0]) * u0[0], silu_f(g0[1]) * u0[1]); w.y = cvt_pk_bf16(silu_f(g0[2]) * u0[2], silu_f(g0[3]) * u0[3]);
                w.z = cvt_pk_bf16(silu_f(g1[0]) * u1[0], silu_f(g1[1]) * u1[1]); w.w = cvt_pk_bf16(silu_f(g1[2]) * u1[2], silu_f(g1[3]) * u1[3]);
                *(u32x4*)rowp = w; asm volatile("" ::: "memory"); }
    }
};
template <int ACT> struct EpiBf16 {
    static constexpr bool PERM = true, AFTER_DRAIN = false;
    bf16_t* O; int ldc;
    __device__ __forceinline__ void operator()(const f32x4 (&acc)[2][2][4][2], const Unit& u, int wr, int wc, int fr, int fq) const {
        const int row0 = u.pm * BM + wr * 64 + fr; const int col0 = u.pn * BM + wc * 32 + 8 * fq;
#pragma unroll
        for (int ai = 0; ai < 2; ++ai)
#pragma unroll
            for (int m = 0; m < 4; ++m) { bf16_t* rowp = O + (size_t)(row0 + ai * HALF + m * 16) * ldc + col0;
#pragma unroll
                for (int bj = 0; bj < 2; ++bj) { f32x4 v0 = acc[ai][bj][m][0], v1 = acc[ai][bj][m][1];
                    if (ACT == 1) { v0 = (f32x4){gelu_tanh_f(v0[0]), gelu_tanh_f(v0[1]), gelu_tanh_f(v0[2]), gelu_tanh_f(v0[3])}; v1 = (f32x4){gelu_tanh_f(v1[0]), gelu_tanh_f(v1[1]), gelu_tanh_f(v1[2]), gelu_tanh_f(v1[3])}; }
                    u32x4 w; w.x = cvt_pk_bf16(v0[0], v0[1]); w.y = cvt_pk_bf16(v0[2], v0[3]); w.z = cvt_pk_bf16(v1[0], v1[1]); w.w = cvt_pk_bf16(v1[2], v1[3]);
                    *(u32x4*)(rowp + bj * HALF) = w; } asm volatile("" ::: "memory"); }
    }
};
struct EpiResid {
    static constexpr bool PERM = true, AFTER_DRAIN = false;
    const float* base; float* out; int ldc; float alpha;
    __device__ __forceinline__ void operator()(const f32x4 (&acc)[2][2][4][2], const Unit& u, int wr, int wc, int fr, int fq) const {
        const int row0 = u.pm * BM + wr * 64 + fr; const int col0 = u.pn * BM + wc * 32 + 8 * fq;
#pragma unroll
        for (int ai = 0; ai < 2; ++ai) {
            f32x4 pre[4][2][2];
#pragma unroll
            for (int m = 0; m < 4; ++m)
#pragma unroll
                for (int bj = 0; bj < 2; ++bj)
#pragma unroll
                    for (int n = 0; n < 2; ++n) pre[m][bj][n] = *(const f32x4*)(base + (size_t)(row0 + ai * HALF + m * 16) * ldc + col0 + bj * HALF + n * 4);
#pragma unroll
            for (int m = 0; m < 4; ++m) { const size_t off = (size_t)(row0 + ai * HALF + m * 16) * ldc + col0;
#pragma unroll
                for (int bj = 0; bj < 2; ++bj) { *(f32x4*)(out + off + bj * HALF) = pre[m][bj][0] + acc[ai][bj][m][0] * alpha; *(f32x4*)(out + off + bj * HALF + 4) = pre[m][bj][1] + acc[ai][bj][m][1] * alpha; } }
            asm volatile("" ::: "memory");
        }
    }
};
template <class Epi, class Sched, bool ALIGN_EPI = false, bool SP2 = false>
__device__ __forceinline__ void gemm_phase(PG8_LAS unsigned char* lds, const Gemm g, const Sched& S, const Epi& E, const int wave_in) {
    int tid_l; asm volatile("v_mbcnt_lo_u32_b32 %0, -1, 0\n\tv_mbcnt_hi_u32_b32 %0, -1, %0" : "=v"(tid_l)); tid_l += wave_in * 64;
    const int tid = tid_l, wid = __builtin_amdgcn_readfirstlane(tid >> 6), lane = tid & 63, wr = wid >> 2, wc = wid & 3, fr = lane & 15, fq = lane >> 4;
    const int K = g.K, nt = K / BK;
    unsigned voffA[2], voffB[2];
#pragma unroll
    for (int i = 0; i < 2; ++i) { int R, C; stage_rc(tid * 16 + i * 8192, R, C); const int Rb = Epi::PERM ? ((R & ~31) + perm32(R & 31)) : R;
        voffA[i] = (unsigned)(R * K + C) * 2u; voffB[i] = (unsigned)(Rb * K + C) * 2u; }
    const size_t kstep = (size_t)(BK * 2);
    const size_t hstep = (size_t)HALF * K * 2;
    const size_t tstep = 2 * hstep;
    const unsigned ldsw = (unsigned)wid * 1024u;
    const int aoff = lds_byte(wr * 64 + fr, fq * 8), boff = lds_byte(wc * 32 + fr, fq * 8);
#define PG8_SA(b, h) (((b) * 2 + (h)) * HTB)
#define PG8_SB(b, h) ((4 + (b) * 2 + (h)) * HTB)
#define PG8_STAGE(bufoff, gbase, voff) do { _Pragma("unroll") for (int _i = 0; _i < 2; ++_i) \
        __builtin_amdgcn_global_load_lds((const unsigned*)((const char*)(gbase) + (voff)[_i]), (PG8_LAS unsigned*)(lds + (bufoff) + ldsw + _i * 8192), 16, 0, 0); } while (0)
#define PG8_LDA(dst, b, h) do { _Pragma("unroll") for (int m = 0; m < 4; ++m) _Pragma("unroll") for (int k = 0; k < 2; ++k) dst[m][k] = *(const PG8_LAS bf16x8*)(lds + PG8_SA(b, h) + aoff + m * 2048 + k * 1024); } while (0)
#define PG8_LDB(dst, b, h) do { _Pragma("unroll") for (int n = 0; n < 2; ++n) _Pragma("unroll") for (int k = 0; k < 2; ++k) dst[n][k] = *(const PG8_LAS bf16x8*)(lds + PG8_SB(b, h) + boff + n * 2048 + k * 1024); } while (0)
#define PG8_MMA(ai, bj, At, Bt) do { __builtin_amdgcn_s_setprio(1); _Pragma("unroll") for (int m = 0; m < 4; ++m) _Pragma("unroll") for (int n = 0; n < 2; ++n) _Pragma("unroll") for (int k = 0; k < 2; ++k) \
        acc[ai][bj][m][n] = __builtin_amdgcn_mfma_f32_16x16x32_bf16(Bt[n][k], At[m][k], acc[ai][bj][m][n], 0, 0, 0); __builtin_amdgcn_s_setprio(0); } while (0)
#define PG8_WAIT_V(n) asm volatile("s_waitcnt vmcnt(" #n ")" ::: "memory")
#define PG8_WAIT_L(n) asm volatile("s_waitcnt lgkmcnt(" #n ")" ::: "memory")
#define PG8_BAR __builtin_amdgcn_s_barrier()
#define PG8_SCHED __builtin_amdgcn_sched_barrier(0)
    Unit cur, nxt; int ui = 0;
    if (!S.next(0, cur)) return;
    f32x4 acc[2][2][4][2];
#pragma unroll
    for (int a = 0; a < 2; ++a)
#pragma unroll
        for (int b = 0; b < 2; ++b)
#pragma unroll
            for (int m = 0; m < 4; ++m)
#pragma unroll
                for (int n = 0; n < 2; ++n) acc[a][b][m][n] = (f32x4){0.f, 0.f, 0.f, 0.f};
    bf16x8 At[4][2], B0[2][2], B1[2][2];
    const char* cA = (const char*)g.A + (size_t)cur.pm * tstep; const char* cB = (const char*)g.Bt + (size_t)cur.pn * tstep;
    S.a_ready(cur);
    if constexpr (SP2) {
        PG8_STAGE(PG8_SB(0, 0), cB, voffB); PG8_STAGE(PG8_SB(0, 1), cB + hstep, voffB); PG8_STAGE(PG8_SA(0, 0), cA, voffA); PG8_STAGE(PG8_SA(0, 1), cA + hstep, voffA);
        if (wr == 1) PG8_BAR;
        PG8_WAIT_V(2); PG8_BAR;
        PG8_STAGE(PG8_SB(1, 0), cB + kstep, voffB); PG8_STAGE(PG8_SA(1, 0), cA + kstep, voffA); PG8_STAGE(PG8_SB(1, 1), cB + hstep + kstep, voffB);
        PG8_WAIT_V(6); PG8_BAR;
    } else {
        PG8_STAGE(PG8_SB(0, 0), cB, voffB); PG8_STAGE(PG8_SA(0, 0), cA, voffA); PG8_STAGE(PG8_SB(0, 1), cB + hstep, voffB); PG8_STAGE(PG8_SA(0, 1), cA + hstep, voffA);
        if (wr == 1) PG8_BAR;
        PG8_WAIT_V(4); PG8_BAR;
        PG8_STAGE(PG8_SB(1, 0), cB + kstep, voffB); PG8_STAGE(PG8_SA(1, 0), cA + kstep, voffA); PG8_STAGE(PG8_SB(1, 1), cB + hstep + kstep, voffB);
        PG8_WAIT_V(6); PG8_BAR;
    }
    for (;;) {
        const bool has_next = S.next(ui + 1, nxt);
        const char* nA = has_next ? (const char*)g.A + (size_t)nxt.pm * tstep : cA; const char* nB = has_next ? (const char*)g.Bt + (size_t)nxt.pn * tstep : cB;
        for (int t = 0; t < nt; t += 2) {
            const bool last = (t == nt - 2);
            const char* a1 = cA + (size_t)(t + 1) * kstep;
            const char* a2 = last ? nA : cA + (size_t)(t + 2) * kstep; const char* b2 = last ? nB : cB + (size_t)(t + 2) * kstep;
            const char* a3 = a2 + kstep; const char* b3 = b2 + kstep;
            if (last && has_next) S.a_ready(nxt);
            if constexpr (SP2) {
            PG8_LDB(B0, 0, 0); PG8_LDB(B1, 0, 1); PG8_SCHED; PG8_LDA(At, 0, 0); PG8_STAGE(PG8_SA(1, 1), a1 + hstep, voffA);
            PG8_WAIT_V(8); PG8_WAIT_L(0); PG8_BAR; PG8_MMA(0, 0, At, B0); PG8_MMA(0, 1, At, B1); PG8_BAR; PG8_SCHED;
            PG8_LDA(At, 0, 1); PG8_STAGE(PG8_SB(0, 0), b2, voffB); PG8_STAGE(PG8_SB(0, 1), b2 + hstep, voffB); PG8_STAGE(PG8_SA(0, 0), a2, voffA);
            PG8_WAIT_V(8); PG8_WAIT_L(0); PG8_BAR; PG8_MMA(1, 0, At, B0); PG8_MMA(1, 1, At, B1); PG8_BAR; PG8_SCHED;
            PG8_LDB(B0, 1, 0); PG8_LDB(B1, 1, 1); PG8_SCHED; PG8_LDA(At, 1, 0); PG8_STAGE(PG8_SA(0, 1), a2 + hstep, voffA);
            PG8_WAIT_V(8); PG8_WAIT_L(0); PG8_BAR; PG8_MMA(0, 0, At, B0); PG8_MMA(0, 1, At, B1); PG8_BAR; PG8_SCHED;
            PG8_LDA(At, 1, 1); PG8_STAGE(PG8_SB(1, 0), b3, voffB); PG8_STAGE(PG8_SB(1, 1), b3 + hstep, voffB); PG8_STAGE(PG8_SA(1, 0), a3, voffA);
            PG8_WAIT_V(8); PG8_WAIT_L(0); PG8_BAR; PG8_MMA(1, 0, At, B0); PG8_MMA(1, 1, At, B1); PG8_BAR; PG8_SCHED;
            } else {
            PG8_LDB(B0, 0, 0); PG8_SCHED; PG8_LDA(At, 0, 0); PG8_STAGE(PG8_SA(1, 1), a1 + hstep, voffA);
            PG8_WAIT_L(8); PG8_BAR; PG8_WAIT_L(0); PG8_MMA(0, 0, At, B0); PG8_BAR; PG8_SCHED;
            PG8_LDB(B1, 0, 1); PG8_STAGE(PG8_SB(0, 0), b2, voffB);
            PG8_BAR; PG8_WAIT_L(0); PG8_MMA(0, 1, At, B1); PG8_BAR;
            PG8_LDA(At, 0, 1); PG8_STAGE(PG8_SA(0, 0), a2, voffA);
            PG8_BAR; PG8_WAIT_L(0); PG8_MMA(1, 0, At, B0); PG8_BAR; PG8_SCHED;
            PG8_STAGE(PG8_SB(0, 1), b2 + hstep, voffB);
            PG8_WAIT_V(6); PG8_BAR; PG8_MMA(1, 1, At, B1); PG8_BAR;
            PG8_LDB(B0, 1, 0); PG8_SCHED; PG8_LDA(At, 1, 0); PG8_STAGE(PG8_SA(0, 1), a2 + hstep, voffA);
            PG8_WAIT_L(8); PG8_BAR; PG8_WAIT_L(0); PG8_MMA(0, 0, At, B0); PG8_BAR; PG8_SCHED;
            PG8_LDB(B1, 1, 1); PG8_STAGE(PG8_SB(1, 0), b3, voffB);
            PG8_BAR; PG8_WAIT_L(0); PG8_MMA(0, 1, At, B1); PG8_BAR;
            PG8_LDA(At, 1, 1); PG8_STAGE(PG8_SA(1, 0), a3, voffA);
            PG8_BAR; PG8_WAIT_L(0); PG8_MMA(1, 0, At, B0); PG8_BAR; PG8_SCHED;
            PG8_STAGE(PG8_SB(1, 1), b3 + hstep, voffB);
            PG8_WAIT_V(6); PG8_BAR; PG8_MMA(1, 1, At, B1); PG8_BAR;
            }
        }
        if constexpr (ALIGN_EPI) { if (wr == 0) PG8_BAR; }
        if constexpr (!Epi::AFTER_DRAIN) { E(acc, cur, wr, wc, fr, fq); S.done(cur); }
        if (!has_next) break;
#pragma unroll
        for (int a = 0; a < 2; ++a)
#pragma unroll
            for (int b = 0; b < 2; ++b)
#pragma unroll
                for (int m = 0; m < 4; ++m)
#pragma unroll
                    for (int n = 0; n < 2; ++n) acc[a][b][m][n] = (f32x4){0.f, 0.f, 0.f, 0.f};
        cur = nxt; cA = nA; cB = nB; ++ui;
        if constexpr (ALIGN_EPI) { if (wr == 1) PG8_BAR; }
    }
    PG8_WAIT_V(0);
    if constexpr (!ALIGN_EPI) { if (wr == 0) PG8_BAR; }
    PG8_BAR;
    if constexpr (Epi::AFTER_DRAIN) { E.fused(acc, cur, wr, wc, fr, fq, lds, wid, lane); S.done(cur); }
#undef PG8_SA
#undef PG8_SB
#undef PG8_STAGE
#undef PG8_LDA
#undef PG8_LDB
#undef PG8_MMA
#undef PG8_WAIT_V
#undef PG8_WAIT_L
#undef PG8_BAR
#undef PG8_SCHED
}
}

#define LAS __attribute__((address_space(3)))
using pg8::ex2; using pg8::rcpf_;
typedef unsigned short u16;
typedef short bf16x8 __attribute__((ext_vector_type(8)));
typedef float f32x4 __attribute__((ext_vector_type(4)));
typedef float f32x16 __attribute__((ext_vector_type(16)));
typedef unsigned u32x4 __attribute__((ext_vector_type(4)));
typedef unsigned u32x2 __attribute__((ext_vector_type(2)));

constexpr int DM = 1024, NB = 16, SEQ = 2048, MTOK = NB * SEQ, DEPTH = 4, DFF = 2816, INW = 2840, PW = 3072;
constexpr int C_MQ = 0, C_MK = 256, C_MV = 512, C_DQ = 768, C_DK = 1024, C_DV = 1280, C_NQ = 1536, C_NKC = 2048, C_NVC = 2176, C_NKS = 2304, C_NVS = 2432, C_NKW = 2560, C_NVW = 2688, C_NG = 2816;
constexpr int NVH = 12;
constexpr float LOG2E = 1.4426950408889634f, NEGF = -1e30f;
constexpr int NPH_L = 14, NPH = NPH_L * DEPTH + 1;
constexpr size_t MiB = 1u << 20;
constexpr size_t WS_GU1 = 1 * MiB, WS_DN1 = 12 * MiB, WS_GU2 = WS_DN1 + 5 * MiB + MiB / 2, WS_DN2 = WS_GU2 + 11 * MiB, WS_WIN = 34 * MiB, WS_WOUT = 40 * MiB, WS_W1 = 42 * MiB;
constexpr size_t WS_PROJ = 44 * MiB, WS_XN = 236 * MiB, WS_VT = 300 * MiB, WS_HID = 348 * MiB, WS_KCMP = 352 * MiB, WS_VCMPT = WS_KCMP + MiB / 2, WS_KMEAN = 353 * MiB, WS_SEL = WS_KMEAN + MiB / 4, WS_END = 354 * MiB;
static_assert(WS_DN2 + 5 * MiB + MiB / 2 == WS_WIN, "ws map");
constexpr int LDS_BYTES = 147456, MISC_OFF = 147456 - 64;
constexpr size_t WS_CTL = 0, CTL_ZERO_BYTES = 65536;
constexpr int ATT_K = 0, ATT_V = 32768, ATT_LUT = 65536, ATT_PARK = 68608;
constexpr int CMP_K = 0, CMP_V = 18432, CMP_A = 36864, CMP_H = CMP_A + 256 * 33 * 4;

struct Params {
    const float* x; const float* rel_bias; const float* norm_ffn1; const float* ffn1_gate; const float* ffn1_up; const float* ffn1_down;
    const float* norm_mix; const float* w_in; const float* diff_lambda; const float* diff_subln; const float* cmp_pe; const float* cmp_w1; const float* cmp_w2;
    const float* w_out; const float* norm_ffn2; const float* ffn2_gate; const float* ffn2_up; const float* ffn2_down; const float* final_norm;
    float* out; unsigned char* ws;
    float lam_init[4];
    int ph_lo, ph_hi;
};
typedef const __attribute__((address_space(4))) Params* KParamsPtr;

__device__ __forceinline__ float bf2f(unsigned v) { return __uint_as_float(v << 16); }
typedef float f32x2_t __attribute__((ext_vector_type(2))); typedef __bf16 bf16x2_t __attribute__((ext_vector_type(2)));
__device__ __forceinline__ unsigned pkbf(float lo, float hi) { f32x2_t v = {lo, hi}; bf16x2_t b = __builtin_convertvector(v, bf16x2_t); return __builtin_bit_cast(unsigned, b); }
__device__ __forceinline__ int lane_opaque() { int l; asm volatile("v_mbcnt_lo_u32_b32 %0, -1, 0\n\tv_mbcnt_hi_u32_b32 %0, -1, %0" : "=v"(l)); return l; }
__device__ __forceinline__ float wave_sum(float v, int lane) {
#pragma unroll
    for (int o = 1; o < 64; o <<= 1) v += __int_as_float(__builtin_amdgcn_ds_bpermute((lane ^ o) << 2, __float_as_int(v)));
    return v;
}
__device__ __forceinline__ float xhalf_max(float v) { auto rr = __builtin_amdgcn_permlane32_swap(__float_as_uint(v), __float_as_uint(v), false, false); return fmaxf(__uint_as_float(rr[0]), __uint_as_float(rr[1])); }
__device__ __forceinline__ float xhalf_sum(float v) { auto rr = __builtin_amdgcn_permlane32_swap(__float_as_uint(v), __float_as_uint(v), false, false); return __uint_as_float(rr[0]) + __uint_as_float(rr[1]); }
__device__ __forceinline__ float sigmoid_f(float x) { return rcpf_(1.0f + ex2(-LOG2E * x)); }
__device__ __forceinline__ int crow(int r, int hi) { return (r & 3) + 8 * (r >> 2) + 4 * hi; }
__device__ __forceinline__ int kperm(int p) { const int h = p >> 3, j = p & 7; return 8 * (j >> 2) + 4 * h + (j & 3); }
__device__ __forceinline__ int pperm(int k) { return ((k >> 2) & 1) * 8 + (k >> 3) * 4 + (k & 3); }

__device__ __forceinline__ void tr_item(const float* W, int K, int N, u16* WT, int kb, int n0, int dst_row0, LAS float* scr, int lane, float cs = 1.0f) {
    const int k0 = 64 * kb; const int n = n0 + (lane & 31); const bool ok = n < N;
#pragma unroll 8
    for (int i = 0; i < 32; ++i) { const int kk = 2 * i + (lane >> 5); scr[kk * 33 + (lane & 31)] = ok ? W[(size_t)(k0 + kk) * N + n] * cs : 0.f; }
    asm volatile("s_waitcnt lgkmcnt(0)" ::: "memory");
    const int c = lane & 7;
#pragma unroll
    for (int j = 0; j < 4; ++j) { const int nn = (lane >> 3) + 8 * j; const LAS float* s = scr + (8 * c) * 33 + nn;
        u32x4 o; o.x = pkbf(s[0 * 33], s[1 * 33]); o.y = pkbf(s[2 * 33], s[3 * 33]); o.z = pkbf(s[4 * 33], s[5 * 33]); o.w = pkbf(s[6 * 33], s[7 * 33]);
        *(u32x4*)(WT + (size_t)(dst_row0 + nn) * K + k0 + 8 * c) = o; }
    asm volatile("s_waitcnt lgkmcnt(0)" ::: "memory");
}

__device__ __forceinline__ void norm_row(const float* xrow, const float* g, u16* dst16, float* dst32, int lane) {
    const f32x4* xr = (const f32x4*)xrow + lane; const f32x4* gr = (const f32x4*)g + lane;
    f32x4 v[4]; float s = 0.f;
#pragma unroll
    for (int j = 0; j < 4; ++j) { v[j] = xr[64 * j]; s += (v[j].x * v[j].x + v[j].y * v[j].y) + (v[j].z * v[j].z + v[j].w * v[j].w); }
    const float rstd = 1.0f / sqrtf(wave_sum(s, lane) * (1.0f / 1024.0f) + 1e-6f);
#pragma unroll
    for (int j = 0; j < 4; ++j) { const f32x4 gg = gr[64 * j]; const f32x4 y = v[j] * rstd * gg;
        if (dst16) { u32x2 o; o.x = pkbf(y.x, y.y); o.y = pkbf(y.z, y.w); *((u32x2*)dst16 + lane + 64 * j) = o; }
        else *((f32x4*)dst32 + lane + 64 * j) = y; }
}

struct AState { f32x16 o0, o1; float m, l; };
__device__ __forceinline__ void astate_init(AState& s) {
#pragma unroll
    for (int r = 0; r < 16; ++r) { s.o0[r] = 0.f; s.o1[r] = 0.f; }
    s.m = 0.f; s.l = 0.f;
}
constexpr float ATT_THR = 8.0f;
constexpr int ATT_SLOT = 9216, ATT_NSLOT = 3;
template <int KS0, int NKS>
__device__ __forceinline__ void qk_block(const LAS unsigned char* Ks, const bf16x8 (&qr)[4], int r32, int hi, f32x16& s0, f32x16& s1) {
    f32x16 ci;
#pragma unroll
    for (int r = 0; r < 16; ++r) ci[r] = 0.f;
    const LAS unsigned char* kp = Ks + hi * 1024 + r32 * 16;
#pragma unroll
    for (int ks = 0; ks < NKS; ++ks) {
        const bf16x8 a0 = *(const LAS bf16x8*)(kp + (KS0 + ks) * 2048);
        const bf16x8 a1 = *(const LAS bf16x8*)(kp + (KS0 + ks) * 2048 + 512);
        s0 = __builtin_amdgcn_mfma_f32_32x32x16_bf16(a0, qr[KS0 + ks], ks == 0 ? ci : s0, 0, 0, 0);
        s1 = __builtin_amdgcn_mfma_f32_32x32x16_bf16(a1, qr[KS0 + ks], ks == 0 ? ci : s1, 0, 0, 0);
    }
    __builtin_amdgcn_sched_group_barrier(0x100, 2 * NKS, 0); __builtin_amdgcn_sched_group_barrier(0x008, 2 * NKS, 0);
}
__device__ __forceinline__ void pv_block(const LAS unsigned char* Vs, const u32x4 (&pk)[4], int r32, int hi, AState& st) {
    const LAS unsigned char* vp = Vs + hi * 1024 + r32 * 16;
#pragma unroll
    for (int c = 0; c < 4; ++c) {
        const bf16x8 v0 = *(const LAS bf16x8*)(vp + c * 2048);
        const bf16x8 v1 = *(const LAS bf16x8*)(vp + c * 2048 + 512);
        const bf16x8 pb = __builtin_bit_cast(bf16x8, pk[c]);
        st.o0 = __builtin_amdgcn_mfma_f32_32x32x16_bf16(v0, pb, st.o0, 0, 0, 0);
        st.o1 = __builtin_amdgcn_mfma_f32_32x32x16_bf16(v1, pb, st.o1, 0, 0, 0);
    }
    __builtin_amdgcn_sched_group_barrier(0x100, 8, 0); __builtin_amdgcn_sched_group_barrier(0x008, 8, 0);
}
__device__ __forceinline__ void glds16(const void* gsrc, unsigned lds_dst) { unsigned keep;
    asm volatile("s_mov_b32 %0, m0\n\ts_mov_b32 m0, %2\n\ts_nop 0\n\tglobal_load_lds_dwordx4 %1, off\n\ts_mov_b32 m0, %0" : "=&s"(keep) : "v"(gsrc), "s"(lds_dst) : "memory"); }
__device__ __forceinline__ void lut_add(f32x16& s0, f32x16& s1, const LAS float* lutz, int dbase, float cc) {
    const LAS float* lp = lutz + (dbase - 59);
#pragma unroll
    for (int r = 0; r < 16; ++r) { const int ko = (r & 3) + 8 * (r >> 2);
        s0[r] += lp[59 - ko] + cc; s1[r] += lp[27 - ko] + cc; }
}
__device__ __forceinline__ void const_add(f32x16& s0, f32x16& s1, float cc) {
#pragma unroll
    for (int r = 0; r < 16; ++r) { s0[r] += cc; s1[r] += cc; }
}
__device__ __forceinline__ float row_max(const f32x16& s0, const f32x16& s1) {
    float mx = fmaxf(s0[0], s1[0]);
#pragma unroll
    for (int r = 1; r < 16; ++r) mx = fmaxf(mx, fmaxf(s0[r], s1[r]));
    return xhalf_max(mx);
}
__device__ __forceinline__ void rescale(AState& st, f32x16& s0, f32x16& s1, float mx) {
    const float dl = fmaxf(mx, 0.f); const float f = ex2(-dl); st.m += dl; st.l *= f;
#pragma unroll
    for (int r = 0; r < 16; ++r) { st.o0[r] *= f; st.o1[r] *= f; s0[r] -= dl; s1[r] -= dl; }
}
__device__ __forceinline__ void exp_pack(f32x16& s0, f32x16& s1, u32x4 (&pk)[4], AState& st) {
    float sum = 0.f;
#pragma unroll
    for (int r = 0; r < 16; ++r) { s0[r] = ex2(s0[r]); s1[r] = ex2(s1[r]); sum += s0[r] + s1[r]; }
    st.l += sum;
    pk[0] = (u32x4){pkbf(s0[0], s0[1]), pkbf(s0[2], s0[3]), pkbf(s0[4], s0[5]), pkbf(s0[6], s0[7])};
    pk[1] = (u32x4){pkbf(s0[8], s0[9]), pkbf(s0[10], s0[11]), pkbf(s0[12], s0[13]), pkbf(s0[14], s0[15])};
    pk[2] = (u32x4){pkbf(s1[0], s1[1]), pkbf(s1[2], s1[3]), pkbf(s1[4], s1[5]), pkbf(s1[6], s1[7])};
    pk[3] = (u32x4){pkbf(s1[8], s1[9]), pkbf(s1[10], s1[11]), pkbf(s1[12], s1[13]), pkbf(s1[14], s1[15])};
}

template <int KS0, int NKS, bool WINDOW, int MODE>
__device__ __forceinline__ void run_tiles(LAS unsigned char* lds, int t0, int t1, const u16* Kg, const u16* Vtg, const bf16x8 (&qr)[4], float c31,
                                          int q0w, unsigned mask, int qb, AState& A, int wave, int lane, int r32, int hi) {
    LAS unsigned char* Kr = lds + ATT_K; LAS unsigned char* Vr = lds + ATT_V; const LAS float* lut1 = (const LAS float*)(lds + ATT_LUT) + 96;
    const u16* ksrc = Kg + (size_t)lane * PW + wave * 8;
    const u16* vsrc = Vtg + (size_t)lane * SEQ + wave * 8;
    const unsigned kdst = (unsigned)(uintptr_t)Kr + wave * 1024, vdst = (unsigned)(uintptr_t)Vr + wave * 1024;
#define TCL(t) ((t) < t0 ? t0 : ((t) > t1 ? t1 : (t)))
#define DMA_K(tn) glds16(ksrc + (size_t)TCL(tn) * 64 * PW, (unsigned)__builtin_amdgcn_readfirstlane(kdst + ((tn) & 3) * 8192))
#define DMA_V(tn) glds16(vsrc + TCL(tn) * 64, (unsigned)__builtin_amdgcn_readfirstlane(vdst + ((tn) & 3) * 8192))
#define KS_(t) (Kr + ((t) & 3) * 8192)
#define VS_(t) (Vr + ((t) & 3) * 8192)
#define WAIT_BAR4() asm volatile("s_waitcnt vmcnt(4) lgkmcnt(0)\n\ts_barrier" ::: "memory")
#define T_ACTIVE(t) (!((q0w + 31 - (t) * 64) < 0 || (WINDOW && (q0w - ((t) * 64 + 63)) >= 512)))
#define T_LUTMODE(t) (((q0w - ((t) * 64 + 63)) < 128) || (WINDOW && (q0w + 31 - (t) * 64) >= 512))
    auto tile_sel = [&](int t) -> int { if (MODE == 1) { const int blk = t >> 2; return blk < qb ? (int)((mask >> blk) & 1u) : 1; } if (MODE == 2) return (int)((mask >> t) & 1u); return 1; };
    asm volatile("s_waitcnt vmcnt(0)" ::: "memory");
#pragma unroll
    for (int j = 0; j < 4; ++j) { DMA_K(t0 + j); DMA_V(t0 + j - 2); }
    WAIT_BAR4();
    f32x16 sn0, sn1, sc0, sc1; u32x4 pk[4];
#pragma unroll
    for (int r = 0; r < 16; ++r) { sn0[r] = 0.f; sn1[r] = 0.f; }
#pragma unroll
    for (int i = 0; i < 4; ++i) pk[i] = (u32x4){0u, 0u, 0u, 0u};
    bool act_n = T_ACTIVE(t0), act_c = false, act_p = false;
    if (act_n) qk_block<KS0, NKS>(KS_(t0), qr, r32, hi, sn0, sn1);
    asm volatile("s_waitcnt lgkmcnt(0)\n\ts_barrier" ::: "memory");
    for (int c = t0; c <= t1 + 1; ++c) {
        act_p = act_c; act_c = act_n; sc0 = sn0; sc1 = sn1;
        DMA_K(c + 4); DMA_V(c + 2);
        act_n = (c + 1 <= t1) && T_ACTIVE(c + 1);
        const bool lm_c = T_LUTMODE(c);
        const int dbase = q0w + r32 - c * 64 - 4 * hi;
        const float selc = tile_sel(c) ? (lm_c ? 0.f : c31) : NEGF;
        if (act_p) pv_block(VS_(c - 1), pk, r32, hi, A);
        if (act_c) {
            if (lm_c) lut_add(sc0, sc1, lut1, dbase, selc - A.m); else const_add(sc0, sc1, selc - A.m);
            const float mx = row_max(sc0, sc1);
            if (__any(mx > ATT_THR)) rescale(A, sc0, sc1, mx);
        }
        if (act_n) qk_block<KS0, NKS>(KS_(c + 1), qr, r32, hi, sn0, sn1);
        if (act_c) exp_pack(sc0, sc1, pk, A);
        WAIT_BAR4();
    }
    asm volatile("s_waitcnt vmcnt(0) lgkmcnt(0)\n\ts_barrier" ::: "memory");
#undef TCL
#undef DMA_K
#undef DMA_V
#undef KS_
#undef VS_
#undef WAIT_BAR4
#undef T_ACTIVE
#undef T_LUTMODE
}

__device__ __forceinline__ void build_lut(LAS unsigned char* lds, const float* rel_bias, int head, bool window, int tid) {
    LAS float* lut = (LAS float*)(lds + ATT_LUT);
    for (int i = tid; i < 704; i += 512) {
        const int d = i - 96; float v;
        if (d < 0) v = NEGF;
        else if (d >= 512) v = window ? NEGF : rel_bias[31 * 16 + head] * LOG2E;
        else { int bk;
            if (d < 16) bk = d; else if (d >= 128) bk = 31; else { bk = 16 + (int)(log2f((float)d * (1.0f / 16.0f)) * (16.0f / 3.0f)); bk = bk > 31 ? 31 : bk; }
            v = rel_bias[bk * 16 + head] * LOG2E; }
        lut[i] = v;
    }
}
__device__ __forceinline__ void load_q(bf16x8 (&qr)[4], const u16* qrow, int hi) {
#pragma unroll
    for (int ks = 0; ks < 4; ++ks) qr[ks] = *(const bf16x8*)(qrow + ks * 16 + hi * 8);
}
__device__ __forceinline__ void store_o(u16* dst, const f32x16& v0, const f32x16& v1, int hi) {
#pragma unroll
    for (int g = 0; g < 4; ++g) {
        u32x2 a; a.x = pkbf(v0[4 * g], v0[4 * g + 1]); a.y = pkbf(v0[4 * g + 2], v0[4 * g + 3]); *(u32x2*)(dst + 8 * g + 4 * hi) = a;
        u32x2 b; b.x = pkbf(v1[4 * g], v1[4 * g + 1]); b.y = pkbf(v1[4 * g + 2], v1[4 * g + 3]); *(u32x2*)(dst + 32 + 8 * g + 4 * hi) = b;
    }
}

struct Ctx { LAS unsigned char* lds; int tid, lane, wave, r32, hi, G, bx; u16* proj; u16* obuf; u16* vt; };

__device__ __forceinline__ void moba_unit(const Ctx& C0, KParamsPtr P, int b, int h, int qb) {
    Ctx C = C0; C.lane = lane_opaque(); C.tid = C.wave * 64 + C.lane; C.r32 = C.lane & 31; C.hi = C.lane >> 5;
    const int q0w = __builtin_amdgcn_readfirstlane(qb * 256 + C.wave * 32); const int qpos = q0w + C.r32; const size_t tok = (size_t)b * SEQ + qpos;
    build_lut(C.lds, P->rel_bias, h, false, C.tid);
    const u16* qrow = C.proj + tok * PW + C_MQ + h * 64;
    bf16x8 qr[4]; load_q(qr, qrow, C.hi);
    unsigned mask = 0;
    if (qb > 0) {
        float g[7];
#pragma unroll
        for (int j = 0; j < 7; ++j) g[j] = 0.f;
        const float* km = (const float*)(P->ws + WS_KMEAN) + (size_t)((b * 4 + h) * 8) * 64;
#pragma unroll
        for (int dc = 0; dc < 8; ++dc) {
            const u32x4 qv = *(const u32x4*)(qrow + dc * 8);
            float qf[8]; qf[0] = bf2f(qv.x & 0xffffu); qf[1] = bf2f(qv.x >> 16); qf[2] = bf2f(qv.y & 0xffffu); qf[3] = bf2f(qv.y >> 16);
            qf[4] = bf2f(qv.z & 0xffffu); qf[5] = bf2f(qv.z >> 16); qf[6] = bf2f(qv.w & 0xffffu); qf[7] = bf2f(qv.w >> 16);
#pragma unroll
            for (int j = 0; j < 7; ++j) if (j < qb) { const float* kmj = km + j * 64 + dc * 8;
#pragma unroll
                for (int e = 0; e < 8; ++e) g[j] = fmaf(qf[e], kmj[e], g[j]); }
        }
#pragma unroll
        for (int j = 0; j < 7; ++j) if (j < qb) { int rank = 0;
#pragma unroll
            for (int i = 0; i < 7; ++i) if (i != j && i < qb) rank += (g[i] > g[j] || (g[i] == g[j] && i < j)) ? 1 : 0;
            if (rank < 3) mask |= 1u << j; }
    }
    AState A; astate_init(A);
    const float c31 = P->rel_bias[31 * 16 + h] * LOG2E;
    run_tiles<0, 4, false, 1>(C.lds, 0, 4 * qb + 3, C.proj + (size_t)b * SEQ * PW + C_MK + h * 64, C.vt + (size_t)((b * NVH + h) * 64) * SEQ, qr, c31, q0w, mask, qb, A, C.wave, C.lane, C.r32, C.hi);
    const float inv = rcpf_(xhalf_sum(A.l));
    A.o0 *= inv; A.o1 *= inv;
    { const int l2 = lane_opaque(); const size_t tok2 = (size_t)b * SEQ + q0w + (l2 & 31);
      store_o(C.obuf + tok2 * DM + h * 64, A.o0, A.o1, l2 >> 5); }
}

__device__ __forceinline__ void diff_unit(const Ctx& C0, KParamsPtr P, int layer, int b, int h, int qb) {
    Ctx C = C0; C.lane = lane_opaque(); C.tid = C.wave * 64 + C.lane; C.r32 = C.lane & 31; C.hi = C.lane >> 5;
    const int q0w = __builtin_amdgcn_readfirstlane(qb * 256 + C.wave * 32); const int qpos = q0w + C.r32; const size_t tok = (size_t)b * SEQ + qpos;
    build_lut(C.lds, P->rel_bias, 4 + h, false, C.tid);
    bf16x8 qr[4]; load_q(qr, C.proj + tok * PW + C_DQ + h * 64, C.hi);
    AState A; astate_init(A);
    const float c31 = P->rel_bias[31 * 16 + 4 + h] * LOG2E;
    const u16* Kg = C.proj + (size_t)b * SEQ * PW + C_DK + h * 64; const u16* Vg = C.vt + (size_t)((b * NVH + 4 + h) * 64) * SEQ;
    run_tiles<0, 2, false, 0>(C.lds, 0, 4 * qb + 3, Kg, Vg, qr, c31, q0w, 0u, 0, A, C.wave, C.lane, C.r32, C.hi);
    LAS float* park = (LAS float*)(C.lds + ATT_PARK) + C.tid;
    { const float i0 = rcpf_(xhalf_sum(A.l));
#pragma unroll
      for (int r = 0; r < 16; ++r) { park[r * 512] = A.o0[r] * i0; park[(16 + r) * 512] = A.o1[r] * i0; } }
    astate_init(A);
    run_tiles<2, 2, false, 0>(C.lds, 0, 4 * qb + 3, Kg, Vg, qr, c31, q0w, 0u, 0, A, C.wave, C.lane, C.r32, C.hi);
    const float* lp = P->diff_lambda + (size_t)layer * 128; float d01 = 0.f, d23 = 0.f;
    for (int i = 0; i < 32; ++i) { d01 = fmaf(lp[i], lp[32 + i], d01); d23 = fmaf(lp[64 + i], lp[96 + i], d23); }
    const float li = P->lam_init[layer]; const float lam = expf(d01) - expf(d23) + li;
    const float i1 = lam * rcpf_(xhalf_sum(A.l));
    float ss = 0.f;
#pragma unroll
    for (int r = 0; r < 16; ++r) { A.o0[r] = park[r * 512] - A.o0[r] * i1; A.o1[r] = park[(16 + r) * 512] - A.o1[r] * i1; ss += A.o0[r] * A.o0[r] + A.o1[r] * A.o1[r]; }
    ss = xhalf_sum(ss);
    const float rstd = (1.0f / sqrtf(ss * (1.0f / 64.0f) + 1e-6f)) * (1.0f - li);
    const float* sg = P->diff_subln + (size_t)layer * 64;
#pragma unroll
    for (int r = 0; r < 16; ++r) { const int d = crow(r, C.hi); A.o0[r] *= rstd * sg[d]; A.o1[r] *= rstd * sg[32 + d]; }
    { const int l2 = lane_opaque(); const size_t tok2 = (size_t)b * SEQ + q0w + (l2 & 31);
      store_o(C.obuf + tok2 * DM + 256 + h * 64, A.o0, A.o1, l2 >> 5); }
}

__device__ __forceinline__ void nsa_unit(const Ctx& C0, KParamsPtr P, int b, int hq, int qb) {
    Ctx C = C0; C.lane = lane_opaque(); C.tid = C.wave * 64 + C.lane; C.r32 = C.lane & 31; C.hi = C.lane >> 5;
    const int g = hq >> 2;
    const int q0w = __builtin_amdgcn_readfirstlane(qb * 256 + C.wave * 32); const int qpos = q0w + C.r32; const size_t tok = (size_t)b * SEQ + qpos;
    build_lut(C.lds, P->rel_bias, 8 + hq, false, C.tid);
    bf16x8 qr[4]; load_q(qr, C.proj + tok * PW + C_NQ + hq * 64, C.hi);
    const u16* gl = C.proj + tok * PW + C_NG + hq * 3;
    const float g1 = sigmoid_f(bf2f(gl[1])), g2 = sigmoid_f(bf2f(gl[2]));
    const unsigned mask = ((const unsigned*)(P->ws + WS_SEL))[(size_t)(b * 2 + g) * SEQ + qpos];
    const float c31 = P->rel_bias[31 * 16 + 8 + hq] * LOG2E;
    AState A; astate_init(A);
    run_tiles<0, 4, false, 2>(C.lds, 0, 4 * qb + 3, C.proj + (size_t)b * SEQ * PW + C_NKS + g * 64, C.vt + (size_t)((b * NVH + 8 + g) * 64) * SEQ, qr, c31, q0w, mask, qb, A, C.wave, C.lane, C.r32, C.hi);
    LAS float* park = (LAS float*)(C.lds + ATT_PARK) + C.tid;
    { const float f = g1 * rcpf_(xhalf_sum(A.l));
#pragma unroll
      for (int r = 0; r < 16; ++r) { park[r * 512] = A.o0[r] * f; park[(16 + r) * 512] = A.o1[r] * f; } }
    if (C.tid < 96) ((LAS float*)(C.lds + ATT_LUT))[608 + C.tid] = NEGF;
    astate_init(A);
    const int tw0 = 4 * qb - 8 < 0 ? 0 : 4 * qb - 8;
    run_tiles<0, 4, true, 0>(C.lds, tw0, 4 * qb + 3, C.proj + (size_t)b * SEQ * PW + C_NKW + g * 64, C.vt + (size_t)((b * NVH + 10 + g) * 64) * SEQ, qr, c31, q0w, 0u, qb, A, C.wave, C.lane, C.r32, C.hi);
    { const float f = g2 * rcpf_(xhalf_sum(A.l));
#pragma unroll
      for (int r = 0; r < 16; ++r) { A.o0[r] = A.o0[r] * f + park[r * 512]; A.o1[r] = A.o1[r] * f + park[(16 + r) * 512]; } }
    const int l2 = lane_opaque(); const int hi2 = l2 >> 5;
    u16* dst = C.obuf + ((size_t)b * SEQ + q0w + (l2 & 31)) * DM + 512 + hq * 64;
#pragma unroll
    for (int gg = 0; gg < 4; ++gg) {
        const u32x2 a = *(const u32x2*)(dst + 8 * gg + 4 * hi2), bq = *(const u32x2*)(dst + 32 + 8 * gg + 4 * hi2);
        A.o0[4 * gg] += bf2f(a.x & 0xffffu); A.o0[4 * gg + 1] += bf2f(a.x >> 16); A.o0[4 * gg + 2] += bf2f(a.y & 0xffffu); A.o0[4 * gg + 3] += bf2f(a.y >> 16);
        A.o1[4 * gg] += bf2f(bq.x & 0xffffu); A.o1[4 * gg + 1] += bf2f(bq.x >> 16); A.o1[4 * gg + 2] += bf2f(bq.y & 0xffffu); A.o1[4 * gg + 3] += bf2f(bq.y >> 16);
    }
    store_o(dst, A.o0, A.o1, hi2);
}

__device__ __forceinline__ void cmp_unit(const Ctx& C0, KParamsPtr P, int b, int g, int qblk) {
    Ctx C = C0; C.lane = lane_opaque(); C.tid = C.wave * 64 + C.lane; C.r32 = C.lane & 31; C.hi = C.lane >> 5;
    LAS unsigned char* lds = C.lds; const int tid = C.tid, r32 = C.r32, hi = C.hi;
    const u16* kc = (const u16*)(P->ws + WS_KCMP) + (size_t)(b * 2 + g) * 128 * 64;
    const u16* vc = (const u16*)(P->ws + WS_VCMPT) + (size_t)(b * 2 + g) * 64 * 128;
#pragma unroll
    for (int i = 0; i < 2; ++i) { const int e = tid + 512 * i;
        { const int row = e >> 3, ch = e & 7; *(LAS u32x4*)(lds + CMP_K + row * 144 + ch * 16) = *(const u32x4*)(kc + row * 64 + ch * 8); }
        { const int row = e >> 4, ch = e & 15; *(LAS u32x4*)(lds + CMP_V + row * 272 + ch * 16) = *(const u32x4*)(vc + row * 128 + ch * 8); } }
    const int q0w = __builtin_amdgcn_readfirstlane(qblk * 256 + C.wave * 32); const int qpos = q0w + r32; const size_t tok = (size_t)b * SEQ + qpos;
    const int nmax = (qpos - 31) >> 4;
    __syncthreads();
    float qa[16], qh[16];
#pragma unroll
    for (int i = 0; i < 16; ++i) { qa[i] = 0.f; qh[i] = 0.f; }
    const LAS unsigned char* kp = lds + CMP_K + r32 * 144 + hi * 16;
    const LAS unsigned char* vp = lds + CMP_V + r32 * 272 + hi * 16;
    for (int rh = 0; rh < 4; ++rh) {
        const int hq = g * 4 + rh;
        bf16x8 qr[4]; load_q(qr, C.proj + tok * PW + C_NQ + hq * 64, hi);
        const float g0 = sigmoid_f(bf2f(C.proj[tok * PW + C_NG + hq * 3]));
        f32x16 s[4];
#pragma unroll
        for (int kb = 0; kb < 4; ++kb) {
#pragma unroll
            for (int r = 0; r < 16; ++r) s[kb][r] = 0.f;
#pragma unroll
            for (int ks = 0; ks < 4; ++ks) { const bf16x8 a = *(const LAS bf16x8*)(kp + kb * 32 * 144 + ks * 32); s[kb] = __builtin_amdgcn_mfma_f32_32x32x16_bf16(a, qr[ks], s[kb], 0, 0, 0); }
        }
        float mx = NEGF;
#pragma unroll
        for (int kb = 0; kb < 4; ++kb)
#pragma unroll
            for (int r = 0; r < 16; ++r) { const int n = 32 * kb + crow(r, hi); const float v = (n <= nmax) ? s[kb][r] : NEGF; s[kb][r] = v; mx = fmaxf(mx, v); }
        mx = xhalf_max(mx);
        float sum = 0.f;
#pragma unroll
        for (int kb = 0; kb < 4; ++kb)
#pragma unroll
            for (int r = 0; r < 16; ++r) { const int n = 32 * kb + crow(r, hi); const float pv = (n <= nmax) ? ex2(s[kb][r] - mx) : 0.f; s[kb][r] = pv; sum += pv; }
        sum = xhalf_sum(sum);
        const float inv = nmax >= 0 ? rcpf_(sum) : 0.f;
        f32x16 o0, o1;
#pragma unroll
        for (int r = 0; r < 16; ++r) { o0[r] = 0.f; o1[r] = 0.f; }
#pragma unroll
        for (int kb = 0; kb < 4; ++kb) {
#pragma unroll
            for (int r = 0; r < 16; ++r) s[kb][r] *= inv;
#pragma unroll
            for (int g4 = 0; g4 < 4; ++g4) { const float h = 0.5f * s[kb][4 * g4 + 3]; qh[kb * 4 + g4] += h; qa[kb * 4 + g4] += (s[kb][4 * g4] + s[kb][4 * g4 + 1]) + (s[kb][4 * g4 + 2] + h); }
#pragma unroll
            for (int c = 0; c < 2; ++c) {
                const u32x4 pk = (u32x4){pkbf(s[kb][8 * c], s[kb][8 * c + 1]), pkbf(s[kb][8 * c + 2], s[kb][8 * c + 3]), pkbf(s[kb][8 * c + 4], s[kb][8 * c + 5]), pkbf(s[kb][8 * c + 6], s[kb][8 * c + 7])};
                const bf16x8 pb = __builtin_bit_cast(bf16x8, pk);
                const bf16x8 v0 = *(const LAS bf16x8*)(vp + (kb * 2 + c) * 32);
                const bf16x8 v1 = *(const LAS bf16x8*)(vp + 32 * 272 + (kb * 2 + c) * 32);
                o0 = __builtin_amdgcn_mfma_f32_32x32x16_bf16(v0, pb, o0, 0, 0, 0);
                o1 = __builtin_amdgcn_mfma_f32_32x32x16_bf16(v1, pb, o1, 0, 0, 0);
            }
            __builtin_amdgcn_sched_barrier(0);
        }
        o0 *= g0; o1 *= g0;
        store_o(C.obuf + tok * DM + 512 + hq * 64, o0, o1, hi);
    }
    LAS float* Aq = (LAS float*)(lds + CMP_A) + (C.wave * 32 + r32) * 33; LAS float* Hq = (LAS float*)(lds + CMP_H) + (C.wave * 32 + r32) * 33;
#pragma unroll
    for (int kb = 0; kb < 4; ++kb)
#pragma unroll
        for (int g4 = 0; g4 < 4; ++g4) { const int j = 8 * kb + 2 * g4 + hi; Aq[j] = qa[kb * 4 + g4]; Hq[j] = qh[kb * 4 + g4]; }
    __syncthreads();
    const int cur = q0w >> 6;
    unsigned bits = 0;
    if (cur < 16) bits = (2u << cur) - 1u;
    else {
        for (int e = 0; e < 16; ++e) { const int j = hi * 16 + e; if (j > 0 && j <= cur - 2) Aq[j] += Hq[j - 1]; }
        asm volatile("s_waitcnt lgkmcnt(0)" ::: "memory");
        for (int e = 0; e < 16; ++e) { const int j = hi * 16 + e;
            if (j <= cur) { const float sj = (j == 0 || j > cur - 2) ? 1e4f : Aq[j]; int rank = 0;
                for (int i = 0; i <= cur; ++i) { const float si = (i == 0 || i > cur - 2) ? 1e4f : Aq[i]; rank += (si > sj || (si == sj && i < j)) ? 1 : 0; }
                if (rank < 16) bits |= 1u << j; } }
        { auto rr = __builtin_amdgcn_permlane32_swap(bits, bits, false, false); bits = rr[0] | rr[1]; }
    }
    if (hi == 0) ((unsigned*)(P->ws + WS_SEL))[(size_t)(b * 2 + g) * SEQ + qpos] = bits;
    __syncthreads();
}

__device__ __forceinline__ void prep_vk(const Ctx& C, KParamsPtr P, int b0) {
    const int G = C.G - b0, bxr = C.bx - b0, tid = C.tid, lane = C.lane;
    if (bxr < 0) return;
    for (int it = bxr; it < NB * NVH * 32; it += G) {
        const int tb = it & 31, hv = (it >> 5) % NVH, b = it / (32 * NVH);
        const int vcol = hv < 4 ? C_MV + hv * 64 : hv < 8 ? C_DV + (hv - 4) * 64 : hv < 10 ? C_NVS + (hv - 8) * 64 : C_NVW + (hv - 10) * 64;
        { const int row = tid >> 3, ch = tid & 7; *(LAS u32x4*)(C.lds + row * 144 + ch * 16) = *(const u32x4*)(C.proj + ((size_t)b * SEQ + tb * 64 + row) * PW + vcol + ch * 8); }
        __syncthreads();
        { const int d = tid >> 3, pc = tid & 7; unsigned w[4];
#pragma unroll
            for (int e = 0; e < 4; ++e) { const int p0 = pc * 8 + 2 * e, p1 = p0 + 1; const int k0 = (p0 & ~15) + kperm(p0 & 15), k1 = (p1 & ~15) + kperm(p1 & 15);
                const unsigned a = *(const LAS u16*)(C.lds + k0 * 144 + d * 2), bb = *(const LAS u16*)(C.lds + k1 * 144 + d * 2); w[e] = a | (bb << 16); }
            *(u32x4*)(C.vt + ((size_t)(b * NVH + hv) * 64 + d) * SEQ + tb * 64 + pc * 8) = (u32x4){w[0], w[1], w[2], w[3]}; }
        __syncthreads();
    }
    const int gw = bxr * 8 + C.wave, NGW = G * 8;
    for (int it = gw; it < NB * 4 * 8; it += NGW) {
        const int blk = it & 7, h = (it >> 3) & 3, b = it >> 5;
        const u16* kp = C.proj + ((size_t)b * SEQ + blk * 256) * PW + C_MK + h * 64 + lane; float s = 0.f;
        for (int k = 0; k < 256; k += 8) { float t[8];
#pragma unroll
            for (int e = 0; e < 8; ++e) t[e] = bf2f(kp[(size_t)(k + e) * PW]);
            s += ((t[0] + t[1]) + (t[2] + t[3])) + ((t[4] + t[5]) + (t[6] + t[7])); }
        ((float*)(P->ws + WS_KMEAN))[(size_t)it * 64 + lane] = s * (1.0f / 256.0f);
    }
}
__device__ __forceinline__ void prep_a(const Ctx& C, KParamsPtr P, int layer) {
    const int G = C.G, lane = C.lane;
    const int gw = C.bx * 8 + C.wave, NGW = G * 8;
    u16* acmp = (u16*)(P->ws + WS_XN);
    for (int it = gw; it < 2 * 4096; it += NGW) {
        const int i = it >> 12, row = it & 4095, n = row & 127, bg = row >> 7, b = bg >> 1, g = bg & 1;
        u16* dst = acmp + (size_t)it * 2048; const float* pe = P->cmp_pe + (size_t)(layer * 2 + i) * 2048;
        const int col = (i == 0 ? C_NKC : C_NVC) + g * 64;
#pragma unroll
        for (int pass = 0; pass < 4; ++pass) { const int l = pass * 8 + (lane >> 3), d0 = (lane & 7) * 8;
            unsigned z0 = 0u; asm volatile("" : "+v"(z0)); u32x4 o = (u32x4){z0, z0, z0, z0};
            if (n < 127) { const u32x4 v = *(const u32x4*)(C.proj + ((size_t)b * SEQ + 16 * n + l) * PW + col + d0); const f32x4 e0 = *(const f32x4*)(pe + l * 64 + d0), e1 = *(const f32x4*)(pe + l * 64 + d0 + 4);
                o.x = pkbf(bf2f(v.x & 0xffffu) + e0.x, bf2f(v.x >> 16) + e0.y); o.y = pkbf(bf2f(v.y & 0xffffu) + e0.z, bf2f(v.y >> 16) + e0.w);
                o.z = pkbf(bf2f(v.z & 0xffffu) + e1.x, bf2f(v.z >> 16) + e1.y); o.w = pkbf(bf2f(v.w & 0xffffu) + e1.z, bf2f(v.w >> 16) + e1.w); }
            *(u32x4*)(dst + l * 64 + d0) = o; }
    }
}
__device__ __forceinline__ void prep_c(const Ctx& C, KParamsPtr P, int layer) {
    const int gw = C.bx * 8 + C.wave, NGW = C.G * 8, lane = C.lane;
    for (int it = gw; it < 2 * 4096; it += NGW) {
        const int i = it >> 12, row = it & 4095;
        const u16* hrow = (const u16*)(P->ws + WS_HID) + (size_t)it * 256; const float* w2 = P->cmp_w2 + (size_t)(layer * 2 + i) * 256 * 64 + lane;
        float acc = 0.f;
        for (int j = 0; j < 256; j += 8) { const u32x4 hv = *(const u32x4*)(hrow + j);
            acc = fmaf(bf2f(hv.x & 0xffffu), w2[(j + 0) * 64], acc); acc = fmaf(bf2f(hv.x >> 16), w2[(j + 1) * 64], acc);
            acc = fmaf(bf2f(hv.y & 0xffffu), w2[(j + 2) * 64], acc); acc = fmaf(bf2f(hv.y >> 16), w2[(j + 3) * 64], acc);
            acc = fmaf(bf2f(hv.z & 0xffffu), w2[(j + 4) * 64], acc); acc = fmaf(bf2f(hv.z >> 16), w2[(j + 5) * 64], acc);
            acc = fmaf(bf2f(hv.w & 0xffffu), w2[(j + 6) * 64], acc); acc = fmaf(bf2f(hv.w >> 16), w2[(j + 7) * 64], acc); }
        const unsigned bits = pkbf(acc, 0.f) & 0xffffu;
        if (i == 0) ((u16*)(P->ws + WS_KCMP))[(size_t)row * 64 + lane] = (u16)bits;
        else { const int bg = row >> 7, n = row & 127; ((u16*)(P->ws + WS_VCMPT))[((size_t)bg * 64 + lane) * 128 + (n & ~15) + pperm(n & 15)] = (u16)bits; }
    }
}

__device__ __forceinline__ void convert_weights(const Ctx& C, KParamsPtr P, int layer) {
    LAS float* scr = (LAS float*)(C.lds + C.wave * 16384);
    const int gw = C.bx * 8 + C.wave, NGW = C.G * 8, lane = C.lane;
    constexpr int I_G = 16 * 88, I_D = 44 * 32, I_IN = 16 * 96, I_O = 16 * 32, I_W1 = 32 * 8;
    constexpr int NIT = 4 * I_G + 2 * I_D + I_IN + I_O + 2 * I_W1;
    unsigned char* ws = P->ws;
    for (int it = gw; it < NIT; it += NGW) {
        int r = it;
        if (r < 4 * I_G) { const int which = r / I_G; r -= which * I_G; const int kb = r / 88, nb = r % 88, n0 = nb * 32;
            const float* W = (which == 0 ? P->ffn1_gate : which == 1 ? P->ffn1_up : which == 2 ? P->ffn2_gate : P->ffn2_up) + (size_t)layer * DM * DFF;
            u16* WT = (u16*)(ws + (which < 2 ? WS_GU1 : WS_GU2));
            tr_item(W, DM, DFF, WT, kb, n0, (n0 >> 7) * 256 + (which & 1) * 128 + (n0 & 127), scr, lane); continue; }
        r -= 4 * I_G;
        if (r < 2 * I_D) { const int which = r / I_D; r -= which * I_D; const int kb = r / 32, nb = r % 32;
            const float* W = (which == 0 ? P->ffn1_down : P->ffn2_down) + (size_t)layer * DFF * DM;
            tr_item(W, DFF, DM, (u16*)(ws + (which == 0 ? WS_DN1 : WS_DN2)), kb, nb * 32, nb * 32, scr, lane); continue; }
        r -= 2 * I_D;
        if (r < I_IN) { const int kb = r / 96, nb = r % 96, n0 = nb * 32;
            const float cs = (n0 < C_MK || (n0 >= C_NQ && n0 < C_NKC)) ? 0.125f * LOG2E : (n0 >= C_DQ && n0 < C_DK) ? 0.17677669529663687f * LOG2E : 1.0f;
            tr_item(P->w_in + (size_t)layer * DM * INW, DM, INW, (u16*)(ws + WS_WIN), kb, n0, n0, scr, lane, cs); continue; }
        r -= I_IN;
        if (r < I_O) { const int kb = r / 32, nb = r % 32; tr_item(P->w_out + (size_t)layer * DM * DM, DM, DM, (u16*)(ws + WS_WOUT), kb, nb * 32, nb * 32, scr, lane); continue; }
        r -= I_O;
        { const int i = r / I_W1; r -= i * I_W1; const int kb = r / 8, nb = r % 8;
            tr_item(P->cmp_w1 + (size_t)(layer * 2 + i) * 2048 * 256, 2048, 256, (u16*)(ws + WS_W1) + (size_t)i * 256 * 2048, kb, nb * 32, nb * 32, scr, lane); }
    }
}
__device__ __forceinline__ void norm_phase(const Ctx& C, const float* src, const float* g, u16* dst16, float* dst32) {
    const int gw = C.bx * 8 + C.wave, NGW = C.G * 8;
    for (int m = gw; m < MTOK; m += NGW) norm_row(src + (size_t)m * DM, g, dst16 ? dst16 + (size_t)m * DM : nullptr, dst32 ? dst32 + (size_t)m * DM : nullptr, C.lane);
}

#define XB_TMO      128
#define XB_XCNT(j)  (256  + 64 * (j))
#define XB_XSUB(j)  (1280 + 64 * (j))
#define XB_XGEN(j)  (2304 + 64 * (j))
#define XB_TOP      3328
#define XB_TOPGEN   3392
#define XCD_BAR_WORDS 3456
#define XB_SPIN_CAP (1u << 18)

__device__ __forceinline__ unsigned xb_ld(unsigned* p)              { return __hip_atomic_load(p, __ATOMIC_RELAXED, __HIP_MEMORY_SCOPE_AGENT); }
__device__ __forceinline__ unsigned xb_add(unsigned* p, unsigned v) { return __hip_atomic_fetch_add(p, v, __ATOMIC_RELAXED, __HIP_MEMORY_SCOPE_AGENT); }
__device__ __forceinline__ unsigned xb_xcc_id() { return (unsigned)__builtin_amdgcn_s_getreg((3 << 11) | 20) & 0xFu; }
#define XB_SPIN(cond, bar) do { unsigned _sp = 0; while (cond) { __builtin_amdgcn_s_sleep(1); \
    if ((++_sp & 255u) == 0u) { if (xb_ld(&(bar)[XB_TMO])) break; if (_sp > XB_SPIN_CAP) { atomicAdd(&(bar)[XB_TMO], 1u); break; } } } } while (0)

struct XcdBarrier {
    unsigned* bar; unsigned x;
    volatile LAS unsigned* st;
};

__device__ __forceinline__ XcdBarrier xcd_barrier_post(unsigned* bar, volatile LAS unsigned* st) {
    XcdBarrier b; b.bar = bar; b.x = xb_xcc_id(); b.st = st;
    if (threadIdx.x == 0) (void)xb_add(&bar[XB_XCNT(b.x)], 1u);
    return b;
}
__device__ __forceinline__ void xcd_barrier_complete(unsigned* bar, unsigned x, unsigned& nloc, unsigned& nx) {
    const unsigned G = gridDim.x * gridDim.y * gridDim.z;
    unsigned sum, cnt, mine, sp = 0u;
    for (;;) {
        sum = 0u; cnt = 0u; mine = 0u;
#pragma unroll
        for (unsigned j = 0; j < 16; ++j) { const unsigned c = xb_ld(&bar[XB_XCNT(j)]); sum += c; cnt += (c > 0u) ? 1u : 0u; mine = (j == x) ? c : mine; }
        if (sum == G) break;
        __builtin_amdgcn_s_sleep(1);
        if ((++sp & 255u) == 0u) { if (xb_ld(&bar[XB_TMO])) break; if (sp > XB_SPIN_CAP) { atomicAdd(&bar[XB_TMO], 1u); break; } }
    }
    nloc = mine > 0u ? mine : 1u; nx = cnt > 0u ? cnt : 1u;
}

__device__ __forceinline__ void xcd_barrier(const XcdBarrier& b) {
    asm volatile("s_waitcnt vmcnt(0)" ::: "memory");
    __syncthreads();
    if (threadIdx.x == 0) {
        unsigned* bar = b.bar;
        __builtin_amdgcn_s_waitcnt(0);
        unsigned nloc = b.st[0], nx = b.st[1];
        if (nloc == 0u) { xcd_barrier_complete(bar, b.x, nloc, nx); b.st[0] = nloc; b.st[1] = nx; }
        const unsigned old = xb_add(&bar[XB_XSUB(b.x)], 1u);
        const unsigned gen = old / nloc;
        if (old + 1u == (gen + 1u) * nloc) {
            __builtin_amdgcn_fence(__ATOMIC_RELEASE, "agent");
            asm volatile("s_waitcnt vmcnt(0)" ::: "memory");
            const unsigned og = xb_add(&bar[XB_TOP], 1u);
            const unsigned tg = og / nx;
            if (og + 1u == (tg + 1u) * nx) xb_add(&bar[XB_TOPGEN], 1u);
            else XB_SPIN(xb_ld(&bar[XB_TOPGEN]) == tg, bar);
            __builtin_amdgcn_fence(__ATOMIC_ACQUIRE, "agent");
            xb_add(&bar[XB_XGEN(b.x)], 1u);
            asm volatile("s_waitcnt vmcnt(0)" ::: "memory");
        } else {
            XB_SPIN(xb_ld(&bar[XB_XGEN(b.x)]) == gen, bar);
            __builtin_amdgcn_fence(__ATOMIC_ACQUIRE, "agent");
            asm volatile("s_waitcnt vmcnt(0)" ::: "memory");
        }
    }
    __syncthreads();
}


__global__ void __launch_bounds__(512, 2) hybrid_fwd(Params P0) {
    extern __shared__ __attribute__((aligned(16))) unsigned char lds_raw[];
    const KParamsPtr kp0 = (KParamsPtr)__builtin_amdgcn_kernarg_segment_ptr();
    cg::grid_group grid = cg::this_grid();
    { volatile LAS unsigned* misc = (volatile LAS unsigned*)((LAS unsigned char*)lds_raw + MISC_OFF); if (threadIdx.x < 2) misc[threadIdx.x] = 0u; }
    __syncthreads();
    XcdBarrier bar = xcd_barrier_post((unsigned*)(P0.ws + WS_CTL) + 1024, (volatile LAS unsigned*)((LAS unsigned char*)lds_raw + MISC_OFF));
    const int ph_lo = P0.ph_lo, ph_hi = P0.ph_hi; const int wave_s = __builtin_amdgcn_readfirstlane(threadIdx.x >> 6);
    bool redone = false; (void)redone;
    for (int ph = ph_lo; ph < ph_hi; ++ph) {
        KParamsPtr kpl = kp0; asm volatile("" : "+s"(kpl));
        const KParamsPtr P = kpl; unsigned char* ws = P->ws;
        u16* XN = (u16*)(ws + WS_XN); u16* HB = (u16*)(ws + WS_PROJ);
        int G = gridDim.x, bx = blockIdx.x; asm volatile("" : "+s"(G), "+s"(bx));
        Ctx C; C.G = G; C.bx = bx; C.lds = (LAS unsigned char*)lds_raw; C.wave = wave_s; C.lane = lane_opaque(); C.tid = wave_s * 64 + C.lane; C.r32 = C.lane & 31; C.hi = C.lane >> 5;
        C.proj = (u16*)(ws + WS_PROJ); C.obuf = (u16*)(ws + WS_XN); C.vt = (u16*)(ws + WS_VT);
        const int layer = ph / NPH_L, s = ph % NPH_L;
        if (ph == NPH - 1) { norm_phase(C, P->out, P->final_norm, nullptr, P->out); }
        else switch (s) {
        case 0: { convert_weights(C, P, layer); __syncthreads(); norm_phase(C, layer == 0 ? P->x : P->out, P->norm_ffn1 + (size_t)layer * DM, XN, nullptr); } break;
        case 3: { norm_phase(C, P->out, P->norm_mix + (size_t)layer * DM, XN, nullptr); } break;
        case 11: { norm_phase(C, P->out, P->norm_ffn2 + (size_t)layer * DM, XN, nullptr); } break;
#ifndef NO_GEMM
#ifndef NO_G1
        case 1: case 12: {
            pg8::Gemm g{XN, (const u16*)(ws + (s == 1 ? WS_GU1 : WS_GU2)), MTOK, 2 * DFF, DM}; pg8::StaticOrder S; S.init(MTOK, 2 * DFF, G, bx);
            pg8::EpiSwiGLU E{HB, DFF};
            pg8::gemm_phase<pg8::EpiSwiGLU, pg8::StaticOrder, true, true>(C.lds, g, S, E, C.wave); } break;
#endif
#ifndef NO_G2
        case 2: case 13: case 10: {
            const u16* A = (s == 10) ? (const u16*)XN : (const u16*)HB; const u16* Bt = (const u16*)(ws + (s == 2 ? WS_DN1 : s == 13 ? WS_DN2 : WS_WOUT));
            pg8::Gemm g{A, Bt, MTOK, DM, s == 10 ? DM : DFF}; pg8::StaticOrder S; S.init(MTOK, DM, G, bx);
            pg8::EpiResid E{(layer == 0 && s == 2) ? P->x : (const float*)P->out, P->out, DM, s == 10 ? 1.0f : 0.5f};
            pg8::gemm_phase<pg8::EpiResid, pg8::StaticOrder, true, true>(C.lds, g, S, E, C.wave); } break;
#endif
#ifndef NO_G4
        case 4: {
            pg8::Gemm g{XN, (const u16*)(ws + WS_WIN), MTOK, PW, DM}; pg8::StaticOrder S; S.init(MTOK, PW, G, bx);
            pg8::EpiBf16<0> E{C.proj, PW};
            pg8::gemm_phase<pg8::EpiBf16<0>, pg8::StaticOrder, true, true>(C.lds, g, S, E, C.wave); } break;
#endif
#endif
#ifndef NO_PREP
        case 5: prep_a(C, P, layer); break;
#endif
#if !defined(NO_GEMM) && !defined(NO_G6)
        case 6: {
            prep_vk(C, P, G > 64 ? 32 : 0); __syncthreads();
            for (int i = 0; i < 2; ++i) {
                pg8::Gemm g{(const u16*)XN + (size_t)i * 4096 * 2048, (const u16*)(ws + WS_W1) + (size_t)i * 256 * 2048, 4096, 256, 2048}; pg8::StaticOrder S; S.init(4096, 256, G, (bx + G - 16 * i) % G);
                pg8::EpiBf16<1> E{(u16*)(ws + WS_HID) + (size_t)i * 4096 * 256, 256};
                pg8::gemm_phase<pg8::EpiBf16<1>, pg8::StaticOrder, true, true>(C.lds, g, S, E, C.wave); } } break;
#endif
#ifndef NO_PREP
        case 7: prep_c(C, P, layer); break;
#endif
#ifndef NO_ATT1
        case 8: {
#ifndef NO_CMP
            for (int c = bx; c < 256; c += G) cmp_unit(C, P, c >> 4, (c >> 3) & 1, c & 7);
#endif
            } break;
#endif
#ifndef NO_ATT2
        case 9: {
            unsigned* qctr = (unsigned*)(ws + WS_CTL) + 8192 + 64 * ph; volatile LAS unsigned* qslot = (volatile LAS unsigned*)(C.lds + MISC_OFF + 16);
            for (;;) {
                if (C.tid == 0) *qslot = __hip_atomic_fetch_add(qctr, 1u, __ATOMIC_RELAXED, __HIP_MEMORY_SCOPE_AGENT);
                __syncthreads();
                const unsigned u = *qslot;
                __syncthreads();
                if (u >= 2048u) break;
                const int qb = 7 - (int)(u >> 8), w = (int)(u & 255);
                if (w < 128) nsa_unit(C, P, w >> 3, w & 7, qb);
                else if (w < 192) {
#ifndef NO_DIFF
                    diff_unit(C, P, layer, (w - 128) >> 2, w & 3, qb);
#endif
                } else {
#ifndef NO_MOBA
                    moba_unit(C, P, (w - 192) >> 2, w & 3, qb);
#endif
                }
            } } break;
#endif
        default: break;
        }
        if (ph + 1 < ph_hi) { if (ph == ph_lo) grid.sync(); else xcd_barrier(bar); }
#ifdef PROBE_LO
        if (ph != NPH - 1 && s == PROBE_HI) { if (!redone) { ph -= (PROBE_HI - PROBE_LO + 1); redone = true; } else redone = false; }
#endif
#ifdef PROBE_SYNC
        if (ph + 1 < ph_hi) xcd_barrier(bar);
#endif
    }
}

#ifndef COOP
#define COOP 1
#endif
extern "C" void kernel_launch(void* const* d_in, const int* in_sizes, int n_in, void* d_out, int out_size, void* d_ws, size_t ws_size, hipStream_t stream) {
    static int grid = 0;
    if (grid == 0) {
        if (n_in != 19 || out_size != MTOK * DM || ws_size < WS_END) { fprintf(stderr, "kernel_launch: unexpected shapes (n_in %d out %d ws %zu)\n", n_in, out_size, ws_size); grid = -1; return; }
        int dev = 0, cus = 0, per_cu = 0;
        (void)hipGetDevice(&dev); (void)hipDeviceGetAttribute(&cus, hipDeviceAttributeMultiprocessorCount, dev);
        if (hipFuncSetAttribute((const void*)hybrid_fwd, hipFuncAttributeMaxDynamicSharedMemorySize, LDS_BYTES) != hipSuccess) { fprintf(stderr, "kernel_launch: hipFuncSetAttribute failed\n"); grid = -1; return; }
        if (hipOccupancyMaxActiveBlocksPerMultiprocessor(&per_cu, (const void*)hybrid_fwd, 512, LDS_BYTES) != hipSuccess || per_cu < 1) { fprintf(stderr, "kernel_launch: occupancy query says %d\n", per_cu); per_cu = 1; }
        (void)hipGetLastError();
        grid = cus * per_cu;
    }
    if (grid < 0) return;
    Params p{};
    p.x = (const float*)d_in[0]; p.rel_bias = (const float*)d_in[1]; p.norm_ffn1 = (const float*)d_in[2]; p.ffn1_gate = (const float*)d_in[3]; p.ffn1_up = (const float*)d_in[4]; p.ffn1_down = (const float*)d_in[5];
    p.norm_mix = (const float*)d_in[6]; p.w_in = (const float*)d_in[7]; p.diff_lambda = (const float*)d_in[8]; p.diff_subln = (const float*)d_in[9]; p.cmp_pe = (const float*)d_in[10]; p.cmp_w1 = (const float*)d_in[11];
    p.cmp_w2 = (const float*)d_in[12]; p.w_out = (const float*)d_in[13]; p.norm_ffn2 = (const float*)d_in[14]; p.ffn2_gate = (const float*)d_in[15]; p.ffn2_up = (const float*)d_in[16]; p.ffn2_down = (const float*)d_in[17];
    p.final_norm = (const float*)d_in[18]; p.out = (float*)d_out; p.ws = (unsigned char*)d_ws;
    for (int l = 0; l < 4; ++l) p.lam_init[l] = (float)(0.8 - 0.6 * exp(-0.3 * (double)l));
#if COOP
    if (hipMemsetAsync((char*)d_ws + WS_CTL, 0, CTL_ZERO_BYTES, stream) != hipSuccess) { fprintf(stderr, "kernel_launch: memset of barrier words failed\n"); return; }
    p.ph_lo = 0; p.ph_hi = NPH;
    void* args[] = {&p};
    hipError_t e = hipLaunchCooperativeKernel((const void*)hybrid_fwd, dim3(grid), dim3(512), args, LDS_BYTES, stream);
    if (e != hipSuccess) fprintf(stderr, "cooperative launch failed: %s (grid %d)\n", hipGetErrorString(e), grid);
#else
    for (int ph = 0; ph < NPH; ++ph) { p.ph_lo = ph; p.ph_hi = ph + 1; hipLaunchKernelGGL(hybrid_fwd, dim3(grid), dim3(512), LDS_BYTES, stream, p); }
#endif
}
```

```cpp
#include <hip/hip_runtime.h>
#include <hip/hip_cooperative_groups.h>
#include <cstdio>
#include <cstdint>
#include <cmath>
namespace cg = cooperative_groups;
#define COOP 1
namespace pg8 {
#define PG8_LAS __attribute__((address_space(3)))
typedef unsigned short bf16_t;
typedef short bf16x8 __attribute__((ext_vector_type(8)));
typedef float f32x4 __attribute__((ext_vector_type(4)));
typedef unsigned u32x4 __attribute__((ext_vector_type(4)));
constexpr int BM = 256, BK = 64, HALF = 128, HTB = HALF * BK * 2  , STAGE_BYTES = 8 * HTB, NXCD = 8, WGM = 8;

__host__ __device__ __forceinline__ int lds_byte(int r, int c) { const int st = (r >> 4) * 2 + (c >> 5), rr = r & 15, cc = c & 31, ob = rr * 64 + cc * 2; return st * 1024 + (ob ^ (((ob >> 9) & 1) << 5)); }
__host__ __device__ __forceinline__ void stage_rc(int b, int& R, int& C) { const int st = b / 1024, sb = b % 1024, swz = sb ^ (((sb >> 9) & 1) << 5); R = (st >> 1) * 16 + swz / 64; C = (st & 1) * 32 + (swz % 64) / 2; }
__host__ __device__ __forceinline__ int perm32(int rho) { const int n = rho >> 4, i = rho & 15; return 8 * (i >> 2) + 4 * n + (i & 3); }

struct Unit { int pm, pn; };
struct Gemm { const bf16_t* A; const bf16_t* Bt; int M, N, K; };

struct StaticOrder {
    int nM, nN, nwg, G, c;
    __host__ __device__ void init(int M, int N, int G_, int c_) { nM = M / BM; nN = N / BM; nwg = nM * nN; G = G_; c = c_; }
    __host__ __device__ bool next(int i, Unit& u) const {
        const long L = (long)i * G + c; if (L >= nwg) return false;
        int wgid = (int)L; { const int q = nwg / NXCD, r = nwg % NXCD, xcd = wgid % NXCD, off = wgid / NXCD; wgid = (xcd < r ? xcd * (q + 1) : r * (q + 1) + (xcd - r) * q) + off; }
        const int nig = WGM * nN, gid = wgid / nig, fm = gid * WGM, gsz = (nM - fm) < WGM ? (nM - fm) : WGM;
        u.pm = fm + ((wgid % nig) % gsz); u.pn = (wgid % nig) / gsz; return true;
    }
    __device__ __forceinline__ void a_ready(const Unit&) const {}
    __device__ __forceinline__ void done(const Unit&) const {}
};

__device__ __forceinline__ unsigned cvt_pk_bf16(float lo, float hi) { unsigned r; asm volatile("v_cvt_pk_bf16_f32 %0, %1, %2" : "=v"(r) : "v"(lo), "v"(hi)); return r; }

__device__ __forceinline__ float ex2(float x) { return __builtin_amdgcn_exp2f(x); }
__device__ __forceinline__ float rcpf_(float x) { return __builtin_amdgcn_rcpf(x); }
__device__ __forceinline__ float silu_f(float x) { return x * rcpf_(1.0f + ex2(-1.4426950408889634f * x)); }
__device__ __forceinline__ float gelu_tanh_f(float x) { const float y2 = 2.0f * 0.7978845608028654f * (x + 0.044715f * x * x * x); return x * (1.0f - rcpf_(1.0f + ex2(1.4426950408889634f * y2))); }

struct EpiSwiGLU {
    static constexpr bool PERM = true, AFTER_DRAIN = false;
    bf16_t* O; int ldc;
    __device__ __forceinline__ void operator()(const f32x4 (&acc)[2][2][4][2], const Unit& u, int wr, int wc, int fr, int fq) const {
        const int row0 = u.pm * BM + wr * 64 + fr; const int col0 = u.pn * HALF + wc * 32 + 8 * fq;
#pragma unroll
        for (int ai = 0; ai < 2; ++ai)
#pragma unroll
            for (int m = 0; m < 4; ++m) { bf16_t* rowp = O + (size_t)(row0 + ai * HALF + m * 16) * ldc + col0;
                const f32x4 g0 = acc[ai][0][m][0], g1 = acc[ai][0][m][1], u0 = acc[ai][1][m][0], u1 = acc[ai][1][m][1];
                u32x4 w; w.x = cvt_pk_bf16(silu_f(g0[0]) * u0[0], silu_f(g0[1]) * u0[1]); w.y = cvt_pk_bf16(silu_f(g0[2]) * u0[2], silu_f(g0[3]) * u0[3]);
                w.z = cvt_pk_bf16(silu_f(g1[0]) * u1[0], silu_f(g1[1]) * u1[1]); w.w = cvt_pk_bf16(silu_f(g1[2]) * u1[2], silu_f(g1[3]) * u1[3]);
                *(u32x4*)rowp = w; asm volatile("" ::: "memory"); }
    }
};
template <int ACT> struct EpiBf16 {
    static constexpr bool PERM = true, AFTER_DRAIN = false;
    bf16_t* O; int ldc;
    __device__ __forceinline__ void operator()(const f32x4 (&acc)[2][2][4][2], const Unit& u, int wr, int wc, int fr, int fq) const {
        const int row0 = u.pm * BM + wr * 64 + fr; const int col0 = u.pn * BM + wc * 32 + 8 * fq;
#pragma unroll
        for (int ai = 0; ai < 2; ++ai)
#pragma unroll
            for (int m = 0; m < 4; ++m) { bf16_t* rowp = O + (size_t)(row0 + ai * HALF + m * 16) * ldc + col0;
#pragma unroll
                for (int bj = 0; bj < 2; ++bj) { f32x4 v0 = acc[ai][bj][m][0], v1 = acc[ai][bj][m][1];
                    if (ACT == 1) { v0 = (f32x4){gelu_tanh_f(v0[0]), gelu_tanh_f(v0[1]), gelu_tanh_f(v0[2]), gelu_tanh_f(v0[3])}; v1 = (f32x4){gelu_tanh_f(v1[0]), gelu_tanh_f(v1[1]), gelu_tanh_f(v1[2]), gelu_tanh_f(v1[3])}; }
                    u32x4 w; w.x = cvt_pk_bf16(v0[0], v0[1]); w.y = cvt_pk_bf16(v0[2], v0[3]); w.z = cvt_pk_bf16(v1[0], v1[1]); w.w = cvt_pk_bf16(v1[2], v1[3]);
                    *(u32x4*)(rowp + bj * HALF) = w; } asm volatile("" ::: "memory"); }
    }
};
struct EpiResid {
    static constexpr bool PERM = true, AFTER_DRAIN = false;
    const float* base; float* out; int ldc; float alpha;
    __device__ __forceinline__ void operator()(const f32x4 (&acc)[2][2][4][2], const Unit& u, int wr, int wc, int fr, int fq) const {
        const int row0 = u.pm * BM + wr * 64 + fr; const int col0 = u.pn * BM + wc * 32 + 8 * fq;
#pragma unroll
        for (int ai = 0; ai < 2; ++ai) {
            f32x4 pre[4][2][2];
#pragma unroll
            for (int m = 0; m < 4; ++m)
#pragma unroll
                for (int bj = 0; bj < 2; ++bj)
#pragma unroll
                    for (int n = 0; n < 2; ++n) pre[m][bj][n] = *(const f32x4*)(base + (size_t)(row0 + ai * HALF + m * 16) * ldc + col0 + bj * HALF + n * 4);
#pragma unroll
            for (int m = 0; m < 4; ++m) { const size_t off = (size_t)(row0 + ai * HALF + m * 16) * ldc + col0;
#pragma unroll
                for (int bj = 0; bj < 2; ++bj) { *(f32x4*)(out + off + bj * HALF) = pre[m][bj][0] + acc[ai][bj][m][0] * alpha; *(f32x4*)(out + off + bj * HALF + 4) = pre[m][bj][1] + acc[ai][bj][m][1] * alpha; } }
            asm volatile("" ::: "memory");
        }
    }
};
template <class Epi, class Sched, bool ALIGN_EPI = false, bool SP2 = false>
__device__ __forceinline__ void gemm_phase(PG8_LAS unsigned char* lds, const Gemm g, const Sched& S, const Epi& E, const int wave_in) {
    int tid_l; asm volatile("v_mbcnt_lo_u32_b32 %0, -1, 0\n\tv_mbcnt_hi_u32_b32 %0, -1, %0" : "=v"(tid_l)); tid_l += wave_in * 64;
    const int tid = tid_l, wid = __builtin_amdgcn_readfirstlane(tid >> 6), lane = tid & 63, wr = wid >> 2, wc = wid & 3, fr = lane & 15, fq = lane >> 4;
    const int K = g.K, nt = K / BK;
    unsigned voffA[2], voffB[2];
#pragma unroll
    for (int i = 0; i < 2; ++i) { int R, C; stage_rc(tid * 16 + i * 8192, R, C); const int Rb = Epi::PERM ? ((R & ~31) + perm32(R & 31)) : R;
        voffA[i] = (unsigned)(R * K + C) * 2u; voffB[i] = (unsigned)(Rb * K + C) * 2u; }
    const size_t kstep = (size_t)(BK * 2);
    const size_t hstep = (size_t)HALF * K * 2;
    const size_t tstep = 2 * hstep;
    const unsigned ldsw = (unsigned)wid * 1024u;
    const int aoff = lds_byte(wr * 64 + fr, fq * 8), boff = lds_byte(wc * 32 + fr, fq * 8);
#define PG8_SA(b, h) (((b) * 2 + (h)) * HTB)
#define PG8_SB(b, h) ((4 + (b) * 2 + (h)) * HTB)
#define PG8_STAGE(bufoff, gbase, voff) do { _Pragma("unroll") for (int _i = 0; _i < 2; ++_i) \
        __builtin_amdgcn_global_load_lds((const unsigned*)((const char*)(gbase) + (voff)[_i]), (PG8_LAS unsigned*)(lds + (bufoff) + ldsw + _i * 8192), 16, 0, 0); } while (0)
#define PG8_LDA(dst, b, h) do { _Pragma("unroll") for (int m = 0; m < 4; ++m) _Pragma("unroll") for (int k = 0; k < 2; ++k) dst[m][k] = *(const PG8_LAS bf16x8*)(lds + PG8_SA(b, h) + aoff + m * 2048 + k * 1024); } while (0)
#define PG8_LDB(dst, b, h) do { _Pragma("unroll") for (int n = 0; n < 2; ++n) _Pragma("unroll") for (int k = 0; k < 2; ++k) dst[n][k] = *(const PG8_LAS bf16x8*)(lds + PG8_SB(b, h) + boff + n * 2048 + k * 1024); } while (0)
#define PG8_MMA(ai, bj, At, Bt) do { __builtin_amdgcn_s_setprio(1); _Pragma("unroll") for (int m = 0; m < 4; ++m) _Pragma("unroll") for (int n = 0; n < 2; ++n) _Pragma("unroll") for (int k = 0; k < 2; ++k) \
        acc[ai][bj][m][n] = __builtin_amdgcn_mfma_f32_16x16x32_bf16(Bt[n][k], At[m][k], acc[ai][bj][m][n], 0, 0, 0); __builtin_amdgcn_s_setprio(0); } while (0)
#define PG8_WAIT_V(n) asm volatile("s_waitcnt vmcnt(" #n ")" ::: "memory")
#define PG8_WAIT_L(n) asm volatile("s_waitcnt lgkmcnt(" #n ")" ::: "memory")
#define PG8_BAR __builtin_amdgcn_s_barrier()
#define PG8_SCHED __builtin_amdgcn_sched_barrier(0)
    Unit cur, nxt; int ui = 0;
    if (!S.next(0, cur)) return;
    f32x4 acc[2][2][4][2];
#pragma unroll
    for (int a = 0; a < 2; ++a)
#pragma unroll
        for (int b = 0; b < 2; ++b)
#pragma unroll
            for (int m = 0; m < 4; ++m)
#pragma unroll
                for (int n = 0; n < 2; ++n) acc[a][b][m][n] = (f32x4){0.f, 0.f, 0.f, 0.f};
    bf16x8 At[4][2], B0[2][2], B1[2][2];
    const char* cA = (const char*)g.A + (size_t)cur.pm * tstep; const char* cB = (const char*)g.Bt + (size_t)cur.pn * tstep;
    S.a_ready(cur);
    if constexpr (SP2) {
        PG8_STAGE(PG8_SB(0, 0), cB, voffB); PG8_STAGE(PG8_SB(0, 1), cB + hstep, voffB); PG8_STAGE(PG8_SA(0, 0), cA, voffA); PG8_STAGE(PG8_SA(0, 1), cA + hstep, voffA);
        if (wr == 1) PG8_BAR;
        PG8_WAIT_V(2); PG8_BAR;
        PG8_STAGE(PG8_SB(1, 0), cB + kstep, voffB); PG8_STAGE(PG8_SA(1, 0), cA + kstep, voffA); PG8_STAGE(PG8_SB(1, 1), cB + hstep + kstep, voffB);
        PG8_WAIT_V(6); PG8_BAR;
    } else {
        PG8_STAGE(PG8_SB(0, 0), cB, voffB); PG8_STAGE(PG8_SA(0, 0), cA, voffA); PG8_STAGE(PG8_SB(0, 1), cB + hstep, voffB); PG8_STAGE(PG8_SA(0, 1), cA + hstep, voffA);
        if (wr == 1) PG8_BAR;
        PG8_WAIT_V(4); PG8_BAR;
        PG8_STAGE(PG8_SB(1, 0), cB + kstep, voffB); PG8_STAGE(PG8_SA(1, 0), cA + kstep, voffA); PG8_STAGE(PG8_SB(1, 1), cB + hstep + kstep, voffB);
        PG8_WAIT_V(6); PG8_BAR;
    }
    for (;;) {
        const bool has_next = S.next(ui + 1, nxt);
        const char* nA = has_next ? (const char*)g.A + (size_t)nxt.pm * tstep : cA; const char* nB = has_next ? (const char*)g.Bt + (size_t)nxt.pn * tstep : cB;
        for (int t = 0; t < nt; t += 2) {
            const bool last = (t == nt - 2);
            const char* a1 = cA + (size_t)(t + 1) * kstep;
            const char* a2 = last ? nA : cA + (size_t)(t + 2) * kstep; const char* b2 = last ? nB : cB + (size_t)(t + 2) * kstep;
            const char* a3 = a2 + kstep; const char* b3 = b2 + kstep;
            if (last && has_next) S.a_ready(nxt);
            if constexpr (SP2) {
            PG8_LDB(B0, 0, 0); PG8_LDB(B1, 0, 1); PG8_SCHED; PG8_LDA(At, 0, 0); PG8_STAGE(PG8_SA(1, 1), a1 + hstep, voffA);
            PG8_WAIT_V(8); PG8_WAIT_L(0); PG8_BAR; PG8_MMA(0, 0, At, B0); PG8_MMA(0, 1, At, B1); PG8_BAR; PG8_SCHED;
            PG8_LDA(At, 0, 1); PG8_STAGE(PG8_SB(0, 0), b2, voffB); PG8_STAGE(PG8_SB(0, 1), b2 + hstep, voffB); PG8_STAGE(PG8_SA(0, 0), a2, voffA);
            PG8_WAIT_V(8); PG8_WAIT_L(0); PG8_BAR; PG8_MMA(1, 0, At, B0); PG8_MMA(1, 1, At, B1); PG8_BAR; PG8_SCHED;
            PG8_LDB(B0, 1, 0); PG8_LDB(B1, 1, 1); PG8_SCHED; PG8_LDA(At, 1, 0); PG8_STAGE(PG8_SA(0, 1), a2 + hstep, voffA);
            PG8_WAIT_V(8); PG8_WAIT_L(0); PG8_BAR; PG8_MMA(0, 0, At, B0); PG8_MMA(0, 1, At, B1); PG8_BAR; PG8_SCHED;
            PG8_LDA(At, 1, 1); PG8_STAGE(PG8_SB(1, 0), b3, voffB); PG8_STAGE(PG8_SB(1, 1), b3 + hstep, voffB); PG8_STAGE(PG8_SA(1, 0), a3, voffA);
            PG8_WAIT_V(8); PG8_WAIT_L(0); PG8_BAR; PG8_MMA(1, 0, At, B0); PG8_MMA(1, 1, At, B1); PG8_BAR; PG8_SCHED;
            } else {
            PG8_LDB(B0, 0, 0); PG8_SCHED; PG8_LDA(At, 0, 0); PG8_STAGE(PG8_SA(1, 1), a1 + hstep, voffA);
            PG8_WAIT_L(8); PG8_BAR; PG8_WAIT_L(0); PG8_MMA(0, 0, At, B0); PG8_BAR; PG8_SCHED;
            PG8_LDB(B1, 0, 1); PG8_STAGE(PG8_SB(0, 0), b2, voffB);
            PG8_BAR; PG8_WAIT_L(0); PG8_MMA(0, 1, At, B1); PG8_BAR;
            PG8_LDA(At, 0, 1); PG8_STAGE(PG8_SA(0, 0), a2, voffA);
            PG8_BAR; PG8_WAIT_L(0); PG8_MMA(1, 0, At, B0); PG8_BAR; PG8_SCHED;
            PG8_STAGE(PG8_SB(0, 1), b2 + hstep, voffB);
            PG8_WAIT_V(6); PG8_BAR; PG8_MMA(1, 1, At, B1); PG8_BAR;
            PG8_LDB(B0, 1, 0); PG8_SCHED; PG8_LDA(At, 1, 0); PG8_STAGE(PG8_SA(0, 1), a2 + hstep, voffA);
            PG8_WAIT_L(8); PG8_BAR; PG8_WAIT_L(0); PG8_MMA(0, 0, At, B0); PG8_BAR; PG8_SCHED;
            PG8_LDB(B1, 1, 1); PG8_STAGE(PG8_SB(1, 0), b3, voffB);
            PG8_BAR; PG8_WAIT_L(0); PG8_MMA(0, 1, At, B1); PG8_BAR;
            PG8_LDA(At, 1, 1); PG8_STAGE(PG8_SA(1, 0), a3, voffA);
            PG8_BAR; PG8_WAIT_L(0); PG8_MMA(1, 0, At, B0); PG8_BAR; PG8_SCHED;
            PG8_STAGE(PG8_SB(1, 1), b3 + hstep, voffB);
            PG8_WAIT_V(6); PG8_BAR; PG8_MMA(1, 1, At, B1); PG8_BAR;
            }
        }
        if constexpr (ALIGN_EPI) { if (wr == 0) PG8_BAR; }
        if constexpr (!Epi::AFTER_DRAIN) { E(acc, cur, wr, wc, fr, fq); S.done(cur); }
        if (!has_next) break;
#pragma unroll
        for (int a = 0; a < 2; ++a)
#pragma unroll
            for (int b = 0; b < 2; ++b)
#pragma unroll
                for (int m = 0; m < 4; ++m)
#pragma unroll
                    for (int n = 0; n < 2; ++n) acc[a][b][m][n] = (f32x4){0.f, 0.f, 0.f, 0.f};
        cur = nxt; cA = nA; cB = nB; ++ui;
        if constexpr (ALIGN_EPI) { if (wr == 1) PG8_BAR; }
    }
    PG8_WAIT_V(0);
    if constexpr (!ALIGN_EPI) { if (wr == 0) PG8_BAR; }
    PG8_BAR;
    if constexpr (Epi::AFTER_DRAIN) { E.fused(acc, cur, wr, wc, fr, fq, lds, wid, lane); S.done(cur); }
#undef PG8_SA
#undef PG8_SB
#undef PG8_STAGE
#undef PG8_LDA
#undef PG8_LDB
#undef PG8_MMA
#undef PG8_WAIT_V
#undef PG8_WAIT_L
#undef PG8_BAR
#undef PG8_SCHED
}
}

#define LAS __attribute__((address_space(3)))
using pg8::ex2; using pg8::rcpf_;
typedef unsigned short u16;
typedef short bf16x8 __attribute__((ext_vector_type(8)));
typedef float f32x4 __attribute__((ext_vector_type(4)));
typedef float f32x16 __attribute__((ext_vector_type(16)));
typedef unsigned u32x4 __attribute__((ext_vector_type(4)));
typedef unsigned u32x2 __attribute__((ext_vector_type(2)));

constexpr int DM = 1024, NB = 16, SEQ = 2048, MTOK = NB * SEQ, DEPTH = 4, DFF = 2816, INW = 2840, PW = 3072;
constexpr int C_MQ = 0, C_MK = 256, C_MV = 512, C_DQ = 768, C_DK = 1024, C_DV = 1280, C_NQ = 1536, C_NKC = 2048, C_NVC = 2176, C_NKS = 2304, C_NVS = 2432, C_NKW = 2560, C_NVW = 2688, C_NG = 2816;
constexpr int NVH = 12;
constexpr float LOG2E = 1.4426950408889634f, NEGF = -1e30f;
constexpr int NPH_L = 14, NPH = NPH_L * DEPTH + 1;
constexpr size_t MiB = 1u << 20;
constexpr size_t WS_GU1 = 1 * MiB, WS_DN1 = 12 * MiB, WS_GU2 = WS_DN1 + 5 * MiB + MiB / 2, WS_DN2 = WS_GU2 + 11 * MiB, WS_WIN = 34 * MiB, WS_WOUT = 40 * MiB, WS_W1 = 42 * MiB;
constexpr size_t WS_PROJ = 44 * MiB, WS_XN = 236 * MiB, WS_VT = 300 * MiB, WS_HID = 348 * MiB, WS_KCMP = 352 * MiB, WS_VCMPT = WS_KCMP + MiB / 2, WS_KMEAN = 353 * MiB, WS_SEL = WS_KMEAN + MiB / 4, WS_END = 354 * MiB;
static_assert(WS_DN2 + 5 * MiB + MiB / 2 == WS_WIN, "ws map");
constexpr int LDS_BYTES = 147456, MISC_OFF = 147456 - 64;
constexpr size_t WS_CTL = 0, CTL_ZERO_BYTES = 65536;
constexpr int ATT_K = 0, ATT_V = 32768, ATT_LUT = 65536, ATT_PARK = 68608;
constexpr int CMP_K = 0, CMP_V = 18432, CMP_A = 36864, CMP_H = CMP_A + 256 * 33 * 4;

struct Params {
    const float* x; const float* rel_bias; const float* norm_ffn1; const float* ffn1_gate; const float* ffn1_up; const float* ffn1_down;
    const float* norm_mix; const float* w_in; const float* diff_lambda; const float* diff_subln; const float* cmp_pe; const float* cmp_w1; const float* cmp_w2;
    const float* w_out; const float* norm_ffn2; const float* ffn2_gate; const float* ffn2_up; const float* ffn2_down; const float* final_norm;
    float* out; unsigned char* ws;
    float lam_init[4];
    int ph_lo, ph_hi;
};
typedef const __attribute__((address_space(4))) Params* KParamsPtr;

__device__ __forceinline__ float bf2f(unsigned v) { return __uint_as_float(v << 16); }
typedef float f32x2_t __attribute__((ext_vector_type(2))); typedef __bf16 bf16x2_t __attribute__((ext_vector_type(2)));
__device__ __forceinline__ unsigned pkbf(float lo, float hi) { f32x2_t v = {lo, hi}; bf16x2_t b = __builtin_convertvector(v, bf16x2_t); return __builtin_bit_cast(unsigned, b); }
__device__ __forceinline__ int lane_opaque() { int l; asm volatile("v_mbcnt_lo_u32_b32 %0, -1, 0\n\tv_mbcnt_hi_u32_b32 %0, -1, %0" : "=v"(l)); return l; }
__device__ __forceinline__ float wave_sum(float v, int lane) {
#pragma unroll
    for (int o = 1; o < 64; o <<= 1) v += __int_as_float(__builtin_amdgcn_ds_bpermute((lane ^ o) << 2, __float_as_int(v)));
    return v;
}
__device__ __forceinline__ float xhalf_max(float v) { auto rr = __builtin_amdgcn_permlane32_swap(__float_as_uint(v), __float_as_uint(v), false, false); return fmaxf(__uint_as_float(rr[0]), __uint_as_float(rr[1])); }
__device__ __forceinline__ float xhalf_sum(float v) { auto rr = __builtin_amdgcn_permlane32_swap(__float_as_uint(v), __float_as_uint(v), false, false); return __uint_as_float(rr[0]) + __uint_as_float(rr[1]); }
__device__ __forceinline__ float sigmoid_f(float x) { return rcpf_(1.0f + ex2(-LOG2E * x)); }
__device__ __forceinline__ int crow(int r, int hi) { return (r & 3) + 8 * (r >> 2) + 4 * hi; }
__device__ __forceinline__ int kperm(int p) { const int h = p >> 3, j = p & 7; return 8 * (j >> 2) + 4 * h + (j & 3); }
__device__ __forceinline__ int pperm(int k) { return ((k >> 2) & 1) * 8 + (k >> 3) * 4 + (k & 3); }

__device__ __forceinline__ void tr_item(const float* W, int K, int N, u16* WT, int kb, int n0, int dst_row0, LAS float* scr, int lane, float cs = 1.0f) {
    const int k0 = 64 * kb; const int n = n0 + (lane & 31); const bool ok = n < N;
#pragma unroll 8
    for (int i = 0; i < 32; ++i) { const int kk = 2 * i + (lane >> 5); scr[kk * 33 + (lane & 31)] = ok ? W[(size_t)(k0 + kk) * N + n] * cs : 0.f; }
    asm volatile("s_waitcnt lgkmcnt(0)" ::: "memory");
    const int c = lane & 7;
#pragma unroll
    for (int j = 0; j < 4; ++j) { const int nn = (lane >> 3) + 8 * j; const LAS float* s = scr + (8 * c) * 33 + nn;
        u32x4 o; o.x = pkbf(s[0 * 33], s[1 * 33]); o.y = pkbf(s[2 * 33], s[3 * 33]); o.z = pkbf(s[4 * 33], s[5 * 33]); o.w = pkbf(s[6 * 33], s[7 * 33]);
        *(u32x4*)(WT + (size_t)(dst_row0 + nn) * K + k0 + 8 * c) = o; }
    asm volatile("s_waitcnt lgkmcnt(0)" ::: "memory");
}

__device__ __forceinline__ void norm_row(const float* xrow, const float* g, u16* dst16, float* dst32, int lane) {
    const f32x4* xr = (const f32x4*)xrow + lane; const f32x4* gr = (const f32x4*)g + lane;
    f32x4 v[4]; float s = 0.f;
#pragma unroll
    for (int j = 0; j < 4; ++j) { v[j] = xr[64 * j]; s += (v[j].x * v[j].x + v[j].y * v[j].y) + (v[j].z * v[j].z + v[j].w * v[j].w); }
    const float rstd = 1.0f / sqrtf(wave_sum(s, lane) * (1.0f / 1024.0f) + 1e-6f);
#pragma unroll
    for (int j = 0; j < 4; ++j) { const f32x4 gg = gr[64 * j]; const f32x4 y = v[j] * rstd * gg;
        if (dst16) { u32x2 o; o.x = pkbf(y.x, y.y); o.y = pkbf(y.z, y.w); *((u32x2*)dst16 + lane + 64 * j) = o; }
        else *((f32x4*)dst32 + lane + 64 * j) = y; }
}

struct AState { f32x16 o0, o1; float m, l; };
__device__ __forceinline__ void astate_init(AState& s) {
#pragma unroll
    for (int r = 0; r < 16; ++r) { s.o0[r] = 0.f; s.o1[r] = 0.f; }
    s.m = 0.f; s.l = 0.f;
}
constexpr float ATT_THR = 8.0f;
constexpr int ATT_SLOT = 9216, ATT_NSLOT = 3;
template <int KS0, int NKS>
__device__ __forceinline__ void qk_block(const LAS unsigned char* Ks, const bf16x8 (&qr)[4], int r32, int hi, f32x16& s0, f32x16& s1) {
    f32x16 ci;
#pragma unroll
    for (int r = 0; r < 16; ++r) ci[r] = 0.f;
    const LAS unsigned char* kp = Ks + hi * 1024 + r32 * 16;
#pragma unroll
    for (int ks = 0; ks < NKS; ++ks) {
        const bf16x8 a0 = *(const LAS bf16x8*)(kp + (KS0 + ks) * 2048);
        const bf16x8 a1 = *(const LAS bf16x8*)(kp + (KS0 + ks) * 2048 + 512);
        s0 = __builtin_amdgcn_mfma_f32_32x32x16_bf16(a0, qr[KS0 + ks], ks == 0 ? ci : s0, 0, 0, 0);
        s1 = __builtin_amdgcn_mfma_f32_32x32x16_bf16(a1, qr[KS0 + ks], ks == 0 ? ci : s1, 0, 0, 0);
    }
    __builtin_amdgcn_sched_group_barrier(0x100, 2 * NKS, 0); __builtin_amdgcn_sched_group_barrier(0x008, 2 * NKS, 0);
}
__device__ __forceinline__ void pv_block(const LAS unsigned char* Vs, const u32x4 (&pk)[4], int r32, int hi, AState& st) {
    const LAS unsigned char* vp = Vs + hi * 1024 + r32 * 16;
#pragma unroll
    for (int c = 0; c < 4; ++c) {
        const bf16x8 v0 = *(const LAS bf16x8*)(vp + c * 2048);
        const bf16x8 v1 = *(const LAS bf16x8*)(vp + c * 2048 + 512);
        const bf16x8 pb = __builtin_bit_cast(bf16x8, pk[c]);
        st.o0 = __builtin_amdgcn_mfma_f32_32x32x16_bf16(v0, pb, st.o0, 0, 0, 0);
        st.o1 = __builtin_amdgcn_mfma_f32_32x32x16_bf16(v1, pb, st.o1, 0, 0, 0);
    }
    __builtin_amdgcn_sched_group_barrier(0x100, 8, 0); __builtin_amdgcn_sched_group_barrier(0x008, 8, 0);
}
__device__ __forceinline__ void glds16(const void* gsrc, unsigned lds_dst) { unsigned keep;
    asm volatile("s_mov_b32 %0, m0\n\ts_mov_b32 m0, %2\n\ts_nop 0\n\tglobal_load_lds_dwordx4 %1, off\n\ts_mov_b32 m0, %0" : "=&s"(keep) : "v"(gsrc), "s"(lds_dst) : "memory"); }
__device__ __forceinline__ void lut_add(f32x16& s0, f32x16& s1, const LAS float* lutz, int dbase, float cc) {
    const LAS float* lp = lutz + (dbase - 59);
#pragma unroll
    for (int r = 0; r < 16; ++r) { const int ko = (r & 3) + 8 * (r >> 2);
        s0[r] += lp[59 - ko] + cc; s1[r] += lp[27 - ko] + cc; }
}
__device__ __forceinline__ void const_add(f32x16& s0, f32x16& s1, float cc) {
#pragma unroll
    for (int r = 0; r < 16; ++r) { s0[r] += cc; s1[r] += cc; }
}
__device__ __forceinline__ float row_max(const f32x16& s0, const f32x16& s1) {
    float mx = fmaxf(s0[0], s1[0]);
#pragma unroll
    for (int r = 1; r < 16; ++r) mx = fmaxf(mx, fmaxf(s0[r], s1[r]));
    return xhalf_max(mx);
}
__device__ __forceinline__ void rescale(AState& st, f32x16& s0, f32x16& s1, float mx) {
    const float dl = fmaxf(mx, 0.f); const float f = ex2(-dl); st.m += dl; st.l *= f;
#pragma unroll
    for (int r = 0; r < 16; ++r) { st.o0[r] *= f; st.o1[r] *= f; s0[r] -= dl; s1[r] -= dl; }
}
__device__ __forceinline__ void exp_pack(f32x16& s0, f32x16& s1, u32x4 (&pk)[4], AState& st) {
    float sum = 0.f;
#pragma unroll
    for (int r = 0; r < 16; ++r) { s0[r] = ex2(s0[r]); s1[r] = ex2(s1[r]); sum += s0[r] + s1[r]; }
    st.l += sum;
    pk[0] = (u32x4){pkbf(s0[0], s0[1]), pkbf(s0[2], s0[3]), pkbf(s0[4], s0[5]), pkbf(s0[6], s0[7])};
    pk[1] = (u32x4){pkbf(s0[8], s0[9]), pkbf(s0[10], s0[11]), pkbf(s0[12], s0[13]), pkbf(s0[14], s0[15])};
    pk[2] = (u32x4){pkbf(s1[0], s1[1]), pkbf(s1[2], s1[3]), pkbf(s1[4], s1[5]), pkbf(s1[6], s1[7])};
    pk[3] = (u32x4){pkbf(s1[8], s1[9]), pkbf(s1[10], s1[11]), pkbf(s1[12], s1[13]), pkbf(s1[14], s1[15])};
}

template <int KS0, int NKS, bool WINDOW, int MODE>
__device__ __forceinline__ void run_tiles(LAS unsigned char* lds, int t0, int t1, const u16* Kg, const u16* Vtg, const bf16x8 (&qr)[4], float c31,
                                          int q0w, unsigned mask, int qb, AState& A, int wave, int lane, int r32, int hi) {
    LAS unsigned char* Kr = lds + ATT_K; LAS unsigned char* Vr = lds + ATT_V; const LAS float* lut1 = (const LAS float*)(lds + ATT_LUT) + 96;
    const u16* ksrc = Kg + (size_t)lane * PW + wave * 8;
    const u16* vsrc = Vtg + (size_t)lane * SEQ + wave * 8;
    const unsigned kdst = (unsigned)(uintptr_t)Kr + wave * 1024, vdst = (unsigned)(uintptr_t)Vr + wave * 1024;
#define TCL(t) ((t) < t0 ? t0 : ((t) > t1 ? t1 : (t)))
#define DMA_K(tn) glds16(ksrc + (size_t)TCL(tn) * 64 * PW, (unsigned)__builtin_amdgcn_readfirstlane(kdst + ((tn) & 3) * 8192))
#define DMA_V(tn) glds16(vsrc + TCL(tn) * 64, (unsigned)__builtin_amdgcn_readfirstlane(vdst + ((tn) & 3) * 8192))
#define KS_(t) (Kr + ((t) & 3) * 8192)
#define VS_(t) (Vr + ((t) & 3) * 8192)
#define WAIT_BAR4() asm volatile("s_waitcnt vmcnt(4) lgkmcnt(0)\n\ts_barrier" ::: "memory")
#define T_ACTIVE(t) (!((q0w + 31 - (t) * 64) < 0 || (WINDOW && (q0w - ((t) * 64 + 63)) >= 512)))
#define T_LUTMODE(t) (((q0w - ((t) * 64 + 63)) < 128) || (WINDOW && (q0w + 31 - (t) * 64) >= 512))
    auto tile_sel = [&](int t) -> int { if (MODE == 1) { const int blk = t >> 2; return blk < qb ? (int)((mask >> blk) & 1u) : 1; } if (MODE == 2) return (int)((mask >> t) & 1u); return 1; };
    asm volatile("s_waitcnt vmcnt(0)" ::: "memory");
#pragma unroll
    for (int j = 0; j < 4; ++j) { DMA_K(t0 + j); DMA_V(t0 + j - 2); }
    WAIT_BAR4();
    f32x16 sn0, sn1, sc0, sc1; u32x4 pk[4];
#pragma unroll
    for (int r = 0; r < 16; ++r) { sn0[r] = 0.f; sn1[r] = 0.f; }
#pragma unroll
    for (int i = 0; i < 4; ++i) pk[i] = (u32x4){0u, 0u, 0u, 0u};
    bool act_n = T_ACTIVE(t0), act_c = false, act_p = false;
    if (act_n) qk_block<KS0, NKS>(KS_(t0), qr, r32, hi, sn0, sn1);
    asm volatile("s_waitcnt lgkmcnt(0)\n\ts_barrier" ::: "memory");
    for (int c = t0; c <= t1 + 1; ++c) {
        act_p = act_c; act_c = act_n; sc0 = sn0; sc1 = sn1;
        DMA_K(c + 4); DMA_V(c + 2);
        act_n = (c + 1 <= t1) && T_ACTIVE(c + 1);
        const bool lm_c = T_LUTMODE(c);
        const int dbase = q0w + r32 - c * 64 - 4 * hi;
        const float selc = tile_sel(c) ? (lm_c ? 0.f : c31) : NEGF;
        if (act_p) pv_block(VS_(c - 1), pk, r32, hi, A);
        if (act_c) {
            if (lm_c) lut_add(sc0, sc1, lut1, dbase, selc - A.m); else const_add(sc0, sc1, selc - A.m);
            const float mx = row_max(sc0, sc1);
            if (__any(mx > ATT_THR)) rescale(A, sc0, sc1, mx);
        }
        if (act_n) qk_block<KS0, NKS>(KS_(c + 1), qr, r32, hi, sn0, sn1);
        if (act_c) exp_pack(sc0, sc1, pk, A);
        WAIT_BAR4();
    }
    asm volatile("s_waitcnt vmcnt(0) lgkmcnt(0)\n\ts_barrier" ::: "memory");
#undef TCL
#undef DMA_K
#undef DMA_V
#undef KS_
#undef VS_
#undef WAIT_BAR4
#undef T_ACTIVE
#undef T_LUTMODE
}

__device__ __forceinline__ void build_lut(LAS unsigned char* lds, const float* rel_bias, int head, bool window, int tid) {
    LAS float* lut = (LAS float*)(lds + ATT_LUT);
    for (int i = tid; i < 704; i += 512) {
        const int d = i - 96; float v;
        if (d < 0) v = NEGF;
        else if (d >= 512) v = window ? NEGF : rel_bias[31 * 16 + head] * LOG2E;
        else { int bk;
            if (d < 16) bk = d; else if (d >= 128) bk = 31; else { bk = 16 + (int)(log2f((float)d * (1.0f / 16.0f)) * (16.0f / 3.0f)); bk = bk > 31 ? 31 : bk; }
            v = rel_bias[bk * 16 + head] * LOG2E; }
        lut[i] = v;
    }
}
__device__ __forceinline__ void load_q(bf16x8 (&qr)[4], const u16* qrow, int hi) {
#pragma unroll
    for (int ks = 0; ks < 4; ++ks) qr[ks] = *(const bf16x8*)(qrow + ks * 16 + hi * 8);
}
__device__ __forceinline__ void store_o(u16* dst, const f32x16& v0, const f32x16& v1, int hi) {
#pragma unroll
    for (int g = 0; g < 4; ++g) {
        u32x2 a; a.x = pkbf(v0[4 * g], v0[4 * g + 1]); a.y = pkbf(v0[4 * g + 2], v0[4 * g + 3]); *(u32x2*)(dst + 8 * g + 4 * hi) = a;
        u32x2 b; b.x = pkbf(v1[4 * g], v1[4 * g + 1]); b.y = pkbf(v1[4 * g + 2], v1[4 * g + 3]); *(u32x2*)(dst + 32 + 8 * g + 4 * hi) = b;
    }
}

struct Ctx { LAS unsigned char* lds; int tid, lane, wave, r32, hi, G, bx; u16* proj; u16* obuf; u16* vt; };

__device__ __forceinline__ void moba_unit(const Ctx& C0, KParamsPtr P, int b, int h, int qb) {
    Ctx C = C0; C.lane = lane_opaque(); C.tid = C.wave * 64 + C.lane; C.r32 = C.lane & 31; C.hi = C.lane >> 5;
    const int q0w = __builtin_amdgcn_readfirstlane(qb * 256 + C.wave * 32); const int qpos = q0w + C.r32; const size_t tok = (size_t)b * SEQ + qpos;
    build_lut(C.lds, P->rel_bias, h, false, C.tid);
    const u16* qrow = C.proj + tok * PW + C_MQ + h * 64;
    bf16x8 qr[4]; load_q(qr, qrow, C.hi);
    unsigned mask = 0;
    if (qb > 0) {
        float g[7];
#pragma unroll
        for (int j = 0; j < 7; ++j) g[j] = 0.f;
        const float* km = (const float*)(P->ws + WS_KMEAN) + (size_t)((b * 4 + h) * 8) * 64;
#pragma unroll
        for (int dc = 0; dc < 8; ++dc) {
            const u32x4 qv = *(const u32x4*)(qrow + dc * 8);
            float qf[8]; qf[0] = bf2f(qv.x & 0xffffu); qf[1] = bf2f(qv.x >> 16); qf[2] = bf2f(qv.y & 0xffffu); qf[3] = bf2f(qv.y >> 16);
            qf[4] = bf2f(qv.z & 0xffffu); qf[5] = bf2f(qv.z >> 16); qf[6] = bf2f(qv.w & 0xffffu); qf[7] = bf2f(qv.w >> 16);
#pragma unroll
            for (int j = 0; j < 7; ++j) if (j < qb) { const float* kmj = km + j * 64 + dc * 8;
#pragma unroll
                for (int e = 0; e < 8; ++e) g[j] = fmaf(qf[e], kmj[e], g[j]); }
        }
#pragma unroll
        for (int j = 0; j < 7; ++j) if (j < qb) { int rank = 0;
#pragma unroll
            for (int i = 0; i < 7; ++i) if (i != j && i < qb) rank += (g[i] > g[j] || (g[i] == g[j] && i < j)) ? 1 : 0;
            if (rank < 3) mask |= 1u << j; }
    }
    AState A; astate_init(A);
    const float c31 = P->rel_bias[31 * 16 + h] * LOG2E;
    run_tiles<0, 4, false, 1>(C.lds, 0, 4 * qb + 3, C.proj + (size_t)b * SEQ * PW + C_MK + h * 64, C.vt + (size_t)((b * NVH + h) * 64) * SEQ, qr, c31, q0w, mask, qb, A, C.wave, C.lane, C.r32, C.hi);
    const float inv = rcpf_(xhalf_sum(A.l));
    A.o0 *= inv; A.o1 *= inv;
    { const int l2 = lane_opaque(); const size_t tok2 = (size_t)b * SEQ + q0w + (l2 & 31);
      store_o(C.obuf + tok2 * DM + h * 64, A.o0, A.o1, l2 >> 5); }
}

__device__ __forceinline__ void diff_unit(const Ctx& C0, KParamsPtr P, int layer, int b, int h, int qb) {
    Ctx C = C0; C.lane = lane_opaque(); C.tid = C.wave * 64 + C.lane; C.r32 = C.lane & 31; C.hi = C.lane >> 5;
    const int q0w = __builtin_amdgcn_readfirstlane(qb * 256 + C.wave * 32); const int qpos = q0w + C.r32; const size_t tok = (size_t)b * SEQ + qpos;
    build_lut(C.lds, P->rel_bias, 4 + h, false, C.tid);
    bf16x8 qr[4]; load_q(qr, C.proj + tok * PW + C_DQ + h * 64, C.hi);
    AState A; astate_init(A);
    const float c31 = P->rel_bias[31 * 16 + 4 + h] * LOG2E;
    const u16* Kg = C.proj + (size_t)b * SEQ * PW + C_DK + h * 64; const u16* Vg = C.vt + (size_t)((b * NVH + 4 + h) * 64) * SEQ;
    run_tiles<0, 2, false, 0>(C.lds, 0, 4 * qb + 3, Kg, Vg, qr, c31, q0w, 0u, 0, A, C.wave, C.lane, C.r32, C.hi);
    LAS float* park = (LAS float*)(C.lds + ATT_PARK) + C.tid;
    { const float i0 = rcpf_(xhalf_sum(A.l));
#pragma unroll
      for (int r = 0; r < 16; ++r) { park[r * 512] = A.o0[r] * i0; park[(16 + r) * 512] = A.o1[r] * i0; } }
    astate_init(A);
    run_tiles<2, 2, false, 0>(C.lds, 0, 4 * qb + 3, Kg, Vg, qr, c31, q0w, 0u, 0, A, C.wave, C.lane, C.r32, C.hi);
    const float* lp = P->diff_lambda + (size_t)layer * 128; float d01 = 0.f, d23 = 0.f;
    for (int i = 0; i < 32; ++i) { d01 = fmaf(lp[i], lp[32 + i], d01); d23 = fmaf(lp[64 + i], lp[96 + i], d23); }
    const float li = P->lam_init[layer]; const float lam = expf(d01) - expf(d23) + li;
    const float i1 = lam * rcpf_(xhalf_sum(A.l));
    float ss = 0.f;
#pragma unroll
    for (int r = 0; r < 16; ++r) { A.o0[r] = park[r * 512] - A.o0[r] * i1; A.o1[r] = park[(16 + r) * 512] - A.o1[r] * i1; ss += A.o0[r] * A.o0[r] + A.o1[r] * A.o1[r]; }
    ss = xhalf_sum(ss);
    const float rstd = (1.0f / sqrtf(ss * (1.0f / 64.0f) + 1e-6f)) * (1.0f - li);
    const float* sg = P->diff_subln + (size_t)layer * 64;
#pragma unroll
    for (int r = 0; r < 16; ++r) { const int d = crow(r, C.hi); A.o0[r] *= rstd * sg[d]; A.o1[r] *= rstd * sg[32 + d]; }
    { const int l2 = lane_opaque(); const size_t tok2 = (size_t)b * SEQ + q0w + (l2 & 31);
      store_o(C.obuf + tok2 * DM + 256 + h * 64, A.o0, A.o1, l2 >> 5); }
}

__device__ __forceinline__ void nsa_unit(const Ctx& C0, KParamsPtr P, int b, int hq, int qb) {
    Ctx C = C0; C.lane = lane_opaque(); C.tid = C.wave * 64 + C.lane; C.r32 = C.lane & 31; C.hi = C.lane >> 5;
    const int g = hq >> 2;
    const int q0w = __builtin_amdgcn_readfirstlane(qb * 256 + C.wave * 32); const int qpos = q0w + C.r32; const size_t tok = (size_t)b * SEQ + qpos;
    build_lut(C.lds, P->rel_bias, 8 + hq, false, C.tid);
    bf16x8 qr[4]; load_q(qr, C.proj + tok * PW + C_NQ + hq * 64, C.hi);
    const u16* gl = C.proj + tok * PW + C_NG + hq * 3;
    const float g1 = sigmoid_f(bf2f(gl[1])), g2 = sigmoid_f(bf2f(gl[2]));
    const unsigned mask = ((const unsigned*)(P->ws + WS_SEL))[(size_t)(b * 2 + g) * SEQ + qpos];
    const float c31 = P->rel_bias[31 * 16 + 8 + hq] * LOG2E;
    AState A; astate_init(A);
    run_tiles<0, 4, false, 2>(C.lds, 0, 4 * qb + 3, C.proj + (size_t)b * SEQ * PW + C_NKS + g * 64, C.vt + (size_t)((b * NVH + 8 + g) * 64) * SEQ, qr, c31, q0w, mask, qb, A, C.wave, C.lane, C.r32, C.hi);
    LAS float* park = (LAS float*)(C.lds + ATT_PARK) + C.tid;
    { const float f = g1 * rcpf_(xhalf_sum(A.l));
#pragma unroll
      for (int r = 0; r < 16; ++r) { park[r * 512] = A.o0[r] * f; park[(16 + r) * 512] = A.o1[r] * f; } }
    if (C.tid < 96) ((LAS float*)(C.lds + ATT_LUT))[608 + C.tid] = NEGF;
    astate_init(A);
    const int tw0 = 4 * qb - 8 < 0 ? 0 : 4 * qb - 8;
    run_tiles<0, 4, true, 0>(C.lds, tw0, 4 * qb + 3, C.proj + (size_t)b * SEQ * PW + C_NKW + g * 64, C.vt + (size_t)((b * NVH + 10 + g) * 64) * SEQ, qr, c31, q0w, 0u, qb, A, C.wave, C.lane, C.r32, C.hi);
    { const float f = g2 * rcpf_(xhalf_sum(A.l));
#pragma unroll
      for (int r = 0; r < 16; ++r) { A.o0[r] = A.o0[r] * f + park[r * 512]; A.o1[r] = A.o1[r] * f + park[(16 + r) * 512]; } }
    const int l2 = lane_opaque(); const int hi2 = l2 >> 5;
    u16* dst = C.obuf + ((size_t)b * SEQ + q0w + (l2 & 31)) * DM + 512 + hq * 64;
#pragma unroll
    for (int gg = 0; gg < 4; ++gg) {
        const u32x2 a = *(const u32x2*)(dst + 8 * gg + 4 * hi2), bq = *(const u32x2*)(dst + 32 + 8 * gg + 4 * hi2);
        A.o0[4 * gg] += bf2f(a.x & 0xffffu); A.o0[4 * gg + 1] += bf2f(a.x >> 16); A.o0[4 * gg + 2] += bf2f(a.y & 0xffffu); A.o0[4 * gg + 3] += bf2f(a.y >> 16);
        A.o1[4 * gg] += bf2f(bq.x & 0xffffu); A.o1[4 * gg + 1] += bf2f(bq.x >> 16); A.o1[4 * gg + 2] += bf2f(bq.y & 0xffffu); A.o1[4 * gg + 3] += bf2f(bq.y >> 16);
    }
    store_o(dst, A.o0, A.o1, hi2);
}

__device__ __forceinline__ void cmp_unit(const Ctx& C0, KParamsPtr P, int b, int g, int qblk) {
    Ctx C = C0; C.lane = lane_opaque(); C.tid = C.wave * 64 + C.lane; C.r32 = C.lane & 31; C.hi = C.lane >> 5;
    LAS unsigned char* lds = C.lds; const int tid = C.tid, r32 = C.r32, hi = C.hi;
    const u16* kc = (const u16*)(P->ws + WS_KCMP) + (size_t)(b * 2 + g) * 128 * 64;
    const u16* vc = (const u16*)(P->ws + WS_VCMPT) + (size_t)(b * 2 + g) * 64 * 128;
#pragma unroll
    for (int i = 0; i < 2; ++i) { const int e = tid + 512 * i;
        { const int row = e >> 3, ch = e & 7; *(LAS u32x4*)(lds + CMP_K + row * 144 + ch * 16) = *(const u32x4*)(kc + row * 64 + ch * 8); }
        { const int row = e >> 4, ch = e & 15; *(LAS u32x4*)(lds + CMP_V + row * 272 + ch * 16) = *(const u32x4*)(vc + row * 128 + ch * 8); } }
    const int q0w = __builtin_amdgcn_readfirstlane(qblk * 256 + C.wave * 32); const int qpos = q0w + r32; const size_t tok = (size_t)b * SEQ + qpos;
    const int nmax = (qpos - 31) >> 4;
    __syncthreads();
    float qa[16], qh[16];
#pragma unroll
    for (int i = 0; i < 16; ++i) { qa[i] = 0.f; qh[i] = 0.f; }
    const LAS unsigned char* kp = lds + CMP_K + r32 * 144 + hi * 16;
    const LAS unsigned char* vp = lds + CMP_V + r32 * 272 + hi * 16;
    for (int rh = 0; rh < 4; ++rh) {
        const int hq = g * 4 + rh;
        bf16x8 qr[4]; load_q(qr, C.proj + tok * PW + C_NQ + hq * 64, hi);
        const float g0 = sigmoid_f(bf2f(C.proj[tok * PW + C_NG + hq * 3]));
        f32x16 s[4];
#pragma unroll
        for (int kb = 0; kb < 4; ++kb) {
#pragma unroll
            for (int r = 0; r < 16; ++r) s[kb][r] = 0.f;
#pragma unroll
            for (int ks = 0; ks < 4; ++ks) { const bf16x8 a = *(const LAS bf16x8*)(kp + kb * 32 * 144 + ks * 32); s[kb] = __builtin_amdgcn_mfma_f32_32x32x16_bf16(a, qr[ks], s[kb], 0, 0, 0); }
        }
        float mx = NEGF;
#pragma unroll
        for (int kb = 0; kb < 4; ++kb)
#pragma unroll
            for (int r = 0; r < 16; ++r) { const int n = 32 * kb + crow(r, hi); const float v = (n <= nmax) ? s[kb][r] : NEGF; s[kb][r] = v; mx = fmaxf(mx, v); }
        mx = xhalf_max(mx);
        float sum = 0.f;
#pragma unroll
        for (int kb = 0; kb < 4; ++kb)
#pragma unroll
            for (int r = 0; r < 16; ++r) { const int n = 32 * kb + crow(r, hi); const float pv = (n <= nmax) ? ex2(s[kb][r] - mx) : 0.f; s[kb][r] = pv; sum += pv; }
        sum = xhalf_sum(sum);
        const float inv = nmax >= 0 ? rcpf_(sum) : 0.f;
        f32x16 o0, o1;
#pragma unroll
        for (int r = 0; r < 16; ++r) { o0[r] = 0.f; o1[r] = 0.f; }
#pragma unroll
        for (int kb = 0; kb < 4; ++kb) {
#pragma unroll
            for (int r = 0; r < 16; ++r) s[kb][r] *= inv;
#pragma unroll
            for (int g4 = 0; g4 < 4; ++g4) { const float h = 0.5f * s[kb][4 * g4 + 3]; qh[kb * 4 + g4] += h; qa[kb * 4 + g4] += (s[kb][4 * g4] + s[kb][4 * g4 + 1]) + (s[kb][4 * g4 + 2] + h); }
#pragma unroll
            for (int c = 0; c < 2; ++c) {
                const u32x4 pk = (u32x4){pkbf(s[kb][8 * c], s[kb][8 * c + 1]), pkbf(s[kb][8 * c + 2], s[kb][8 * c + 3]), pkbf(s[kb][8 * c + 4], s[kb][8 * c + 5]), pkbf(s[kb][8 * c + 6], s[kb][8 * c + 7])};
                const bf16x8 pb = __builtin_bit_cast(bf16x8, pk);
                const bf16x8 v0 = *(const LAS bf16x8*)(vp + (kb * 2 + c) * 32);
                const bf16x8 v1 = *(const LAS bf16x8*)(vp + 32 * 272 + (kb * 2 + c) * 32);
                o0 = __builtin_amdgcn_mfma_f32_32x32x16_bf16(v0, pb, o0, 0, 0, 0);
                o1 = __builtin_amdgcn_mfma_f32_32x32x16_bf16(v1, pb, o1, 0, 0, 0);
            }
            __builtin_amdgcn_sched_barrier(0);
        }
        o0 *= g0; o1 *= g0;
        store_o(C.obuf + tok * DM + 512 + hq * 64, o0, o1, hi);
    }
    LAS float* Aq = (LAS float*)(lds + CMP_A) + (C.wave * 32 + r32) * 33; LAS float* Hq = (LAS float*)(lds + CMP_H) + (C.wave * 32 + r32) * 33;
#pragma unroll
    for (int kb = 0; kb < 4; ++kb)
#pragma unroll
        for (int g4 = 0; g4 < 4; ++g4) { const int j = 8 * kb + 2 * g4 + hi; Aq[j] = qa[kb * 4 + g4]; Hq[j] = qh[kb * 4 + g4]; }
    __syncthreads();
    const int cur = q0w >> 6;
    unsigned bits = 0;
    if (cur < 16) bits = (2u << cur) - 1u;
    else {
        for (int e = 0; e < 16; ++e) { const int j = hi * 16 + e; if (j > 0 && j <= cur - 2) Aq[j] += Hq[j - 1]; }
        asm volatile("s_waitcnt lgkmcnt(0)" ::: "memory");
        for (int e = 0; e < 16; ++e) { const int j = hi * 16 + e;
            if (j <= cur) { const float sj = (j == 0 || j > cur - 2) ? 1e4f : Aq[j]; int rank = 0;
                for (int i = 0; i <= cur; ++i) { const float si = (i == 0 || i > cur - 2) ? 1e4f : Aq[i]; rank += (si > sj || (si == sj && i < j)) ? 1 : 0; }
                if (rank < 16) bits |= 1u << j; } }
        { auto rr = __builtin_amdgcn_permlane32_swap(bits, bits, false, false); bits = rr[0] | rr[1]; }
    }
    if (hi == 0) ((unsigned*)(P->ws + WS_SEL))[(size_t)(b * 2 + g) * SEQ + qpos] = bits;
    __syncthreads();
}

__device__ __forceinline__ void prep_vk(const Ctx& C, KParamsPtr P, int b0) {
    const int G = C.G - b0, bxr = C.bx - b0, tid = C.tid, lane = C.lane;
    if (bxr < 0) return;
    for (int it = bxr; it < NB * NVH * 32; it += G) {
        const int tb = it & 31, hv = (it >> 5) % NVH, b = it / (32 * NVH);
        const int vcol = hv < 4 ? C_MV + hv * 64 : hv < 8 ? C_DV + (hv - 4) * 64 : hv < 10 ? C_NVS + (hv - 8) * 64 : C_NVW + (hv - 10) * 64;
        { const int row = tid >> 3, ch = tid & 7; *(LAS u32x4*)(C.lds + row * 144 + ch * 16) = *(const u32x4*)(C.proj + ((size_t)b * SEQ + tb * 64 + row) * PW + vcol + ch * 8); }
        __syncthreads();
        { const int d = tid >> 3, pc = tid & 7; unsigned w[4];
#pragma unroll
            for (int e = 0; e < 4; ++e) { const int p0 = pc * 8 + 2 * e, p1 = p0 + 1; const int k0 = (p0 & ~15) + kperm(p0 & 15), k1 = (p1 & ~15) + kperm(p1 & 15);
                const unsigned a = *(const LAS u16*)(C.lds + k0 * 144 + d * 2), bb = *(const LAS u16*)(C.lds + k1 * 144 + d * 2); w[e] = a | (bb << 16); }
            *(u32x4*)(C.vt + ((size_t)(b * NVH + hv) * 64 + d) * SEQ + tb * 64 + pc * 8) = (u32x4){w[0], w[1], w[2], w[3]}; }
        __syncthreads();
    }
    const int gw = bxr * 8 + C.wave, NGW = G * 8;
    for (int it = gw; it < NB * 4 * 8; it += NGW) {
        const int blk = it & 7, h = (it >> 3) & 3, b = it >> 5;
        const u16* kp = C.proj + ((size_t)b * SEQ + blk * 256) * PW + C_MK + h * 64 + lane; float s = 0.f;
        for (int k = 0; k < 256; k += 8) { float t[8];
#pragma unroll
            for (int e = 0; e < 8; ++e) t[e] = bf2f(kp[(size_t)(k + e) * PW]);
            s += ((t[0] + t[1]) + (t[2] + t[3])) + ((t[4] + t[5]) + (t[6] + t[7])); }
        ((float*)(P->ws + WS_KMEAN))[(size_t)it * 64 + lane] = s * (1.0f / 256.0f);
    }
}
__device__ __forceinline__ void prep_a(const Ctx& C, KParamsPtr P, int layer) {
    const int G = C.G, lane = C.lane;
    const int gw = C.bx * 8 + C.wave, NGW = G * 8;
    u16* acmp = (u16*)(P->ws + WS_XN);
    for (int it = gw; it < 2 * 4096; it += NGW) {
        const int i = it >> 12, row = it & 4095, n = row & 127, bg = row >> 7, b = bg >> 1, g = bg & 1;
        u16* dst = acmp + (size_t)it * 2048; const float* pe = P->cmp_pe + (size_t)(layer * 2 + i) * 2048;
        const int col = (i == 0 ? C_NKC : C_NVC) + g * 64;
#pragma unroll
        for (int pass = 0; pass < 4; ++pass) { const int l = pass * 8 + (lane >> 3), d0 = (lane & 7) * 8;
            unsigned z0 = 0u; asm volatile("" : "+v"(z0)); u32x4 o = (u32x4){z0, z0, z0, z0};
            if (n < 127) { const u32x4 v = *(const u32x4*)(C.proj + ((size_t)b * SEQ + 16 * n + l) * PW + col + d0); const f32x4 e0 = *(const f32x4*)(pe + l * 64 + d0), e1 = *(const f32x4*)(pe + l * 64 + d0 + 4);
                o.x = pkbf(bf2f(v.x & 0xffffu) + e0.x, bf2f(v.x >> 16) + e0.y); o.y = pkbf(bf2f(v.y & 0xffffu) + e0.z, bf2f(v.y >> 16) + e0.w);
                o.z = pkbf(bf2f(v.z & 0xffffu) + e1.x, bf2f(v.z >> 16) + e1.y); o.w = pkbf(bf2f(v.w & 0xffffu) + e1.z, bf2f(v.w >> 16) + e1.w); }
            *(u32x4*)(dst + l * 64 + d0) = o; }
    }
}
__device__ __forceinline__ void prep_c(const Ctx& C, KParamsPtr P, int layer, int it0) {
    const int i = it0 >> 12, row0 = it0 & 4095, lane = lane_opaque(), tid = C.wave * 64 + lane, r32 = lane & 31, hi = lane >> 5;
    const float* w2 = P->cmp_w2 + (size_t)(layer * 2 + i) * 256 * 64;
    for (int e = tid; e < 256 * 64; e += 512) { const int k = e >> 6, c = e & 63; *(LAS u16*)(C.lds + c * 528 + k * 2) = (u16)(pkbf(w2[e], 0.f) & 0xffffu); }
    __syncthreads();
    const int wrow = row0 + C.wave * 32;
    const u16* hrow = (const u16*)(P->ws + WS_HID) + ((size_t)i * 4096 + wrow + r32) * 256 + hi * 8;
    f32x16 d0, d1;
#pragma unroll
    for (int r = 0; r < 16; ++r) { d0[r] = 0.f; d1[r] = 0.f; }
#pragma unroll 4
    for (int ks = 0; ks < 16; ++ks) {
        const bf16x8 a = *(const bf16x8*)(hrow + ks * 16);
        const bf16x8 b0 = *(const LAS bf16x8*)(C.lds + r32 * 528 + (ks * 16 + hi * 8) * 2);
        const bf16x8 b1 = *(const LAS bf16x8*)(C.lds + (32 + r32) * 528 + (ks * 16 + hi * 8) * 2);
        d0 = __builtin_amdgcn_mfma_f32_32x32x16_bf16(a, b0, d0, 0, 0, 0);
        d1 = __builtin_amdgcn_mfma_f32_32x32x16_bf16(a, b1, d1, 0, 0, 0);
    }
#pragma unroll
    for (int r = 0; r < 16; ++r) { const int row = wrow + crow(r, hi);
        const unsigned v0 = pkbf(d0[r], 0.f) & 0xffffu, v1 = pkbf(d1[r], 0.f) & 0xffffu;
        if (i == 0) { u16* o = (u16*)(P->ws + WS_KCMP) + (size_t)row * 64; o[r32] = (u16)v0; o[32 + r32] = (u16)v1; }
        else { const int bg = row >> 7, n = row & 127; u16* o = (u16*)(P->ws + WS_VCMPT) + (size_t)bg * 64 * 128 + (n & ~15) + pperm(n & 15); o[(size_t)r32 * 128] = (u16)v0; o[(size_t)(32 + r32) * 128] = (u16)v1; }
    }
}

__device__ __forceinline__ void convert_weights(const Ctx& C, KParamsPtr P, int layer) {
    LAS float* scr = (LAS float*)(C.lds + C.wave * 16384);
    const int gw = C.bx * 8 + C.wave, NGW = C.G * 8, lane = C.lane;
    constexpr int I_G = 16 * 88, I_D = 44 * 32, I_IN = 16 * 96, I_O = 16 * 32, I_W1 = 32 * 8;
    constexpr int NIT = 4 * I_G + 2 * I_D + I_IN + I_O + 2 * I_W1;
    unsigned char* ws = P->ws;
    for (int it = gw; it < NIT; it += NGW) {
        int r = it;
        if (r < 4 * I_G) { const int which = r / I_G; r -= which * I_G; const int kb = r / 88, nb = r % 88, n0 = nb * 32;
            const float* W = (which == 0 ? P->ffn1_gate : which == 1 ? P->ffn1_up : which == 2 ? P->ffn2_gate : P->ffn2_up) + (size_t)layer * DM * DFF;
            u16* WT = (u16*)(ws + (which < 2 ? WS_GU1 : WS_GU2));
            tr_item(W, DM, DFF, WT, kb, n0, (n0 >> 7) * 256 + (which & 1) * 128 + (n0 & 127), scr, lane); continue; }
        r -= 4 * I_G;
        if (r < 2 * I_D) { const int which = r / I_D; r -= which * I_D; const int kb = r / 32, nb = r % 32;
            const float* W = (which == 0 ? P->ffn1_down : P->ffn2_down) + (size_t)layer * DFF * DM;
            tr_item(W, DFF, DM, (u16*)(ws + (which == 0 ? WS_DN1 : WS_DN2)), kb, nb * 32, nb * 32, scr, lane); continue; }
        r -= 2 * I_D;
        if (r < I_IN) { const int kb = r / 96, nb = r % 96, n0 = nb * 32;
            const float cs = (n0 < C_MK || (n0 >= C_NQ && n0 < C_NKC)) ? 0.125f * LOG2E : (n0 >= C_DQ && n0 < C_DK) ? 0.17677669529663687f * LOG2E : 1.0f;
            tr_item(P->w_in + (size_t)layer * DM * INW, DM, INW, (u16*)(ws + WS_WIN), kb, n0, n0, scr, lane, cs); continue; }
        r -= I_IN;
        if (r < I_O) { const int kb = r / 32, nb = r % 32; tr_item(P->w_out + (size_t)layer * DM * DM, DM, DM, (u16*)(ws + WS_WOUT), kb, nb * 32, nb * 32, scr, lane); continue; }
        r -= I_O;
        { const int i = r / I_W1; r -= i * I_W1; const int kb = r / 8, nb = r % 8;
            tr_item(P->cmp_w1 + (size_t)(layer * 2 + i) * 2048 * 256, 2048, 256, (u16*)(ws + WS_W1) + (size_t)i * 256 * 2048, kb, nb * 32, nb * 32, scr, lane); }
    }
}
__device__ __forceinline__ void norm_phase(const Ctx& C, const float* src, const float* g, u16* dst16, float* dst32) {
    const int gw = C.bx * 8 + C.wave, NGW = C.G * 8;
    for (int m = gw; m < MTOK; m += NGW) norm_row(src + (size_t)m * DM, g, dst16 ? dst16 + (size_t)m * DM : nullptr, dst32 ? dst32 + (size_t)m * DM : nullptr, C.lane);
}

#define XB_TMO      128
#define XB_XCNT(j)  (256  + 64 * (j))
#define XB_XSUB(j)  (1280 + 64 * (j))
#define XB_XGEN(j)  (2304 + 64 * (j))
#define XB_TOP      3328
#define XB_TOPGEN   3392
#define XCD_BAR_WORDS 3456
#define XB_SPIN_CAP (1u << 18)

__device__ __forceinline__ unsigned xb_ld(unsigned* p)              { return __hip_atomic_load(p, __ATOMIC_RELAXED, __HIP_MEMORY_SCOPE_AGENT); }
__device__ __forceinline__ unsigned xb_add(unsigned* p, unsigned v) { return __hip_atomic_fetch_add(p, v, __ATOMIC_RELAXED, __HIP_MEMORY_SCOPE_AGENT); }
__device__ __forceinline__ unsigned xb_xcc_id() { return (unsigned)__builtin_amdgcn_s_getreg((3 << 11) | 20) & 0xFu; }
#define XB_SPIN(cond, bar) do { unsigned _sp = 0; while (cond) { __builtin_amdgcn_s_sleep(1); \
    if ((++_sp & 255u) == 0u) { if (xb_ld(&(bar)[XB_TMO])) break; if (_sp > XB_SPIN_CAP) { atomicAdd(&(bar)[XB_TMO], 1u); break; } } } } while (0)

struct XcdBarrier {
    unsigned* bar; unsigned x;
    volatile LAS unsigned* st;
};

__device__ __forceinline__ XcdBarrier xcd_barrier_post(unsigned* bar, volatile LAS unsigned* st) {
    XcdBarrier b; b.bar = bar; b.x = xb_xcc_id(); b.st = st;
    if (threadIdx.x == 0) (void)xb_add(&bar[XB_XCNT(b.x)], 1u);
    return b;
}
__device__ __forceinline__ void xcd_barrier_complete(unsigned* bar, unsigned x, unsigned& nloc, unsigned& nx) {
    const unsigned G = gridDim.x * gridDim.y * gridDim.z;
    unsigned sum, cnt, mine, sp = 0u;
    for (;;) {
        sum = 0u; cnt = 0u; mine = 0u;
#pragma unroll
        for (unsigned j = 0; j < 16; ++j) { const unsigned c = xb_ld(&bar[XB_XCNT(j)]); sum += c; cnt += (c > 0u) ? 1u : 0u; mine = (j == x) ? c : mine; }
        if (sum == G) break;
        __builtin_amdgcn_s_sleep(1);
        if ((++sp & 255u) == 0u) { if (xb_ld(&bar[XB_TMO])) break; if (sp > XB_SPIN_CAP) { atomicAdd(&bar[XB_TMO], 1u); break; } }
    }
    nloc = mine > 0u ? mine : 1u; nx = cnt > 0u ? cnt : 1u;
}

__device__ __forceinline__ void xcd_barrier(const XcdBarrier& b) {
    asm volatile("s_waitcnt vmcnt(0)" ::: "memory");
    __syncthreads();
    if (threadIdx.x == 0) {
        unsigned* bar = b.bar;
        __builtin_amdgcn_s_waitcnt(0);
        unsigned nloc = b.st[0], nx = b.st[1];
        if (nloc == 0u) { xcd_barrier_complete(bar, b.x, nloc, nx); b.st[0] = nloc; b.st[1] = nx; }
        const unsigned old = xb_add(&bar[XB_XSUB(b.x)], 1u);
        const unsigned gen = old / nloc;
        if (old + 1u == (gen + 1u) * nloc) {
            __builtin_amdgcn_fence(__ATOMIC_RELEASE, "agent");
            asm volatile("s_waitcnt vmcnt(0)" ::: "memory");
            const unsigned og = xb_add(&bar[XB_TOP], 1u);
            const unsigned tg = og / nx;
            if (og + 1u == (tg + 1u) * nx) xb_add(&bar[XB_TOPGEN], 1u);
            else XB_SPIN(xb_ld(&bar[XB_TOPGEN]) == tg, bar);
            __builtin_amdgcn_fence(__ATOMIC_ACQUIRE, "agent");
            xb_add(&bar[XB_XGEN(b.x)], 1u);
            asm volatile("s_waitcnt vmcnt(0)" ::: "memory");
        } else {
            XB_SPIN(xb_ld(&bar[XB_XGEN(b.x)]) == gen, bar);
            __builtin_amdgcn_fence(__ATOMIC_ACQUIRE, "agent");
            asm volatile("s_waitcnt vmcnt(0)" ::: "memory");
        }
    }
    __syncthreads();
}


struct OneUnit { int pm;
    __device__ __forceinline__ bool next(int i, pg8::Unit& u) const { if (i) return false; u.pm = pm; u.pn = 0; return true; }
    __device__ __forceinline__ void a_ready(const pg8::Unit&) const {}
    __device__ __forceinline__ void done(const pg8::Unit&) const {} };
__global__ void __launch_bounds__(512, 2) hybrid_fwd(Params P0) {
    extern __shared__ __attribute__((aligned(16))) unsigned char lds_raw[];
    const KParamsPtr kp0 = (KParamsPtr)__builtin_amdgcn_kernarg_segment_ptr();
    cg::grid_group grid = cg::this_grid();
    { volatile LAS unsigned* misc = (volatile LAS unsigned*)((LAS unsigned char*)lds_raw + MISC_OFF); if (threadIdx.x < 2) misc[threadIdx.x] = 0u; }
    __syncthreads();
    XcdBarrier bar = xcd_barrier_post((unsigned*)(P0.ws + WS_CTL) + 1024, (volatile LAS unsigned*)((LAS unsigned char*)lds_raw + MISC_OFF));
    const int ph_lo = P0.ph_lo, ph_hi = P0.ph_hi; const int wave_s = __builtin_amdgcn_readfirstlane(threadIdx.x >> 6);
    bool redone = false; (void)redone;
    for (int ph = ph_lo; ph < ph_hi; ++ph) {
        KParamsPtr kpl = kp0; asm volatile("" : "+s"(kpl));
        const KParamsPtr P = kpl; unsigned char* ws = P->ws;
        u16* XN = (u16*)(ws + WS_XN); u16* HB = (u16*)(ws + WS_PROJ);
        int G = gridDim.x, bx = blockIdx.x; asm volatile("" : "+s"(G), "+s"(bx));
        Ctx C; C.G = G; C.bx = bx; C.lds = (LAS unsigned char*)lds_raw; C.wave = wave_s; C.lane = lane_opaque(); C.tid = wave_s * 64 + C.lane; C.r32 = C.lane & 31; C.hi = C.lane >> 5;
        C.proj = (u16*)(ws + WS_PROJ); C.obuf = (u16*)(ws + WS_XN); C.vt = (u16*)(ws + WS_VT);
        const int layer = ph / NPH_L, s = ph % NPH_L;
        if (ph != NPH - 1 && s == 7) continue;
        if (ph == NPH - 1) { norm_phase(C, P->out, P->final_norm, nullptr, P->out); }
        else switch (s) {
        case 0: { convert_weights(C, P, layer); __syncthreads(); norm_phase(C, layer == 0 ? P->x : P->out, P->norm_ffn1 + (size_t)layer * DM, XN, nullptr); } break;
        case 3: { norm_phase(C, P->out, P->norm_mix + (size_t)layer * DM, XN, nullptr); } break;
        case 11: { norm_phase(C, P->out, P->norm_ffn2 + (size_t)layer * DM, XN, nullptr); } break;
#ifndef NO_GEMM
#ifndef NO_G1
        case 1: case 12: {
            pg8::Gemm g{XN, (const u16*)(ws + (s == 1 ? WS_GU1 : WS_GU2)), MTOK, 2 * DFF, DM}; pg8::StaticOrder S; S.init(MTOK, 2 * DFF, G, bx);
            pg8::EpiSwiGLU E{HB, DFF};
            pg8::gemm_phase<pg8::EpiSwiGLU, pg8::StaticOrder, true, true>(C.lds, g, S, E, C.wave); } break;
#endif
#ifndef NO_G2
        case 2: case 13: case 10: {
            const u16* A = (s == 10) ? (const u16*)XN : (const u16*)HB; const u16* Bt = (const u16*)(ws + (s == 2 ? WS_DN1 : s == 13 ? WS_DN2 : WS_WOUT));
            pg8::Gemm g{A, Bt, MTOK, DM, s == 10 ? DM : DFF}; pg8::StaticOrder S; S.init(MTOK, DM, G, bx);
            pg8::EpiResid E{(layer == 0 && s == 2) ? P->x : (const float*)P->out, P->out, DM, s == 10 ? 1.0f : 0.5f};
            pg8::gemm_phase<pg8::EpiResid, pg8::StaticOrder, true, true>(C.lds, g, S, E, C.wave); } break;
#endif
#ifndef NO_G4
        case 4: {
            pg8::Gemm g{XN, (const u16*)(ws + WS_WIN), MTOK, PW, DM}; pg8::StaticOrder S; S.init(MTOK, PW, G, bx);
            pg8::EpiBf16<0> E{C.proj, PW};
            pg8::gemm_phase<pg8::EpiBf16<0>, pg8::StaticOrder, true, true>(C.lds, g, S, E, C.wave); } break;
#endif
#endif
#ifndef NO_PREP
        case 5: prep_a(C, P, layer); prep_vk(C, P, 0); break;
#endif
#if !defined(NO_GEMM) && !defined(NO_G6)
        case 6: {
            unsigned* qctr = (unsigned*)(ws + WS_CTL) + 8192 + 64 * ph + (redone ? 32 : 0); volatile LAS unsigned* qslot = (volatile LAS unsigned*)(C.lds + MISC_OFF + 16);
            for (;;) {
                if (C.tid == 0) *qslot = __hip_atomic_fetch_add(qctr, 1u, __ATOMIC_RELAXED, __HIP_MEMORY_SCOPE_AGENT);
                __syncthreads();
                const unsigned u = *qslot;
                __syncthreads();
                if (u >= 32u + 1024u) break;
                if (u < 32u) { const int i = (int)u >> 4, tile = (int)u & 15;
                    pg8::Gemm g{(const u16*)XN + (size_t)i * 4096 * 2048, (const u16*)(ws + WS_W1) + (size_t)i * 256 * 2048, 4096, 256, 2048}; OneUnit S{tile};
                    pg8::EpiBf16<1> E{(u16*)(ws + WS_HID) + (size_t)i * 4096 * 256, 256};
                    pg8::gemm_phase<pg8::EpiBf16<1>, OneUnit, true, true>(C.lds, g, S, E, C.wave);
                    __builtin_amdgcn_fence(__ATOMIC_RELEASE, "agent"); __syncthreads(); __builtin_amdgcn_fence(__ATOMIC_ACQUIRE, "agent");
                    prep_c(C, P, layer, i * 4096 + tile * 256);
                    __syncthreads();
                } else { const unsigned v = u - 32u; const int qb = 7 - (int)(v >> 7), w = (int)(v & 127);
                    if (w < 64) {
#ifndef NO_DIFF
                        diff_unit(C, P, layer, w >> 2, w & 3, qb);
#endif
                    } else {
#ifndef NO_MOBA
                        moba_unit(C, P, (w - 64) >> 2, w & 3, qb);
#endif
                    } }
            } } break;
#endif
#ifndef NO_ATT1
        case 8: {
#ifndef NO_CMP
            for (int c = bx; c < 256; c += G) cmp_unit(C, P, c >> 4, (c >> 3) & 1, c & 7);
#endif
            } break;
#endif
#ifndef NO_ATT2
        case 9: {
            unsigned* qctr = (unsigned*)(ws + WS_CTL) + 8192 + 64 * ph; volatile LAS unsigned* qslot = (volatile LAS unsigned*)(C.lds + MISC_OFF + 16);
            for (;;) {
                if (C.tid == 0) *qslot = __hip_atomic_fetch_add(qctr, 1u, __ATOMIC_RELAXED, __HIP_MEMORY_SCOPE_AGENT);
                __syncthreads();
                const unsigned u = *qslot;
                __syncthreads();
                if (u >= 1024u) break;
                nsa_unit(C, P, (int)(u & 127) >> 3, (int)u & 7, 7 - (int)(u >> 7));
            } } break;
#endif
        default: break;
        }
        if (ph + 1 < ph_hi) { if (ph == ph_lo) grid.sync(); else xcd_barrier(bar); }
#ifdef PROBE_LO
        if (ph != NPH - 1 && s == PROBE_HI) { if (!redone) { ph -= (PROBE_HI - PROBE_LO + 1); redone = true; } else redone = false; }
#endif
#ifdef PROBE_SYNC
        if (ph + 1 < ph_hi) xcd_barrier(bar);
#endif
    }
}

#ifndef COOP
#define COOP 1
#endif
extern "C" void kernel_launch(void* const* d_in, const int* in_sizes, int n_in, void* d_out, int out_size, void* d_ws, size_t ws_size, hipStream_t stream) {
    static int grid = 0;
    if (grid == 0) {
        if (n_in != 19 || out_size != MTOK * DM || ws_size < WS_END) { fprintf(stderr, "kernel_launch: unexpected shapes (n_in %d out %d ws %zu)\n", n_in, out_size, ws_size); grid = -1; return; }
        int dev = 0, cus = 0, per_cu = 0;
        (void)hipGetDevice(&dev); (void)hipDeviceGetAttribute(&cus, hipDeviceAttributeMultiprocessorCount, dev);
        if (hipFuncSetAttribute((const void*)hybrid_fwd, hipFuncAttributeMaxDynamicSharedMemorySize, LDS_BYTES) != hipSuccess) { fprintf(stderr, "kernel_launch: hipFuncSetAttribute failed\n"); grid = -1; return; }
        if (hipOccupancyMaxActiveBlocksPerMultiprocessor(&per_cu, (const void*)hybrid_fwd, 512, LDS_BYTES) != hipSuccess || per_cu < 1) { fprintf(stderr, "kernel_launch: occupancy query says %d\n", per_cu); per_cu = 1; }
        (void)hipGetLastError();
        grid = cus * per_cu;
    }
    if (grid < 0) return;
    Params p{};
    p.x = (const float*)d_in[0]; p.rel_bias = (const float*)d_in[1]; p.norm_ffn1 = (const float*)d_in[2]; p.ffn1_gate = (const float*)d_in[3]; p.ffn1_up = (const float*)d_in[4]; p.ffn1_down = (const float*)d_in[5];
    p.norm_mix = (const float*)d_in[6]; p.w_in = (const float*)d_in[7]; p.diff_lambda = (const float*)d_in[8]; p.diff_subln = (const float*)d_in[9]; p.cmp_pe = (const float*)d_in[10]; p.cmp_w1 = (const float*)d_in[11];
    p.cmp_w2 = (const float*)d_in[12]; p.w_out = (const float*)d_in[13]; p.norm_ffn2 = (const float*)d_in[14]; p.ffn2_gate = (const float*)d_in[15]; p.ffn2_up = (const float*)d_in[16]; p.ffn2_down = (const float*)d_in[17];
    p.final_norm = (const float*)d_in[18]; p.out = (float*)d_out; p.ws = (unsigned char*)d_ws;
    for (int l = 0; l < 4; ++l) p.lam_init[l] = (float)(0.8 - 0.6 * exp(-0.3 * (double)l));
#if COOP
    if (hipMemsetAsync((char*)d_ws + WS_CTL, 0, CTL_ZERO_BYTES, stream) != hipSuccess) { fprintf(stderr, "kernel_launch: memset of barrier words failed\n"); return; }
    p.ph_lo = 0; p.ph_hi = NPH;
    void* args[] = {&p};
    hipError_t e = hipLaunchCooperativeKernel((const void*)hybrid_fwd, dim3(grid), dim3(512), args, LDS_BYTES, stream);
    if (e != hipSuccess) fprintf(stderr, "cooperative launch failed: %s (grid %d)\n", hipGetErrorString(e), grid);
#else
    for (int ph = 0; ph < NPH; ++ph) { p.ph_lo = ph; p.ph_hi = ph + 1; hipLaunchKernelGGL(hybrid_fwd, dim3(grid), dim3(512), LDS_BYTES, stream, p); }
#endif
}
```

```cpp
#include <hip/hip_runtime.h>
#include <hip/hip_cooperative_groups.h>
#include <cstdio>
#include <cstdint>
#include <cmath>
namespace cg = cooperative_groups;
#define COOP 1
namespace pg8 {
#define PG8_LAS __attribute__((address_space(3)))
typedef unsigned short bf16_t;
typedef short bf16x8 __attribute__((ext_vector_type(8)));
typedef float f32x4 __attribute__((ext_vector_type(4)));
typedef unsigned u32x4 __attribute__((ext_vector_type(4)));
constexpr int BM = 256, BK = 64, HALF = 128, HTB = HALF * BK * 2  , STAGE_BYTES = 8 * HTB, NXCD = 8, WGM = 8;

__host__ __device__ __forceinline__ int lds_byte(int r, int c) { const int st = (r >> 4) * 2 + (c >> 5), rr = r & 15, cc = c & 31, ob = rr * 64 + cc * 2; return st * 1024 + (ob ^ (((ob >> 9) & 1) << 5)); }
__host__ __device__ __forceinline__ void stage_rc(int b, int& R, int& C) { const int st = b / 1024, sb = b % 1024, swz = sb ^ (((sb >> 9) & 1) << 5); R = (st >> 1) * 16 + swz / 64; C = (st & 1) * 32 + (swz % 64) / 2; }
__host__ __device__ __forceinline__ int perm32(int rho) { const int n = rho >> 4, i = rho & 15; return 8 * (i >> 2) + 4 * n + (i & 3); }

struct Unit { int pm, pn; };
struct Gemm { const bf16_t* A; const bf16_t* Bt; int M, N, K; };

struct StaticOrder {
    int nM, nN, nwg, G, c;
    __host__ __device__ void init(int M, int N, int G_, int c_) { nM = M / BM; nN = N / BM; nwg = nM * nN; G = G_; c = c_; }
    __host__ __device__ bool next(int i, Unit& u) const {
        const long L = (long)i * G + c; if (L >= nwg) return false;
        int wgid = (int)L; { const int q = nwg / NXCD, r = nwg % NXCD, xcd = wgid % NXCD, off = wgid / NXCD; wgid = (xcd < r ? xcd * (q + 1) : r * (q + 1) + (xcd - r) * q) + off; }
        const int nig = WGM * nN, gid = wgid / nig, fm = gid * WGM, gsz = (nM - fm) < WGM ? (nM - fm) : WGM;
        u.pm = fm + ((wgid % nig) % gsz); u.pn = (wgid % nig) / gsz; return true;
    }
    __device__ __forceinline__ void a_ready(const Unit&) const {}
    __device__ __forceinline__ void done(const Unit&) const {}
};

__device__ __forceinline__ unsigned cvt_pk_bf16(float lo, float hi) { unsigned r; asm volatile("v_cvt_pk_bf16_f32 %0, %1, %2" : "=v"(r) : "v"(lo), "v"(hi)); return r; }

__device__ __forceinline__ float ex2(float x) { return __builtin_amdgcn_exp2f(x); }
__device__ __forceinline__ float rcpf_(float x) { return __builtin_amdgcn_rcpf(x); }
__device__ __forceinline__ float silu_f(float x) { return x * rcpf_(1.0f + ex2(-1.4426950408889634f * x)); }
__device__ __forceinline__ float gelu_tanh_f(float x) { const float y2 = 2.0f * 0.7978845608028654f * (x + 0.044715f * x * x * x); return x * (1.0f - rcpf_(1.0f + ex2(1.4426950408889634f * y2))); }

struct EpiSwiGLU {
    static constexpr bool PERM = true, AFTER_DRAIN = false;
    bf16_t* O; int ldc;
    __device__ __forceinline__ void operator()(const f32x4 (&acc)[2][2][4][2], const Unit& u, int wr, int wc, int fr, int fq) const {
        const int row0 = u.pm * BM + wr * 64 + fr; const int col0 = u.pn * HALF + wc * 32 + 8 * fq;
#pragma unroll
        for (int ai = 0; ai < 2; ++ai)
#pragma unroll
            for (int m = 0; m < 4; ++m) { bf16_t* rowp = O + (size_t)(row0 + ai * HALF + m * 16) * ldc + col0;
                const f32x4 g0 = acc[ai][0][m][0], g1 = acc[ai][0][m][1], u0 = acc[ai][1][m][0], u1 = acc[ai][1][m][1];
                u32x4 w; w.x = cvt_pk_bf16(silu_f(g0[0]) * u0[0], silu_f(g0[1]) * u0[1]); w.y = cvt_pk_bf16(silu_f(g0[2]) * u0[2], silu_f(g0[3]) * u0[3]);
                w.z = cvt_pk_bf16(silu_f(g1[0]) * u1[0], silu_f(g1[1]) * u1[1]); w.w = cvt_pk_bf16(silu_f(g1[2]) * u1[2], silu_f(g1[3]) * u1[3]);
                *(u32x4*)rowp = w; asm volatile("" ::: "memory"); }
    }
};
template <int ACT> struct EpiBf16 {
    static constexpr bool PERM = true, AFTER_DRAIN = false;
    bf16_t* O; int ldc;
    __device__ __forceinline__ void operator()(const f32x4 (&acc)[2][2][4][2], const Unit& u, int wr, int wc, int fr, int fq) const {
        const int row0 = u.pm * BM + wr * 64 + fr; const int col0 = u.pn * BM + wc * 32 + 8 * fq;
#pragma unroll
        for (int ai = 0; ai < 2; ++ai)
#pragma unroll
            for (int m = 0; m < 4; ++m) { bf16_t* rowp = O + (size_t)(row0 + ai * HALF + m * 16) * ldc + col0;
#pragma unroll
                for (int bj = 0; bj < 2; ++bj) { f32x4 v0 = acc[ai][bj][m][0], v1 = acc[ai][bj][m][1];
                    if (ACT == 1) { v0 = (f32x4){gelu_tanh_f(v0[0]), gelu_tanh_f(v0[1]), gelu_tanh_f(v0[2]), gelu_tanh_f(v0[3])}; v1 = (f32x4){gelu_tanh_f(v1[0]), gelu_tanh_f(v1[1]), gelu_tanh_f(v1[2]), gelu_tanh_f(v1[3])}; }
                    u32x4 w; w.x = cvt_pk_bf16(v0[0], v0[1]); w.y = cvt_pk_bf16(v0[2], v0[3]); w.z = cvt_pk_bf16(v1[0], v1[1]); w.w = cvt_pk_bf16(v1[2], v1[3]);
                    *(u32x4*)(rowp + bj * HALF) = w; } asm volatile("" ::: "memory"); }
    }
};
struct EpiResid {
    static constexpr bool PERM = true, AFTER_DRAIN = false;
    const float* base; float* out; int ldc; float alpha;
    __device__ __forceinline__ void operator()(const f32x4 (&acc)[2][2][4][2], const Unit& u, int wr, int wc, int fr, int fq) const {
        const int row0 = u.pm * BM + wr * 64 + fr; const int col0 = u.pn * BM + wc * 32 + 8 * fq;
#pragma unroll
        for (int ai = 0; ai < 2; ++ai) {
            f32x4 pre[4][2][2];
#pragma unroll
            for (int m = 0; m < 4; ++m)
#pragma unroll
                for (int bj = 0; bj < 2; ++bj)
#pragma unroll
                    for (int n = 0; n < 2; ++n) pre[m][bj][n] = *(const f32x4*)(base + (size_t)(row0 + ai * HALF + m * 16) * ldc + col0 + bj * HALF + n * 4);
#pragma unroll
            for (int m = 0; m < 4; ++m) { const size_t off = (size_t)(row0 + ai * HALF + m * 16) * ldc + col0;
#pragma unroll
                for (int bj = 0; bj < 2; ++bj) { *(f32x4*)(out + off + bj * HALF) = pre[m][bj][0] + acc[ai][bj][m][0] * alpha; *(f32x4*)(out + off + bj * HALF + 4) = pre[m][bj][1] + acc[ai][bj][m][1] * alpha; } }
            asm volatile("" ::: "memory");
        }
    }
};
template <class Epi, class Sched, bool ALIGN_EPI = false, bool SP2 = false>
__device__ __forceinline__ void gemm_phase(PG8_LAS unsigned char* lds, const Gemm g, const Sched& S, const Epi& E, const int wave_in) {
    int tid_l; asm volatile("v_mbcnt_lo_u32_b32 %0, -1, 0\n\tv_mbcnt_hi_u32_b32 %0, -1, %0" : "=v"(tid_l)); tid_l += wave_in * 64;
    const int tid = tid_l, wid = __builtin_amdgcn_readfirstlane(tid >> 6), lane = tid & 63, wr = wid >> 2, wc = wid & 3, fr = lane & 15, fq = lane >> 4;
    const int K = g.K, nt = K / BK;
    unsigned voffA[2], voffB[2];
#pragma unroll
    for (int i = 0; i < 2; ++i) { int R, C; stage_rc(tid * 16 + i * 8192, R, C); const int Rb = Epi::PERM ? ((R & ~31) + perm32(R & 31)) : R;
        voffA[i] = (unsigned)(R * K + C) * 2u; voffB[i] = (unsigned)(Rb * K + C) * 2u; }
    const size_t kstep = (size_t)(BK * 2);
    const size_t hstep = (size_t)HALF * K * 2;
    const size_t tstep = 2 * hstep;
    const unsigned ldsw = (unsigned)wid * 1024u;
    const int aoff = lds_byte(wr * 64 + fr, fq * 8), boff = lds_byte(wc * 32 + fr, fq * 8);
#define PG8_SA(b, h) (((b) * 2 + (h)) * HTB)
#define PG8_SB(b, h) ((4 + (b) * 2 + (h)) * HTB)
#define PG8_STAGE(bufoff, gbase, voff) do { _Pragma("unroll") for (int _i = 0; _i < 2; ++_i) \
        __builtin_amdgcn_global_load_lds((const unsigned*)((const char*)(gbase) + (voff)[_i]), (PG8_LAS unsigned*)(lds + (bufoff) + ldsw + _i * 8192), 16, 0, 0); } while (0)
#define PG8_LDA(dst, b, h) do { _Pragma("unroll") for (int m = 0; m < 4; ++m) _Pragma("unroll") for (int k = 0; k < 2; ++k) dst[m][k] = *(const PG8_LAS bf16x8*)(lds + PG8_SA(b, h) + aoff + m * 2048 + k * 1024); } while (0)
#define PG8_LDB(dst, b, h) do { _Pragma("unroll") for (int n = 0; n < 2; ++n) _Pragma("unroll") for (int k = 0; k < 2; ++k) dst[n][k] = *(const PG8_LAS bf16x8*)(lds + PG8_SB(b, h) + boff + n * 2048 + k * 1024); } while (0)
#define PG8_MMA(ai, bj, At, Bt) do { __builtin_amdgcn_s_setprio(1); _Pragma("unroll") for (int m = 0; m < 4; ++m) _Pragma("unroll") for (int n = 0; n < 2; ++n) _Pragma("unroll") for (int k = 0; k < 2; ++k) \
        acc[ai][bj][m][n] = __builtin_amdgcn_mfma_f32_16x16x32_bf16(Bt[n][k], At[m][k], acc[ai][bj][m][n], 0, 0, 0); __builtin_amdgcn_s_setprio(0); } while (0)
#define PG8_WAIT_V(n) asm volatile("s_waitcnt vmcnt(" #n ")" ::: "memory")
#define PG8_WAIT_L(n) asm volatile("s_waitcnt lgkmcnt(" #n ")" ::: "memory")
#define PG8_BAR __builtin_amdgcn_s_barrier()
#define PG8_SCHED __builtin_amdgcn_sched_barrier(0)
    Unit cur, nxt; int ui = 0;
    if (!S.next(0, cur)) return;
    f32x4 acc[2][2][4][2];
#pragma unroll
    for (int a = 0; a < 2; ++a)
#pragma unroll
        for (int b = 0; b < 2; ++b)
#pragma unroll
            for (int m = 0; m < 4; ++m)
#pragma unroll
                for (int n = 0; n < 2; ++n) acc[a][b][m][n] = (f32x4){0.f, 0.f, 0.f, 0.f};
    bf16x8 At[4][2], B0[2][2], B1[2][2];
    const char* cA = (const char*)g.A + (size_t)cur.pm * tstep; const char* cB = (const char*)g.Bt + (size_t)cur.pn * tstep;
    S.a_ready(cur);
    if constexpr (SP2) {
        PG8_STAGE(PG8_SB(0, 0), cB, voffB); PG8_STAGE(PG8_SB(0, 1), cB + hstep, voffB); PG8_STAGE(PG8_SA(0, 0), cA, voffA); PG8_STAGE(PG8_SA(0, 1), cA + hstep, voffA);
        if (wr == 1) PG8_BAR;
        PG8_WAIT_V(2); PG8_BAR;
        PG8_STAGE(PG8_SB(1, 0), cB + kstep, voffB); PG8_STAGE(PG8_SA(1, 0), cA + kstep, voffA); PG8_STAGE(PG8_SB(1, 1), cB + hstep + kstep, voffB);
        PG8_WAIT_V(6); PG8_BAR;
    } else {
        PG8_STAGE(PG8_SB(0, 0), cB, voffB); PG8_STAGE(PG8_SA(0, 0), cA, voffA); PG8_STAGE(PG8_SB(0, 1), cB + hstep, voffB); PG8_STAGE(PG8_SA(0, 1), cA + hstep, voffA);
        if (wr == 1) PG8_BAR;
        PG8_WAIT_V(4); PG8_BAR;
        PG8_STAGE(PG8_SB(1, 0), cB + kstep, voffB); PG8_STAGE(PG8_SA(1, 0), cA + kstep, voffA); PG8_STAGE(PG8_SB(1, 1), cB + hstep + kstep, voffB);
        PG8_WAIT_V(6); PG8_BAR;
    }
    for (;;) {
        const bool has_next = S.next(ui + 1, nxt);
        const char* nA = has_next ? (const char*)g.A + (size_t)nxt.pm * tstep : cA; const char* nB = has_next ? (const char*)g.Bt + (size_t)nxt.pn * tstep : cB;
        for (int t = 0; t < nt; t += 2) {
            const bool last = (t == nt - 2);
            const char* a1 = cA + (size_t)(t + 1) * kstep;
            const char* a2 = last ? nA : cA + (size_t)(t + 2) * kstep; const char* b2 = last ? nB : cB + (size_t)(t + 2) * kstep;
            const char* a3 = a2 + kstep; const char* b3 = b2 + kstep;
            if (last && has_next) S.a_ready(nxt);
            if constexpr (SP2) {
            PG8_LDB(B0, 0, 0); PG8_LDB(B1, 0, 1); PG8_SCHED; PG8_LDA(At, 0, 0); PG8_STAGE(PG8_SA(1, 1), a1 + hstep, voffA);
            PG8_WAIT_V(8); PG8_WAIT_L(0); PG8_BAR; PG8_MMA(0, 0, At, B0); PG8_MMA(0, 1, At, B1); PG8_BAR; PG8_SCHED;
            PG8_LDA(At, 0, 1); PG8_STAGE(PG8_SB(0, 0), b2, voffB); PG8_STAGE(PG8_SB(0, 1), b2 + hstep, voffB); PG8_STAGE(PG8_SA(0, 0), a2, voffA);
            PG8_WAIT_V(8); PG8_WAIT_L(0); PG8_BAR; PG8_MMA(1, 0, At, B0); PG8_MMA(1, 1, At, B1); PG8_BAR; PG8_SCHED;
            PG8_LDB(B0, 1, 0); PG8_LDB(B1, 1, 1); PG8_SCHED; PG8_LDA(At, 1, 0); PG8_STAGE(PG8_SA(0, 1), a2 + hstep, voffA);
            PG8_WAIT_V(8); PG8_WAIT_L(0); PG8_BAR; PG8_MMA(0, 0, At, B0); PG8_MMA(0, 1, At, B1); PG8_BAR; PG8_SCHED;
            PG8_LDA(At, 1, 1); PG8_STAGE(PG8_SB(1, 0), b3, voffB); PG8_STAGE(PG8_SB(1, 1), b3 + hstep, voffB); PG8_STAGE(PG8_SA(1, 0), a3, voffA);
            PG8_WAIT_V(8); PG8_WAIT_L(0); PG8_BAR; PG8_MMA(1, 0, At, B0); PG8_MMA(1, 1, At, B1); PG8_BAR; PG8_SCHED;
            } else {
            PG8_LDB(B0, 0, 0); PG8_SCHED; PG8_LDA(At, 0, 0); PG8_STAGE(PG8_SA(1, 1), a1 + hstep, voffA);
            PG8_WAIT_L(8); PG8_BAR; PG8_WAIT_L(0); PG8_MMA(0, 0, At, B0); PG8_BAR; PG8_SCHED;
            PG8_LDB(B1, 0, 1); PG8_STAGE(PG8_SB(0, 0), b2, voffB);
            PG8_BAR; PG8_WAIT_L(0); PG8_MMA(0, 1, At, B1); PG8_BAR;
            PG8_LDA(At, 0, 1); PG8_STAGE(PG8_SA(0, 0), a2, voffA);
            PG8_BAR; PG8_WAIT_L(0); PG8_MMA(1, 0, At, B0); PG8_BAR; PG8_SCHED;
            PG8_STAGE(PG8_SB(0, 1), b2 + hstep, voffB);
            PG8_WAIT_V(6); PG8_BAR; PG8_MMA(1, 1, At, B1); PG8_BAR;
            PG8_LDB(B0, 1, 0); PG8_SCHED; PG8_LDA(At, 1, 0); PG8_STAGE(PG8_SA(0, 1), a2 + hstep, voffA);
            PG8_WAIT_L(8); PG8_BAR; PG8_WAIT_L(0); PG8_MMA(0, 0, At, B0); PG8_BAR; PG8_SCHED;
            PG8_LDB(B1, 1, 1); PG8_STAGE(PG8_SB(1, 0), b3, voffB);
            PG8_BAR; PG8_WAIT_L(0); PG8_MMA(0, 1, At, B1); PG8_BAR;
            PG8_LDA(At, 1, 1); PG8_STAGE(PG8_SA(1, 0), a3, voffA);
            PG8_BAR; PG8_WAIT_L(0); PG8_MMA(1, 0, At, B0); PG8_BAR; PG8_SCHED;
            PG8_STAGE(PG8_SB(1, 1), b3 + hstep, voffB);
            PG8_WAIT_V(6); PG8_BAR; PG8_MMA(1, 1, At, B1); PG8_BAR;
            }
        }
        if constexpr (ALIGN_EPI) { if (wr == 0) PG8_BAR; }
        if constexpr (!Epi::AFTER_DRAIN) { E(acc, cur, wr, wc, fr, fq); S.done(cur); }
        if (!has_next) break;
#pragma unroll
        for (int a = 0; a < 2; ++a)
#pragma unroll
            for (int b = 0; b < 2; ++b)
#pragma unroll
                for (int m = 0; m < 4; ++m)
#pragma unroll
                    for (int n = 0; n < 2; ++n) acc[a][b][m][n] = (f32x4){0.f, 0.f, 0.f, 0.f};
        cur = nxt; cA = nA; cB = nB; ++ui;
        if constexpr (ALIGN_EPI) { if (wr == 1) PG8_BAR; }
    }
    PG8_WAIT_V(0);
    if constexpr (!ALIGN_EPI) { if (wr == 0) PG8_BAR; }
    PG8_BAR;
    if constexpr (Epi::AFTER_DRAIN) { E.fused(acc, cur, wr, wc, fr, fq, lds, wid, lane); S.done(cur); }
#undef PG8_SA
#undef PG8_SB
#undef PG8_STAGE
#undef PG8_LDA
#undef PG8_LDB
#undef PG8_MMA
#undef PG8_WAIT_V
#undef PG8_WAIT_L
#undef PG8_BAR
#undef PG8_SCHED
}
}

#define LAS __attribute__((address_space(3)))
using pg8::ex2; using pg8::rcpf_;
typedef unsigned short u16;
typedef short bf16x8 __attribute__((ext_vector_type(8)));
typedef float f32x4 __attribute__((ext_vector_type(4)));
typedef float f32x16 __attribute__((ext_vector_type(16)));
typedef unsigned u32x4 __attribute__((ext_vector_type(4)));
typedef unsigned u32x2 __attribute__((ext_vector_type(2)));

constexpr int DM = 1024, NB = 16, SEQ = 2048, MTOK = NB * SEQ, DEPTH = 4, DFF = 2816, INW = 2840, PW = 3072;
constexpr int C_MQ = 0, C_MK = 256, C_MV = 512, C_DQ = 768, C_DK = 1024, C_DV = 1280, C_NQ = 1536, C_NKC = 2048, C_NVC = 2176, C_NKS = 2304, C_NVS = 2432, C_NKW = 2560, C_NVW = 2688, C_NG = 2816;
constexpr int NVH = 12;
constexpr float LOG2E = 1.4426950408889634f, NEGF = -1e30f;
constexpr int NPH_L = 14, NPH = NPH_L * DEPTH + 1;
constexpr size_t MiB = 1u << 20;
constexpr size_t WS_GU1 = 1 * MiB, WS_DN1 = 12 * MiB, WS_GU2 = WS_DN1 + 5 * MiB + MiB / 2, WS_DN2 = WS_GU2 + 11 * MiB, WS_WIN = 34 * MiB, WS_WOUT = 40 * MiB, WS_W1 = 42 * MiB;
constexpr size_t WS_PROJ = 44 * MiB, WS_XN = 236 * MiB, WS_VT = 300 * MiB, WS_HID = 348 * MiB, WS_KCMP = 352 * MiB, WS_VCMPT = WS_KCMP + MiB / 2, WS_KMEAN = 353 * MiB, WS_SEL = WS_KMEAN + MiB / 4, WS_END = 354 * MiB;
static_assert(WS_DN2 + 5 * MiB + MiB / 2 == WS_WIN, "ws map");
constexpr int LDS_BYTES = 147456, MISC_OFF = 147456 - 64;
constexpr size_t WS_CTL = 0, CTL_ZERO_BYTES = 65536;
constexpr int ATT_K = 0, ATT_V = 32768, ATT_LUT = 65536, ATT_PARK = 68608;
constexpr int CMP_K = 0, CMP_V = 18432, CMP_A = 36864, CMP_H = CMP_A + 256 * 33 * 4;

struct Params {
    const float* x; const float* rel_bias; const float* norm_ffn1; const float* ffn1_gate; const float* ffn1_up; const float* ffn1_down;
    const float* norm_mix; const float* w_in; const float* diff_lambda; const float* diff_subln; const float* cmp_pe; const float* cmp_w1; const float* cmp_w2;
    const float* w_out; const float* norm_ffn2; const float* ffn2_gate; const float* ffn2_up; const float* ffn2_down; const float* final_norm;
    float* out; unsigned char* ws;
    float lam_init[4];
    int ph_lo, ph_hi;
};
typedef const __attribute__((address_space(4))) Params* KParamsPtr;

__device__ __forceinline__ float bf2f(unsigned v) { return __uint_as_float(v << 16); }
typedef float f32x2_t __attribute__((ext_vector_type(2))); typedef __bf16 bf16x2_t __attribute__((ext_vector_type(2)));
__device__ __forceinline__ unsigned pkbf(float lo, float hi) { f32x2_t v = {lo, hi}; bf16x2_t b = __builtin_convertvector(v, bf16x2_t); return __builtin_bit_cast(unsigned, b); }
__device__ __forceinline__ int lane_opaque() { int l; asm volatile("v_mbcnt_lo_u32_b32 %0, -1, 0\n\tv_mbcnt_hi_u32_b32 %0, -1, %0" : "=v"(l)); return l; }
__device__ __forceinline__ float wave_sum(float v, int lane) {
#pragma unroll
    for (int o = 1; o < 64; o <<= 1) v += __int_as_float(__builtin_amdgcn_ds_bpermute((lane ^ o) << 2, __float_as_int(v)));
    return v;
}
__device__ __forceinline__ float xhalf_max(float v) { auto rr = __builtin_amdgcn_permlane32_swap(__float_as_uint(v), __float_as_uint(v), false, false); return fmaxf(__uint_as_float(rr[0]), __uint_as_float(rr[1])); }
__device__ __forceinline__ float xhalf_sum(float v) { auto rr = __builtin_amdgcn_permlane32_swap(__float_as_uint(v), __float_as_uint(v), false, false); return __uint_as_float(rr[0]) + __uint_as_float(rr[1]); }
__device__ __forceinline__ float sigmoid_f(float x) { return rcpf_(1.0f + ex2(-LOG2E * x)); }
__device__ __forceinline__ int crow(int r, int hi) { return (r & 3) + 8 * (r >> 2) + 4 * hi; }
__device__ __forceinline__ int kperm(int p) { const int h = p >> 3, j = p & 7; return 8 * (j >> 2) + 4 * h + (j & 3); }
__device__ __forceinline__ int pperm(int k) { return ((k >> 2) & 1) * 8 + (k >> 3) * 4 + (k & 3); }

__device__ __forceinline__ void tr_item(const float* W, int K, int N, u16* WT, int kb, int n0, int dst_row0, LAS float* scr, int lane, float cs = 1.0f) {
    const int k0 = 64 * kb; const int n = n0 + (lane & 31); const bool ok = n < N;
    float wv[32];
#pragma unroll
    for (int i = 0; i < 32; ++i) { const int kk = 2 * i + (lane >> 5); wv[i] = ok ? W[(size_t)(k0 + kk) * N + n] : 0.f; }
#pragma unroll
    for (int i = 0; i < 32; ++i) { const int kk = 2 * i + (lane >> 5); scr[kk * 33 + (lane & 31)] = wv[i] * cs; }
    asm volatile("s_waitcnt lgkmcnt(0)" ::: "memory");
    const int c = lane & 7;
#pragma unroll
    for (int j = 0; j < 4; ++j) { const int nn = (lane >> 3) + 8 * j; const LAS float* s = scr + (8 * c) * 33 + nn;
        u32x4 o; o.x = pkbf(s[0 * 33], s[1 * 33]); o.y = pkbf(s[2 * 33], s[3 * 33]); o.z = pkbf(s[4 * 33], s[5 * 33]); o.w = pkbf(s[6 * 33], s[7 * 33]);
        *(u32x4*)(WT + (size_t)(dst_row0 + nn) * K + k0 + 8 * c) = o; }
    asm volatile("s_waitcnt lgkmcnt(0)" ::: "memory");
}

__device__ __forceinline__ void norm_row(const float* xrow, const float* g, u16* dst16, float* dst32, int lane) {
    const f32x4* xr = (const f32x4*)xrow + lane; const f32x4* gr = (const f32x4*)g + lane;
    f32x4 v[4]; float s = 0.f;
#pragma unroll
    for (int j = 0; j < 4; ++j) { v[j] = xr[64 * j]; s += (v[j].x * v[j].x + v[j].y * v[j].y) + (v[j].z * v[j].z + v[j].w * v[j].w); }
    const float rstd = 1.0f / sqrtf(wave_sum(s, lane) * (1.0f / 1024.0f) + 1e-6f);
#pragma unroll
    for (int j = 0; j < 4; ++j) { const f32x4 gg = gr[64 * j]; const f32x4 y = v[j] * rstd * gg;
        if (dst16) { u32x2 o; o.x = pkbf(y.x, y.y); o.y = pkbf(y.z, y.w); *((u32x2*)dst16 + lane + 64 * j) = o; }
        else *((f32x4*)dst32 + lane + 64 * j) = y; }
}

struct AState { f32x16 o0, o1; float m, l; };
__device__ __forceinline__ void astate_init(AState& s) {
#pragma unroll
    for (int r = 0; r < 16; ++r) { s.o0[r] = 0.f; s.o1[r] = 0.f; }
    s.m = 0.f; s.l = 0.f;
}
constexpr float ATT_THR = 8.0f;
constexpr int ATT_SLOT = 9216, ATT_NSLOT = 3;
template <int KS0, int NKS>
__device__ __forceinline__ void qk_block(const LAS unsigned char* Ks, const bf16x8 (&qr)[4], int r32, int hi, f32x16& s0, f32x16& s1) {
    f32x16 ci;
#pragma unroll
    for (int r = 0; r < 16; ++r) ci[r] = 0.f;
    const LAS unsigned char* kp = Ks + hi * 1024 + r32 * 16;
#pragma unroll
    for (int ks = 0; ks < NKS; ++ks) {
        const bf16x8 a0 = *(const LAS bf16x8*)(kp + (KS0 + ks) * 2048);
        const bf16x8 a1 = *(const LAS bf16x8*)(kp + (KS0 + ks) * 2048 + 512);
        s0 = __builtin_amdgcn_mfma_f32_32x32x16_bf16(a0, qr[KS0 + ks], ks == 0 ? ci : s0, 0, 0, 0);
        s1 = __builtin_amdgcn_mfma_f32_32x32x16_bf16(a1, qr[KS0 + ks], ks == 0 ? ci : s1, 0, 0, 0);
    }
    __builtin_amdgcn_sched_group_barrier(0x100, 2 * NKS, 0); __builtin_amdgcn_sched_group_barrier(0x008, 2 * NKS, 0);
}
__device__ __forceinline__ void pv_block(const LAS unsigned char* Vs, const u32x4 (&pk)[4], int r32, int hi, AState& st) {
    const LAS unsigned char* vp = Vs + hi * 1024 + r32 * 16;
#pragma unroll
    for (int c = 0; c < 4; ++c) {
        const bf16x8 v0 = *(const LAS bf16x8*)(vp + c * 2048);
        const bf16x8 v1 = *(const LAS bf16x8*)(vp + c * 2048 + 512);
        const bf16x8 pb = __builtin_bit_cast(bf16x8, pk[c]);
        st.o0 = __builtin_amdgcn_mfma_f32_32x32x16_bf16(v0, pb, st.o0, 0, 0, 0);
        st.o1 = __builtin_amdgcn_mfma_f32_32x32x16_bf16(v1, pb, st.o1, 0, 0, 0);
    }
    __builtin_amdgcn_sched_group_barrier(0x100, 8, 0); __builtin_amdgcn_sched_group_barrier(0x008, 8, 0);
}
__device__ __forceinline__ void glds16(const void* gsrc, unsigned lds_dst) { unsigned keep;
    asm volatile("s_mov_b32 %0, m0\n\ts_mov_b32 m0, %2\n\ts_nop 0\n\tglobal_load_lds_dwordx4 %1, off\n\ts_mov_b32 m0, %0" : "=&s"(keep) : "v"(gsrc), "s"(lds_dst) : "memory"); }
__device__ __forceinline__ void lut_add(f32x16& s0, f32x16& s1, const LAS float* lutz, int dbase, float cc) {
    const LAS float* lp = lutz + (dbase - 59);
#pragma unroll
    for (int r = 0; r < 16; ++r) { const int ko = (r & 3) + 8 * (r >> 2);
        s0[r] += lp[59 - ko] + cc; s1[r] += lp[27 - ko] + cc; }
}
__device__ __forceinline__ void const_add(f32x16& s0, f32x16& s1, float cc) {
#pragma unroll
    for (int r = 0; r < 16; ++r) { s0[r] += cc; s1[r] += cc; }
}
__device__ __forceinline__ float row_max(const f32x16& s0, const f32x16& s1) {
    float mx = fmaxf(s0[0], s1[0]);
#pragma unroll
    for (int r = 1; r < 16; ++r) mx = fmaxf(mx, fmaxf(s0[r], s1[r]));
    return xhalf_max(mx);
}
__device__ __forceinline__ void rescale(AState& st, f32x16& s0, f32x16& s1, float mx) {
    const float dl = fmaxf(mx, 0.f); const float f = ex2(-dl); st.m += dl; st.l *= f;
#pragma unroll
    for (int r = 0; r < 16; ++r) { st.o0[r] *= f; st.o1[r] *= f; s0[r] -= dl; s1[r] -= dl; }
}
__device__ __forceinline__ void exp_pack(f32x16& s0, f32x16& s1, u32x4 (&pk)[4], AState& st) {
    float sum = 0.f;
#pragma unroll
    for (int r = 0; r < 16; ++r) { s0[r] = ex2(s0[r]); s1[r] = ex2(s1[r]); sum += s0[r] + s1[r]; }
    st.l += sum;
    pk[0] = (u32x4){pkbf(s0[0], s0[1]), pkbf(s0[2], s0[3]), pkbf(s0[4], s0[5]), pkbf(s0[6], s0[7])};
    pk[1] = (u32x4){pkbf(s0[8], s0[9]), pkbf(s0[10], s0[11]), pkbf(s0[12], s0[13]), pkbf(s0[14], s0[15])};
    pk[2] = (u32x4){pkbf(s1[0], s1[1]), pkbf(s1[2], s1[3]), pkbf(s1[4], s1[5]), pkbf(s1[6], s1[7])};
    pk[3] = (u32x4){pkbf(s1[8], s1[9]), pkbf(s1[10], s1[11]), pkbf(s1[12], s1[13]), pkbf(s1[14], s1[15])};
}

template <int KS0, int NKS, bool WINDOW, int MODE>
__device__ __forceinline__ void run_tiles(LAS unsigned char* lds, int t0, int t1, const u16* Kg, const u16* Vtg, const bf16x8 (&qr)[4], float c31,
                                          int q0w, unsigned mask, int qb, AState& A, int wave, int lane, int r32, int hi) {
    LAS unsigned char* Kr = lds + ATT_K; LAS unsigned char* Vr = lds + ATT_V; const LAS float* lut1 = (const LAS float*)(lds + ATT_LUT) + 96;
    const u16* ksrc = Kg + (size_t)lane * PW + wave * 8;
    const u16* vsrc = Vtg + (size_t)lane * SEQ + wave * 8;
    const unsigned kdst = (unsigned)(uintptr_t)Kr + wave * 1024, vdst = (unsigned)(uintptr_t)Vr + wave * 1024;
#define TCL(t) ((t) < t0 ? t0 : ((t) > t1 ? t1 : (t)))
#define DMA_K(tn) glds16(ksrc + (size_t)TCL(tn) * 64 * PW, (unsigned)__builtin_amdgcn_readfirstlane(kdst + ((tn) & 3) * 8192))
#define DMA_V(tn) glds16(vsrc + TCL(tn) * 64, (unsigned)__builtin_amdgcn_readfirstlane(vdst + ((tn) & 3) * 8192))
#define KS_(t) (Kr + ((t) & 3) * 8192)
#define VS_(t) (Vr + ((t) & 3) * 8192)
#define WAIT_BAR4() asm volatile("s_waitcnt vmcnt(4) lgkmcnt(0)\n\ts_barrier" ::: "memory")
#define T_ACTIVE(t) (!((q0w + 31 - (t) * 64) < 0 || (WINDOW && (q0w - ((t) * 64 + 63)) >= 512)))
#define T_LUTMODE(t) (((q0w - ((t) * 64 + 63)) < 128) || (WINDOW && (q0w + 31 - (t) * 64) >= 512))
    auto tile_sel = [&](int t) -> int { if (MODE == 1) { const int blk = t >> 2; return blk < qb ? (int)((mask >> blk) & 1u) : 1; } if (MODE == 2) return (int)((mask >> t) & 1u); return 1; };
    asm volatile("s_waitcnt vmcnt(0)" ::: "memory");
#pragma unroll
    for (int j = 0; j < 4; ++j) { DMA_K(t0 + j); DMA_V(t0 + j - 2); }
    WAIT_BAR4();
    f32x16 sn0, sn1, sc0, sc1; u32x4 pk[4];
#pragma unroll
    for (int r = 0; r < 16; ++r) { sn0[r] = 0.f; sn1[r] = 0.f; }
#pragma unroll
    for (int i = 0; i < 4; ++i) pk[i] = (u32x4){0u, 0u, 0u, 0u};
    bool act_n = T_ACTIVE(t0), act_c = false, act_p = false;
    if (act_n) qk_block<KS0, NKS>(KS_(t0), qr, r32, hi, sn0, sn1);
    asm volatile("s_waitcnt lgkmcnt(0)\n\ts_barrier" ::: "memory");
    for (int c = t0; c <= t1 + 1; ++c) {
        act_p = act_c; act_c = act_n; sc0 = sn0; sc1 = sn1;
        DMA_K(c + 4); DMA_V(c + 2);
        act_n = (c + 1 <= t1) && T_ACTIVE(c + 1);
        const bool lm_c = T_LUTMODE(c);
        const int dbase = q0w + r32 - c * 64 - 4 * hi;
        const float selc = tile_sel(c) ? (lm_c ? 0.f : c31) : NEGF;
        if (act_p) pv_block(VS_(c - 1), pk, r32, hi, A);
        if (act_c) {
            if (lm_c) lut_add(sc0, sc1, lut1, dbase, selc - A.m); else const_add(sc0, sc1, selc - A.m);
            const float mx = row_max(sc0, sc1);
            if (__any(mx > ATT_THR)) rescale(A, sc0, sc1, mx);
        }
        if (act_n) qk_block<KS0, NKS>(KS_(c + 1), qr, r32, hi, sn0, sn1);
        if (act_c) exp_pack(sc0, sc1, pk, A);
        WAIT_BAR4();
    }
    asm volatile("s_waitcnt vmcnt(0) lgkmcnt(0)\n\ts_barrier" ::: "memory");
#undef TCL
#undef DMA_K
#undef DMA_V
#undef KS_
#undef VS_
#undef WAIT_BAR4
#undef T_ACTIVE
#undef T_LUTMODE
}

__device__ __forceinline__ void build_lut(LAS unsigned char* lds, const float* rel_bias, int head, bool window, int tid) {
    LAS float* lut = (LAS float*)(lds + ATT_LUT);
    for (int i = tid; i < 704; i += 512) {
        const int d = i - 96; float v;
        if (d < 0) v = NEGF;
        else if (d >= 512) v = window ? NEGF : rel_bias[31 * 16 + head] * LOG2E;
        else { int bk;
            if (d < 16) bk = d; else if (d >= 128) bk = 31; else { bk = 16 + (int)(log2f((float)d * (1.0f / 16.0f)) * (16.0f / 3.0f)); bk = bk > 31 ? 31 : bk; }
            v = rel_bias[bk * 16 + head] * LOG2E; }
        lut[i] = v;
    }
}
__device__ __forceinline__ void load_q(bf16x8 (&qr)[4], const u16* qrow, int hi) {
#pragma unroll
    for (int ks = 0; ks < 4; ++ks) qr[ks] = *(const bf16x8*)(qrow + ks * 16 + hi * 8);
}
__device__ __forceinline__ void store_o(u16* dst, const f32x16& v0, const f32x16& v1, int hi) {
#pragma unroll
    for (int g = 0; g < 4; ++g) {
        u32x2 a; a.x = pkbf(v0[4 * g], v0[4 * g + 1]); a.y = pkbf(v0[4 * g + 2], v0[4 * g + 3]); *(u32x2*)(dst + 8 * g + 4 * hi) = a;
        u32x2 b; b.x = pkbf(v1[4 * g], v1[4 * g + 1]); b.y = pkbf(v1[4 * g + 2], v1[4 * g + 3]); *(u32x2*)(dst + 32 + 8 * g + 4 * hi) = b;
    }
}

struct Ctx { LAS unsigned char* lds; int tid, lane, wave, r32, hi, G, bx; u16* proj; u16* obuf; u16* vt; };

__device__ __forceinline__ void moba_unit(const Ctx& C0, KParamsPtr P, int b, int h, int qb) {
    Ctx C = C0; C.lane = lane_opaque(); C.tid = C.wave * 64 + C.lane; C.r32 = C.lane & 31; C.hi = C.lane >> 5;
    const int q0w = __builtin_amdgcn_readfirstlane(qb * 256 + C.wave * 32); const int qpos = q0w + C.r32; const size_t tok = (size_t)b * SEQ + qpos;
    build_lut(C.lds, P->rel_bias, h, false, C.tid);
    const u16* qrow = C.proj + tok * PW + C_MQ + h * 64;
    bf16x8 qr[4]; load_q(qr, qrow, C.hi);
    unsigned mask = 0;
    if (qb > 0) {
        float g[7];
#pragma unroll
        for (int j = 0; j < 7; ++j) g[j] = 0.f;
        const float* km = (const float*)(P->ws + WS_KMEAN) + (size_t)((b * 4 + h) * 8) * 64;
#pragma unroll
        for (int dc = 0; dc < 8; ++dc) {
            const u32x4 qv = *(const u32x4*)(qrow + dc * 8);
            float qf[8]; qf[0] = bf2f(qv.x & 0xffffu); qf[1] = bf2f(qv.x >> 16); qf[2] = bf2f(qv.y & 0xffffu); qf[3] = bf2f(qv.y >> 16);
            qf[4] = bf2f(qv.z & 0xffffu); qf[5] = bf2f(qv.z >> 16); qf[6] = bf2f(qv.w & 0xffffu); qf[7] = bf2f(qv.w >> 16);
#pragma unroll
            for (int j = 0; j < 7; ++j) if (j < qb) { const float* kmj = km + j * 64 + dc * 8;
#pragma unroll
                for (int e = 0; e < 8; ++e) g[j] = fmaf(qf[e], kmj[e], g[j]); }
        }
#pragma unroll
        for (int j = 0; j < 7; ++j) if (j < qb) { int rank = 0;
#pragma unroll
            for (int i = 0; i < 7; ++i) if (i != j && i < qb) rank += (g[i] > g[j] || (g[i] == g[j] && i < j)) ? 1 : 0;
            if (rank < 3) mask |= 1u << j; }
    }
    AState A; astate_init(A);
    const float c31 = P->rel_bias[31 * 16 + h] * LOG2E;
    run_tiles<0, 4, false, 1>(C.lds, 0, 4 * qb + 3, C.proj + (size_t)b * SEQ * PW + C_MK + h * 64, C.vt + (size_t)((b * NVH + h) * 64) * SEQ, qr, c31, q0w, mask, qb, A, C.wave, C.lane, C.r32, C.hi);
    const float inv = rcpf_(xhalf_sum(A.l));
    A.o0 *= inv; A.o1 *= inv;
    { const int l2 = lane_opaque(); const size_t tok2 = (size_t)b * SEQ + q0w + (l2 & 31);
      store_o(C.obuf + tok2 * DM + h * 64, A.o0, A.o1, l2 >> 5); }
}

__device__ __forceinline__ void diff_unit(const Ctx& C0, KParamsPtr P, int layer, int b, int h, int qb) {
    Ctx C = C0; C.lane = lane_opaque(); C.tid = C.wave * 64 + C.lane; C.r32 = C.lane & 31; C.hi = C.lane >> 5;
    const int q0w = __builtin_amdgcn_readfirstlane(qb * 256 + C.wave * 32); const int qpos = q0w + C.r32; const size_t tok = (size_t)b * SEQ + qpos;
    build_lut(C.lds, P->rel_bias, 4 + h, false, C.tid);
    bf16x8 qr[4]; load_q(qr, C.proj + tok * PW + C_DQ + h * 64, C.hi);
    AState A; astate_init(A);
    const float c31 = P->rel_bias[31 * 16 + 4 + h] * LOG2E;
    const u16* Kg = C.proj + (size_t)b * SEQ * PW + C_DK + h * 64; const u16* Vg = C.vt + (size_t)((b * NVH + 4 + h) * 64) * SEQ;
    run_tiles<0, 2, false, 0>(C.lds, 0, 4 * qb + 3, Kg, Vg, qr, c31, q0w, 0u, 0, A, C.wave, C.lane, C.r32, C.hi);
    LAS float* park = (LAS float*)(C.lds + ATT_PARK) + C.tid;
    { const float i0 = rcpf_(xhalf_sum(A.l));
#pragma unroll
      for (int r = 0; r < 16; ++r) { park[r * 512] = A.o0[r] * i0; park[(16 + r) * 512] = A.o1[r] * i0; } }
    astate_init(A);
    run_tiles<2, 2, false, 0>(C.lds, 0, 4 * qb + 3, Kg, Vg, qr, c31, q0w, 0u, 0, A, C.wave, C.lane, C.r32, C.hi);
    const float* lp = P->diff_lambda + (size_t)layer * 128; float d01 = 0.f, d23 = 0.f;
    for (int i = 0; i < 32; ++i) { d01 = fmaf(lp[i], lp[32 + i], d01); d23 = fmaf(lp[64 + i], lp[96 + i], d23); }
    const float li = P->lam_init[layer]; const float lam = expf(d01) - expf(d23) + li;
    const float i1 = lam * rcpf_(xhalf_sum(A.l));
    float ss = 0.f;
#pragma unroll
    for (int r = 0; r < 16; ++r) { A.o0[r] = park[r * 512] - A.o0[r] * i1; A.o1[r] = park[(16 + r) * 512] - A.o1[r] * i1; ss += A.o0[r] * A.o0[r] + A.o1[r] * A.o1[r]; }
    ss = xhalf_sum(ss);
    const float rstd = (1.0f / sqrtf(ss * (1.0f / 64.0f) + 1e-6f)) * (1.0f - li);
    const float* sg = P->diff_subln + (size_t)layer * 64;
#pragma unroll
    for (int r = 0; r < 16; ++r) { const int d = crow(r, C.hi); A.o0[r] *= rstd * sg[d]; A.o1[r] *= rstd * sg[32 + d]; }
    { const int l2 = lane_opaque(); const size_t tok2 = (size_t)b * SEQ + q0w + (l2 & 31);
      store_o(C.obuf + tok2 * DM + 256 + h * 64, A.o0, A.o1, l2 >> 5); }
}

__device__ __forceinline__ void nsa_unit(const Ctx& C0, KParamsPtr P, int b, int hq, int qb) {
    Ctx C = C0; C.lane = lane_opaque(); C.tid = C.wave * 64 + C.lane; C.r32 = C.lane & 31; C.hi = C.lane >> 5;
    const int g = hq >> 2;
    const int q0w = __builtin_amdgcn_readfirstlane(qb * 256 + C.wave * 32); const int qpos = q0w + C.r32; const size_t tok = (size_t)b * SEQ + qpos;
    build_lut(C.lds, P->rel_bias, 8 + hq, false, C.tid);
    bf16x8 qr[4]; load_q(qr, C.proj + tok * PW + C_NQ + hq * 64, C.hi);
    const u16* gl = C.proj + tok * PW + C_NG + hq * 3;
    const float g1 = sigmoid_f(bf2f(gl[1])), g2 = sigmoid_f(bf2f(gl[2]));
    const unsigned mask = ((const unsigned*)(P->ws + WS_SEL))[(size_t)(b * 2 + g) * SEQ + qpos];
    const float c31 = P->rel_bias[31 * 16 + 8 + hq] * LOG2E;
    AState A; astate_init(A);
    run_tiles<0, 4, false, 2>(C.lds, 0, 4 * qb + 3, C.proj + (size_t)b * SEQ * PW + C_NKS + g * 64, C.vt + (size_t)((b * NVH + 8 + g) * 64) * SEQ, qr, c31, q0w, mask, qb, A, C.wave, C.lane, C.r32, C.hi);
    LAS float* park = (LAS float*)(C.lds + ATT_PARK) + C.tid;
    { const float f = g1 * rcpf_(xhalf_sum(A.l));
#pragma unroll
      for (int r = 0; r < 16; ++r) { park[r * 512] = A.o0[r] * f; park[(16 + r) * 512] = A.o1[r] * f; } }
    if (C.tid < 96) ((LAS float*)(C.lds + ATT_LUT))[608 + C.tid] = NEGF;
    astate_init(A);
    const int tw0 = 4 * qb - 8 < 0 ? 0 : 4 * qb - 8;
    run_tiles<0, 4, true, 0>(C.lds, tw0, 4 * qb + 3, C.proj + (size_t)b * SEQ * PW + C_NKW + g * 64, C.vt + (size_t)((b * NVH + 10 + g) * 64) * SEQ, qr, c31, q0w, 0u, qb, A, C.wave, C.lane, C.r32, C.hi);
    { const float f = g2 * rcpf_(xhalf_sum(A.l));
#pragma unroll
      for (int r = 0; r < 16; ++r) { A.o0[r] = A.o0[r] * f + park[r * 512]; A.o1[r] = A.o1[r] * f + park[(16 + r) * 512]; } }
    const int l2 = lane_opaque(); const int hi2 = l2 >> 5;
    u16* dst = C.obuf + ((size_t)b * SEQ + q0w + (l2 & 31)) * DM + 512 + hq * 64;
#pragma unroll
    for (int gg = 0; gg < 4; ++gg) {
        const u32x2 a = *(const u32x2*)(dst + 8 * gg + 4 * hi2), bq = *(const u32x2*)(dst + 32 + 8 * gg + 4 * hi2);
        A.o0[4 * gg] += bf2f(a.x & 0xffffu); A.o0[4 * gg + 1] += bf2f(a.x >> 16); A.o0[4 * gg + 2] += bf2f(a.y & 0xffffu); A.o0[4 * gg + 3] += bf2f(a.y >> 16);
        A.o1[4 * gg] += bf2f(bq.x & 0xffffu); A.o1[4 * gg + 1] += bf2f(bq.x >> 16); A.o1[4 * gg + 2] += bf2f(bq.y & 0xffffu); A.o1[4 * gg + 3] += bf2f(bq.y >> 16);
    }
    store_o(dst, A.o0, A.o1, hi2);
}

__device__ __forceinline__ void cmp_unit(const Ctx& C0, KParamsPtr P, int b, int g, int qblk) {
    Ctx C = C0; C.lane = lane_opaque(); C.tid = C.wave * 64 + C.lane; C.r32 = C.lane & 31; C.hi = C.lane >> 5;
    LAS unsigned char* lds = C.lds; const int tid = C.tid, r32 = C.r32, hi = C.hi;
    const u16* kc = (const u16*)(P->ws + WS_KCMP) + (size_t)(b * 2 + g) * 128 * 64;
    const u16* vc = (const u16*)(P->ws + WS_VCMPT) + (size_t)(b * 2 + g) * 64 * 128;
#pragma unroll
    for (int i = 0; i < 2; ++i) { const int e = tid + 512 * i;
        { const int row = e >> 3, ch = e & 7; *(LAS u32x4*)(lds + CMP_K + row * 144 + ch * 16) = *(const u32x4*)(kc + row * 64 + ch * 8); }
        { const int row = e >> 4, ch = e & 15; *(LAS u32x4*)(lds + CMP_V + row * 272 + ch * 16) = *(const u32x4*)(vc + row * 128 + ch * 8); } }
    const int q0w = __builtin_amdgcn_readfirstlane(qblk * 256 + C.wave * 32); const int qpos = q0w + r32; const size_t tok = (size_t)b * SEQ + qpos;
    const int nmax = (qpos - 31) >> 4;
    __syncthreads();
    float qa[16], qh[16];
#pragma unroll
    for (int i = 0; i < 16; ++i) { qa[i] = 0.f; qh[i] = 0.f; }
    const LAS unsigned char* kp = lds + CMP_K + r32 * 144 + hi * 16;
    const LAS unsigned char* vp = lds + CMP_V + r32 * 272 + hi * 16;
    bf16x8 qn[4]; load_q(qn, C.proj + tok * PW + C_NQ + g * 4 * 64, hi);
    for (int rh = 0; rh < 4; ++rh) {
        const int hq = g * 4 + rh;
        bf16x8 qr[4];
#pragma unroll
        for (int ks = 0; ks < 4; ++ks) qr[ks] = qn[ks];
        load_q(qn, C.proj + tok * PW + C_NQ + (g * 4 + (rh < 3 ? rh + 1 : rh)) * 64, hi);
        const float g0 = sigmoid_f(bf2f(C.proj[tok * PW + C_NG + hq * 3]));
        f32x16 s[4];
#pragma unroll
        for (int kb = 0; kb < 4; ++kb) {
#pragma unroll
            for (int r = 0; r < 16; ++r) s[kb][r] = 0.f;
#pragma unroll
            for (int ks = 0; ks < 4; ++ks) { const bf16x8 a = *(const LAS bf16x8*)(kp + kb * 32 * 144 + ks * 32); s[kb] = __builtin_amdgcn_mfma_f32_32x32x16_bf16(a, qr[ks], s[kb], 0, 0, 0); }
        }
        float mx = NEGF;
#pragma unroll
        for (int kb = 0; kb < 4; ++kb)
#pragma unroll
            for (int r = 0; r < 16; ++r) { const int n = 32 * kb + crow(r, hi); const float v = (n <= nmax) ? s[kb][r] : NEGF; s[kb][r] = v; mx = fmaxf(mx, v); }
        mx = xhalf_max(mx);
        float sum = 0.f;
#pragma unroll
        for (int kb = 0; kb < 4; ++kb)
#pragma unroll
            for (int r = 0; r < 16; ++r) { const int n = 32 * kb + crow(r, hi); const float pv = (n <= nmax) ? ex2(s[kb][r] - mx) : 0.f; s[kb][r] = pv; sum += pv; }
        sum = xhalf_sum(sum);
        const float inv = nmax >= 0 ? rcpf_(sum) : 0.f;
        f32x16 o0, o1;
#pragma unroll
        for (int r = 0; r < 16; ++r) { o0[r] = 0.f; o1[r] = 0.f; }
#pragma unroll
        for (int kb = 0; kb < 4; ++kb) {
#pragma unroll
            for (int r = 0; r < 16; ++r) s[kb][r] *= inv;
#pragma unroll
            for (int g4 = 0; g4 < 4; ++g4) { const float h = 0.5f * s[kb][4 * g4 + 3]; qh[kb * 4 + g4] += h; qa[kb * 4 + g4] += (s[kb][4 * g4] + s[kb][4 * g4 + 1]) + (s[kb][4 * g4 + 2] + h); }
#pragma unroll
            for (int c = 0; c < 2; ++c) {
                const u32x4 pk = (u32x4){pkbf(s[kb][8 * c], s[kb][8 * c + 1]), pkbf(s[kb][8 * c + 2], s[kb][8 * c + 3]), pkbf(s[kb][8 * c + 4], s[kb][8 * c + 5]), pkbf(s[kb][8 * c + 6], s[kb][8 * c + 7])};
                const bf16x8 pb = __builtin_bit_cast(bf16x8, pk);
                const bf16x8 v0 = *(const LAS bf16x8*)(vp + (kb * 2 + c) * 32);
                const bf16x8 v1 = *(const LAS bf16x8*)(vp + 32 * 272 + (kb * 2 + c) * 32);
                o0 = __builtin_amdgcn_mfma_f32_32x32x16_bf16(v0, pb, o0, 0, 0, 0);
                o1 = __builtin_amdgcn_mfma_f32_32x32x16_bf16(v1, pb, o1, 0, 0, 0);
            }
            __builtin_amdgcn_sched_barrier(0);
        }
        o0 *= g0; o1 *= g0;
        store_o(C.obuf + tok * DM + 512 + hq * 64, o0, o1, hi);
    }
    LAS float* Aq = (LAS float*)(lds + CMP_A) + (C.wave * 32 + r32) * 33; LAS float* Hq = (LAS float*)(lds + CMP_H) + (C.wave * 32 + r32) * 33;
#pragma unroll
    for (int kb = 0; kb < 4; ++kb)
#pragma unroll
        for (int g4 = 0; g4 < 4; ++g4) { const int j = 8 * kb + 2 * g4 + hi; Aq[j] = qa[kb * 4 + g4]; Hq[j] = qh[kb * 4 + g4]; }
    __syncthreads();
    const int cur = q0w >> 6;
    unsigned bits = 0;
    if (cur < 16) bits = (2u << cur) - 1u;
    else {
        float sc[32];
#pragma unroll
        for (int i = 0; i < 32; ++i) { const float imp = Aq[i] + (i > 0 ? Hq[i - 1] : 0.f); sc[i] = (i > cur) ? -3.0e38f : ((i == 0 || i > cur - 2) ? 1e4f : imp); }
#pragma unroll
        for (int e = 0; e < 16; ++e) {
            const float sj = hi ? sc[16 + e] : sc[e]; int rank = 0;
#pragma unroll
            for (int i = 0; i < 32; ++i) { const bool lt = (i < e) || (hi && i < 16 + e);
                rank += (sc[i] > sj || (sc[i] == sj && lt)) ? 1 : 0; }
            const int j = hi * 16 + e;
            if (j <= cur && rank < 16) bits |= 1u << j; }
        { auto rr = __builtin_amdgcn_permlane32_swap(bits, bits, false, false); bits = rr[0] | rr[1]; }
    }
    if (hi == 0) ((unsigned*)(P->ws + WS_SEL))[(size_t)(b * 2 + g) * SEQ + qpos] = bits;
    __syncthreads();
}

__device__ __forceinline__ void prep_vk(const Ctx& C, KParamsPtr P, int b0) {
    const int G = C.G - b0, bxr = C.bx - b0, tid = C.tid, lane = C.lane;
    if (bxr < 0) return;
    for (int it = bxr; it < NB * NVH * 32; it += G) {
        const int tb = it & 31, hv = (it >> 5) % NVH, b = it / (32 * NVH);
        const int vcol = hv < 4 ? C_MV + hv * 64 : hv < 8 ? C_DV + (hv - 4) * 64 : hv < 10 ? C_NVS + (hv - 8) * 64 : C_NVW + (hv - 10) * 64;
        { const int row = tid >> 3, ch = tid & 7; *(LAS u32x4*)(C.lds + row * 144 + ch * 16) = *(const u32x4*)(C.proj + ((size_t)b * SEQ + tb * 64 + row) * PW + vcol + ch * 8); }
        __syncthreads();
        { const int d = tid >> 3, pc = tid & 7; unsigned w[4];
#pragma unroll
            for (int e = 0; e < 4; ++e) { const int p0 = pc * 8 + 2 * e, p1 = p0 + 1; const int k0 = (p0 & ~15) + kperm(p0 & 15), k1 = (p1 & ~15) + kperm(p1 & 15);
                const unsigned a = *(const LAS u16*)(C.lds + k0 * 144 + d * 2), bb = *(const LAS u16*)(C.lds + k1 * 144 + d * 2); w[e] = a | (bb << 16); }
            *(u32x4*)(C.vt + ((size_t)(b * NVH + hv) * 64 + d) * SEQ + tb * 64 + pc * 8) = (u32x4){w[0], w[1], w[2], w[3]}; }
        __syncthreads();
    }
    const int gw = bxr * 8 + C.wave, NGW = G * 8;
    for (int it = gw; it < NB * 4 * 8; it += NGW) {
        const int blk = it & 7, h = (it >> 3) & 3, b = it >> 5;
        const u16* kp = C.proj + ((size_t)b * SEQ + blk * 256) * PW + C_MK + h * 64 + lane; float s = 0.f;
        for (int k = 0; k < 256; k += 8) { float t[8];
#pragma unroll
            for (int e = 0; e < 8; ++e) t[e] = bf2f(kp[(size_t)(k + e) * PW]);
            s += ((t[0] + t[1]) + (t[2] + t[3])) + ((t[4] + t[5]) + (t[6] + t[7])); }
        ((float*)(P->ws + WS_KMEAN))[(size_t)it * 64 + lane] = s * (1.0f / 256.0f);
    }
}
__device__ __forceinline__ void prep_a(const Ctx& C, KParamsPtr P, int layer) {
    const int G = C.G, lane = C.lane;
    const int gw = C.bx * 8 + C.wave, NGW = G * 8;
    u16* acmp = (u16*)(P->ws + WS_XN);
    for (int it = gw; it < 2 * 4096; it += NGW) {
        const int i = it >> 12, row = it & 4095, n = row & 127, bg = row >> 7, b = bg >> 1, g = bg & 1;
        u16* dst = acmp + (size_t)it * 2048; const float* pe = P->cmp_pe + (size_t)(layer * 2 + i) * 2048;
        const int col = (i == 0 ? C_NKC : C_NVC) + g * 64;
#pragma unroll
        for (int pass = 0; pass < 4; ++pass) { const int l = pass * 8 + (lane >> 3), d0 = (lane & 7) * 8;
            unsigned z0 = 0u; asm volatile("" : "+v"(z0)); u32x4 o = (u32x4){z0, z0, z0, z0};
            if (n < 127) { const u32x4 v = *(const u32x4*)(C.proj + ((size_t)b * SEQ + 16 * n + l) * PW + col + d0); const f32x4 e0 = *(const f32x4*)(pe + l * 64 + d0), e1 = *(const f32x4*)(pe + l * 64 + d0 + 4);
                o.x = pkbf(bf2f(v.x & 0xffffu) + e0.x, bf2f(v.x >> 16) + e0.y); o.y = pkbf(bf2f(v.y & 0xffffu) + e0.z, bf2f(v.y >> 16) + e0.w);
                o.z = pkbf(bf2f(v.z & 0xffffu) + e1.x, bf2f(v.z >> 16) + e1.y); o.w = pkbf(bf2f(v.w & 0xffffu) + e1.z, bf2f(v.w >> 16) + e1.w); }
            *(u32x4*)(dst + l * 64 + d0) = o; }
    }
}
__device__ __forceinline__ void prep_c(const Ctx& C, KParamsPtr P, int layer, int it0) {
    const int i = it0 >> 12, row0 = it0 & 4095, lane = lane_opaque(), tid = C.wave * 64 + lane, r32 = lane & 31, hi = lane >> 5;
    const float* w2 = P->cmp_w2 + (size_t)(layer * 2 + i) * 256 * 64;
    for (int e = tid; e < 256 * 64; e += 512) { const int k = e >> 6, c = e & 63; *(LAS u16*)(C.lds + c * 528 + k * 2) = (u16)(pkbf(w2[e], 0.f) & 0xffffu); }
    __syncthreads();
    const int wrow = row0 + C.wave * 32;
    const u16* hrow = (const u16*)(P->ws + WS_HID) + ((size_t)i * 4096 + wrow + r32) * 256 + hi * 8;
    f32x16 d0, d1;
#pragma unroll
    for (int r = 0; r < 16; ++r) { d0[r] = 0.f; d1[r] = 0.f; }
#pragma unroll 4
    for (int ks = 0; ks < 16; ++ks) {
        const bf16x8 a = *(const bf16x8*)(hrow + ks * 16);
        const bf16x8 b0 = *(const LAS bf16x8*)(C.lds + r32 * 528 + (ks * 16 + hi * 8) * 2);
        const bf16x8 b1 = *(const LAS bf16x8*)(C.lds + (32 + r32) * 528 + (ks * 16 + hi * 8) * 2);
        d0 = __builtin_amdgcn_mfma_f32_32x32x16_bf16(a, b0, d0, 0, 0, 0);
        d1 = __builtin_amdgcn_mfma_f32_32x32x16_bf16(a, b1, d1, 0, 0, 0);
    }
#pragma unroll
    for (int r = 0; r < 16; ++r) { const int row = wrow + crow(r, hi);
        const unsigned v0 = pkbf(d0[r], 0.f) & 0xffffu, v1 = pkbf(d1[r], 0.f) & 0xffffu;
        if (i == 0) { u16* o = (u16*)(P->ws + WS_KCMP) + (size_t)row * 64; o[r32] = (u16)v0; o[32 + r32] = (u16)v1; }
        else { const int bg = row >> 7, n = row & 127; u16* o = (u16*)(P->ws + WS_VCMPT) + (size_t)bg * 64 * 128 + (n & ~15) + pperm(n & 15); o[(size_t)r32 * 128] = (u16)v0; o[(size_t)(32 + r32) * 128] = (u16)v1; }
    }
}

__device__ __forceinline__ void convert_weights(const Ctx& C, KParamsPtr P, int layer) {
    LAS float* scr = (LAS float*)(C.lds + C.wave * 16384);
    const int gw = C.bx * 8 + C.wave, NGW = C.G * 8, lane = C.lane;
    constexpr int I_G = 16 * 88, I_D = 44 * 32, I_IN = 16 * 96, I_O = 16 * 32, I_W1 = 32 * 8;
    constexpr int NIT = 4 * I_G + 2 * I_D + I_IN + I_O + 2 * I_W1;
    unsigned char* ws = P->ws;
    for (int it = gw; it < NIT; it += NGW) {
        int r = it;
        if (r < 4 * I_G) { const int which = r / I_G; r -= which * I_G; const int kb = r / 88, nb = r % 88, n0 = nb * 32;
            const float* W = (which == 0 ? P->ffn1_gate : which == 1 ? P->ffn1_up : which == 2 ? P->ffn2_gate : P->ffn2_up) + (size_t)layer * DM * DFF;
            u16* WT = (u16*)(ws + (which < 2 ? WS_GU1 : WS_GU2));
            tr_item(W, DM, DFF, WT, kb, n0, (n0 >> 7) * 256 + (which & 1) * 128 + (n0 & 127), scr, lane); continue; }
        r -= 4 * I_G;
        if (r < 2 * I_D) { const int which = r / I_D; r -= which * I_D; const int kb = r / 32, nb = r % 32;
            const float* W = (which == 0 ? P->ffn1_down : P->ffn2_down) + (size_t)layer * DFF * DM;
            tr_item(W, DFF, DM, (u16*)(ws + (which == 0 ? WS_DN1 : WS_DN2)), kb, nb * 32, nb * 32, scr, lane); continue; }
        r -= 2 * I_D;
        if (r < I_IN) { const int kb = r / 96, nb = r % 96, n0 = nb * 32;
            const float cs = (n0 < C_MK || (n0 >= C_NQ && n0 < C_NKC)) ? 0.125f * LOG2E : (n0 >= C_DQ && n0 < C_DK) ? 0.17677669529663687f * LOG2E : 1.0f;
            tr_item(P->w_in + (size_t)layer * DM * INW, DM, INW, (u16*)(ws + WS_WIN), kb, n0, n0, scr, lane, cs); continue; }
        r -= I_IN;
        if (r < I_O) { const int kb = r / 32, nb = r % 32; tr_item(P->w_out + (size_t)layer * DM * DM, DM, DM, (u16*)(ws + WS_WOUT), kb, nb * 32, nb * 32, scr, lane); continue; }
        r -= I_O;
        { const int i = r / I_W1; r -= i * I_W1; const int kb = r / 8, nb = r % 8;
            tr_item(P->cmp_w1 + (size_t)(layer * 2 + i) * 2048 * 256, 2048, 256, (u16*)(ws + WS_W1) + (size_t)i * 256 * 2048, kb, nb * 32, nb * 32, scr, lane); }
    }
}
__device__ __forceinline__ void norm_phase(const Ctx& C, const float* src, const float* g, u16* dst16, float* dst32) {
    const int gw = C.bx * 8 + C.wave, NGW = C.G * 8;
    for (int m = gw; m < MTOK; m += NGW) norm_row(src + (size_t)m * DM, g, dst16 ? dst16 + (size_t)m * DM : nullptr, dst32 ? dst32 + (size_t)m * DM : nullptr, C.lane);
}

#define XB_TMO      128
#define XB_XCNT(j)  (256  + 64 * (j))
#define XB_XSUB(j)  (1280 + 64 * (j))
#define XB_XGEN(j)  (2304 + 64 * (j))
#define XB_TOP      3328
#define XB_TOPGEN   3392
#define XCD_BAR_WORDS 3456
#define XB_SPIN_CAP (1u << 18)

__device__ __forceinline__ unsigned xb_ld(unsigned* p)              { return __hip_atomic_load(p, __ATOMIC_RELAXED, __HIP_MEMORY_SCOPE_AGENT); }
__device__ __forceinline__ unsigned xb_add(unsigned* p, unsigned v) { return __hip_atomic_fetch_add(p, v, __ATOMIC_RELAXED, __HIP_MEMORY_SCOPE_AGENT); }
__device__ __forceinline__ unsigned xb_xcc_id() { return (unsigned)__builtin_amdgcn_s_getreg((3 << 11) | 20) & 0xFu; }
#define XB_SPIN(cond, bar) do { unsigned _sp = 0; while (cond) { __builtin_amdgcn_s_sleep(1); \
    if ((++_sp & 255u) == 0u) { if (xb_ld(&(bar)[XB_TMO])) break; if (_sp > XB_SPIN_CAP) { atomicAdd(&(bar)[XB_TMO], 1u); break; } } } } while (0)

struct XcdBarrier {
    unsigned* bar; unsigned x;
    volatile LAS unsigned* st;
};

__device__ __forceinline__ XcdBarrier xcd_barrier_post(unsigned* bar, volatile LAS unsigned* st) {
    XcdBarrier b; b.bar = bar; b.x = xb_xcc_id(); b.st = st;
    if (threadIdx.x == 0) (void)xb_add(&bar[XB_XCNT(b.x)], 1u);
    return b;
}
__device__ __forceinline__ void xcd_barrier_complete(unsigned* bar, unsigned x, unsigned& nloc, unsigned& nx) {
    const unsigned G = gridDim.x * gridDim.y * gridDim.z;
    unsigned sum, cnt, mine, sp = 0u;
    for (;;) {
        sum = 0u; cnt = 0u; mine = 0u;
#pragma unroll
        for (unsigned j = 0; j < 16; ++j) { const unsigned c = xb_ld(&bar[XB_XCNT(j)]); sum += c; cnt += (c > 0u) ? 1u : 0u; mine = (j == x) ? c : mine; }
        if (sum == G) break;
        __builtin_amdgcn_s_sleep(1);
        if ((++sp & 255u) == 0u) { if (xb_ld(&bar[XB_TMO])) break; if (sp > XB_SPIN_CAP) { atomicAdd(&bar[XB_TMO], 1u); break; } }
    }
    nloc = mine > 0u ? mine : 1u; nx = cnt > 0u ? cnt : 1u;
}

__device__ __forceinline__ void xcd_barrier(const XcdBarrier& b) {
    asm volatile("s_waitcnt vmcnt(0)" ::: "memory");
    __syncthreads();
    if (threadIdx.x == 0) {
        unsigned* bar = b.bar;
        __builtin_amdgcn_s_waitcnt(0);
        unsigned nloc = b.st[0], nx = b.st[1];
        if (nloc == 0u) { xcd_barrier_complete(bar, b.x, nloc, nx); b.st[0] = nloc; b.st[1] = nx; }
        const unsigned old = xb_add(&bar[XB_XSUB(b.x)], 1u);
        const unsigned gen = old / nloc;
        if (old + 1u == (gen + 1u) * nloc) {
            __builtin_amdgcn_fence(__ATOMIC_RELEASE, "agent");
            asm volatile("s_waitcnt vmcnt(0)" ::: "memory");
            const unsigned og = xb_add(&bar[XB_TOP], 1u);
            const unsigned tg = og / nx;
            if (og + 1u == (tg + 1u) * nx) xb_add(&bar[XB_TOPGEN], 1u);
            else XB_SPIN(xb_ld(&bar[XB_TOPGEN]) == tg, bar);
            __builtin_amdgcn_fence(__ATOMIC_ACQUIRE, "agent");
            xb_add(&bar[XB_XGEN(b.x)], 1u);
            asm volatile("s_waitcnt vmcnt(0)" ::: "memory");
        } else {
            XB_SPIN(xb_ld(&bar[XB_XGEN(b.x)]) == gen, bar);
            __builtin_amdgcn_fence(__ATOMIC_ACQUIRE, "agent");
            asm volatile("s_waitcnt vmcnt(0)" ::: "memory");
        }
    }
    __syncthreads();
}


struct OneUnit { int pm;
    __device__ __forceinline__ bool next(int i, pg8::Unit& u) const { if (i) return false; u.pm = pm; u.pn = 0; return true; }
    __device__ __forceinline__ void a_ready(const pg8::Unit&) const {}
    __device__ __forceinline__ void done(const pg8::Unit&) const {} };
__global__ void __launch_bounds__(512, 2) hybrid_fwd(Params P0) {
    extern __shared__ __attribute__((aligned(16))) unsigned char lds_raw[];
    const KParamsPtr kp0 = (KParamsPtr)__builtin_amdgcn_kernarg_segment_ptr();
    cg::grid_group grid = cg::this_grid();
    { volatile LAS unsigned* misc = (volatile LAS unsigned*)((LAS unsigned char*)lds_raw + MISC_OFF); if (threadIdx.x < 2) misc[threadIdx.x] = 0u; }
    __syncthreads();
    XcdBarrier bar = xcd_barrier_post((unsigned*)(P0.ws + WS_CTL) + 1024, (volatile LAS unsigned*)((LAS unsigned char*)lds_raw + MISC_OFF));
    const int ph_lo = P0.ph_lo, ph_hi = P0.ph_hi; const int wave_s = __builtin_amdgcn_readfirstlane(threadIdx.x >> 6);
    bool redone = false; (void)redone;
    for (int ph = ph_lo; ph < ph_hi; ++ph) {
        KParamsPtr kpl = kp0; asm volatile("" : "+s"(kpl));
        const KParamsPtr P = kpl; unsigned char* ws = P->ws;
        u16* XN = (u16*)(ws + WS_XN); u16* HB = (u16*)(ws + WS_PROJ);
        int G = gridDim.x, bx = blockIdx.x; asm volatile("" : "+s"(G), "+s"(bx));
        Ctx C; C.G = G; C.bx = bx; C.lds = (LAS unsigned char*)lds_raw; C.wave = wave_s; C.lane = lane_opaque(); C.tid = wave_s * 64 + C.lane; C.r32 = C.lane & 31; C.hi = C.lane >> 5;
        C.proj = (u16*)(ws + WS_PROJ); C.obuf = (u16*)(ws + WS_XN); C.vt = (u16*)(ws + WS_VT);
        const int layer = ph / NPH_L, s = ph % NPH_L;
        if (ph != NPH - 1 && s == 7) continue;
        if (ph == NPH - 1) { norm_phase(C, P->out, P->final_norm, nullptr, P->out); }
        else switch (s) {
        case 0: { convert_weights(C, P, layer); __syncthreads(); norm_phase(C, layer == 0 ? P->x : P->out, P->norm_ffn1 + (size_t)layer * DM, XN, nullptr); } break;
        case 3: { norm_phase(C, P->out, P->norm_mix + (size_t)layer * DM, XN, nullptr); } break;
        case 11: { norm_phase(C, P->out, P->norm_ffn2 + (size_t)layer * DM, XN, nullptr); } break;
#ifndef NO_GEMM
#ifndef NO_G1
        case 1: case 12: {
            pg8::Gemm g{XN, (const u16*)(ws + (s == 1 ? WS_GU1 : WS_GU2)), MTOK, 2 * DFF, DM}; pg8::StaticOrder S; S.init(MTOK, 2 * DFF, G, bx);
            pg8::EpiSwiGLU E{HB, DFF};
            pg8::gemm_phase<pg8::EpiSwiGLU, pg8::StaticOrder, true, true>(C.lds, g, S, E, C.wave); } break;
#endif
#ifndef NO_G2
        case 2: case 13: case 10: {
            const u16* A = (s == 10) ? (const u16*)XN : (const u16*)HB; const u16* Bt = (const u16*)(ws + (s == 2 ? WS_DN1 : s == 13 ? WS_DN2 : WS_WOUT));
            pg8::Gemm g{A, Bt, MTOK, DM, s == 10 ? DM : DFF}; pg8::StaticOrder S; S.init(MTOK, DM, G, bx);
            pg8::EpiResid E{(layer == 0 && s == 2) ? P->x : (const float*)P->out, P->out, DM, s == 10 ? 1.0f : 0.5f};
            pg8::gemm_phase<pg8::EpiResid, pg8::StaticOrder, true, true>(C.lds, g, S, E, C.wave); } break;
#endif
#ifndef NO_G4
        case 4: {
            pg8::Gemm g{XN, (const u16*)(ws + WS_WIN), MTOK, PW, DM}; pg8::StaticOrder S; S.init(MTOK, PW, G, bx);
            pg8::EpiBf16<0> E{C.proj, PW};
            pg8::gemm_phase<pg8::EpiBf16<0>, pg8::StaticOrder, true, true>(C.lds, g, S, E, C.wave); } break;
#endif
#endif
#ifndef NO_PREP
        case 5: prep_a(C, P, layer); prep_vk(C, P, 0); break;
#endif
#if !defined(NO_GEMM) && !defined(NO_G6)
        case 6: {
            unsigned* qctr = (unsigned*)(ws + WS_CTL) + 8192 + 64 * ph + (redone ? 32 : 0); volatile LAS unsigned* qslot = (volatile LAS unsigned*)(C.lds + MISC_OFF + 16);
            for (;;) {
                if (C.tid == 0) *qslot = __hip_atomic_fetch_add(qctr, 1u, __ATOMIC_RELAXED, __HIP_MEMORY_SCOPE_AGENT);
                __syncthreads();
                const unsigned u = *qslot;
                __syncthreads();
                if (u >= 32u + 1024u) break;
                if (u < 32u) { const int i = (int)u >> 4, tile = (int)u & 15;
                    pg8::Gemm g{(const u16*)XN + (size_t)i * 4096 * 2048, (const u16*)(ws + WS_W1) + (size_t)i * 256 * 2048, 4096, 256, 2048}; OneUnit S{tile};
                    pg8::EpiBf16<1> E{(u16*)(ws + WS_HID) + (size_t)i * 4096 * 256, 256};
                    pg8::gemm_phase<pg8::EpiBf16<1>, OneUnit, true, true>(C.lds, g, S, E, C.wave);
                    __builtin_amdgcn_fence(__ATOMIC_RELEASE, "agent"); __syncthreads(); __builtin_amdgcn_fence(__ATOMIC_ACQUIRE, "agent");
                    prep_c(C, P, layer, i * 4096 + tile * 256);
                    __syncthreads();
                } else { const unsigned v = u - 32u; const int qb = 7 - (int)(v >> 7), w = (int)(v & 127);
                    if (w < 64) {
#ifndef NO_DIFF
                        diff_unit(C, P, layer, w >> 2, w & 3, qb);
#endif
                    } else {
#ifndef NO_MOBA
                        moba_unit(C, P, (w - 64) >> 2, w & 3, qb);
#endif
                    } }
            } } break;
#endif
#ifndef NO_ATT1
        case 8: {
#ifndef NO_CMP
            for (int c = bx; c < 256; c += G) cmp_unit(C, P, c >> 4, (c >> 3) & 1, c & 7);
#endif
            } break;
#endif
#ifndef NO_ATT2
        case 9: {
            unsigned* qctr = (unsigned*)(ws + WS_CTL) + 8192 + 64 * ph; volatile LAS unsigned* qslot = (volatile LAS unsigned*)(C.lds + MISC_OFF + 16);
            for (;;) {
                if (C.tid == 0) *qslot = __hip_atomic_fetch_add(qctr, 1u, __ATOMIC_RELAXED, __HIP_MEMORY_SCOPE_AGENT);
                __syncthreads();
                const unsigned u = *qslot;
                __syncthreads();
                if (u >= 1024u) break;
                nsa_unit(C, P, (int)(u & 127) >> 3, (int)u & 7, 7 - (int)(u >> 7));
            } } break;
#endif
        default: break;
        }
        if (ph + 1 < ph_hi) { if (ph == ph_lo) grid.sync(); else xcd_barrier(bar); }
#ifdef PROBE_LO
        if (ph != NPH - 1 && s == PROBE_HI) { if (!redone) { ph -= (PROBE_HI - PROBE_LO + 1); redone = true; } else redone = false; }
#endif
#ifdef PROBE_SYNC
        if (ph + 1 < ph_hi) xcd_barrier(bar);
#endif
    }
}

#ifndef COOP
#define COOP 1
#endif
extern "C" void kernel_launch(void* const* d_in, const int* in_sizes, int n_in, void* d_out, int out_size, void* d_ws, size_t ws_size, hipStream_t stream) {
    static int grid = 0;
    if (grid == 0) {
        if (n_in != 19 || out_size != MTOK * DM || ws_size < WS_END) { fprintf(stderr, "kernel_launch: unexpected shapes (n_in %d out %d ws %zu)\n", n_in, out_size, ws_size); grid = -1; return; }
        int dev = 0, cus = 0, per_cu = 0;
        (void)hipGetDevice(&dev); (void)hipDeviceGetAttribute(&cus, hipDeviceAttributeMultiprocessorCount, dev);
        if (hipFuncSetAttribute((const void*)hybrid_fwd, hipFuncAttributeMaxDynamicSharedMemorySize, LDS_BYTES) != hipSuccess) { fprintf(stderr, "kernel_launch: hipFuncSetAttribute failed\n"); grid = -1; return; }
        if (hipOccupancyMaxActiveBlocksPerMultiprocessor(&per_cu, (const void*)hybrid_fwd, 512, LDS_BYTES) != hipSuccess || per_cu < 1) { fprintf(stderr, "kernel_launch: occupancy query says %d\n", per_cu); per_cu = 1; }
        (void)hipGetLastError();
        grid = cus * per_cu;
    }
    if (grid < 0) return;
    Params p{};
    p.x = (const float*)d_in[0]; p.rel_bias = (const float*)d_in[1]; p.norm_ffn1 = (const float*)d_in[2]; p.ffn1_gate = (const float*)d_in[3]; p.ffn1_up = (const float*)d_in[4]; p.ffn1_down = (const float*)d_in[5];
    p.norm_mix = (const float*)d_in[6]; p.w_in = (const float*)d_in[7]; p.diff_lambda = (const float*)d_in[8]; p.diff_subln = (const float*)d_in[9]; p.cmp_pe = (const float*)d_in[10]; p.cmp_w1 = (const float*)d_in[11];
    p.cmp_w2 = (const float*)d_in[12]; p.w_out = (const float*)d_in[13]; p.norm_ffn2 = (const float*)d_in[14]; p.ffn2_gate = (const float*)d_in[15]; p.ffn2_up = (const float*)d_in[16]; p.ffn2_down = (const float*)d_in[17];
    p.final_norm = (const float*)d_in[18]; p.out = (float*)d_out; p.ws = (unsigned char*)d_ws;
    for (int l = 0; l < 4; ++l) p.lam_init[l] = (float)(0.8 - 0.6 * exp(-0.3 * (double)l));
#if COOP
    if (hipMemsetAsync((char*)d_ws + WS_CTL, 0, CTL_ZERO_BYTES, stream) != hipSuccess) { fprintf(stderr, "kernel_launch: memset of barrier words failed\n"); return; }
    p.ph_lo = 0; p.ph_hi = NPH;
    void* args[] = {&p};
    hipError_t e = hipLaunchCooperativeKernel((const void*)hybrid_fwd, dim3(grid), dim3(512), args, LDS_BYTES, stream);
    if (e != hipSuccess) fprintf(stderr, "cooperative launch failed: %s (grid %d)\n", hipGetErrorString(e), grid);
#else
    for (int ph = 0; ph < NPH; ++ph) { p.ph_lo = ph; p.ph_hi = ph + 1; hipLaunchKernelGGL(hybrid_fwd, dim3(grid), dim3(512), LDS_BYTES, stream, p); }
#endif
}
```

```cpp
#include <hip/hip_runtime.h>
#include <hip/hip_cooperative_groups.h>
#include <cstdio>
#include <cstdint>
#include <cmath>
namespace cg = cooperative_groups;
#define COOP 1
namespace pg8 {
#define PG8_LAS __attribute__((address_space(3)))
typedef unsigned short bf16_t;
typedef short bf16x8 __attribute__((ext_vector_type(8)));
typedef float f32x4 __attribute__((ext_vector_type(4)));
typedef unsigned u32x4 __attribute__((ext_vector_type(4)));
constexpr int BM = 256, BK = 64, HALF = 128, HTB = HALF * BK * 2  , STAGE_BYTES = 8 * HTB, NXCD = 8, WGM = 8;

__host__ __device__ __forceinline__ int lds_byte(int r, int c) { const int st = (r >> 4) * 2 + (c >> 5), rr = r & 15, cc = c & 31, ob = rr * 64 + cc * 2; return st * 1024 + (ob ^ (((ob >> 9) & 1) << 5)); }
__host__ __device__ __forceinline__ void stage_rc(int b, int& R, int& C) { const int st = b / 1024, sb = b % 1024, swz = sb ^ (((sb >> 9) & 1) << 5); R = (st >> 1) * 16 + swz / 64; C = (st & 1) * 32 + (swz % 64) / 2; }
__host__ __device__ __forceinline__ int perm32(int rho) { const int n = rho >> 4, i = rho & 15; return 8 * (i >> 2) + 4 * n + (i & 3); }

struct Unit { int pm, pn; };
struct Gemm { const bf16_t* A; const bf16_t* Bt; int M, N, K; };

struct StaticOrder {
    int nM, nN, nwg, G, c;
    __host__ __device__ void init(int M, int N, int G_, int c_) { nM = M / BM; nN = N / BM; nwg = nM * nN; G = G_; c = c_; }
    __host__ __device__ bool next(int i, Unit& u) const {
        const long L = (long)i * G + c; if (L >= nwg) return false;
        int wgid = (int)L; { const int q = nwg / NXCD, r = nwg % NXCD, xcd = wgid % NXCD, off = wgid / NXCD; wgid = (xcd < r ? xcd * (q + 1) : r * (q + 1) + (xcd - r) * q) + off; }
        const int nig = WGM * nN, gid = wgid / nig, fm = gid * WGM, gsz = (nM - fm) < WGM ? (nM - fm) : WGM;
        u.pm = fm + ((wgid % nig) % gsz); u.pn = (wgid % nig) / gsz; return true;
    }
    __device__ __forceinline__ void a_ready(const Unit&) const {}
    __device__ __forceinline__ void done(const Unit&) const {}
};

__device__ __forceinline__ unsigned cvt_pk_bf16(float lo, float hi) { unsigned r; asm volatile("v_cvt_pk_bf16_f32 %0, %1, %2" : "=v"(r) : "v"(lo), "v"(hi)); return r; }

__device__ __forceinline__ float ex2(float x) { return __builtin_amdgcn_exp2f(x); }
__device__ __forceinline__ float rcpf_(float x) { return __builtin_amdgcn_rcpf(x); }
__device__ __forceinline__ float silu_f(float x) { return x * rcpf_(1.0f + ex2(-1.4426950408889634f * x)); }
__device__ __forceinline__ float gelu_tanh_f(float x) { const float y2 = 2.0f * 0.7978845608028654f * (x + 0.044715f * x * x * x); return x * (1.0f - rcpf_(1.0f + ex2(1.4426950408889634f * y2))); }

struct EpiSwiGLU {
    static constexpr bool PERM = true, AFTER_DRAIN = false;
    bf16_t* O; int ldc;
    __device__ __forceinline__ void operator()(const f32x4 (&acc)[2][2][4][2], const Unit& u, int wr, int wc, int fr, int fq) const {
        const int row0 = u.pm * BM + wr * 64 + fr; const int col0 = u.pn * HALF + wc * 32 + 8 * fq;
#pragma unroll
        for (int ai = 0; ai < 2; ++ai)
#pragma unroll
            for (int m = 0; m < 4; ++m) { bf16_t* rowp = O + (size_t)(row0 + ai * HALF + m * 16) * ldc + col0;
                const f32x4 g0 = acc[ai][0][m][0], g1 = acc[ai][0][m][1], u0 = acc[ai][1][m][0], u1 = acc[ai][1][m][1];
                u32x4 w; w.x = cvt_pk_bf16(silu_f(g0[0]) * u0[0], silu_f(g0[1]) * u0[1]); w.y = cvt_pk_bf16(silu_f(g0[2]) * u0[2], silu_f(g0[3]) * u0[3]);
                w.z = cvt_pk_bf16(silu_f(g1[0]) * u1[0], silu_f(g1[1]) * u1[1]); w.w = cvt_pk_bf16(silu_f(g1[2]) * u1[2], silu_f(g1[3]) * u1[3]);
                *(u32x4*)rowp = w; asm volatile("" ::: "memory"); }
    }
};
template <int ACT> struct EpiBf16 {
    static constexpr bool PERM = true, AFTER_DRAIN = false;
    bf16_t* O; int ldc;
    __device__ __forceinline__ void operator()(const f32x4 (&acc)[2][2][4][2], const Unit& u, int wr, int wc, int fr, int fq) const {
        const int row0 = u.pm * BM + wr * 64 + fr; const int col0 = u.pn * BM + wc * 32 + 8 * fq;
#pragma unroll
        for (int ai = 0; ai < 2; ++ai)
#pragma unroll
            for (int m = 0; m < 4; ++m) { bf16_t* rowp = O + (size_t)(row0 + ai * HALF + m * 16) * ldc + col0;
#pragma unroll
                for (int bj = 0; bj < 2; ++bj) { f32x4 v0 = acc[ai][bj][m][0], v1 = acc[ai][bj][m][1];
                    if (ACT == 1) { v0 = (f32x4){gelu_tanh_f(v0[0]), gelu_tanh_f(v0[1]), gelu_tanh_f(v0[2]), gelu_tanh_f(v0[3])}; v1 = (f32x4){gelu_tanh_f(v1[0]), gelu_tanh_f(v1[1]), gelu_tanh_f(v1[2]), gelu_tanh_f(v1[3])}; }
                    u32x4 w; w.x = cvt_pk_bf16(v0[0], v0[1]); w.y = cvt_pk_bf16(v0[2], v0[3]); w.z = cvt_pk_bf16(v1[0], v1[1]); w.w = cvt_pk_bf16(v1[2], v1[3]);
                    *(u32x4*)(rowp + bj * HALF) = w; } asm volatile("" ::: "memory"); }
    }
};
struct EpiResid {
    static constexpr bool PERM = true, AFTER_DRAIN = false;
    const float* base; float* out; int ldc; float alpha;
    __device__ __forceinline__ void operator()(const f32x4 (&acc)[2][2][4][2], const Unit& u, int wr, int wc, int fr, int fq) const {
        const int row0 = u.pm * BM + wr * 64 + fr; const int col0 = u.pn * BM + wc * 32 + 8 * fq;
#pragma unroll
        for (int ai = 0; ai < 2; ++ai) {
            f32x4 pre[4][2][2];
#pragma unroll
            for (int m = 0; m < 4; ++m)
#pragma unroll
                for (int bj = 0; bj < 2; ++bj)
#pragma unroll
                    for (int n = 0; n < 2; ++n) pre[m][bj][n] = *(const f32x4*)(base + (size_t)(row0 + ai * HALF + m * 16) * ldc + col0 + bj * HALF + n * 4);
#pragma unroll
            for (int m = 0; m < 4; ++m) { const size_t off = (size_t)(row0 + ai * HALF + m * 16) * ldc + col0;
#pragma unroll
                for (int bj = 0; bj < 2; ++bj) { *(f32x4*)(out + off + bj * HALF) = pre[m][bj][0] + acc[ai][bj][m][0] * alpha; *(f32x4*)(out + off + bj * HALF + 4) = pre[m][bj][1] + acc[ai][bj][m][1] * alpha; } }
            asm volatile("" ::: "memory");
        }
    }
};
template <class Epi, class Sched, bool ALIGN_EPI = false, bool SP2 = false>
__device__ __forceinline__ void gemm_phase(PG8_LAS unsigned char* lds, const Gemm g, const Sched& S, const Epi& E, const int wave_in) {
    int tid_l; asm volatile("v_mbcnt_lo_u32_b32 %0, -1, 0\n\tv_mbcnt_hi_u32_b32 %0, -1, %0" : "=v"(tid_l)); tid_l += wave_in * 64;
    const int tid = tid_l, wid = __builtin_amdgcn_readfirstlane(tid >> 6), lane = tid & 63, wr = wid >> 2, wc = wid & 3, fr = lane & 15, fq = lane >> 4;
    const int K = g.K, nt = K / BK;
    unsigned voffA[2], voffB[2];
#pragma unroll
    for (int i = 0; i < 2; ++i) { int R, C; stage_rc(tid * 16 + i * 8192, R, C); const int Rb = Epi::PERM ? ((R & ~31) + perm32(R & 31)) : R;
        voffA[i] = (unsigned)(R * K + C) * 2u; voffB[i] = (unsigned)(Rb * K + C) * 2u; }
    const size_t kstep = (size_t)(BK * 2);
    const size_t hstep = (size_t)HALF * K * 2;
    const size_t tstep = 2 * hstep;
    const unsigned ldsw = (unsigned)wid * 1024u;
    const int aoff = lds_byte(wr * 64 + fr, fq * 8), boff = lds_byte(wc * 32 + fr, fq * 8);
#define PG8_SA(b, h) (((b) * 2 + (h)) * HTB)
#define PG8_SB(b, h) ((4 + (b) * 2 + (h)) * HTB)
#define PG8_STAGE(bufoff, gbase, voff) do { _Pragma("unroll") for (int _i = 0; _i < 2; ++_i) \
        __builtin_amdgcn_global_load_lds((const unsigned*)((const char*)(gbase) + (voff)[_i]), (PG8_LAS unsigned*)(lds + (bufoff) + ldsw + _i * 8192), 16, 0, 0); } while (0)
#define PG8_LDA(dst, b, h) do { _Pragma("unroll") for (int m = 0; m < 4; ++m) _Pragma("unroll") for (int k = 0; k < 2; ++k) dst[m][k] = *(const PG8_LAS bf16x8*)(lds + PG8_SA(b, h) + aoff + m * 2048 + k * 1024); } while (0)
#define PG8_LDB(dst, b, h) do { _Pragma("unroll") for (int n = 0; n < 2; ++n) _Pragma("unroll") for (int k = 0; k < 2; ++k) dst[n][k] = *(const PG8_LAS bf16x8*)(lds + PG8_SB(b, h) + boff + n * 2048 + k * 1024); } while (0)
#define PG8_MMA(ai, bj, At, Bt) do { __builtin_amdgcn_s_setprio(1); _Pragma("unroll") for (int m = 0; m < 4; ++m) _Pragma("unroll") for (int n = 0; n < 2; ++n) _Pragma("unroll") for (int k = 0; k < 2; ++k) \
        acc[ai][bj][m][n] = __builtin_amdgcn_mfma_f32_16x16x32_bf16(Bt[n][k], At[m][k], acc[ai][bj][m][n], 0, 0, 0); __builtin_amdgcn_s_setprio(0); } while (0)
#define PG8_WAIT_V(n) asm volatile("s_waitcnt vmcnt(" #n ")" ::: "memory")
#define PG8_WAIT_L(n) asm volatile("s_waitcnt lgkmcnt(" #n ")" ::: "memory")
#define PG8_BAR __builtin_amdgcn_s_barrier()
#define PG8_SCHED __builtin_amdgcn_sched_barrier(0)
    Unit cur, nxt; int ui = 0;
    if (!S.next(0, cur)) return;
    f32x4 acc[2][2][4][2];
#pragma unroll
    for (int a = 0; a < 2; ++a)
#pragma unroll
        for (int b = 0; b < 2; ++b)
#pragma unroll
            for (int m = 0; m < 4; ++m)
#pragma unroll
                for (int n = 0; n < 2; ++n) acc[a][b][m][n] = (f32x4){0.f, 0.f, 0.f, 0.f};
    bf16x8 At[4][2], B0[2][2], B1[2][2];
    const char* cA = (const char*)g.A + (size_t)cur.pm * tstep; const char* cB = (const char*)g.Bt + (size_t)cur.pn * tstep;
    S.a_ready(cur);
    if constexpr (SP2) {
        PG8_STAGE(PG8_SB(0, 0), cB, voffB); PG8_STAGE(PG8_SB(0, 1), cB + hstep, voffB); PG8_STAGE(PG8_SA(0, 0), cA, voffA); PG8_STAGE(PG8_SA(0, 1), cA + hstep, voffA);
        if (wr == 1) PG8_BAR;
        PG8_WAIT_V(2); PG8_BAR;
        PG8_STAGE(PG8_SB(1, 0), cB + kstep, voffB); PG8_STAGE(PG8_SA(1, 0), cA + kstep, voffA); PG8_STAGE(PG8_SB(1, 1), cB + hstep + kstep, voffB);
        PG8_WAIT_V(6); PG8_BAR;
    } else {
        PG8_STAGE(PG8_SB(0, 0), cB, voffB); PG8_STAGE(PG8_SA(0, 0), cA, voffA); PG8_STAGE(PG8_SB(0, 1), cB + hstep, voffB); PG8_STAGE(PG8_SA(0, 1), cA + hstep, voffA);
        if (wr == 1) PG8_BAR;
        PG8_WAIT_V(4); PG8_BAR;
        PG8_STAGE(PG8_SB(1, 0), cB + kstep, voffB); PG8_STAGE(PG8_SA(1, 0), cA + kstep, voffA); PG8_STAGE(PG8_SB(1, 1), cB + hstep + kstep, voffB);
        PG8_WAIT_V(6); PG8_BAR;
    }
    for (;;) {
        const bool has_next = S.next(ui + 1, nxt);
        const char* nA = has_next ? (const char*)g.A + (size_t)nxt.pm * tstep : cA; const char* nB = has_next ? (const char*)g.Bt + (size_t)nxt.pn * tstep : cB;
        for (int t = 0; t < nt; t += 2) {
            const bool last = (t == nt - 2);
            const char* a1 = cA + (size_t)(t + 1) * kstep;
            const char* a2 = last ? nA : cA + (size_t)(t + 2) * kstep; const char* b2 = last ? nB : cB + (size_t)(t + 2) * kstep;
            const char* a3 = a2 + kstep; const char* b3 = b2 + kstep;
            if (last && has_next) S.a_ready(nxt);
            if constexpr (SP2) {
            PG8_LDB(B0, 0, 0); PG8_LDB(B1, 0, 1); PG8_SCHED; PG8_LDA(At, 0, 0); PG8_STAGE(PG8_SA(1, 1), a1 + hstep, voffA);
            PG8_WAIT_V(8); PG8_WAIT_L(0); PG8_BAR; PG8_MMA(0, 0, At, B0); PG8_MMA(0, 1, At, B1); PG8_BAR; PG8_SCHED;
            PG8_LDA(At, 0, 1); PG8_STAGE(PG8_SB(0, 0), b2, voffB); PG8_STAGE(PG8_SB(0, 1), b2 + hstep, voffB); PG8_STAGE(PG8_SA(0, 0), a2, voffA);
            PG8_WAIT_V(8); PG8_WAIT_L(0); PG8_BAR; PG8_MMA(1, 0, At, B0); PG8_MMA(1, 1, At, B1); PG8_BAR; PG8_SCHED;
            PG8_LDB(B0, 1, 0); PG8_LDB(B1, 1, 1); PG8_SCHED; PG8_LDA(At, 1, 0); PG8_STAGE(PG8_SA(0, 1), a2 + hstep, voffA);
            PG8_WAIT_V(8); PG8_WAIT_L(0); PG8_BAR; PG8_MMA(0, 0, At, B0); PG8_MMA(0, 1, At, B1); PG8_BAR; PG8_SCHED;
            PG8_LDA(At, 1, 1); PG8_STAGE(PG8_SB(1, 0), b3, voffB); PG8_STAGE(PG8_SB(1, 1), b3 + hstep, voffB); PG8_STAGE(PG8_SA(1, 0), a3, voffA);
            PG8_WAIT_V(8); PG8_WAIT_L(0); PG8_BAR; PG8_MMA(1, 0, At, B0); PG8_MMA(1, 1, At, B1); PG8_BAR; PG8_SCHED;
            } else {
            PG8_LDB(B0, 0, 0); PG8_SCHED; PG8_LDA(At, 0, 0); PG8_STAGE(PG8_SA(1, 1), a1 + hstep, voffA);
            PG8_WAIT_L(8); PG8_BAR; PG8_WAIT_L(0); PG8_MMA(0, 0, At, B0); PG8_BAR; PG8_SCHED;
            PG8_LDB(B1, 0, 1); PG8_STAGE(PG8_SB(0, 0), b2, voffB);
            PG8_BAR; PG8_WAIT_L(0); PG8_MMA(0, 1, At, B1); PG8_BAR;
            PG8_LDA(At, 0, 1); PG8_STAGE(PG8_SA(0, 0), a2, voffA);
            PG8_BAR; PG8_WAIT_L(0); PG8_MMA(1, 0, At, B0); PG8_BAR; PG8_SCHED;
            PG8_STAGE(PG8_SB(0, 1), b2 + hstep, voffB);
            PG8_WAIT_V(6); PG8_BAR; PG8_MMA(1, 1, At, B1); PG8_BAR;
            PG8_LDB(B0, 1, 0); PG8_SCHED; PG8_LDA(At, 1, 0); PG8_STAGE(PG8_SA(0, 1), a2 + hstep, voffA);
            PG8_WAIT_L(8); PG8_BAR; PG8_WAIT_L(0); PG8_MMA(0, 0, At, B0); PG8_BAR; PG8_SCHED;
            PG8_LDB(B1, 1, 1); PG8_STAGE(PG8_SB(1, 0), b3, voffB);
            PG8_BAR; PG8_WAIT_L(0); PG8_MMA(0, 1, At, B1); PG8_BAR;
            PG8_LDA(At, 1, 1); PG8_STAGE(PG8_SA(1, 0), a3, voffA);
            PG8_BAR; PG8_WAIT_L(0); PG8_MMA(1, 0, At, B0); PG8_BAR; PG8_SCHED;
            PG8_STAGE(PG8_SB(1, 1), b3 + hstep, voffB);
            PG8_WAIT_V(6); PG8_BAR; PG8_MMA(1, 1, At, B1); PG8_BAR;
            }
        }
        if constexpr (ALIGN_EPI) { if (wr == 0) PG8_BAR; }
        if constexpr (!Epi::AFTER_DRAIN) { E(acc, cur, wr, wc, fr, fq); S.done(cur); }
        if (!has_next) break;
#pragma unroll
        for (int a = 0; a < 2; ++a)
#pragma unroll
            for (int b = 0; b < 2; ++b)
#pragma unroll
                for (int m = 0; m < 4; ++m)
#pragma unroll
                    for (int n = 0; n < 2; ++n) acc[a][b][m][n] = (f32x4){0.f, 0.f, 0.f, 0.f};
        cur = nxt; cA = nA; cB = nB; ++ui;
        if constexpr (ALIGN_EPI) { if (wr == 1) PG8_BAR; }
    }
    PG8_WAIT_V(0);
    if constexpr (!ALIGN_EPI) { if (wr == 0) PG8_BAR; }
    PG8_BAR;
    if constexpr (Epi::AFTER_DRAIN) { E.fused(acc, cur, wr, wc, fr, fq, lds, wid, lane); S.done(cur); }
#undef PG8_SA
#undef PG8_SB
#undef PG8_STAGE
#undef PG8_LDA
#undef PG8_LDB
#undef PG8_MMA
#undef PG8_WAIT_V
#undef PG8_WAIT_L
#undef PG8_BAR
#undef PG8_SCHED
}
}

#define LAS __attribute__((address_space(3)))
using pg8::ex2; using pg8::rcpf_;
typedef unsigned short u16;
typedef short bf16x8 __attribute__((ext_vector_type(8)));
typedef float f32x4 __attribute__((ext_vector_type(4)));
typedef float f32x16 __attribute__((ext_vector_type(16)));
typedef unsigned u32x4 __attribute__((ext_vector_type(4)));
typedef unsigned u32x2 __attribute__((ext_vector_type(2)));

constexpr int DM = 1024, NB = 16, SEQ = 2048, MTOK = NB * SEQ, DEPTH = 4, DFF = 2816, INW = 2840, PW = 3072;
constexpr int C_MQ = 0, C_MK = 256, C_MV = 512, C_DQ = 768, C_DK = 1024, C_DV = 1280, C_NQ = 1536, C_NKC = 2048, C_NVC = 2176, C_NKS = 2304, C_NVS = 2432, C_NKW = 2560, C_NVW = 2688, C_NG = 2816;
constexpr int NVH = 12;
constexpr float LOG2E = 1.4426950408889634f, NEGF = -1e30f;
constexpr int NPH_L = 14, NPH = NPH_L * DEPTH + 1;
constexpr size_t MiB = 1u << 20;
constexpr size_t WS_GU1 = 1 * MiB, WS_DN1 = 12 * MiB, WS_GU2 = WS_DN1 + 5 * MiB + MiB / 2, WS_DN2 = WS_GU2 + 11 * MiB, WS_WIN = 34 * MiB, WS_WOUT = 40 * MiB, WS_W1 = 42 * MiB;
constexpr size_t WS_PROJ = 44 * MiB, WS_XN = 236 * MiB, WS_VT = 300 * MiB, WS_HID = 348 * MiB, WS_KCMP = 352 * MiB, WS_VCMPT = WS_KCMP + MiB / 2, WS_KMEAN = 353 * MiB, WS_SEL = WS_KMEAN + MiB / 4, WS_END = 354 * MiB;
static_assert(WS_DN2 + 5 * MiB + MiB / 2 == WS_WIN, "ws map");
constexpr int LDS_BYTES = 147456, MISC_OFF = 147456 - 64;
constexpr size_t WS_CTL = 0, CTL_ZERO_BYTES = 65536;
constexpr int ATT_K = 0, ATT_V = 32768, ATT_LUT = 65536, ATT_PARK = 68608;
constexpr int CMP_K = 0, CMP_V = 18432, CMP_A = 36864, CMP_H = CMP_A + 256 * 33 * 4;

struct Params {
    const float* x; const float* rel_bias; const float* norm_ffn1; const float* ffn1_gate; const float* ffn1_up; const float* ffn1_down;
    const float* norm_mix; const float* w_in; const float* diff_lambda; const float* diff_subln; const float* cmp_pe; const float* cmp_w1; const float* cmp_w2;
    const float* w_out; const float* norm_ffn2; const float* ffn2_gate; const float* ffn2_up; const float* ffn2_down; const float* final_norm;
    float* out; unsigned char* ws;
    float lam_init[4];
    int ph_lo, ph_hi;
};
typedef const __attribute__((address_space(4))) Params* KParamsPtr;

__device__ __forceinline__ float bf2f(unsigned v) { return __uint_as_float(v << 16); }
typedef float f32x2_t __attribute__((ext_vector_type(2))); typedef __bf16 bf16x2_t __attribute__((ext_vector_type(2)));
__device__ __forceinline__ unsigned pkbf(float lo, float hi) { f32x2_t v = {lo, hi}; bf16x2_t b = __builtin_convertvector(v, bf16x2_t); return __builtin_bit_cast(unsigned, b); }
__device__ __forceinline__ int lane_opaque() { int l; asm volatile("v_mbcnt_lo_u32_b32 %0, -1, 0\n\tv_mbcnt_hi_u32_b32 %0, -1, %0" : "=v"(l)); return l; }
__device__ __forceinline__ float wave_sum(float v, int lane) {
#pragma unroll
    for (int o = 1; o < 64; o <<= 1) v += __int_as_float(__builtin_amdgcn_ds_bpermute((lane ^ o) << 2, __float_as_int(v)));
    return v;
}
__device__ __forceinline__ float xhalf_max(float v) { auto rr = __builtin_amdgcn_permlane32_swap(__float_as_uint(v), __float_as_uint(v), false, false); return fmaxf(__uint_as_float(rr[0]), __uint_as_float(rr[1])); }
__device__ __forceinline__ float xhalf_sum(float v) { auto rr = __builtin_amdgcn_permlane32_swap(__float_as_uint(v), __float_as_uint(v), false, false); return __uint_as_float(rr[0]) + __uint_as_float(rr[1]); }
__device__ __forceinline__ float sigmoid_f(float x) { return rcpf_(1.0f + ex2(-LOG2E * x)); }
__device__ __forceinline__ int crow(int r, int hi) { return (r & 3) + 8 * (r >> 2) + 4 * hi; }
__device__ __forceinline__ int kperm(int p) { const int h = p >> 3, j = p & 7; return 8 * (j >> 2) + 4 * h + (j & 3); }
__device__ __forceinline__ int pperm(int k) { return ((k >> 2) & 1) * 8 + (k >> 3) * 4 + (k & 3); }

__device__ __forceinline__ void tr_item(const float* W, int K, int N, u16* WT, int kb, int n0, int dst_row0, LAS float* scr, int lane, float cs = 1.0f) {
    const int k0 = 64 * kb; const int n = n0 + (lane & 31); const bool ok = n < N;
    float wv[32];
#pragma unroll
    for (int i = 0; i < 32; ++i) { const int kk = 2 * i + (lane >> 5); wv[i] = ok ? W[(size_t)(k0 + kk) * N + n] : 0.f; }
#pragma unroll
    for (int i = 0; i < 32; ++i) { const int kk = 2 * i + (lane >> 5); scr[kk * 33 + (lane & 31)] = wv[i] * cs; }
    asm volatile("s_waitcnt lgkmcnt(0)" ::: "memory");
    const int c = lane & 7;
#pragma unroll
    for (int j = 0; j < 4; ++j) { const int nn = (lane >> 3) + 8 * j; const LAS float* s = scr + (8 * c) * 33 + nn;
        u32x4 o; o.x = pkbf(s[0 * 33], s[1 * 33]); o.y = pkbf(s[2 * 33], s[3 * 33]); o.z = pkbf(s[4 * 33], s[5 * 33]); o.w = pkbf(s[6 * 33], s[7 * 33]);
        *(u32x4*)(WT + (size_t)(dst_row0 + nn) * K + k0 + 8 * c) = o; }
    asm volatile("s_waitcnt lgkmcnt(0)" ::: "memory");
}

__device__ __forceinline__ void norm_row(const float* xrow, const float* g, u16* dst16, float* dst32, int lane) {
    const f32x4* xr = (const f32x4*)xrow + lane; const f32x4* gr = (const f32x4*)g + lane;
    f32x4 v[4]; float s = 0.f;
#pragma unroll
    for (int j = 0; j < 4; ++j) { v[j] = xr[64 * j]; s += (v[j].x * v[j].x + v[j].y * v[j].y) + (v[j].z * v[j].z + v[j].w * v[j].w); }
    const float rstd = 1.0f / sqrtf(wave_sum(s, lane) * (1.0f / 1024.0f) + 1e-6f);
#pragma unroll
    for (int j = 0; j < 4; ++j) { const f32x4 gg = gr[64 * j]; const f32x4 y = v[j] * rstd * gg;
        if (dst16) { u32x2 o; o.x = pkbf(y.x, y.y); o.y = pkbf(y.z, y.w); *((u32x2*)dst16 + lane + 64 * j) = o; }
        else *((f32x4*)dst32 + lane + 64 * j) = y; }
}

struct AState { f32x16 o0, o1; float m, l; };
__device__ __forceinline__ void astate_init(AState& s) {
#pragma unroll
    for (int r = 0; r < 16; ++r) { s.o0[r] = 0.f; s.o1[r] = 0.f; }
    s.m = 0.f; s.l = 0.f;
}
constexpr float ATT_THR = 8.0f;
constexpr int ATT_SLOT = 9216, ATT_NSLOT = 3;
template <int KS0, int NKS>
__device__ __forceinline__ void qk_block(const LAS unsigned char* Ks, const bf16x8 (&qr)[4], int r32, int hi, f32x16& s0, f32x16& s1) {
    f32x16 ci;
#pragma unroll
    for (int r = 0; r < 16; ++r) ci[r] = 0.f;
    const LAS unsigned char* kp = Ks + hi * 1024 + r32 * 16;
#pragma unroll
    for (int ks = 0; ks < NKS; ++ks) {
        const bf16x8 a0 = *(const LAS bf16x8*)(kp + (KS0 + ks) * 2048);
        const bf16x8 a1 = *(const LAS bf16x8*)(kp + (KS0 + ks) * 2048 + 512);
        s0 = __builtin_amdgcn_mfma_f32_32x32x16_bf16(a0, qr[KS0 + ks], ks == 0 ? ci : s0, 0, 0, 0);
        s1 = __builtin_amdgcn_mfma_f32_32x32x16_bf16(a1, qr[KS0 + ks], ks == 0 ? ci : s1, 0, 0, 0);
    }
    __builtin_amdgcn_sched_group_barrier(0x100, 2 * NKS, 0); __builtin_amdgcn_sched_group_barrier(0x008, 2 * NKS, 0);
}
__device__ __forceinline__ void pv_block(const LAS unsigned char* Vs, const u32x4 (&pk)[4], int r32, int hi, AState& st) {
    const LAS unsigned char* vp = Vs + hi * 1024 + r32 * 16;
#pragma unroll
    for (int c = 0; c < 4; ++c) {
        const bf16x8 v0 = *(const LAS bf16x8*)(vp + c * 2048);
        const bf16x8 v1 = *(const LAS bf16x8*)(vp + c * 2048 + 512);
        const bf16x8 pb = __builtin_bit_cast(bf16x8, pk[c]);
        st.o0 = __builtin_amdgcn_mfma_f32_32x32x16_bf16(v0, pb, st.o0, 0, 0, 0);
        st.o1 = __builtin_amdgcn_mfma_f32_32x32x16_bf16(v1, pb, st.o1, 0, 0, 0);
    }
    __builtin_amdgcn_sched_group_barrier(0x100, 8, 0); __builtin_amdgcn_sched_group_barrier(0x008, 8, 0);
}
__device__ __forceinline__ void glds16(const void* gsrc, unsigned lds_dst) { unsigned keep;
    asm volatile("s_mov_b32 %0, m0\n\ts_mov_b32 m0, %2\n\ts_nop 0\n\tglobal_load_lds_dwordx4 %1, off\n\ts_mov_b32 m0, %0" : "=&s"(keep) : "v"(gsrc), "s"(lds_dst) : "memory"); }
__device__ __forceinline__ void lut_add(f32x16& s0, f32x16& s1, const LAS float* lutz, int dbase, float cc) {
    const LAS float* lp = lutz + (dbase - 59);
#pragma unroll
    for (int r = 0; r < 16; ++r) { const int ko = (r & 3) + 8 * (r >> 2);
        s0[r] += lp[59 - ko] + cc; s1[r] += lp[27 - ko] + cc; }
}
__device__ __forceinline__ void const_add(f32x16& s0, f32x16& s1, float cc) {
#pragma unroll
    for (int r = 0; r < 16; ++r) { s0[r] += cc; s1[r] += cc; }
}
__device__ __forceinline__ float row_max(const f32x16& s0, const f32x16& s1) {
    float mx = fmaxf(s0[0], s1[0]);
#pragma unroll
    for (int r = 1; r < 16; ++r) mx = fmaxf(mx, fmaxf(s0[r], s1[r]));
    return xhalf_max(mx);
}
__device__ __forceinline__ void rescale(AState& st, f32x16& s0, f32x16& s1, float mx) {
    const float dl = fmaxf(mx, 0.f); const float f = ex2(-dl); st.m += dl; st.l *= f;
#pragma unroll
    for (int r = 0; r < 16; ++r) { st.o0[r] *= f; st.o1[r] *= f; s0[r] -= dl; s1[r] -= dl; }
}
__device__ __forceinline__ void exp_pack(f32x16& s0, f32x16& s1, u32x4 (&pk)[4], AState& st) {
    float sum = 0.f;
#pragma unroll
    for (int r = 0; r < 16; ++r) { s0[r] = ex2(s0[r]); s1[r] = ex2(s1[r]); sum += s0[r] + s1[r]; }
    st.l += sum;
    pk[0] = (u32x4){pkbf(s0[0], s0[1]), pkbf(s0[2], s0[3]), pkbf(s0[4], s0[5]), pkbf(s0[6], s0[7])};
    pk[1] = (u32x4){pkbf(s0[8], s0[9]), pkbf(s0[10], s0[11]), pkbf(s0[12], s0[13]), pkbf(s0[14], s0[15])};
    pk[2] = (u32x4){pkbf(s1[0], s1[1]), pkbf(s1[2], s1[3]), pkbf(s1[4], s1[5]), pkbf(s1[6], s1[7])};
    pk[3] = (u32x4){pkbf(s1[8], s1[9]), pkbf(s1[10], s1[11]), pkbf(s1[12], s1[13]), pkbf(s1[14], s1[15])};
}

template <int KS0, int NKS, bool WINDOW, int MODE>
__device__ __forceinline__ void run_tiles(LAS unsigned char* lds, int t0, int t1, const u16* Kg, const u16* Vtg, const bf16x8 (&qr)[4], float c31,
                                          int q0w, unsigned mask, int qb, AState& A, int wave, int lane, int r32, int hi) {
    LAS unsigned char* Kr = lds + ATT_K; LAS unsigned char* Vr = lds + ATT_V; const LAS float* lut1 = (const LAS float*)(lds + ATT_LUT) + 96;
    const u16* ksrc = Kg + (size_t)lane * PW + wave * 8;
    const u16* vsrc = Vtg + (size_t)lane * SEQ + wave * 8;
    const unsigned kdst = (unsigned)(uintptr_t)Kr + wave * 1024, vdst = (unsigned)(uintptr_t)Vr + wave * 1024;
#define TCL(t) ((t) < t0 ? t0 : ((t) > t1 ? t1 : (t)))
#define DMA_K(tn) glds16(ksrc + (size_t)TCL(tn) * 64 * PW, (unsigned)__builtin_amdgcn_readfirstlane(kdst + ((tn) & 3) * 8192))
#define DMA_V(tn) glds16(vsrc + TCL(tn) * 64, (unsigned)__builtin_amdgcn_readfirstlane(vdst + ((tn) & 3) * 8192))
#define KS_(t) (Kr + ((t) & 3) * 8192)
#define VS_(t) (Vr + ((t) & 3) * 8192)
#define WAIT_BAR4() asm volatile("s_waitcnt vmcnt(4) lgkmcnt(0)\n\ts_barrier" ::: "memory")
#define T_ACTIVE(t) (!((q0w + 31 - (t) * 64) < 0 || (WINDOW && (q0w - ((t) * 64 + 63)) >= 512)))
#define T_LUTMODE(t) (((q0w - ((t) * 64 + 63)) < 128) || (WINDOW && (q0w + 31 - (t) * 64) >= 512))
    auto tile_sel = [&](int t) -> int { if (MODE == 1) { const int blk = t >> 2; return blk < qb ? (int)((mask >> blk) & 1u) : 1; } if (MODE == 2) return (int)((mask >> t) & 1u); return 1; };
    asm volatile("s_waitcnt vmcnt(0)" ::: "memory");
#pragma unroll
    for (int j = 0; j < 4; ++j) { DMA_K(t0 + j); DMA_V(t0 + j - 2); }
    WAIT_BAR4();
    f32x16 sn0, sn1, sc0, sc1; u32x4 pk[4];
#pragma unroll
    for (int r = 0; r < 16; ++r) { sn0[r] = 0.f; sn1[r] = 0.f; }
#pragma unroll
    for (int i = 0; i < 4; ++i) pk[i] = (u32x4){0u, 0u, 0u, 0u};
    bool act_n = T_ACTIVE(t0), act_c = false, act_p = false;
    if (act_n) qk_block<KS0, NKS>(KS_(t0), qr, r32, hi, sn0, sn1);
    asm volatile("s_waitcnt lgkmcnt(0)\n\ts_barrier" ::: "memory");
    for (int c = t0; c <= t1 + 1; ++c) {
        act_p = act_c; act_c = act_n; sc0 = sn0; sc1 = sn1;
        DMA_K(c + 4); DMA_V(c + 2);
        act_n = (c + 1 <= t1) && T_ACTIVE(c + 1);
        const bool lm_c = T_LUTMODE(c);
        const int dbase = q0w + r32 - c * 64 - 4 * hi;
        const float selc = tile_sel(c) ? (lm_c ? 0.f : c31) : NEGF;
        if (act_p) pv_block(VS_(c - 1), pk, r32, hi, A);
        if (act_c) {
            if (lm_c) lut_add(sc0, sc1, lut1, dbase, selc - A.m); else const_add(sc0, sc1, selc - A.m);
            const float mx = row_max(sc0, sc1);
            if (__any(mx > ATT_THR)) rescale(A, sc0, sc1, mx);
        }
        if (act_n) qk_block<KS0, NKS>(KS_(c + 1), qr, r32, hi, sn0, sn1);
        if (act_c) exp_pack(sc0, sc1, pk, A);
        WAIT_BAR4();
    }
    asm volatile("s_waitcnt vmcnt(0) lgkmcnt(0)\n\ts_barrier" ::: "memory");
#undef TCL
#undef DMA_K
#undef DMA_V
#undef KS_
#undef VS_
#undef WAIT_BAR4
#undef T_ACTIVE
#undef T_LUTMODE
}

__device__ __forceinline__ void build_lut(LAS unsigned char* lds, const float* rel_bias, int head, bool window, int tid) {
    LAS float* lut = (LAS float*)(lds + ATT_LUT);
    for (int i = tid; i < 704; i += 512) {
        const int d = i - 96; float v;
        if (d < 0) v = NEGF;
        else if (d >= 512) v = window ? NEGF : rel_bias[31 * 16 + head] * LOG2E;
        else { int bk;
            if (d < 16) bk = d; else if (d >= 128) bk = 31; else { bk = 16 + (int)(log2f((float)d * (1.0f / 16.0f)) * (16.0f / 3.0f)); bk = bk > 31 ? 31 : bk; }
            v = rel_bias[bk * 16 + head] * LOG2E; }
        lut[i] = v;
    }
}
__device__ __forceinline__ void load_q(bf16x8 (&qr)[4], const u16* qrow, int hi) {
#pragma unroll
    for (int ks = 0; ks < 4; ++ks) qr[ks] = *(const bf16x8*)(qrow + ks * 16 + hi * 8);
}
__device__ __forceinline__ void store_o(u16* dst, const f32x16& v0, const f32x16& v1, int hi) {
#pragma unroll
    for (int g = 0; g < 4; ++g) {
        u32x2 a; a.x = pkbf(v0[4 * g], v0[4 * g + 1]); a.y = pkbf(v0[4 * g + 2], v0[4 * g + 3]); *(u32x2*)(dst + 8 * g + 4 * hi) = a;
        u32x2 b; b.x = pkbf(v1[4 * g], v1[4 * g + 1]); b.y = pkbf(v1[4 * g + 2], v1[4 * g + 3]); *(u32x2*)(dst + 32 + 8 * g + 4 * hi) = b;
    }
}

struct Ctx { LAS unsigned char* lds; int tid, lane, wave, r32, hi, G, bx; u16* proj; u16* obuf; u16* vt; };

__device__ __forceinline__ void moba_unit(const Ctx& C0, KParamsPtr P, int b, int h, int qb) {
    Ctx C = C0; C.lane = lane_opaque(); C.tid = C.wave * 64 + C.lane; C.r32 = C.lane & 31; C.hi = C.lane >> 5;
    const int q0w = __builtin_amdgcn_readfirstlane(qb * 256 + C.wave * 32); const int qpos = q0w + C.r32; const size_t tok = (size_t)b * SEQ + qpos;
    build_lut(C.lds, P->rel_bias, h, false, C.tid);
    const u16* qrow = C.proj + tok * PW + C_MQ + h * 64;
    bf16x8 qr[4]; load_q(qr, qrow, C.hi);
    unsigned mask = 0;
    if (qb > 0) {
        float g[7];
#pragma unroll
        for (int j = 0; j < 7; ++j) g[j] = 0.f;
        const float* km = (const float*)(P->ws + WS_KMEAN) + (size_t)((b * 4 + h) * 8) * 64;
#pragma unroll
        for (int dc = 0; dc < 8; ++dc) {
            const u32x4 qv = *(const u32x4*)(qrow + dc * 8);
            float qf[8]; qf[0] = bf2f(qv.x & 0xffffu); qf[1] = bf2f(qv.x >> 16); qf[2] = bf2f(qv.y & 0xffffu); qf[3] = bf2f(qv.y >> 16);
            qf[4] = bf2f(qv.z & 0xffffu); qf[5] = bf2f(qv.z >> 16); qf[6] = bf2f(qv.w & 0xffffu); qf[7] = bf2f(qv.w >> 16);
#pragma unroll
            for (int j = 0; j < 7; ++j) if (j < qb) { const float* kmj = km + j * 64 + dc * 8;
#pragma unroll
                for (int e = 0; e < 8; ++e) g[j] = fmaf(qf[e], kmj[e], g[j]); }
        }
#pragma unroll
        for (int j = 0; j < 7; ++j) if (j < qb) { int rank = 0;
#pragma unroll
            for (int i = 0; i < 7; ++i) if (i != j && i < qb) rank += (g[i] > g[j] || (g[i] == g[j] && i < j)) ? 1 : 0;
            if (rank < 3) mask |= 1u << j; }
    }
    AState A; astate_init(A);
    const float c31 = P->rel_bias[31 * 16 + h] * LOG2E;
    run_tiles<0, 4, false, 1>(C.lds, 0, 4 * qb + 3, C.proj + (size_t)b * SEQ * PW + C_MK + h * 64, C.vt + (size_t)((b * NVH + h) * 64) * SEQ, qr, c31, q0w, mask, qb, A, C.wave, C.lane, C.r32, C.hi);
    const float inv = rcpf_(xhalf_sum(A.l));
    A.o0 *= inv; A.o1 *= inv;
    { const int l2 = lane_opaque(); const size_t tok2 = (size_t)b * SEQ + q0w + (l2 & 31);
      store_o(C.obuf + tok2 * DM + h * 64, A.o0, A.o1, l2 >> 5); }
}

__device__ __forceinline__ void diff_unit(const Ctx& C0, KParamsPtr P, int layer, int b, int h, int qb) {
    Ctx C = C0; C.lane = lane_opaque(); C.tid = C.wave * 64 + C.lane; C.r32 = C.lane & 31; C.hi = C.lane >> 5;
    const int q0w = __builtin_amdgcn_readfirstlane(qb * 256 + C.wave * 32); const int qpos = q0w + C.r32; const size_t tok = (size_t)b * SEQ + qpos;
    build_lut(C.lds, P->rel_bias, 4 + h, false, C.tid);
    bf16x8 qr[4]; load_q(qr, C.proj + tok * PW + C_DQ + h * 64, C.hi);
    AState A; astate_init(A);
    const float c31 = P->rel_bias[31 * 16 + 4 + h] * LOG2E;
    const u16* Kg = C.proj + (size_t)b * SEQ * PW + C_DK + h * 64; const u16* Vg = C.vt + (size_t)((b * NVH + 4 + h) * 64) * SEQ;
    run_tiles<0, 2, false, 0>(C.lds, 0, 4 * qb + 3, Kg, Vg, qr, c31, q0w, 0u, 0, A, C.wave, C.lane, C.r32, C.hi);
    LAS float* park = (LAS float*)(C.lds + ATT_PARK) + C.tid;
    { const float i0 = rcpf_(xhalf_sum(A.l));
#pragma unroll
      for (int r = 0; r < 16; ++r) { park[r * 512] = A.o0[r] * i0; park[(16 + r) * 512] = A.o1[r] * i0; } }
    astate_init(A);
    run_tiles<2, 2, false, 0>(C.lds, 0, 4 * qb + 3, Kg, Vg, qr, c31, q0w, 0u, 0, A, C.wave, C.lane, C.r32, C.hi);
    const float* lp = P->diff_lambda + (size_t)layer * 128; float d01 = 0.f, d23 = 0.f;
    for (int i = 0; i < 32; ++i) { d01 = fmaf(lp[i], lp[32 + i], d01); d23 = fmaf(lp[64 + i], lp[96 + i], d23); }
    const float li = P->lam_init[layer]; const float lam = expf(d01) - expf(d23) + li;
    const float i1 = lam * rcpf_(xhalf_sum(A.l));
    float ss = 0.f;
#pragma unroll
    for (int r = 0; r < 16; ++r) { A.o0[r] = park[r * 512] - A.o0[r] * i1; A.o1[r] = park[(16 + r) * 512] - A.o1[r] * i1; ss += A.o0[r] * A.o0[r] + A.o1[r] * A.o1[r]; }
    ss = xhalf_sum(ss);
    const float rstd = (1.0f / sqrtf(ss * (1.0f / 64.0f) + 1e-6f)) * (1.0f - li);
    const float* sg = P->diff_subln + (size_t)layer * 64;
#pragma unroll
    for (int r = 0; r < 16; ++r) { const int d = crow(r, C.hi); A.o0[r] *= rstd * sg[d]; A.o1[r] *= rstd * sg[32 + d]; }
    { const int l2 = lane_opaque(); const size_t tok2 = (size_t)b * SEQ + q0w + (l2 & 31);
      store_o(C.obuf + tok2 * DM + 256 + h * 64, A.o0, A.o1, l2 >> 5); }
}

__device__ __forceinline__ void nsa_unit(const Ctx& C0, KParamsPtr P, int b, int hq, int qb) {
    Ctx C = C0; C.lane = lane_opaque(); C.tid = C.wave * 64 + C.lane; C.r32 = C.lane & 31; C.hi = C.lane >> 5;
    const int g = hq >> 2;
    const int q0w = __builtin_amdgcn_readfirstlane(qb * 256 + C.wave * 32); const int qpos = q0w + C.r32; const size_t tok = (size_t)b * SEQ + qpos;
    build_lut(C.lds, P->rel_bias, 8 + hq, false, C.tid);
    bf16x8 qr[4]; load_q(qr, C.proj + tok * PW + C_NQ + hq * 64, C.hi);
    const u16* gl = C.proj + tok * PW + C_NG + hq * 3;
    const float g1 = sigmoid_f(bf2f(gl[1])), g2 = sigmoid_f(bf2f(gl[2]));
    const unsigned mask = ((const unsigned*)(P->ws + WS_SEL))[(size_t)(b * 2 + g) * SEQ + qpos];
    const float c31 = P->rel_bias[31 * 16 + 8 + hq] * LOG2E;
    AState A; astate_init(A);
    run_tiles<0, 4, false, 2>(C.lds, 0, 4 * qb + 3, C.proj + (size_t)b * SEQ * PW + C_NKS + g * 64, C.vt + (size_t)((b * NVH + 8 + g) * 64) * SEQ, qr, c31, q0w, mask, qb, A, C.wave, C.lane, C.r32, C.hi);
    LAS float* park = (LAS float*)(C.lds + ATT_PARK) + C.tid;
    { const float f = g1 * rcpf_(xhalf_sum(A.l));
#pragma unroll
      for (int r = 0; r < 16; ++r) { park[r * 512] = A.o0[r] * f; park[(16 + r) * 512] = A.o1[r] * f; } }
    if (C.tid < 96) ((LAS float*)(C.lds + ATT_LUT))[608 + C.tid] = NEGF;
    astate_init(A);
    const int tw0 = 4 * qb - 8 < 0 ? 0 : 4 * qb - 8;
    run_tiles<0, 4, true, 0>(C.lds, tw0, 4 * qb + 3, C.proj + (size_t)b * SEQ * PW + C_NKW + g * 64, C.vt + (size_t)((b * NVH + 10 + g) * 64) * SEQ, qr, c31, q0w, 0u, qb, A, C.wave, C.lane, C.r32, C.hi);
    { const float f = g2 * rcpf_(xhalf_sum(A.l));
#pragma unroll
      for (int r = 0; r < 16; ++r) { A.o0[r] = A.o0[r] * f + park[r * 512]; A.o1[r] = A.o1[r] * f + park[(16 + r) * 512]; } }
    const int l2 = lane_opaque(); const int hi2 = l2 >> 5;
    u16* dst = C.obuf + ((size_t)b * SEQ + q0w + (l2 & 31)) * DM + 512 + hq * 64;
#pragma unroll
    for (int gg = 0; gg < 4; ++gg) {
        const u32x2 a = *(const u32x2*)(dst + 8 * gg + 4 * hi2), bq = *(const u32x2*)(dst + 32 + 8 * gg + 4 * hi2);
        A.o0[4 * gg] += bf2f(a.x & 0xffffu); A.o0[4 * gg + 1] += bf2f(a.x >> 16); A.o0[4 * gg + 2] += bf2f(a.y & 0xffffu); A.o0[4 * gg + 3] += bf2f(a.y >> 16);
        A.o1[4 * gg] += bf2f(bq.x & 0xffffu); A.o1[4 * gg + 1] += bf2f(bq.x >> 16); A.o1[4 * gg + 2] += bf2f(bq.y & 0xffffu); A.o1[4 * gg + 3] += bf2f(bq.y >> 16);
    }
    store_o(dst, A.o0, A.o1, hi2);
}

__device__ __forceinline__ void cmp_unit(const Ctx& C0, KParamsPtr P, int b, int g, int qblk) {
    Ctx C = C0; C.lane = lane_opaque(); C.tid = C.wave * 64 + C.lane; C.r32 = C.lane & 31; C.hi = C.lane >> 5;
    LAS unsigned char* lds = C.lds; const int tid = C.tid, r32 = C.r32, hi = C.hi;
    const u16* kc = (const u16*)(P->ws + WS_KCMP) + (size_t)(b * 2 + g) * 128 * 64;
    const u16* vc = (const u16*)(P->ws + WS_VCMPT) + (size_t)(b * 2 + g) * 64 * 128;
#pragma unroll
    for (int i = 0; i < 2; ++i) { const int e = tid + 512 * i;
        { const int row = e >> 3, ch = e & 7; *(LAS u32x4*)(lds + CMP_K + row * 144 + ch * 16) = *(const u32x4*)(kc + row * 64 + ch * 8); }
        { const int row = e >> 4, ch = e & 15; *(LAS u32x4*)(lds + CMP_V + row * 272 + ch * 16) = *(const u32x4*)(vc + row * 128 + ch * 8); } }
    const int q0w = __builtin_amdgcn_readfirstlane(qblk * 256 + C.wave * 32); const int qpos = q0w + r32; const size_t tok = (size_t)b * SEQ + qpos;
    const int nmax = (qpos - 31) >> 4;
    __syncthreads();
    float qa[16], qh[16];
#pragma unroll
    for (int i = 0; i < 16; ++i) { qa[i] = 0.f; qh[i] = 0.f; }
    const LAS unsigned char* kp = lds + CMP_K + r32 * 144 + hi * 16;
    const LAS unsigned char* vp = lds + CMP_V + r32 * 272 + hi * 16;
    bf16x8 qn[4]; load_q(qn, C.proj + tok * PW + C_NQ + g * 4 * 64, hi);
    for (int rh = 0; rh < 4; ++rh) {
        const int hq = g * 4 + rh;
        bf16x8 qr[4];
#pragma unroll
        for (int ks = 0; ks < 4; ++ks) qr[ks] = qn[ks];
        load_q(qn, C.proj + tok * PW + C_NQ + (g * 4 + (rh < 3 ? rh + 1 : rh)) * 64, hi);
        const float g0 = sigmoid_f(bf2f(C.proj[tok * PW + C_NG + hq * 3]));
        f32x16 s[4];
#pragma unroll
        for (int kb = 0; kb < 4; ++kb) {
#pragma unroll
            for (int r = 0; r < 16; ++r) s[kb][r] = 0.f;
#pragma unroll
            for (int ks = 0; ks < 4; ++ks) { const bf16x8 a = *(const LAS bf16x8*)(kp + kb * 32 * 144 + ks * 32); s[kb] = __builtin_amdgcn_mfma_f32_32x32x16_bf16(a, qr[ks], s[kb], 0, 0, 0); }
        }
        float mx = NEGF;
#pragma unroll
        for (int kb = 0; kb < 4; ++kb)
#pragma unroll
            for (int r = 0; r < 16; ++r) { const int n = 32 * kb + crow(r, hi); const float v = (n <= nmax) ? s[kb][r] : NEGF; s[kb][r] = v; mx = fmaxf(mx, v); }
        mx = xhalf_max(mx);
        float sum = 0.f;
#pragma unroll
        for (int kb = 0; kb < 4; ++kb)
#pragma unroll
            for (int r = 0; r < 16; ++r) { const int n = 32 * kb + crow(r, hi); const float pv = (n <= nmax) ? ex2(s[kb][r] - mx) : 0.f; s[kb][r] = pv; sum += pv; }
        sum = xhalf_sum(sum);
        const float inv = nmax >= 0 ? rcpf_(sum) : 0.f;
        f32x16 o0, o1;
#pragma unroll
        for (int r = 0; r < 16; ++r) { o0[r] = 0.f; o1[r] = 0.f; }
#pragma unroll
        for (int kb = 0; kb < 4; ++kb) {
#pragma unroll
            for (int r = 0; r < 16; ++r) s[kb][r] *= inv;
#pragma unroll
            for (int g4 = 0; g4 < 4; ++g4) { const float h = 0.5f * s[kb][4 * g4 + 3]; qh[kb * 4 + g4] += h; qa[kb * 4 + g4] += (s[kb][4 * g4] + s[kb][4 * g4 + 1]) + (s[kb][4 * g4 + 2] + h); }
#pragma unroll
            for (int c = 0; c < 2; ++c) {
                const u32x4 pk = (u32x4){pkbf(s[kb][8 * c], s[kb][8 * c + 1]), pkbf(s[kb][8 * c + 2], s[kb][8 * c + 3]), pkbf(s[kb][8 * c + 4], s[kb][8 * c + 5]), pkbf(s[kb][8 * c + 6], s[kb][8 * c + 7])};
                const bf16x8 pb = __builtin_bit_cast(bf16x8, pk);
                const bf16x8 v0 = *(const LAS bf16x8*)(vp + (kb * 2 + c) * 32);
                const bf16x8 v1 = *(const LAS bf16x8*)(vp + 32 * 272 + (kb * 2 + c) * 32);
                o0 = __builtin_amdgcn_mfma_f32_32x32x16_bf16(v0, pb, o0, 0, 0, 0);
                o1 = __builtin_amdgcn_mfma_f32_32x32x16_bf16(v1, pb, o1, 0, 0, 0);
            }
            __builtin_amdgcn_sched_barrier(0);
        }
        o0 *= g0; o1 *= g0;
        store_o(C.obuf + tok * DM + 512 + hq * 64, o0, o1, hi);
    }
    LAS float* Aq = (LAS float*)(lds + CMP_A) + (C.wave * 32 + r32) * 33; LAS float* Hq = (LAS float*)(lds + CMP_H) + (C.wave * 32 + r32) * 33;
#pragma unroll
    for (int kb = 0; kb < 4; ++kb)
#pragma unroll
        for (int g4 = 0; g4 < 4; ++g4) { const int j = 8 * kb + 2 * g4 + hi; Aq[j] = qa[kb * 4 + g4]; Hq[j] = qh[kb * 4 + g4]; }
    __syncthreads();
    const int cur = q0w >> 6;
    unsigned bits = 0;
    if (cur < 16) bits = (2u << cur) - 1u;
    else {
        float sc[32];
#pragma unroll
        for (int i = 0; i < 32; ++i) { const float imp = Aq[i] + (i > 0 ? Hq[i - 1] : 0.f); sc[i] = (i > cur) ? -3.0e38f : ((i == 0 || i > cur - 2) ? 1e4f : imp); }
#pragma unroll
        for (int e = 0; e < 16; ++e) {
            const float sj = hi ? sc[16 + e] : sc[e]; int rank = 0;
#pragma unroll
            for (int i = 0; i < 32; ++i) { const bool lt = (i < e) || (hi && i < 16 + e);
                rank += (sc[i] > sj || (sc[i] == sj && lt)) ? 1 : 0; }
            const int j = hi * 16 + e;
            if (j <= cur && rank < 16) bits |= 1u << j; }
        { auto rr = __builtin_amdgcn_permlane32_swap(bits, bits, false, false); bits = rr[0] | rr[1]; }
    }
    if (hi == 0) ((unsigned*)(P->ws + WS_SEL))[(size_t)(b * 2 + g) * SEQ + qpos] = bits;
    __syncthreads();
}

__device__ __forceinline__ void prep_vk(const Ctx& C, KParamsPtr P, int b0) {
    const int G = C.G - b0, bxr = C.bx - b0, tid = C.tid, lane = C.lane;
    if (bxr < 0) return;
    for (int it = bxr; it < NB * NVH * 32; it += G) {
        const int tb = it & 31, hv = (it >> 5) % NVH, b = it / (32 * NVH);
        const int vcol = hv < 4 ? C_MV + hv * 64 : hv < 8 ? C_DV + (hv - 4) * 64 : hv < 10 ? C_NVS + (hv - 8) * 64 : C_NVW + (hv - 10) * 64;
        { const int row = tid >> 3, ch = tid & 7; *(LAS u32x4*)(C.lds + row * 144 + ch * 16) = *(const u32x4*)(C.proj + ((size_t)b * SEQ + tb * 64 + row) * PW + vcol + ch * 8); }
        __syncthreads();
        { const int d = tid >> 3, pc = tid & 7; unsigned w[4];
#pragma unroll
            for (int e = 0; e < 4; ++e) { const int p0 = pc * 8 + 2 * e, p1 = p0 + 1; const int k0 = (p0 & ~15) + kperm(p0 & 15), k1 = (p1 & ~15) + kperm(p1 & 15);
                const unsigned a = *(const LAS u16*)(C.lds + k0 * 144 + d * 2), bb = *(const LAS u16*)(C.lds + k1 * 144 + d * 2); w[e] = a | (bb << 16); }
            *(u32x4*)(C.vt + ((size_t)(b * NVH + hv) * 64 + d) * SEQ + tb * 64 + pc * 8) = (u32x4){w[0], w[1], w[2], w[3]}; }
        __syncthreads();
    }
    const int gw = bxr * 8 + C.wave, NGW = G * 8;
    for (int it = gw; it < NB * 4 * 8; it += NGW) {
        const int blk = it & 7, h = (it >> 3) & 3, b = it >> 5;
        const u16* kp = C.proj + ((size_t)b * SEQ + blk * 256) * PW + C_MK + h * 64 + lane; float s = 0.f;
        for (int k = 0; k < 256; k += 8) { float t[8];
#pragma unroll
            for (int e = 0; e < 8; ++e) t[e] = bf2f(kp[(size_t)(k + e) * PW]);
            s += ((t[0] + t[1]) + (t[2] + t[3])) + ((t[4] + t[5]) + (t[6] + t[7])); }
        ((float*)(P->ws + WS_KMEAN))[(size_t)it * 64 + lane] = s * (1.0f / 256.0f);
    }
}
__device__ __forceinline__ void prep_a(const Ctx& C, KParamsPtr P, int layer) {
    const int G = C.G, lane = C.lane;
    const int gw = C.bx * 8 + C.wave, NGW = G * 8;
    u16* acmp = (u16*)(P->ws + WS_XN);
    for (int it = gw; it < 2 * 4096; it += NGW) {
        const int i = it >> 12, row = it & 4095, n = row & 127, bg = row >> 7, b = bg >> 1, g = bg & 1;
        u16* dst = acmp + (size_t)it * 2048; const float* pe = P->cmp_pe + (size_t)(layer * 2 + i) * 2048;
        const int col = (i == 0 ? C_NKC : C_NVC) + g * 64;
#pragma unroll
        for (int pass = 0; pass < 4; ++pass) { const int l = pass * 8 + (lane >> 3), d0 = (lane & 7) * 8;
            unsigned z0 = 0u; asm volatile("" : "+v"(z0)); u32x4 o = (u32x4){z0, z0, z0, z0};
            if (n < 127) { const u32x4 v = *(const u32x4*)(C.proj + ((size_t)b * SEQ + 16 * n + l) * PW + col + d0); const f32x4 e0 = *(const f32x4*)(pe + l * 64 + d0), e1 = *(const f32x4*)(pe + l * 64 + d0 + 4);
                o.x = pkbf(bf2f(v.x & 0xffffu) + e0.x, bf2f(v.x >> 16) + e0.y); o.y = pkbf(bf2f(v.y & 0xffffu) + e0.z, bf2f(v.y >> 16) + e0.w);
                o.z = pkbf(bf2f(v.z & 0xffffu) + e1.x, bf2f(v.z >> 16) + e1.y); o.w = pkbf(bf2f(v.w & 0xffffu) + e1.z, bf2f(v.w >> 16) + e1.w); }
            *(u32x4*)(dst + l * 64 + d0) = o; }
    }
}
__device__ __forceinline__ void prep_c(const Ctx& C, KParamsPtr P, int layer, int it0) {
    const int i = it0 >> 12, row0 = it0 & 4095, lane = lane_opaque(), tid = C.wave * 64 + lane, r32 = lane & 31, hi = lane >> 5;
    const float* w2 = P->cmp_w2 + (size_t)(layer * 2 + i) * 256 * 64;
    for (int e = tid; e < 256 * 64; e += 512) { const int k = e >> 6, c = e & 63; *(LAS u16*)(C.lds + c * 528 + k * 2) = (u16)(pkbf(w2[e], 0.f) & 0xffffu); }
    __syncthreads();
    const int wrow = row0 + C.wave * 32;
    const u16* hrow = (const u16*)(P->ws + WS_HID) + ((size_t)i * 4096 + wrow + r32) * 256 + hi * 8;
    f32x16 d0, d1;
#pragma unroll
    for (int r = 0; r < 16; ++r) { d0[r] = 0.f; d1[r] = 0.f; }
#pragma unroll 4
    for (int ks = 0; ks < 16; ++ks) {
        const bf16x8 a = *(const bf16x8*)(hrow + ks * 16);
        const bf16x8 b0 = *(const LAS bf16x8*)(C.lds + r32 * 528 + (ks * 16 + hi * 8) * 2);
        const bf16x8 b1 = *(const LAS bf16x8*)(C.lds + (32 + r32) * 528 + (ks * 16 + hi * 8) * 2);
        d0 = __builtin_amdgcn_mfma_f32_32x32x16_bf16(a, b0, d0, 0, 0, 0);
        d1 = __builtin_amdgcn_mfma_f32_32x32x16_bf16(a, b1, d1, 0, 0, 0);
    }
#pragma unroll
    for (int r = 0; r < 16; ++r) { const int row = wrow + crow(r, hi);
        const unsigned v0 = pkbf(d0[r], 0.f) & 0xffffu, v1 = pkbf(d1[r], 0.f) & 0xffffu;
        if (i == 0) { u16* o = (u16*)(P->ws + WS_KCMP) + (size_t)row * 64; o[r32] = (u16)v0; o[32 + r32] = (u16)v1; }
        else { const int bg = row >> 7, n = row & 127; u16* o = (u16*)(P->ws + WS_VCMPT) + (size_t)bg * 64 * 128 + (n & ~15) + pperm(n & 15); o[(size_t)r32 * 128] = (u16)v0; o[(size_t)(32 + r32) * 128] = (u16)v1; }
    }
}

__device__ __forceinline__ void convert_weights(const Ctx& C, KParamsPtr P, int layer) {
    LAS float* scr = (LAS float*)(C.lds + C.wave * 16384);
    const int gw = C.bx * 8 + C.wave, NGW = C.G * 8, lane = C.lane;
    constexpr int I_G = 16 * 88, I_D = 44 * 32, I_IN = 16 * 96, I_O = 16 * 32, I_W1 = 32 * 8;
    constexpr int NIT = 4 * I_G + 2 * I_D + I_IN + I_O + 2 * I_W1;
    unsigned char* ws = P->ws;
    for (int it = gw; it < NIT; it += NGW) {
        int r = it;
        if (r < 4 * I_G) { const int which = r / I_G; r -= which * I_G; const int kb = r / 88, nb = r % 88, n0 = nb * 32;
            const float* W = (which == 0 ? P->ffn1_gate : which == 1 ? P->ffn1_up : which == 2 ? P->ffn2_gate : P->ffn2_up) + (size_t)layer * DM * DFF;
            u16* WT = (u16*)(ws + (which < 2 ? WS_GU1 : WS_GU2));
            tr_item(W, DM, DFF, WT, kb, n0, (n0 >> 7) * 256 + (which & 1) * 128 + (n0 & 127), scr, lane); continue; }
        r -= 4 * I_G;
        if (r < 2 * I_D) { const int which = r / I_D; r -= which * I_D; const int kb = r / 32, nb = r % 32;
            const float* W = (which == 0 ? P->ffn1_down : P->ffn2_down) + (size_t)layer * DFF * DM;
            tr_item(W, DFF, DM, (u16*)(ws + (which == 0 ? WS_DN1 : WS_DN2)), kb, nb * 32, nb * 32, scr, lane); continue; }
        r -= 2 * I_D;
        if (r < I_IN) { const int kb = r / 96, nb = r % 96, n0 = nb * 32;
            const float cs = (n0 < C_MK || (n0 >= C_NQ && n0 < C_NKC)) ? 0.125f * LOG2E : (n0 >= C_DQ && n0 < C_DK) ? 0.17677669529663687f * LOG2E : 1.0f;
            tr_item(P->w_in + (size_t)layer * DM * INW, DM, INW, (u16*)(ws + WS_WIN), kb, n0, n0, scr, lane, cs); continue; }
        r -= I_IN;
        if (r < I_O) { const int kb = r / 32, nb = r % 32; tr_item(P->w_out + (size_t)layer * DM * DM, DM, DM, (u16*)(ws + WS_WOUT), kb, nb * 32, nb * 32, scr, lane); continue; }
        r -= I_O;
        { const int i = r / I_W1; r -= i * I_W1; const int kb = r / 8, nb = r % 8;
            tr_item(P->cmp_w1 + (size_t)(layer * 2 + i) * 2048 * 256, 2048, 256, (u16*)(ws + WS_W1) + (size_t)i * 256 * 2048, kb, nb * 32, nb * 32, scr, lane); }
    }
}
__device__ __forceinline__ void norm_phase(const Ctx& C, const float* src, const float* g, u16* dst16, float* dst32) {
    const int gw = C.bx * 8 + C.wave, NGW = C.G * 8;
    for (int m = gw; m < MTOK; m += NGW) norm_row(src + (size_t)m * DM, g, dst16 ? dst16 + (size_t)m * DM : nullptr, dst32 ? dst32 + (size_t)m * DM : nullptr, C.lane);
}

#define XB_TMO      128
#define XB_XCNT(j)  (256  + 64 * (j))
#define XB_XSUB(j)  (1280 + 64 * (j))
#define XB_XGEN(j)  (2304 + 64 * (j))
#define XB_TOP      3328
#define XB_TOPGEN   3392
#define XCD_BAR_WORDS 3456
#define XB_SPIN_CAP (1u << 18)

__device__ __forceinline__ unsigned xb_ld(unsigned* p)              { return __hip_atomic_load(p, __ATOMIC_RELAXED, __HIP_MEMORY_SCOPE_AGENT); }
__device__ __forceinline__ unsigned xb_add(unsigned* p, unsigned v) { return __hip_atomic_fetch_add(p, v, __ATOMIC_RELAXED, __HIP_MEMORY_SCOPE_AGENT); }
__device__ __forceinline__ unsigned xb_xcc_id() { return (unsigned)__builtin_amdgcn_s_getreg((3 << 11) | 20) & 0xFu; }
#define XB_SPIN(cond, bar) do { unsigned _sp = 0; while (cond) { __builtin_amdgcn_s_sleep(1); \
    if ((++_sp & 255u) == 0u) { if (xb_ld(&(bar)[XB_TMO])) break; if (_sp > XB_SPIN_CAP) { atomicAdd(&(bar)[XB_TMO], 1u); break; } } } } while (0)

struct XcdBarrier {
    unsigned* bar; unsigned x;
    volatile LAS unsigned* st;
};

__device__ __forceinline__ XcdBarrier xcd_barrier_post(unsigned* bar, volatile LAS unsigned* st) {
    XcdBarrier b; b.bar = bar; b.x = xb_xcc_id(); b.st = st;
    if (threadIdx.x == 0) (void)xb_add(&bar[XB_XCNT(b.x)], 1u);
    return b;
}
__device__ __forceinline__ void xcd_barrier_complete(unsigned* bar, unsigned x, unsigned& nloc, unsigned& nx) {
    const unsigned G = gridDim.x * gridDim.y * gridDim.z;
    unsigned sum, cnt, mine, sp = 0u;
    for (;;) {
        sum = 0u; cnt = 0u; mine = 0u;
#pragma unroll
        for (unsigned j = 0; j < 16; ++j) { const unsigned c = xb_ld(&bar[XB_XCNT(j)]); sum += c; cnt += (c > 0u) ? 1u : 0u; mine = (j == x) ? c : mine; }
        if (sum == G) break;
        __builtin_amdgcn_s_sleep(1);
        if ((++sp & 255u) == 0u) { if (xb_ld(&bar[XB_TMO])) break; if (sp > XB_SPIN_CAP) { atomicAdd(&bar[XB_TMO], 1u); break; } }
    }
    nloc = mine > 0u ? mine : 1u; nx = cnt > 0u ? cnt : 1u;
}

__device__ __forceinline__ void xcd_barrier(const XcdBarrier& b) {
    asm volatile("s_waitcnt vmcnt(0)" ::: "memory");
    __syncthreads();
    if (threadIdx.x == 0) {
        unsigned* bar = b.bar;
        __builtin_amdgcn_s_waitcnt(0);
        unsigned nloc = b.st[0], nx = b.st[1];
        if (nloc == 0u) { xcd_barrier_complete(bar, b.x, nloc, nx); b.st[0] = nloc; b.st[1] = nx; }
        const unsigned old = xb_add(&bar[XB_XSUB(b.x)], 1u);
        const unsigned gen = old / nloc;
        if (old + 1u == (gen + 1u) * nloc) {
            __builtin_amdgcn_fence(__ATOMIC_RELEASE, "agent");
            asm volatile("s_waitcnt vmcnt(0)" ::: "memory");
            const unsigned og = xb_add(&bar[XB_TOP], 1u);
            const unsigned tg = og / nx;
            if (og + 1u == (tg + 1u) * nx) xb_add(&bar[XB_TOPGEN], 1u);
            else XB_SPIN(xb_ld(&bar[XB_TOPGEN]) == tg, bar);
            __builtin_amdgcn_fence(__ATOMIC_ACQUIRE, "agent");
            xb_add(&bar[XB_XGEN(b.x)], 1u);
            asm volatile("s_waitcnt vmcnt(0)" ::: "memory");
        } else {
            XB_SPIN(xb_ld(&bar[XB_XGEN(b.x)]) == gen, bar);
            __builtin_amdgcn_fence(__ATOMIC_ACQUIRE, "agent");
            asm volatile("s_waitcnt vmcnt(0)" ::: "memory");
        }
    }
    __syncthreads();
}


struct OneUnit { int pm;
    __device__ __forceinline__ bool next(int i, pg8::Unit& u) const { if (i) return false; u.pm = pm; u.pn = 0; return true; }
    __device__ __forceinline__ void a_ready(const pg8::Unit&) const {}
    __device__ __forceinline__ void done(const pg8::Unit&) const {} };
__global__ void __launch_bounds__(512, 2) hybrid_fwd(Params P0) {
    extern __shared__ __attribute__((aligned(16))) unsigned char lds_raw[];
    const KParamsPtr kp0 = (KParamsPtr)__builtin_amdgcn_kernarg_segment_ptr();
    cg::grid_group grid = cg::this_grid();
    { volatile LAS unsigned* misc = (volatile LAS unsigned*)((LAS unsigned char*)lds_raw + MISC_OFF); if (threadIdx.x < 2) misc[threadIdx.x] = 0u; }
    __syncthreads();
    XcdBarrier bar = xcd_barrier_post((unsigned*)(P0.ws + WS_CTL) + 1024, (volatile LAS unsigned*)((LAS unsigned char*)lds_raw + MISC_OFF));
    const int ph_lo = P0.ph_lo, ph_hi = P0.ph_hi; const int wave_s = __builtin_amdgcn_readfirstlane(threadIdx.x >> 6);
    bool redone = false; (void)redone;
    for (int ph = ph_lo; ph < ph_hi; ++ph) {
        KParamsPtr kpl = kp0; asm volatile("" : "+s"(kpl));
        const KParamsPtr P = kpl; unsigned char* ws = P->ws;
        u16* XN = (u16*)(ws + WS_XN); u16* HB = (u16*)(ws + WS_PROJ);
        int G = gridDim.x, bx = blockIdx.x; asm volatile("" : "+s"(G), "+s"(bx));
        Ctx C; C.G = G; C.bx = bx; C.lds = (LAS unsigned char*)lds_raw; C.wave = wave_s; C.lane = lane_opaque(); C.tid = wave_s * 64 + C.lane; C.r32 = C.lane & 31; C.hi = C.lane >> 5;
        C.proj = (u16*)(ws + WS_PROJ); C.obuf = (u16*)(ws + WS_XN); C.vt = (u16*)(ws + WS_VT);
        const int layer = ph / NPH_L, s = ph % NPH_L;
        if (ph != NPH - 1 && s == 7) continue;
        if (ph == NPH - 1) { norm_phase(C, P->out, P->final_norm, nullptr, P->out); }
        else switch (s) {
        case 0: { convert_weights(C, P, layer); __syncthreads(); norm_phase(C, layer == 0 ? P->x : P->out, P->norm_ffn1 + (size_t)layer * DM, XN, nullptr); } break;
        case 3: { norm_phase(C, P->out, P->norm_mix + (size_t)layer * DM, XN, nullptr); } break;
        case 11: { norm_phase(C, P->out, P->norm_ffn2 + (size_t)layer * DM, XN, nullptr); } break;
#ifndef NO_GEMM
#ifndef NO_G1
        case 1: case 12: {
            pg8::Gemm g{XN, (const u16*)(ws + (s == 1 ? WS_GU1 : WS_GU2)), MTOK, 2 * DFF, DM}; pg8::StaticOrder S; S.init(MTOK, 2 * DFF, G, bx);
            pg8::EpiSwiGLU E{HB, DFF};
            pg8::gemm_phase<pg8::EpiSwiGLU, pg8::StaticOrder, true, true>(C.lds, g, S, E, C.wave); } break;
#endif
#ifndef NO_G2
        case 2: case 13: case 10: {
            const u16* A = (s == 10) ? (const u16*)XN : (const u16*)HB; const u16* Bt = (const u16*)(ws + (s == 2 ? WS_DN1 : s == 13 ? WS_DN2 : WS_WOUT));
            pg8::Gemm g{A, Bt, MTOK, DM, s == 10 ? DM : DFF}; pg8::StaticOrder S; S.init(MTOK, DM, G, bx);
            pg8::EpiResid E{(layer == 0 && s == 2) ? P->x : (const float*)P->out, P->out, DM, s == 10 ? 1.0f : 0.5f};
            pg8::gemm_phase<pg8::EpiResid, pg8::StaticOrder, false, true>(C.lds, g, S, E, C.wave); } break;
#endif
#ifndef NO_G4
        case 4: {
            pg8::Gemm g{XN, (const u16*)(ws + WS_WIN), MTOK, PW, DM}; pg8::StaticOrder S; S.init(MTOK, PW, G, bx);
            pg8::EpiBf16<0> E{C.proj, PW};
            pg8::gemm_phase<pg8::EpiBf16<0>, pg8::StaticOrder, true, true>(C.lds, g, S, E, C.wave); } break;
#endif
#endif
#ifndef NO_PREP
        case 5: prep_a(C, P, layer); prep_vk(C, P, 0); break;
#endif
#if !defined(NO_GEMM) && !defined(NO_G6)
        case 6: {
            unsigned* qctr = (unsigned*)(ws + WS_CTL) + 8192 + 64 * ph + (redone ? 32 : 0); volatile LAS unsigned* qslot = (volatile LAS unsigned*)(C.lds + MISC_OFF + 16);
            for (;;) {
                if (C.tid == 0) *qslot = __hip_atomic_fetch_add(qctr, 1u, __ATOMIC_RELAXED, __HIP_MEMORY_SCOPE_AGENT);
                __syncthreads();
                const unsigned u = *qslot;
                __syncthreads();
                if (u >= 32u + 1024u) break;
                if (u < 32u) { const int i = (int)u >> 4, tile = (int)u & 15;
                    pg8::Gemm g{(const u16*)XN + (size_t)i * 4096 * 2048, (const u16*)(ws + WS_W1) + (size_t)i * 256 * 2048, 4096, 256, 2048}; OneUnit S{tile};
                    pg8::EpiBf16<1> E{(u16*)(ws + WS_HID) + (size_t)i * 4096 * 256, 256};
                    pg8::gemm_phase<pg8::EpiBf16<1>, OneUnit, true, true>(C.lds, g, S, E, C.wave);
                    __builtin_amdgcn_fence(__ATOMIC_RELEASE, "agent"); __syncthreads(); __builtin_amdgcn_fence(__ATOMIC_ACQUIRE, "agent");
                    prep_c(C, P, layer, i * 4096 + tile * 256);
                    __syncthreads();
                } else { const unsigned v = u - 32u; const int qb = 7 - (int)(v >> 7), w = (int)(v & 127);
                    if (w < 64) {
#ifndef NO_DIFF
                        diff_unit(C, P, layer, w >> 2, w & 3, qb);
#endif
                    } else {
#ifndef NO_MOBA
                        moba_unit(C, P, (w - 64) >> 2, w & 3, qb);
#endif
                    } }
            } } break;
#endif
#ifndef NO_ATT1
        case 8: {
#ifndef NO_CMP
            for (int c = bx; c < 256; c += G) cmp_unit(C, P, c >> 4, (c >> 3) & 1, c & 7);
#endif
            } break;
#endif
#ifndef NO_ATT2
        case 9: {
            unsigned* qctr = (unsigned*)(ws + WS_CTL) + 8192 + 64 * ph; volatile LAS unsigned* qslot = (volatile LAS unsigned*)(C.lds + MISC_OFF + 16);
            for (;;) {
                if (C.tid == 0) *qslot = __hip_atomic_fetch_add(qctr, 1u, __ATOMIC_RELAXED, __HIP_MEMORY_SCOPE_AGENT);
                __syncthreads();
                const unsigned u = *qslot;
                __syncthreads();
                if (u >= 1024u) break;
                nsa_unit(C, P, (int)(u & 127) >> 3, (int)u & 7, 7 - (int)(u >> 7));
            } } break;
#endif
        default: break;
        }
        if (ph + 1 < ph_hi) { if (ph == ph_lo) grid.sync(); else xcd_barrier(bar); }
#ifdef PROBE_LO
        if (ph != NPH - 1 && s == PROBE_HI) { if (!redone) { ph -= (PROBE_HI - PROBE_LO + 1); redone = true; } else redone = false; }
#endif
#ifdef PROBE_SYNC
        if (ph + 1 < ph_hi) xcd_barrier(bar);
#endif
    }
}

#ifndef COOP
#define COOP 1
#endif
extern "C" void kernel_launch(void* const* d_in, const int* in_sizes, int n_in, void* d_out, int out_size, void* d_ws, size_t ws_size, hipStream_t stream) {
    static int grid = 0;
    if (grid == 0) {
        if (n_in != 19 || out_size != MTOK * DM || ws_size < WS_END) { fprintf(stderr, "kernel_launch: unexpected shapes (n_in %d out %d ws %zu)\n", n_in, out_size, ws_size); grid = -1; return; }
        int dev = 0, cus = 0, per_cu = 0;
        (void)hipGetDevice(&dev); (void)hipDeviceGetAttribute(&cus, hipDeviceAttributeMultiprocessorCount, dev);
        if (hipFuncSetAttribute((const void*)hybrid_fwd, hipFuncAttributeMaxDynamicSharedMemorySize, LDS_BYTES) != hipSuccess) { fprintf(stderr, "kernel_launch: hipFuncSetAttribute failed\n"); grid = -1; return; }
        if (hipOccupancyMaxActiveBlocksPerMultiprocessor(&per_cu, (const void*)hybrid_fwd, 512, LDS_BYTES) != hipSuccess || per_cu < 1) { fprintf(stderr, "kernel_launch: occupancy query says %d\n", per_cu); per_cu = 1; }
        (void)hipGetLastError();
        grid = cus * per_cu;
    }
    if (grid < 0) return;
    Params p{};
    p.x = (const float*)d_in[0]; p.rel_bias = (const float*)d_in[1]; p.norm_ffn1 = (const float*)d_in[2]; p.ffn1_gate = (const float*)d_in[3]; p.ffn1_up = (const float*)d_in[4]; p.ffn1_down = (const float*)d_in[5];
    p.norm_mix = (const float*)d_in[6]; p.w_in = (const float*)d_in[7]; p.diff_lambda = (const float*)d_in[8]; p.diff_subln = (const float*)d_in[9]; p.cmp_pe = (const float*)d_in[10]; p.cmp_w1 = (const float*)d_in[11];
    p.cmp_w2 = (const float*)d_in[12]; p.w_out = (const float*)d_in[13]; p.norm_ffn2 = (const float*)d_in[14]; p.ffn2_gate = (const float*)d_in[15]; p.ffn2_up = (const float*)d_in[16]; p.ffn2_down = (const float*)d_in[17];
    p.final_norm = (const float*)d_in[18]; p.out = (float*)d_out; p.ws = (unsigned char*)d_ws;
    for (int l = 0; l < 4; ++l) p.lam_init[l] = (float)(0.8 - 0.6 * exp(-0.3 * (double)l));
#if COOP
    if (hipMemsetAsync((char*)d_ws + WS_CTL, 0, CTL_ZERO_BYTES, stream) != hipSuccess) { fprintf(stderr, "kernel_launch: memset of barrier words failed\n"); return; }
    p.ph_lo = 0; p.ph_hi = NPH;
    void* args[] = {&p};
    hipError_t e = hipLaunchCooperativeKernel((const void*)hybrid_fwd, dim3(grid), dim3(512), args, LDS_BYTES, stream);
    if (e != hipSuccess) fprintf(stderr, "cooperative launch failed: %s (grid %d)\n", hipGetErrorString(e), grid);
#else
    for (int ph = 0; ph < NPH; ++ph) { p.ph_lo = ph; p.ph_hi = ph + 1; hipLaunchKernelGGL(hybrid_fwd, dim3(grid), dim3(512), LDS_BYTES, stream, p); }
#endif
}
```

```cpp
#include <hip/hip_runtime.h>
#include <hip/hip_cooperative_groups.h>
#include <cstdio>
#include <cstdint>
#include <cmath>
namespace cg = cooperative_groups;
#define COOP 1
namespace pg8 {
#define PG8_LAS __attribute__((address_space(3)))
typedef unsigned short bf16_t;
typedef short bf16x8 __attribute__((ext_vector_type(8)));
typedef float f32x4 __attribute__((ext_vector_type(4)));
typedef unsigned u32x4 __attribute__((ext_vector_type(4)));
constexpr int BM = 256, BK = 64, HALF = 128, HTB = HALF * BK * 2  , STAGE_BYTES = 8 * HTB, NXCD = 8, WGM = 8;

__host__ __device__ __forceinline__ int lds_byte(int r, int c) { const int st = (r >> 4) * 2 + (c >> 5), rr = r & 15, cc = c & 31, ob = rr * 64 + cc * 2; return st * 1024 + (ob ^ (((ob >> 9) & 1) << 5)); }
__host__ __device__ __forceinline__ void stage_rc(int b, int& R, int& C) { const int st = b / 1024, sb = b % 1024, swz = sb ^ (((sb >> 9) & 1) << 5); R = (st >> 1) * 16 + swz / 64; C = (st & 1) * 32 + (swz % 64) / 2; }
__host__ __device__ __forceinline__ int perm32(int rho) { const int n = rho >> 4, i = rho & 15; return 8 * (i >> 2) + 4 * n + (i & 3); }

struct Unit { int pm, pn; };
struct Gemm { const bf16_t* A; const bf16_t* Bt; int M, N, K; };

struct StaticOrder {
    int nM, nN, nwg, G, c;
    __host__ __device__ void init(int M, int N, int G_, int c_) { nM = M / BM; nN = N / BM; nwg = nM * nN; G = G_; c = c_; }
    __host__ __device__ bool next(int i, Unit& u) const {
        const long L = (long)i * G + c; if (L >= nwg) return false;
        int wgid = (int)L; { const int q = nwg / NXCD, r = nwg % NXCD, xcd = wgid % NXCD, off = wgid / NXCD; wgid = (xcd < r ? xcd * (q + 1) : r * (q + 1) + (xcd - r) * q) + off; }
        const int nig = WGM * nN, gid = wgid / nig, fm = gid * WGM, gsz = (nM - fm) < WGM ? (nM - fm) : WGM;
        u.pm = fm + ((wgid % nig) % gsz); u.pn = (wgid % nig) / gsz; return true;
    }
    __device__ __forceinline__ void a_ready(const Unit&) const {}
    __device__ __forceinline__ void done(const Unit&) const {}
};

__device__ __forceinline__ unsigned cvt_pk_bf16(float lo, float hi) { unsigned r; asm volatile("v_cvt_pk_bf16_f32 %0, %1, %2" : "=v"(r) : "v"(lo), "v"(hi)); return r; }

__device__ __forceinline__ float ex2(float x) { return __builtin_amdgcn_exp2f(x); }
__device__ __forceinline__ float rcpf_(float x) { return __builtin_amdgcn_rcpf(x); }
__device__ __forceinline__ float silu_f(float x) { return x * rcpf_(1.0f + ex2(-1.4426950408889634f * x)); }
__device__ __forceinline__ float gelu_tanh_f(float x) { const float y2 = 2.0f * 0.7978845608028654f * (x + 0.044715f * x * x * x); return x * (1.0f - rcpf_(1.0f + ex2(1.4426950408889634f * y2))); }

struct EpiSwiGLU {
    static constexpr bool PERM = true, AFTER_DRAIN = false;
    bf16_t* O; int ldc;
    __device__ __forceinline__ void operator()(const f32x4 (&acc)[2][2][4][2], const Unit& u, int wr, int wc, int fr, int fq) const {
        const int row0 = u.pm * BM + wr * 64 + fr; const int col0 = u.pn * HALF + wc * 32 + 8 * fq;
#pragma unroll
        for (int ai = 0; ai < 2; ++ai)
#pragma unroll
            for (int m = 0; m < 4; ++m) { bf16_t* rowp = O + (size_t)(row0 + ai * HALF + m * 16) * ldc + col0;
                const f32x4 g0 = acc[ai][0][m][0], g1 = acc[ai][0][m][1], u0 = acc[ai][1][m][0], u1 = acc[ai][1][m][1];
                u32x4 w; w.x = cvt_pk_bf16(silu_f(g0[0]) * u0[0], silu_f(g0[1]) * u0[1]); w.y = cvt_pk_bf16(silu_f(g0[2]) * u0[2], silu_f(g0[3]) * u0[3]);
                w.z = cvt_pk_bf16(silu_f(g1[0]) * u1[0], silu_f(g1[1]) * u1[1]); w.w = cvt_pk_bf16(silu_f(g1[2]) * u1[2], silu_f(g1[3]) * u1[3]);
                *(u32x4*)rowp = w; asm volatile("" ::: "memory"); }
    }
};
template <int ACT> struct EpiBf16 {
    static constexpr bool PERM = true, AFTER_DRAIN = false;
    bf16_t* O; int ldc;
    __device__ __forceinline__ void operator()(const f32x4 (&acc)[2][2][4][2], const Unit& u, int wr, int wc, int fr, int fq) const {
        const int row0 = u.pm * BM + wr * 64 + fr; const int col0 = u.pn * BM + wc * 32 + 8 * fq;
#pragma unroll
        for (int ai = 0; ai < 2; ++ai)
#pragma unroll
            for (int m = 0; m < 4; ++m) { bf16_t* rowp = O + (size_t)(row0 + ai * HALF + m * 16) * ldc + col0;
#pragma unroll
                for (int bj = 0; bj < 2; ++bj) { f32x4 v0 = acc[ai][bj][m][0], v1 = acc[ai][bj][m][1];
                    if (ACT == 1) { v0 = (f32x4){gelu_tanh_f(v0[0]), gelu_tanh_f(v0[1]), gelu_tanh_f(v0[2]), gelu_tanh_f(v0[3])}; v1 = (f32x4){gelu_tanh_f(v1[0]), gelu_tanh_f(v1[1]), gelu_tanh_f(v1[2]), gelu_tanh_f(v1[3])}; }
                    u32x4 w; w.x = cvt_pk_bf16(v0[0], v0[1]); w.y = cvt_pk_bf16(v0[2], v0[3]); w.z = cvt_pk_bf16(v1[0], v1[1]); w.w = cvt_pk_bf16(v1[2], v1[3]);
                    *(u32x4*)(rowp + bj * HALF) = w; } asm volatile("" ::: "memory"); }
    }
};
struct EpiResid {
    static constexpr bool PERM = true, AFTER_DRAIN = false;
    bf16_t* xb; int ldc; float alpha;
    __device__ __forceinline__ void operator()(const f32x4 (&acc)[2][2][4][2], const Unit& u, int wr, int wc, int fr, int fq) const {
        const int row0 = u.pm * BM + wr * 64 + fr; const int col0 = u.pn * BM + wc * 32 + 8 * fq;
#pragma unroll
        for (int ai = 0; ai < 2; ++ai) {
            u32x4 pre[4][2];
#pragma unroll
            for (int m = 0; m < 4; ++m)
#pragma unroll
                for (int bj = 0; bj < 2; ++bj) pre[m][bj] = *(const u32x4*)(xb + (size_t)(row0 + ai * HALF + m * 16) * ldc + col0 + bj * HALF);
#pragma unroll
            for (int m = 0; m < 4; ++m) { bf16_t* rowp = xb + (size_t)(row0 + ai * HALF + m * 16) * ldc + col0;
#pragma unroll
                for (int bj = 0; bj < 2; ++bj) { const u32x4 p = pre[m][bj]; const f32x4 a0 = acc[ai][bj][m][0] * alpha, a1 = acc[ai][bj][m][1] * alpha;
                    u32x4 w;
                    w.x = cvt_pk_bf16(__uint_as_float(p.x << 16) + a0[0], __uint_as_float(p.x & 0xffff0000u) + a0[1]);
                    w.y = cvt_pk_bf16(__uint_as_float(p.y << 16) + a0[2], __uint_as_float(p.y & 0xffff0000u) + a0[3]);
                    w.z = cvt_pk_bf16(__uint_as_float(p.z << 16) + a1[0], __uint_as_float(p.z & 0xffff0000u) + a1[1]);
                    w.w = cvt_pk_bf16(__uint_as_float(p.w << 16) + a1[2], __uint_as_float(p.w & 0xffff0000u) + a1[3]);
                    *(u32x4*)(rowp + bj * HALF) = w; } }
            asm volatile("" ::: "memory");
        }
    }
};
template <class Epi, class Sched, bool ALIGN_EPI = false, bool SP2 = false>
__device__ __forceinline__ void gemm_phase(PG8_LAS unsigned char* lds, const Gemm g, const Sched& S, const Epi& E, const int wave_in) {
    int tid_l; asm volatile("v_mbcnt_lo_u32_b32 %0, -1, 0\n\tv_mbcnt_hi_u32_b32 %0, -1, %0" : "=v"(tid_l)); tid_l += wave_in * 64;
    const int tid = tid_l, wid = __builtin_amdgcn_readfirstlane(tid >> 6), lane = tid & 63, wr = wid >> 2, wc = wid & 3, fr = lane & 15, fq = lane >> 4;
    const int K = g.K, nt = K / BK;
    unsigned voffA[2], voffB[2];
#pragma unroll
    for (int i = 0; i < 2; ++i) { int R, C; stage_rc(tid * 16 + i * 8192, R, C); const int Rb = Epi::PERM ? ((R & ~31) + perm32(R & 31)) : R;
        voffA[i] = (unsigned)(R * K + C) * 2u; voffB[i] = (unsigned)(Rb * K + C) * 2u; }
    const size_t kstep = (size_t)(BK * 2);
    const size_t hstep = (size_t)HALF * K * 2;
    const size_t tstep = 2 * hstep;
    const unsigned ldsw = (unsigned)wid * 1024u;
    const int aoff = lds_byte(wr * 64 + fr, fq * 8), boff = lds_byte(wc * 32 + fr, fq * 8);
#define PG8_SA(b, h) (((b) * 2 + (h)) * HTB)
#define PG8_SB(b, h) ((4 + (b) * 2 + (h)) * HTB)
#define PG8_STAGE(bufoff, gbase, voff) do { _Pragma("unroll") for (int _i = 0; _i < 2; ++_i) \
        __builtin_amdgcn_global_load_lds((const unsigned*)((const char*)(gbase) + (voff)[_i]), (PG8_LAS unsigned*)(lds + (bufoff) + ldsw + _i * 8192), 16, 0, 0); } while (0)
#define PG8_LDA(dst, b, h) do { _Pragma("unroll") for (int m = 0; m < 4; ++m) _Pragma("unroll") for (int k = 0; k < 2; ++k) dst[m][k] = *(const PG8_LAS bf16x8*)(lds + PG8_SA(b, h) + aoff + m * 2048 + k * 1024); } while (0)
#define PG8_LDB(dst, b, h) do { _Pragma("unroll") for (int n = 0; n < 2; ++n) _Pragma("unroll") for (int k = 0; k < 2; ++k) dst[n][k] = *(const PG8_LAS bf16x8*)(lds + PG8_SB(b, h) + boff + n * 2048 + k * 1024); } while (0)
#define PG8_MMA(ai, bj, At, Bt) do { __builtin_amdgcn_s_setprio(1); _Pragma("unroll") for (int m = 0; m < 4; ++m) _Pragma("unroll") for (int n = 0; n < 2; ++n) _Pragma("unroll") for (int k = 0; k < 2; ++k) \
        acc[ai][bj][m][n] = __builtin_amdgcn_mfma_f32_16x16x32_bf16(Bt[n][k], At[m][k], acc[ai][bj][m][n], 0, 0, 0); __builtin_amdgcn_s_setprio(0); } while (0)
#define PG8_WAIT_V(n) asm volatile("s_waitcnt vmcnt(" #n ")" ::: "memory")
#define PG8_WAIT_L(n) asm volatile("s_waitcnt lgkmcnt(" #n ")" ::: "memory")
#define PG8_BAR __builtin_amdgcn_s_barrier()
#define PG8_SCHED __builtin_amdgcn_sched_barrier(0)
    Unit cur, nxt; int ui = 0;
    if (!S.next(0, cur)) return;
    f32x4 acc[2][2][4][2];
#pragma unroll
    for (int a = 0; a < 2; ++a)
#pragma unroll
        for (int b = 0; b < 2; ++b)
#pragma unroll
            for (int m = 0; m < 4; ++m)
#pragma unroll
                for (int n = 0; n < 2; ++n) acc[a][b][m][n] = (f32x4){0.f, 0.f, 0.f, 0.f};
    bf16x8 At[4][2], B0[2][2], B1[2][2];
    const char* cA = (const char*)g.A + (size_t)cur.pm * tstep; const char* cB = (const char*)g.Bt + (size_t)cur.pn * tstep;
    S.a_ready(cur);
    if constexpr (SP2) {
        PG8_STAGE(PG8_SB(0, 0), cB, voffB); PG8_STAGE(PG8_SB(0, 1), cB + hstep, voffB); PG8_STAGE(PG8_SA(0, 0), cA, voffA); PG8_STAGE(PG8_SA(0, 1), cA + hstep, voffA);
        if (wr == 1) PG8_BAR;
        PG8_WAIT_V(2); PG8_BAR;
        PG8_STAGE(PG8_SB(1, 0), cB + kstep, voffB); PG8_STAGE(PG8_SA(1, 0), cA + kstep, voffA); PG8_STAGE(PG8_SB(1, 1), cB + hstep + kstep, voffB);
        PG8_WAIT_V(6); PG8_BAR;
    } else {
        PG8_STAGE(PG8_SB(0, 0), cB, voffB); PG8_STAGE(PG8_SA(0, 0), cA, voffA); PG8_STAGE(PG8_SB(0, 1), cB + hstep, voffB); PG8_STAGE(PG8_SA(0, 1), cA + hstep, voffA);
        if (wr == 1) PG8_BAR;
        PG8_WAIT_V(4); PG8_BAR;
        PG8_STAGE(PG8_SB(1, 0), cB + kstep, voffB); PG8_STAGE(PG8_SA(1, 0), cA + kstep, voffA); PG8_STAGE(PG8_SB(1, 1), cB + hstep + kstep, voffB);
        PG8_WAIT_V(6); PG8_BAR;
    }
    for (;;) {
        const bool has_next = S.next(ui + 1, nxt);
        const char* nA = has_next ? (const char*)g.A + (size_t)nxt.pm * tstep : cA; const char* nB = has_next ? (const char*)g.Bt + (size_t)nxt.pn * tstep : cB;
        for (int t = 0; t < nt; t += 2) {
            const bool last = (t == nt - 2);
            const char* a1 = cA + (size_t)(t + 1) * kstep;
            const char* a2 = last ? nA : cA + (size_t)(t + 2) * kstep; const char* b2 = last ? nB : cB + (size_t)(t + 2) * kstep;
            const char* a3 = a2 + kstep; const char* b3 = b2 + kstep;
            if (last && has_next) S.a_ready(nxt);
            if constexpr (SP2) {
            PG8_LDB(B0, 0, 0); PG8_LDB(B1, 0, 1); PG8_SCHED; PG8_LDA(At, 0, 0); PG8_STAGE(PG8_SA(1, 1), a1 + hstep, voffA);
            PG8_WAIT_V(8); PG8_WAIT_L(0); PG8_BAR; PG8_MMA(0, 0, At, B0); PG8_MMA(0, 1, At, B1); PG8_BAR; PG8_SCHED;
            PG8_LDA(At, 0, 1); PG8_STAGE(PG8_SB(0, 0), b2, voffB); PG8_STAGE(PG8_SB(0, 1), b2 + hstep, voffB); PG8_STAGE(PG8_SA(0, 0), a2, voffA);
            PG8_WAIT_V(8); PG8_WAIT_L(0); PG8_BAR; PG8_MMA(1, 0, At, B0); PG8_MMA(1, 1, At, B1); PG8_BAR; PG8_SCHED;
            PG8_LDB(B0, 1, 0); PG8_LDB(B1, 1, 1); PG8_SCHED; PG8_LDA(At, 1, 0); PG8_STAGE(PG8_SA(0, 1), a2 + hstep, voffA);
            PG8_WAIT_V(8); PG8_WAIT_L(0); PG8_BAR; PG8_MMA(0, 0, At, B0); PG8_MMA(0, 1, At, B1); PG8_BAR; PG8_SCHED;
            PG8_LDA(At, 1, 1); PG8_STAGE(PG8_SB(1, 0), b3, voffB); PG8_STAGE(PG8_SB(1, 1), b3 + hstep, voffB); PG8_STAGE(PG8_SA(1, 0), a3, voffA);
            PG8_WAIT_V(8); PG8_WAIT_L(0); PG8_BAR; PG8_MMA(1, 0, At, B0); PG8_MMA(1, 1, At, B1); PG8_BAR; PG8_SCHED;
            } else {
            PG8_LDB(B0, 0, 0); PG8_SCHED; PG8_LDA(At, 0, 0); PG8_STAGE(PG8_SA(1, 1), a1 + hstep, voffA);
            PG8_WAIT_L(8); PG8_BAR; PG8_WAIT_L(0); PG8_MMA(0, 0, At, B0); PG8_BAR; PG8_SCHED;
            PG8_LDB(B1, 0, 1); PG8_STAGE(PG8_SB(0, 0), b2, voffB);
            PG8_BAR; PG8_WAIT_L(0); PG8_MMA(0, 1, At, B1); PG8_BAR;
            PG8_LDA(At, 0, 1); PG8_STAGE(PG8_SA(0, 0), a2, voffA);
            PG8_BAR; PG8_WAIT_L(0); PG8_MMA(1, 0, At, B0); PG8_BAR; PG8_SCHED;
            PG8_STAGE(PG8_SB(0, 1), b2 + hstep, voffB);
            PG8_WAIT_V(6); PG8_BAR; PG8_MMA(1, 1, At, B1); PG8_BAR;
            PG8_LDB(B0, 1, 0); PG8_SCHED; PG8_LDA(At, 1, 0); PG8_STAGE(PG8_SA(0, 1), a2 + hstep, voffA);
            PG8_WAIT_L(8); PG8_BAR; PG8_WAIT_L(0); PG8_MMA(0, 0, At, B0); PG8_BAR; PG8_SCHED;
            PG8_LDB(B1, 1, 1); PG8_STAGE(PG8_SB(1, 0), b3, voffB);
            PG8_BAR; PG8_WAIT_L(0); PG8_MMA(0, 1, At, B1); PG8_BAR;
            PG8_LDA(At, 1, 1); PG8_STAGE(PG8_SA(1, 0), a3, voffA);
            PG8_BAR; PG8_WAIT_L(0); PG8_MMA(1, 0, At, B0); PG8_BAR; PG8_SCHED;
            PG8_STAGE(PG8_SB(1, 1), b3 + hstep, voffB);
            PG8_WAIT_V(6); PG8_BAR; PG8_MMA(1, 1, At, B1); PG8_BAR;
            }
        }
        if constexpr (ALIGN_EPI) { if (wr == 0) PG8_BAR; }
        if constexpr (!Epi::AFTER_DRAIN) { E(acc, cur, wr, wc, fr, fq); S.done(cur); }
        if (!has_next) break;
#pragma unroll
        for (int a = 0; a < 2; ++a)
#pragma unroll
            for (int b = 0; b < 2; ++b)
#pragma unroll
                for (int m = 0; m < 4; ++m)
#pragma unroll
                    for (int n = 0; n < 2; ++n) acc[a][b][m][n] = (f32x4){0.f, 0.f, 0.f, 0.f};
        cur = nxt; cA = nA; cB = nB; ++ui;
        if constexpr (ALIGN_EPI) { if (wr == 1) PG8_BAR; }
    }
    PG8_WAIT_V(0);
    if constexpr (!ALIGN_EPI) { if (wr == 0) PG8_BAR; }
    PG8_BAR;
    if constexpr (Epi::AFTER_DRAIN) { E.fused(acc, cur, wr, wc, fr, fq, lds, wid, lane); S.done(cur); }
#undef PG8_SA
#undef PG8_SB
#undef PG8_STAGE
#undef PG8_LDA
#undef PG8_LDB
#undef PG8_MMA
#undef PG8_WAIT_V
#undef PG8_WAIT_L
#undef PG8_BAR
#undef PG8_SCHED
}
}

#define LAS __attribute__((address_space(3)))
using pg8::ex2; using pg8::rcpf_;
typedef unsigned short u16;
typedef short bf16x8 __attribute__((ext_vector_type(8)));
typedef float f32x4 __attribute__((ext_vector_type(4)));
typedef float f32x16 __attribute__((ext_vector_type(16)));
typedef unsigned u32x4 __attribute__((ext_vector_type(4)));
typedef unsigned u32x2 __attribute__((ext_vector_type(2)));

constexpr int DM = 1024, NB = 16, SEQ = 2048, MTOK = NB * SEQ, DEPTH = 4, DFF = 2816, INW = 2840, PW = 3072;
constexpr int C_MQ = 0, C_MK = 256, C_MV = 512, C_DQ = 768, C_DK = 1024, C_DV = 1280, C_NQ = 1536, C_NKC = 2048, C_NVC = 2176, C_NKS = 2304, C_NVS = 2432, C_NKW = 2560, C_NVW = 2688, C_NG = 2816;
constexpr int NVH = 12;
constexpr float LOG2E = 1.4426950408889634f, NEGF = -1e30f;
constexpr int NPH_L = 14, NPH = NPH_L * DEPTH + 1;
constexpr size_t MiB = 1u << 20;
constexpr size_t WS_GU1 = 1 * MiB, WS_DN1 = 12 * MiB, WS_GU2 = WS_DN1 + 5 * MiB + MiB / 2, WS_DN2 = WS_GU2 + 11 * MiB, WS_WIN = 34 * MiB, WS_WOUT = 40 * MiB, WS_W1 = 42 * MiB;
constexpr size_t WS_PROJ = 44 * MiB, WS_XN = 236 * MiB, WS_VT = 300 * MiB, WS_HID = 348 * MiB, WS_KCMP = 352 * MiB, WS_VCMPT = WS_KCMP + MiB / 2, WS_KMEAN = 353 * MiB, WS_SEL = WS_KMEAN + MiB / 4, WS_XB = 354 * MiB, WS_END = 418 * MiB;
static_assert(WS_DN2 + 5 * MiB + MiB / 2 == WS_WIN, "ws map");
constexpr int LDS_BYTES = 147456, MISC_OFF = 147456 - 64;
constexpr size_t WS_CTL = 0, CTL_ZERO_BYTES = 65536;
constexpr int ATT_K = 0, ATT_V = 32768, ATT_LUT = 65536, ATT_PARK = 68608;
constexpr int CMP_K = 0, CMP_V = 18432, CMP_A = 36864, CMP_H = CMP_A + 256 * 33 * 4;

struct Params {
    const float* x; const float* rel_bias; const float* norm_ffn1; const float* ffn1_gate; const float* ffn1_up; const float* ffn1_down;
    const float* norm_mix; const float* w_in; const float* diff_lambda; const float* diff_subln; const float* cmp_pe; const float* cmp_w1; const float* cmp_w2;
    const float* w_out; const float* norm_ffn2; const float* ffn2_gate; const float* ffn2_up; const float* ffn2_down; const float* final_norm;
    float* out; unsigned char* ws;
    float lam_init[4];
    int ph_lo, ph_hi;
};
typedef const __attribute__((address_space(4))) Params* KParamsPtr;

__device__ __forceinline__ float bf2f(unsigned v) { return __uint_as_float(v << 16); }
typedef float f32x2_t __attribute__((ext_vector_type(2))); typedef __bf16 bf16x2_t __attribute__((ext_vector_type(2)));
__device__ __forceinline__ unsigned pkbf(float lo, float hi) { f32x2_t v = {lo, hi}; bf16x2_t b = __builtin_convertvector(v, bf16x2_t); return __builtin_bit_cast(unsigned, b); }
__device__ __forceinline__ int lane_opaque() { int l; asm volatile("v_mbcnt_lo_u32_b32 %0, -1, 0\n\tv_mbcnt_hi_u32_b32 %0, -1, %0" : "=v"(l)); return l; }
__device__ __forceinline__ float wave_sum(float v, int lane) {
#pragma unroll
    for (int o = 1; o < 64; o <<= 1) v += __int_as_float(__builtin_amdgcn_ds_bpermute((lane ^ o) << 2, __float_as_int(v)));
    return v;
}
__device__ __forceinline__ float xhalf_max(float v) { auto rr = __builtin_amdgcn_permlane32_swap(__float_as_uint(v), __float_as_uint(v), false, false); return fmaxf(__uint_as_float(rr[0]), __uint_as_float(rr[1])); }
__device__ __forceinline__ float xhalf_sum(float v) { auto rr = __builtin_amdgcn_permlane32_swap(__float_as_uint(v), __float_as_uint(v), false, false); return __uint_as_float(rr[0]) + __uint_as_float(rr[1]); }
__device__ __forceinline__ float sigmoid_f(float x) { return rcpf_(1.0f + ex2(-LOG2E * x)); }
__device__ __forceinline__ int crow(int r, int hi) { return (r & 3) + 8 * (r >> 2) + 4 * hi; }
__device__ __forceinline__ int kperm(int p) { const int h = p >> 3, j = p & 7; return 8 * (j >> 2) + 4 * h + (j & 3); }
__device__ __forceinline__ int pperm(int k) { return ((k >> 2) & 1) * 8 + (k >> 3) * 4 + (k & 3); }

__device__ __forceinline__ void tr_item(const float* W, int K, int N, u16* WT, int kb, int n0, int dst_row0, LAS float* scr, int lane, float cs = 1.0f) {
    const int k0 = 64 * kb; const int n = n0 + (lane & 31); const bool ok = n < N;
    float wv[32];
#pragma unroll
    for (int i = 0; i < 32; ++i) { const int kk = 2 * i + (lane >> 5); wv[i] = ok ? W[(size_t)(k0 + kk) * N + n] : 0.f; }
#pragma unroll
    for (int i = 0; i < 32; ++i) { const int kk = 2 * i + (lane >> 5); scr[kk * 33 + (lane & 31)] = wv[i] * cs; }
    asm volatile("s_waitcnt lgkmcnt(0)" ::: "memory");
    const int c = lane & 7;
#pragma unroll
    for (int j = 0; j < 4; ++j) { const int nn = (lane >> 3) + 8 * j; const LAS float* s = scr + (8 * c) * 33 + nn;
        u32x4 o; o.x = pkbf(s[0 * 33], s[1 * 33]); o.y = pkbf(s[2 * 33], s[3 * 33]); o.z = pkbf(s[4 * 33], s[5 * 33]); o.w = pkbf(s[6 * 33], s[7 * 33]);
        *(u32x4*)(WT + (size_t)(dst_row0 + nn) * K + k0 + 8 * c) = o; }
    asm volatile("s_waitcnt lgkmcnt(0)" ::: "memory");
}

__device__ __forceinline__ void norm_row(const float* xrow, const u16* xrow16, const float* g, u16* dst16, float* dst32, u16* xb0, int lane) {
    float v[16];
    if (xrow) { const f32x4* xr = (const f32x4*)xrow + 4 * lane;
#pragma unroll
        for (int j = 0; j < 4; ++j) { const f32x4 t = xr[j]; v[4 * j] = t.x; v[4 * j + 1] = t.y; v[4 * j + 2] = t.z; v[4 * j + 3] = t.w; }
        if (xb0) { u32x4 o0, o1; o0.x = pkbf(v[0], v[1]); o0.y = pkbf(v[2], v[3]); o0.z = pkbf(v[4], v[5]); o0.w = pkbf(v[6], v[7]); o1.x = pkbf(v[8], v[9]); o1.y = pkbf(v[10], v[11]); o1.z = pkbf(v[12], v[13]); o1.w = pkbf(v[14], v[15]);
            ((u32x4*)xb0)[2 * lane] = o0; ((u32x4*)xb0)[2 * lane + 1] = o1; }
    } else { const u32x4 p0 = ((const u32x4*)xrow16)[2 * lane], p1 = ((const u32x4*)xrow16)[2 * lane + 1];
        v[0] = bf2f(p0.x & 0xffffu); v[1] = bf2f(p0.x >> 16); v[2] = bf2f(p0.y & 0xffffu); v[3] = bf2f(p0.y >> 16); v[4] = bf2f(p0.z & 0xffffu); v[5] = bf2f(p0.z >> 16); v[6] = bf2f(p0.w & 0xffffu); v[7] = bf2f(p0.w >> 16);
        v[8] = bf2f(p1.x & 0xffffu); v[9] = bf2f(p1.x >> 16); v[10] = bf2f(p1.y & 0xffffu); v[11] = bf2f(p1.y >> 16); v[12] = bf2f(p1.z & 0xffffu); v[13] = bf2f(p1.z >> 16); v[14] = bf2f(p1.w & 0xffffu); v[15] = bf2f(p1.w >> 16); }
    float s = 0.f;
#pragma unroll
    for (int j = 0; j < 16; ++j) s = fmaf(v[j], v[j], s);
    const float rstd = 1.0f / sqrtf(wave_sum(s, lane) * (1.0f / 1024.0f) + 1e-6f);
    const f32x4* gr = (const f32x4*)g + 4 * lane;
#pragma unroll
    for (int j = 0; j < 4; ++j) { const f32x4 gg = gr[j]; v[4 * j] *= rstd * gg.x; v[4 * j + 1] *= rstd * gg.y; v[4 * j + 2] *= rstd * gg.z; v[4 * j + 3] *= rstd * gg.w; }
    if (dst16) { u32x4 o0, o1; o0.x = pkbf(v[0], v[1]); o0.y = pkbf(v[2], v[3]); o0.z = pkbf(v[4], v[5]); o0.w = pkbf(v[6], v[7]); o1.x = pkbf(v[8], v[9]); o1.y = pkbf(v[10], v[11]); o1.z = pkbf(v[12], v[13]); o1.w = pkbf(v[14], v[15]);
        ((u32x4*)dst16)[2 * lane] = o0; ((u32x4*)dst16)[2 * lane + 1] = o1; }
    else {
#pragma unroll
        for (int j = 0; j < 4; ++j) ((f32x4*)dst32)[4 * lane + j] = (f32x4){v[4 * j], v[4 * j + 1], v[4 * j + 2], v[4 * j + 3]}; }
}

struct AState { f32x16 o0, o1; float m, l; };
__device__ __forceinline__ void astate_init(AState& s) {
#pragma unroll
    for (int r = 0; r < 16; ++r) { s.o0[r] = 0.f; s.o1[r] = 0.f; }
    s.m = 0.f; s.l = 0.f;
}
constexpr float ATT_THR = 8.0f;
constexpr int ATT_SLOT = 9216, ATT_NSLOT = 3;
template <int KS0, int NKS>
__device__ __forceinline__ void qk_block(const LAS unsigned char* Ks, const bf16x8 (&qr)[4], int r32, int hi, f32x16& s0, f32x16& s1) {
    f32x16 ci;
#pragma unroll
    for (int r = 0; r < 16; ++r) ci[r] = 0.f;
    const LAS unsigned char* kp = Ks + hi * 1024 + r32 * 16;
#pragma unroll
    for (int ks = 0; ks < NKS; ++ks) {
        const bf16x8 a0 = *(const LAS bf16x8*)(kp + (KS0 + ks) * 2048);
        const bf16x8 a1 = *(const LAS bf16x8*)(kp + (KS0 + ks) * 2048 + 512);
        s0 = __builtin_amdgcn_mfma_f32_32x32x16_bf16(a0, qr[KS0 + ks], ks == 0 ? ci : s0, 0, 0, 0);
        s1 = __builtin_amdgcn_mfma_f32_32x32x16_bf16(a1, qr[KS0 + ks], ks == 0 ? ci : s1, 0, 0, 0);
    }
    __builtin_amdgcn_sched_group_barrier(0x100, 2 * NKS, 0); __builtin_amdgcn_sched_group_barrier(0x008, 2 * NKS, 0);
}
__device__ __forceinline__ void pv_block(const LAS unsigned char* Vs, const u32x4 (&pk)[4], int r32, int hi, AState& st) {
    const LAS unsigned char* vp = Vs + hi * 1024 + r32 * 16;
#pragma unroll
    for (int c = 0; c < 4; ++c) {
        const bf16x8 v0 = *(const LAS bf16x8*)(vp + c * 2048);
        const bf16x8 v1 = *(const LAS bf16x8*)(vp + c * 2048 + 512);
        const bf16x8 pb = __builtin_bit_cast(bf16x8, pk[c]);
        st.o0 = __builtin_amdgcn_mfma_f32_32x32x16_bf16(v0, pb, st.o0, 0, 0, 0);
        st.o1 = __builtin_amdgcn_mfma_f32_32x32x16_bf16(v1, pb, st.o1, 0, 0, 0);
    }
    __builtin_amdgcn_sched_group_barrier(0x100, 8, 0); __builtin_amdgcn_sched_group_barrier(0x008, 8, 0);
}
__device__ __forceinline__ void glds16(const void* gsrc, unsigned lds_dst) { unsigned keep;
    asm volatile("s_mov_b32 %0, m0\n\ts_mov_b32 m0, %2\n\ts_nop 0\n\tglobal_load_lds_dwordx4 %1, off\n\ts_mov_b32 m0, %0" : "=&s"(keep) : "v"(gsrc), "s"(lds_dst) : "memory"); }
__device__ __forceinline__ void lut_add(f32x16& s0, f32x16& s1, const LAS float* lutz, int dbase, float cc) {
    const LAS float* lp = lutz + (dbase - 59);
#pragma unroll
    for (int r = 0; r < 16; ++r) { const int ko = (r & 3) + 8 * (r >> 2);
        s0[r] += lp[59 - ko] + cc; s1[r] += lp[27 - ko] + cc; }
}
__device__ __forceinline__ void const_add(f32x16& s0, f32x16& s1, float cc) {
#pragma unroll
    for (int r = 0; r < 16; ++r) { s0[r] += cc; s1[r] += cc; }
}
__device__ __forceinline__ float row_max(const f32x16& s0, const f32x16& s1) {
    float mx = fmaxf(s0[0], s1[0]);
#pragma unroll
    for (int r = 1; r < 16; ++r) mx = fmaxf(mx, fmaxf(s0[r], s1[r]));
    return xhalf_max(mx);
}
__device__ __forceinline__ void rescale(AState& st, f32x16& s0, f32x16& s1, float mx) {
    const float dl = fmaxf(mx, 0.f); const float f = ex2(-dl); st.m += dl; st.l *= f;
#pragma unroll
    for (int r = 0; r < 16; ++r) { st.o0[r] *= f; st.o1[r] *= f; s0[r] -= dl; s1[r] -= dl; }
}
__device__ __forceinline__ void exp_pack(f32x16& s0, f32x16& s1, u32x4 (&pk)[4], AState& st) {
    float sum = 0.f;
#pragma unroll
    for (int r = 0; r < 16; ++r) { s0[r] = ex2(s0[r]); s1[r] = ex2(s1[r]); sum += s0[r] + s1[r]; }
    st.l += sum;
    pk[0] = (u32x4){pkbf(s0[0], s0[1]), pkbf(s0[2], s0[3]), pkbf(s0[4], s0[5]), pkbf(s0[6], s0[7])};
    pk[1] = (u32x4){pkbf(s0[8], s0[9]), pkbf(s0[10], s0[11]), pkbf(s0[12], s0[13]), pkbf(s0[14], s0[15])};
    pk[2] = (u32x4){pkbf(s1[0], s1[1]), pkbf(s1[2], s1[3]), pkbf(s1[4], s1[5]), pkbf(s1[6], s1[7])};
    pk[3] = (u32x4){pkbf(s1[8], s1[9]), pkbf(s1[10], s1[11]), pkbf(s1[12], s1[13]), pkbf(s1[14], s1[15])};
}

template <int KS0, int NKS, bool WINDOW, int MODE>
__device__ __forceinline__ void run_tiles(LAS unsigned char* lds, int t0, int t1, const u16* Kg, const u16* Vtg, const bf16x8 (&qr)[4], float c31,
                                          int q0w, unsigned mask, int qb, AState& A, int wave, int lane, int r32, int hi) {
    LAS unsigned char* Kr = lds + ATT_K; LAS unsigned char* Vr = lds + ATT_V; const LAS float* lut1 = (const LAS float*)(lds + ATT_LUT) + 96;
    const u16* ksrc = Kg + (size_t)lane * PW + wave * 8;
    const u16* vsrc = Vtg + (size_t)lane * SEQ + wave * 8;
    const unsigned kdst = (unsigned)(uintptr_t)Kr + wave * 1024, vdst = (unsigned)(uintptr_t)Vr + wave * 1024;
#define TCL(t) ((t) < t0 ? t0 : ((t) > t1 ? t1 : (t)))
#define DMA_K(tn) glds16(ksrc + (size_t)TCL(tn) * 64 * PW, (unsigned)__builtin_amdgcn_readfirstlane(kdst + ((tn) & 3) * 8192))
#define DMA_V(tn) glds16(vsrc + TCL(tn) * 64, (unsigned)__builtin_amdgcn_readfirstlane(vdst + ((tn) & 3) * 8192))
#define KS_(t) (Kr + ((t) & 3) * 8192)
#define VS_(t) (Vr + ((t) & 3) * 8192)
#define WAIT_BAR4() asm volatile("s_waitcnt vmcnt(4) lgkmcnt(0)\n\ts_barrier" ::: "memory")
#define T_ACTIVE(t) (!((q0w + 31 - (t) * 64) < 0 || (WINDOW && (q0w - ((t) * 64 + 63)) >= 512)))
#define T_LUTMODE(t) (((q0w - ((t) * 64 + 63)) < 128) || (WINDOW && (q0w + 31 - (t) * 64) >= 512))
    auto tile_sel = [&](int t) -> int { if (MODE == 1) { const int blk = t >> 2; return blk < qb ? (int)((mask >> blk) & 1u) : 1; } if (MODE == 2) return (int)((mask >> t) & 1u); return 1; };
    asm volatile("s_waitcnt vmcnt(0)" ::: "memory");
#pragma unroll
    for (int j = 0; j < 4; ++j) { DMA_K(t0 + j); DMA_V(t0 + j - 2); }
    WAIT_BAR4();
    f32x16 sn0, sn1, sc0, sc1; u32x4 pk[4];
#pragma unroll
    for (int r = 0; r < 16; ++r) { sn0[r] = 0.f; sn1[r] = 0.f; }
#pragma unroll
    for (int i = 0; i < 4; ++i) pk[i] = (u32x4){0u, 0u, 0u, 0u};
    bool act_n = T_ACTIVE(t0), act_c = false, act_p = false;
    if (act_n) qk_block<KS0, NKS>(KS_(t0), qr, r32, hi, sn0, sn1);
    asm volatile("s_waitcnt lgkmcnt(0)\n\ts_barrier" ::: "memory");
    for (int c = t0; c <= t1 + 1; ++c) {
        act_p = act_c; act_c = act_n; sc0 = sn0; sc1 = sn1;
        DMA_K(c + 4); DMA_V(c + 2);
        act_n = (c + 1 <= t1) && T_ACTIVE(c + 1);
        const bool lm_c = T_LUTMODE(c);
        const int dbase = q0w + r32 - c * 64 - 4 * hi;
        const float selc = tile_sel(c) ? (lm_c ? 0.f : c31) : NEGF;
        if (act_p) pv_block(VS_(c - 1), pk, r32, hi, A);
        if (act_c) {
            if (lm_c) lut_add(sc0, sc1, lut1, dbase, selc - A.m); else const_add(sc0, sc1, selc - A.m);
            const float mx = row_max(sc0, sc1);
            if (__any(mx > ATT_THR)) rescale(A, sc0, sc1, mx);
        }
        if (act_n) qk_block<KS0, NKS>(KS_(c + 1), qr, r32, hi, sn0, sn1);
        if (act_c) exp_pack(sc0, sc1, pk, A);
        WAIT_BAR4();
    }
    asm volatile("s_waitcnt vmcnt(0) lgkmcnt(0)\n\ts_barrier" ::: "memory");
#undef TCL
#undef DMA_K
#undef DMA_V
#undef KS_
#undef VS_
#undef WAIT_BAR4
#undef T_ACTIVE
#undef T_LUTMODE
}

__device__ __forceinline__ void build_lut(LAS unsigned char* lds, const float* rel_bias, int head, bool window, int tid) {
    LAS float* lut = (LAS float*)(lds + ATT_LUT);
    for (int i = tid; i < 704; i += 512) {
        const int d = i - 96; float v;
        if (d < 0) v = NEGF;
        else if (d >= 512) v = window ? NEGF : rel_bias[31 * 16 + head] * LOG2E;
        else { int bk;
            if (d < 16) bk = d; else if (d >= 128) bk = 31; else { bk = 16 + (int)(log2f((float)d * (1.0f / 16.0f)) * (16.0f / 3.0f)); bk = bk > 31 ? 31 : bk; }
            v = rel_bias[bk * 16 + head] * LOG2E; }
        lut[i] = v;
    }
}
__device__ __forceinline__ void load_q(bf16x8 (&qr)[4], const u16* qrow, int hi) {
#pragma unroll
    for (int ks = 0; ks < 4; ++ks) qr[ks] = *(const bf16x8*)(qrow + ks * 16 + hi * 8);
}
__device__ __forceinline__ void store_o(u16* dst, const f32x16& v0, const f32x16& v1, int hi) {
#pragma unroll
    for (int g = 0; g < 4; ++g) {
        u32x2 a; a.x = pkbf(v0[4 * g], v0[4 * g + 1]); a.y = pkbf(v0[4 * g + 2], v0[4 * g + 3]); *(u32x2*)(dst + 8 * g + 4 * hi) = a;
        u32x2 b; b.x = pkbf(v1[4 * g], v1[4 * g + 1]); b.y = pkbf(v1[4 * g + 2], v1[4 * g + 3]); *(u32x2*)(dst + 32 + 8 * g + 4 * hi) = b;
    }
}

struct Ctx { LAS unsigned char* lds; int tid, lane, wave, r32, hi, G, bx; u16* proj; u16* obuf; u16* vt; };

__device__ __forceinline__ void moba_unit(const Ctx& C0, KParamsPtr P, int b, int h, int qb) {
    Ctx C = C0; C.lane = lane_opaque(); C.tid = C.wave * 64 + C.lane; C.r32 = C.lane & 31; C.hi = C.lane >> 5;
    const int q0w = __builtin_amdgcn_readfirstlane(qb * 256 + C.wave * 32); const int qpos = q0w + C.r32; const size_t tok = (size_t)b * SEQ + qpos;
    build_lut(C.lds, P->rel_bias, h, false, C.tid);
    const u16* qrow = C.proj + tok * PW + C_MQ + h * 64;
    bf16x8 qr[4]; load_q(qr, qrow, C.hi);
    unsigned mask = 0;
    if (qb > 0) {
        float g[7];
#pragma unroll
        for (int j = 0; j < 7; ++j) g[j] = 0.f;
        const float* km = (const float*)(P->ws + WS_KMEAN) + (size_t)((b * 4 + h) * 8) * 64;
#pragma unroll
        for (int dc = 0; dc < 8; ++dc) {
            const u32x4 qv = *(const u32x4*)(qrow + dc * 8);
            float qf[8]; qf[0] = bf2f(qv.x & 0xffffu); qf[1] = bf2f(qv.x >> 16); qf[2] = bf2f(qv.y & 0xffffu); qf[3] = bf2f(qv.y >> 16);
            qf[4] = bf2f(qv.z & 0xffffu); qf[5] = bf2f(qv.z >> 16); qf[6] = bf2f(qv.w & 0xffffu); qf[7] = bf2f(qv.w >> 16);
#pragma unroll
            for (int j = 0; j < 7; ++j) if (j < qb) { const float* kmj = km + j * 64 + dc * 8;
#pragma unroll
                for (int e = 0; e < 8; ++e) g[j] = fmaf(qf[e], kmj[e], g[j]); }
        }
#pragma unroll
        for (int j = 0; j < 7; ++j) if (j < qb) { int rank = 0;
#pragma unroll
            for (int i = 0; i < 7; ++i) if (i != j && i < qb) rank += (g[i] > g[j] || (g[i] == g[j] && i < j)) ? 1 : 0;
            if (rank < 3) mask |= 1u << j; }
    }
    AState A; astate_init(A);
    const float c31 = P->rel_bias[31 * 16 + h] * LOG2E;
    run_tiles<0, 4, false, 1>(C.lds, 0, 4 * qb + 3, C.proj + (size_t)b * SEQ * PW + C_MK + h * 64, C.vt + (size_t)((b * NVH + h) * 64) * SEQ, qr, c31, q0w, mask, qb, A, C.wave, C.lane, C.r32, C.hi);
    const float inv = rcpf_(xhalf_sum(A.l));
    A.o0 *= inv; A.o1 *= inv;
    { const int l2 = lane_opaque(); const size_t tok2 = (size_t)b * SEQ + q0w + (l2 & 31);
      store_o(C.obuf + tok2 * DM + h * 64, A.o0, A.o1, l2 >> 5); }
}

__device__ __forceinline__ void diff_unit(const Ctx& C0, KParamsPtr P, int layer, int b, int h, int qb) {
    Ctx C = C0; C.lane = lane_opaque(); C.tid = C.wave * 64 + C.lane; C.r32 = C.lane & 31; C.hi = C.lane >> 5;
    const int q0w = __builtin_amdgcn_readfirstlane(qb * 256 + C.wave * 32); const int qpos = q0w + C.r32; const size_t tok = (size_t)b * SEQ + qpos;
    build_lut(C.lds, P->rel_bias, 4 + h, false, C.tid);
    bf16x8 qr[4]; load_q(qr, C.proj + tok * PW + C_DQ + h * 64, C.hi);
    AState A; astate_init(A);
    const float c31 = P->rel_bias[31 * 16 + 4 + h] * LOG2E;
    const u16* Kg = C.proj + (size_t)b * SEQ * PW + C_DK + h * 64; const u16* Vg = C.vt + (size_t)((b * NVH + 4 + h) * 64) * SEQ;
    run_tiles<0, 2, false, 0>(C.lds, 0, 4 * qb + 3, Kg, Vg, qr, c31, q0w, 0u, 0, A, C.wave, C.lane, C.r32, C.hi);
    LAS float* park = (LAS float*)(C.lds + ATT_PARK) + C.tid;
    { const float i0 = rcpf_(xhalf_sum(A.l));
#pragma unroll
      for (int r = 0; r < 16; ++r) { park[r * 512] = A.o0[r] * i0; park[(16 + r) * 512] = A.o1[r] * i0; } }
    astate_init(A);
    run_tiles<2, 2, false, 0>(C.lds, 0, 4 * qb + 3, Kg, Vg, qr, c31, q0w, 0u, 0, A, C.wave, C.lane, C.r32, C.hi);
    const float* lp = P->diff_lambda + (size_t)layer * 128; float d01 = 0.f, d23 = 0.f;
    for (int i = 0; i < 32; ++i) { d01 = fmaf(lp[i], lp[32 + i], d01); d23 = fmaf(lp[64 + i], lp[96 + i], d23); }
    const float li = P->lam_init[layer]; const float lam = expf(d01) - expf(d23) + li;
    const float i1 = lam * rcpf_(xhalf_sum(A.l));
    float ss = 0.f;
#pragma unroll
    for (int r = 0; r < 16; ++r) { A.o0[r] = park[r * 512] - A.o0[r] * i1; A.o1[r] = park[(16 + r) * 512] - A.o1[r] * i1; ss += A.o0[r] * A.o0[r] + A.o1[r] * A.o1[r]; }
    ss = xhalf_sum(ss);
    const float rstd = (1.0f / sqrtf(ss * (1.0f / 64.0f) + 1e-6f)) * (1.0f - li);
    const float* sg = P->diff_subln + (size_t)layer * 64;
#pragma unroll
    for (int r = 0; r < 16; ++r) { const int d = crow(r, C.hi); A.o0[r] *= rstd * sg[d]; A.o1[r] *= rstd * sg[32 + d]; }
    { const int l2 = lane_opaque(); const size_t tok2 = (size_t)b * SEQ + q0w + (l2 & 31);
      store_o(C.obuf + tok2 * DM + 256 + h * 64, A.o0, A.o1, l2 >> 5); }
}

__device__ __forceinline__ void nsa_unit(const Ctx& C0, KParamsPtr P, int b, int hq, int qb) {
    Ctx C = C0; C.lane = lane_opaque(); C.tid = C.wave * 64 + C.lane; C.r32 = C.lane & 31; C.hi = C.lane >> 5;
    const int g = hq >> 2;
    const int q0w = __builtin_amdgcn_readfirstlane(qb * 256 + C.wave * 32); const int qpos = q0w + C.r32; const size_t tok = (size_t)b * SEQ + qpos;
    build_lut(C.lds, P->rel_bias, 8 + hq, false, C.tid);
    bf16x8 qr[4]; load_q(qr, C.proj + tok * PW + C_NQ + hq * 64, C.hi);
    const u16* gl = C.proj + tok * PW + C_NG + hq * 3;
    const float g1 = sigmoid_f(bf2f(gl[1])), g2 = sigmoid_f(bf2f(gl[2]));
    const unsigned mask = ((const unsigned*)(P->ws + WS_SEL))[(size_t)(b * 2 + g) * SEQ + qpos];
    const float c31 = P->rel_bias[31 * 16 + 8 + hq] * LOG2E;
    AState A; astate_init(A);
    run_tiles<0, 4, false, 2>(C.lds, 0, 4 * qb + 3, C.proj + (size_t)b * SEQ * PW + C_NKS + g * 64, C.vt + (size_t)((b * NVH + 8 + g) * 64) * SEQ, qr, c31, q0w, mask, qb, A, C.wave, C.lane, C.r32, C.hi);
    LAS float* park = (LAS float*)(C.lds + ATT_PARK) + C.tid;
    { const float f = g1 * rcpf_(xhalf_sum(A.l));
#pragma unroll
      for (int r = 0; r < 16; ++r) { park[r * 512] = A.o0[r] * f; park[(16 + r) * 512] = A.o1[r] * f; } }
    if (C.tid < 96) ((LAS float*)(C.lds + ATT_LUT))[608 + C.tid] = NEGF;
    astate_init(A);
    const int tw0 = 4 * qb - 8 < 0 ? 0 : 4 * qb - 8;
    run_tiles<0, 4, true, 0>(C.lds, tw0, 4 * qb + 3, C.proj + (size_t)b * SEQ * PW + C_NKW + g * 64, C.vt + (size_t)((b * NVH + 10 + g) * 64) * SEQ, qr, c31, q0w, 0u, qb, A, C.wave, C.lane, C.r32, C.hi);
    { const float f = g2 * rcpf_(xhalf_sum(A.l));
#pragma unroll
      for (int r = 0; r < 16; ++r) { A.o0[r] = A.o0[r] * f + park[r * 512]; A.o1[r] = A.o1[r] * f + park[(16 + r) * 512]; } }
    const int l2 = lane_opaque(); const int hi2 = l2 >> 5;
    u16* dst = C.obuf + ((size_t)b * SEQ + q0w + (l2 & 31)) * DM + 512 + hq * 64;
#pragma unroll
    for (int gg = 0; gg < 4; ++gg) {
        const u32x2 a = *(const u32x2*)(dst + 8 * gg + 4 * hi2), bq = *(const u32x2*)(dst + 32 + 8 * gg + 4 * hi2);
        A.o0[4 * gg] += bf2f(a.x & 0xffffu); A.o0[4 * gg + 1] += bf2f(a.x >> 16); A.o0[4 * gg + 2] += bf2f(a.y & 0xffffu); A.o0[4 * gg + 3] += bf2f(a.y >> 16);
        A.o1[4 * gg] += bf2f(bq.x & 0xffffu); A.o1[4 * gg + 1] += bf2f(bq.x >> 16); A.o1[4 * gg + 2] += bf2f(bq.y & 0xffffu); A.o1[4 * gg + 3] += bf2f(bq.y >> 16);
    }
    store_o(dst, A.o0, A.o1, hi2);
}

__device__ __forceinline__ void cmp_unit(const Ctx& C0, KParamsPtr P, int b, int g, int qblk) {
    Ctx C = C0; C.lane = lane_opaque(); C.tid = C.wave * 64 + C.lane; C.r32 = C.lane & 31; C.hi = C.lane >> 5;
    LAS unsigned char* lds = C.lds; const int tid = C.tid, r32 = C.r32, hi = C.hi;
    const u16* kc = (const u16*)(P->ws + WS_KCMP) + (size_t)(b * 2 + g) * 128 * 64;
    const u16* vc = (const u16*)(P->ws + WS_VCMPT) + (size_t)(b * 2 + g) * 64 * 128;
#pragma unroll
    for (int i = 0; i < 2; ++i) { const int e = tid + 512 * i;
        { const int row = e >> 3, ch = e & 7; *(LAS u32x4*)(lds + CMP_K + row * 144 + ch * 16) = *(const u32x4*)(kc + row * 64 + ch * 8); }
        { const int row = e >> 4, ch = e & 15; *(LAS u32x4*)(lds + CMP_V + row * 272 + ch * 16) = *(const u32x4*)(vc + row * 128 + ch * 8); } }
    const int q0w = __builtin_amdgcn_readfirstlane(qblk * 256 + C.wave * 32); const int qpos = q0w + r32; const size_t tok = (size_t)b * SEQ + qpos;
    const int nmax = (qpos - 31) >> 4;
    __syncthreads();
    float qa[16], qh[16];
#pragma unroll
    for (int i = 0; i < 16; ++i) { qa[i] = 0.f; qh[i] = 0.f; }
    const LAS unsigned char* kp = lds + CMP_K + r32 * 144 + hi * 16;
    const LAS unsigned char* vp = lds + CMP_V + r32 * 272 + hi * 16;
    bf16x8 qn[4]; load_q(qn, C.proj + tok * PW + C_NQ + g * 4 * 64, hi);
    for (int rh = 0; rh < 4; ++rh) {
        const int hq = g * 4 + rh;
        bf16x8 qr[4];
#pragma unroll
        for (int ks = 0; ks < 4; ++ks) qr[ks] = qn[ks];
        load_q(qn, C.proj + tok * PW + C_NQ + (g * 4 + (rh < 3 ? rh + 1 : rh)) * 64, hi);
        const float g0 = sigmoid_f(bf2f(C.proj[tok * PW + C_NG + hq * 3]));
        f32x16 s[4];
#pragma unroll
        for (int kb = 0; kb < 4; ++kb) {
#pragma unroll
            for (int r = 0; r < 16; ++r) s[kb][r] = 0.f;
#pragma unroll
            for (int ks = 0; ks < 4; ++ks) { const bf16x8 a = *(const LAS bf16x8*)(kp + kb * 32 * 144 + ks * 32); s[kb] = __builtin_amdgcn_mfma_f32_32x32x16_bf16(a, qr[ks], s[kb], 0, 0, 0); }
        }
        float mx = NEGF;
#pragma unroll
        for (int kb = 0; kb < 4; ++kb)
#pragma unroll
            for (int r = 0; r < 16; ++r) { const int n = 32 * kb + crow(r, hi); const float v = (n <= nmax) ? s[kb][r] : NEGF; s[kb][r] = v; mx = fmaxf(mx, v); }
        mx = xhalf_max(mx);
        float sum = 0.f;
#pragma unroll
        for (int kb = 0; kb < 4; ++kb)
#pragma unroll
            for (int r = 0; r < 16; ++r) { const int n = 32 * kb + crow(r, hi); const float pv = (n <= nmax) ? ex2(s[kb][r] - mx) : 0.f; s[kb][r] = pv; sum += pv; }
        sum = xhalf_sum(sum);
        const float inv = nmax >= 0 ? rcpf_(sum) : 0.f;
        f32x16 o0, o1;
#pragma unroll
        for (int r = 0; r < 16; ++r) { o0[r] = 0.f; o1[r] = 0.f; }
#pragma unroll
        for (int kb = 0; kb < 4; ++kb) {
#pragma unroll
            for (int r = 0; r < 16; ++r) s[kb][r] *= inv;
#pragma unroll
            for (int g4 = 0; g4 < 4; ++g4) { const float h = 0.5f * s[kb][4 * g4 + 3]; qh[kb * 4 + g4] += h; qa[kb * 4 + g4] += (s[kb][4 * g4] + s[kb][4 * g4 + 1]) + (s[kb][4 * g4 + 2] + h); }
#pragma unroll
            for (int c = 0; c < 2; ++c) {
                const u32x4 pk = (u32x4){pkbf(s[kb][8 * c], s[kb][8 * c + 1]), pkbf(s[kb][8 * c + 2], s[kb][8 * c + 3]), pkbf(s[kb][8 * c + 4], s[kb][8 * c + 5]), pkbf(s[kb][8 * c + 6], s[kb][8 * c + 7])};
                const bf16x8 pb = __builtin_bit_cast(bf16x8, pk);
                const bf16x8 v0 = *(const LAS bf16x8*)(vp + (kb * 2 + c) * 32);
                const bf16x8 v1 = *(const LAS bf16x8*)(vp + 32 * 272 + (kb * 2 + c) * 32);
                o0 = __builtin_amdgcn_mfma_f32_32x32x16_bf16(v0, pb, o0, 0, 0, 0);
                o1 = __builtin_amdgcn_mfma_f32_32x32x16_bf16(v1, pb, o1, 0, 0, 0);
            }
            __builtin_amdgcn_sched_barrier(0);
        }
        o0 *= g0; o1 *= g0;
        store_o(C.obuf + tok * DM + 512 + hq * 64, o0, o1, hi);
    }
    LAS float* Aq = (LAS float*)(lds + CMP_A) + (C.wave * 32 + r32) * 33; LAS float* Hq = (LAS float*)(lds + CMP_H) + (C.wave * 32 + r32) * 33;
#pragma unroll
    for (int kb = 0; kb < 4; ++kb)
#pragma unroll
        for (int g4 = 0; g4 < 4; ++g4) { const int j = 8 * kb + 2 * g4 + hi; Aq[j] = qa[kb * 4 + g4]; Hq[j] = qh[kb * 4 + g4]; }
    __syncthreads();
    const int cur = q0w >> 6;
    unsigned bits = 0;
    if (cur < 16) bits = (2u << cur) - 1u;
    else {
        float sc[32];
#pragma unroll
        for (int i = 0; i < 32; ++i) { const float imp = Aq[i] + (i > 0 ? Hq[i - 1] : 0.f); sc[i] = (i > cur) ? -3.0e38f : ((i == 0 || i > cur - 2) ? 1e4f : imp); }
#pragma unroll
        for (int e = 0; e < 16; ++e) {
            const float sj = hi ? sc[16 + e] : sc[e]; int rank = 0;
#pragma unroll
            for (int i = 0; i < 32; ++i) { const bool lt = (i < e) || (hi && i < 16 + e);
                rank += (sc[i] > sj || (sc[i] == sj && lt)) ? 1 : 0; }
            const int j = hi * 16 + e;
            if (j <= cur && rank < 16) bits |= 1u << j; }
        { auto rr = __builtin_amdgcn_permlane32_swap(bits, bits, false, false); bits = rr[0] | rr[1]; }
    }
    if (hi == 0) ((unsigned*)(P->ws + WS_SEL))[(size_t)(b * 2 + g) * SEQ + qpos] = bits;
    __syncthreads();
}

__device__ __forceinline__ void prep_vk(const Ctx& C, KParamsPtr P, int b0) {
    const int G = C.G - b0, bxr = C.bx - b0, tid = C.tid, lane = C.lane;
    if (bxr < 0) return;
    for (int it = bxr; it < NB * NVH * 32; it += G) {
        const int tb = it & 31, hv = (it >> 5) % NVH, b = it / (32 * NVH);
        const int vcol = hv < 4 ? C_MV + hv * 64 : hv < 8 ? C_DV + (hv - 4) * 64 : hv < 10 ? C_NVS + (hv - 8) * 64 : C_NVW + (hv - 10) * 64;
        { const int row = tid >> 3, ch = tid & 7; *(LAS u32x4*)(C.lds + row * 144 + ch * 16) = *(const u32x4*)(C.proj + ((size_t)b * SEQ + tb * 64 + row) * PW + vcol + ch * 8); }
        __syncthreads();
        { const int d = tid >> 3, pc = tid & 7; unsigned w[4];
#pragma unroll
            for (int e = 0; e < 4; ++e) { const int p0 = pc * 8 + 2 * e, p1 = p0 + 1; const int k0 = (p0 & ~15) + kperm(p0 & 15), k1 = (p1 & ~15) + kperm(p1 & 15);
                const unsigned a = *(const LAS u16*)(C.lds + k0 * 144 + d * 2), bb = *(const LAS u16*)(C.lds + k1 * 144 + d * 2); w[e] = a | (bb << 16); }
            *(u32x4*)(C.vt + ((size_t)(b * NVH + hv) * 64 + d) * SEQ + tb * 64 + pc * 8) = (u32x4){w[0], w[1], w[2], w[3]}; }
        __syncthreads();
    }
    const int gw = bxr * 8 + C.wave, NGW = G * 8;
    for (int it = gw; it < NB * 4 * 8; it += NGW) {
        const int blk = it & 7, h = (it >> 3) & 3, b = it >> 5;
        const u16* kp = C.proj + ((size_t)b * SEQ + blk * 256) * PW + C_MK + h * 64 + lane; float s = 0.f;
        for (int k = 0; k < 256; k += 8) { float t[8];
#pragma unroll
            for (int e = 0; e < 8; ++e) t[e] = bf2f(kp[(size_t)(k + e) * PW]);
            s += ((t[0] + t[1]) + (t[2] + t[3])) + ((t[4] + t[5]) + (t[6] + t[7])); }
        ((float*)(P->ws + WS_KMEAN))[(size_t)it * 64 + lane] = s * (1.0f / 256.0f);
    }
}
__device__ __forceinline__ void prep_a(const Ctx& C, KParamsPtr P, int layer) {
    const int G = C.G, lane = C.lane;
    const int gw = C.bx * 8 + C.wave, NGW = G * 8;
    u16* acmp = (u16*)(P->ws + WS_XN);
    for (int it = gw; it < 2 * 4096; it += NGW) {
        const int i = it >> 12, row = it & 4095, n = row & 127, bg = row >> 7, b = bg >> 1, g = bg & 1;
        u16* dst = acmp + (size_t)it * 2048; const float* pe = P->cmp_pe + (size_t)(layer * 2 + i) * 2048;
        const int col = (i == 0 ? C_NKC : C_NVC) + g * 64;
#pragma unroll
        for (int pass = 0; pass < 4; ++pass) { const int l = pass * 8 + (lane >> 3), d0 = (lane & 7) * 8;
            unsigned z0 = 0u; asm volatile("" : "+v"(z0)); u32x4 o = (u32x4){z0, z0, z0, z0};
            if (n < 127) { const u32x4 v = *(const u32x4*)(C.proj + ((size_t)b * SEQ + 16 * n + l) * PW + col + d0); const f32x4 e0 = *(const f32x4*)(pe + l * 64 + d0), e1 = *(const f32x4*)(pe + l * 64 + d0 + 4);
                o.x = pkbf(bf2f(v.x & 0xffffu) + e0.x, bf2f(v.x >> 16) + e0.y); o.y = pkbf(bf2f(v.y & 0xffffu) + e0.z, bf2f(v.y >> 16) + e0.w);
                o.z = pkbf(bf2f(v.z & 0xffffu) + e1.x, bf2f(v.z >> 16) + e1.y); o.w = pkbf(bf2f(v.w & 0xffffu) + e1.z, bf2f(v.w >> 16) + e1.w); }
            *(u32x4*)(dst + l * 64 + d0) = o; }
    }
}
__device__ __forceinline__ void prep_c(const Ctx& C, KParamsPtr P, int layer, int it0) {
    const int i = it0 >> 12, row0 = it0 & 4095, lane = lane_opaque(), tid = C.wave * 64 + lane, r32 = lane & 31, hi = lane >> 5;
    const float* w2 = P->cmp_w2 + (size_t)(layer * 2 + i) * 256 * 64;
    for (int e = tid; e < 256 * 64; e += 512) { const int k = e >> 6, c = e & 63; *(LAS u16*)(C.lds + c * 528 + k * 2) = (u16)(pkbf(w2[e], 0.f) & 0xffffu); }
    __syncthreads();
    const int wrow = row0 + C.wave * 32;
    const u16* hrow = (const u16*)(P->ws + WS_HID) + ((size_t)i * 4096 + wrow + r32) * 256 + hi * 8;
    f32x16 d0, d1;
#pragma unroll
    for (int r = 0; r < 16; ++r) { d0[r] = 0.f; d1[r] = 0.f; }
#pragma unroll 4
    for (int ks = 0; ks < 16; ++ks) {
        const bf16x8 a = *(const bf16x8*)(hrow + ks * 16);
        const bf16x8 b0 = *(const LAS bf16x8*)(C.lds + r32 * 528 + (ks * 16 + hi * 8) * 2);
        const bf16x8 b1 = *(const LAS bf16x8*)(C.lds + (32 + r32) * 528 + (ks * 16 + hi * 8) * 2);
        d0 = __builtin_amdgcn_mfma_f32_32x32x16_bf16(a, b0, d0, 0, 0, 0);
        d1 = __builtin_amdgcn_mfma_f32_32x32x16_bf16(a, b1, d1, 0, 0, 0);
    }
#pragma unroll
    for (int r = 0; r < 16; ++r) { const int row = wrow + crow(r, hi);
        const unsigned v0 = pkbf(d0[r], 0.f) & 0xffffu, v1 = pkbf(d1[r], 0.f) & 0xffffu;
        if (i == 0) { u16* o = (u16*)(P->ws + WS_KCMP) + (size_t)row * 64; o[r32] = (u16)v0; o[32 + r32] = (u16)v1; }
        else { const int bg = row >> 7, n = row & 127; u16* o = (u16*)(P->ws + WS_VCMPT) + (size_t)bg * 64 * 128 + (n & ~15) + pperm(n & 15); o[(size_t)r32 * 128] = (u16)v0; o[(size_t)(32 + r32) * 128] = (u16)v1; }
    }
}

__device__ __forceinline__ void convert_weights(const Ctx& C, KParamsPtr P, int layer) {
    LAS float* scr = (LAS float*)(C.lds + C.wave * 16384);
    const int gw = C.bx * 8 + C.wave, NGW = C.G * 8, lane = C.lane;
    constexpr int I_G = 16 * 88, I_D = 44 * 32, I_IN = 16 * 96, I_O = 16 * 32, I_W1 = 32 * 8;
    constexpr int NIT = 4 * I_G + 2 * I_D + I_IN + I_O + 2 * I_W1;
    unsigned char* ws = P->ws;
    for (int it = gw; it < NIT; it += NGW) {
        int r = it;
        if (r < 4 * I_G) { const int which = r / I_G; r -= which * I_G; const int kb = r / 88, nb = r % 88, n0 = nb * 32;
            const float* W = (which == 0 ? P->ffn1_gate : which == 1 ? P->ffn1_up : which == 2 ? P->ffn2_gate : P->ffn2_up) + (size_t)layer * DM * DFF;
            u16* WT = (u16*)(ws + (which < 2 ? WS_GU1 : WS_GU2));
            tr_item(W, DM, DFF, WT, kb, n0, (n0 >> 7) * 256 + (which & 1) * 128 + (n0 & 127), scr, lane); continue; }
        r -= 4 * I_G;
        if (r < 2 * I_D) { const int which = r / I_D; r -= which * I_D; const int kb = r / 32, nb = r % 32;
            const float* W = (which == 0 ? P->ffn1_down : P->ffn2_down) + (size_t)layer * DFF * DM;
            tr_item(W, DFF, DM, (u16*)(ws + (which == 0 ? WS_DN1 : WS_DN2)), kb, nb * 32, nb * 32, scr, lane); continue; }
        r -= 2 * I_D;
        if (r < I_IN) { const int kb = r / 96, nb = r % 96, n0 = nb * 32;
            const float cs = (n0 < C_MK || (n0 >= C_NQ && n0 < C_NKC)) ? 0.125f * LOG2E : (n0 >= C_DQ && n0 < C_DK) ? 0.17677669529663687f * LOG2E : 1.0f;
            tr_item(P->w_in + (size_t)layer * DM * INW, DM, INW, (u16*)(ws + WS_WIN), kb, n0, n0, scr, lane, cs); continue; }
        r -= I_IN;
        if (r < I_O) { const int kb = r / 32, nb = r % 32; tr_item(P->w_out + (size_t)layer * DM * DM, DM, DM, (u16*)(ws + WS_WOUT), kb, nb * 32, nb * 32, scr, lane); continue; }
        r -= I_O;
        { const int i = r / I_W1; r -= i * I_W1; const int kb = r / 8, nb = r % 8;
            tr_item(P->cmp_w1 + (size_t)(layer * 2 + i) * 2048 * 256, 2048, 256, (u16*)(ws + WS_W1) + (size_t)i * 256 * 2048, kb, nb * 32, nb * 32, scr, lane); }
    }
}
__device__ __forceinline__ void norm_phase(const Ctx& C, const float* src32, const u16* src16, const float* g, u16* dst16, float* dst32, u16* xb0) {
    const int gw = C.bx * 8 + C.wave, NGW = C.G * 8;
    for (int m = gw; m < MTOK; m += NGW) norm_row(src32 ? src32 + (size_t)m * DM : nullptr, src16 ? src16 + (size_t)m * DM : nullptr, g, dst16 ? dst16 + (size_t)m * DM : nullptr, dst32 ? dst32 + (size_t)m * DM : nullptr, xb0 ? xb0 + (size_t)m * DM : nullptr, C.lane);
}

#define XB_TMO      128
#define XB_XCNT(j)  (256  + 64 * (j))
#define XB_XSUB(j)  (1280 + 64 * (j))
#define XB_XGEN(j)  (2304 + 64 * (j))
#define XB_TOP      3328
#define XB_TOPGEN   3392
#define XCD_BAR_WORDS 3456
#define XB_SPIN_CAP (1u << 18)

__device__ __forceinline__ unsigned xb_ld(unsigned* p)              { return __hip_atomic_load(p, __ATOMIC_RELAXED, __HIP_MEMORY_SCOPE_AGENT); }
__device__ __forceinline__ unsigned xb_add(unsigned* p, unsigned v) { return __hip_atomic_fetch_add(p, v, __ATOMIC_RELAXED, __HIP_MEMORY_SCOPE_AGENT); }
__device__ __forceinline__ unsigned xb_xcc_id() { return (unsigned)__builtin_amdgcn_s_getreg((3 << 11) | 20) & 0xFu; }
#define XB_SPIN(cond, bar) do { unsigned _sp = 0; while (cond) { __builtin_amdgcn_s_sleep(1); \
    if ((++_sp & 255u) == 0u) { if (xb_ld(&(bar)[XB_TMO])) break; if (_sp > XB_SPIN_CAP) { atomicAdd(&(bar)[XB_TMO], 1u); break; } } } } while (0)

struct XcdBarrier {
    unsigned* bar; unsigned x;
    volatile LAS unsigned* st;
};

__device__ __forceinline__ XcdBarrier xcd_barrier_post(unsigned* bar, volatile LAS unsigned* st) {
    XcdBarrier b; b.bar = bar; b.x = xb_xcc_id(); b.st = st;
    if (threadIdx.x == 0) (void)xb_add(&bar[XB_XCNT(b.x)], 1u);
    return b;
}
__device__ __forceinline__ void xcd_barrier_complete(unsigned* bar, unsigned x, unsigned& nloc, unsigned& nx) {
    const unsigned G = gridDim.x * gridDim.y * gridDim.z;
    unsigned sum, cnt, mine, sp = 0u;
    for (;;) {
        sum = 0u; cnt = 0u; mine = 0u;
#pragma unroll
        for (unsigned j = 0; j < 16; ++j) { const unsigned c = xb_ld(&bar[XB_XCNT(j)]); sum += c; cnt += (c > 0u) ? 1u : 0u; mine = (j == x) ? c : mine; }
        if (sum == G) break;
        __builtin_amdgcn_s_sleep(1);
        if ((++sp & 255u) == 0u) { if (xb_ld(&bar[XB_TMO])) break; if (sp > XB_SPIN_CAP) { atomicAdd(&bar[XB_TMO], 1u); break; } }
    }
    nloc = mine > 0u ? mine : 1u; nx = cnt > 0u ? cnt : 1u;
}

__device__ __forceinline__ void xcd_barrier(const XcdBarrier& b) {
    asm volatile("s_waitcnt vmcnt(0)" ::: "memory");
    __syncthreads();
    if (threadIdx.x == 0) {
        unsigned* bar = b.bar;
        __builtin_amdgcn_s_waitcnt(0);
        unsigned nloc = b.st[0], nx = b.st[1];
        if (nloc == 0u) { xcd_barrier_complete(bar, b.x, nloc, nx); b.st[0] = nloc; b.st[1] = nx; }
        const unsigned old = xb_add(&bar[XB_XSUB(b.x)], 1u);
        const unsigned gen = old / nloc;
        if (old + 1u == (gen + 1u) * nloc) {
            __builtin_amdgcn_fence(__ATOMIC_RELEASE, "agent");
            asm volatile("s_waitcnt vmcnt(0)" ::: "memory");
            const unsigned og = xb_add(&bar[XB_TOP], 1u);
            const unsigned tg = og / nx;
            if (og + 1u == (tg + 1u) * nx) xb_add(&bar[XB_TOPGEN], 1u);
            else XB_SPIN(xb_ld(&bar[XB_TOPGEN]) == tg, bar);
            __builtin_amdgcn_fence(__ATOMIC_ACQUIRE, "agent");
            xb_add(&bar[XB_XGEN(b.x)], 1u);
            asm volatile("s_waitcnt vmcnt(0)" ::: "memory");
        } else {
            XB_SPIN(xb_ld(&bar[XB_XGEN(b.x)]) == gen, bar);
            __builtin_amdgcn_fence(__ATOMIC_ACQUIRE, "agent");
            asm volatile("s_waitcnt vmcnt(0)" ::: "memory");
        }
    }
    __syncthreads();
}


struct OneUnit { int pm;
    __device__ __forceinline__ bool next(int i, pg8::Unit& u) const { if (i) return false; u.pm = pm; u.pn = 0; return true; }
    __device__ __forceinline__ void a_ready(const pg8::Unit&) const {}
    __device__ __forceinline__ void done(const pg8::Unit&) const {} };
__global__ void __launch_bounds__(512, 2) hybrid_fwd(Params P0) {
    extern __shared__ __attribute__((aligned(16))) unsigned char lds_raw[];
    const KParamsPtr kp0 = (KParamsPtr)__builtin_amdgcn_kernarg_segment_ptr();
    cg::grid_group grid = cg::this_grid();
    { volatile LAS unsigned* misc = (volatile LAS unsigned*)((LAS unsigned char*)lds_raw + MISC_OFF); if (threadIdx.x < 2) misc[threadIdx.x] = 0u; }
    __syncthreads();
    XcdBarrier bar = xcd_barrier_post((unsigned*)(P0.ws + WS_CTL) + 1024, (volatile LAS unsigned*)((LAS unsigned char*)lds_raw + MISC_OFF));
    const int ph_lo = P0.ph_lo, ph_hi = P0.ph_hi; const int wave_s = __builtin_amdgcn_readfirstlane(threadIdx.x >> 6);
    bool redone = false; (void)redone;
    for (int ph = ph_lo; ph < ph_hi; ++ph) {
        KParamsPtr kpl = kp0; asm volatile("" : "+s"(kpl));
        const KParamsPtr P = kpl; unsigned char* ws = P->ws;
        u16* XN = (u16*)(ws + WS_XN); u16* HB = (u16*)(ws + WS_PROJ);
        int G = gridDim.x, bx = blockIdx.x; asm volatile("" : "+s"(G), "+s"(bx));
        Ctx C; C.G = G; C.bx = bx; C.lds = (LAS unsigned char*)lds_raw; C.wave = wave_s; C.lane = lane_opaque(); C.tid = wave_s * 64 + C.lane; C.r32 = C.lane & 31; C.hi = C.lane >> 5;
        C.proj = (u16*)(ws + WS_PROJ); C.obuf = (u16*)(ws + WS_XN); C.vt = (u16*)(ws + WS_VT);
        const int layer = ph / NPH_L, s = ph % NPH_L;
        if (ph != NPH - 1 && s == 7) continue;
        u16* XB = (u16*)(ws + WS_XB);
        if (ph == NPH - 1) { norm_phase(C, nullptr, XB, P->final_norm, nullptr, P->out, nullptr); }
        else switch (s) {
        case 0: { convert_weights(C, P, layer); __syncthreads(); if (layer == 0) norm_phase(C, P->x, nullptr, P->norm_ffn1, XN, nullptr, XB); else norm_phase(C, nullptr, XB, P->norm_ffn1 + (size_t)layer * DM, XN, nullptr, nullptr); } break;
        case 3: { norm_phase(C, nullptr, XB, P->norm_mix + (size_t)layer * DM, XN, nullptr, nullptr); } break;
        case 11: { norm_phase(C, nullptr, XB, P->norm_ffn2 + (size_t)layer * DM, XN, nullptr, nullptr); } break;
#ifndef NO_GEMM
#ifndef NO_G1
        case 1: case 12: {
            pg8::Gemm g{XN, (const u16*)(ws + (s == 1 ? WS_GU1 : WS_GU2)), MTOK, 2 * DFF, DM}; pg8::StaticOrder S; S.init(MTOK, 2 * DFF, G, bx);
            pg8::EpiSwiGLU E{HB, DFF};
            pg8::gemm_phase<pg8::EpiSwiGLU, pg8::StaticOrder, true, true>(C.lds, g, S, E, C.wave); } break;
#endif
#ifndef NO_G2
        case 2: case 13: case 10: {
            const u16* A = (s == 10) ? (const u16*)XN : (const u16*)HB; const u16* Bt = (const u16*)(ws + (s == 2 ? WS_DN1 : s == 13 ? WS_DN2 : WS_WOUT));
            pg8::Gemm g{A, Bt, MTOK, DM, s == 10 ? DM : DFF}; pg8::StaticOrder S; S.init(MTOK, DM, G, bx);
            pg8::EpiResid E{XB, DM, s == 10 ? 1.0f : 0.5f};
            pg8::gemm_phase<pg8::EpiResid, pg8::StaticOrder, false, true>(C.lds, g, S, E, C.wave); } break;
#endif
#ifndef NO_G4
        case 4: {
            pg8::Gemm g{XN, (const u16*)(ws + WS_WIN), MTOK, PW, DM}; pg8::StaticOrder S; S.init(MTOK, PW, G, bx);
            pg8::EpiBf16<0> E{C.proj, PW};
            pg8::gemm_phase<pg8::EpiBf16<0>, pg8::StaticOrder, true, true>(C.lds, g, S, E, C.wave); } break;
#endif
#endif
#ifndef NO_PREP
        case 5: prep_a(C, P, layer); prep_vk(C, P, 0); break;
#endif
#if !defined(NO_GEMM) && !defined(NO_G6)
        case 6: {
            unsigned* qctr = (unsigned*)(ws + WS_CTL) + 8192 + 64 * ph + (redone ? 32 : 0); volatile LAS unsigned* qslot = (volatile LAS unsigned*)(C.lds + MISC_OFF + 16);
            for (;;) {
                if (C.tid == 0) *qslot = __hip_atomic_fetch_add(qctr, 1u, __ATOMIC_RELAXED, __HIP_MEMORY_SCOPE_AGENT);
                __syncthreads();
                const unsigned u = *qslot;
                __syncthreads();
                if (u >= 32u + 1024u) break;
                if (u < 32u) { const int i = (int)u >> 4, tile = (int)u & 15;
                    pg8::Gemm g{(const u16*)XN + (size_t)i * 4096 * 2048, (const u16*)(ws + WS_W1) + (size_t)i * 256 * 2048, 4096, 256, 2048}; OneUnit S{tile};
                    pg8::EpiBf16<1> E{(u16*)(ws + WS_HID) + (size_t)i * 4096 * 256, 256};
                    pg8::gemm_phase<pg8::EpiBf16<1>, OneUnit, true, true>(C.lds, g, S, E, C.wave);
                    __builtin_amdgcn_fence(__ATOMIC_RELEASE, "agent"); __syncthreads(); __builtin_amdgcn_fence(__ATOMIC_ACQUIRE, "agent");
                    prep_c(C, P, layer, i * 4096 + tile * 256);
                    __syncthreads();
                } else { const unsigned v = u - 32u; const int qb = 7 - (int)(v >> 7), w = (int)(v & 127);
                    if (w < 64) {
#ifndef NO_DIFF
                        diff_unit(C, P, layer, w >> 2, w & 3, qb);
#endif
                    } else {
#ifndef NO_MOBA
                        moba_unit(C, P, (w - 64) >> 2, w & 3, qb);
#endif
                    } }
            } } break;
#endif
#ifndef NO_ATT1
        case 8: {
#ifndef NO_CMP
            for (int c = bx; c < 256; c += G) cmp_unit(C, P, c >> 4, (c >> 3) & 1, c & 7);
#endif
            } break;
#endif
#ifndef NO_ATT2
        case 9: {
            unsigned* qctr = (unsigned*)(ws + WS_CTL) + 8192 + 64 * ph; volatile LAS unsigned* qslot = (volatile LAS unsigned*)(C.lds + MISC_OFF + 16);
            for (;;) {
                if (C.tid == 0) *qslot = __hip_atomic_fetch_add(qctr, 1u, __ATOMIC_RELAXED, __HIP_MEMORY_SCOPE_AGENT);
                __syncthreads();
                const unsigned u = *qslot;
                __syncthreads();
                if (u >= 1024u) break;
                nsa_unit(C, P, (int)(u & 127) >> 3, (int)u & 7, 7 - (int)(u >> 7));
            } } break;
#endif
        default: break;
        }
        if (ph + 1 < ph_hi) { if (ph == ph_lo) grid.sync(); else xcd_barrier(bar); }
#ifdef PROBE_LO
        if (ph != NPH - 1 && s == PROBE_HI) { if (!redone) { ph -= (PROBE_HI - PROBE_LO + 1); redone = true; } else redone = false; }
#endif
#ifdef PROBE_SYNC
        if (ph + 1 < ph_hi) xcd_barrier(bar);
#endif
    }
}

#ifndef COOP
#define COOP 1
#endif
extern "C" void kernel_launch(void* const* d_in, const int* in_sizes, int n_in, void* d_out, int out_size, void* d_ws, size_t ws_size, hipStream_t stream) {
    static int grid = 0;
    if (grid == 0) {
        if (n_in != 19 || out_size != MTOK * DM || ws_size < WS_END) { fprintf(stderr, "kernel_launch: unexpected shapes (n_in %d out %d ws %zu)\n", n_in, out_size, ws_size); grid = -1; return; }
        int dev = 0, cus = 0, per_cu = 0;
        (void)hipGetDevice(&dev); (void)hipDeviceGetAttribute(&cus, hipDeviceAttributeMultiprocessorCount, dev);
        if (hipFuncSetAttribute((const void*)hybrid_fwd, hipFuncAttributeMaxDynamicSharedMemorySize, LDS_BYTES) != hipSuccess) { fprintf(stderr, "kernel_launch: hipFuncSetAttribute failed\n"); grid = -1; return; }
        if (hipOccupancyMaxActiveBlocksPerMultiprocessor(&per_cu, (const void*)hybrid_fwd, 512, LDS_BYTES) != hipSuccess || per_cu < 1) { fprintf(stderr, "kernel_launch: occupancy query says %d\n", per_cu); per_cu = 1; }
        (void)hipGetLastError();
        grid = cus * per_cu;
    }
    if (grid < 0) return;
    Params p{};
    p.x = (const float*)d_in[0]; p.rel_bias = (const float*)d_in[1]; p.norm_ffn1 = (const float*)d_in[2]; p.ffn1_gate = (const float*)d_in[3]; p.ffn1_up = (const float*)d_in[4]; p.ffn1_down = (const float*)d_in[5];
    p.norm_mix = (const float*)d_in[6]; p.w_in = (const float*)d_in[7]; p.diff_lambda = (const float*)d_in[8]; p.diff_subln = (const float*)d_in[9]; p.cmp_pe = (const float*)d_in[10]; p.cmp_w1 = (const float*)d_in[11];
    p.cmp_w2 = (const float*)d_in[12]; p.w_out = (const float*)d_in[13]; p.norm_ffn2 = (const float*)d_in[14]; p.ffn2_gate = (const float*)d_in[15]; p.ffn2_up = (const float*)d_in[16]; p.ffn2_down = (const float*)d_in[17];
    p.final_norm = (const float*)d_in[18]; p.out = (float*)d_out; p.ws = (unsigned char*)d_ws;
    for (int l = 0; l < 4; ++l) p.lam_init[l] = (float)(0.8 - 0.6 * exp(-0.3 * (double)l));
#if COOP
    if (hipMemsetAsync((char*)d_ws + WS_CTL, 0, CTL_ZERO_BYTES, stream) != hipSuccess) { fprintf(stderr, "kernel_launch: memset of barrier words failed\n"); return; }
    p.ph_lo = 0; p.ph_hi = NPH;
    void* args[] = {&p};
    hipError_t e = hipLaunchCooperativeKernel((const void*)hybrid_fwd, dim3(grid), dim3(512), args, LDS_BYTES, stream);
    if (e != hipSuccess) fprintf(stderr, "cooperative launch failed: %s (grid %d)\n", hipGetErrorString(e), grid);
#else
    for (int ph = 0; ph < NPH; ++ph) { p.ph_lo = ph; p.ph_hi = ph + 1; hipLaunchKernelGGL(hybrid_fwd, dim3(grid), dim3(512), LDS_BYTES, stream, p); }
#endif
}
```

```cpp
#include <hip/hip_runtime.h>
#include <hip/hip_cooperative_groups.h>
#include <cstdio>
#include <cstdint>
#include <cmath>
namespace cg = cooperative_groups;
#define COOP 1
namespace pg8 {
#define PG8_LAS __attribute__((address_space(3)))
typedef unsigned short bf16_t;
typedef short bf16x8 __attribute__((ext_vector_type(8)));
typedef float f32x4 __attribute__((ext_vector_type(4)));
typedef unsigned u32x4 __attribute__((ext_vector_type(4)));
constexpr int BM = 256, BK = 64, HALF = 128, HTB = HALF * BK * 2  , STAGE_BYTES = 8 * HTB, NXCD = 8, WGM = 8;

__host__ __device__ __forceinline__ int lds_byte(int r, int c) { const int st = (r >> 4) * 2 + (c >> 5), rr = r & 15, cc = c & 31, ob = rr * 64 + cc * 2; return st * 1024 + (ob ^ (((ob >> 9) & 1) << 5)); }
__host__ __device__ __forceinline__ void stage_rc(int b, int& R, int& C) { const int st = b / 1024, sb = b % 1024, swz = sb ^ (((sb >> 9) & 1) << 5); R = (st >> 1) * 16 + swz / 64; C = (st & 1) * 32 + (swz % 64) / 2; }
__host__ __device__ __forceinline__ int perm32(int rho) { const int n = rho >> 4, i = rho & 15; return 8 * (i >> 2) + 4 * n + (i & 3); }

struct Unit { int pm, pn; };
struct Gemm { const bf16_t* A; const bf16_t* Bt; int M, N, K; };

struct StaticOrder {
    int nM, nN, nwg, G, c;
    __host__ __device__ void init(int M, int N, int G_, int c_) { nM = M / BM; nN = N / BM; nwg = nM * nN; G = G_; c = c_; }
    __host__ __device__ bool next(int i, Unit& u) const {
        const long L = (long)i * G + c; if (L >= nwg) return false;
        int wgid = (int)L; { const int q = nwg / NXCD, r = nwg % NXCD, xcd = wgid % NXCD, off = wgid / NXCD; wgid = (xcd < r ? xcd * (q + 1) : r * (q + 1) + (xcd - r) * q) + off; }
        const int nig = WGM * nN, gid = wgid / nig, fm = gid * WGM, gsz = (nM - fm) < WGM ? (nM - fm) : WGM;
        u.pm = fm + ((wgid % nig) % gsz); u.pn = (wgid % nig) / gsz; return true;
    }
    __device__ __forceinline__ void a_ready(const Unit&) const {}
    __device__ __forceinline__ void done(const Unit&) const {}
};

__device__ __forceinline__ unsigned cvt_pk_bf16(float lo, float hi) { unsigned r; asm volatile("v_cvt_pk_bf16_f32 %0, %1, %2" : "=v"(r) : "v"(lo), "v"(hi)); return r; }

__device__ __forceinline__ float ex2(float x) { return __builtin_amdgcn_exp2f(x); }
__device__ __forceinline__ float rcpf_(float x) { return __builtin_amdgcn_rcpf(x); }
__device__ __forceinline__ float silu_f(float x) { return x * rcpf_(1.0f + ex2(-1.4426950408889634f * x)); }
__device__ __forceinline__ float gelu_tanh_f(float x) { const float y2 = 2.0f * 0.7978845608028654f * (x + 0.044715f * x * x * x); return x * (1.0f - rcpf_(1.0f + ex2(1.4426950408889634f * y2))); }

__device__ __forceinline__ float row_rstd(const float* ss, int row) {
    const f32x4* p = (const f32x4*)(ss + (size_t)row * 16); const f32x4 a = p[0], b = p[1], c = p[2], d = p[3];
    const float s = ((a[0] + a[1]) + (a[2] + a[3])) + ((b[0] + b[1]) + (b[2] + b[3])) + ((c[0] + c[1]) + (c[2] + c[3])) + ((d[0] + d[1]) + (d[2] + d[3]));
    return 1.0f / sqrtf(s * (1.0f / 1024.0f) + 1e-6f);
}

struct EpiSwiGLU {
    static constexpr bool PERM = true, AFTER_DRAIN = false;
    bf16_t* O; int ldc; const PG8_LAS float* rtab; mutable int ui;
    __device__ __forceinline__ void operator()(const f32x4 (&acc)[2][2][4][2], const Unit& u, int wr, int wc, int fr, int fq) const {
        const int row0 = u.pm * BM + wr * 64 + fr; const int col0 = u.pn * HALF + wc * 32 + 8 * fq;
#pragma unroll
        for (int ai = 0; ai < 2; ++ai)
#pragma unroll
            for (int m = 0; m < 4; ++m) { bf16_t* rowp = O + (size_t)(row0 + ai * HALF + m * 16) * ldc + col0;
                const float rs = rtab[ui * 256 + wr * 64 + fr + ai * HALF + m * 16];
                const f32x4 g0 = acc[ai][0][m][0] * rs, g1 = acc[ai][0][m][1] * rs, u0 = acc[ai][1][m][0] * rs, u1 = acc[ai][1][m][1] * rs;
                u32x4 w; w.x = cvt_pk_bf16(silu_f(g0[0]) * u0[0], silu_f(g0[1]) * u0[1]); w.y = cvt_pk_bf16(silu_f(g0[2]) * u0[2], silu_f(g0[3]) * u0[3]);
                w.z = cvt_pk_bf16(silu_f(g1[0]) * u1[0], silu_f(g1[1]) * u1[1]); w.w = cvt_pk_bf16(silu_f(g1[2]) * u1[2], silu_f(g1[3]) * u1[3]);
                *(u32x4*)rowp = w; asm volatile("" ::: "memory"); }
        ++ui;
    }
};
template <int ACT> struct EpiBf16 {
    static constexpr bool PERM = true, AFTER_DRAIN = false;
    bf16_t* O; int ldc; const PG8_LAS float* rtab; mutable int ui;
    __device__ __forceinline__ void operator()(const f32x4 (&acc)[2][2][4][2], const Unit& u, int wr, int wc, int fr, int fq) const {
        const int row0 = u.pm * BM + wr * 64 + fr; const int col0 = u.pn * BM + wc * 32 + 8 * fq;
#pragma unroll
        for (int ai = 0; ai < 2; ++ai)
#pragma unroll
            for (int m = 0; m < 4; ++m) { bf16_t* rowp = O + (size_t)(row0 + ai * HALF + m * 16) * ldc + col0;
                const float rs = rtab ? rtab[ui * 256 + wr * 64 + fr + ai * HALF + m * 16] : 1.0f;
#pragma unroll
                for (int bj = 0; bj < 2; ++bj) { f32x4 v0 = acc[ai][bj][m][0] * rs, v1 = acc[ai][bj][m][1] * rs;
                    if (ACT == 1) { v0 = (f32x4){gelu_tanh_f(v0[0]), gelu_tanh_f(v0[1]), gelu_tanh_f(v0[2]), gelu_tanh_f(v0[3])}; v1 = (f32x4){gelu_tanh_f(v1[0]), gelu_tanh_f(v1[1]), gelu_tanh_f(v1[2]), gelu_tanh_f(v1[3])}; }
                    u32x4 w; w.x = cvt_pk_bf16(v0[0], v0[1]); w.y = cvt_pk_bf16(v0[2], v0[3]); w.z = cvt_pk_bf16(v1[0], v1[1]); w.w = cvt_pk_bf16(v1[2], v1[3]);
                    *(u32x4*)(rowp + bj * HALF) = w; } asm volatile("" ::: "memory"); }
        ++ui;
    }
};
struct EpiResid {
    static constexpr bool PERM = true, AFTER_DRAIN = false;
    bf16_t* xb; int ldc; float alpha; float* ss;
    __device__ __forceinline__ void operator()(const f32x4 (&acc)[2][2][4][2], const Unit& u, int wr, int wc, int fr, int fq) const {
        const int row0 = u.pm * BM + wr * 64 + fr; const int col0 = u.pn * BM + wc * 32 + 8 * fq; const int lane = fq * 16 + fr;
#pragma unroll
        for (int ai = 0; ai < 2; ++ai) {
            u32x4 pre[4][2];
#pragma unroll
            for (int m = 0; m < 4; ++m)
#pragma unroll
                for (int bj = 0; bj < 2; ++bj) pre[m][bj] = *(const u32x4*)(xb + (size_t)(row0 + ai * HALF + m * 16) * ldc + col0 + bj * HALF);
#pragma unroll
            for (int m = 0; m < 4; ++m) { const int row = row0 + ai * HALF + m * 16; bf16_t* rowp = xb + (size_t)row * ldc + col0; float sq = 0.f;
#pragma unroll
                for (int bj = 0; bj < 2; ++bj) { const u32x4 p = pre[m][bj]; const f32x4 a0 = acc[ai][bj][m][0] * alpha, a1 = acc[ai][bj][m][1] * alpha;
                    const float x0 = __uint_as_float(p.x << 16) + a0[0], x1 = __uint_as_float(p.x & 0xffff0000u) + a0[1], x2 = __uint_as_float(p.y << 16) + a0[2], x3 = __uint_as_float(p.y & 0xffff0000u) + a0[3];
                    const float x4 = __uint_as_float(p.z << 16) + a1[0], x5 = __uint_as_float(p.z & 0xffff0000u) + a1[1], x6 = __uint_as_float(p.w << 16) + a1[2], x7 = __uint_as_float(p.w & 0xffff0000u) + a1[3];
                    sq += ((x0 * x0 + x1 * x1) + (x2 * x2 + x3 * x3)) + ((x4 * x4 + x5 * x5) + (x6 * x6 + x7 * x7));
                    u32x4 w; w.x = cvt_pk_bf16(x0, x1); w.y = cvt_pk_bf16(x2, x3); w.z = cvt_pk_bf16(x4, x5); w.w = cvt_pk_bf16(x6, x7);
                    *(u32x4*)(rowp + bj * HALF) = w; }
                sq += __int_as_float(__builtin_amdgcn_ds_bpermute((lane ^ 16) << 2, __float_as_int(sq)));
                sq += __int_as_float(__builtin_amdgcn_ds_bpermute((lane ^ 32) << 2, __float_as_int(sq)));
                if (fq == 0) ss[(size_t)row * 16 + u.pn * 4 + wc] = sq; }
            asm volatile("" ::: "memory");
        }
    }
};
template <class Epi, class Sched, bool ALIGN_EPI = false, bool SP2 = false>
__device__ __forceinline__ void gemm_phase(PG8_LAS unsigned char* lds, const Gemm g, const Sched& S, const Epi& E, const int wave_in) {
    int tid_l; asm volatile("v_mbcnt_lo_u32_b32 %0, -1, 0\n\tv_mbcnt_hi_u32_b32 %0, -1, %0" : "=v"(tid_l)); tid_l += wave_in * 64;
    const int tid = tid_l, wid = __builtin_amdgcn_readfirstlane(tid >> 6), lane = tid & 63, wr = wid >> 2, wc = wid & 3, fr = lane & 15, fq = lane >> 4;
    const int K = g.K, nt = K / BK;
    unsigned voffA[2], voffB[2];
#pragma unroll
    for (int i = 0; i < 2; ++i) { int R, C; stage_rc(tid * 16 + i * 8192, R, C); const int Rb = Epi::PERM ? ((R & ~31) + perm32(R & 31)) : R;
        voffA[i] = (unsigned)(R * K + C) * 2u; voffB[i] = (unsigned)(Rb * K + C) * 2u; }
    const size_t kstep = (size_t)(BK * 2);
    const size_t hstep = (size_t)HALF * K * 2;
    const size_t tstep = 2 * hstep;
    const unsigned ldsw = (unsigned)wid * 1024u;
    const int aoff = lds_byte(wr * 64 + fr, fq * 8), boff = lds_byte(wc * 32 + fr, fq * 8);
#define PG8_SA(b, h) (((b) * 2 + (h)) * HTB)
#define PG8_SB(b, h) ((4 + (b) * 2 + (h)) * HTB)
#define PG8_STAGE(bufoff, gbase, voff) do { _Pragma("unroll") for (int _i = 0; _i < 2; ++_i) \
        __builtin_amdgcn_global_load_lds((const unsigned*)((const char*)(gbase) + (voff)[_i]), (PG8_LAS unsigned*)(lds + (bufoff) + ldsw + _i * 8192), 16, 0, 0); } while (0)
#define PG8_LDA(dst, b, h) do { _Pragma("unroll") for (int m = 0; m < 4; ++m) _Pragma("unroll") for (int k = 0; k < 2; ++k) dst[m][k] = *(const PG8_LAS bf16x8*)(lds + PG8_SA(b, h) + aoff + m * 2048 + k * 1024); } while (0)
#define PG8_LDB(dst, b, h) do { _Pragma("unroll") for (int n = 0; n < 2; ++n) _Pragma("unroll") for (int k = 0; k < 2; ++k) dst[n][k] = *(const PG8_LAS bf16x8*)(lds + PG8_SB(b, h) + boff + n * 2048 + k * 1024); } while (0)
#define PG8_MMA(ai, bj, At, Bt) do { __builtin_amdgcn_s_setprio(1); _Pragma("unroll") for (int m = 0; m < 4; ++m) _Pragma("unroll") for (int n = 0; n < 2; ++n) _Pragma("unroll") for (int k = 0; k < 2; ++k) \
        acc[ai][bj][m][n] = __builtin_amdgcn_mfma_f32_16x16x32_bf16(Bt[n][k], At[m][k], acc[ai][bj][m][n], 0, 0, 0); __builtin_amdgcn_s_setprio(0); } while (0)
#define PG8_WAIT_V(n) asm volatile("s_waitcnt vmcnt(" #n ")" ::: "memory")
#define PG8_WAIT_L(n) asm volatile("s_waitcnt lgkmcnt(" #n ")" ::: "memory")
#define PG8_BAR __builtin_amdgcn_s_barrier()
#define PG8_SCHED __builtin_amdgcn_sched_barrier(0)
    Unit cur, nxt; int ui = 0;
    if (!S.next(0, cur)) return;
    f32x4 acc[2][2][4][2];
#pragma unroll
    for (int a = 0; a < 2; ++a)
#pragma unroll
        for (int b = 0; b < 2; ++b)
#pragma unroll
            for (int m = 0; m < 4; ++m)
#pragma unroll
                for (int n = 0; n < 2; ++n) acc[a][b][m][n] = (f32x4){0.f, 0.f, 0.f, 0.f};
    bf16x8 At[4][2], B0[2][2], B1[2][2];
    const char* cA = (const char*)g.A + (size_t)cur.pm * tstep; const char* cB = (const char*)g.Bt + (size_t)cur.pn * tstep;
    S.a_ready(cur);
    if constexpr (SP2) {
        PG8_STAGE(PG8_SB(0, 0), cB, voffB); PG8_STAGE(PG8_SB(0, 1), cB + hstep, voffB); PG8_STAGE(PG8_SA(0, 0), cA, voffA); PG8_STAGE(PG8_SA(0, 1), cA + hstep, voffA);
        if (wr == 1) PG8_BAR;
        PG8_WAIT_V(2); PG8_BAR;
        PG8_STAGE(PG8_SB(1, 0), cB + kstep, voffB); PG8_STAGE(PG8_SA(1, 0), cA + kstep, voffA); PG8_STAGE(PG8_SB(1, 1), cB + hstep + kstep, voffB);
        PG8_WAIT_V(6); PG8_BAR;
    } else {
        PG8_STAGE(PG8_SB(0, 0), cB, voffB); PG8_STAGE(PG8_SA(0, 0), cA, voffA); PG8_STAGE(PG8_SB(0, 1), cB + hstep, voffB); PG8_STAGE(PG8_SA(0, 1), cA + hstep, voffA);
        if (wr == 1) PG8_BAR;
        PG8_WAIT_V(4); PG8_BAR;
        PG8_STAGE(PG8_SB(1, 0), cB + kstep, voffB); PG8_STAGE(PG8_SA(1, 0), cA + kstep, voffA); PG8_STAGE(PG8_SB(1, 1), cB + hstep + kstep, voffB);
        PG8_WAIT_V(6); PG8_BAR;
    }
    for (;;) {
        const bool has_next = S.next(ui + 1, nxt);
        const char* nA = has_next ? (const char*)g.A + (size_t)nxt.pm * tstep : cA; const char* nB = has_next ? (const char*)g.Bt + (size_t)nxt.pn * tstep : cB;
        for (int t = 0; t < nt; t += 2) {
            const bool last = (t == nt - 2);
            const char* a1 = cA + (size_t)(t + 1) * kstep;
            const char* a2 = last ? nA : cA + (size_t)(t + 2) * kstep; const char* b2 = last ? nB : cB + (size_t)(t + 2) * kstep;
            const char* a3 = a2 + kstep; const char* b3 = b2 + kstep;
            if (last && has_next) S.a_ready(nxt);
            if constexpr (SP2) {
            PG8_LDB(B0, 0, 0); PG8_LDB(B1, 0, 1); PG8_SCHED; PG8_LDA(At, 0, 0); PG8_STAGE(PG8_SA(1, 1), a1 + hstep, voffA);
            PG8_WAIT_V(8); PG8_WAIT_L(0); PG8_BAR; PG8_MMA(0, 0, At, B0); PG8_MMA(0, 1, At, B1); PG8_BAR; PG8_SCHED;
            PG8_LDA(At, 0, 1); PG8_STAGE(PG8_SB(0, 0), b2, voffB); PG8_STAGE(PG8_SB(0, 1), b2 + hstep, voffB); PG8_STAGE(PG8_SA(0, 0), a2, voffA);
            PG8_WAIT_V(8); PG8_WAIT_L(0); PG8_BAR; PG8_MMA(1, 0, At, B0); PG8_MMA(1, 1, At, B1); PG8_BAR; PG8_SCHED;
            PG8_LDB(B0, 1, 0); PG8_LDB(B1, 1, 1); PG8_SCHED; PG8_LDA(At, 1, 0); PG8_STAGE(PG8_SA(0, 1), a2 + hstep, voffA);
            PG8_WAIT_V(8); PG8_WAIT_L(0); PG8_BAR; PG8_MMA(0, 0, At, B0); PG8_MMA(0, 1, At, B1); PG8_BAR; PG8_SCHED;
            PG8_LDA(At, 1, 1); PG8_STAGE(PG8_SB(1, 0), b3, voffB); PG8_STAGE(PG8_SB(1, 1), b3 + hstep, voffB); PG8_STAGE(PG8_SA(1, 0), a3, voffA);
            PG8_WAIT_V(8); PG8_WAIT_L(0); PG8_BAR; PG8_MMA(1, 0, At, B0); PG8_MMA(1, 1, At, B1); PG8_BAR; PG8_SCHED;
            } else {
            PG8_LDB(B0, 0, 0); PG8_SCHED; PG8_LDA(At, 0, 0); PG8_STAGE(PG8_SA(1, 1), a1 + hstep, voffA);
            PG8_WAIT_L(8); PG8_BAR; PG8_WAIT_L(0); PG8_MMA(0, 0, At, B0); PG8_BAR; PG8_SCHED;
            PG8_LDB(B1, 0, 1); PG8_STAGE(PG8_SB(0, 0), b2, voffB);
            PG8_BAR; PG8_WAIT_L(0); PG8_MMA(0, 1, At, B1); PG8_BAR;
            PG8_LDA(At, 0, 1); PG8_STAGE(PG8_SA(0, 0), a2, voffA);
            PG8_BAR; PG8_WAIT_L(0); PG8_MMA(1, 0, At, B0); PG8_BAR; PG8_SCHED;
            PG8_STAGE(PG8_SB(0, 1), b2 + hstep, voffB);
            PG8_WAIT_V(6); PG8_BAR; PG8_MMA(1, 1, At, B1); PG8_BAR;
            PG8_LDB(B0, 1, 0); PG8_SCHED; PG8_LDA(At, 1, 0); PG8_STAGE(PG8_SA(0, 1), a2 + hstep, voffA);
            PG8_WAIT_L(8); PG8_BAR; PG8_WAIT_L(0); PG8_MMA(0, 0, At, B0); PG8_BAR; PG8_SCHED;
            PG8_LDB(B1, 1, 1); PG8_STAGE(PG8_SB(1, 0), b3, voffB);
            PG8_BAR; PG8_WAIT_L(0); PG8_MMA(0, 1, At, B1); PG8_BAR;
            PG8_LDA(At, 1, 1); PG8_STAGE(PG8_SA(1, 0), a3, voffA);
            PG8_BAR; PG8_WAIT_L(0); PG8_MMA(1, 0, At, B0); PG8_BAR; PG8_SCHED;
            PG8_STAGE(PG8_SB(1, 1), b3 + hstep, voffB);
            PG8_WAIT_V(6); PG8_BAR; PG8_MMA(1, 1, At, B1); PG8_BAR;
            }
        }
        if constexpr (ALIGN_EPI) { if (wr == 0) PG8_BAR; }
        if constexpr (!Epi::AFTER_DRAIN) { E(acc, cur, wr, wc, fr, fq); S.done(cur); }
        if (!has_next) break;
#pragma unroll
        for (int a = 0; a < 2; ++a)
#pragma unroll
            for (int b = 0; b < 2; ++b)
#pragma unroll
                for (int m = 0; m < 4; ++m)
#pragma unroll
                    for (int n = 0; n < 2; ++n) acc[a][b][m][n] = (f32x4){0.f, 0.f, 0.f, 0.f};
        cur = nxt; cA = nA; cB = nB; ++ui;
        if constexpr (ALIGN_EPI) { if (wr == 1) PG8_BAR; }
    }
    PG8_WAIT_V(0);
    if constexpr (!ALIGN_EPI) { if (wr == 0) PG8_BAR; }
    PG8_BAR;
    if constexpr (Epi::AFTER_DRAIN) { E.fused(acc, cur, wr, wc, fr, fq, lds, wid, lane); S.done(cur); }
#undef PG8_SA
#undef PG8_SB
#undef PG8_STAGE
#undef PG8_LDA
#undef PG8_LDB
#undef PG8_MMA
#undef PG8_WAIT_V
#undef PG8_WAIT_L
#undef PG8_BAR
#undef PG8_SCHED
}
}

#define LAS __attribute__((address_space(3)))
using pg8::ex2; using pg8::rcpf_;
typedef unsigned short u16;
typedef short bf16x8 __attribute__((ext_vector_type(8)));
typedef float f32x4 __attribute__((ext_vector_type(4)));
typedef float f32x16 __attribute__((ext_vector_type(16)));
typedef unsigned u32x4 __attribute__((ext_vector_type(4)));
typedef unsigned u32x2 __attribute__((ext_vector_type(2)));

constexpr int DM = 1024, NB = 16, SEQ = 2048, MTOK = NB * SEQ, DEPTH = 4, DFF = 2816, INW = 2840, PW = 3072;
constexpr int C_MQ = 0, C_MK = 256, C_MV = 512, C_DQ = 768, C_DK = 1024, C_DV = 1280, C_NQ = 1536, C_NKC = 2048, C_NVC = 2176, C_NKS = 2304, C_NVS = 2432, C_NKW = 2560, C_NVW = 2688, C_NG = 2816;
constexpr int NVH = 12;
constexpr float LOG2E = 1.4426950408889634f, NEGF = -1e30f;
constexpr int NPH_L = 14, NPH = NPH_L * DEPTH + 1;
constexpr size_t MiB = 1u << 20;
constexpr size_t WS_GU1 = 1 * MiB, WS_DN1 = 12 * MiB, WS_GU2 = WS_DN1 + 5 * MiB + MiB / 2, WS_DN2 = WS_GU2 + 11 * MiB, WS_WIN = 34 * MiB, WS_WOUT = 40 * MiB, WS_W1 = 42 * MiB;
constexpr size_t WS_PROJ = 44 * MiB, WS_XN = 236 * MiB, WS_VT = 300 * MiB, WS_HID = 348 * MiB, WS_KCMP = 352 * MiB, WS_VCMPT = WS_KCMP + MiB / 2, WS_KMEAN = 353 * MiB, WS_SEL = WS_KMEAN + MiB / 4, WS_XB = 354 * MiB, WS_SS = 418 * MiB, WS_END = 420 * MiB;
static_assert(WS_DN2 + 5 * MiB + MiB / 2 == WS_WIN, "ws map");
constexpr int LDS_BYTES = 147456, MISC_OFF = 147456 - 64, RTAB_OFF = 131072;
constexpr size_t WS_CTL = 0, CTL_ZERO_BYTES = 65536;
constexpr int ATT_K = 0, ATT_V = 32768, ATT_LUT = 65536, ATT_PARK = 68608;
constexpr int CMP_K = 0, CMP_V = 18432, CMP_A = 36864, CMP_H = CMP_A + 256 * 33 * 4;

struct Params {
    const float* x; const float* rel_bias; const float* norm_ffn1; const float* ffn1_gate; const float* ffn1_up; const float* ffn1_down;
    const float* norm_mix; const float* w_in; const float* diff_lambda; const float* diff_subln; const float* cmp_pe; const float* cmp_w1; const float* cmp_w2;
    const float* w_out; const float* norm_ffn2; const float* ffn2_gate; const float* ffn2_up; const float* ffn2_down; const float* final_norm;
    float* out; unsigned char* ws;
    float lam_init[4];
    int ph_lo, ph_hi;
};
typedef const __attribute__((address_space(4))) Params* KParamsPtr;

__device__ __forceinline__ float bf2f(unsigned v) { return __uint_as_float(v << 16); }
typedef float f32x2_t __attribute__((ext_vector_type(2))); typedef __bf16 bf16x2_t __attribute__((ext_vector_type(2)));
__device__ __forceinline__ unsigned pkbf(float lo, float hi) { f32x2_t v = {lo, hi}; bf16x2_t b = __builtin_convertvector(v, bf16x2_t); return __builtin_bit_cast(unsigned, b); }
__device__ __forceinline__ int lane_opaque() { int l; asm volatile("v_mbcnt_lo_u32_b32 %0, -1, 0\n\tv_mbcnt_hi_u32_b32 %0, -1, %0" : "=v"(l)); return l; }
__device__ __forceinline__ float wave_sum(float v, int lane) {
#pragma unroll
    for (int o = 1; o < 64; o <<= 1) v += __int_as_float(__builtin_amdgcn_ds_bpermute((lane ^ o) << 2, __float_as_int(v)));
    return v;
}
__device__ __forceinline__ float xhalf_max(float v) { auto rr = __builtin_amdgcn_permlane32_swap(__float_as_uint(v), __float_as_uint(v), false, false); return fmaxf(__uint_as_float(rr[0]), __uint_as_float(rr[1])); }
__device__ __forceinline__ float xhalf_sum(float v) { auto rr = __builtin_amdgcn_permlane32_swap(__float_as_uint(v), __float_as_uint(v), false, false); return __uint_as_float(rr[0]) + __uint_as_float(rr[1]); }
__device__ __forceinline__ float sigmoid_f(float x) { return rcpf_(1.0f + ex2(-LOG2E * x)); }
__device__ __forceinline__ int crow(int r, int hi) { return (r & 3) + 8 * (r >> 2) + 4 * hi; }
__device__ __forceinline__ int kperm(int p) { const int h = p >> 3, j = p & 7; return 8 * (j >> 2) + 4 * h + (j & 3); }
__device__ __forceinline__ int pperm(int k) { return ((k >> 2) & 1) * 8 + (k >> 3) * 4 + (k & 3); }

__device__ __forceinline__ void tr_item(const float* W, int K, int N, u16* WT, int kb, int n0, int dst_row0, LAS float* scr, int lane, float cs = 1.0f, const float* gk = nullptr) {
    const int k0 = 64 * kb; const int n = n0 + (lane & 31); const bool ok = n < N;
    float wv[32];
#pragma unroll
    for (int i = 0; i < 32; ++i) { const int kk = 2 * i + (lane >> 5); wv[i] = ok ? W[(size_t)(k0 + kk) * N + n] : 0.f; }
#pragma unroll
    for (int i = 0; i < 32; ++i) { const int kk = 2 * i + (lane >> 5); scr[kk * 33 + (lane & 31)] = wv[i] * (gk ? gk[k0 + kk] * cs : cs); }
    asm volatile("s_waitcnt lgkmcnt(0)" ::: "memory");
    const int c = lane & 7;
#pragma unroll
    for (int j = 0; j < 4; ++j) { const int nn = (lane >> 3) + 8 * j; const LAS float* s = scr + (8 * c) * 33 + nn;
        u32x4 o; o.x = pkbf(s[0 * 33], s[1 * 33]); o.y = pkbf(s[2 * 33], s[3 * 33]); o.z = pkbf(s[4 * 33], s[5 * 33]); o.w = pkbf(s[6 * 33], s[7 * 33]);
        *(u32x4*)(WT + (size_t)(dst_row0 + nn) * K + k0 + 8 * c) = o; }
    asm volatile("s_waitcnt lgkmcnt(0)" ::: "memory");
}

__device__ __forceinline__ void norm_row(const float* xrow, const u16* xrow16, const float* g, u16* dst16, float* dst32, u16* xb0, int lane) {
    float v[16];
    if (xrow) { const f32x4* xr = (const f32x4*)xrow + 4 * lane;
#pragma unroll
        for (int j = 0; j < 4; ++j) { const f32x4 t = xr[j]; v[4 * j] = t.x; v[4 * j + 1] = t.y; v[4 * j + 2] = t.z; v[4 * j + 3] = t.w; }
        if (xb0) { u32x4 o0, o1; o0.x = pkbf(v[0], v[1]); o0.y = pkbf(v[2], v[3]); o0.z = pkbf(v[4], v[5]); o0.w = pkbf(v[6], v[7]); o1.x = pkbf(v[8], v[9]); o1.y = pkbf(v[10], v[11]); o1.z = pkbf(v[12], v[13]); o1.w = pkbf(v[14], v[15]);
            ((u32x4*)xb0)[2 * lane] = o0; ((u32x4*)xb0)[2 * lane + 1] = o1; }
    } else { const u32x4 p0 = ((const u32x4*)xrow16)[2 * lane], p1 = ((const u32x4*)xrow16)[2 * lane + 1];
        v[0] = bf2f(p0.x & 0xffffu); v[1] = bf2f(p0.x >> 16); v[2] = bf2f(p0.y & 0xffffu); v[3] = bf2f(p0.y >> 16); v[4] = bf2f(p0.z & 0xffffu); v[5] = bf2f(p0.z >> 16); v[6] = bf2f(p0.w & 0xffffu); v[7] = bf2f(p0.w >> 16);
        v[8] = bf2f(p1.x & 0xffffu); v[9] = bf2f(p1.x >> 16); v[10] = bf2f(p1.y & 0xffffu); v[11] = bf2f(p1.y >> 16); v[12] = bf2f(p1.z & 0xffffu); v[13] = bf2f(p1.z >> 16); v[14] = bf2f(p1.w & 0xffffu); v[15] = bf2f(p1.w >> 16); }
    float s = 0.f;
#pragma unroll
    for (int j = 0; j < 16; ++j) s = fmaf(v[j], v[j], s);
    const float rstd = 1.0f / sqrtf(wave_sum(s, lane) * (1.0f / 1024.0f) + 1e-6f);
    const f32x4* gr = (const f32x4*)g + 4 * lane;
#pragma unroll
    for (int j = 0; j < 4; ++j) { const f32x4 gg = gr[j]; v[4 * j] *= rstd * gg.x; v[4 * j + 1] *= rstd * gg.y; v[4 * j + 2] *= rstd * gg.z; v[4 * j + 3] *= rstd * gg.w; }
    if (dst16) { u32x4 o0, o1; o0.x = pkbf(v[0], v[1]); o0.y = pkbf(v[2], v[3]); o0.z = pkbf(v[4], v[5]); o0.w = pkbf(v[6], v[7]); o1.x = pkbf(v[8], v[9]); o1.y = pkbf(v[10], v[11]); o1.z = pkbf(v[12], v[13]); o1.w = pkbf(v[14], v[15]);
        ((u32x4*)dst16)[2 * lane] = o0; ((u32x4*)dst16)[2 * lane + 1] = o1; }
    else {
#pragma unroll
        for (int j = 0; j < 4; ++j) ((f32x4*)dst32)[4 * lane + j] = (f32x4){v[4 * j], v[4 * j + 1], v[4 * j + 2], v[4 * j + 3]}; }
}

struct AState { f32x16 o0, o1; float m, l; };
__device__ __forceinline__ void astate_init(AState& s) {
#pragma unroll
    for (int r = 0; r < 16; ++r) { s.o0[r] = 0.f; s.o1[r] = 0.f; }
    s.m = 0.f; s.l = 0.f;
}
constexpr float ATT_THR = 8.0f;
constexpr int ATT_SLOT = 9216, ATT_NSLOT = 3;
template <int KS0, int NKS>
__device__ __forceinline__ void qk_block(const LAS unsigned char* Ks, const bf16x8 (&qr)[4], int r32, int hi, f32x16& s0, f32x16& s1) {
    f32x16 ci;
#pragma unroll
    for (int r = 0; r < 16; ++r) ci[r] = 0.f;
    const LAS unsigned char* kp = Ks + hi * 1024 + r32 * 16;
#pragma unroll
    for (int ks = 0; ks < NKS; ++ks) {
        const bf16x8 a0 = *(const LAS bf16x8*)(kp + (KS0 + ks) * 2048);
        const bf16x8 a1 = *(const LAS bf16x8*)(kp + (KS0 + ks) * 2048 + 512);
        s0 = __builtin_amdgcn_mfma_f32_32x32x16_bf16(a0, qr[KS0 + ks], ks == 0 ? ci : s0, 0, 0, 0);
        s1 = __builtin_amdgcn_mfma_f32_32x32x16_bf16(a1, qr[KS0 + ks], ks == 0 ? ci : s1, 0, 0, 0);
    }
    __builtin_amdgcn_sched_group_barrier(0x100, 2 * NKS, 0); __builtin_amdgcn_sched_group_barrier(0x008, 2 * NKS, 0);
}
__device__ __forceinline__ void pv_block(const LAS unsigned char* Vs, const u32x4 (&pk)[4], int r32, int hi, AState& st) {
    const LAS unsigned char* vp = Vs + hi * 1024 + r32 * 16;
#pragma unroll
    for (int c = 0; c < 4; ++c) {
        const bf16x8 v0 = *(const LAS bf16x8*)(vp + c * 2048);
        const bf16x8 v1 = *(const LAS bf16x8*)(vp + c * 2048 + 512);
        const bf16x8 pb = __builtin_bit_cast(bf16x8, pk[c]);
        st.o0 = __builtin_amdgcn_mfma_f32_32x32x16_bf16(v0, pb, st.o0, 0, 0, 0);
        st.o1 = __builtin_amdgcn_mfma_f32_32x32x16_bf16(v1, pb, st.o1, 0, 0, 0);
    }
    __builtin_amdgcn_sched_group_barrier(0x100, 8, 0); __builtin_amdgcn_sched_group_barrier(0x008, 8, 0);
}
__device__ __forceinline__ void glds16(const void* gsrc, unsigned lds_dst) { unsigned keep;
    asm volatile("s_mov_b32 %0, m0\n\ts_mov_b32 m0, %2\n\ts_nop 0\n\tglobal_load_lds_dwordx4 %1, off\n\ts_mov_b32 m0, %0" : "=&s"(keep) : "v"(gsrc), "s"(lds_dst) : "memory"); }
__device__ __forceinline__ void lut_add(f32x16& s0, f32x16& s1, const LAS float* lutz, int dbase, float cc) {
    const LAS float* lp = lutz + (dbase - 59);
#pragma unroll
    for (int r = 0; r < 16; ++r) { const int ko = (r & 3) + 8 * (r >> 2);
        s0[r] += lp[59 - ko] + cc; s1[r] += lp[27 - ko] + cc; }
}
__device__ __forceinline__ void const_add(f32x16& s0, f32x16& s1, float cc) {
#pragma unroll
    for (int r = 0; r < 16; ++r) { s0[r] += cc; s1[r] += cc; }
}
__device__ __forceinline__ float row_max(const f32x16& s0, const f32x16& s1) {
    float mx = fmaxf(s0[0], s1[0]);
#pragma unroll
    for (int r = 1; r < 16; ++r) mx = fmaxf(mx, fmaxf(s0[r], s1[r]));
    return xhalf_max(mx);
}
__device__ __forceinline__ void rescale(AState& st, f32x16& s0, f32x16& s1, float mx) {
    const float dl = fmaxf(mx, 0.f); const float f = ex2(-dl); st.m += dl; st.l *= f;
#pragma unroll
    for (int r = 0; r < 16; ++r) { st.o0[r] *= f; st.o1[r] *= f; s0[r] -= dl; s1[r] -= dl; }
}
__device__ __forceinline__ void exp_pack(f32x16& s0, f32x16& s1, u32x4 (&pk)[4], AState& st) {
    float sum = 0.f;
#pragma unroll
    for (int r = 0; r < 16; ++r) { s0[r] = ex2(s0[r]); s1[r] = ex2(s1[r]); sum += s0[r] + s1[r]; }
    st.l += sum;
    pk[0] = (u32x4){pkbf(s0[0], s0[1]), pkbf(s0[2], s0[3]), pkbf(s0[4], s0[5]), pkbf(s0[6], s0[7])};
    pk[1] = (u32x4){pkbf(s0[8], s0[9]), pkbf(s0[10], s0[11]), pkbf(s0[12], s0[13]), pkbf(s0[14], s0[15])};
    pk[2] = (u32x4){pkbf(s1[0], s1[1]), pkbf(s1[2], s1[3]), pkbf(s1[4], s1[5]), pkbf(s1[6], s1[7])};
    pk[3] = (u32x4){pkbf(s1[8], s1[9]), pkbf(s1[10], s1[11]), pkbf(s1[12], s1[13]), pkbf(s1[14], s1[15])};
}

template <int KS0, int NKS, bool WINDOW, int MODE>
__device__ __forceinline__ void run_tiles(LAS unsigned char* lds, int t0, int t1, const u16* Kg, const u16* Vtg, const bf16x8 (&qr)[4], float c31,
                                          int q0w, unsigned mask, int qb, AState& A, int wave, int lane, int r32, int hi) {
    LAS unsigned char* Kr = lds + ATT_K; LAS unsigned char* Vr = lds + ATT_V; const LAS float* lut1 = (const LAS float*)(lds + ATT_LUT) + 96;
    const u16* ksrc = Kg + (size_t)lane * PW + wave * 8;
    const u16* vsrc = Vtg + (size_t)lane * SEQ + wave * 8;
    const unsigned kdst = (unsigned)(uintptr_t)Kr + wave * 1024, vdst = (unsigned)(uintptr_t)Vr + wave * 1024;
#define TCL(t) ((t) < t0 ? t0 : ((t) > t1 ? t1 : (t)))
#define DMA_K(tn) glds16(ksrc + (size_t)TCL(tn) * 64 * PW, (unsigned)__builtin_amdgcn_readfirstlane(kdst + ((tn) & 3) * 8192))
#define DMA_V(tn) glds16(vsrc + TCL(tn) * 64, (unsigned)__builtin_amdgcn_readfirstlane(vdst + ((tn) & 3) * 8192))
#define KS_(t) (Kr + ((t) & 3) * 8192)
#define VS_(t) (Vr + ((t) & 3) * 8192)
#define WAIT_BAR4() asm volatile("s_waitcnt vmcnt(4) lgkmcnt(0)\n\ts_barrier" ::: "memory")
#define T_ACTIVE(t) (!((q0w + 31 - (t) * 64) < 0 || (WINDOW && (q0w - ((t) * 64 + 63)) >= 512)))
#define T_LUTMODE(t) (((q0w - ((t) * 64 + 63)) < 128) || (WINDOW && (q0w + 31 - (t) * 64) >= 512))
    auto tile_sel = [&](int t) -> int { if (MODE == 1) { const int blk = t >> 2; return blk < qb ? (int)((mask >> blk) & 1u) : 1; } if (MODE == 2) return (int)((mask >> t) & 1u); return 1; };
    asm volatile("s_waitcnt vmcnt(0)" ::: "memory");
#pragma unroll
    for (int j = 0; j < 4; ++j) { DMA_K(t0 + j); DMA_V(t0 + j - 2); }
    WAIT_BAR4();
    f32x16 sn0, sn1, sc0, sc1; u32x4 pk[4];
#pragma unroll
    for (int r = 0; r < 16; ++r) { sn0[r] = 0.f; sn1[r] = 0.f; }
#pragma unroll
    for (int i = 0; i < 4; ++i) pk[i] = (u32x4){0u, 0u, 0u, 0u};
    bool act_n = T_ACTIVE(t0), act_c = false, act_p = false;
    if (act_n) qk_block<KS0, NKS>(KS_(t0), qr, r32, hi, sn0, sn1);
    asm volatile("s_waitcnt lgkmcnt(0)\n\ts_barrier" ::: "memory");
    for (int c = t0; c <= t1 + 1; ++c) {
        act_p = act_c; act_c = act_n; sc0 = sn0; sc1 = sn1;
        DMA_K(c + 4); DMA_V(c + 2);
        act_n = (c + 1 <= t1) && T_ACTIVE(c + 1);
        const bool lm_c = T_LUTMODE(c);
        const int dbase = q0w + r32 - c * 64 - 4 * hi;
        const float selc = tile_sel(c) ? (lm_c ? 0.f : c31) : NEGF;
        if (act_p) pv_block(VS_(c - 1), pk, r32, hi, A);
        if (act_c) {
            if (lm_c) lut_add(sc0, sc1, lut1, dbase, selc - A.m); else const_add(sc0, sc1, selc - A.m);
            const float mx = row_max(sc0, sc1);
            if (__any(mx > ATT_THR)) rescale(A, sc0, sc1, mx);
        }
        if (act_n) qk_block<KS0, NKS>(KS_(c + 1), qr, r32, hi, sn0, sn1);
        if (act_c) exp_pack(sc0, sc1, pk, A);
        WAIT_BAR4();
    }
    asm volatile("s_waitcnt vmcnt(0) lgkmcnt(0)\n\ts_barrier" ::: "memory");
#undef TCL
#undef DMA_K
#undef DMA_V
#undef KS_
#undef VS_
#undef WAIT_BAR4
#undef T_ACTIVE
#undef T_LUTMODE
}

__device__ __forceinline__ void build_lut(LAS unsigned char* lds, const float* rel_bias, int head, bool window, int tid) {
    LAS float* lut = (LAS float*)(lds + ATT_LUT);
    for (int i = tid; i < 704; i += 512) {
        const int d = i - 96; float v;
        if (d < 0) v = NEGF;
        else if (d >= 512) v = window ? NEGF : rel_bias[31 * 16 + head] * LOG2E;
        else { int bk;
            if (d < 16) bk = d; else if (d >= 128) bk = 31; else { bk = 16 + (int)(log2f((float)d * (1.0f / 16.0f)) * (16.0f / 3.0f)); bk = bk > 31 ? 31 : bk; }
            v = rel_bias[bk * 16 + head] * LOG2E; }
        lut[i] = v;
    }
}
__device__ __forceinline__ void load_q(bf16x8 (&qr)[4], const u16* qrow, int hi) {
#pragma unroll
    for (int ks = 0; ks < 4; ++ks) qr[ks] = *(const bf16x8*)(qrow + ks * 16 + hi * 8);
}
__device__ __forceinline__ void store_o(u16* dst, const f32x16& v0, const f32x16& v1, int hi) {
#pragma unroll
    for (int g = 0; g < 4; ++g) {
        u32x2 a; a.x = pkbf(v0[4 * g], v0[4 * g + 1]); a.y = pkbf(v0[4 * g + 2], v0[4 * g + 3]); *(u32x2*)(dst + 8 * g + 4 * hi) = a;
        u32x2 b; b.x = pkbf(v1[4 * g], v1[4 * g + 1]); b.y = pkbf(v1[4 * g + 2], v1[4 * g + 3]); *(u32x2*)(dst + 32 + 8 * g + 4 * hi) = b;
    }
}

struct Ctx { LAS unsigned char* lds; int tid, lane, wave, r32, hi, G, bx; u16* proj; u16* obuf; u16* vt; };

__device__ __forceinline__ void moba_unit(const Ctx& C0, KParamsPtr P, int b, int h, int qb) {
    Ctx C = C0; C.lane = lane_opaque(); C.tid = C.wave * 64 + C.lane; C.r32 = C.lane & 31; C.hi = C.lane >> 5;
    const int q0w = __builtin_amdgcn_readfirstlane(qb * 256 + C.wave * 32); const int qpos = q0w + C.r32; const size_t tok = (size_t)b * SEQ + qpos;
    build_lut(C.lds, P->rel_bias, h, false, C.tid);
    const u16* qrow = C.proj + tok * PW + C_MQ + h * 64;
    bf16x8 qr[4]; load_q(qr, qrow, C.hi);
    unsigned mask = 0;
    if (qb > 0) {
        float g[7];
#pragma unroll
        for (int j = 0; j < 7; ++j) g[j] = 0.f;
        const float* km = (const float*)(P->ws + WS_KMEAN) + (size_t)((b * 4 + h) * 8) * 64;
#pragma unroll
        for (int dc = 0; dc < 8; ++dc) {
            const u32x4 qv = *(const u32x4*)(qrow + dc * 8);
            float qf[8]; qf[0] = bf2f(qv.x & 0xffffu); qf[1] = bf2f(qv.x >> 16); qf[2] = bf2f(qv.y & 0xffffu); qf[3] = bf2f(qv.y >> 16);
            qf[4] = bf2f(qv.z & 0xffffu); qf[5] = bf2f(qv.z >> 16); qf[6] = bf2f(qv.w & 0xffffu); qf[7] = bf2f(qv.w >> 16);
#pragma unroll
            for (int j = 0; j < 7; ++j) if (j < qb) { const float* kmj = km + j * 64 + dc * 8;
#pragma unroll
                for (int e = 0; e < 8; ++e) g[j] = fmaf(qf[e], kmj[e], g[j]); }
        }
#pragma unroll
        for (int j = 0; j < 7; ++j) if (j < qb) { int rank = 0;
#pragma unroll
            for (int i = 0; i < 7; ++i) if (i != j && i < qb) rank += (g[i] > g[j] || (g[i] == g[j] && i < j)) ? 1 : 0;
            if (rank < 3) mask |= 1u << j; }
    }
    AState A; astate_init(A);
    const float c31 = P->rel_bias[31 * 16 + h] * LOG2E;
    run_tiles<0, 4, false, 1>(C.lds, 0, 4 * qb + 3, C.proj + (size_t)b * SEQ * PW + C_MK + h * 64, C.vt + (size_t)((b * NVH + h) * 64) * SEQ, qr, c31, q0w, mask, qb, A, C.wave, C.lane, C.r32, C.hi);
    const float inv = rcpf_(xhalf_sum(A.l));
    A.o0 *= inv; A.o1 *= inv;
    { const int l2 = lane_opaque(); const size_t tok2 = (size_t)b * SEQ + q0w + (l2 & 31);
      store_o(C.obuf + tok2 * DM + h * 64, A.o0, A.o1, l2 >> 5); }
}

__device__ __forceinline__ void diff_unit(const Ctx& C0, KParamsPtr P, int layer, int b, int h, int qb) {
    Ctx C = C0; C.lane = lane_opaque(); C.tid = C.wave * 64 + C.lane; C.r32 = C.lane & 31; C.hi = C.lane >> 5;
    const int q0w = __builtin_amdgcn_readfirstlane(qb * 256 + C.wave * 32); const int qpos = q0w + C.r32; const size_t tok = (size_t)b * SEQ + qpos;
    build_lut(C.lds, P->rel_bias, 4 + h, false, C.tid);
    bf16x8 qr[4]; load_q(qr, C.proj + tok * PW + C_DQ + h * 64, C.hi);
    AState A; astate_init(A);
    const float c31 = P->rel_bias[31 * 16 + 4 + h] * LOG2E;
    const u16* Kg = C.proj + (size_t)b * SEQ * PW + C_DK + h * 64; const u16* Vg = C.vt + (size_t)((b * NVH + 4 + h) * 64) * SEQ;
    run_tiles<0, 2, false, 0>(C.lds, 0, 4 * qb + 3, Kg, Vg, qr, c31, q0w, 0u, 0, A, C.wave, C.lane, C.r32, C.hi);
    LAS float* park = (LAS float*)(C.lds + ATT_PARK) + C.tid;
    { const float i0 = rcpf_(xhalf_sum(A.l));
#pragma unroll
      for (int r = 0; r < 16; ++r) { park[r * 512] = A.o0[r] * i0; park[(16 + r) * 512] = A.o1[r] * i0; } }
    astate_init(A);
    run_tiles<2, 2, false, 0>(C.lds, 0, 4 * qb + 3, Kg, Vg, qr, c31, q0w, 0u, 0, A, C.wave, C.lane, C.r32, C.hi);
    const float* lp = P->diff_lambda + (size_t)layer * 128; float d01 = 0.f, d23 = 0.f;
    for (int i = 0; i < 32; ++i) { d01 = fmaf(lp[i], lp[32 + i], d01); d23 = fmaf(lp[64 + i], lp[96 + i], d23); }
    const float li = P->lam_init[layer]; const float lam = expf(d01) - expf(d23) + li;
    const float i1 = lam * rcpf_(xhalf_sum(A.l));
    float ss = 0.f;
#pragma unroll
    for (int r = 0; r < 16; ++r) { A.o0[r] = park[r * 512] - A.o0[r] * i1; A.o1[r] = park[(16 + r) * 512] - A.o1[r] * i1; ss += A.o0[r] * A.o0[r] + A.o1[r] * A.o1[r]; }
    ss = xhalf_sum(ss);
    const float rstd = (1.0f / sqrtf(ss * (1.0f / 64.0f) + 1e-6f)) * (1.0f - li);
    const float* sg = P->diff_subln + (size_t)layer * 64;
#pragma unroll
    for (int r = 0; r < 16; ++r) { const int d = crow(r, C.hi); A.o0[r] *= rstd * sg[d]; A.o1[r] *= rstd * sg[32 + d]; }
    { const int l2 = lane_opaque(); const size_t tok2 = (size_t)b * SEQ + q0w + (l2 & 31);
      store_o(C.obuf + tok2 * DM + 256 + h * 64, A.o0, A.o1, l2 >> 5); }
}

__device__ __forceinline__ void nsa_unit(const Ctx& C0, KParamsPtr P, int b, int hq, int qb) {
    Ctx C = C0; C.lane = lane_opaque(); C.tid = C.wave * 64 + C.lane; C.r32 = C.lane & 31; C.hi = C.lane >> 5;
    const int g = hq >> 2;
    const int q0w = __builtin_amdgcn_readfirstlane(qb * 256 + C.wave * 32); const int qpos = q0w + C.r32; const size_t tok = (size_t)b * SEQ + qpos;
    build_lut(C.lds, P->rel_bias, 8 + hq, false, C.tid);
    bf16x8 qr[4]; load_q(qr, C.proj + tok * PW + C_NQ + hq * 64, C.hi);
    const u16* gl = C.proj + tok * PW + C_NG + hq * 3;
    const float g1 = sigmoid_f(bf2f(gl[1])), g2 = sigmoid_f(bf2f(gl[2]));
    const unsigned mask = ((const unsigned*)(P->ws + WS_SEL))[(size_t)(b * 2 + g) * SEQ + qpos];
    const float c31 = P->rel_bias[31 * 16 + 8 + hq] * LOG2E;
    AState A; astate_init(A);
    run_tiles<0, 4, false, 2>(C.lds, 0, 4 * qb + 3, C.proj + (size_t)b * SEQ * PW + C_NKS + g * 64, C.vt + (size_t)((b * NVH + 8 + g) * 64) * SEQ, qr, c31, q0w, mask, qb, A, C.wave, C.lane, C.r32, C.hi);
    LAS float* park = (LAS float*)(C.lds + ATT_PARK) + C.tid;
    { const float f = g1 * rcpf_(xhalf_sum(A.l));
#pragma unroll
      for (int r = 0; r < 16; ++r) { park[r * 512] = A.o0[r] * f; park[(16 + r) * 512] = A.o1[r] * f; } }
    if (C.tid < 96) ((LAS float*)(C.lds + ATT_LUT))[608 + C.tid] = NEGF;
    astate_init(A);
    const int tw0 = 4 * qb - 8 < 0 ? 0 : 4 * qb - 8;
    run_tiles<0, 4, true, 0>(C.lds, tw0, 4 * qb + 3, C.proj + (size_t)b * SEQ * PW + C_NKW + g * 64, C.vt + (size_t)((b * NVH + 10 + g) * 64) * SEQ, qr, c31, q0w, 0u, qb, A, C.wave, C.lane, C.r32, C.hi);
    { const float f = g2 * rcpf_(xhalf_sum(A.l));
#pragma unroll
      for (int r = 0; r < 16; ++r) { A.o0[r] = A.o0[r] * f + park[r * 512]; A.o1[r] = A.o1[r] * f + park[(16 + r) * 512]; } }
    const int l2 = lane_opaque(); const int hi2 = l2 >> 5;
    u16* dst = C.obuf + ((size_t)b * SEQ + q0w + (l2 & 31)) * DM + 512 + hq * 64;
#pragma unroll
    for (int gg = 0; gg < 4; ++gg) {
        const u32x2 a = *(const u32x2*)(dst + 8 * gg + 4 * hi2), bq = *(const u32x2*)(dst + 32 + 8 * gg + 4 * hi2);
        A.o0[4 * gg] += bf2f(a.x & 0xffffu); A.o0[4 * gg + 1] += bf2f(a.x >> 16); A.o0[4 * gg + 2] += bf2f(a.y & 0xffffu); A.o0[4 * gg + 3] += bf2f(a.y >> 16);
        A.o1[4 * gg] += bf2f(bq.x & 0xffffu); A.o1[4 * gg + 1] += bf2f(bq.x >> 16); A.o1[4 * gg + 2] += bf2f(bq.y & 0xffffu); A.o1[4 * gg + 3] += bf2f(bq.y >> 16);
    }
    store_o(dst, A.o0, A.o1, hi2);
}

__device__ __forceinline__ void cmp_unit(const Ctx& C0, KParamsPtr P, int b, int g, int qblk) {
    Ctx C = C0; C.lane = lane_opaque(); C.tid = C.wave * 64 + C.lane; C.r32 = C.lane & 31; C.hi = C.lane >> 5;
    LAS unsigned char* lds = C.lds; const int tid = C.tid, r32 = C.r32, hi = C.hi;
    const u16* kc = (const u16*)(P->ws + WS_KCMP) + (size_t)(b * 2 + g) * 128 * 64;
    const u16* vc = (const u16*)(P->ws + WS_VCMPT) + (size_t)(b * 2 + g) * 64 * 128;
#pragma unroll
    for (int i = 0; i < 2; ++i) { const int e = tid + 512 * i;
        { const int row = e >> 3, ch = e & 7; *(LAS u32x4*)(lds + CMP_K + row * 144 + ch * 16) = *(const u32x4*)(kc + row * 64 + ch * 8); }
        { const int row = e >> 4, ch = e & 15; *(LAS u32x4*)(lds + CMP_V + row * 272 + ch * 16) = *(const u32x4*)(vc + row * 128 + ch * 8); } }
    const int q0w = __builtin_amdgcn_readfirstlane(qblk * 256 + C.wave * 32); const int qpos = q0w + r32; const size_t tok = (size_t)b * SEQ + qpos;
    const int nmax = (qpos - 31) >> 4;
    __syncthreads();
    float qa[16], qh[16];
#pragma unroll
    for (int i = 0; i < 16; ++i) { qa[i] = 0.f; qh[i] = 0.f; }
    const LAS unsigned char* kp = lds + CMP_K + r32 * 144 + hi * 16;
    const LAS unsigned char* vp = lds + CMP_V + r32 * 272 + hi * 16;
    bf16x8 qn[4]; load_q(qn, C.proj + tok * PW + C_NQ + g * 4 * 64, hi);
    for (int rh = 0; rh < 4; ++rh) {
        const int hq = g * 4 + rh;
        bf16x8 qr[4];
#pragma unroll
        for (int ks = 0; ks < 4; ++ks) qr[ks] = qn[ks];
        load_q(qn, C.proj + tok * PW + C_NQ + (g * 4 + (rh < 3 ? rh + 1 : rh)) * 64, hi);
        const float g0 = sigmoid_f(bf2f(C.proj[tok * PW + C_NG + hq * 3]));
        f32x16 s[4];
#pragma unroll
        for (int kb = 0; kb < 4; ++kb) {
#pragma unroll
            for (int r = 0; r < 16; ++r) s[kb][r] = 0.f;
#pragma unroll
            for (int ks = 0; ks < 4; ++ks) { const bf16x8 a = *(const LAS bf16x8*)(kp + kb * 32 * 144 + ks * 32); s[kb] = __builtin_amdgcn_mfma_f32_32x32x16_bf16(a, qr[ks], s[kb], 0, 0, 0); }
        }
        float mx = NEGF;
#pragma unroll
        for (int kb = 0; kb < 4; ++kb)
#pragma unroll
            for (int r = 0; r < 16; ++r) { const int n = 32 * kb + crow(r, hi); const float v = (n <= nmax) ? s[kb][r] : NEGF; s[kb][r] = v; mx = fmaxf(mx, v); }
        mx = xhalf_max(mx);
        float sum = 0.f;
#pragma unroll
        for (int kb = 0; kb < 4; ++kb)
#pragma unroll
            for (int r = 0; r < 16; ++r) { const int n = 32 * kb + crow(r, hi); const float pv = (n <= nmax) ? ex2(s[kb][r] - mx) : 0.f; s[kb][r] = pv; sum += pv; }
        sum = xhalf_sum(sum);
        const float inv = nmax >= 0 ? rcpf_(sum) : 0.f;
        f32x16 o0, o1;
#pragma unroll
        for (int r = 0; r < 16; ++r) { o0[r] = 0.f; o1[r] = 0.f; }
#pragma unroll
        for (int kb = 0; kb < 4; ++kb) {
#pragma unroll
            for (int r = 0; r < 16; ++r) s[kb][r] *= inv;
#pragma unroll
            for (int g4 = 0; g4 < 4; ++g4) { const float h = 0.5f * s[kb][4 * g4 + 3]; qh[kb * 4 + g4] += h; qa[kb * 4 + g4] += (s[kb][4 * g4] + s[kb][4 * g4 + 1]) + (s[kb][4 * g4 + 2] + h); }
#pragma unroll
            for (int c = 0; c < 2; ++c) {
                const u32x4 pk = (u32x4){pkbf(s[kb][8 * c], s[kb][8 * c + 1]), pkbf(s[kb][8 * c + 2], s[kb][8 * c + 3]), pkbf(s[kb][8 * c + 4], s[kb][8 * c + 5]), pkbf(s[kb][8 * c + 6], s[kb][8 * c + 7])};
                const bf16x8 pb = __builtin_bit_cast(bf16x8, pk);
                const bf16x8 v0 = *(const LAS bf16x8*)(vp + (kb * 2 + c) * 32);
                const bf16x8 v1 = *(const LAS bf16x8*)(vp + 32 * 272 + (kb * 2 + c) * 32);
                o0 = __builtin_amdgcn_mfma_f32_32x32x16_bf16(v0, pb, o0, 0, 0, 0);
                o1 = __builtin_amdgcn_mfma_f32_32x32x16_bf16(v1, pb, o1, 0, 0, 0);
            }
            __builtin_amdgcn_sched_barrier(0);
        }
        o0 *= g0; o1 *= g0;
        store_o(C.obuf + tok * DM + 512 + hq * 64, o0, o1, hi);
    }
    LAS float* Aq = (LAS float*)(lds + CMP_A) + (C.wave * 32 + r32) * 33; LAS float* Hq = (LAS float*)(lds + CMP_H) + (C.wave * 32 + r32) * 33;
#pragma unroll
    for (int kb = 0; kb < 4; ++kb)
#pragma unroll
        for (int g4 = 0; g4 < 4; ++g4) { const int j = 8 * kb + 2 * g4 + hi; Aq[j] = qa[kb * 4 + g4]; Hq[j] = qh[kb * 4 + g4]; }
    __syncthreads();
    const int cur = q0w >> 6;
    unsigned bits = 0;
    if (cur < 16) bits = (2u << cur) - 1u;
    else {
        float sc[32];
#pragma unroll
        for (int i = 0; i < 32; ++i) { const float imp = Aq[i] + (i > 0 ? Hq[i - 1] : 0.f); sc[i] = (i > cur) ? -3.0e38f : ((i == 0 || i > cur - 2) ? 1e4f : imp); }
#pragma unroll
        for (int e = 0; e < 16; ++e) {
            const float sj = hi ? sc[16 + e] : sc[e]; int rank = 0;
#pragma unroll
            for (int i = 0; i < 32; ++i) { const bool lt = (i < e) || (hi && i < 16 + e);
                rank += (sc[i] > sj || (sc[i] == sj && lt)) ? 1 : 0; }
            const int j = hi * 16 + e;
            if (j <= cur && rank < 16) bits |= 1u << j; }
        { auto rr = __builtin_amdgcn_permlane32_swap(bits, bits, false, false); bits = rr[0] | rr[1]; }
    }
    if (hi == 0) ((unsigned*)(P->ws + WS_SEL))[(size_t)(b * 2 + g) * SEQ + qpos] = bits;
    __syncthreads();
}

__device__ __forceinline__ void prep_vk(const Ctx& C, KParamsPtr P, int b0) {
    const int G = C.G - b0, bxr = C.bx - b0, tid = C.tid, lane = C.lane;
    if (bxr < 0) return;
    for (int it = bxr; it < NB * NVH * 32; it += G) {
        const int tb = it & 31, hv = (it >> 5) % NVH, b = it / (32 * NVH);
        const int vcol = hv < 4 ? C_MV + hv * 64 : hv < 8 ? C_DV + (hv - 4) * 64 : hv < 10 ? C_NVS + (hv - 8) * 64 : C_NVW + (hv - 10) * 64;
        { const int row = tid >> 3, ch = tid & 7; *(LAS u32x4*)(C.lds + row * 144 + ch * 16) = *(const u32x4*)(C.proj + ((size_t)b * SEQ + tb * 64 + row) * PW + vcol + ch * 8); }
        __syncthreads();
        { const int d = tid >> 3, pc = tid & 7; unsigned w[4];
#pragma unroll
            for (int e = 0; e < 4; ++e) { const int p0 = pc * 8 + 2 * e, p1 = p0 + 1; const int k0 = (p0 & ~15) + kperm(p0 & 15), k1 = (p1 & ~15) + kperm(p1 & 15);
                const unsigned a = *(const LAS u16*)(C.lds + k0 * 144 + d * 2), bb = *(const LAS u16*)(C.lds + k1 * 144 + d * 2); w[e] = a | (bb << 16); }
            *(u32x4*)(C.vt + ((size_t)(b * NVH + hv) * 64 + d) * SEQ + tb * 64 + pc * 8) = (u32x4){w[0], w[1], w[2], w[3]}; }
        __syncthreads();
    }
    const int gw = bxr * 8 + C.wave, NGW = G * 8;
    for (int it = gw; it < NB * 4 * 8; it += NGW) {
        const int blk = it & 7, h = (it >> 3) & 3, b = it >> 5;
        const u16* kp = C.proj + ((size_t)b * SEQ + blk * 256) * PW + C_MK + h * 64 + lane; float s = 0.f;
        for (int k = 0; k < 256; k += 8) { float t[8];
#pragma unroll
            for (int e = 0; e < 8; ++e) t[e] = bf2f(kp[(size_t)(k + e) * PW]);
            s += ((t[0] + t[1]) + (t[2] + t[3])) + ((t[4] + t[5]) + (t[6] + t[7])); }
        ((float*)(P->ws + WS_KMEAN))[(size_t)it * 64 + lane] = s * (1.0f / 256.0f);
    }
}
__device__ __forceinline__ void prep_a(const Ctx& C, KParamsPtr P, int layer) {
    const int G = C.G, lane = C.lane;
    const int gw = C.bx * 8 + C.wave, NGW = G * 8;
    u16* acmp = (u16*)(P->ws + WS_XN);
    for (int it = gw; it < 2 * 4096; it += NGW) {
        const int i = it >> 12, row = it & 4095, n = row & 127, bg = row >> 7, b = bg >> 1, g = bg & 1;
        u16* dst = acmp + (size_t)it * 2048; const float* pe = P->cmp_pe + (size_t)(layer * 2 + i) * 2048;
        const int col = (i == 0 ? C_NKC : C_NVC) + g * 64;
#pragma unroll
        for (int pass = 0; pass < 4; ++pass) { const int l = pass * 8 + (lane >> 3), d0 = (lane & 7) * 8;
            unsigned z0 = 0u; asm volatile("" : "+v"(z0)); u32x4 o = (u32x4){z0, z0, z0, z0};
            if (n < 127) { const u32x4 v = *(const u32x4*)(C.proj + ((size_t)b * SEQ + 16 * n + l) * PW + col + d0); const f32x4 e0 = *(const f32x4*)(pe + l * 64 + d0), e1 = *(const f32x4*)(pe + l * 64 + d0 + 4);
                o.x = pkbf(bf2f(v.x & 0xffffu) + e0.x, bf2f(v.x >> 16) + e0.y); o.y = pkbf(bf2f(v.y & 0xffffu) + e0.z, bf2f(v.y >> 16) + e0.w);
                o.z = pkbf(bf2f(v.z & 0xffffu) + e1.x, bf2f(v.z >> 16) + e1.y); o.w = pkbf(bf2f(v.w & 0xffffu) + e1.z, bf2f(v.w >> 16) + e1.w); }
            *(u32x4*)(dst + l * 64 + d0) = o; }
    }
}
__device__ __forceinline__ void prep_c(const Ctx& C, KParamsPtr P, int layer, int it0) {
    const int i = it0 >> 12, row0 = it0 & 4095, lane = lane_opaque(), tid = C.wave * 64 + lane, r32 = lane & 31, hi = lane >> 5;
    const float* w2 = P->cmp_w2 + (size_t)(layer * 2 + i) * 256 * 64;
    for (int e = tid; e < 256 * 64; e += 512) { const int k = e >> 6, c = e & 63; *(LAS u16*)(C.lds + c * 528 + k * 2) = (u16)(pkbf(w2[e], 0.f) & 0xffffu); }
    __syncthreads();
    const int wrow = row0 + C.wave * 32;
    const u16* hrow = (const u16*)(P->ws + WS_HID) + ((size_t)i * 4096 + wrow + r32) * 256 + hi * 8;
    f32x16 d0, d1;
#pragma unroll
    for (int r = 0; r < 16; ++r) { d0[r] = 0.f; d1[r] = 0.f; }
#pragma unroll 4
    for (int ks = 0; ks < 16; ++ks) {
        const bf16x8 a = *(const bf16x8*)(hrow + ks * 16);
        const bf16x8 b0 = *(const LAS bf16x8*)(C.lds + r32 * 528 + (ks * 16 + hi * 8) * 2);
        const bf16x8 b1 = *(const LAS bf16x8*)(C.lds + (32 + r32) * 528 + (ks * 16 + hi * 8) * 2);
        d0 = __builtin_amdgcn_mfma_f32_32x32x16_bf16(a, b0, d0, 0, 0, 0);
        d1 = __builtin_amdgcn_mfma_f32_32x32x16_bf16(a, b1, d1, 0, 0, 0);
    }
#pragma unroll
    for (int r = 0; r < 16; ++r) { const int row = wrow + crow(r, hi);
        const unsigned v0 = pkbf(d0[r], 0.f) & 0xffffu, v1 = pkbf(d1[r], 0.f) & 0xffffu;
        if (i == 0) { u16* o = (u16*)(P->ws + WS_KCMP) + (size_t)row * 64; o[r32] = (u16)v0; o[32 + r32] = (u16)v1; }
        else { const int bg = row >> 7, n = row & 127; u16* o = (u16*)(P->ws + WS_VCMPT) + (size_t)bg * 64 * 128 + (n & ~15) + pperm(n & 15); o[(size_t)r32 * 128] = (u16)v0; o[(size_t)(32 + r32) * 128] = (u16)v1; }
    }
}

__device__ __forceinline__ void convert_weights(const Ctx& C, KParamsPtr P, int layer) {
    LAS float* scr = (LAS float*)(C.lds + C.wave * 16384);
    const int gw = C.bx * 8 + C.wave, NGW = C.G * 8, lane = C.lane;
    constexpr int I_G = 16 * 88, I_D = 44 * 32, I_IN = 16 * 96, I_O = 16 * 32, I_W1 = 32 * 8;
    constexpr int NIT = 4 * I_G + 2 * I_D + I_IN + I_O + 2 * I_W1;
    unsigned char* ws = P->ws;
    for (int it = gw; it < NIT; it += NGW) {
        int r = it;
        if (r < 4 * I_G) { const int which = r / I_G; r -= which * I_G; const int kb = r / 88, nb = r % 88, n0 = nb * 32;
            const float* W = (which == 0 ? P->ffn1_gate : which == 1 ? P->ffn1_up : which == 2 ? P->ffn2_gate : P->ffn2_up) + (size_t)layer * DM * DFF;
            u16* WT = (u16*)(ws + (which < 2 ? WS_GU1 : WS_GU2));
            tr_item(W, DM, DFF, WT, kb, n0, (n0 >> 7) * 256 + (which & 1) * 128 + (n0 & 127), scr, lane, 1.0f, (which < 2 ? P->norm_ffn1 : P->norm_ffn2) + (size_t)layer * DM); continue; }
        r -= 4 * I_G;
        if (r < 2 * I_D) { const int which = r / I_D; r -= which * I_D; const int kb = r / 32, nb = r % 32;
            const float* W = (which == 0 ? P->ffn1_down : P->ffn2_down) + (size_t)layer * DFF * DM;
            tr_item(W, DFF, DM, (u16*)(ws + (which == 0 ? WS_DN1 : WS_DN2)), kb, nb * 32, nb * 32, scr, lane); continue; }
        r -= 2 * I_D;
        if (r < I_IN) { const int kb = r / 96, nb = r % 96, n0 = nb * 32;
            const float cs = (n0 < C_MK || (n0 >= C_NQ && n0 < C_NKC)) ? 0.125f * LOG2E : (n0 >= C_DQ && n0 < C_DK) ? 0.17677669529663687f * LOG2E : 1.0f;
            tr_item(P->w_in + (size_t)layer * DM * INW, DM, INW, (u16*)(ws + WS_WIN), kb, n0, n0, scr, lane, cs, P->norm_mix + (size_t)layer * DM); continue; }
        r -= I_IN;
        if (r < I_O) { const int kb = r / 32, nb = r % 32; tr_item(P->w_out + (size_t)layer * DM * DM, DM, DM, (u16*)(ws + WS_WOUT), kb, nb * 32, nb * 32, scr, lane); continue; }
        r -= I_O;
        { const int i = r / I_W1; r -= i * I_W1; const int kb = r / 8, nb = r % 8;
            tr_item(P->cmp_w1 + (size_t)(layer * 2 + i) * 2048 * 256, 2048, 256, (u16*)(ws + WS_W1) + (size_t)i * 256 * 2048, kb, nb * 32, nb * 32, scr, lane); }
    }
}
__device__ __forceinline__ void norm_phase(const Ctx& C, const float* src32, const u16* src16, const float* g, u16* dst16, float* dst32, u16* xb0) {
    const int gw = C.bx * 8 + C.wave, NGW = C.G * 8;
    for (int m = gw; m < MTOK; m += NGW) norm_row(src32 ? src32 + (size_t)m * DM : nullptr, src16 ? src16 + (size_t)m * DM : nullptr, g, dst16 ? dst16 + (size_t)m * DM : nullptr, dst32 ? dst32 + (size_t)m * DM : nullptr, xb0 ? xb0 + (size_t)m * DM : nullptr, C.lane);
}

#define XB_TMO      128
#define XB_XCNT(j)  (256  + 64 * (j))
#define XB_XSUB(j)  (1280 + 64 * (j))
#define XB_XGEN(j)  (2304 + 64 * (j))
#define XB_TOP      3328
#define XB_TOPGEN   3392
#define XCD_BAR_WORDS 3456
#define XB_SPIN_CAP (1u << 18)

__device__ __forceinline__ unsigned xb_ld(unsigned* p)              { return __hip_atomic_load(p, __ATOMIC_RELAXED, __HIP_MEMORY_SCOPE_AGENT); }
__device__ __forceinline__ unsigned xb_add(unsigned* p, unsigned v) { return __hip_atomic_fetch_add(p, v, __ATOMIC_RELAXED, __HIP_MEMORY_SCOPE_AGENT); }
__device__ __forceinline__ unsigned xb_xcc_id() { return (unsigned)__builtin_amdgcn_s_getreg((3 << 11) | 20) & 0xFu; }
#define XB_SPIN(cond, bar) do { unsigned _sp = 0; while (cond) { __builtin_amdgcn_s_sleep(1); \
    if ((++_sp & 255u) == 0u) { if (xb_ld(&(bar)[XB_TMO])) break; if (_sp > XB_SPIN_CAP) { atomicAdd(&(bar)[XB_TMO], 1u); break; } } } } while (0)

struct XcdBarrier {
    unsigned* bar; unsigned x;
    volatile LAS unsigned* st;
};

__device__ __forceinline__ XcdBarrier xcd_barrier_post(unsigned* bar, volatile LAS unsigned* st) {
    XcdBarrier b; b.bar = bar; b.x = xb_xcc_id(); b.st = st;
    if (threadIdx.x == 0) (void)xb_add(&bar[XB_XCNT(b.x)], 1u);
    return b;
}
__device__ __forceinline__ void xcd_barrier_complete(unsigned* bar, unsigned x, unsigned& nloc, unsigned& nx) {
    const unsigned G = gridDim.x * gridDim.y * gridDim.z;
    unsigned sum, cnt, mine, sp = 0u;
    for (;;) {
        sum = 0u; cnt = 0u; mine = 0u;
#pragma unroll
        for (unsigned j = 0; j < 16; ++j) { const unsigned c = xb_ld(&bar[XB_XCNT(j)]); sum += c; cnt += (c > 0u) ? 1u : 0u; mine = (j == x) ? c : mine; }
        if (sum == G) break;
        __builtin_amdgcn_s_sleep(1);
        if ((++sp & 255u) == 0u) { if (xb_ld(&bar[XB_TMO])) break; if (sp > XB_SPIN_CAP) { atomicAdd(&bar[XB_TMO], 1u); break; } }
    }
    nloc = mine > 0u ? mine : 1u; nx = cnt > 0u ? cnt : 1u;
}

__device__ __forceinline__ void xcd_barrier(const XcdBarrier& b) {
    asm volatile("s_waitcnt vmcnt(0)" ::: "memory");
    __syncthreads();
    if (threadIdx.x == 0) {
        unsigned* bar = b.bar;
        __builtin_amdgcn_s_waitcnt(0);
        unsigned nloc = b.st[0], nx = b.st[1];
        if (nloc == 0u) { xcd_barrier_complete(bar, b.x, nloc, nx); b.st[0] = nloc; b.st[1] = nx; }
        const unsigned old = xb_add(&bar[XB_XSUB(b.x)], 1u);
        const unsigned gen = old / nloc;
        if (old + 1u == (gen + 1u) * nloc) {
            __builtin_amdgcn_fence(__ATOMIC_RELEASE, "agent");
            asm volatile("s_waitcnt vmcnt(0)" ::: "memory");
            const unsigned og = xb_add(&bar[XB_TOP], 1u);
            const unsigned tg = og / nx;
            if (og + 1u == (tg + 1u) * nx) xb_add(&bar[XB_TOPGEN], 1u);
            else XB_SPIN(xb_ld(&bar[XB_TOPGEN]) == tg, bar);
            __builtin_amdgcn_fence(__ATOMIC_ACQUIRE, "agent");
            xb_add(&bar[XB_XGEN(b.x)], 1u);
            asm volatile("s_waitcnt vmcnt(0)" ::: "memory");
        } else {
            XB_SPIN(xb_ld(&bar[XB_XGEN(b.x)]) == gen, bar);
            __builtin_amdgcn_fence(__ATOMIC_ACQUIRE, "agent");
            asm volatile("s_waitcnt vmcnt(0)" ::: "memory");
        }
    }
    __syncthreads();
}


__device__ __forceinline__ void fill_rtab(const Ctx& C, const pg8::StaticOrder& S, const float* SS, LAS float* rtab) {
    LAS int* pml = (LAS int*)(rtab + 11 * 256);
    int nu = 0; { pg8::Unit u_; for (int i_ = 0; i_ < 11 && S.next(i_, u_); ++i_) { if (C.tid == 0) pml[i_] = u_.pm; nu = i_ + 1; } }
    __syncthreads();
    const int tot = nu * 256; float rsv[6];
#pragma unroll
    for (int k = 0; k < 6; ++k) { const int e = C.tid + 512 * k; rsv[k] = e < tot ? pg8::row_rstd(SS, pml[e >> 8] * 256 + (e & 255)) : 0.f; }
#pragma unroll
    for (int k = 0; k < 6; ++k) { const int e = C.tid + 512 * k; if (e < tot) rtab[e] = rsv[k]; }
    __syncthreads();
}
__device__ __forceinline__ void x0_phase(const Ctx& C, const float* src, u16* xb, float* ss) {
    const int gw = C.bx * 8 + C.wave, NGW = C.G * 8, lane = C.lane;
    for (int m = gw; m < MTOK; m += NGW) {
        const f32x4* xr = (const f32x4*)(src + (size_t)m * DM) + lane; float s = 0.f;
#pragma unroll
        for (int j = 0; j < 4; ++j) { const f32x4 v = xr[64 * j]; s += (v.x * v.x + v.y * v.y) + (v.z * v.z + v.w * v.w);
            u32x2 o; o.x = pkbf(v.x, v.y); o.y = pkbf(v.z, v.w); *((u32x2*)(xb + (size_t)m * DM) + lane + 64 * j) = o; }
        s = wave_sum(s, lane);
        if (lane < 16) ss[(size_t)m * 16 + lane] = lane == 0 ? s : 0.f;
    }
}
struct OneUnit { int pm;
    __device__ __forceinline__ bool next(int i, pg8::Unit& u) const { if (i) return false; u.pm = pm; u.pn = 0; return true; }
    __device__ __forceinline__ void a_ready(const pg8::Unit&) const {}
    __device__ __forceinline__ void done(const pg8::Unit&) const {} };
__global__ void __launch_bounds__(512, 2) hybrid_fwd(Params P0) {
    extern __shared__ __attribute__((aligned(16))) unsigned char lds_raw[];
    const KParamsPtr kp0 = (KParamsPtr)__builtin_amdgcn_kernarg_segment_ptr();
    cg::grid_group grid = cg::this_grid();
    { volatile LAS unsigned* misc = (volatile LAS unsigned*)((LAS unsigned char*)lds_raw + MISC_OFF); if (threadIdx.x < 2) misc[threadIdx.x] = 0u; }
    __syncthreads();
    XcdBarrier bar = xcd_barrier_post((unsigned*)(P0.ws + WS_CTL) + 1024, (volatile LAS unsigned*)((LAS unsigned char*)lds_raw + MISC_OFF));
    const int ph_lo = P0.ph_lo, ph_hi = P0.ph_hi; const int wave_s = __builtin_amdgcn_readfirstlane(threadIdx.x >> 6);
    bool redone = false; (void)redone;
    for (int ph = ph_lo; ph < ph_hi; ++ph) {
        KParamsPtr kpl = kp0; asm volatile("" : "+s"(kpl));
        const KParamsPtr P = kpl; unsigned char* ws = P->ws;
        u16* XN = (u16*)(ws + WS_XN); u16* HB = (u16*)(ws + WS_PROJ);
        int G = gridDim.x, bx = blockIdx.x; asm volatile("" : "+s"(G), "+s"(bx));
        Ctx C; C.G = G; C.bx = bx; C.lds = (LAS unsigned char*)lds_raw; C.wave = wave_s; C.lane = lane_opaque(); C.tid = wave_s * 64 + C.lane; C.r32 = C.lane & 31; C.hi = C.lane >> 5;
        C.proj = (u16*)(ws + WS_PROJ); C.obuf = (u16*)(ws + WS_XN); C.vt = (u16*)(ws + WS_VT);
        const int layer = ph / NPH_L, s = ph % NPH_L;
        if (ph != NPH - 1 && (s == 7 || s == 3 || s == 11)) continue;
        float* SS = (float*)(ws + WS_SS);
        u16* XB = (u16*)(ws + WS_XB);
        if (ph == NPH - 1) { norm_phase(C, nullptr, XB, P->final_norm, nullptr, P->out, nullptr); }
        else switch (s) {
        case 0: { convert_weights(C, P, layer); if (layer == 0) { __syncthreads(); x0_phase(C, P->x, XB, SS); } } break;
#ifndef NO_GEMM
#ifndef NO_G1
        case 1: case 12: {
            pg8::Gemm g{XB, (const u16*)(ws + (s == 1 ? WS_GU1 : WS_GU2)), MTOK, 2 * DFF, DM}; pg8::StaticOrder S; S.init(MTOK, 2 * DFF, G, bx);
            LAS float* rtab = (LAS float*)(C.lds + RTAB_OFF); fill_rtab(C, S, SS, rtab);
            pg8::EpiSwiGLU E{HB, DFF, rtab, 0};
            pg8::gemm_phase<pg8::EpiSwiGLU, pg8::StaticOrder, true, true>(C.lds, g, S, E, C.wave); } break;
#endif
#ifndef NO_G2
        case 2: case 13: case 10: {
            const u16* A = (s == 10) ? (const u16*)XN : (const u16*)HB; const u16* Bt = (const u16*)(ws + (s == 2 ? WS_DN1 : s == 13 ? WS_DN2 : WS_WOUT));
            pg8::Gemm g{A, Bt, MTOK, DM, s == 10 ? DM : DFF}; pg8::StaticOrder S; S.init(MTOK, DM, G, bx);
            pg8::EpiResid E{XB, DM, s == 10 ? 1.0f : 0.5f, SS};
            pg8::gemm_phase<pg8::EpiResid, pg8::StaticOrder, false, true>(C.lds, g, S, E, C.wave); } break;
#endif
#ifndef NO_G4
        case 4: {
            pg8::Gemm g{XB, (const u16*)(ws + WS_WIN), MTOK, PW, DM}; pg8::StaticOrder S; S.init(MTOK, PW, G, bx);
            LAS float* rtab = (LAS float*)(C.lds + RTAB_OFF); fill_rtab(C, S, SS, rtab);
            pg8::EpiBf16<0> E{C.proj, PW, rtab, 0};
            pg8::gemm_phase<pg8::EpiBf16<0>, pg8::StaticOrder, true, true>(C.lds, g, S, E, C.wave); } break;
#endif
#endif
#ifndef NO_PREP
        case 5: prep_a(C, P, layer); prep_vk(C, P, 0); break;
#endif
#if !defined(NO_GEMM) && !defined(NO_G6)
        case 6: {
            unsigned* qctr = (unsigned*)(ws + WS_CTL) + 8192 + 64 * ph + (redone ? 32 : 0); volatile LAS unsigned* qslot = (volatile LAS unsigned*)(C.lds + MISC_OFF + 16);
            for (;;) {
                if (C.tid == 0) *qslot = __hip_atomic_fetch_add(qctr, 1u, __ATOMIC_RELAXED, __HIP_MEMORY_SCOPE_AGENT);
                __syncthreads();
                const unsigned u = *qslot;
                __syncthreads();
                if (u >= 32u + 1024u) break;
                if (u < 32u) { const int i = (int)u >> 4, tile = (int)u & 15;
                    pg8::Gemm g{(const u16*)XN + (size_t)i * 4096 * 2048, (const u16*)(ws + WS_W1) + (size_t)i * 256 * 2048, 4096, 256, 2048}; OneUnit S{tile};
                    pg8::EpiBf16<1> E{(u16*)(ws + WS_HID) + (size_t)i * 4096 * 256, 256, nullptr, 0};
                    pg8::gemm_phase<pg8::EpiBf16<1>, OneUnit, true, true>(C.lds, g, S, E, C.wave);
                    __builtin_amdgcn_fence(__ATOMIC_RELEASE, "agent"); __syncthreads(); __builtin_amdgcn_fence(__ATOMIC_ACQUIRE, "agent");
                    prep_c(C, P, layer, i * 4096 + tile * 256);
                    __syncthreads();
                } else { const unsigned v = u - 32u; const int qb = 7 - (int)(v >> 7), w = (int)(v & 127);
                    if (w < 64) {
#ifndef NO_DIFF
                        diff_unit(C, P, layer, w >> 2, w & 3, qb);
#endif
                    } else {
#ifndef NO_MOBA
                        moba_unit(C, P, (w - 64) >> 2, w & 3, qb);
#endif
                    } }
            } } break;
#endif
#ifndef NO_ATT1
        case 8: {
#ifndef NO_CMP
            for (int c = bx; c < 256; c += G) cmp_unit(C, P, c >> 4, (c >> 3) & 1, c & 7);
#endif
            } break;
#endif
#ifndef NO_ATT2
        case 9: {
            unsigned* qctr = (unsigned*)(ws + WS_CTL) + 8192 + 64 * ph; volatile LAS unsigned* qslot = (volatile LAS unsigned*)(C.lds + MISC_OFF + 16);
            for (;;) {
                if (C.tid == 0) *qslot = __hip_atomic_fetch_add(qctr, 1u, __ATOMIC_RELAXED, __HIP_MEMORY_SCOPE_AGENT);
                __syncthreads();
                const unsigned u = *qslot;
                __syncthreads();
                if (u >= 1024u) break;
                nsa_unit(C, P, (int)(u & 127) >> 3, (int)u & 7, 7 - (int)(u >> 7));
            } } break;
#endif
        default: break;
        }
        if (ph + 1 < ph_hi) { if (ph == ph_lo) grid.sync(); else xcd_barrier(bar); }
#ifdef PROBE_LO
        if (ph != NPH - 1 && s == PROBE_HI) { if (!redone) { ph -= (PROBE_HI - PROBE_LO + 1); redone = true; } else redone = false; }
#endif
#ifdef PROBE_SYNC
        if (ph + 1 < ph_hi) xcd_barrier(bar);
#endif
    }
}

#ifndef COOP
#define COOP 1
#endif
extern "C" void kernel_launch(void* const* d_in, const int* in_sizes, int n_in, void* d_out, int out_size, void* d_ws, size_t ws_size, hipStream_t stream) {
    static int grid = 0;
    if (grid == 0) {
        if (n_in != 19 || out_size != MTOK * DM || ws_size < WS_END) { fprintf(stderr, "kernel_launch: unexpected shapes (n_in %d out %d ws %zu)\n", n_in, out_size, ws_size); grid = -1; return; }
        int dev = 0, cus = 0, per_cu = 0;
        (void)hipGetDevice(&dev); (void)hipDeviceGetAttribute(&cus, hipDeviceAttributeMultiprocessorCount, dev);
        if (hipFuncSetAttribute((const void*)hybrid_fwd, hipFuncAttributeMaxDynamicSharedMemorySize, LDS_BYTES) != hipSuccess) { fprintf(stderr, "kernel_launch: hipFuncSetAttribute failed\n"); grid = -1; return; }
        if (hipOccupancyMaxActiveBlocksPerMultiprocessor(&per_cu, (const void*)hybrid_fwd, 512, LDS_BYTES) != hipSuccess || per_cu < 1) { fprintf(stderr, "kernel_launch: occupancy query says %d\n", per_cu); per_cu = 1; }
        (void)hipGetLastError();
        grid = cus * per_cu;
    }
    if (grid < 0) return;
    Params p{};
    p.x = (const float*)d_in[0]; p.rel_bias = (const float*)d_in[1]; p.norm_ffn1 = (const float*)d_in[2]; p.ffn1_gate = (const float*)d_in[3]; p.ffn1_up = (const float*)d_in[4]; p.ffn1_down = (const float*)d_in[5];
    p.norm_mix = (const float*)d_in[6]; p.w_in = (const float*)d_in[7]; p.diff_lambda = (const float*)d_in[8]; p.diff_subln = (const float*)d_in[9]; p.cmp_pe = (const float*)d_in[10]; p.cmp_w1 = (const float*)d_in[11];
    p.cmp_w2 = (const float*)d_in[12]; p.w_out = (const float*)d_in[13]; p.norm_ffn2 = (const float*)d_in[14]; p.ffn2_gate = (const float*)d_in[15]; p.ffn2_up = (const float*)d_in[16]; p.ffn2_down = (const float*)d_in[17];
    p.final_norm = (const float*)d_in[18]; p.out = (float*)d_out; p.ws = (unsigned char*)d_ws;
    for (int l = 0; l < 4; ++l) p.lam_init[l] = (float)(0.8 - 0.6 * exp(-0.3 * (double)l));
#if COOP
    if (hipMemsetAsync((char*)d_ws + WS_CTL, 0, CTL_ZERO_BYTES, stream) != hipSuccess) { fprintf(stderr, "kernel_launch: memset of barrier words failed\n"); return; }
    p.ph_lo = 0; p.ph_hi = NPH;
    void* args[] = {&p};
    hipError_t e = hipLaunchCooperativeKernel((const void*)hybrid_fwd, dim3(grid), dim3(512), args, LDS_BYTES, stream);
    if (e != hipSuccess) fprintf(stderr, "cooperative launch failed: %s (grid %d)\n", hipGetErrorString(e), grid);
#else
    for (int ph = 0; ph < NPH; ++ph) { p.ph_lo = ph; p.ph_hi = ph + 1; hipLaunchKernelGGL(hybrid_fwd, dim3(grid), dim3(512), LDS_BYTES, stream, p); }
#endif
}
```

```cpp
#include <hip/hip_runtime.h>
#include <hip/hip_cooperative_groups.h>
#include <cstdio>
#include <cstdint>
#include <cmath>
namespace cg = cooperative_groups;
#define COOP 1
namespace pg8 {
#define PG8_LAS __attribute__((address_space(3)))
typedef unsigned short bf16_t;
typedef short bf16x8 __attribute__((ext_vector_type(8)));
typedef float f32x4 __attribute__((ext_vector_type(4)));
typedef unsigned u32x4 __attribute__((ext_vector_type(4)));
constexpr int BM = 256, BK = 64, HALF = 128, HTB = HALF * BK * 2  , STAGE_BYTES = 8 * HTB, NXCD = 8, WGM = 8;

__host__ __device__ __forceinline__ int lds_byte(int r, int c) { const int st = (r >> 4) * 2 + (c >> 5), rr = r & 15, cc = c & 31, ob = rr * 64 + cc * 2; return st * 1024 + (ob ^ (((ob >> 9) & 1) << 5)); }
__host__ __device__ __forceinline__ void stage_rc(int b, int& R, int& C) { const int st = b / 1024, sb = b % 1024, swz = sb ^ (((sb >> 9) & 1) << 5); R = (st >> 1) * 16 + swz / 64; C = (st & 1) * 32 + (swz % 64) / 2; }
__host__ __device__ __forceinline__ int perm32(int rho) { const int n = rho >> 4, i = rho & 15; return 8 * (i >> 2) + 4 * n + (i & 3); }

struct Unit { int pm, pn; };
struct Gemm { const bf16_t* A; const bf16_t* Bt; int M, N, K; };

struct StaticOrder {
    int nM, nN, nwg, G, c;
    __host__ __device__ void init(int M, int N, int G_, int c_) { nM = M / BM; nN = N / BM; nwg = nM * nN; G = G_; c = c_; }
    __host__ __device__ bool next(int i, Unit& u) const {
        const long L = (long)i * G + c; if (L >= nwg) return false;
        int wgid = (int)L; { const int q = nwg / NXCD, r = nwg % NXCD, xcd = wgid % NXCD, off = wgid / NXCD; wgid = (xcd < r ? xcd * (q + 1) : r * (q + 1) + (xcd - r) * q) + off; }
        const int nig = WGM * nN, gid = wgid / nig, fm = gid * WGM, gsz = (nM - fm) < WGM ? (nM - fm) : WGM;
        u.pm = fm + ((wgid % nig) % gsz); u.pn = (wgid % nig) / gsz; return true;
    }
    __device__ __forceinline__ void a_ready(const Unit&) const {}
    __device__ __forceinline__ void done(const Unit&) const {}
};

__device__ __forceinline__ unsigned cvt_pk_bf16(float lo, float hi) { unsigned r; asm volatile("v_cvt_pk_bf16_f32 %0, %1, %2" : "=v"(r) : "v"(lo), "v"(hi)); return r; }

__device__ __forceinline__ float ex2(float x) { return __builtin_amdgcn_exp2f(x); }
__device__ __forceinline__ float rcpf_(float x) { return __builtin_amdgcn_rcpf(x); }
__device__ __forceinline__ float silu_f(float x) { return x * rcpf_(1.0f + ex2(-1.4426950408889634f * x)); }
__device__ __forceinline__ float gelu_tanh_f(float x) { const float y2 = 2.0f * 0.7978845608028654f * (x + 0.044715f * x * x * x); return x * (1.0f - rcpf_(1.0f + ex2(1.4426950408889634f * y2))); }

__device__ __forceinline__ float row_rstd(const float* ss, int row) {
    const f32x4* p = (const f32x4*)(ss + (size_t)row * 16); const f32x4 a = p[0], b = p[1], c = p[2], d = p[3];
    const float s = ((a[0] + a[1]) + (a[2] + a[3])) + ((b[0] + b[1]) + (b[2] + b[3])) + ((c[0] + c[1]) + (c[2] + c[3])) + ((d[0] + d[1]) + (d[2] + d[3]));
    return 1.0f / sqrtf(s * (1.0f / 1024.0f) + 1e-6f);
}

struct EpiSwiGLU {
    static constexpr bool PERM = true, AFTER_DRAIN = false;
    bf16_t* O; int ldc; const PG8_LAS float* rtab; mutable int ui;
    __device__ __forceinline__ void operator()(const f32x4 (&acc)[2][2][4][2], const Unit& u, int wr, int wc, int fr, int fq) const {
        const int row0 = u.pm * BM + wr * 64 + fr; const int col0 = u.pn * HALF + wc * 32 + 8 * fq;
#pragma unroll
        for (int ai = 0; ai < 2; ++ai)
#pragma unroll
            for (int m = 0; m < 4; ++m) { bf16_t* rowp = O + (size_t)(row0 + ai * HALF + m * 16) * ldc + col0;
                const float rs = rtab[ui * 256 + wr * 64 + fr + ai * HALF + m * 16];
                const f32x4 g0 = acc[ai][0][m][0] * rs, g1 = acc[ai][0][m][1] * rs, u0 = acc[ai][1][m][0] * rs, u1 = acc[ai][1][m][1] * rs;
                u32x4 w; w.x = cvt_pk_bf16(silu_f(g0[0]) * u0[0], silu_f(g0[1]) * u0[1]); w.y = cvt_pk_bf16(silu_f(g0[2]) * u0[2], silu_f(g0[3]) * u0[3]);
                w.z = cvt_pk_bf16(silu_f(g1[0]) * u1[0], silu_f(g1[1]) * u1[1]); w.w = cvt_pk_bf16(silu_f(g1[2]) * u1[2], silu_f(g1[3]) * u1[3]);
                *(u32x4*)rowp = w; asm volatile("" ::: "memory"); }
        ++ui;
    }
};
template <int ACT> struct EpiBf16 {
    static constexpr bool PERM = true, AFTER_DRAIN = false;
    bf16_t* O; int ldc; const PG8_LAS float* rtab; mutable int ui;
    __device__ __forceinline__ void operator()(const f32x4 (&acc)[2][2][4][2], const Unit& u, int wr, int wc, int fr, int fq) const {
        const int row0 = u.pm * BM + wr * 64 + fr; const int col0 = u.pn * BM + wc * 32 + 8 * fq;
#pragma unroll
        for (int ai = 0; ai < 2; ++ai)
#pragma unroll
            for (int m = 0; m < 4; ++m) { bf16_t* rowp = O + (size_t)(row0 + ai * HALF + m * 16) * ldc + col0;
                const float rs = rtab ? rtab[ui * 256 + wr * 64 + fr + ai * HALF + m * 16] : 1.0f;
#pragma unroll
                for (int bj = 0; bj < 2; ++bj) { f32x4 v0 = acc[ai][bj][m][0] * rs, v1 = acc[ai][bj][m][1] * rs;
                    if (ACT == 1) { v0 = (f32x4){gelu_tanh_f(v0[0]), gelu_tanh_f(v0[1]), gelu_tanh_f(v0[2]), gelu_tanh_f(v0[3])}; v1 = (f32x4){gelu_tanh_f(v1[0]), gelu_tanh_f(v1[1]), gelu_tanh_f(v1[2]), gelu_tanh_f(v1[3])}; }
                    u32x4 w; w.x = cvt_pk_bf16(v0[0], v0[1]); w.y = cvt_pk_bf16(v0[2], v0[3]); w.z = cvt_pk_bf16(v1[0], v1[1]); w.w = cvt_pk_bf16(v1[2], v1[3]);
                    *(u32x4*)(rowp + bj * HALF) = w; } asm volatile("" ::: "memory"); }
        ++ui;
    }
};
struct EpiResid {
    static constexpr bool PERM = true, AFTER_DRAIN = false;
    bf16_t* xb; int ldc; float alpha; float* ss;
    __device__ __forceinline__ void operator()(const f32x4 (&acc)[2][2][4][2], const Unit& u, int wr, int wc, int fr, int fq) const {
        const int row0 = u.pm * BM + wr * 64 + fr; const int col0 = u.pn * BM + wc * 32 + 8 * fq; const int lane = fq * 16 + fr;
#pragma unroll
        for (int ai = 0; ai < 2; ++ai) {
            u32x4 pre[4][2];
#pragma unroll
            for (int m = 0; m < 4; ++m)
#pragma unroll
                for (int bj = 0; bj < 2; ++bj) pre[m][bj] = *(const u32x4*)(xb + (size_t)(row0 + ai * HALF + m * 16) * ldc + col0 + bj * HALF);
#pragma unroll
            for (int m = 0; m < 4; ++m) { const int row = row0 + ai * HALF + m * 16; bf16_t* rowp = xb + (size_t)row * ldc + col0; float sq = 0.f;
#pragma unroll
                for (int bj = 0; bj < 2; ++bj) { const u32x4 p = pre[m][bj]; const f32x4 a0 = acc[ai][bj][m][0] * alpha, a1 = acc[ai][bj][m][1] * alpha;
                    const float x0 = __uint_as_float(p.x << 16) + a0[0], x1 = __uint_as_float(p.x & 0xffff0000u) + a0[1], x2 = __uint_as_float(p.y << 16) + a0[2], x3 = __uint_as_float(p.y & 0xffff0000u) + a0[3];
                    const float x4 = __uint_as_float(p.z << 16) + a1[0], x5 = __uint_as_float(p.z & 0xffff0000u) + a1[1], x6 = __uint_as_float(p.w << 16) + a1[2], x7 = __uint_as_float(p.w & 0xffff0000u) + a1[3];
                    sq += ((x0 * x0 + x1 * x1) + (x2 * x2 + x3 * x3)) + ((x4 * x4 + x5 * x5) + (x6 * x6 + x7 * x7));
                    u32x4 w; w.x = cvt_pk_bf16(x0, x1); w.y = cvt_pk_bf16(x2, x3); w.z = cvt_pk_bf16(x4, x5); w.w = cvt_pk_bf16(x6, x7);
                    *(u32x4*)(rowp + bj * HALF) = w; }
                sq += __int_as_float(__builtin_amdgcn_ds_bpermute((lane ^ 16) << 2, __float_as_int(sq)));
                sq += __int_as_float(__builtin_amdgcn_ds_bpermute((lane ^ 32) << 2, __float_as_int(sq)));
                if (fq == 0) ss[(size_t)row * 16 + u.pn * 4 + wc] = sq; }
            asm volatile("" ::: "memory");
        }
    }
};
template <class Epi, class Sched, bool ALIGN_EPI = false, bool SP2 = false>
__device__ __forceinline__ void gemm_phase(PG8_LAS unsigned char* lds, const Gemm g, const Sched& S, const Epi& E, const int wave_in) {
    int tid_l; asm volatile("v_mbcnt_lo_u32_b32 %0, -1, 0\n\tv_mbcnt_hi_u32_b32 %0, -1, %0" : "=v"(tid_l)); tid_l += wave_in * 64;
    const int tid = tid_l, wid = __builtin_amdgcn_readfirstlane(tid >> 6), lane = tid & 63, wr = wid >> 2, wc = wid & 3, fr = lane & 15, fq = lane >> 4;
    const int K = g.K, nt = K / BK;
    unsigned voffA[2], voffB[2];
#pragma unroll
    for (int i = 0; i < 2; ++i) { int R, C; stage_rc(tid * 16 + i * 8192, R, C); const int Rb = Epi::PERM ? ((R & ~31) + perm32(R & 31)) : R;
        voffA[i] = (unsigned)(R * K + C) * 2u; voffB[i] = (unsigned)(Rb * K + C) * 2u; }
    const size_t kstep = (size_t)(BK * 2);
    const size_t hstep = (size_t)HALF * K * 2;
    const size_t tstep = 2 * hstep;
    const unsigned ldsw = (unsigned)wid * 1024u;
    const int aoff = lds_byte(wr * 64 + fr, fq * 8), boff = lds_byte(wc * 32 + fr, fq * 8);
#define PG8_SA(b, h) (((b) * 2 + (h)) * HTB)
#define PG8_SB(b, h) ((4 + (b) * 2 + (h)) * HTB)
#define PG8_STAGE(bufoff, gbase, voff) do { _Pragma("unroll") for (int _i = 0; _i < 2; ++_i) \
        __builtin_amdgcn_global_load_lds((const unsigned*)((const char*)(gbase) + (voff)[_i]), (PG8_LAS unsigned*)(lds + (bufoff) + ldsw + _i * 8192), 16, 0, 0); } while (0)
#define PG8_LDA(dst, b, h) do { _Pragma("unroll") for (int m = 0; m < 4; ++m) _Pragma("unroll") for (int k = 0; k < 2; ++k) dst[m][k] = *(const PG8_LAS bf16x8*)(lds + PG8_SA(b, h) + aoff + m * 2048 + k * 1024); } while (0)
#define PG8_LDB(dst, b, h) do { _Pragma("unroll") for (int n = 0; n < 2; ++n) _Pragma("unroll") for (int k = 0; k < 2; ++k) dst[n][k] = *(const PG8_LAS bf16x8*)(lds + PG8_SB(b, h) + boff + n * 2048 + k * 1024); } while (0)
#define PG8_MMA(ai, bj, At, Bt) do { __builtin_amdgcn_s_setprio(1); _Pragma("unroll") for (int m = 0; m < 4; ++m) _Pragma("unroll") for (int n = 0; n < 2; ++n) _Pragma("unroll") for (int k = 0; k < 2; ++k) \
        acc[ai][bj][m][n] = __builtin_amdgcn_mfma_f32_16x16x32_bf16(Bt[n][k], At[m][k], acc[ai][bj][m][n], 0, 0, 0); __builtin_amdgcn_s_setprio(0); } while (0)
#define PG8_WAIT_V(n) asm volatile("s_waitcnt vmcnt(" #n ")" ::: "memory")
#define PG8_WAIT_L(n) asm volatile("s_waitcnt lgkmcnt(" #n ")" ::: "memory")
#define PG8_BAR __builtin_amdgcn_s_barrier()
#define PG8_SCHED __builtin_amdgcn_sched_barrier(0)
    Unit cur, nxt; int ui = 0;
    if (!S.next(0, cur)) return;
    f32x4 acc[2][2][4][2];
#pragma unroll
    for (int a = 0; a < 2; ++a)
#pragma unroll
        for (int b = 0; b < 2; ++b)
#pragma unroll
            for (int m = 0; m < 4; ++m)
#pragma unroll
                for (int n = 0; n < 2; ++n) acc[a][b][m][n] = (f32x4){0.f, 0.f, 0.f, 0.f};
    bf16x8 At[4][2], B0[2][2], B1[2][2];
    const char* cA = (const char*)g.A + (size_t)cur.pm * tstep; const char* cB = (const char*)g.Bt + (size_t)cur.pn * tstep;
    S.a_ready(cur);
    if constexpr (SP2) {
        PG8_STAGE(PG8_SB(0, 0), cB, voffB); PG8_STAGE(PG8_SB(0, 1), cB + hstep, voffB); PG8_STAGE(PG8_SA(0, 0), cA, voffA); PG8_STAGE(PG8_SA(0, 1), cA + hstep, voffA);
        if (wr == 1) PG8_BAR;
        PG8_WAIT_V(2); PG8_BAR;
        PG8_STAGE(PG8_SB(1, 0), cB + kstep, voffB); PG8_STAGE(PG8_SA(1, 0), cA + kstep, voffA); PG8_STAGE(PG8_SB(1, 1), cB + hstep + kstep, voffB);
        PG8_WAIT_V(6); PG8_BAR;
    } else {
        PG8_STAGE(PG8_SB(0, 0), cB, voffB); PG8_STAGE(PG8_SA(0, 0), cA, voffA); PG8_STAGE(PG8_SB(0, 1), cB + hstep, voffB); PG8_STAGE(PG8_SA(0, 1), cA + hstep, voffA);
        if (wr == 1) PG8_BAR;
        PG8_WAIT_V(4); PG8_BAR;
        PG8_STAGE(PG8_SB(1, 0), cB + kstep, voffB); PG8_STAGE(PG8_SA(1, 0), cA + kstep, voffA); PG8_STAGE(PG8_SB(1, 1), cB + hstep + kstep, voffB);
        PG8_WAIT_V(6); PG8_BAR;
    }
    for (;;) {
        const bool has_next = S.next(ui + 1, nxt);
        const char* nA = has_next ? (const char*)g.A + (size_t)nxt.pm * tstep : cA; const char* nB = has_next ? (const char*)g.Bt + (size_t)nxt.pn * tstep : cB;
        for (int t = 0; t < nt; t += 2) {
            const bool last = (t == nt - 2);
            const char* a1 = cA + (size_t)(t + 1) * kstep;
            const char* a2 = last ? nA : cA + (size_t)(t + 2) * kstep; const char* b2 = last ? nB : cB + (size_t)(t + 2) * kstep;
            const char* a3 = a2 + kstep; const char* b3 = b2 + kstep;
            if (last && has_next) S.a_ready(nxt);
            if constexpr (SP2) {
            PG8_LDB(B0, 0, 0); PG8_LDB(B1, 0, 1); PG8_SCHED; PG8_LDA(At, 0, 0); PG8_STAGE(PG8_SA(1, 1), a1 + hstep, voffA);
            PG8_WAIT_V(8); PG8_WAIT_L(0); PG8_BAR; PG8_MMA(0, 0, At, B0); PG8_MMA(0, 1, At, B1); PG8_BAR; PG8_SCHED;
            PG8_LDA(At, 0, 1); PG8_STAGE(PG8_SB(0, 0), b2, voffB); PG8_STAGE(PG8_SB(0, 1), b2 + hstep, voffB); PG8_STAGE(PG8_SA(0, 0), a2, voffA);
            PG8_WAIT_V(8); PG8_WAIT_L(0); PG8_BAR; PG8_MMA(1, 0, At, B0); PG8_MMA(1, 1, At, B1); PG8_BAR; PG8_SCHED;
            PG8_LDB(B0, 1, 0); PG8_LDB(B1, 1, 1); PG8_SCHED; PG8_LDA(At, 1, 0); PG8_STAGE(PG8_SA(0, 1), a2 + hstep, voffA);
            PG8_WAIT_V(8); PG8_WAIT_L(0); PG8_BAR; PG8_MMA(0, 0, At, B0); PG8_MMA(0, 1, At, B1); PG8_BAR; PG8_SCHED;
            PG8_LDA(At, 1, 1); PG8_STAGE(PG8_SB(1, 0), b3, voffB); PG8_STAGE(PG8_SB(1, 1), b3 + hstep, voffB); PG8_STAGE(PG8_SA(1, 0), a3, voffA);
            PG8_WAIT_V(8); PG8_WAIT_L(0); PG8_BAR; PG8_MMA(1, 0, At, B0); PG8_MMA(1, 1, At, B1); PG8_BAR; PG8_SCHED;
            } else {
            PG8_LDB(B0, 0, 0); PG8_SCHED; PG8_LDA(At, 0, 0); PG8_STAGE(PG8_SA(1, 1), a1 + hstep, voffA);
            PG8_WAIT_L(8); PG8_BAR; PG8_WAIT_L(0); PG8_MMA(0, 0, At, B0); PG8_BAR; PG8_SCHED;
            PG8_LDB(B1, 0, 1); PG8_STAGE(PG8_SB(0, 0), b2, voffB);
            PG8_BAR; PG8_WAIT_L(0); PG8_MMA(0, 1, At, B1); PG8_BAR;
            PG8_LDA(At, 0, 1); PG8_STAGE(PG8_SA(0, 0), a2, voffA);
            PG8_BAR; PG8_WAIT_L(0); PG8_MMA(1, 0, At, B0); PG8_BAR; PG8_SCHED;
            PG8_STAGE(PG8_SB(0, 1), b2 + hstep, voffB);
            PG8_WAIT_V(6); PG8_BAR; PG8_MMA(1, 1, At, B1); PG8_BAR;
            PG8_LDB(B0, 1, 0); PG8_SCHED; PG8_LDA(At, 1, 0); PG8_STAGE(PG8_SA(0, 1), a2 + hstep, voffA);
            PG8_WAIT_L(8); PG8_BAR; PG8_WAIT_L(0); PG8_MMA(0, 0, At, B0); PG8_BAR; PG8_SCHED;
            PG8_LDB(B1, 1, 1); PG8_STAGE(PG8_SB(1, 0), b3, voffB);
            PG8_BAR; PG8_WAIT_L(0); PG8_MMA(0, 1, At, B1); PG8_BAR;
            PG8_LDA(At, 1, 1); PG8_STAGE(PG8_SA(1, 0), a3, voffA);
            PG8_BAR; PG8_WAIT_L(0); PG8_MMA(1, 0, At, B0); PG8_BAR; PG8_SCHED;
            PG8_STAGE(PG8_SB(1, 1), b3 + hstep, voffB);
            PG8_WAIT_V(6); PG8_BAR; PG8_MMA(1, 1, At, B1); PG8_BAR;
            }
        }
        if constexpr (ALIGN_EPI) { if (wr == 0) PG8_BAR; }
        if constexpr (!Epi::AFTER_DRAIN) { E(acc, cur, wr, wc, fr, fq); S.done(cur); }
        if (!has_next) break;
#pragma unroll
        for (int a = 0; a < 2; ++a)
#pragma unroll
            for (int b = 0; b < 2; ++b)
#pragma unroll
                for (int m = 0; m < 4; ++m)
#pragma unroll
                    for (int n = 0; n < 2; ++n) acc[a][b][m][n] = (f32x4){0.f, 0.f, 0.f, 0.f};
        cur = nxt; cA = nA; cB = nB; ++ui;
        if constexpr (ALIGN_EPI) { if (wr == 1) PG8_BAR; }
    }
    PG8_WAIT_V(0);
    if constexpr (!ALIGN_EPI) { if (wr == 0) PG8_BAR; }
    PG8_BAR;
    if constexpr (Epi::AFTER_DRAIN) { E.fused(acc, cur, wr, wc, fr, fq, lds, wid, lane); S.done(cur); }
#undef PG8_SA
#undef PG8_SB
#undef PG8_STAGE
#undef PG8_LDA
#undef PG8_LDB
#undef PG8_MMA
#undef PG8_WAIT_V
#undef PG8_WAIT_L
#undef PG8_BAR
#undef PG8_SCHED
}
}

#define LAS __attribute__((address_space(3)))
using pg8::ex2; using pg8::rcpf_;
typedef unsigned short u16;
typedef short bf16x8 __attribute__((ext_vector_type(8)));
typedef float f32x4 __attribute__((ext_vector_type(4)));
typedef float f32x16 __attribute__((ext_vector_type(16)));
typedef unsigned u32x4 __attribute__((ext_vector_type(4)));
typedef unsigned u32x2 __attribute__((ext_vector_type(2)));

constexpr int DM = 1024, NB = 16, SEQ = 2048, MTOK = NB * SEQ, DEPTH = 4, DFF = 2816, INW = 2840, PW = 3072;
constexpr int C_MQ = 0, C_MK = 256, C_MV = 512, C_DQ = 768, C_DK = 1024, C_DV = 1280, C_NQ = 1536, C_NKC = 2048, C_NVC = 2176, C_NKS = 2304, C_NVS = 2432, C_NKW = 2560, C_NVW = 2688, C_NG = 2816;
constexpr int NVH = 12;
constexpr float LOG2E = 1.4426950408889634f, NEGF = -1e30f;
constexpr int NPH_L = 14, NPH = NPH_L * DEPTH + 1;
constexpr size_t MiB = 1u << 20;
constexpr size_t WS_GU1 = 1 * MiB, WS_DN1 = 12 * MiB, WS_GU2 = WS_DN1 + 5 * MiB + MiB / 2, WS_DN2 = WS_GU2 + 11 * MiB, WS_WIN = 34 * MiB, WS_WOUT = 40 * MiB, WS_W1 = 42 * MiB;
constexpr size_t WS_PROJ = 44 * MiB, WS_XN = 236 * MiB, WS_VT = 300 * MiB, WS_HID = 348 * MiB, WS_KCMP = 352 * MiB, WS_VCMPT = WS_KCMP + MiB / 2, WS_KMEAN = 353 * MiB, WS_SEL = WS_KMEAN + MiB / 4, WS_XB = 354 * MiB, WS_SS = 418 * MiB, WS_END = 420 * MiB;
static_assert(WS_DN2 + 5 * MiB + MiB / 2 == WS_WIN, "ws map");
constexpr int LDS_BYTES = 147456, MISC_OFF = 147456 - 64, RTAB_OFF = 131072;
constexpr size_t WS_CTL = 0, CTL_ZERO_BYTES = 262144;
constexpr int ATT_K = 0, ATT_V = 32768, ATT_LUT = 65536, ATT_PARK = 68608;
constexpr int CMP_K = 0, CMP_V = 18432, CMP_A = 36864, CMP_H = CMP_A + 256 * 33 * 4;

struct Params {
    const float* x; const float* rel_bias; const float* norm_ffn1; const float* ffn1_gate; const float* ffn1_up; const float* ffn1_down;
    const float* norm_mix; const float* w_in; const float* diff_lambda; const float* diff_subln; const float* cmp_pe; const float* cmp_w1; const float* cmp_w2;
    const float* w_out; const float* norm_ffn2; const float* ffn2_gate; const float* ffn2_up; const float* ffn2_down; const float* final_norm;
    float* out; unsigned char* ws;
    float lam_init[4];
    int ph_lo, ph_hi;
};
typedef const __attribute__((address_space(4))) Params* KParamsPtr;

__device__ __forceinline__ float bf2f(unsigned v) { return __uint_as_float(v << 16); }
typedef float f32x2_t __attribute__((ext_vector_type(2))); typedef __bf16 bf16x2_t __attribute__((ext_vector_type(2)));
__device__ __forceinline__ unsigned pkbf(float lo, float hi) { f32x2_t v = {lo, hi}; bf16x2_t b = __builtin_convertvector(v, bf16x2_t); return __builtin_bit_cast(unsigned, b); }
__device__ __forceinline__ int lane_opaque() { int l; asm volatile("v_mbcnt_lo_u32_b32 %0, -1, 0\n\tv_mbcnt_hi_u32_b32 %0, -1, %0" : "=v"(l)); return l; }
__device__ __forceinline__ float wave_sum(float v, int lane) {
#pragma unroll
    for (int o = 1; o < 64; o <<= 1) v += __int_as_float(__builtin_amdgcn_ds_bpermute((lane ^ o) << 2, __float_as_int(v)));
    return v;
}
__device__ __forceinline__ float xhalf_max(float v) { auto rr = __builtin_amdgcn_permlane32_swap(__float_as_uint(v), __float_as_uint(v), false, false); return fmaxf(__uint_as_float(rr[0]), __uint_as_float(rr[1])); }
__device__ __forceinline__ float xhalf_sum(float v) { auto rr = __builtin_amdgcn_permlane32_swap(__float_as_uint(v), __float_as_uint(v), false, false); return __uint_as_float(rr[0]) + __uint_as_float(rr[1]); }
__device__ __forceinline__ float sigmoid_f(float x) { return rcpf_(1.0f + ex2(-LOG2E * x)); }
__device__ __forceinline__ int crow(int r, int hi) { return (r & 3) + 8 * (r >> 2) + 4 * hi; }
__device__ __forceinline__ int kperm(int p) { const int h = p >> 3, j = p & 7; return 8 * (j >> 2) + 4 * h + (j & 3); }
__device__ __forceinline__ int pperm(int k) { return ((k >> 2) & 1) * 8 + (k >> 3) * 4 + (k & 3); }

__device__ __forceinline__ void tr_item(const float* W, int K, int N, u16* WT, int kb, int n0, int dst_row0, LAS float* scr, int lane, float cs = 1.0f, const float* gk = nullptr) {
    const int k0 = 64 * kb; const int n = n0 + (lane & 31); const bool ok = n < N;
    float wv[32];
#pragma unroll
    for (int i = 0; i < 32; ++i) { const int kk = 2 * i + (lane >> 5); wv[i] = ok ? W[(size_t)(k0 + kk) * N + n] : 0.f; }
#pragma unroll
    for (int i = 0; i < 32; ++i) { const int kk = 2 * i + (lane >> 5); scr[kk * 33 + (lane & 31)] = wv[i] * (gk ? gk[k0 + kk] * cs : cs); }
    asm volatile("s_waitcnt lgkmcnt(0)" ::: "memory");
    const int c = lane & 7;
#pragma unroll
    for (int j = 0; j < 4; ++j) { const int nn = (lane >> 3) + 8 * j; const LAS float* s = scr + (8 * c) * 33 + nn;
        u32x4 o; o.x = pkbf(s[0 * 33], s[1 * 33]); o.y = pkbf(s[2 * 33], s[3 * 33]); o.z = pkbf(s[4 * 33], s[5 * 33]); o.w = pkbf(s[6 * 33], s[7 * 33]);
        *(u32x4*)(WT + (size_t)(dst_row0 + nn) * K + k0 + 8 * c) = o; }
    asm volatile("s_waitcnt lgkmcnt(0)" ::: "memory");
}

__device__ __forceinline__ void norm_row(const float* xrow, const u16* xrow16, const float* g, u16* dst16, float* dst32, u16* xb0, int lane) {
    float v[16];
    if (xrow) { const f32x4* xr = (const f32x4*)xrow + 4 * lane;
#pragma unroll
        for (int j = 0; j < 4; ++j) { const f32x4 t = xr[j]; v[4 * j] = t.x; v[4 * j + 1] = t.y; v[4 * j + 2] = t.z; v[4 * j + 3] = t.w; }
        if (xb0) { u32x4 o0, o1; o0.x = pkbf(v[0], v[1]); o0.y = pkbf(v[2], v[3]); o0.z = pkbf(v[4], v[5]); o0.w = pkbf(v[6], v[7]); o1.x = pkbf(v[8], v[9]); o1.y = pkbf(v[10], v[11]); o1.z = pkbf(v[12], v[13]); o1.w = pkbf(v[14], v[15]);
            ((u32x4*)xb0)[2 * lane] = o0; ((u32x4*)xb0)[2 * lane + 1] = o1; }
    } else { const u32x4 p0 = ((const u32x4*)xrow16)[2 * lane], p1 = ((const u32x4*)xrow16)[2 * lane + 1];
        v[0] = bf2f(p0.x & 0xffffu); v[1] = bf2f(p0.x >> 16); v[2] = bf2f(p0.y & 0xffffu); v[3] = bf2f(p0.y >> 16); v[4] = bf2f(p0.z & 0xffffu); v[5] = bf2f(p0.z >> 16); v[6] = bf2f(p0.w & 0xffffu); v[7] = bf2f(p0.w >> 16);
        v[8] = bf2f(p1.x & 0xffffu); v[9] = bf2f(p1.x >> 16); v[10] = bf2f(p1.y & 0xffffu); v[11] = bf2f(p1.y >> 16); v[12] = bf2f(p1.z & 0xffffu); v[13] = bf2f(p1.z >> 16); v[14] = bf2f(p1.w & 0xffffu); v[15] = bf2f(p1.w >> 16); }
    float s = 0.f;
#pragma unroll
    for (int j = 0; j < 16; ++j) s = fmaf(v[j], v[j], s);
    const float rstd = 1.0f / sqrtf(wave_sum(s, lane) * (1.0f / 1024.0f) + 1e-6f);
    const f32x4* gr = (const f32x4*)g + 4 * lane;
#pragma unroll
    for (int j = 0; j < 4; ++j) { const f32x4 gg = gr[j]; v[4 * j] *= rstd * gg.x; v[4 * j + 1] *= rstd * gg.y; v[4 * j + 2] *= rstd * gg.z; v[4 * j + 3] *= rstd * gg.w; }
    if (dst16) { u32x4 o0, o1; o0.x = pkbf(v[0], v[1]); o0.y = pkbf(v[2], v[3]); o0.z = pkbf(v[4], v[5]); o0.w = pkbf(v[6], v[7]); o1.x = pkbf(v[8], v[9]); o1.y = pkbf(v[10], v[11]); o1.z = pkbf(v[12], v[13]); o1.w = pkbf(v[14], v[15]);
        ((u32x4*)dst16)[2 * lane] = o0; ((u32x4*)dst16)[2 * lane + 1] = o1; }
    else {
#pragma unroll
        for (int j = 0; j < 4; ++j) ((f32x4*)dst32)[4 * lane + j] = (f32x4){v[4 * j], v[4 * j + 1], v[4 * j + 2], v[4 * j + 3]}; }
}

struct AState { f32x16 o0, o1; float m, l; };
__device__ __forceinline__ void astate_init(AState& s) {
#pragma unroll
    for (int r = 0; r < 16; ++r) { s.o0[r] = 0.f; s.o1[r] = 0.f; }
    s.m = 0.f; s.l = 0.f;
}
constexpr float ATT_THR = 8.0f;
constexpr int ATT_SLOT = 9216, ATT_NSLOT = 3;
template <int KS0, int NKS>
__device__ __forceinline__ void qk_block(const LAS unsigned char* Ks, const bf16x8 (&qr)[4], int r32, int hi, f32x16& s0, f32x16& s1) {
    f32x16 ci;
#pragma unroll
    for (int r = 0; r < 16; ++r) ci[r] = 0.f;
    const LAS unsigned char* kp = Ks + hi * 1024 + r32 * 16;
#pragma unroll
    for (int ks = 0; ks < NKS; ++ks) {
        const bf16x8 a0 = *(const LAS bf16x8*)(kp + (KS0 + ks) * 2048);
        const bf16x8 a1 = *(const LAS bf16x8*)(kp + (KS0 + ks) * 2048 + 512);
        s0 = __builtin_amdgcn_mfma_f32_32x32x16_bf16(a0, qr[KS0 + ks], ks == 0 ? ci : s0, 0, 0, 0);
        s1 = __builtin_amdgcn_mfma_f32_32x32x16_bf16(a1, qr[KS0 + ks], ks == 0 ? ci : s1, 0, 0, 0);
    }
    __builtin_amdgcn_sched_group_barrier(0x100, 2 * NKS, 0); __builtin_amdgcn_sched_group_barrier(0x008, 2 * NKS, 0);
}
__device__ __forceinline__ void pv_block(const LAS unsigned char* Vs, const u32x4 (&pk)[4], int r32, int hi, AState& st) {
    const LAS unsigned char* vp = Vs + hi * 1024 + r32 * 16;
#pragma unroll
    for (int c = 0; c < 4; ++c) {
        const bf16x8 v0 = *(const LAS bf16x8*)(vp + c * 2048);
        const bf16x8 v1 = *(const LAS bf16x8*)(vp + c * 2048 + 512);
        const bf16x8 pb = __builtin_bit_cast(bf16x8, pk[c]);
        st.o0 = __builtin_amdgcn_mfma_f32_32x32x16_bf16(v0, pb, st.o0, 0, 0, 0);
        st.o1 = __builtin_amdgcn_mfma_f32_32x32x16_bf16(v1, pb, st.o1, 0, 0, 0);
    }
    __builtin_amdgcn_sched_group_barrier(0x100, 8, 0); __builtin_amdgcn_sched_group_barrier(0x008, 8, 0);
}
__device__ __forceinline__ void glds16(const void* gsrc, unsigned lds_dst) { unsigned keep;
    asm volatile("s_mov_b32 %0, m0\n\ts_mov_b32 m0, %2\n\ts_nop 0\n\tglobal_load_lds_dwordx4 %1, off\n\ts_mov_b32 m0, %0" : "=&s"(keep) : "v"(gsrc), "s"(lds_dst) : "memory"); }
__device__ __forceinline__ void lut_add(f32x16& s0, f32x16& s1, const LAS float* lutz, int dbase, float cc) {
    const LAS float* lp = lutz + (dbase - 59);
#pragma unroll
    for (int r = 0; r < 16; ++r) { const int ko = (r & 3) + 8 * (r >> 2);
        s0[r] += lp[59 - ko] + cc; s1[r] += lp[27 - ko] + cc; }
}
__device__ __forceinline__ void const_add(f32x16& s0, f32x16& s1, float cc) {
#pragma unroll
    for (int r = 0; r < 16; ++r) { s0[r] += cc; s1[r] += cc; }
}
__device__ __forceinline__ float row_max(const f32x16& s0, const f32x16& s1) {
    float mx = fmaxf(s0[0], s1[0]);
#pragma unroll
    for (int r = 1; r < 16; ++r) mx = fmaxf(mx, fmaxf(s0[r], s1[r]));
    return xhalf_max(mx);
}
__device__ __forceinline__ void rescale(AState& st, f32x16& s0, f32x16& s1, float mx) {
    const float dl = fmaxf(mx, 0.f); const float f = ex2(-dl); st.m += dl; st.l *= f;
#pragma unroll
    for (int r = 0; r < 16; ++r) { st.o0[r] *= f; st.o1[r] *= f; s0[r] -= dl; s1[r] -= dl; }
}
__device__ __forceinline__ void exp_pack(f32x16& s0, f32x16& s1, u32x4 (&pk)[4], AState& st) {
    float sum = 0.f;
#pragma unroll
    for (int r = 0; r < 16; ++r) { s0[r] = ex2(s0[r]); s1[r] = ex2(s1[r]); sum += s0[r] + s1[r]; }
    st.l += sum;
    pk[0] = (u32x4){pkbf(s0[0], s0[1]), pkbf(s0[2], s0[3]), pkbf(s0[4], s0[5]), pkbf(s0[6], s0[7])};
    pk[1] = (u32x4){pkbf(s0[8], s0[9]), pkbf(s0[10], s0[11]), pkbf(s0[12], s0[13]), pkbf(s0[14], s0[15])};
    pk[2] = (u32x4){pkbf(s1[0], s1[1]), pkbf(s1[2], s1[3]), pkbf(s1[4], s1[5]), pkbf(s1[6], s1[7])};
    pk[3] = (u32x4){pkbf(s1[8], s1[9]), pkbf(s1[10], s1[11]), pkbf(s1[12], s1[13]), pkbf(s1[14], s1[15])};
}

template <int KS0, int NKS, bool WINDOW, int MODE>
__device__ __forceinline__ void run_tiles(LAS unsigned char* lds, int t0, int t1, const u16* Kg, const u16* Vtg, const bf16x8 (&qr)[4], float c31,
                                          int q0w, unsigned mask, int qb, AState& A, int wave, int lane, int r32, int hi) {
    LAS unsigned char* Kr = lds + ATT_K; LAS unsigned char* Vr = lds + ATT_V; const LAS float* lut1 = (const LAS float*)(lds + ATT_LUT) + 96;
    const u16* ksrc = Kg + (size_t)lane * PW + wave * 8;
    const u16* vsrc = Vtg + (size_t)lane * SEQ + wave * 8;
    const unsigned kdst = (unsigned)(uintptr_t)Kr + wave * 1024, vdst = (unsigned)(uintptr_t)Vr + wave * 1024;
#define TCL(t) ((t) < t0 ? t0 : ((t) > t1 ? t1 : (t)))
#define DMA_K(tn) glds16(ksrc + (size_t)TCL(tn) * 64 * PW, (unsigned)__builtin_amdgcn_readfirstlane(kdst + ((tn) & 3) * 8192))
#define DMA_V(tn) glds16(vsrc + TCL(tn) * 64, (unsigned)__builtin_amdgcn_readfirstlane(vdst + ((tn) & 3) * 8192))
#define KS_(t) (Kr + ((t) & 3) * 8192)
#define VS_(t) (Vr + ((t) & 3) * 8192)
#define WAIT_BAR4() asm volatile("s_waitcnt vmcnt(4) lgkmcnt(0)\n\ts_barrier" ::: "memory")
#define T_ACTIVE(t) (!((q0w + 31 - (t) * 64) < 0 || (WINDOW && (q0w - ((t) * 64 + 63)) >= 512)))
#define T_LUTMODE(t) (((q0w - ((t) * 64 + 63)) < 128) || (WINDOW && (q0w + 31 - (t) * 64) >= 512))
    auto tile_sel = [&](int t) -> int { if (MODE == 1) { const int blk = t >> 2; return blk < qb ? (int)((mask >> blk) & 1u) : 1; } if (MODE == 2) return (int)((mask >> t) & 1u); return 1; };
    asm volatile("s_waitcnt vmcnt(0)" ::: "memory");
#pragma unroll
    for (int j = 0; j < 4; ++j) { DMA_K(t0 + j); DMA_V(t0 + j - 2); }
    WAIT_BAR4();
    f32x16 sn0, sn1, sc0, sc1; u32x4 pk[4];
#pragma unroll
    for (int r = 0; r < 16; ++r) { sn0[r] = 0.f; sn1[r] = 0.f; }
#pragma unroll
    for (int i = 0; i < 4; ++i) pk[i] = (u32x4){0u, 0u, 0u, 0u};
    bool act_n = T_ACTIVE(t0), act_c = false, act_p = false;
    if (act_n) qk_block<KS0, NKS>(KS_(t0), qr, r32, hi, sn0, sn1);
    asm volatile("s_waitcnt lgkmcnt(0)\n\ts_barrier" ::: "memory");
    for (int c = t0; c <= t1 + 1; ++c) {
        act_p = act_c; act_c = act_n; sc0 = sn0; sc1 = sn1;
        DMA_K(c + 4); DMA_V(c + 2);
        act_n = (c + 1 <= t1) && T_ACTIVE(c + 1);
        const bool lm_c = T_LUTMODE(c);
        const int dbase = q0w + r32 - c * 64 - 4 * hi;
        const float selc = tile_sel(c) ? (lm_c ? 0.f : c31) : NEGF;
        if (act_p) pv_block(VS_(c - 1), pk, r32, hi, A);
        if (act_c) {
            if (lm_c) lut_add(sc0, sc1, lut1, dbase, selc - A.m); else const_add(sc0, sc1, selc - A.m);
            const float mx = row_max(sc0, sc1);
            if (__any(mx > ATT_THR)) rescale(A, sc0, sc1, mx);
        }
        if (act_n) qk_block<KS0, NKS>(KS_(c + 1), qr, r32, hi, sn0, sn1);
        if (act_c) exp_pack(sc0, sc1, pk, A);
        WAIT_BAR4();
    }
    asm volatile("s_waitcnt vmcnt(0) lgkmcnt(0)\n\ts_barrier" ::: "memory");
#undef TCL
#undef DMA_K
#undef DMA_V
#undef KS_
#undef VS_
#undef WAIT_BAR4
#undef T_ACTIVE
#undef T_LUTMODE
}

__device__ __forceinline__ void build_lut(LAS unsigned char* lds, const float* rel_bias, int head, bool window, int tid) {
    LAS float* lut = (LAS float*)(lds + ATT_LUT);
    for (int i = tid; i < 704; i += 512) {
        const int d = i - 96; float v;
        if (d < 0) v = NEGF;
        else if (d >= 512) v = window ? NEGF : rel_bias[31 * 16 + head] * LOG2E;
        else { int bk;
            if (d < 16) bk = d; else if (d >= 128) bk = 31; else { bk = 16 + (int)(log2f((float)d * (1.0f / 16.0f)) * (16.0f / 3.0f)); bk = bk > 31 ? 31 : bk; }
            v = rel_bias[bk * 16 + head] * LOG2E; }
        lut[i] = v;
    }
}
__device__ __forceinline__ void load_q(bf16x8 (&qr)[4], const u16* qrow, int hi) {
#pragma unroll
    for (int ks = 0; ks < 4; ++ks) qr[ks] = *(const bf16x8*)(qrow + ks * 16 + hi * 8);
}
__device__ __forceinline__ void store_o(u16* dst, const f32x16& v0, const f32x16& v1, int hi) {
#pragma unroll
    for (int g = 0; g < 4; ++g) {
        u32x2 a; a.x = pkbf(v0[4 * g], v0[4 * g + 1]); a.y = pkbf(v0[4 * g + 2], v0[4 * g + 3]); *(u32x2*)(dst + 8 * g + 4 * hi) = a;
        u32x2 b; b.x = pkbf(v1[4 * g], v1[4 * g + 1]); b.y = pkbf(v1[4 * g + 2], v1[4 * g + 3]); *(u32x2*)(dst + 32 + 8 * g + 4 * hi) = b;
    }
}

struct Ctx { LAS unsigned char* lds; int tid, lane, wave, r32, hi, G, bx; u16* proj; u16* obuf; u16* vt; };

__device__ __forceinline__ void moba_unit(const Ctx& C0, KParamsPtr P, int b, int h, int qb) {
    Ctx C = C0; C.lane = lane_opaque(); C.tid = C.wave * 64 + C.lane; C.r32 = C.lane & 31; C.hi = C.lane >> 5;
    const int q0w = __builtin_amdgcn_readfirstlane(qb * 256 + C.wave * 32); const int qpos = q0w + C.r32; const size_t tok = (size_t)b * SEQ + qpos;
    build_lut(C.lds, P->rel_bias, h, false, C.tid);
    const u16* qrow = C.proj + tok * PW + C_MQ + h * 64;
    bf16x8 qr[4]; load_q(qr, qrow, C.hi);
    unsigned mask = 0;
    if (qb > 0) {
        float g[7];
#pragma unroll
        for (int j = 0; j < 7; ++j) g[j] = 0.f;
        const float* km = (const float*)(P->ws + WS_KMEAN) + (size_t)((b * 4 + h) * 8) * 64;
#pragma unroll
        for (int dc = 0; dc < 8; ++dc) {
            const u32x4 qv = *(const u32x4*)(qrow + dc * 8);
            float qf[8]; qf[0] = bf2f(qv.x & 0xffffu); qf[1] = bf2f(qv.x >> 16); qf[2] = bf2f(qv.y & 0xffffu); qf[3] = bf2f(qv.y >> 16);
            qf[4] = bf2f(qv.z & 0xffffu); qf[5] = bf2f(qv.z >> 16); qf[6] = bf2f(qv.w & 0xffffu); qf[7] = bf2f(qv.w >> 16);
#pragma unroll
            for (int j = 0; j < 7; ++j) if (j < qb) { const float* kmj = km + j * 64 + dc * 8;
#pragma unroll
                for (int e = 0; e < 8; ++e) g[j] = fmaf(qf[e], kmj[e], g[j]); }
        }
#pragma unroll
        for (int j = 0; j < 7; ++j) if (j < qb) { int rank = 0;
#pragma unroll
            for (int i = 0; i < 7; ++i) if (i != j && i < qb) rank += (g[i] > g[j] || (g[i] == g[j] && i < j)) ? 1 : 0;
            if (rank < 3) mask |= 1u << j; }
    }
    AState A; astate_init(A);
    const float c31 = P->rel_bias[31 * 16 + h] * LOG2E;
    run_tiles<0, 4, false, 1>(C.lds, 0, 4 * qb + 3, C.proj + (size_t)b * SEQ * PW + C_MK + h * 64, C.vt + (size_t)((b * NVH + h) * 64) * SEQ, qr, c31, q0w, mask, qb, A, C.wave, C.lane, C.r32, C.hi);
    const float inv = rcpf_(xhalf_sum(A.l));
    A.o0 *= inv; A.o1 *= inv;
    { const int l2 = lane_opaque(); const size_t tok2 = (size_t)b * SEQ + q0w + (l2 & 31);
      store_o(C.obuf + tok2 * DM + h * 64, A.o0, A.o1, l2 >> 5); }
}

__device__ __forceinline__ void diff_unit(const Ctx& C0, KParamsPtr P, int layer, int b, int h, int qb) {
    Ctx C = C0; C.lane = lane_opaque(); C.tid = C.wave * 64 + C.lane; C.r32 = C.lane & 31; C.hi = C.lane >> 5;
    const int q0w = __builtin_amdgcn_readfirstlane(qb * 256 + C.wave * 32); const int qpos = q0w + C.r32; const size_t tok = (size_t)b * SEQ + qpos;
    build_lut(C.lds, P->rel_bias, 4 + h, false, C.tid);
    bf16x8 qr[4]; load_q(qr, C.proj + tok * PW + C_DQ + h * 64, C.hi);
    AState A; astate_init(A);
    const float c31 = P->rel_bias[31 * 16 + 4 + h] * LOG2E;
    const u16* Kg = C.proj + (size_t)b * SEQ * PW + C_DK + h * 64; const u16* Vg = C.vt + (size_t)((b * NVH + 4 + h) * 64) * SEQ;
    run_tiles<0, 2, false, 0>(C.lds, 0, 4 * qb + 3, Kg, Vg, qr, c31, q0w, 0u, 0, A, C.wave, C.lane, C.r32, C.hi);
    LAS float* park = (LAS float*)(C.lds + ATT_PARK) + C.tid;
    { const float i0 = rcpf_(xhalf_sum(A.l));
#pragma unroll
      for (int r = 0; r < 16; ++r) { park[r * 512] = A.o0[r] * i0; park[(16 + r) * 512] = A.o1[r] * i0; } }
    astate_init(A);
    run_tiles<2, 2, false, 0>(C.lds, 0, 4 * qb + 3, Kg, Vg, qr, c31, q0w, 0u, 0, A, C.wave, C.lane, C.r32, C.hi);
    const float* lp = P->diff_lambda + (size_t)layer * 128; float d01 = 0.f, d23 = 0.f;
    for (int i = 0; i < 32; ++i) { d01 = fmaf(lp[i], lp[32 + i], d01); d23 = fmaf(lp[64 + i], lp[96 + i], d23); }
    const float li = P->lam_init[layer]; const float lam = expf(d01) - expf(d23) + li;
    const float i1 = lam * rcpf_(xhalf_sum(A.l));
    float ss = 0.f;
#pragma unroll
    for (int r = 0; r < 16; ++r) { A.o0[r] = park[r * 512] - A.o0[r] * i1; A.o1[r] = park[(16 + r) * 512] - A.o1[r] * i1; ss += A.o0[r] * A.o0[r] + A.o1[r] * A.o1[r]; }
    ss = xhalf_sum(ss);
    const float rstd = (1.0f / sqrtf(ss * (1.0f / 64.0f) + 1e-6f)) * (1.0f - li);
    const float* sg = P->diff_subln + (size_t)layer * 64;
#pragma unroll
    for (int r = 0; r < 16; ++r) { const int d = crow(r, C.hi); A.o0[r] *= rstd * sg[d]; A.o1[r] *= rstd * sg[32 + d]; }
    { const int l2 = lane_opaque(); const size_t tok2 = (size_t)b * SEQ + q0w + (l2 & 31);
      store_o(C.obuf + tok2 * DM + 256 + h * 64, A.o0, A.o1, l2 >> 5); }
}

__device__ __forceinline__ void nsa_unit(const Ctx& C0, KParamsPtr P, int b, int hq, int qb) {
    Ctx C = C0; C.lane = lane_opaque(); C.tid = C.wave * 64 + C.lane; C.r32 = C.lane & 31; C.hi = C.lane >> 5;
    const int g = hq >> 2;
    const int q0w = __builtin_amdgcn_readfirstlane(qb * 256 + C.wave * 32); const int qpos = q0w + C.r32; const size_t tok = (size_t)b * SEQ + qpos;
    build_lut(C.lds, P->rel_bias, 8 + hq, false, C.tid);
    bf16x8 qr[4]; load_q(qr, C.proj + tok * PW + C_NQ + hq * 64, C.hi);
    const u16* gl = C.proj + tok * PW + C_NG + hq * 3;
    const float g1 = sigmoid_f(bf2f(gl[1])), g2 = sigmoid_f(bf2f(gl[2]));
    const unsigned mask = ((const unsigned*)(P->ws + WS_SEL))[(size_t)(b * 2 + g) * SEQ + qpos];
    const float c31 = P->rel_bias[31 * 16 + 8 + hq] * LOG2E;
    AState A; astate_init(A);
    run_tiles<0, 4, false, 2>(C.lds, 0, 4 * qb + 3, C.proj + (size_t)b * SEQ * PW + C_NKS + g * 64, C.vt + (size_t)((b * NVH + 8 + g) * 64) * SEQ, qr, c31, q0w, mask, qb, A, C.wave, C.lane, C.r32, C.hi);
    LAS float* park = (LAS float*)(C.lds + ATT_PARK) + C.tid;
    { const float f = g1 * rcpf_(xhalf_sum(A.l));
#pragma unroll
      for (int r = 0; r < 16; ++r) { park[r * 512] = A.o0[r] * f; park[(16 + r) * 512] = A.o1[r] * f; } }
    if (C.tid < 96) ((LAS float*)(C.lds + ATT_LUT))[608 + C.tid] = NEGF;
    astate_init(A);
    const int tw0 = 4 * qb - 8 < 0 ? 0 : 4 * qb - 8;
    run_tiles<0, 4, true, 0>(C.lds, tw0, 4 * qb + 3, C.proj + (size_t)b * SEQ * PW + C_NKW + g * 64, C.vt + (size_t)((b * NVH + 10 + g) * 64) * SEQ, qr, c31, q0w, 0u, qb, A, C.wave, C.lane, C.r32, C.hi);
    { const float f = g2 * rcpf_(xhalf_sum(A.l));
#pragma unroll
      for (int r = 0; r < 16; ++r) { A.o0[r] = A.o0[r] * f + park[r * 512]; A.o1[r] = A.o1[r] * f + park[(16 + r) * 512]; } }
    const int l2 = lane_opaque(); const int hi2 = l2 >> 5;
    u16* dst = C.obuf + ((size_t)b * SEQ + q0w + (l2 & 31)) * DM + 512 + hq * 64;
#pragma unroll
    for (int gg = 0; gg < 4; ++gg) {
        const u32x2 a = *(const u32x2*)(dst + 8 * gg + 4 * hi2), bq = *(const u32x2*)(dst + 32 + 8 * gg + 4 * hi2);
        A.o0[4 * gg] += bf2f(a.x & 0xffffu); A.o0[4 * gg + 1] += bf2f(a.x >> 16); A.o0[4 * gg + 2] += bf2f(a.y & 0xffffu); A.o0[4 * gg + 3] += bf2f(a.y >> 16);
        A.o1[4 * gg] += bf2f(bq.x & 0xffffu); A.o1[4 * gg + 1] += bf2f(bq.x >> 16); A.o1[4 * gg + 2] += bf2f(bq.y & 0xffffu); A.o1[4 * gg + 3] += bf2f(bq.y >> 16);
    }
    store_o(dst, A.o0, A.o1, hi2);
}

__device__ __forceinline__ void cmp_unit(const Ctx& C0, KParamsPtr P, int b, int g, int qblk) {
    Ctx C = C0; C.lane = lane_opaque(); C.tid = C.wave * 64 + C.lane; C.r32 = C.lane & 31; C.hi = C.lane >> 5;
    LAS unsigned char* lds = C.lds; const int tid = C.tid, r32 = C.r32, hi = C.hi;
    const u16* kc = (const u16*)(P->ws + WS_KCMP) + (size_t)(b * 2 + g) * 128 * 64;
    const u16* vc = (const u16*)(P->ws + WS_VCMPT) + (size_t)(b * 2 + g) * 64 * 128;
#pragma unroll
    for (int i = 0; i < 2; ++i) { const int e = tid + 512 * i;
        { const int row = e >> 3, ch = e & 7; *(LAS u32x4*)(lds + CMP_K + row * 144 + ch * 16) = *(const u32x4*)(kc + row * 64 + ch * 8); }
        { const int row = e >> 4, ch = e & 15; *(LAS u32x4*)(lds + CMP_V + row * 272 + ch * 16) = *(const u32x4*)(vc + row * 128 + ch * 8); } }
    const int q0w = __builtin_amdgcn_readfirstlane(qblk * 256 + C.wave * 32); const int qpos = q0w + r32; const size_t tok = (size_t)b * SEQ + qpos;
    const int nmax = (qpos - 31) >> 4;
    __syncthreads();
    float qa[16], qh[16];
#pragma unroll
    for (int i = 0; i < 16; ++i) { qa[i] = 0.f; qh[i] = 0.f; }
    const LAS unsigned char* kp = lds + CMP_K + r32 * 144 + hi * 16;
    const LAS unsigned char* vp = lds + CMP_V + r32 * 272 + hi * 16;
    bf16x8 qn[4]; load_q(qn, C.proj + tok * PW + C_NQ + g * 4 * 64, hi);
    for (int rh = 0; rh < 4; ++rh) {
        const int hq = g * 4 + rh;
        bf16x8 qr[4];
#pragma unroll
        for (int ks = 0; ks < 4; ++ks) qr[ks] = qn[ks];
        load_q(qn, C.proj + tok * PW + C_NQ + (g * 4 + (rh < 3 ? rh + 1 : rh)) * 64, hi);
        const float g0 = sigmoid_f(bf2f(C.proj[tok * PW + C_NG + hq * 3]));
        f32x16 s[4];
#pragma unroll
        for (int kb = 0; kb < 4; ++kb) {
#pragma unroll
            for (int r = 0; r < 16; ++r) s[kb][r] = 0.f;
#pragma unroll
            for (int ks = 0; ks < 4; ++ks) { const bf16x8 a = *(const LAS bf16x8*)(kp + kb * 32 * 144 + ks * 32); s[kb] = __builtin_amdgcn_mfma_f32_32x32x16_bf16(a, qr[ks], s[kb], 0, 0, 0); }
        }
        float mx = NEGF;
#pragma unroll
        for (int kb = 0; kb < 4; ++kb)
#pragma unroll
            for (int r = 0; r < 16; ++r) { const int n = 32 * kb + crow(r, hi); const float v = (n <= nmax) ? s[kb][r] : NEGF; s[kb][r] = v; mx = fmaxf(mx, v); }
        mx = xhalf_max(mx);
        float sum = 0.f;
#pragma unroll
        for (int kb = 0; kb < 4; ++kb)
#pragma unroll
            for (int r = 0; r < 16; ++r) { const int n = 32 * kb + crow(r, hi); const float pv = (n <= nmax) ? ex2(s[kb][r] - mx) : 0.f; s[kb][r] = pv; sum += pv; }
        sum = xhalf_sum(sum);
        const float inv = nmax >= 0 ? rcpf_(sum) : 0.f;
        f32x16 o0, o1;
#pragma unroll
        for (int r = 0; r < 16; ++r) { o0[r] = 0.f; o1[r] = 0.f; }
#pragma unroll
        for (int kb = 0; kb < 4; ++kb) {
#pragma unroll
            for (int r = 0; r < 16; ++r) s[kb][r] *= inv;
#pragma unroll
            for (int g4 = 0; g4 < 4; ++g4) { const float h = 0.5f * s[kb][4 * g4 + 3]; qh[kb * 4 + g4] += h; qa[kb * 4 + g4] += (s[kb][4 * g4] + s[kb][4 * g4 + 1]) + (s[kb][4 * g4 + 2] + h); }
#pragma unroll
            for (int c = 0; c < 2; ++c) {
                const u32x4 pk = (u32x4){pkbf(s[kb][8 * c], s[kb][8 * c + 1]), pkbf(s[kb][8 * c + 2], s[kb][8 * c + 3]), pkbf(s[kb][8 * c + 4], s[kb][8 * c + 5]), pkbf(s[kb][8 * c + 6], s[kb][8 * c + 7])};
                const bf16x8 pb = __builtin_bit_cast(bf16x8, pk);
                const bf16x8 v0 = *(const LAS bf16x8*)(vp + (kb * 2 + c) * 32);
                const bf16x8 v1 = *(const LAS bf16x8*)(vp + 32 * 272 + (kb * 2 + c) * 32);
                o0 = __builtin_amdgcn_mfma_f32_32x32x16_bf16(v0, pb, o0, 0, 0, 0);
                o1 = __builtin_amdgcn_mfma_f32_32x32x16_bf16(v1, pb, o1, 0, 0, 0);
            }
            __builtin_amdgcn_sched_barrier(0);
        }
        o0 *= g0; o1 *= g0;
        store_o(C.obuf + tok * DM + 512 + hq * 64, o0, o1, hi);
    }
    LAS float* Aq = (LAS float*)(lds + CMP_A) + (C.wave * 32 + r32) * 33; LAS float* Hq = (LAS float*)(lds + CMP_H) + (C.wave * 32 + r32) * 33;
#pragma unroll
    for (int kb = 0; kb < 4; ++kb)
#pragma unroll
        for (int g4 = 0; g4 < 4; ++g4) { const int j = 8 * kb + 2 * g4 + hi; Aq[j] = qa[kb * 4 + g4]; Hq[j] = qh[kb * 4 + g4]; }
    __syncthreads();
    const int cur = q0w >> 6;
    unsigned bits = 0;
    if (cur < 16) bits = (2u << cur) - 1u;
    else {
        float sc[32];
#pragma unroll
        for (int i = 0; i < 32; ++i) { const float imp = Aq[i] + (i > 0 ? Hq[i - 1] : 0.f); sc[i] = (i > cur) ? -3.0e38f : ((i == 0 || i > cur - 2) ? 1e4f : imp); }
#pragma unroll
        for (int e = 0; e < 16; ++e) {
            const float sj = hi ? sc[16 + e] : sc[e]; int rank = 0;
#pragma unroll
            for (int i = 0; i < 32; ++i) { const bool lt = (i < e) || (hi && i < 16 + e);
                rank += (sc[i] > sj || (sc[i] == sj && lt)) ? 1 : 0; }
            const int j = hi * 16 + e;
            if (j <= cur && rank < 16) bits |= 1u << j; }
        { auto rr = __builtin_amdgcn_permlane32_swap(bits, bits, false, false); bits = rr[0] | rr[1]; }
    }
    if (hi == 0) ((unsigned*)(P->ws + WS_SEL))[(size_t)(b * 2 + g) * SEQ + qpos] = bits;
    __syncthreads();
}

__device__ __forceinline__ void prep_vk(const Ctx& C, KParamsPtr P, int b0) {
    const int G = C.G - b0, bxr = C.bx - b0, tid = C.tid, lane = C.lane;
    if (bxr < 0) return;
    for (int it = bxr; it < NB * NVH * 32; it += G) {
        const int tb = it & 31, hv = (it >> 5) % NVH, b = it / (32 * NVH);
        const int vcol = hv < 4 ? C_MV + hv * 64 : hv < 8 ? C_DV + (hv - 4) * 64 : hv < 10 ? C_NVS + (hv - 8) * 64 : C_NVW + (hv - 10) * 64;
        { const int row = tid >> 3, ch = tid & 7; *(LAS u32x4*)(C.lds + row * 144 + ch * 16) = *(const u32x4*)(C.proj + ((size_t)b * SEQ + tb * 64 + row) * PW + vcol + ch * 8); }
        __syncthreads();
        { const int d = tid >> 3, pc = tid & 7; unsigned w[4];
#pragma unroll
            for (int e = 0; e < 4; ++e) { const int p0 = pc * 8 + 2 * e, p1 = p0 + 1; const int k0 = (p0 & ~15) + kperm(p0 & 15), k1 = (p1 & ~15) + kperm(p1 & 15);
                const unsigned a = *(const LAS u16*)(C.lds + k0 * 144 + d * 2), bb = *(const LAS u16*)(C.lds + k1 * 144 + d * 2); w[e] = a | (bb << 16); }
            *(u32x4*)(C.vt + ((size_t)(b * NVH + hv) * 64 + d) * SEQ + tb * 64 + pc * 8) = (u32x4){w[0], w[1], w[2], w[3]}; }
        __syncthreads();
    }
    const int gw = bxr * 8 + C.wave, NGW = G * 8;
    for (int it = gw; it < NB * 4 * 8; it += NGW) {
        const int blk = it & 7, h = (it >> 3) & 3, b = it >> 5;
        const u16* kp = C.proj + ((size_t)b * SEQ + blk * 256) * PW + C_MK + h * 64 + lane; float s = 0.f;
        for (int k = 0; k < 256; k += 8) { float t[8];
#pragma unroll
            for (int e = 0; e < 8; ++e) t[e] = bf2f(kp[(size_t)(k + e) * PW]);
            s += ((t[0] + t[1]) + (t[2] + t[3])) + ((t[4] + t[5]) + (t[6] + t[7])); }
        ((float*)(P->ws + WS_KMEAN))[(size_t)it * 64 + lane] = s * (1.0f / 256.0f);
    }
}
__device__ __forceinline__ void prep_a(const Ctx& C, KParamsPtr P, int layer) {
    const int G = C.G, lane = C.lane;
    const int gw = C.bx * 8 + C.wave, NGW = G * 8;
    u16* acmp = (u16*)(P->ws + WS_XN);
    for (int it = gw; it < 2 * 4096; it += NGW) {
        const int i = it >> 12, row = it & 4095, n = row & 127, bg = row >> 7, b = bg >> 1, g = bg & 1;
        u16* dst = acmp + (size_t)it * 2048; const float* pe = P->cmp_pe + (size_t)(layer * 2 + i) * 2048;
        const int col = (i == 0 ? C_NKC : C_NVC) + g * 64;
#pragma unroll
        for (int pass = 0; pass < 4; ++pass) { const int l = pass * 8 + (lane >> 3), d0 = (lane & 7) * 8;
            unsigned z0 = 0u; asm volatile("" : "+v"(z0)); u32x4 o = (u32x4){z0, z0, z0, z0};
            if (n < 127) { const u32x4 v = *(const u32x4*)(C.proj + ((size_t)b * SEQ + 16 * n + l) * PW + col + d0); const f32x4 e0 = *(const f32x4*)(pe + l * 64 + d0), e1 = *(const f32x4*)(pe + l * 64 + d0 + 4);
                o.x = pkbf(bf2f(v.x & 0xffffu) + e0.x, bf2f(v.x >> 16) + e0.y); o.y = pkbf(bf2f(v.y & 0xffffu) + e0.z, bf2f(v.y >> 16) + e0.w);
                o.z = pkbf(bf2f(v.z & 0xffffu) + e1.x, bf2f(v.z >> 16) + e1.y); o.w = pkbf(bf2f(v.w & 0xffffu) + e1.z, bf2f(v.w >> 16) + e1.w); }
            *(u32x4*)(dst + l * 64 + d0) = o; }
    }
}
__device__ __forceinline__ void prep_c(const Ctx& C, KParamsPtr P, int layer, int it0) {
    const int i = it0 >> 12, row0 = it0 & 4095, lane = lane_opaque(), tid = C.wave * 64 + lane, r32 = lane & 31, hi = lane >> 5;
    const float* w2 = P->cmp_w2 + (size_t)(layer * 2 + i) * 256 * 64;
    for (int e = tid; e < 256 * 64; e += 512) { const int k = e >> 6, c = e & 63; *(LAS u16*)(C.lds + c * 528 + k * 2) = (u16)(pkbf(w2[e], 0.f) & 0xffffu); }
    __syncthreads();
    const int wrow = row0 + C.wave * 32;
    const u16* hrow = (const u16*)(P->ws + WS_HID) + ((size_t)i * 4096 + wrow + r32) * 256 + hi * 8;
    f32x16 d0, d1;
#pragma unroll
    for (int r = 0; r < 16; ++r) { d0[r] = 0.f; d1[r] = 0.f; }
#pragma unroll 4
    for (int ks = 0; ks < 16; ++ks) {
        const bf16x8 a = *(const bf16x8*)(hrow + ks * 16);
        const bf16x8 b0 = *(const LAS bf16x8*)(C.lds + r32 * 528 + (ks * 16 + hi * 8) * 2);
        const bf16x8 b1 = *(const LAS bf16x8*)(C.lds + (32 + r32) * 528 + (ks * 16 + hi * 8) * 2);
        d0 = __builtin_amdgcn_mfma_f32_32x32x16_bf16(a, b0, d0, 0, 0, 0);
        d1 = __builtin_amdgcn_mfma_f32_32x32x16_bf16(a, b1, d1, 0, 0, 0);
    }
#pragma unroll
    for (int r = 0; r < 16; ++r) { const int row = wrow + crow(r, hi);
        const unsigned v0 = pkbf(d0[r], 0.f) & 0xffffu, v1 = pkbf(d1[r], 0.f) & 0xffffu;
        if (i == 0) { u16* o = (u16*)(P->ws + WS_KCMP) + (size_t)row * 64; o[r32] = (u16)v0; o[32 + r32] = (u16)v1; }
        else { const int bg = row >> 7, n = row & 127; u16* o = (u16*)(P->ws + WS_VCMPT) + (size_t)bg * 64 * 128 + (n & ~15) + pperm(n & 15); o[(size_t)r32 * 128] = (u16)v0; o[(size_t)(32 + r32) * 128] = (u16)v1; }
    }
}

__device__ __forceinline__ void convert_weights(const Ctx& C, KParamsPtr P, int layer) {
    LAS float* scr = (LAS float*)(C.lds + C.wave * 16384);
    const int gw = C.bx * 8 + C.wave, NGW = C.G * 8, lane = C.lane;
    constexpr int I_G = 16 * 88, I_D = 44 * 32, I_IN = 16 * 96, I_O = 16 * 32, I_W1 = 32 * 8;
    constexpr int NIT = 4 * I_G + 2 * I_D + I_IN + I_O + 2 * I_W1;
    unsigned char* ws = P->ws;
    for (int it = gw; it < NIT; it += NGW) {
        int r = it;
        if (r < 4 * I_G) { const int which = r / I_G; r -= which * I_G; const int kb = r / 88, nb = r % 88, n0 = nb * 32;
            const float* W = (which == 0 ? P->ffn1_gate : which == 1 ? P->ffn1_up : which == 2 ? P->ffn2_gate : P->ffn2_up) + (size_t)layer * DM * DFF;
            u16* WT = (u16*)(ws + (which < 2 ? WS_GU1 : WS_GU2));
            tr_item(W, DM, DFF, WT, kb, n0, (n0 >> 7) * 256 + (which & 1) * 128 + (n0 & 127), scr, lane, 1.0f, (which < 2 ? P->norm_ffn1 : P->norm_ffn2) + (size_t)layer * DM); continue; }
        r -= 4 * I_G;
        if (r < 2 * I_D) { const int which = r / I_D; r -= which * I_D; const int kb = r / 32, nb = r % 32;
            const float* W = (which == 0 ? P->ffn1_down : P->ffn2_down) + (size_t)layer * DFF * DM;
            tr_item(W, DFF, DM, (u16*)(ws + (which == 0 ? WS_DN1 : WS_DN2)), kb, nb * 32, nb * 32, scr, lane); continue; }
        r -= 2 * I_D;
        if (r < I_IN) { const int kb = r / 96, nb = r % 96, n0 = nb * 32;
            const float cs = (n0 < C_MK || (n0 >= C_NQ && n0 < C_NKC)) ? 0.125f * LOG2E : (n0 >= C_DQ && n0 < C_DK) ? 0.17677669529663687f * LOG2E : 1.0f;
            tr_item(P->w_in + (size_t)layer * DM * INW, DM, INW, (u16*)(ws + WS_WIN), kb, n0, n0, scr, lane, cs, P->norm_mix + (size_t)layer * DM); continue; }
        r -= I_IN;
        if (r < I_O) { const int kb = r / 32, nb = r % 32; tr_item(P->w_out + (size_t)layer * DM * DM, DM, DM, (u16*)(ws + WS_WOUT), kb, nb * 32, nb * 32, scr, lane); continue; }
        r -= I_O;
        { const int i = r / I_W1; r -= i * I_W1; const int kb = r / 8, nb = r % 8;
            tr_item(P->cmp_w1 + (size_t)(layer * 2 + i) * 2048 * 256, 2048, 256, (u16*)(ws + WS_W1) + (size_t)i * 256 * 2048, kb, nb * 32, nb * 32, scr, lane); }
    }
}
__device__ __forceinline__ void norm_phase(const Ctx& C, const float* src32, const u16* src16, const float* g, u16* dst16, float* dst32, u16* xb0) {
    const int gw = C.bx * 8 + C.wave, NGW = C.G * 8;
    for (int m = gw; m < MTOK; m += NGW) norm_row(src32 ? src32 + (size_t)m * DM : nullptr, src16 ? src16 + (size_t)m * DM : nullptr, g, dst16 ? dst16 + (size_t)m * DM : nullptr, dst32 ? dst32 + (size_t)m * DM : nullptr, xb0 ? xb0 + (size_t)m * DM : nullptr, C.lane);
}

#define XB_TMO      128
#define XB_XCNT(j)  (256  + 64 * (j))
#define XB_XSUB(j)  (1280 + 64 * (j))
#define XB_XGEN(j)  (2304 + 64 * (j))
#define XB_TOP      3328
#define XB_TOPGEN   3392
#define XCD_BAR_WORDS 3456
#define XB_SPIN_CAP (1u << 18)

__device__ __forceinline__ unsigned xb_ld(unsigned* p)              { return __hip_atomic_load(p, __ATOMIC_RELAXED, __HIP_MEMORY_SCOPE_AGENT); }
__device__ __forceinline__ unsigned xb_add(unsigned* p, unsigned v) { return __hip_atomic_fetch_add(p, v, __ATOMIC_RELAXED, __HIP_MEMORY_SCOPE_AGENT); }
__device__ __forceinline__ unsigned xb_xcc_id() { return (unsigned)__builtin_amdgcn_s_getreg((3 << 11) | 20) & 0xFu; }
#define XB_SPIN(cond, bar) do { unsigned _sp = 0; while (cond) { __builtin_amdgcn_s_sleep(1); \
    if ((++_sp & 255u) == 0u) { if (xb_ld(&(bar)[XB_TMO])) break; if (_sp > XB_SPIN_CAP) { atomicAdd(&(bar)[XB_TMO], 1u); break; } } } } while (0)

struct XcdBarrier {
    unsigned* bar; unsigned x;
    volatile LAS unsigned* st;
};

__device__ __forceinline__ XcdBarrier xcd_barrier_post(unsigned* bar, volatile LAS unsigned* st) {
    XcdBarrier b; b.bar = bar; b.x = xb_xcc_id(); b.st = st;
    if (threadIdx.x == 0) (void)xb_add(&bar[XB_XCNT(b.x)], 1u);
    return b;
}
__device__ __forceinline__ void xcd_barrier_complete(unsigned* bar, unsigned x, unsigned& nloc, unsigned& nx) {
    const unsigned G = gridDim.x * gridDim.y * gridDim.z;
    unsigned sum, cnt, mine, sp = 0u;
    for (;;) {
        sum = 0u; cnt = 0u; mine = 0u;
#pragma unroll
        for (unsigned j = 0; j < 16; ++j) { const unsigned c = xb_ld(&bar[XB_XCNT(j)]); sum += c; cnt += (c > 0u) ? 1u : 0u; mine = (j == x) ? c : mine; }
        if (sum == G) break;
        __builtin_amdgcn_s_sleep(1);
        if ((++sp & 255u) == 0u) { if (xb_ld(&bar[XB_TMO])) break; if (sp > XB_SPIN_CAP) { atomicAdd(&bar[XB_TMO], 1u); break; } }
    }
    nloc = mine > 0u ? mine : 1u; nx = cnt > 0u ? cnt : 1u;
}

__device__ __forceinline__ void xcd_barrier(const XcdBarrier& b) {
    asm volatile("s_waitcnt vmcnt(0)" ::: "memory");
    __syncthreads();
    if (threadIdx.x == 0) {
        unsigned* bar = b.bar;
        __builtin_amdgcn_s_waitcnt(0);
        unsigned nloc = b.st[0], nx = b.st[1];
        if (nloc == 0u) { xcd_barrier_complete(bar, b.x, nloc, nx); b.st[0] = nloc; b.st[1] = nx; }
        const unsigned old = xb_add(&bar[XB_XSUB(b.x)], 1u);
        const unsigned gen = old / nloc;
        if (old + 1u == (gen + 1u) * nloc) {
            __builtin_amdgcn_fence(__ATOMIC_RELEASE, "agent");
            asm volatile("s_waitcnt vmcnt(0)" ::: "memory");
            const unsigned og = xb_add(&bar[XB_TOP], 1u);
            const unsigned tg = og / nx;
            if (og + 1u == (tg + 1u) * nx) xb_add(&bar[XB_TOPGEN], 1u);
            else XB_SPIN(xb_ld(&bar[XB_TOPGEN]) == tg, bar);
            __builtin_amdgcn_fence(__ATOMIC_ACQUIRE, "agent");
            xb_add(&bar[XB_XGEN(b.x)], 1u);
            asm volatile("s_waitcnt vmcnt(0)" ::: "memory");
        } else {
            XB_SPIN(xb_ld(&bar[XB_XGEN(b.x)]) == gen, bar);
            __builtin_amdgcn_fence(__ATOMIC_ACQUIRE, "agent");
            asm volatile("s_waitcnt vmcnt(0)" ::: "memory");
        }
    }
    __syncthreads();
}


__device__ __forceinline__ void fill_rtab(const Ctx& C, const pg8::StaticOrder& S, const float* SS, LAS float* rtab) {
    LAS int* pml = (LAS int*)(rtab + 11 * 256);
    int nu = 0; { pg8::Unit u_; for (int i_ = 0; i_ < 11 && S.next(i_, u_); ++i_) { if (C.tid == 0) pml[i_] = u_.pm; nu = i_ + 1; } }
    __syncthreads();
    const int tot = nu * 256; float rsv[6];
#pragma unroll
    for (int k = 0; k < 6; ++k) { const int e = C.tid + 512 * k; rsv[k] = e < tot ? pg8::row_rstd(SS, pml[e >> 8] * 256 + (e & 255)) : 0.f; }
#pragma unroll
    for (int k = 0; k < 6; ++k) { const int e = C.tid + 512 * k; if (e < tot) rtab[e] = rsv[k]; }
    __syncthreads();
}
__device__ __forceinline__ void x0_phase(const Ctx& C, const float* src, u16* xb, float* ss) {
    const int gw = C.bx * 8 + C.wave, NGW = C.G * 8, lane = C.lane;
    for (int m = gw; m < MTOK; m += NGW) {
        const f32x4* xr = (const f32x4*)(src + (size_t)m * DM) + lane; float s = 0.f;
#pragma unroll
        for (int j = 0; j < 4; ++j) { const f32x4 v = xr[64 * j]; s += (v.x * v.x + v.y * v.y) + (v.z * v.z + v.w * v.w);
            u32x2 o; o.x = pkbf(v.x, v.y); o.y = pkbf(v.z, v.w); *((u32x2*)(xb + (size_t)m * DM) + lane + 64 * j) = o; }
        s = wave_sum(s, lane);
        if (lane < 16) ss[(size_t)m * 16 + lane] = lane == 0 ? s : 0.f;
    }
}
__device__ __forceinline__ void unit_publish(unsigned* flag, int tid) {
    asm volatile("s_waitcnt vmcnt(0)" ::: "memory"); __syncthreads();
    if (tid == 0) { __builtin_amdgcn_fence(__ATOMIC_RELEASE, "agent"); asm volatile("s_waitcnt vmcnt(0)" ::: "memory"); __hip_atomic_store(flag, 1u, __ATOMIC_RELAXED, __HIP_MEMORY_SCOPE_AGENT); }
}
__device__ __forceinline__ void unit_wait(unsigned* f0, unsigned* f1, int tid) {
    if (tid == 0) { unsigned sp = 0;
        while ((__hip_atomic_load(f0, __ATOMIC_RELAXED, __HIP_MEMORY_SCOPE_AGENT) == 0u || __hip_atomic_load(f1, __ATOMIC_RELAXED, __HIP_MEMORY_SCOPE_AGENT) == 0u) && ++sp < (1u << 24)) __builtin_amdgcn_s_sleep(8);
        __builtin_amdgcn_fence(__ATOMIC_ACQUIRE, "agent"); asm volatile("s_waitcnt vmcnt(0)" ::: "memory"); }
    __syncthreads();
}
struct OneUnit { int pm;
    __device__ __forceinline__ bool next(int i, pg8::Unit& u) const { if (i) return false; u.pm = pm; u.pn = 0; return true; }
    __device__ __forceinline__ void a_ready(const pg8::Unit&) const {}
    __device__ __forceinline__ void done(const pg8::Unit&) const {} };
__global__ void __launch_bounds__(512, 2) hybrid_fwd(Params P0) {
    extern __shared__ __attribute__((aligned(16))) unsigned char lds_raw[];
    const KParamsPtr kp0 = (KParamsPtr)__builtin_amdgcn_kernarg_segment_ptr();
    cg::grid_group grid = cg::this_grid();
    { volatile LAS unsigned* misc = (volatile LAS unsigned*)((LAS unsigned char*)lds_raw + MISC_OFF); if (threadIdx.x < 2) misc[threadIdx.x] = 0u; }
    __syncthreads();
    XcdBarrier bar = xcd_barrier_post((unsigned*)(P0.ws + WS_CTL) + 1024, (volatile LAS unsigned*)((LAS unsigned char*)lds_raw + MISC_OFF));
    const int ph_lo = P0.ph_lo, ph_hi = P0.ph_hi; const int wave_s = __builtin_amdgcn_readfirstlane(threadIdx.x >> 6);
    bool redone = false; (void)redone;
    for (int ph = ph_lo; ph < ph_hi; ++ph) {
        KParamsPtr kpl = kp0; asm volatile("" : "+s"(kpl));
        const KParamsPtr P = kpl; unsigned char* ws = P->ws;
        u16* XN = (u16*)(ws + WS_XN); u16* HB = (u16*)(ws + WS_PROJ);
        int G = gridDim.x, bx = blockIdx.x; asm volatile("" : "+s"(G), "+s"(bx));
        Ctx C; C.G = G; C.bx = bx; C.lds = (LAS unsigned char*)lds_raw; C.wave = wave_s; C.lane = lane_opaque(); C.tid = wave_s * 64 + C.lane; C.r32 = C.lane & 31; C.hi = C.lane >> 5;
        C.proj = (u16*)(ws + WS_PROJ); C.obuf = (u16*)(ws + WS_XN); C.vt = (u16*)(ws + WS_VT);
        const int layer = ph / NPH_L, s = ph % NPH_L;
        if (ph != NPH - 1 && (s == 7 || s == 3 || s == 11 || s == 8 || s == 9)) continue;
        float* SS = (float*)(ws + WS_SS);
        u16* XB = (u16*)(ws + WS_XB);
        if (ph == NPH - 1) { norm_phase(C, nullptr, XB, P->final_norm, nullptr, P->out, nullptr); }
        else switch (s) {
        case 0: { convert_weights(C, P, layer); if (layer == 0) { __syncthreads(); x0_phase(C, P->x, XB, SS); } } break;
#ifndef NO_GEMM
#ifndef NO_G1
        case 1: case 12: {
            pg8::Gemm g{XB, (const u16*)(ws + (s == 1 ? WS_GU1 : WS_GU2)), MTOK, 2 * DFF, DM}; pg8::StaticOrder S; S.init(MTOK, 2 * DFF, G, bx);
            LAS float* rtab = (LAS float*)(C.lds + RTAB_OFF); fill_rtab(C, S, SS, rtab);
            pg8::EpiSwiGLU E{HB, DFF, rtab, 0};
            pg8::gemm_phase<pg8::EpiSwiGLU, pg8::StaticOrder, true, true>(C.lds, g, S, E, C.wave); } break;
#endif
#ifndef NO_G2
        case 2: case 13: case 10: {
            const u16* A = (s == 10) ? (const u16*)XN : (const u16*)HB; const u16* Bt = (const u16*)(ws + (s == 2 ? WS_DN1 : s == 13 ? WS_DN2 : WS_WOUT));
            pg8::Gemm g{A, Bt, MTOK, DM, s == 10 ? DM : DFF}; pg8::StaticOrder S; S.init(MTOK, DM, G, bx);
            pg8::EpiResid E{XB, DM, s == 10 ? 1.0f : 0.5f, SS};
            pg8::gemm_phase<pg8::EpiResid, pg8::StaticOrder, false, true>(C.lds, g, S, E, C.wave); } break;
#endif
#ifndef NO_G4
        case 4: {
            pg8::Gemm g{XB, (const u16*)(ws + WS_WIN), MTOK, PW, DM}; pg8::StaticOrder S; S.init(MTOK, PW, G, bx);
            LAS float* rtab = (LAS float*)(C.lds + RTAB_OFF); fill_rtab(C, S, SS, rtab);
            pg8::EpiBf16<0> E{C.proj, PW, rtab, 0};
            pg8::gemm_phase<pg8::EpiBf16<0>, pg8::StaticOrder, true, true>(C.lds, g, S, E, C.wave); } break;
#endif
#endif
#ifndef NO_PREP
        case 5: prep_a(C, P, layer); prep_vk(C, P, 0); break;
#endif
#if !defined(NO_GEMM) && !defined(NO_G6)
        case 6: {
            unsigned* ctl = (unsigned*)(ws + WS_CTL); unsigned* qctr = ctl + 8192 + 64 * ph + (redone ? 32 : 0); unsigned* fcomp = ctl + 16384 + 64 * ph; unsigned* fcmp = ctl + 24576 + 256 * (ph / NPH_L);
            volatile LAS unsigned* qslot = (volatile LAS unsigned*)(C.lds + MISC_OFF + 16);
            for (;;) {
                if (C.tid == 0) *qslot = __hip_atomic_fetch_add(qctr, 1u, __ATOMIC_RELAXED, __HIP_MEMORY_SCOPE_AGENT);
                __syncthreads();
                const unsigned u = *qslot;
                __syncthreads();
                if (u >= 32u + 512u + 256u + 1024u + 512u) break;
                if (u < 32u) { const int i = (int)u >> 4, tile = (int)u & 15;
                    pg8::Gemm g{(const u16*)XN + (size_t)i * 4096 * 2048, (const u16*)(ws + WS_W1) + (size_t)i * 256 * 2048, 4096, 256, 2048}; OneUnit S{tile};
                    pg8::EpiBf16<1> E{(u16*)(ws + WS_HID) + (size_t)i * 4096 * 256, 256, nullptr, 0};
                    pg8::gemm_phase<pg8::EpiBf16<1>, OneUnit, true, true>(C.lds, g, S, E, C.wave);
                    __builtin_amdgcn_fence(__ATOMIC_RELEASE, "agent"); __syncthreads(); __builtin_amdgcn_fence(__ATOMIC_ACQUIRE, "agent");
                    prep_c(C, P, layer, i * 4096 + tile * 256);
                    unit_publish(fcomp + u, C.tid);
                    __syncthreads();
                } else if (u < 544u || u >= 1824u) { const unsigned v = u < 544u ? u - 32u : u - 1824u + 512u; const int qb = 7 - (int)(v >> 7), w = (int)(v & 127);
                    if (w < 64) {
#ifndef NO_DIFF
                        diff_unit(C, P, layer, w >> 2, w & 3, qb);
#endif
                    } else {
#ifndef NO_MOBA
                        moba_unit(C, P, (w - 64) >> 2, w & 3, qb);
#endif
                    }
                } else if (u < 800u) { const int c = (int)u - 544, qblk = 7 - (c >> 5), bg = c & 31;
                    unit_wait(fcomp + (bg >> 1), fcomp + 16 + (bg >> 1), C.tid);
#ifndef NO_CMP
                    cmp_unit(C, P, bg >> 1, bg & 1, qblk);
#endif
                    unit_publish(fcmp + bg * 8 + qblk, C.tid);
                    __syncthreads();
                } else { const int v = (int)u - 800, qb = 7 - (v >> 7), b = (v & 127) >> 3, hq = v & 7; unsigned* f = fcmp + (b * 2 + (hq >> 2)) * 8 + qb;
                    unit_wait(f, f, C.tid);
#ifndef NO_ATT2
                    nsa_unit(C, P, b, hq, qb);
#endif
                }
            } } break;
#endif
        default: break;
        }
        if (ph + 1 < ph_hi) { if (ph == ph_lo) grid.sync(); else xcd_barrier(bar); }
#ifdef PROBE_LO
        if (ph != NPH - 1 && s == PROBE_HI) { if (!redone) { ph -= (PROBE_HI - PROBE_LO + 1); redone = true; } else redone = false; }
#endif
#ifdef PROBE_SYNC
        if (ph + 1 < ph_hi) xcd_barrier(bar);
#endif
    }
}

#ifndef COOP
#define COOP 1
#endif
extern "C" void kernel_launch(void* const* d_in, const int* in_sizes, int n_in, void* d_out, int out_size, void* d_ws, size_t ws_size, hipStream_t stream) {
    static int grid = 0;
    if (grid == 0) {
        if (n_in != 19 || out_size != MTOK * DM || ws_size < WS_END) { fprintf(stderr, "kernel_launch: unexpected shapes (n_in %d out %d ws %zu)\n", n_in, out_size, ws_size); grid = -1; return; }
        int dev = 0, cus = 0, per_cu = 0;
        (void)hipGetDevice(&dev); (void)hipDeviceGetAttribute(&cus, hipDeviceAttributeMultiprocessorCount, dev);
        if (hipFuncSetAttribute((const void*)hybrid_fwd, hipFuncAttributeMaxDynamicSharedMemorySize, LDS_BYTES) != hipSuccess) { fprintf(stderr, "kernel_launch: hipFuncSetAttribute failed\n"); grid = -1; return; }
        if (hipOccupancyMaxActiveBlocksPerMultiprocessor(&per_cu, (const void*)hybrid_fwd, 512, LDS_BYTES) != hipSuccess || per_cu < 1) { fprintf(stderr, "kernel_launch: occupancy query says %d\n", per_cu); per_cu = 1; }
        (void)hipGetLastError();
        grid = cus * per_cu;
    }
    if (grid < 0) return;
    Params p{};
    p.x = (const float*)d_in[0]; p.rel_bias = (const float*)d_in[1]; p.norm_ffn1 = (const float*)d_in[2]; p.ffn1_gate = (const float*)d_in[3]; p.ffn1_up = (const float*)d_in[4]; p.ffn1_down = (const float*)d_in[5];
    p.norm_mix = (const float*)d_in[6]; p.w_in = (const float*)d_in[7]; p.diff_lambda = (const float*)d_in[8]; p.diff_subln = (const float*)d_in[9]; p.cmp_pe = (const float*)d_in[10]; p.cmp_w1 = (const float*)d_in[11];
    p.cmp_w2 = (const float*)d_in[12]; p.w_out = (const float*)d_in[13]; p.norm_ffn2 = (const float*)d_in[14]; p.ffn2_gate = (const float*)d_in[15]; p.ffn2_up = (const float*)d_in[16]; p.ffn2_down = (const float*)d_in[17];
    p.final_norm = (const float*)d_in[18]; p.out = (float*)d_out; p.ws = (unsigned char*)d_ws;
    for (int l = 0; l < 4; ++l) p.lam_init[l] = (float)(0.8 - 0.6 * exp(-0.3 * (double)l));
#if COOP
    if (hipMemsetAsync((char*)d_ws + WS_CTL, 0, CTL_ZERO_BYTES, stream) != hipSuccess) { fprintf(stderr, "kernel_launch: memset of barrier words failed\n"); return; }
    p.ph_lo = 0; p.ph_hi = NPH;
    void* args[] = {&p};
    hipError_t e = hipLaunchCooperativeKernel((const void*)hybrid_fwd, dim3(grid), dim3(512), args, LDS_BYTES, stream);
    if (e != hipSuccess) fprintf(stderr, "cooperative launch failed: %s (grid %d)\n", hipGetErrorString(e), grid);
#else
    for (int ph = 0; ph < NPH; ++ph) { p.ph_lo = ph; p.ph_hi = ph + 1; hipLaunchKernelGGL(hybrid_fwd, dim3(grid), dim3(512), LDS_BYTES, stream, p); }
#endif
}
```

```cpp
#include <hip/hip_runtime.h>
#include <hip/hip_cooperative_groups.h>
#include <cstdio>
#include <cstdint>
#include <cmath>
namespace cg = cooperative_groups;
#define COOP 1
namespace pg8 {
#define PG8_LAS __attribute__((address_space(3)))
typedef unsigned short bf16_t;
typedef short bf16x8 __attribute__((ext_vector_type(8)));
typedef float f32x4 __attribute__((ext_vector_type(4)));
typedef unsigned u32x4 __attribute__((ext_vector_type(4)));
constexpr int BM = 256, BK = 64, HALF = 128, HTB = HALF * BK * 2  , STAGE_BYTES = 8 * HTB, NXCD = 8, WGM = 8;

__host__ __device__ __forceinline__ int lds_byte(int r, int c) { const int st = (r >> 4) * 2 + (c >> 5), rr = r & 15, cc = c & 31, ob = rr * 64 + cc * 2; return st * 1024 + (ob ^ (((ob >> 9) & 1) << 5)); }
__host__ __device__ __forceinline__ void stage_rc(int b, int& R, int& C) { const int st = b / 1024, sb = b % 1024, swz = sb ^ (((sb >> 9) & 1) << 5); R = (st >> 1) * 16 + swz / 64; C = (st & 1) * 32 + (swz % 64) / 2; }
__host__ __device__ __forceinline__ int perm32(int rho) { const int n = rho >> 4, i = rho & 15; return 8 * (i >> 2) + 4 * n + (i & 3); }

struct Unit { int pm, pn; };
struct Gemm { const bf16_t* A; const bf16_t* Bt; int M, N, K; };

struct StaticOrder {
    int nM, nN, nwg, G, c;
    __host__ __device__ void init(int M, int N, int G_, int c_) { nM = M / BM; nN = N / BM; nwg = nM * nN; G = G_; c = c_; }
    __host__ __device__ bool next(int i, Unit& u) const {
        const long L = (long)i * G + c; if (L >= nwg) return false;
        int wgid = (int)L; { const int q = nwg / NXCD, r = nwg % NXCD, xcd = wgid % NXCD, off = wgid / NXCD; wgid = (xcd < r ? xcd * (q + 1) : r * (q + 1) + (xcd - r) * q) + off; }
        const int nig = WGM * nN, gid = wgid / nig, fm = gid * WGM, gsz = (nM - fm) < WGM ? (nM - fm) : WGM;
        u.pm = fm + ((wgid % nig) % gsz); u.pn = (wgid % nig) / gsz; return true;
    }
    __device__ __forceinline__ void a_ready(const Unit&) const {}
    __device__ __forceinline__ void done(const Unit&) const {}
};

__device__ __forceinline__ unsigned cvt_pk_bf16(float lo, float hi) { unsigned r; asm volatile("v_cvt_pk_bf16_f32 %0, %1, %2" : "=v"(r) : "v"(lo), "v"(hi)); return r; }

__device__ __forceinline__ float ex2(float x) { return __builtin_amdgcn_exp2f(x); }
__device__ __forceinline__ float rcpf_(float x) { return __builtin_amdgcn_rcpf(x); }
__device__ __forceinline__ float silu_f(float x) { return x * rcpf_(1.0f + ex2(-1.4426950408889634f * x)); }
__device__ __forceinline__ float gelu_tanh_f(float x) { const float y2 = 2.0f * 0.7978845608028654f * (x + 0.044715f * x * x * x); return x * (1.0f - rcpf_(1.0f + ex2(1.4426950408889634f * y2))); }

__device__ __forceinline__ float row_rstd(const float* ss, int row) {
    const f32x4* p = (const f32x4*)(ss + (size_t)row * 16); const f32x4 a = p[0], b = p[1], c = p[2], d = p[3];
    const float s = ((a[0] + a[1]) + (a[2] + a[3])) + ((b[0] + b[1]) + (b[2] + b[3])) + ((c[0] + c[1]) + (c[2] + c[3])) + ((d[0] + d[1]) + (d[2] + d[3]));
    return 1.0f / sqrtf(s * (1.0f / 1024.0f) + 1e-6f);
}

struct EpiSwiGLU {
    static constexpr bool PERM = true, AFTER_DRAIN = false;
    bf16_t* O; int ldc; const PG8_LAS float* rtab; mutable int ui;
    __device__ __forceinline__ void operator()(const f32x4 (&acc)[2][2][4][2], const Unit& u, int wr, int wc, int fr, int fq) const {
        const int row0 = u.pm * BM + wr * 64 + fr; const int col0 = u.pn * HALF + wc * 32 + 8 * fq;
#pragma unroll
        for (int ai = 0; ai < 2; ++ai)
#pragma unroll
            for (int m = 0; m < 4; ++m) { bf16_t* rowp = O + (size_t)(row0 + ai * HALF + m * 16) * ldc + col0;
                const float rs = rtab[ui * 256 + wr * 64 + fr + ai * HALF + m * 16];
                const f32x4 g0 = acc[ai][0][m][0] * rs, g1 = acc[ai][0][m][1] * rs, u0 = acc[ai][1][m][0] * rs, u1 = acc[ai][1][m][1] * rs;
                u32x4 w; w.x = cvt_pk_bf16(silu_f(g0[0]) * u0[0], silu_f(g0[1]) * u0[1]); w.y = cvt_pk_bf16(silu_f(g0[2]) * u0[2], silu_f(g0[3]) * u0[3]);
                w.z = cvt_pk_bf16(silu_f(g1[0]) * u1[0], silu_f(g1[1]) * u1[1]); w.w = cvt_pk_bf16(silu_f(g1[2]) * u1[2], silu_f(g1[3]) * u1[3]);
                *(u32x4*)rowp = w; asm volatile("" ::: "memory"); }
        ++ui;
    }
};
template <int ACT> struct EpiBf16 {
    static constexpr bool PERM = true, AFTER_DRAIN = false;
    bf16_t* O; int ldc; const PG8_LAS float* rtab; mutable int ui;
    __device__ __forceinline__ void operator()(const f32x4 (&acc)[2][2][4][2], const Unit& u, int wr, int wc, int fr, int fq) const {
        const int row0 = u.pm * BM + wr * 64 + fr; const int col0 = u.pn * BM + wc * 32 + 8 * fq;
#pragma unroll
        for (int ai = 0; ai < 2; ++ai)
#pragma unroll
            for (int m = 0; m < 4; ++m) { bf16_t* rowp = O + (size_t)(row0 + ai * HALF + m * 16) * ldc + col0;
                const float rs = rtab ? rtab[ui * 256 + wr * 64 + fr + ai * HALF + m * 16] : 1.0f;
#pragma unroll
                for (int bj = 0; bj < 2; ++bj) { f32x4 v0 = acc[ai][bj][m][0] * rs, v1 = acc[ai][bj][m][1] * rs;
                    if (ACT == 1) { v0 = (f32x4){gelu_tanh_f(v0[0]), gelu_tanh_f(v0[1]), gelu_tanh_f(v0[2]), gelu_tanh_f(v0[3])}; v1 = (f32x4){gelu_tanh_f(v1[0]), gelu_tanh_f(v1[1]), gelu_tanh_f(v1[2]), gelu_tanh_f(v1[3])}; }
                    u32x4 w; w.x = cvt_pk_bf16(v0[0], v0[1]); w.y = cvt_pk_bf16(v0[2], v0[3]); w.z = cvt_pk_bf16(v1[0], v1[1]); w.w = cvt_pk_bf16(v1[2], v1[3]);
                    *(u32x4*)(rowp + bj * HALF) = w; } asm volatile("" ::: "memory"); }
        ++ui;
    }
};
struct EpiResid {
    static constexpr bool PERM = true, AFTER_DRAIN = false;
    bf16_t* xb; int ldc; float alpha; float* ss;
    __device__ __forceinline__ void operator()(const f32x4 (&acc)[2][2][4][2], const Unit& u, int wr, int wc, int fr, int fq) const {
        const int row0 = u.pm * BM + wr * 64 + fr; const int col0 = u.pn * BM + wc * 32 + 8 * fq; const int lane = fq * 16 + fr;
#pragma unroll
        for (int ai = 0; ai < 2; ++ai) {
            u32x4 pre[4][2];
#pragma unroll
            for (int m = 0; m < 4; ++m)
#pragma unroll
                for (int bj = 0; bj < 2; ++bj) pre[m][bj] = *(const u32x4*)(xb + (size_t)(row0 + ai * HALF + m * 16) * ldc + col0 + bj * HALF);
#pragma unroll
            for (int m = 0; m < 4; ++m) { const int row = row0 + ai * HALF + m * 16; bf16_t* rowp = xb + (size_t)row * ldc + col0; float sq = 0.f;
#pragma unroll
                for (int bj = 0; bj < 2; ++bj) { const u32x4 p = pre[m][bj]; const f32x4 a0 = acc[ai][bj][m][0] * alpha, a1 = acc[ai][bj][m][1] * alpha;
                    const float x0 = __uint_as_float(p.x << 16) + a0[0], x1 = __uint_as_float(p.x & 0xffff0000u) + a0[1], x2 = __uint_as_float(p.y << 16) + a0[2], x3 = __uint_as_float(p.y & 0xffff0000u) + a0[3];
                    const float x4 = __uint_as_float(p.z << 16) + a1[0], x5 = __uint_as_float(p.z & 0xffff0000u) + a1[1], x6 = __uint_as_float(p.w << 16) + a1[2], x7 = __uint_as_float(p.w & 0xffff0000u) + a1[3];
                    sq += ((x0 * x0 + x1 * x1) + (x2 * x2 + x3 * x3)) + ((x4 * x4 + x5 * x5) + (x6 * x6 + x7 * x7));
                    u32x4 w; w.x = cvt_pk_bf16(x0, x1); w.y = cvt_pk_bf16(x2, x3); w.z = cvt_pk_bf16(x4, x5); w.w = cvt_pk_bf16(x6, x7);
                    *(u32x4*)(rowp + bj * HALF) = w; }
                sq += __int_as_float(__builtin_amdgcn_ds_bpermute((lane ^ 16) << 2, __float_as_int(sq)));
                sq += __int_as_float(__builtin_amdgcn_ds_bpermute((lane ^ 32) << 2, __float_as_int(sq)));
                if (fq == 0) ss[(size_t)row * 16 + u.pn * 4 + wc] = sq; }
            asm volatile("" ::: "memory");
        }
    }
};
template <class Epi, class Sched, bool ALIGN_EPI = false, bool SP2 = false>
__device__ __forceinline__ void gemm_phase(PG8_LAS unsigned char* lds, const Gemm g, const Sched& S, const Epi& E, const int wave_in) {
    int tid_l; asm volatile("v_mbcnt_lo_u32_b32 %0, -1, 0\n\tv_mbcnt_hi_u32_b32 %0, -1, %0" : "=v"(tid_l)); tid_l += wave_in * 64;
    const int tid = tid_l, wid = __builtin_amdgcn_readfirstlane(tid >> 6), lane = tid & 63, wr = wid >> 2, wc = wid & 3, fr = lane & 15, fq = lane >> 4;
    const int K = g.K, nt = K / BK;
    unsigned voffA[2], voffB[2];
#pragma unroll
    for (int i = 0; i < 2; ++i) { int R, C; stage_rc(tid * 16 + i * 8192, R, C); const int Rb = Epi::PERM ? ((R & ~31) + perm32(R & 31)) : R;
        voffA[i] = (unsigned)(R * K + C) * 2u; voffB[i] = (unsigned)(Rb * K + C) * 2u; }
    const size_t kstep = (size_t)(BK * 2);
    const size_t hstep = (size_t)HALF * K * 2;
    const size_t tstep = 2 * hstep;
    const unsigned ldsw = (unsigned)wid * 1024u;
    const int aoff = lds_byte(wr * 64 + fr, fq * 8), boff = lds_byte(wc * 32 + fr, fq * 8);
#define PG8_SA(b, h) (((b) * 2 + (h)) * HTB)
#define PG8_SB(b, h) ((4 + (b) * 2 + (h)) * HTB)
#define PG8_STAGE(bufoff, gbase, voff) do { _Pragma("unroll") for (int _i = 0; _i < 2; ++_i) \
        __builtin_amdgcn_global_load_lds((const unsigned*)((const char*)(gbase) + (voff)[_i]), (PG8_LAS unsigned*)(lds + (bufoff) + ldsw + _i * 8192), 16, 0, 0); } while (0)
#define PG8_LDA(dst, b, h) do { _Pragma("unroll") for (int m = 0; m < 4; ++m) _Pragma("unroll") for (int k = 0; k < 2; ++k) dst[m][k] = *(const PG8_LAS bf16x8*)(lds + PG8_SA(b, h) + aoff + m * 2048 + k * 1024); } while (0)
#define PG8_LDB(dst, b, h) do { _Pragma("unroll") for (int n = 0; n < 2; ++n) _Pragma("unroll") for (int k = 0; k < 2; ++k) dst[n][k] = *(const PG8_LAS bf16x8*)(lds + PG8_SB(b, h) + boff + n * 2048 + k * 1024); } while (0)
#define PG8_MMA(ai, bj, At, Bt) do { __builtin_amdgcn_s_setprio(1); _Pragma("unroll") for (int m = 0; m < 4; ++m) _Pragma("unroll") for (int n = 0; n < 2; ++n) _Pragma("unroll") for (int k = 0; k < 2; ++k) \
        acc[ai][bj][m][n] = __builtin_amdgcn_mfma_f32_16x16x32_bf16(Bt[n][k], At[m][k], acc[ai][bj][m][n], 0, 0, 0); __builtin_amdgcn_s_setprio(0); } while (0)
#define PG8_WAIT_V(n) asm volatile("s_waitcnt vmcnt(" #n ")" ::: "memory")
#define PG8_WAIT_L(n) asm volatile("s_waitcnt lgkmcnt(" #n ")" ::: "memory")
#define PG8_BAR __builtin_amdgcn_s_barrier()
#define PG8_SCHED __builtin_amdgcn_sched_barrier(0)
    Unit cur, nxt; int ui = 0;
    if (!S.next(0, cur)) return;
    f32x4 acc[2][2][4][2];
#pragma unroll
    for (int a = 0; a < 2; ++a)
#pragma unroll
        for (int b = 0; b < 2; ++b)
#pragma unroll
            for (int m = 0; m < 4; ++m)
#pragma unroll
                for (int n = 0; n < 2; ++n) acc[a][b][m][n] = (f32x4){0.f, 0.f, 0.f, 0.f};
    bf16x8 At[4][2], B0[2][2], B1[2][2];
    const char* cA = (const char*)g.A + (size_t)cur.pm * tstep; const char* cB = (const char*)g.Bt + (size_t)cur.pn * tstep;
    S.a_ready(cur);
    if constexpr (SP2) {
        PG8_STAGE(PG8_SB(0, 0), cB, voffB); PG8_STAGE(PG8_SB(0, 1), cB + hstep, voffB); PG8_STAGE(PG8_SA(0, 0), cA, voffA); PG8_STAGE(PG8_SA(0, 1), cA + hstep, voffA);
        if (wr == 1) PG8_BAR;
        PG8_WAIT_V(2); PG8_BAR;
        PG8_STAGE(PG8_SB(1, 0), cB + kstep, voffB); PG8_STAGE(PG8_SA(1, 0), cA + kstep, voffA); PG8_STAGE(PG8_SB(1, 1), cB + hstep + kstep, voffB);
        PG8_WAIT_V(6); PG8_BAR;
    } else {
        PG8_STAGE(PG8_SB(0, 0), cB, voffB); PG8_STAGE(PG8_SA(0, 0), cA, voffA); PG8_STAGE(PG8_SB(0, 1), cB + hstep, voffB); PG8_STAGE(PG8_SA(0, 1), cA + hstep, voffA);
        if (wr == 1) PG8_BAR;
        PG8_WAIT_V(4); PG8_BAR;
        PG8_STAGE(PG8_SB(1, 0), cB + kstep, voffB); PG8_STAGE(PG8_SA(1, 0), cA + kstep, voffA); PG8_STAGE(PG8_SB(1, 1), cB + hstep + kstep, voffB);
        PG8_WAIT_V(6); PG8_BAR;
    }
    for (;;) {
        const bool has_next = S.next(ui + 1, nxt);
        const char* nA = has_next ? (const char*)g.A + (size_t)nxt.pm * tstep : cA; const char* nB = has_next ? (const char*)g.Bt + (size_t)nxt.pn * tstep : cB;
        for (int t = 0; t < nt; t += 2) {
            const bool last = (t == nt - 2);
            const char* a1 = cA + (size_t)(t + 1) * kstep;
            const char* a2 = last ? nA : cA + (size_t)(t + 2) * kstep; const char* b2 = last ? nB : cB + (size_t)(t + 2) * kstep;
            const char* a3 = a2 + kstep; const char* b3 = b2 + kstep;
            if (last && has_next) S.a_ready(nxt);
            if constexpr (SP2) {
            PG8_LDB(B0, 0, 0); PG8_LDB(B1, 0, 1); PG8_SCHED; PG8_LDA(At, 0, 0); PG8_STAGE(PG8_SA(1, 1), a1 + hstep, voffA);
            PG8_WAIT_V(8); PG8_WAIT_L(0); PG8_BAR; PG8_MMA(0, 0, At, B0); PG8_MMA(0, 1, At, B1); PG8_BAR; PG8_SCHED;
            PG8_LDA(At, 0, 1); PG8_STAGE(PG8_SB(0, 0), b2, voffB); PG8_STAGE(PG8_SB(0, 1), b2 + hstep, voffB); PG8_STAGE(PG8_SA(0, 0), a2, voffA);
            PG8_WAIT_V(8); PG8_WAIT_L(0); PG8_BAR; PG8_MMA(1, 0, At, B0); PG8_MMA(1, 1, At, B1); PG8_BAR; PG8_SCHED;
            PG8_LDB(B0, 1, 0); PG8_LDB(B1, 1, 1); PG8_SCHED; PG8_LDA(At, 1, 0); PG8_STAGE(PG8_SA(0, 1), a2 + hstep, voffA);
            PG8_WAIT_V(8); PG8_WAIT_L(0); PG8_BAR; PG8_MMA(0, 0, At, B0); PG8_MMA(0, 1, At, B1); PG8_BAR; PG8_SCHED;
            PG8_LDA(At, 1, 1); PG8_STAGE(PG8_SB(1, 0), b3, voffB); PG8_STAGE(PG8_SB(1, 1), b3 + hstep, voffB); PG8_STAGE(PG8_SA(1, 0), a3, voffA);
            PG8_WAIT_V(8); PG8_WAIT_L(0); PG8_BAR; PG8_MMA(1, 0, At, B0); PG8_MMA(1, 1, At, B1); PG8_BAR; PG8_SCHED;
            } else {
            PG8_LDB(B0, 0, 0); PG8_SCHED; PG8_LDA(At, 0, 0); PG8_STAGE(PG8_SA(1, 1), a1 + hstep, voffA);
            PG8_WAIT_L(8); PG8_BAR; PG8_WAIT_L(0); PG8_MMA(0, 0, At, B0); PG8_BAR; PG8_SCHED;
            PG8_LDB(B1, 0, 1); PG8_STAGE(PG8_SB(0, 0), b2, voffB);
            PG8_BAR; PG8_WAIT_L(0); PG8_MMA(0, 1, At, B1); PG8_BAR;
            PG8_LDA(At, 0, 1); PG8_STAGE(PG8_SA(0, 0), a2, voffA);
            PG8_BAR; PG8_WAIT_L(0); PG8_MMA(1, 0, At, B0); PG8_BAR; PG8_SCHED;
            PG8_STAGE(PG8_SB(0, 1), b2 + hstep, voffB);
            PG8_WAIT_V(6); PG8_BAR; PG8_MMA(1, 1, At, B1); PG8_BAR;
            PG8_LDB(B0, 1, 0); PG8_SCHED; PG8_LDA(At, 1, 0); PG8_STAGE(PG8_SA(0, 1), a2 + hstep, voffA);
            PG8_WAIT_L(8); PG8_BAR; PG8_WAIT_L(0); PG8_MMA(0, 0, At, B0); PG8_BAR; PG8_SCHED;
            PG8_LDB(B1, 1, 1); PG8_STAGE(PG8_SB(1, 0), b3, voffB);
            PG8_BAR; PG8_WAIT_L(0); PG8_MMA(0, 1, At, B1); PG8_BAR;
            PG8_LDA(At, 1, 1); PG8_STAGE(PG8_SA(1, 0), a3, voffA);
            PG8_BAR; PG8_WAIT_L(0); PG8_MMA(1, 0, At, B0); PG8_BAR; PG8_SCHED;
            PG8_STAGE(PG8_SB(1, 1), b3 + hstep, voffB);
            PG8_WAIT_V(6); PG8_BAR; PG8_MMA(1, 1, At, B1); PG8_BAR;
            }
        }
        if constexpr (ALIGN_EPI) { if (wr == 0) PG8_BAR; }
        if constexpr (!Epi::AFTER_DRAIN) { E(acc, cur, wr, wc, fr, fq); S.done(cur); }
        if (!has_next) break;
#pragma unroll
        for (int a = 0; a < 2; ++a)
#pragma unroll
            for (int b = 0; b < 2; ++b)
#pragma unroll
                for (int m = 0; m < 4; ++m)
#pragma unroll
                    for (int n = 0; n < 2; ++n) acc[a][b][m][n] = (f32x4){0.f, 0.f, 0.f, 0.f};
        cur = nxt; cA = nA; cB = nB; ++ui;
        if constexpr (ALIGN_EPI) { if (wr == 1) PG8_BAR; }
    }
    PG8_WAIT_V(0);
    if constexpr (!ALIGN_EPI) { if (wr == 0) PG8_BAR; }
    PG8_BAR;
    if constexpr (Epi::AFTER_DRAIN) { E.fused(acc, cur, wr, wc, fr, fq, lds, wid, lane); S.done(cur); }
#undef PG8_SA
#undef PG8_SB
#undef PG8_STAGE
#undef PG8_LDA
#undef PG8_LDB
#undef PG8_MMA
#undef PG8_WAIT_V
#undef PG8_WAIT_L
#undef PG8_BAR
#undef PG8_SCHED
}
}

#define LAS __attribute__((address_space(3)))
using pg8::ex2; using pg8::rcpf_;
typedef unsigned short u16;
typedef short bf16x8 __attribute__((ext_vector_type(8)));
typedef float f32x4 __attribute__((ext_vector_type(4)));
typedef float f32x16 __attribute__((ext_vector_type(16)));
typedef unsigned u32x4 __attribute__((ext_vector_type(4)));
typedef unsigned u32x2 __attribute__((ext_vector_type(2)));

constexpr int DM = 1024, NB = 16, SEQ = 2048, MTOK = NB * SEQ, DEPTH = 4, DFF = 2816, INW = 2840, PW = 3072;
constexpr int C_MQ = 0, C_MK = 256, C_MV = 512, C_DQ = 768, C_DK = 1024, C_DV = 1280, C_NQ = 1536, C_NKC = 2048, C_NVC = 2176, C_NKS = 2304, C_NVS = 2432, C_NKW = 2560, C_NVW = 2688, C_NG = 2816;
constexpr int NVH = 12;
constexpr float LOG2E = 1.4426950408889634f, NEGF = -1e30f;
constexpr int NPH_L = 14, NPH = NPH_L * DEPTH + 1;
constexpr size_t MiB = 1u << 20;
constexpr size_t WS_GU1 = 1 * MiB, WS_DN1 = 12 * MiB, WS_GU2 = WS_DN1 + 5 * MiB + MiB / 2, WS_DN2 = WS_GU2 + 11 * MiB, WS_WIN = 34 * MiB, WS_WOUT = 40 * MiB, WS_W1 = 42 * MiB;
constexpr size_t WS_PROJ = 44 * MiB, WS_XN = 236 * MiB, WS_VT = 300 * MiB, WS_HID = 348 * MiB, WS_KCMP = 352 * MiB, WS_VCMPT = WS_KCMP + MiB / 2, WS_KMEAN = 353 * MiB, WS_SEL = WS_KMEAN + MiB / 4, WS_XB = 354 * MiB, WS_SS = 418 * MiB, WS_END = 420 * MiB;
static_assert(WS_DN2 + 5 * MiB + MiB / 2 == WS_WIN, "ws map");
constexpr int LDS_BYTES = 147456, MISC_OFF = 147456 - 64, RTAB_OFF = 131072;
constexpr size_t WS_CTL = 0, CTL_ZERO_BYTES = 262144;
constexpr int ATT_K = 0, ATT_V = 32768, ATT_LUT = 65536, ATT_PARK = 68608;
constexpr int CMP_K = 0, CMP_V = 18432, CMP_A = 36864, CMP_H = CMP_A + 256 * 33 * 4;

struct Params {
    const float* x; const float* rel_bias; const float* norm_ffn1; const float* ffn1_gate; const float* ffn1_up; const float* ffn1_down;
    const float* norm_mix; const float* w_in; const float* diff_lambda; const float* diff_subln; const float* cmp_pe; const float* cmp_w1; const float* cmp_w2;
    const float* w_out; const float* norm_ffn2; const float* ffn2_gate; const float* ffn2_up; const float* ffn2_down; const float* final_norm;
    float* out; unsigned char* ws;
    float lam_init[4];
    int ph_lo, ph_hi;
};
typedef const __attribute__((address_space(4))) Params* KParamsPtr;

__device__ __forceinline__ float bf2f(unsigned v) { return __uint_as_float(v << 16); }
typedef float f32x2_t __attribute__((ext_vector_type(2))); typedef __bf16 bf16x2_t __attribute__((ext_vector_type(2)));
__device__ __forceinline__ unsigned pkbf(float lo, float hi) { f32x2_t v = {lo, hi}; bf16x2_t b = __builtin_convertvector(v, bf16x2_t); return __builtin_bit_cast(unsigned, b); }
__device__ __forceinline__ int lane_opaque() { int l; asm volatile("v_mbcnt_lo_u32_b32 %0, -1, 0\n\tv_mbcnt_hi_u32_b32 %0, -1, %0" : "=v"(l)); return l; }
__device__ __forceinline__ float wave_sum(float v, int lane) {
#pragma unroll
    for (int o = 1; o < 64; o <<= 1) v += __int_as_float(__builtin_amdgcn_ds_bpermute((lane ^ o) << 2, __float_as_int(v)));
    return v;
}
__device__ __forceinline__ float xhalf_max(float v) { auto rr = __builtin_amdgcn_permlane32_swap(__float_as_uint(v), __float_as_uint(v), false, false); return fmaxf(__uint_as_float(rr[0]), __uint_as_float(rr[1])); }
__device__ __forceinline__ float xhalf_sum(float v) { auto rr = __builtin_amdgcn_permlane32_swap(__float_as_uint(v), __float_as_uint(v), false, false); return __uint_as_float(rr[0]) + __uint_as_float(rr[1]); }
__device__ __forceinline__ float sigmoid_f(float x) { return rcpf_(1.0f + ex2(-LOG2E * x)); }
__device__ __forceinline__ int crow(int r, int hi) { return (r & 3) + 8 * (r >> 2) + 4 * hi; }
__device__ __forceinline__ int kperm(int p) { const int h = p >> 3, j = p & 7; return 8 * (j >> 2) + 4 * h + (j & 3); }
__device__ __forceinline__ int pperm(int k) { return ((k >> 2) & 1) * 8 + (k >> 3) * 4 + (k & 3); }

__device__ __forceinline__ void tr_item(const float* W, int K, int N, u16* WT, int kb, int n0, int dst_row0, LAS float* scr, int lane, float cs = 1.0f, const float* gk = nullptr) {
    const int k0 = 64 * kb; const int n = n0 + (lane & 31); const bool ok = n < N;
    float wv[32];
#pragma unroll
    for (int i = 0; i < 32; ++i) { const int kk = 2 * i + (lane >> 5); wv[i] = ok ? W[(size_t)(k0 + kk) * N + n] : 0.f; }
#pragma unroll
    for (int i = 0; i < 32; ++i) { const int kk = 2 * i + (lane >> 5); scr[kk * 33 + (lane & 31)] = wv[i] * (gk ? gk[k0 + kk] * cs : cs); }
    asm volatile("s_waitcnt lgkmcnt(0)" ::: "memory");
    const int c = lane & 7;
#pragma unroll
    for (int j = 0; j < 4; ++j) { const int nn = (lane >> 3) + 8 * j; const LAS float* s = scr + (8 * c) * 33 + nn;
        u32x4 o; o.x = pkbf(s[0 * 33], s[1 * 33]); o.y = pkbf(s[2 * 33], s[3 * 33]); o.z = pkbf(s[4 * 33], s[5 * 33]); o.w = pkbf(s[6 * 33], s[7 * 33]);
        *(u32x4*)(WT + (size_t)(dst_row0 + nn) * K + k0 + 8 * c) = o; }
    asm volatile("s_waitcnt lgkmcnt(0)" ::: "memory");
}

__device__ __forceinline__ void norm_row(const float* xrow, const u16* xrow16, const float* g, u16* dst16, float* dst32, u16* xb0, int lane) {
    float v[16];
    if (xrow) { const f32x4* xr = (const f32x4*)xrow + 4 * lane;
#pragma unroll
        for (int j = 0; j < 4; ++j) { const f32x4 t = xr[j]; v[4 * j] = t.x; v[4 * j + 1] = t.y; v[4 * j + 2] = t.z; v[4 * j + 3] = t.w; }
        if (xb0) { u32x4 o0, o1; o0.x = pkbf(v[0], v[1]); o0.y = pkbf(v[2], v[3]); o0.z = pkbf(v[4], v[5]); o0.w = pkbf(v[6], v[7]); o1.x = pkbf(v[8], v[9]); o1.y = pkbf(v[10], v[11]); o1.z = pkbf(v[12], v[13]); o1.w = pkbf(v[14], v[15]);
            ((u32x4*)xb0)[2 * lane] = o0; ((u32x4*)xb0)[2 * lane + 1] = o1; }
    } else { const u32x4 p0 = ((const u32x4*)xrow16)[2 * lane], p1 = ((const u32x4*)xrow16)[2 * lane + 1];
        v[0] = bf2f(p0.x & 0xffffu); v[1] = bf2f(p0.x >> 16); v[2] = bf2f(p0.y & 0xffffu); v[3] = bf2f(p0.y >> 16); v[4] = bf2f(p0.z & 0xffffu); v[5] = bf2f(p0.z >> 16); v[6] = bf2f(p0.w & 0xffffu); v[7] = bf2f(p0.w >> 16);
        v[8] = bf2f(p1.x & 0xffffu); v[9] = bf2f(p1.x >> 16); v[10] = bf2f(p1.y & 0xffffu); v[11] = bf2f(p1.y >> 16); v[12] = bf2f(p1.z & 0xffffu); v[13] = bf2f(p1.z >> 16); v[14] = bf2f(p1.w & 0xffffu); v[15] = bf2f(p1.w >> 16); }
    float s = 0.f;
#pragma unroll
    for (int j = 0; j < 16; ++j) s = fmaf(v[j], v[j], s);
    const float rstd = 1.0f / sqrtf(wave_sum(s, lane) * (1.0f / 1024.0f) + 1e-6f);
    const f32x4* gr = (const f32x4*)g + 4 * lane;
#pragma unroll
    for (int j = 0; j < 4; ++j) { const f32x4 gg = gr[j]; v[4 * j] *= rstd * gg.x; v[4 * j + 1] *= rstd * gg.y; v[4 * j + 2] *= rstd * gg.z; v[4 * j + 3] *= rstd * gg.w; }
    if (dst16) { u32x4 o0, o1; o0.x = pkbf(v[0], v[1]); o0.y = pkbf(v[2], v[3]); o0.z = pkbf(v[4], v[5]); o0.w = pkbf(v[6], v[7]); o1.x = pkbf(v[8], v[9]); o1.y = pkbf(v[10], v[11]); o1.z = pkbf(v[12], v[13]); o1.w = pkbf(v[14], v[15]);
        ((u32x4*)dst16)[2 * lane] = o0; ((u32x4*)dst16)[2 * lane + 1] = o1; }
    else {
#pragma unroll
        for (int j = 0; j < 4; ++j) ((f32x4*)dst32)[4 * lane + j] = (f32x4){v[4 * j], v[4 * j + 1], v[4 * j + 2], v[4 * j + 3]}; }
}

struct AState { f32x16 o0, o1; float m, l; };
__device__ __forceinline__ void astate_init(AState& s) {
#pragma unroll
    for (int r = 0; r < 16; ++r) { s.o0[r] = 0.f; s.o1[r] = 0.f; }
    s.m = 0.f; s.l = 0.f;
}
constexpr float ATT_THR = 8.0f;
constexpr int ATT_SLOT = 9216, ATT_NSLOT = 3;
template <int KS0, int NKS>
__device__ __forceinline__ void qk_block(const LAS unsigned char* Ks, const bf16x8 (&qr)[4], int r32, int hi, f32x16& s0, f32x16& s1) {
    f32x16 ci;
#pragma unroll
    for (int r = 0; r < 16; ++r) ci[r] = 0.f;
    const LAS unsigned char* kp = Ks + hi * 1024 + r32 * 16;
#pragma unroll
    for (int ks = 0; ks < NKS; ++ks) {
        const bf16x8 a0 = *(const LAS bf16x8*)(kp + (KS0 + ks) * 2048);
        const bf16x8 a1 = *(const LAS bf16x8*)(kp + (KS0 + ks) * 2048 + 512);
        s0 = __builtin_amdgcn_mfma_f32_32x32x16_bf16(a0, qr[KS0 + ks], ks == 0 ? ci : s0, 0, 0, 0);
        s1 = __builtin_amdgcn_mfma_f32_32x32x16_bf16(a1, qr[KS0 + ks], ks == 0 ? ci : s1, 0, 0, 0);
    }
    __builtin_amdgcn_sched_group_barrier(0x100, 2 * NKS, 0); __builtin_amdgcn_sched_group_barrier(0x008, 2 * NKS, 0);
}
__device__ __forceinline__ void pv_block(const LAS unsigned char* Vs, const u32x4 (&pk)[4], int r32, int hi, AState& st) {
    const LAS unsigned char* vp = Vs + hi * 1024 + r32 * 16;
#pragma unroll
    for (int c = 0; c < 4; ++c) {
        const bf16x8 v0 = *(const LAS bf16x8*)(vp + c * 2048);
        const bf16x8 v1 = *(const LAS bf16x8*)(vp + c * 2048 + 512);
        const bf16x8 pb = __builtin_bit_cast(bf16x8, pk[c]);
        st.o0 = __builtin_amdgcn_mfma_f32_32x32x16_bf16(v0, pb, st.o0, 0, 0, 0);
        st.o1 = __builtin_amdgcn_mfma_f32_32x32x16_bf16(v1, pb, st.o1, 0, 0, 0);
    }
    __builtin_amdgcn_sched_group_barrier(0x100, 8, 0); __builtin_amdgcn_sched_group_barrier(0x008, 8, 0);
}
__device__ __forceinline__ void glds16(const void* gsrc, unsigned lds_dst) { unsigned keep;
    asm volatile("s_mov_b32 %0, m0\n\ts_mov_b32 m0, %2\n\ts_nop 0\n\tglobal_load_lds_dwordx4 %1, off\n\ts_mov_b32 m0, %0" : "=&s"(keep) : "v"(gsrc), "s"(lds_dst) : "memory"); }
__device__ __forceinline__ void lut_add(f32x16& s0, f32x16& s1, const LAS float* lutz, int dbase, float cc) {
    const LAS float* lp = lutz + (dbase - 59);
#pragma unroll
    for (int r = 0; r < 16; ++r) { const int ko = (r & 3) + 8 * (r >> 2);
        s0[r] += lp[59 - ko] + cc; s1[r] += lp[27 - ko] + cc; }
}
__device__ __forceinline__ void const_add(f32x16& s0, f32x16& s1, float cc) {
#pragma unroll
    for (int r = 0; r < 16; ++r) { s0[r] += cc; s1[r] += cc; }
}
__device__ __forceinline__ float row_max(const f32x16& s0, const f32x16& s1) {
    float mx = fmaxf(s0[0], s1[0]);
#pragma unroll
    for (int r = 1; r < 16; ++r) mx = fmaxf(mx, fmaxf(s0[r], s1[r]));
    return xhalf_max(mx);
}
__device__ __forceinline__ void rescale(AState& st, f32x16& s0, f32x16& s1, float mx) {
    const float dl = fmaxf(mx, 0.f); const float f = ex2(-dl); st.m += dl; st.l *= f;
#pragma unroll
    for (int r = 0; r < 16; ++r) { st.o0[r] *= f; st.o1[r] *= f; s0[r] -= dl; s1[r] -= dl; }
}
constexpr float ATT_BIG = 1024.0f;
__device__ __forceinline__ void exp_pack(f32x16& s0, f32x16& s1, u32x4 (&pk)[4], AState& st) {
    float sum = 0.f;
#pragma unroll
    for (int r = 0; r < 16; ++r) { s0[r] = ex2(s0[r]); s1[r] = ex2(s1[r]); sum += s0[r] + s1[r]; }
    if (__any(sum > ATT_BIG)) {
        float mx = fmaxf(s0[0], s1[0]);
#pragma unroll
        for (int r = 1; r < 16; ++r) mx = fmaxf(mx, fmaxf(s0[r], s1[r]));
        mx = xhalf_max(mx);
        const float dl = fmaxf(__builtin_amdgcn_logf(fmaxf(mx, 1.0f)), 0.f), f = ex2(-dl);
        st.m += dl; st.l *= f; sum *= f;
#pragma unroll
        for (int r = 0; r < 16; ++r) { st.o0[r] *= f; st.o1[r] *= f; s0[r] *= f; s1[r] *= f; }
    }
    st.l += sum;
    pk[0] = (u32x4){pkbf(s0[0], s0[1]), pkbf(s0[2], s0[3]), pkbf(s0[4], s0[5]), pkbf(s0[6], s0[7])};
    pk[1] = (u32x4){pkbf(s0[8], s0[9]), pkbf(s0[10], s0[11]), pkbf(s0[12], s0[13]), pkbf(s0[14], s0[15])};
    pk[2] = (u32x4){pkbf(s1[0], s1[1]), pkbf(s1[2], s1[3]), pkbf(s1[4], s1[5]), pkbf(s1[6], s1[7])};
    pk[3] = (u32x4){pkbf(s1[8], s1[9]), pkbf(s1[10], s1[11]), pkbf(s1[12], s1[13]), pkbf(s1[14], s1[15])};
}

template <int KS0, int NKS, bool WINDOW, int MODE>
__device__ __forceinline__ void run_tiles(LAS unsigned char* lds, int t0, int t1, const u16* Kg, const u16* Vtg, const bf16x8 (&qr)[4], float c31,
                                          int q0w, unsigned mask, int qb, AState& A, int wave, int lane, int r32, int hi) {
    LAS unsigned char* Kr = lds + ATT_K; LAS unsigned char* Vr = lds + ATT_V; const LAS float* lut1 = (const LAS float*)(lds + ATT_LUT) + 96;
    const u16* ksrc = Kg + (size_t)lane * PW + wave * 8;
    const u16* vsrc = Vtg + (size_t)lane * SEQ + wave * 8;
    const unsigned kdst = (unsigned)(uintptr_t)Kr + wave * 1024, vdst = (unsigned)(uintptr_t)Vr + wave * 1024;
#define TCL(t) ((t) < t0 ? t0 : ((t) > t1 ? t1 : (t)))
#define DMA_K(tn) glds16(ksrc + (size_t)TCL(tn) * 64 * PW, (unsigned)__builtin_amdgcn_readfirstlane(kdst + ((tn) & 3) * 8192))
#define DMA_V(tn) glds16(vsrc + TCL(tn) * 64, (unsigned)__builtin_amdgcn_readfirstlane(vdst + ((tn) & 3) * 8192))
#define KS_(t) (Kr + ((t) & 3) * 8192)
#define VS_(t) (Vr + ((t) & 3) * 8192)
#define WAIT_BAR4() asm volatile("s_waitcnt vmcnt(4) lgkmcnt(0)\n\ts_barrier" ::: "memory")
#define T_ACTIVE(t) (!((q0w + 31 - (t) * 64) < 0 || (WINDOW && (q0w - ((t) * 64 + 63)) >= 512)))
#define T_LUTMODE(t) (((q0w - ((t) * 64 + 63)) < 128) || (WINDOW && (q0w + 31 - (t) * 64) >= 512))
    auto tile_sel = [&](int t) -> int { if (MODE == 1) { const int blk = t >> 2; return blk < qb ? (int)((mask >> blk) & 1u) : 1; } if (MODE == 2) return (int)((mask >> t) & 1u); return 1; };
    asm volatile("s_waitcnt vmcnt(0)" ::: "memory");
#pragma unroll
    for (int j = 0; j < 4; ++j) { DMA_K(t0 + j); DMA_V(t0 + j - 2); }
    WAIT_BAR4();
    f32x16 sn0, sn1, sc0, sc1; u32x4 pk[4];
#pragma unroll
    for (int r = 0; r < 16; ++r) { sn0[r] = 0.f; sn1[r] = 0.f; }
#pragma unroll
    for (int i = 0; i < 4; ++i) pk[i] = (u32x4){0u, 0u, 0u, 0u};
    bool act_n = T_ACTIVE(t0), act_c = false, act_p = false;
    if (act_n) qk_block<KS0, NKS>(KS_(t0), qr, r32, hi, sn0, sn1);
    asm volatile("s_waitcnt lgkmcnt(0)\n\ts_barrier" ::: "memory");
    for (int c = t0; c <= t1 + 1; ++c) {
        act_p = act_c; act_c = act_n; sc0 = sn0; sc1 = sn1;
        DMA_K(c + 4); DMA_V(c + 2);
        act_n = (c + 1 <= t1) && T_ACTIVE(c + 1);
        const bool lm_c = T_LUTMODE(c);
        const int dbase = q0w + r32 - c * 64 - 4 * hi;
        const float selc = tile_sel(c) ? 0.f : NEGF;
        if (act_p) pv_block(VS_(c - 1), pk, r32, hi, A);
        if (act_c) {
            const float cc = selc - A.m;
            if (lm_c) lut_add(sc0, sc1, lut1, dbase, cc); else if (__any(cc != 0.f)) const_add(sc0, sc1, cc);
        }
        if (act_n) qk_block<KS0, NKS>(KS_(c + 1), qr, r32, hi, sn0, sn1);
        if (act_c) exp_pack(sc0, sc1, pk, A);
        WAIT_BAR4();
    }
    asm volatile("s_waitcnt vmcnt(0) lgkmcnt(0)\n\ts_barrier" ::: "memory");
#undef TCL
#undef DMA_K
#undef DMA_V
#undef KS_
#undef VS_
#undef WAIT_BAR4
#undef T_ACTIVE
#undef T_LUTMODE
}

__device__ __forceinline__ void build_lut(LAS unsigned char* lds, const float* rel_bias, int head, bool window, int tid) {
    LAS float* lut = (LAS float*)(lds + ATT_LUT);
    for (int i = tid; i < 704; i += 512) {
        const int d = i - 96; float v; const float c31 = rel_bias[31 * 16 + head];
        if (d < 0) v = NEGF;
        else if (d >= 512) v = window ? NEGF : 0.f;
        else { int bk;
            if (d < 16) bk = d; else if (d >= 128) bk = 31; else { bk = 16 + (int)(log2f((float)d * (1.0f / 16.0f)) * (16.0f / 3.0f)); bk = bk > 31 ? 31 : bk; }
            v = (rel_bias[bk * 16 + head] - c31) * LOG2E; }
        lut[i] = v;
    }
}
__device__ __forceinline__ void load_q(bf16x8 (&qr)[4], const u16* qrow, int hi) {
#pragma unroll
    for (int ks = 0; ks < 4; ++ks) qr[ks] = *(const bf16x8*)(qrow + ks * 16 + hi * 8);
}
__device__ __forceinline__ void store_o(u16* dst, const f32x16& v0, const f32x16& v1, int hi) {
#pragma unroll
    for (int g = 0; g < 4; ++g) {
        u32x2 a; a.x = pkbf(v0[4 * g], v0[4 * g + 1]); a.y = pkbf(v0[4 * g + 2], v0[4 * g + 3]); *(u32x2*)(dst + 8 * g + 4 * hi) = a;
        u32x2 b; b.x = pkbf(v1[4 * g], v1[4 * g + 1]); b.y = pkbf(v1[4 * g + 2], v1[4 * g + 3]); *(u32x2*)(dst + 32 + 8 * g + 4 * hi) = b;
    }
}

struct Ctx { LAS unsigned char* lds; int tid, lane, wave, r32, hi, G, bx; u16* proj; u16* obuf; u16* vt; };

__device__ __forceinline__ void moba_unit(const Ctx& C0, KParamsPtr P, int b, int h, int qb) {
    Ctx C = C0; C.lane = lane_opaque(); C.tid = C.wave * 64 + C.lane; C.r32 = C.lane & 31; C.hi = C.lane >> 5;
    const int q0w = __builtin_amdgcn_readfirstlane(qb * 256 + C.wave * 32); const int qpos = q0w + C.r32; const size_t tok = (size_t)b * SEQ + qpos;
    build_lut(C.lds, P->rel_bias, h, false, C.tid);
    const u16* qrow = C.proj + tok * PW + C_MQ + h * 64;
    bf16x8 qr[4]; load_q(qr, qrow, C.hi);
    unsigned mask = 0;
    if (qb > 0) {
        float g[7];
#pragma unroll
        for (int j = 0; j < 7; ++j) g[j] = 0.f;
        const float* km = (const float*)(P->ws + WS_KMEAN) + (size_t)((b * 4 + h) * 8) * 64;
#pragma unroll
        for (int dc = 0; dc < 8; ++dc) {
            const u32x4 qv = *(const u32x4*)(qrow + dc * 8);
            float qf[8]; qf[0] = bf2f(qv.x & 0xffffu); qf[1] = bf2f(qv.x >> 16); qf[2] = bf2f(qv.y & 0xffffu); qf[3] = bf2f(qv.y >> 16);
            qf[4] = bf2f(qv.z & 0xffffu); qf[5] = bf2f(qv.z >> 16); qf[6] = bf2f(qv.w & 0xffffu); qf[7] = bf2f(qv.w >> 16);
#pragma unroll
            for (int j = 0; j < 7; ++j) if (j < qb) { const float* kmj = km + j * 64 + dc * 8;
#pragma unroll
                for (int e = 0; e < 8; ++e) g[j] = fmaf(qf[e], kmj[e], g[j]); }
        }
#pragma unroll
        for (int j = 0; j < 7; ++j) if (j < qb) { int rank = 0;
#pragma unroll
            for (int i = 0; i < 7; ++i) if (i != j && i < qb) rank += (g[i] > g[j] || (g[i] == g[j] && i < j)) ? 1 : 0;
            if (rank < 3) mask |= 1u << j; }
    }
    AState A; astate_init(A);
    const float c31 = P->rel_bias[31 * 16 + h] * LOG2E;
    run_tiles<0, 4, false, 1>(C.lds, 0, 4 * qb + 3, C.proj + (size_t)b * SEQ * PW + C_MK + h * 64, C.vt + (size_t)((b * NVH + h) * 64) * SEQ, qr, c31, q0w, mask, qb, A, C.wave, C.lane, C.r32, C.hi);
    const float inv = rcpf_(xhalf_sum(A.l));
    A.o0 *= inv; A.o1 *= inv;
    { const int l2 = lane_opaque(); const size_t tok2 = (size_t)b * SEQ + q0w + (l2 & 31);
      store_o(C.obuf + tok2 * DM + h * 64, A.o0, A.o1, l2 >> 5); }
}

__device__ __forceinline__ void diff_unit(const Ctx& C0, KParamsPtr P, int layer, int b, int h, int qb) {
    Ctx C = C0; C.lane = lane_opaque(); C.tid = C.wave * 64 + C.lane; C.r32 = C.lane & 31; C.hi = C.lane >> 5;
    const int q0w = __builtin_amdgcn_readfirstlane(qb * 256 + C.wave * 32); const int qpos = q0w + C.r32; const size_t tok = (size_t)b * SEQ + qpos;
    build_lut(C.lds, P->rel_bias, 4 + h, false, C.tid);
    bf16x8 qr[4]; load_q(qr, C.proj + tok * PW + C_DQ + h * 64, C.hi);
    AState A; astate_init(A);
    const float c31 = P->rel_bias[31 * 16 + 4 + h] * LOG2E;
    const u16* Kg = C.proj + (size_t)b * SEQ * PW + C_DK + h * 64; const u16* Vg = C.vt + (size_t)((b * NVH + 4 + h) * 64) * SEQ;
    run_tiles<0, 2, false, 0>(C.lds, 0, 4 * qb + 3, Kg, Vg, qr, c31, q0w, 0u, 0, A, C.wave, C.lane, C.r32, C.hi);
    LAS float* park = (LAS float*)(C.lds + ATT_PARK) + C.tid;
    { const float i0 = rcpf_(xhalf_sum(A.l));
#pragma unroll
      for (int r = 0; r < 16; ++r) { park[r * 512] = A.o0[r] * i0; park[(16 + r) * 512] = A.o1[r] * i0; } }
    astate_init(A);
    run_tiles<2, 2, false, 0>(C.lds, 0, 4 * qb + 3, Kg, Vg, qr, c31, q0w, 0u, 0, A, C.wave, C.lane, C.r32, C.hi);
    const float* lp = P->diff_lambda + (size_t)layer * 128; float d01 = 0.f, d23 = 0.f;
    for (int i = 0; i < 32; ++i) { d01 = fmaf(lp[i], lp[32 + i], d01); d23 = fmaf(lp[64 + i], lp[96 + i], d23); }
    const float li = P->lam_init[layer]; const float lam = expf(d01) - expf(d23) + li;
    const float i1 = lam * rcpf_(xhalf_sum(A.l));
    float ss = 0.f;
#pragma unroll
    for (int r = 0; r < 16; ++r) { A.o0[r] = park[r * 512] - A.o0[r] * i1; A.o1[r] = park[(16 + r) * 512] - A.o1[r] * i1; ss += A.o0[r] * A.o0[r] + A.o1[r] * A.o1[r]; }
    ss = xhalf_sum(ss);
    const float rstd = (1.0f / sqrtf(ss * (1.0f / 64.0f) + 1e-6f)) * (1.0f - li);
    const float* sg = P->diff_subln + (size_t)layer * 64;
#pragma unroll
    for (int r = 0; r < 16; ++r) { const int d = crow(r, C.hi); A.o0[r] *= rstd * sg[d]; A.o1[r] *= rstd * sg[32 + d]; }
    { const int l2 = lane_opaque(); const size_t tok2 = (size_t)b * SEQ + q0w + (l2 & 31);
      store_o(C.obuf + tok2 * DM + 256 + h * 64, A.o0, A.o1, l2 >> 5); }
}

__device__ __forceinline__ void nsa_unit(const Ctx& C0, KParamsPtr P, int b, int hq, int qb) {
    Ctx C = C0; C.lane = lane_opaque(); C.tid = C.wave * 64 + C.lane; C.r32 = C.lane & 31; C.hi = C.lane >> 5;
    const int g = hq >> 2;
    const int q0w = __builtin_amdgcn_readfirstlane(qb * 256 + C.wave * 32); const int qpos = q0w + C.r32; const size_t tok = (size_t)b * SEQ + qpos;
    build_lut(C.lds, P->rel_bias, 8 + hq, false, C.tid);
    bf16x8 qr[4]; load_q(qr, C.proj + tok * PW + C_NQ + hq * 64, C.hi);
    const u16* gl = C.proj + tok * PW + C_NG + hq * 3;
    const float g1 = sigmoid_f(bf2f(gl[1])), g2 = sigmoid_f(bf2f(gl[2]));
    const unsigned mask = ((const unsigned*)(P->ws + WS_SEL))[(size_t)(b * 2 + g) * SEQ + qpos];
    const float c31 = P->rel_bias[31 * 16 + 8 + hq] * LOG2E;
    AState A; astate_init(A);
    run_tiles<0, 4, false, 2>(C.lds, 0, 4 * qb + 3, C.proj + (size_t)b * SEQ * PW + C_NKS + g * 64, C.vt + (size_t)((b * NVH + 8 + g) * 64) * SEQ, qr, c31, q0w, mask, qb, A, C.wave, C.lane, C.r32, C.hi);
    LAS float* park = (LAS float*)(C.lds + ATT_PARK) + C.tid;
    { const float f = g1 * rcpf_(xhalf_sum(A.l));
#pragma unroll
      for (int r = 0; r < 16; ++r) { park[r * 512] = A.o0[r] * f; park[(16 + r) * 512] = A.o1[r] * f; } }
    if (C.tid < 96) ((LAS float*)(C.lds + ATT_LUT))[608 + C.tid] = NEGF;
    astate_init(A);
    const int tw0 = 4 * qb - 8 < 0 ? 0 : 4 * qb - 8;
    run_tiles<0, 4, true, 0>(C.lds, tw0, 4 * qb + 3, C.proj + (size_t)b * SEQ * PW + C_NKW + g * 64, C.vt + (size_t)((b * NVH + 10 + g) * 64) * SEQ, qr, c31, q0w, 0u, qb, A, C.wave, C.lane, C.r32, C.hi);
    { const float f = g2 * rcpf_(xhalf_sum(A.l));
#pragma unroll
      for (int r = 0; r < 16; ++r) { A.o0[r] = A.o0[r] * f + park[r * 512]; A.o1[r] = A.o1[r] * f + park[(16 + r) * 512]; } }
    const int l2 = lane_opaque(); const int hi2 = l2 >> 5;
    u16* dst = C.obuf + ((size_t)b * SEQ + q0w + (l2 & 31)) * DM + 512 + hq * 64;
#pragma unroll
    for (int gg = 0; gg < 4; ++gg) {
        const u32x2 a = *(const u32x2*)(dst + 8 * gg + 4 * hi2), bq = *(const u32x2*)(dst + 32 + 8 * gg + 4 * hi2);
        A.o0[4 * gg] += bf2f(a.x & 0xffffu); A.o0[4 * gg + 1] += bf2f(a.x >> 16); A.o0[4 * gg + 2] += bf2f(a.y & 0xffffu); A.o0[4 * gg + 3] += bf2f(a.y >> 16);
        A.o1[4 * gg] += bf2f(bq.x & 0xffffu); A.o1[4 * gg + 1] += bf2f(bq.x >> 16); A.o1[4 * gg + 2] += bf2f(bq.y & 0xffffu); A.o1[4 * gg + 3] += bf2f(bq.y >> 16);
    }
    store_o(dst, A.o0, A.o1, hi2);
}

__device__ __forceinline__ void cmp_unit(const Ctx& C0, KParamsPtr P, int b, int g, int qblk) {
    Ctx C = C0; C.lane = lane_opaque(); C.tid = C.wave * 64 + C.lane; C.r32 = C.lane & 31; C.hi = C.lane >> 5;
    LAS unsigned char* lds = C.lds; const int tid = C.tid, r32 = C.r32, hi = C.hi;
    const u16* kc = (const u16*)(P->ws + WS_KCMP) + (size_t)(b * 2 + g) * 128 * 64;
    const u16* vc = (const u16*)(P->ws + WS_VCMPT) + (size_t)(b * 2 + g) * 64 * 128;
#pragma unroll
    for (int i = 0; i < 2; ++i) { const int e = tid + 512 * i;
        { const int row = e >> 3, ch = e & 7; *(LAS u32x4*)(lds + CMP_K + row * 144 + ch * 16) = *(const u32x4*)(kc + row * 64 + ch * 8); }
        { const int row = e >> 4, ch = e & 15; *(LAS u32x4*)(lds + CMP_V + row * 272 + ch * 16) = *(const u32x4*)(vc + row * 128 + ch * 8); } }
    const int q0w = __builtin_amdgcn_readfirstlane(qblk * 256 + C.wave * 32); const int qpos = q0w + r32; const size_t tok = (size_t)b * SEQ + qpos;
    const int nmax = (qpos - 31) >> 4;
    __syncthreads();
    float qa[16], qh[16];
#pragma unroll
    for (int i = 0; i < 16; ++i) { qa[i] = 0.f; qh[i] = 0.f; }
    const LAS unsigned char* kp = lds + CMP_K + r32 * 144 + hi * 16;
    const LAS unsigned char* vp = lds + CMP_V + r32 * 272 + hi * 16;
    bf16x8 qn[4]; load_q(qn, C.proj + tok * PW + C_NQ + g * 4 * 64, hi);
    for (int rh = 0; rh < 4; ++rh) {
        const int hq = g * 4 + rh;
        bf16x8 qr[4];
#pragma unroll
        for (int ks = 0; ks < 4; ++ks) qr[ks] = qn[ks];
        load_q(qn, C.proj + tok * PW + C_NQ + (g * 4 + (rh < 3 ? rh + 1 : rh)) * 64, hi);
        const float g0 = sigmoid_f(bf2f(C.proj[tok * PW + C_NG + hq * 3]));
        f32x16 s[4];
#pragma unroll
        for (int kb = 0; kb < 4; ++kb) {
#pragma unroll
            for (int r = 0; r < 16; ++r) s[kb][r] = 0.f;
#pragma unroll
            for (int ks = 0; ks < 4; ++ks) { const bf16x8 a = *(const LAS bf16x8*)(kp + kb * 32 * 144 + ks * 32); s[kb] = __builtin_amdgcn_mfma_f32_32x32x16_bf16(a, qr[ks], s[kb], 0, 0, 0); }
        }
        float mx = NEGF;
#pragma unroll
        for (int kb = 0; kb < 4; ++kb)
#pragma unroll
            for (int r = 0; r < 16; ++r) { const int n = 32 * kb + crow(r, hi); const float v = (n <= nmax) ? s[kb][r] : NEGF; s[kb][r] = v; mx = fmaxf(mx, v); }
        mx = xhalf_max(mx);
        float sum = 0.f;
#pragma unroll
        for (int kb = 0; kb < 4; ++kb)
#pragma unroll
            for (int r = 0; r < 16; ++r) { const int n = 32 * kb + crow(r, hi); const float pv = (n <= nmax) ? ex2(s[kb][r] - mx) : 0.f; s[kb][r] = pv; sum += pv; }
        sum = xhalf_sum(sum);
        const float inv = nmax >= 0 ? rcpf_(sum) : 0.f;
        f32x16 o0, o1;
#pragma unroll
        for (int r = 0; r < 16; ++r) { o0[r] = 0.f; o1[r] = 0.f; }
#pragma unroll
        for (int kb = 0; kb < 4; ++kb) {
#pragma unroll
            for (int r = 0; r < 16; ++r) s[kb][r] *= inv;
#pragma unroll
            for (int g4 = 0; g4 < 4; ++g4) { const float h = 0.5f * s[kb][4 * g4 + 3]; qh[kb * 4 + g4] += h; qa[kb * 4 + g4] += (s[kb][4 * g4] + s[kb][4 * g4 + 1]) + (s[kb][4 * g4 + 2] + h); }
#pragma unroll
            for (int c = 0; c < 2; ++c) {
                const u32x4 pk = (u32x4){pkbf(s[kb][8 * c], s[kb][8 * c + 1]), pkbf(s[kb][8 * c + 2], s[kb][8 * c + 3]), pkbf(s[kb][8 * c + 4], s[kb][8 * c + 5]), pkbf(s[kb][8 * c + 6], s[kb][8 * c + 7])};
                const bf16x8 pb = __builtin_bit_cast(bf16x8, pk);
                const bf16x8 v0 = *(const LAS bf16x8*)(vp + (kb * 2 + c) * 32);
                const bf16x8 v1 = *(const LAS bf16x8*)(vp + 32 * 272 + (kb * 2 + c) * 32);
                o0 = __builtin_amdgcn_mfma_f32_32x32x16_bf16(v0, pb, o0, 0, 0, 0);
                o1 = __builtin_amdgcn_mfma_f32_32x32x16_bf16(v1, pb, o1, 0, 0, 0);
            }
            __builtin_amdgcn_sched_barrier(0);
        }
        o0 *= g0; o1 *= g0;
        store_o(C.obuf + tok * DM + 512 + hq * 64, o0, o1, hi);
    }
    LAS float* Aq = (LAS float*)(lds + CMP_A) + (C.wave * 32 + r32) * 33; LAS float* Hq = (LAS float*)(lds + CMP_H) + (C.wave * 32 + r32) * 33;
#pragma unroll
    for (int kb = 0; kb < 4; ++kb)
#pragma unroll
        for (int g4 = 0; g4 < 4; ++g4) { const int j = 8 * kb + 2 * g4 + hi; Aq[j] = qa[kb * 4 + g4]; Hq[j] = qh[kb * 4 + g4]; }
    __syncthreads();
    const int cur = q0w >> 6;
    unsigned bits = 0;
    if (cur < 16) bits = (2u << cur) - 1u;
    else {
        float sc[32];
#pragma unroll
        for (int i = 0; i < 32; ++i) { const float imp = Aq[i] + (i > 0 ? Hq[i - 1] : 0.f); sc[i] = (i > cur) ? -3.0e38f : ((i == 0 || i > cur - 2) ? 1e4f : imp); }
#pragma unroll
        for (int e = 0; e < 16; ++e) {
            const float sj = hi ? sc[16 + e] : sc[e]; int rank = 0;
#pragma unroll
            for (int i = 0; i < 32; ++i) { const bool lt = (i < e) || (hi && i < 16 + e);
                rank += (sc[i] > sj || (sc[i] == sj && lt)) ? 1 : 0; }
            const int j = hi * 16 + e;
            if (j <= cur && rank < 16) bits |= 1u << j; }
        { auto rr = __builtin_amdgcn_permlane32_swap(bits, bits, false, false); bits = rr[0] | rr[1]; }
    }
    if (hi == 0) ((unsigned*)(P->ws + WS_SEL))[(size_t)(b * 2 + g) * SEQ + qpos] = bits;
    __syncthreads();
}

__device__ __forceinline__ void prep_vk(const Ctx& C, KParamsPtr P, int b0) {
    const int G = C.G - b0, bxr = C.bx - b0, tid = C.tid, lane = C.lane;
    if (bxr < 0) return;
    for (int it = bxr; it < NB * NVH * 32; it += G) {
        const int tb = it & 31, hv = (it >> 5) % NVH, b = it / (32 * NVH);
        const int vcol = hv < 4 ? C_MV + hv * 64 : hv < 8 ? C_DV + (hv - 4) * 64 : hv < 10 ? C_NVS + (hv - 8) * 64 : C_NVW + (hv - 10) * 64;
        { const int row = tid >> 3, ch = tid & 7; *(LAS u32x4*)(C.lds + row * 144 + ch * 16) = *(const u32x4*)(C.proj + ((size_t)b * SEQ + tb * 64 + row) * PW + vcol + ch * 8); }
        __syncthreads();
        { const int d = tid >> 3, pc = tid & 7; unsigned w[4];
#pragma unroll
            for (int e = 0; e < 4; ++e) { const int p0 = pc * 8 + 2 * e, p1 = p0 + 1; const int k0 = (p0 & ~15) + kperm(p0 & 15), k1 = (p1 & ~15) + kperm(p1 & 15);
                const unsigned a = *(const LAS u16*)(C.lds + k0 * 144 + d * 2), bb = *(const LAS u16*)(C.lds + k1 * 144 + d * 2); w[e] = a | (bb << 16); }
            *(u32x4*)(C.vt + ((size_t)(b * NVH + hv) * 64 + d) * SEQ + tb * 64 + pc * 8) = (u32x4){w[0], w[1], w[2], w[3]}; }
        __syncthreads();
    }
    const int gw = bxr * 8 + C.wave, NGW = G * 8;
    for (int it = gw; it < NB * 4 * 8; it += NGW) {
        const int blk = it & 7, h = (it >> 3) & 3, b = it >> 5;
        const u16* kp = C.proj + ((size_t)b * SEQ + blk * 256) * PW + C_MK + h * 64 + lane; float s = 0.f;
        for (int k = 0; k < 256; k += 8) { float t[8];
#pragma unroll
            for (int e = 0; e < 8; ++e) t[e] = bf2f(kp[(size_t)(k + e) * PW]);
            s += ((t[0] + t[1]) + (t[2] + t[3])) + ((t[4] + t[5]) + (t[6] + t[7])); }
        ((float*)(P->ws + WS_KMEAN))[(size_t)it * 64 + lane] = s * (1.0f / 256.0f);
    }
}
__device__ __forceinline__ void prep_a(const Ctx& C, KParamsPtr P, int layer) {
    const int G = C.G, lane = C.lane;
    const int gw = C.bx * 8 + C.wave, NGW = G * 8;
    u16* acmp = (u16*)(P->ws + WS_XN);
    for (int it = gw; it < 2 * 4096; it += NGW) {
        const int i = it >> 12, row = it & 4095, n = row & 127, bg = row >> 7, b = bg >> 1, g = bg & 1;
        u16* dst = acmp + (size_t)it * 2048; const float* pe = P->cmp_pe + (size_t)(layer * 2 + i) * 2048;
        const int col = (i == 0 ? C_NKC : C_NVC) + g * 64;
#pragma unroll
        for (int pass = 0; pass < 4; ++pass) { const int l = pass * 8 + (lane >> 3), d0 = (lane & 7) * 8;
            unsigned z0 = 0u; asm volatile("" : "+v"(z0)); u32x4 o = (u32x4){z0, z0, z0, z0};
            if (n < 127) { const u32x4 v = *(const u32x4*)(C.proj + ((size_t)b * SEQ + 16 * n + l) * PW + col + d0); const f32x4 e0 = *(const f32x4*)(pe + l * 64 + d0), e1 = *(const f32x4*)(pe + l * 64 + d0 + 4);
                o.x = pkbf(bf2f(v.x & 0xffffu) + e0.x, bf2f(v.x >> 16) + e0.y); o.y = pkbf(bf2f(v.y & 0xffffu) + e0.z, bf2f(v.y >> 16) + e0.w);
                o.z = pkbf(bf2f(v.z & 0xffffu) + e1.x, bf2f(v.z >> 16) + e1.y); o.w = pkbf(bf2f(v.w & 0xffffu) + e1.z, bf2f(v.w >> 16) + e1.w); }
            *(u32x4*)(dst + l * 64 + d0) = o; }
    }
}
__device__ __forceinline__ void prep_c(const Ctx& C, KParamsPtr P, int layer, int it0) {
    const int i = it0 >> 12, row0 = it0 & 4095, lane = lane_opaque(), tid = C.wave * 64 + lane, r32 = lane & 31, hi = lane >> 5;
    const float* w2 = P->cmp_w2 + (size_t)(layer * 2 + i) * 256 * 64;
    for (int e = tid; e < 256 * 64; e += 512) { const int k = e >> 6, c = e & 63; *(LAS u16*)(C.lds + c * 528 + k * 2) = (u16)(pkbf(w2[e], 0.f) & 0xffffu); }
    __syncthreads();
    const int wrow = row0 + C.wave * 32;
    const u16* hrow = (const u16*)(P->ws + WS_HID) + ((size_t)i * 4096 + wrow + r32) * 256 + hi * 8;
    f32x16 d0, d1;
#pragma unroll
    for (int r = 0; r < 16; ++r) { d0[r] = 0.f; d1[r] = 0.f; }
#pragma unroll 4
    for (int ks = 0; ks < 16; ++ks) {
        const bf16x8 a = *(const bf16x8*)(hrow + ks * 16);
        const bf16x8 b0 = *(const LAS bf16x8*)(C.lds + r32 * 528 + (ks * 16 + hi * 8) * 2);
        const bf16x8 b1 = *(const LAS bf16x8*)(C.lds + (32 + r32) * 528 + (ks * 16 + hi * 8) * 2);
        d0 = __builtin_amdgcn_mfma_f32_32x32x16_bf16(a, b0, d0, 0, 0, 0);
        d1 = __builtin_amdgcn_mfma_f32_32x32x16_bf16(a, b1, d1, 0, 0, 0);
    }
#pragma unroll
    for (int r = 0; r < 16; ++r) { const int row = wrow + crow(r, hi);
        const unsigned v0 = pkbf(d0[r], 0.f) & 0xffffu, v1 = pkbf(d1[r], 0.f) & 0xffffu;
        if (i == 0) { u16* o = (u16*)(P->ws + WS_KCMP) + (size_t)row * 64; o[r32] = (u16)v0; o[32 + r32] = (u16)v1; }
        else { const int bg = row >> 7, n = row & 127; u16* o = (u16*)(P->ws + WS_VCMPT) + (size_t)bg * 64 * 128 + (n & ~15) + pperm(n & 15); o[(size_t)r32 * 128] = (u16)v0; o[(size_t)(32 + r32) * 128] = (u16)v1; }
    }
}

__device__ __forceinline__ void convert_weights(const Ctx& C, KParamsPtr P, int layer) {
    LAS float* scr = (LAS float*)(C.lds + C.wave * 16384);
    const int gw = C.bx * 8 + C.wave, NGW = C.G * 8, lane = C.lane;
    constexpr int I_G = 16 * 88, I_D = 44 * 32, I_IN = 16 * 96, I_O = 16 * 32, I_W1 = 32 * 8;
    constexpr int NIT = 4 * I_G + 2 * I_D + I_IN + I_O + 2 * I_W1;
    unsigned char* ws = P->ws;
    for (int it = gw; it < NIT; it += NGW) {
        int r = it;
        if (r < 4 * I_G) { const int which = r / I_G; r -= which * I_G; const int kb = r / 88, nb = r % 88, n0 = nb * 32;
            const float* W = (which == 0 ? P->ffn1_gate : which == 1 ? P->ffn1_up : which == 2 ? P->ffn2_gate : P->ffn2_up) + (size_t)layer * DM * DFF;
            u16* WT = (u16*)(ws + (which < 2 ? WS_GU1 : WS_GU2));
            tr_item(W, DM, DFF, WT, kb, n0, (n0 >> 7) * 256 + (which & 1) * 128 + (n0 & 127), scr, lane, 1.0f, (which < 2 ? P->norm_ffn1 : P->norm_ffn2) + (size_t)layer * DM); continue; }
        r -= 4 * I_G;
        if (r < 2 * I_D) { const int which = r / I_D; r -= which * I_D; const int kb = r / 32, nb = r % 32;
            const float* W = (which == 0 ? P->ffn1_down : P->ffn2_down) + (size_t)layer * DFF * DM;
            tr_item(W, DFF, DM, (u16*)(ws + (which == 0 ? WS_DN1 : WS_DN2)), kb, nb * 32, nb * 32, scr, lane); continue; }
        r -= 2 * I_D;
        if (r < I_IN) { const int kb = r / 96, nb = r % 96, n0 = nb * 32;
            const float cs = (n0 < C_MK || (n0 >= C_NQ && n0 < C_NKC)) ? 0.125f * LOG2E : (n0 >= C_DQ && n0 < C_DK) ? 0.17677669529663687f * LOG2E : 1.0f;
            tr_item(P->w_in + (size_t)layer * DM * INW, DM, INW, (u16*)(ws + WS_WIN), kb, n0, n0, scr, lane, cs, P->norm_mix + (size_t)layer * DM); continue; }
        r -= I_IN;
        if (r < I_O) { const int kb = r / 32, nb = r % 32; tr_item(P->w_out + (size_t)layer * DM * DM, DM, DM, (u16*)(ws + WS_WOUT), kb, nb * 32, nb * 32, scr, lane); continue; }
        r -= I_O;
        { const int i = r / I_W1; r -= i * I_W1; const int kb = r / 8, nb = r % 8;
            tr_item(P->cmp_w1 + (size_t)(layer * 2 + i) * 2048 * 256, 2048, 256, (u16*)(ws + WS_W1) + (size_t)i * 256 * 2048, kb, nb * 32, nb * 32, scr, lane); }
    }
}
__device__ __forceinline__ void norm_phase(const Ctx& C, const float* src32, const u16* src16, const float* g, u16* dst16, float* dst32, u16* xb0) {
    const int gw = C.bx * 8 + C.wave, NGW = C.G * 8;
    for (int m = gw; m < MTOK; m += NGW) norm_row(src32 ? src32 + (size_t)m * DM : nullptr, src16 ? src16 + (size_t)m * DM : nullptr, g, dst16 ? dst16 + (size_t)m * DM : nullptr, dst32 ? dst32 + (size_t)m * DM : nullptr, xb0 ? xb0 + (size_t)m * DM : nullptr, C.lane);
}

#define XB_TMO      128
#define XB_XCNT(j)  (256  + 64 * (j))
#define XB_XSUB(j)  (1280 + 64 * (j))
#define XB_XGEN(j)  (2304 + 64 * (j))
#define XB_TOP      3328
#define XB_TOPGEN   3392
#define XCD_BAR_WORDS 3456
#define XB_SPIN_CAP (1u << 18)

__device__ __forceinline__ unsigned xb_ld(unsigned* p)              { return __hip_atomic_load(p, __ATOMIC_RELAXED, __HIP_MEMORY_SCOPE_AGENT); }
__device__ __forceinline__ unsigned xb_add(unsigned* p, unsigned v) { return __hip_atomic_fetch_add(p, v, __ATOMIC_RELAXED, __HIP_MEMORY_SCOPE_AGENT); }
__device__ __forceinline__ unsigned xb_xcc_id() { return (unsigned)__builtin_amdgcn_s_getreg((3 << 11) | 20) & 0xFu; }
#define XB_SPIN(cond, bar) do { unsigned _sp = 0; while (cond) { __builtin_amdgcn_s_sleep(1); \
    if ((++_sp & 255u) == 0u) { if (xb_ld(&(bar)[XB_TMO])) break; if (_sp > XB_SPIN_CAP) { atomicAdd(&(bar)[XB_TMO], 1u); break; } } } } while (0)

struct XcdBarrier {
    unsigned* bar; unsigned x;
    volatile LAS unsigned* st;
};

__device__ __forceinline__ XcdBarrier xcd_barrier_post(unsigned* bar, volatile LAS unsigned* st) {
    XcdBarrier b; b.bar = bar; b.x = xb_xcc_id(); b.st = st;
    if (threadIdx.x == 0) (void)xb_add(&bar[XB_XCNT(b.x)], 1u);
    return b;
}
__device__ __forceinline__ void xcd_barrier_complete(unsigned* bar, unsigned x, unsigned& nloc, unsigned& nx) {
    const unsigned G = gridDim.x * gridDim.y * gridDim.z;
    unsigned sum, cnt, mine, sp = 0u;
    for (;;) {
        sum = 0u; cnt = 0u; mine = 0u;
#pragma unroll
        for (unsigned j = 0; j < 16; ++j) { const unsigned c = xb_ld(&bar[XB_XCNT(j)]); sum += c; cnt += (c > 0u) ? 1u : 0u; mine = (j == x) ? c : mine; }
        if (sum == G) break;
        __builtin_amdgcn_s_sleep(1);
        if ((++sp & 255u) == 0u) { if (xb_ld(&bar[XB_TMO])) break; if (sp > XB_SPIN_CAP) { atomicAdd(&bar[XB_TMO], 1u); break; } }
    }
    nloc = mine > 0u ? mine : 1u; nx = cnt > 0u ? cnt : 1u;
}

__device__ __forceinline__ void xcd_barrier(const XcdBarrier& b) {
    asm volatile("s_waitcnt vmcnt(0)" ::: "memory");
    __syncthreads();
    if (threadIdx.x == 0) {
        unsigned* bar = b.bar;
        __builtin_amdgcn_s_waitcnt(0);
        unsigned nloc = b.st[0], nx = b.st[1];
        if (nloc == 0u) { xcd_barrier_complete(bar, b.x, nloc, nx); b.st[0] = nloc; b.st[1] = nx; }
        const unsigned old = xb_add(&bar[XB_XSUB(b.x)], 1u);
        const unsigned gen = old / nloc;
        if (old + 1u == (gen + 1u) * nloc) {
            __builtin_amdgcn_fence(__ATOMIC_RELEASE, "agent");
            asm volatile("s_waitcnt vmcnt(0)" ::: "memory");
            const unsigned og = xb_add(&bar[XB_TOP], 1u);
            const unsigned tg = og / nx;
            if (og + 1u == (tg + 1u) * nx) xb_add(&bar[XB_TOPGEN], 1u);
            else XB_SPIN(xb_ld(&bar[XB_TOPGEN]) == tg, bar);
            __builtin_amdgcn_fence(__ATOMIC_ACQUIRE, "agent");
            xb_add(&bar[XB_XGEN(b.x)], 1u);
            asm volatile("s_waitcnt vmcnt(0)" ::: "memory");
        } else {
            XB_SPIN(xb_ld(&bar[XB_XGEN(b.x)]) == gen, bar);
            __builtin_amdgcn_fence(__ATOMIC_ACQUIRE, "agent");
            asm volatile("s_waitcnt vmcnt(0)" ::: "memory");
        }
    }
    __syncthreads();
}


__device__ __forceinline__ void fill_rtab(const Ctx& C, const pg8::StaticOrder& S, const float* SS, LAS float* rtab) {
    LAS int* pml = (LAS int*)(rtab + 11 * 256);
    int nu = 0; { pg8::Unit u_; for (int i_ = 0; i_ < 11 && S.next(i_, u_); ++i_) { if (C.tid == 0) pml[i_] = u_.pm; nu = i_ + 1; } }
    __syncthreads();
    const int tot = nu * 256; float rsv[6];
#pragma unroll
    for (int k = 0; k < 6; ++k) { const int e = C.tid + 512 * k; rsv[k] = e < tot ? pg8::row_rstd(SS, pml[e >> 8] * 256 + (e & 255)) : 0.f; }
#pragma unroll
    for (int k = 0; k < 6; ++k) { const int e = C.tid + 512 * k; if (e < tot) rtab[e] = rsv[k]; }
    __syncthreads();
}
__device__ __forceinline__ void x0_phase(const Ctx& C, const float* src, u16* xb, float* ss) {
    const int gw = C.bx * 8 + C.wave, NGW = C.G * 8, lane = C.lane;
    for (int m = gw; m < MTOK; m += NGW) {
        const f32x4* xr = (const f32x4*)(src + (size_t)m * DM) + lane; float s = 0.f;
#pragma unroll
        for (int j = 0; j < 4; ++j) { const f32x4 v = xr[64 * j]; s += (v.x * v.x + v.y * v.y) + (v.z * v.z + v.w * v.w);
            u32x2 o; o.x = pkbf(v.x, v.y); o.y = pkbf(v.z, v.w); *((u32x2*)(xb + (size_t)m * DM) + lane + 64 * j) = o; }
        s = wave_sum(s, lane);
        if (lane < 16) ss[(size_t)m * 16 + lane] = lane == 0 ? s : 0.f;
    }
}
__device__ __forceinline__ void unit_publish(unsigned* flag, int tid) {
    asm volatile("s_waitcnt vmcnt(0)" ::: "memory"); __syncthreads();
    if (tid == 0) { __builtin_amdgcn_fence(__ATOMIC_RELEASE, "agent"); asm volatile("s_waitcnt vmcnt(0)" ::: "memory"); __hip_atomic_store(flag, 1u, __ATOMIC_RELAXED, __HIP_MEMORY_SCOPE_AGENT); }
}
__device__ __forceinline__ void unit_wait(unsigned* f0, unsigned* f1, int tid) {
    if (tid == 0) { unsigned sp = 0;
        while ((__hip_atomic_load(f0, __ATOMIC_RELAXED, __HIP_MEMORY_SCOPE_AGENT) == 0u || __hip_atomic_load(f1, __ATOMIC_RELAXED, __HIP_MEMORY_SCOPE_AGENT) == 0u) && ++sp < (1u << 24)) __builtin_amdgcn_s_sleep(8);
        __builtin_amdgcn_fence(__ATOMIC_ACQUIRE, "agent"); asm volatile("s_waitcnt vmcnt(0)" ::: "memory"); }
    __syncthreads();
}
struct OneUnit { int pm;
    __device__ __forceinline__ bool next(int i, pg8::Unit& u) const { if (i) return false; u.pm = pm; u.pn = 0; return true; }
    __device__ __forceinline__ void a_ready(const pg8::Unit&) const {}
    __device__ __forceinline__ void done(const pg8::Unit&) const {} };
__global__ void __launch_bounds__(512, 2) hybrid_fwd(Params P0) {
    extern __shared__ __attribute__((aligned(16))) unsigned char lds_raw[];
    const KParamsPtr kp0 = (KParamsPtr)__builtin_amdgcn_kernarg_segment_ptr();
    cg::grid_group grid = cg::this_grid();
    { volatile LAS unsigned* misc = (volatile LAS unsigned*)((LAS unsigned char*)lds_raw + MISC_OFF); if (threadIdx.x < 2) misc[threadIdx.x] = 0u; }
    __syncthreads();
    XcdBarrier bar = xcd_barrier_post((unsigned*)(P0.ws + WS_CTL) + 1024, (volatile LAS unsigned*)((LAS unsigned char*)lds_raw + MISC_OFF));
    const int ph_lo = P0.ph_lo, ph_hi = P0.ph_hi; const int wave_s = __builtin_amdgcn_readfirstlane(threadIdx.x >> 6);
    bool redone = false; (void)redone;
    for (int ph = ph_lo; ph < ph_hi; ++ph) {
        KParamsPtr kpl = kp0; asm volatile("" : "+s"(kpl));
        const KParamsPtr P = kpl; unsigned char* ws = P->ws;
        u16* XN = (u16*)(ws + WS_XN); u16* HB = (u16*)(ws + WS_PROJ);
        int G = gridDim.x, bx = blockIdx.x; asm volatile("" : "+s"(G), "+s"(bx));
        Ctx C; C.G = G; C.bx = bx; C.lds = (LAS unsigned char*)lds_raw; C.wave = wave_s; C.lane = lane_opaque(); C.tid = wave_s * 64 + C.lane; C.r32 = C.lane & 31; C.hi = C.lane >> 5;
        C.proj = (u16*)(ws + WS_PROJ); C.obuf = (u16*)(ws + WS_XN); C.vt = (u16*)(ws + WS_VT);
        const int layer = ph / NPH_L, s = ph % NPH_L;
        if (ph != NPH - 1 && (s == 7 || s == 3 || s == 11 || s == 8 || s == 9)) continue;
        float* SS = (float*)(ws + WS_SS);
        u16* XB = (u16*)(ws + WS_XB);
        if (ph == NPH - 1) { norm_phase(C, nullptr, XB, P->final_norm, nullptr, P->out, nullptr); }
        else switch (s) {
        case 0: { convert_weights(C, P, layer); if (layer == 0) { __syncthreads(); x0_phase(C, P->x, XB, SS); } } break;
#ifndef NO_GEMM
#ifndef NO_G1
        case 1: case 12: {
            pg8::Gemm g{XB, (const u16*)(ws + (s == 1 ? WS_GU1 : WS_GU2)), MTOK, 2 * DFF, DM}; pg8::StaticOrder S; S.init(MTOK, 2 * DFF, G, bx);
            LAS float* rtab = (LAS float*)(C.lds + RTAB_OFF); fill_rtab(C, S, SS, rtab);
            pg8::EpiSwiGLU E{HB, DFF, rtab, 0};
            pg8::gemm_phase<pg8::EpiSwiGLU, pg8::StaticOrder, true, true>(C.lds, g, S, E, C.wave); } break;
#endif
#ifndef NO_G2
        case 2: case 13: case 10: {
            const u16* A = (s == 10) ? (const u16*)XN : (const u16*)HB; const u16* Bt = (const u16*)(ws + (s == 2 ? WS_DN1 : s == 13 ? WS_DN2 : WS_WOUT));
            pg8::Gemm g{A, Bt, MTOK, DM, s == 10 ? DM : DFF}; pg8::StaticOrder S; S.init(MTOK, DM, G, bx);
            pg8::EpiResid E{XB, DM, s == 10 ? 1.0f : 0.5f, SS};
            pg8::gemm_phase<pg8::EpiResid, pg8::StaticOrder, false, true>(C.lds, g, S, E, C.wave); } break;
#endif
#ifndef NO_G4
        case 4: {
            pg8::Gemm g{XB, (const u16*)(ws + WS_WIN), MTOK, PW, DM}; pg8::StaticOrder S; S.init(MTOK, PW, G, bx);
            LAS float* rtab = (LAS float*)(C.lds + RTAB_OFF); fill_rtab(C, S, SS, rtab);
            pg8::EpiBf16<0> E{C.proj, PW, rtab, 0};
            pg8::gemm_phase<pg8::EpiBf16<0>, pg8::StaticOrder, true, true>(C.lds, g, S, E, C.wave); } break;
#endif
#endif
#ifndef NO_PREP
        case 5: prep_a(C, P, layer); prep_vk(C, P, 0); break;
#endif
#if !defined(NO_GEMM) && !defined(NO_G6)
        case 6: {
            unsigned* ctl = (unsigned*)(ws + WS_CTL); unsigned* qctr = ctl + 8192 + 64 * ph + (redone ? 32 : 0); unsigned* fcomp = ctl + 16384 + 64 * ph; unsigned* fcmp = ctl + 24576 + 256 * (ph / NPH_L);
            volatile LAS unsigned* qslot = (volatile LAS unsigned*)(C.lds + MISC_OFF + 16);
            for (;;) {
                if (C.tid == 0) *qslot = __hip_atomic_fetch_add(qctr, 1u, __ATOMIC_RELAXED, __HIP_MEMORY_SCOPE_AGENT);
                __syncthreads();
                const unsigned u = *qslot;
                __syncthreads();
                if (u >= 32u + 512u + 256u + 1024u + 512u) break;
                if (u < 32u) { const int i = (int)u >> 4, tile = (int)u & 15;
                    pg8::Gemm g{(const u16*)XN + (size_t)i * 4096 * 2048, (const u16*)(ws + WS_W1) + (size_t)i * 256 * 2048, 4096, 256, 2048}; OneUnit S{tile};
                    pg8::EpiBf16<1> E{(u16*)(ws + WS_HID) + (size_t)i * 4096 * 256, 256, nullptr, 0};
                    pg8::gemm_phase<pg8::EpiBf16<1>, OneUnit, true, true>(C.lds, g, S, E, C.wave);
                    __builtin_amdgcn_fence(__ATOMIC_RELEASE, "agent"); __syncthreads(); __builtin_amdgcn_fence(__ATOMIC_ACQUIRE, "agent");
                    prep_c(C, P, layer, i * 4096 + tile * 256);
                    unit_publish(fcomp + u, C.tid);
                    __syncthreads();
                } else if (u < 544u || u >= 1824u) { const unsigned v = u < 544u ? u - 32u : u - 1824u + 512u; const int qb = 7 - (int)(v >> 7), w = (int)(v & 127);
                    if (w < 64) {
#ifndef NO_DIFF
                        diff_unit(C, P, layer, w >> 2, w & 3, qb);
#endif
                    } else {
#ifndef NO_MOBA
                        moba_unit(C, P, (w - 64) >> 2, w & 3, qb);
#endif
                    }
                } else if (u < 800u) { const int c = (int)u - 544, qblk = 7 - (c >> 5), bg = c & 31;
                    unit_wait(fcomp + (bg >> 1), fcomp + 16 + (bg >> 1), C.tid);
#ifndef NO_CMP
                    cmp_unit(C, P, bg >> 1, bg & 1, qblk);
#endif
                    unit_publish(fcmp + bg * 8 + qblk, C.tid);
                    __syncthreads();
                } else { const int v = (int)u - 800, qb = 7 - (v >> 7), b = (v & 127) >> 3, hq = v & 7; unsigned* f = fcmp + (b * 2 + (hq >> 2)) * 8 + qb;
                    unit_wait(f, f, C.tid);
#ifndef NO_ATT2
                    nsa_unit(C, P, b, hq, qb);
#endif
                }
            } } break;
#endif
        default: break;
        }
        if (ph + 1 < ph_hi) { if (ph == ph_lo) grid.sync(); else xcd_barrier(bar); }
#ifdef PROBE_LO
        if (ph != NPH - 1 && s == PROBE_HI) { if (!redone) { ph -= (PROBE_HI - PROBE_LO + 1); redone = true; } else redone = false; }
#endif
#ifdef PROBE_SYNC
        if (ph + 1 < ph_hi) xcd_barrier(bar);
#endif
    }
}

#ifndef COOP
#define COOP 1
#endif
extern "C" void kernel_launch(void* const* d_in, const int* in_sizes, int n_in, void* d_out, int out_size, void* d_ws, size_t ws_size, hipStream_t stream) {
    static int grid = 0;
    if (grid == 0) {
        if (n_in != 19 || out_size != MTOK * DM || ws_size < WS_END) { fprintf(stderr, "kernel_launch: unexpected shapes (n_in %d out %d ws %zu)\n", n_in, out_size, ws_size); grid = -1; return; }
        int dev = 0, cus = 0, per_cu = 0;
        (void)hipGetDevice(&dev); (void)hipDeviceGetAttribute(&cus, hipDeviceAttributeMultiprocessorCount, dev);
        if (hipFuncSetAttribute((const void*)hybrid_fwd, hipFuncAttributeMaxDynamicSharedMemorySize, LDS_BYTES) != hipSuccess) { fprintf(stderr, "kernel_launch: hipFuncSetAttribute failed\n"); grid = -1; return; }
        if (hipOccupancyMaxActiveBlocksPerMultiprocessor(&per_cu, (const void*)hybrid_fwd, 512, LDS_BYTES) != hipSuccess || per_cu < 1) { fprintf(stderr, "kernel_launch: occupancy query says %d\n", per_cu); per_cu = 1; }
        (void)hipGetLastError();
        grid = cus * per_cu;
    }
    if (grid < 0) return;
    Params p{};
    p.x = (const float*)d_in[0]; p.rel_bias = (const float*)d_in[1]; p.norm_ffn1 = (const float*)d_in[2]; p.ffn1_gate = (const float*)d_in[3]; p.ffn1_up = (const float*)d_in[4]; p.ffn1_down = (const float*)d_in[5];
    p.norm_mix = (const float*)d_in[6]; p.w_in = (const float*)d_in[7]; p.diff_lambda = (const float*)d_in[8]; p.diff_subln = (const float*)d_in[9]; p.cmp_pe = (const float*)d_in[10]; p.cmp_w1 = (const float*)d_in[11];
    p.cmp_w2 = (const float*)d_in[12]; p.w_out = (const float*)d_in[13]; p.norm_ffn2 = (const float*)d_in[14]; p.ffn2_gate = (const float*)d_in[15]; p.ffn2_up = (const float*)d_in[16]; p.ffn2_down = (const float*)d_in[17];
    p.final_norm = (const float*)d_in[18]; p.out = (float*)d_out; p.ws = (unsigned char*)d_ws;
    for (int l = 0; l < 4; ++l) p.lam_init[l] = (float)(0.8 - 0.6 * exp(-0.3 * (double)l));
#if COOP
    if (hipMemsetAsync((char*)d_ws + WS_CTL, 0, CTL_ZERO_BYTES, stream) != hipSuccess) { fprintf(stderr, "kernel_launch: memset of barrier words failed\n"); return; }
    p.ph_lo = 0; p.ph_hi = NPH;
    void* args[] = {&p};
    hipError_t e = hipLaunchCooperativeKernel((const void*)hybrid_fwd, dim3(grid), dim3(512), args, LDS_BYTES, stream);
    if (e != hipSuccess) fprintf(stderr, "cooperative launch failed: %s (grid %d)\n", hipGetErrorString(e), grid);
#else
    for (int ph = 0; ph < NPH; ++ph) { p.ph_lo = ph; p.ph_hi = ph + 1; hipLaunchKernelGGL(hybrid_fwd, dim3(grid), dim3(512), LDS_BYTES, stream, p); }
#endif
}
```

```cpp
#include <hip/hip_runtime.h>
#include <hip/hip_cooperative_groups.h>
#include <cstdio>
#include <cstdint>
#include <cmath>
namespace cg = cooperative_groups;
#define COOP 1
namespace pg8 {
#define PG8_LAS __attribute__((address_space(3)))
typedef unsigned short bf16_t;
typedef short bf16x8 __attribute__((ext_vector_type(8)));
typedef float f32x4 __attribute__((ext_vector_type(4)));
typedef unsigned u32x4 __attribute__((ext_vector_type(4)));
constexpr int BM = 256, BK = 64, HALF = 128, HTB = HALF * BK * 2  , STAGE_BYTES = 8 * HTB, NXCD = 8, WGM = 8;

__host__ __device__ __forceinline__ int lds_byte(int r, int c) { const int st = (r >> 4) * 2 + (c >> 5), rr = r & 15, cc = c & 31, ob = rr * 64 + cc * 2; return st * 1024 + (ob ^ (((ob >> 9) & 1) << 5)); }
__host__ __device__ __forceinline__ void stage_rc(int b, int& R, int& C) { const int st = b / 1024, sb = b % 1024, swz = sb ^ (((sb >> 9) & 1) << 5); R = (st >> 1) * 16 + swz / 64; C = (st & 1) * 32 + (swz % 64) / 2; }
__host__ __device__ __forceinline__ int perm32(int rho) { const int n = rho >> 4, i = rho & 15; return 8 * (i >> 2) + 4 * n + (i & 3); }

struct Unit { int pm, pn; };
struct Gemm { const bf16_t* A; const bf16_t* Bt; int M, N, K; };

struct StaticOrder {
    int nM, nN, nwg, G, c;
    __host__ __device__ void init(int M, int N, int G_, int c_) { nM = M / BM; nN = N / BM; nwg = nM * nN; G = G_; c = c_; }
    __host__ __device__ bool next(int i, Unit& u) const {
        const long L = (long)i * G + c; if (L >= nwg) return false;
        int wgid = (int)L; { const int q = nwg / NXCD, r = nwg % NXCD, xcd = wgid % NXCD, off = wgid / NXCD; wgid = (xcd < r ? xcd * (q + 1) : r * (q + 1) + (xcd - r) * q) + off; }
        const int nig = WGM * nN, gid = wgid / nig, fm = gid * WGM, gsz = (nM - fm) < WGM ? (nM - fm) : WGM;
        u.pm = fm + ((wgid % nig) % gsz); u.pn = (wgid % nig) / gsz; return true;
    }
    __device__ __forceinline__ void a_ready(const Unit&) const {}
    __device__ __forceinline__ void done(const Unit&) const {}
};

__device__ __forceinline__ unsigned cvt_pk_bf16(float lo, float hi) { unsigned r; asm volatile("v_cvt_pk_bf16_f32 %0, %1, %2" : "=v"(r) : "v"(lo), "v"(hi)); return r; }

__device__ __forceinline__ float ex2(float x) { return __builtin_amdgcn_exp2f(x); }
__device__ __forceinline__ float rcpf_(float x) { return __builtin_amdgcn_rcpf(x); }
__device__ __forceinline__ float silu_f(float x) { return x * rcpf_(1.0f + ex2(-1.4426950408889634f * x)); }
__device__ __forceinline__ float gelu_tanh_f(float x) { const float y2 = 2.0f * 0.7978845608028654f * (x + 0.044715f * x * x * x); return x * (1.0f - rcpf_(1.0f + ex2(1.4426950408889634f * y2))); }

__device__ __forceinline__ float row_rstd(const float* ss, int row) {
    const f32x4* p = (const f32x4*)(ss + (size_t)row * 16); const f32x4 a = p[0], b = p[1], c = p[2], d = p[3];
    const float s = ((a[0] + a[1]) + (a[2] + a[3])) + ((b[0] + b[1]) + (b[2] + b[3])) + ((c[0] + c[1]) + (c[2] + c[3])) + ((d[0] + d[1]) + (d[2] + d[3]));
    return 1.0f / sqrtf(s * (1.0f / 1024.0f) + 1e-6f);
}

struct EpiSwiGLU {
    static constexpr bool PERM = true, AFTER_DRAIN = false;
    bf16_t* O; int ldc; const PG8_LAS float* rtab; mutable int ui;
    __device__ __forceinline__ void operator()(const f32x4 (&acc)[2][2][4][2], const Unit& u, int wr, int wc, int fr, int fq) const {
        const int row0 = u.pm * BM + wr * 64 + fr; const int col0 = u.pn * HALF + wc * 32 + 8 * fq;
#pragma unroll
        for (int ai = 0; ai < 2; ++ai)
#pragma unroll
            for (int m = 0; m < 4; ++m) { bf16_t* rowp = O + (size_t)(row0 + ai * HALF + m * 16) * ldc + col0;
                const float rs = rtab[ui * 256 + wr * 64 + fr + ai * HALF + m * 16];
                const f32x4 g0 = acc[ai][0][m][0] * rs, g1 = acc[ai][0][m][1] * rs, u0 = acc[ai][1][m][0] * rs, u1 = acc[ai][1][m][1] * rs;
                u32x4 w; w.x = cvt_pk_bf16(silu_f(g0[0]) * u0[0], silu_f(g0[1]) * u0[1]); w.y = cvt_pk_bf16(silu_f(g0[2]) * u0[2], silu_f(g0[3]) * u0[3]);
                w.z = cvt_pk_bf16(silu_f(g1[0]) * u1[0], silu_f(g1[1]) * u1[1]); w.w = cvt_pk_bf16(silu_f(g1[2]) * u1[2], silu_f(g1[3]) * u1[3]);
                *(u32x4*)rowp = w; asm volatile("" ::: "memory"); }
        ++ui;
    }
};
template <int ACT> struct EpiBf16 {
    static constexpr bool PERM = true, AFTER_DRAIN = false;
    bf16_t* O; int ldc; const PG8_LAS float* rtab; mutable int ui;
    __device__ __forceinline__ void operator()(const f32x4 (&acc)[2][2][4][2], const Unit& u, int wr, int wc, int fr, int fq) const {
        const int row0 = u.pm * BM + wr * 64 + fr; const int col0 = u.pn * BM + wc * 32 + 8 * fq;
#pragma unroll
        for (int ai = 0; ai < 2; ++ai)
#pragma unroll
            for (int m = 0; m < 4; ++m) { bf16_t* rowp = O + (size_t)(row0 + ai * HALF + m * 16) * ldc + col0;
                const float rs = rtab ? rtab[ui * 256 + wr * 64 + fr + ai * HALF + m * 16] : 1.0f;
#pragma unroll
                for (int bj = 0; bj < 2; ++bj) { f32x4 v0 = acc[ai][bj][m][0] * rs, v1 = acc[ai][bj][m][1] * rs;
                    if (ACT == 1) { v0 = (f32x4){gelu_tanh_f(v0[0]), gelu_tanh_f(v0[1]), gelu_tanh_f(v0[2]), gelu_tanh_f(v0[3])}; v1 = (f32x4){gelu_tanh_f(v1[0]), gelu_tanh_f(v1[1]), gelu_tanh_f(v1[2]), gelu_tanh_f(v1[3])}; }
                    u32x4 w; w.x = cvt_pk_bf16(v0[0], v0[1]); w.y = cvt_pk_bf16(v0[2], v0[3]); w.z = cvt_pk_bf16(v1[0], v1[1]); w.w = cvt_pk_bf16(v1[2], v1[3]);
                    *(u32x4*)(rowp + bj * HALF) = w; } asm volatile("" ::: "memory"); }
        ++ui;
    }
};
struct EpiResid {
    static constexpr bool PERM = true, AFTER_DRAIN = false;
    bf16_t* xb; int ldc; float alpha; float* ss;
    __device__ __forceinline__ void operator()(const f32x4 (&acc)[2][2][4][2], const Unit& u, int wr, int wc, int fr, int fq) const {
        const int row0 = u.pm * BM + wr * 64 + fr; const int col0 = u.pn * BM + wc * 32 + 8 * fq; const int lane = fq * 16 + fr;
#pragma unroll
        for (int ai = 0; ai < 2; ++ai) {
            u32x4 pre[4][2];
#pragma unroll
            for (int m = 0; m < 4; ++m)
#pragma unroll
                for (int bj = 0; bj < 2; ++bj) pre[m][bj] = *(const u32x4*)(xb + (size_t)(row0 + ai * HALF + m * 16) * ldc + col0 + bj * HALF);
#pragma unroll
            for (int m = 0; m < 4; ++m) { const int row = row0 + ai * HALF + m * 16; bf16_t* rowp = xb + (size_t)row * ldc + col0; float sq = 0.f;
#pragma unroll
                for (int bj = 0; bj < 2; ++bj) { const u32x4 p = pre[m][bj]; const f32x4 a0 = acc[ai][bj][m][0] * alpha, a1 = acc[ai][bj][m][1] * alpha;
                    const float x0 = __uint_as_float(p.x << 16) + a0[0], x1 = __uint_as_float(p.x & 0xffff0000u) + a0[1], x2 = __uint_as_float(p.y << 16) + a0[2], x3 = __uint_as_float(p.y & 0xffff0000u) + a0[3];
                    const float x4 = __uint_as_float(p.z << 16) + a1[0], x5 = __uint_as_float(p.z & 0xffff0000u) + a1[1], x6 = __uint_as_float(p.w << 16) + a1[2], x7 = __uint_as_float(p.w & 0xffff0000u) + a1[3];
                    sq += ((x0 * x0 + x1 * x1) + (x2 * x2 + x3 * x3)) + ((x4 * x4 + x5 * x5) + (x6 * x6 + x7 * x7));
                    u32x4 w; w.x = cvt_pk_bf16(x0, x1); w.y = cvt_pk_bf16(x2, x3); w.z = cvt_pk_bf16(x4, x5); w.w = cvt_pk_bf16(x6, x7);
                    *(u32x4*)(rowp + bj * HALF) = w; }
                sq += __int_as_float(__builtin_amdgcn_ds_bpermute((lane ^ 16) << 2, __float_as_int(sq)));
                sq += __int_as_float(__builtin_amdgcn_ds_bpermute((lane ^ 32) << 2, __float_as_int(sq)));
                if (fq == 0) ss[(size_t)row * 16 + u.pn * 4 + wc] = sq; }
            asm volatile("" ::: "memory");
        }
    }
};
template <class Epi, class Sched, bool ALIGN_EPI = false, bool SP2 = false>
__device__ __forceinline__ void gemm_phase(PG8_LAS unsigned char* lds, const Gemm g, const Sched& S, const Epi& E, const int wave_in) {
    int tid_l; asm volatile("v_mbcnt_lo_u32_b32 %0, -1, 0\n\tv_mbcnt_hi_u32_b32 %0, -1, %0" : "=v"(tid_l)); tid_l += wave_in * 64;
    const int tid = tid_l, wid = __builtin_amdgcn_readfirstlane(tid >> 6), lane = tid & 63, wr = wid >> 2, wc = wid & 3, fr = lane & 15, fq = lane >> 4;
    const int K = g.K, nt = K / BK;
    unsigned voffA[2], voffB[2];
#pragma unroll
    for (int i = 0; i < 2; ++i) { int R, C; stage_rc(tid * 16 + i * 8192, R, C); const int Rb = Epi::PERM ? ((R & ~31) + perm32(R & 31)) : R;
        voffA[i] = (unsigned)(R * K + C) * 2u; voffB[i] = (unsigned)(Rb * K + C) * 2u; }
    const size_t kstep = (size_t)(BK * 2);
    const size_t hstep = (size_t)HALF * K * 2;
    const size_t tstep = 2 * hstep;
    const unsigned ldsw = (unsigned)wid * 1024u;
    const int aoff = lds_byte(wr * 64 + fr, fq * 8), boff = lds_byte(wc * 32 + fr, fq * 8);
#define PG8_SA(b, h) (((b) * 2 + (h)) * HTB)
#define PG8_SB(b, h) ((4 + (b) * 2 + (h)) * HTB)
#define PG8_STAGE(bufoff, gbase, voff) do { _Pragma("unroll") for (int _i = 0; _i < 2; ++_i) \
        __builtin_amdgcn_global_load_lds((const unsigned*)((const char*)(gbase) + (voff)[_i]), (PG8_LAS unsigned*)(lds + (bufoff) + ldsw + _i * 8192), 16, 0, 0); } while (0)
#define PG8_LDA(dst, b, h) do { _Pragma("unroll") for (int m = 0; m < 4; ++m) _Pragma("unroll") for (int k = 0; k < 2; ++k) dst[m][k] = *(const PG8_LAS bf16x8*)(lds + PG8_SA(b, h) + aoff + m * 2048 + k * 1024); } while (0)
#define PG8_LDB(dst, b, h) do { _Pragma("unroll") for (int n = 0; n < 2; ++n) _Pragma("unroll") for (int k = 0; k < 2; ++k) dst[n][k] = *(const PG8_LAS bf16x8*)(lds + PG8_SB(b, h) + boff + n * 2048 + k * 1024); } while (0)
#define PG8_MMA(ai, bj, At, Bt) do { __builtin_amdgcn_s_setprio(1); _Pragma("unroll") for (int m = 0; m < 4; ++m) _Pragma("unroll") for (int n = 0; n < 2; ++n) _Pragma("unroll") for (int k = 0; k < 2; ++k) \
        acc[ai][bj][m][n] = __builtin_amdgcn_mfma_f32_16x16x32_bf16(Bt[n][k], At[m][k], acc[ai][bj][m][n], 0, 0, 0); __builtin_amdgcn_s_setprio(0); } while (0)
#define PG8_WAIT_V(n) asm volatile("s_waitcnt vmcnt(" #n ")" ::: "memory")
#define PG8_WAIT_L(n) asm volatile("s_waitcnt lgkmcnt(" #n ")" ::: "memory")
#define PG8_BAR __builtin_amdgcn_s_barrier()
#define PG8_SCHED __builtin_amdgcn_sched_barrier(0)
    Unit cur, nxt; int ui = 0;
    if (!S.next(0, cur)) return;
    f32x4 acc[2][2][4][2];
#pragma unroll
    for (int a = 0; a < 2; ++a)
#pragma unroll
        for (int b = 0; b < 2; ++b)
#pragma unroll
            for (int m = 0; m < 4; ++m)
#pragma unroll
                for (int n = 0; n < 2; ++n) acc[a][b][m][n] = (f32x4){0.f, 0.f, 0.f, 0.f};
    bf16x8 At[4][2], B0[2][2], B1[2][2];
    const char* cA = (const char*)g.A + (size_t)cur.pm * tstep; const char* cB = (const char*)g.Bt + (size_t)cur.pn * tstep;
    S.a_ready(cur);
    if constexpr (SP2) {
        PG8_STAGE(PG8_SB(0, 0), cB, voffB); PG8_STAGE(PG8_SB(0, 1), cB + hstep, voffB); PG8_STAGE(PG8_SA(0, 0), cA, voffA); PG8_STAGE(PG8_SA(0, 1), cA + hstep, voffA);
        if (wr == 1) PG8_BAR;
        PG8_WAIT_V(2); PG8_BAR;
        PG8_STAGE(PG8_SB(1, 0), cB + kstep, voffB); PG8_STAGE(PG8_SA(1, 0), cA + kstep, voffA); PG8_STAGE(PG8_SB(1, 1), cB + hstep + kstep, voffB);
        PG8_WAIT_V(6); PG8_BAR;
    } else {
        PG8_STAGE(PG8_SB(0, 0), cB, voffB); PG8_STAGE(PG8_SA(0, 0), cA, voffA); PG8_STAGE(PG8_SB(0, 1), cB + hstep, voffB); PG8_STAGE(PG8_SA(0, 1), cA + hstep, voffA);
        if (wr == 1) PG8_BAR;
        PG8_WAIT_V(4); PG8_BAR;
        PG8_STAGE(PG8_SB(1, 0), cB + kstep, voffB); PG8_STAGE(PG8_SA(1, 0), cA + kstep, voffA); PG8_STAGE(PG8_SB(1, 1), cB + hstep + kstep, voffB);
        PG8_WAIT_V(6); PG8_BAR;
    }
    for (;;) {
        const bool has_next = S.next(ui + 1, nxt);
        const char* nA = has_next ? (const char*)g.A + (size_t)nxt.pm * tstep : cA; const char* nB = has_next ? (const char*)g.Bt + (size_t)nxt.pn * tstep : cB;
        for (int t = 0; t < nt; t += 2) {
            const bool last = (t == nt - 2);
            const char* a1 = cA + (size_t)(t + 1) * kstep;
            const char* a2 = last ? nA : cA + (size_t)(t + 2) * kstep; const char* b2 = last ? nB : cB + (size_t)(t + 2) * kstep;
            const char* a3 = a2 + kstep; const char* b3 = b2 + kstep;
            if (last && has_next) S.a_ready(nxt);
            if constexpr (SP2) {
            PG8_LDB(B0, 0, 0); PG8_LDB(B1, 0, 1); PG8_SCHED; PG8_LDA(At, 0, 0); PG8_STAGE(PG8_SA(1, 1), a1 + hstep, voffA);
            PG8_WAIT_V(8); PG8_WAIT_L(0); PG8_BAR; PG8_MMA(0, 0, At, B0); PG8_MMA(0, 1, At, B1); PG8_BAR; PG8_SCHED;
            PG8_LDA(At, 0, 1); PG8_STAGE(PG8_SB(0, 0), b2, voffB); PG8_STAGE(PG8_SB(0, 1), b2 + hstep, voffB); PG8_STAGE(PG8_SA(0, 0), a2, voffA);
            PG8_WAIT_V(8); PG8_WAIT_L(0); PG8_BAR; PG8_MMA(1, 0, At, B0); PG8_MMA(1, 1, At, B1); PG8_BAR; PG8_SCHED;
            PG8_LDB(B0, 1, 0); PG8_LDB(B1, 1, 1); PG8_SCHED; PG8_LDA(At, 1, 0); PG8_STAGE(PG8_SA(0, 1), a2 + hstep, voffA);
            PG8_WAIT_V(8); PG8_WAIT_L(0); PG8_BAR; PG8_MMA(0, 0, At, B0); PG8_MMA(0, 1, At, B1); PG8_BAR; PG8_SCHED;
            PG8_LDA(At, 1, 1); PG8_STAGE(PG8_SB(1, 0), b3, voffB); PG8_STAGE(PG8_SB(1, 1), b3 + hstep, voffB); PG8_STAGE(PG8_SA(1, 0), a3, voffA);
            PG8_WAIT_V(8); PG8_WAIT_L(0); PG8_BAR; PG8_MMA(1, 0, At, B0); PG8_MMA(1, 1, At, B1); PG8_BAR; PG8_SCHED;
            } else {
            PG8_LDB(B0, 0, 0); PG8_SCHED; PG8_LDA(At, 0, 0); PG8_STAGE(PG8_SA(1, 1), a1 + hstep, voffA);
            PG8_WAIT_L(8); PG8_BAR; PG8_WAIT_L(0); PG8_MMA(0, 0, At, B0); PG8_BAR; PG8_SCHED;
            PG8_LDB(B1, 0, 1); PG8_STAGE(PG8_SB(0, 0), b2, voffB);
            PG8_BAR; PG8_WAIT_L(0); PG8_MMA(0, 1, At, B1); PG8_BAR;
            PG8_LDA(At, 0, 1); PG8_STAGE(PG8_SA(0, 0), a2, voffA);
            PG8_BAR; PG8_WAIT_L(0); PG8_MMA(1, 0, At, B0); PG8_BAR; PG8_SCHED;
            PG8_STAGE(PG8_SB(0, 1), b2 + hstep, voffB);
            PG8_WAIT_V(6); PG8_BAR; PG8_MMA(1, 1, At, B1); PG8_BAR;
            PG8_LDB(B0, 1, 0); PG8_SCHED; PG8_LDA(At, 1, 0); PG8_STAGE(PG8_SA(0, 1), a2 + hstep, voffA);
            PG8_WAIT_L(8); PG8_BAR; PG8_WAIT_L(0); PG8_MMA(0, 0, At, B0); PG8_BAR; PG8_SCHED;
            PG8_LDB(B1, 1, 1); PG8_STAGE(PG8_SB(1, 0), b3, voffB);
            PG8_BAR; PG8_WAIT_L(0); PG8_MMA(0, 1, At, B1); PG8_BAR;
            PG8_LDA(At, 1, 1); PG8_STAGE(PG8_SA(1, 0), a3, voffA);
            PG8_BAR; PG8_WAIT_L(0); PG8_MMA(1, 0, At, B0); PG8_BAR; PG8_SCHED;
            PG8_STAGE(PG8_SB(1, 1), b3 + hstep, voffB);
            PG8_WAIT_V(6); PG8_BAR; PG8_MMA(1, 1, At, B1); PG8_BAR;
            }
        }
        if constexpr (ALIGN_EPI) { if (wr == 0) PG8_BAR; }
        if constexpr (!Epi::AFTER_DRAIN) { E(acc, cur, wr, wc, fr, fq); S.done(cur); }
        if (!has_next) break;
#pragma unroll
        for (int a = 0; a < 2; ++a)
#pragma unroll
            for (int b = 0; b < 2; ++b)
#pragma unroll
                for (int m = 0; m < 4; ++m)
#pragma unroll
                    for (int n = 0; n < 2; ++n) acc[a][b][m][n] = (f32x4){0.f, 0.f, 0.f, 0.f};
        cur = nxt; cA = nA; cB = nB; ++ui;
        if constexpr (ALIGN_EPI) { if (wr == 1) PG8_BAR; }
    }
    PG8_WAIT_V(0);
    if constexpr (!ALIGN_EPI) { if (wr == 0) PG8_BAR; }
    PG8_BAR;
    if constexpr (Epi::AFTER_DRAIN) { E.fused(acc, cur, wr, wc, fr, fq, lds, wid, lane); S.done(cur); }
#undef PG8_SA
#undef PG8_SB
#undef PG8_STAGE
#undef PG8_LDA
#undef PG8_LDB
#undef PG8_MMA
#undef PG8_WAIT_V
#undef PG8_WAIT_L
#undef PG8_BAR
#undef PG8_SCHED
}
}

#define LAS __attribute__((address_space(3)))
using pg8::ex2; using pg8::rcpf_;
typedef unsigned short u16;
typedef short bf16x8 __attribute__((ext_vector_type(8)));
typedef float f32x4 __attribute__((ext_vector_type(4)));
typedef float f32x16 __attribute__((ext_vector_type(16)));
typedef unsigned u32x4 __attribute__((ext_vector_type(4)));
typedef unsigned u32x2 __attribute__((ext_vector_type(2)));

constexpr int DM = 1024, NB = 16, SEQ = 2048, MTOK = NB * SEQ, DEPTH = 4, DFF = 2816, INW = 2840, PW = 3072;
constexpr int C_MQ = 0, C_MK = 256, C_MV = 512, C_DQ = 768, C_DK = 1024, C_DV = 1280, C_NQ = 1536, C_NKC = 2048, C_NVC = 2176, C_NKS = 2304, C_NVS = 2432, C_NKW = 2560, C_NVW = 2688, C_NG = 2816;
constexpr int NVH = 12;
constexpr float LOG2E = 1.4426950408889634f, NEGF = -1e30f;
constexpr int NPH_L = 14, NPH = NPH_L * DEPTH + 1;
constexpr size_t MiB = 1u << 20;
constexpr size_t WS_GU1 = 1 * MiB, WS_DN1 = 12 * MiB, WS_GU2 = WS_DN1 + 5 * MiB + MiB / 2, WS_DN2 = WS_GU2 + 11 * MiB, WS_WIN = 34 * MiB, WS_WOUT = 40 * MiB, WS_W1 = 42 * MiB;
constexpr size_t WS_PROJ = 44 * MiB, WS_XN = 236 * MiB, WS_VT = 300 * MiB, WS_HID = 348 * MiB, WS_KCMP = 352 * MiB, WS_VCMPT = WS_KCMP + MiB / 2, WS_KMEAN = 353 * MiB, WS_SEL = WS_KMEAN + MiB / 4, WS_XB = 354 * MiB, WS_SS = 418 * MiB, WS_END = 420 * MiB;
static_assert(WS_DN2 + 5 * MiB + MiB / 2 == WS_WIN, "ws map");
constexpr int LDS_BYTES = 147456, MISC_OFF = 147456 - 64, RTAB_OFF = 131072;
constexpr size_t WS_CTL = 0, CTL_ZERO_BYTES = 262144;
constexpr int ATT_K = 0, ATT_V = 32768, ATT_LUT = 32768 + 4 * 8704, ATT_PARK = ATT_LUT + 2816;
constexpr int CMP_K = 0, CMP_V = 18432, CMP_A = 36864, CMP_H = CMP_A + 256 * 33 * 4;

struct Params {
    const float* x; const float* rel_bias; const float* norm_ffn1; const float* ffn1_gate; const float* ffn1_up; const float* ffn1_down;
    const float* norm_mix; const float* w_in; const float* diff_lambda; const float* diff_subln; const float* cmp_pe; const float* cmp_w1; const float* cmp_w2;
    const float* w_out; const float* norm_ffn2; const float* ffn2_gate; const float* ffn2_up; const float* ffn2_down; const float* final_norm;
    float* out; unsigned char* ws;
    float lam_init[4];
    int ph_lo, ph_hi;
};
typedef const __attribute__((address_space(4))) Params* KParamsPtr;

__device__ __forceinline__ float bf2f(unsigned v) { return __uint_as_float(v << 16); }
typedef float f32x2_t __attribute__((ext_vector_type(2))); typedef __bf16 bf16x2_t __attribute__((ext_vector_type(2)));
__device__ __forceinline__ unsigned pkbf(float lo, float hi) { f32x2_t v = {lo, hi}; bf16x2_t b = __builtin_convertvector(v, bf16x2_t); return __builtin_bit_cast(unsigned, b); }
__device__ __forceinline__ int lane_opaque() { int l; asm volatile("v_mbcnt_lo_u32_b32 %0, -1, 0\n\tv_mbcnt_hi_u32_b32 %0, -1, %0" : "=v"(l)); return l; }
__device__ __forceinline__ float wave_sum(float v, int lane) {
#pragma unroll
    for (int o = 1; o < 64; o <<= 1) v += __int_as_float(__builtin_amdgcn_ds_bpermute((lane ^ o) << 2, __float_as_int(v)));
    return v;
}
__device__ __forceinline__ float xhalf_max(float v) { auto rr = __builtin_amdgcn_permlane32_swap(__float_as_uint(v), __float_as_uint(v), false, false); return fmaxf(__uint_as_float(rr[0]), __uint_as_float(rr[1])); }
__device__ __forceinline__ float xhalf_sum(float v) { auto rr = __builtin_amdgcn_permlane32_swap(__float_as_uint(v), __float_as_uint(v), false, false); return __uint_as_float(rr[0]) + __uint_as_float(rr[1]); }
__device__ __forceinline__ float sigmoid_f(float x) { return rcpf_(1.0f + ex2(-LOG2E * x)); }
__device__ __forceinline__ int crow(int r, int hi) { return (r & 3) + 8 * (r >> 2) + 4 * hi; }
__device__ __forceinline__ int kperm(int p) { const int h = p >> 3, j = p & 7; return 8 * (j >> 2) + 4 * h + (j & 3); }
__device__ __forceinline__ int pperm(int k) { return ((k >> 2) & 1) * 8 + (k >> 3) * 4 + (k & 3); }

__device__ __forceinline__ void tr_item(const float* W, int K, int N, u16* WT, int kb, int n0, int dst_row0, LAS float* scr, int lane, float cs = 1.0f, const float* gk = nullptr) {
    const int k0 = 64 * kb; const int n = n0 + (lane & 31); const bool ok = n < N;
    float wv[32];
#pragma unroll
    for (int i = 0; i < 32; ++i) { const int kk = 2 * i + (lane >> 5); wv[i] = ok ? W[(size_t)(k0 + kk) * N + n] : 0.f; }
#pragma unroll
    for (int i = 0; i < 32; ++i) { const int kk = 2 * i + (lane >> 5); scr[kk * 33 + (lane & 31)] = wv[i] * (gk ? gk[k0 + kk] * cs : cs); }
    asm volatile("s_waitcnt lgkmcnt(0)" ::: "memory");
    const int c = lane & 7;
#pragma unroll
    for (int j = 0; j < 4; ++j) { const int nn = (lane >> 3) + 8 * j; const LAS float* s = scr + (8 * c) * 33 + nn;
        u32x4 o; o.x = pkbf(s[0 * 33], s[1 * 33]); o.y = pkbf(s[2 * 33], s[3 * 33]); o.z = pkbf(s[4 * 33], s[5 * 33]); o.w = pkbf(s[6 * 33], s[7 * 33]);
        *(u32x4*)(WT + (size_t)(dst_row0 + nn) * K + k0 + 8 * c) = o; }
    asm volatile("s_waitcnt lgkmcnt(0)" ::: "memory");
}

__device__ __forceinline__ void norm_row(const float* xrow, const u16* xrow16, const float* g, u16* dst16, float* dst32, u16* xb0, int lane) {
    float v[16];
    if (xrow) { const f32x4* xr = (const f32x4*)xrow + 4 * lane;
#pragma unroll
        for (int j = 0; j < 4; ++j) { const f32x4 t = xr[j]; v[4 * j] = t.x; v[4 * j + 1] = t.y; v[4 * j + 2] = t.z; v[4 * j + 3] = t.w; }
        if (xb0) { u32x4 o0, o1; o0.x = pkbf(v[0], v[1]); o0.y = pkbf(v[2], v[3]); o0.z = pkbf(v[4], v[5]); o0.w = pkbf(v[6], v[7]); o1.x = pkbf(v[8], v[9]); o1.y = pkbf(v[10], v[11]); o1.z = pkbf(v[12], v[13]); o1.w = pkbf(v[14], v[15]);
            ((u32x4*)xb0)[2 * lane] = o0; ((u32x4*)xb0)[2 * lane + 1] = o1; }
    } else { const u32x4 p0 = ((const u32x4*)xrow16)[2 * lane], p1 = ((const u32x4*)xrow16)[2 * lane + 1];
        v[0] = bf2f(p0.x & 0xffffu); v[1] = bf2f(p0.x >> 16); v[2] = bf2f(p0.y & 0xffffu); v[3] = bf2f(p0.y >> 16); v[4] = bf2f(p0.z & 0xffffu); v[5] = bf2f(p0.z >> 16); v[6] = bf2f(p0.w & 0xffffu); v[7] = bf2f(p0.w >> 16);
        v[8] = bf2f(p1.x & 0xffffu); v[9] = bf2f(p1.x >> 16); v[10] = bf2f(p1.y & 0xffffu); v[11] = bf2f(p1.y >> 16); v[12] = bf2f(p1.z & 0xffffu); v[13] = bf2f(p1.z >> 16); v[14] = bf2f(p1.w & 0xffffu); v[15] = bf2f(p1.w >> 16); }
    float s = 0.f;
#pragma unroll
    for (int j = 0; j < 16; ++j) s = fmaf(v[j], v[j], s);
    const float rstd = 1.0f / sqrtf(wave_sum(s, lane) * (1.0f / 1024.0f) + 1e-6f);
    const f32x4* gr = (const f32x4*)g + 4 * lane;
#pragma unroll
    for (int j = 0; j < 4; ++j) { const f32x4 gg = gr[j]; v[4 * j] *= rstd * gg.x; v[4 * j + 1] *= rstd * gg.y; v[4 * j + 2] *= rstd * gg.z; v[4 * j + 3] *= rstd * gg.w; }
    if (dst16) { u32x4 o0, o1; o0.x = pkbf(v[0], v[1]); o0.y = pkbf(v[2], v[3]); o0.z = pkbf(v[4], v[5]); o0.w = pkbf(v[6], v[7]); o1.x = pkbf(v[8], v[9]); o1.y = pkbf(v[10], v[11]); o1.z = pkbf(v[12], v[13]); o1.w = pkbf(v[14], v[15]);
        ((u32x4*)dst16)[2 * lane] = o0; ((u32x4*)dst16)[2 * lane + 1] = o1; }
    else {
#pragma unroll
        for (int j = 0; j < 4; ++j) ((f32x4*)dst32)[4 * lane + j] = (f32x4){v[4 * j], v[4 * j + 1], v[4 * j + 2], v[4 * j + 3]}; }
}

struct AState { f32x16 o0, o1; float m, l; };
__device__ __forceinline__ void astate_init(AState& s) {
#pragma unroll
    for (int r = 0; r < 16; ++r) { s.o0[r] = 0.f; s.o1[r] = 0.f; }
    s.m = 0.f; s.l = 0.f;
}
constexpr float ATT_THR = 8.0f;
constexpr int ATT_SLOT = 9216, ATT_NSLOT = 3;
template <int KS0, int NKS>
__device__ __forceinline__ void qk_block(const LAS unsigned char* Ks, const bf16x8 (&qr)[4], int r32, int hi, f32x16& s0, f32x16& s1) {
    f32x16 ci;
#pragma unroll
    for (int r = 0; r < 16; ++r) ci[r] = 0.f;
    const LAS unsigned char* kp = Ks + hi * 1024 + r32 * 16;
#pragma unroll
    for (int ks = 0; ks < NKS; ++ks) {
        const bf16x8 a0 = *(const LAS bf16x8*)(kp + (KS0 + ks) * 2048);
        const bf16x8 a1 = *(const LAS bf16x8*)(kp + (KS0 + ks) * 2048 + 512);
        s0 = __builtin_amdgcn_mfma_f32_32x32x16_bf16(a0, qr[KS0 + ks], ks == 0 ? ci : s0, 0, 0, 0);
        s1 = __builtin_amdgcn_mfma_f32_32x32x16_bf16(a1, qr[KS0 + ks], ks == 0 ? ci : s1, 0, 0, 0);
    }
    __builtin_amdgcn_sched_group_barrier(0x100, 2 * NKS, 0); __builtin_amdgcn_sched_group_barrier(0x008, 2 * NKS, 0);
}
constexpr int ATT_VCH = 1088, ATT_VSLOT = 8 * ATT_VCH;
typedef short v4i16_t __attribute__((ext_vector_type(4)));
__device__ __forceinline__ void pv_block(const LAS unsigned char* Vs, const u32x4 (&pk)[4], int lane, AState& st) {
    const int p = lane & 3, q = (lane & 15) >> 2, dsel = (lane >> 4) & 1, hi = lane >> 5;
    const LAS unsigned char* vp = Vs + (2 * dsel + (p >> 1)) * ATT_VCH + (4 * hi + q) * 16 + (p & 1) * 8;
#pragma unroll
    for (int c = 0; c < 4; ++c) {
        const v4i16_t a0 = __builtin_amdgcn_ds_read_tr16_b64_v4i16((LAS v4i16_t*)(vp + c * 256));
        const v4i16_t a1 = __builtin_amdgcn_ds_read_tr16_b64_v4i16((LAS v4i16_t*)(vp + c * 256 + 128));
        const v4i16_t b0 = __builtin_amdgcn_ds_read_tr16_b64_v4i16((LAS v4i16_t*)(vp + 4 * ATT_VCH + c * 256));
        const v4i16_t b1 = __builtin_amdgcn_ds_read_tr16_b64_v4i16((LAS v4i16_t*)(vp + 4 * ATT_VCH + c * 256 + 128));
        const bf16x8 v0 = (bf16x8){a0[0], a0[1], a0[2], a0[3], a1[0], a1[1], a1[2], a1[3]};
        const bf16x8 v1 = (bf16x8){b0[0], b0[1], b0[2], b0[3], b1[0], b1[1], b1[2], b1[3]};
        const bf16x8 pb = __builtin_bit_cast(bf16x8, pk[c]);
        st.o0 = __builtin_amdgcn_mfma_f32_32x32x16_bf16(v0, pb, st.o0, 0, 0, 0);
        st.o1 = __builtin_amdgcn_mfma_f32_32x32x16_bf16(v1, pb, st.o1, 0, 0, 0);
    }
}
__device__ __forceinline__ void glds16(const void* gsrc, unsigned lds_dst) { unsigned keep;
    asm volatile("s_mov_b32 %0, m0\n\ts_mov_b32 m0, %2\n\ts_nop 0\n\tglobal_load_lds_dwordx4 %1, off\n\ts_mov_b32 m0, %0" : "=&s"(keep) : "v"(gsrc), "s"(lds_dst) : "memory"); }
__device__ __forceinline__ void lut_add(f32x16& s0, f32x16& s1, const LAS float* lutz, int dbase, float cc) {
    const LAS float* lp = lutz + (dbase - 59);
#pragma unroll
    for (int r = 0; r < 16; ++r) { const int ko = (r & 3) + 8 * (r >> 2);
        s0[r] += lp[59 - ko] + cc; s1[r] += lp[27 - ko] + cc; }
}
__device__ __forceinline__ void const_add(f32x16& s0, f32x16& s1, float cc) {
#pragma unroll
    for (int r = 0; r < 16; ++r) { s0[r] += cc; s1[r] += cc; }
}
__device__ __forceinline__ float row_max(const f32x16& s0, const f32x16& s1) {
    float mx = fmaxf(s0[0], s1[0]);
#pragma unroll
    for (int r = 1; r < 16; ++r) mx = fmaxf(mx, fmaxf(s0[r], s1[r]));
    return xhalf_max(mx);
}
__device__ __forceinline__ void rescale(AState& st, f32x16& s0, f32x16& s1, float mx) {
    const float dl = fmaxf(mx, 0.f); const float f = ex2(-dl); st.m += dl; st.l *= f;
#pragma unroll
    for (int r = 0; r < 16; ++r) { st.o0[r] *= f; st.o1[r] *= f; s0[r] -= dl; s1[r] -= dl; }
}
constexpr float ATT_BIG = 1024.0f;
__device__ __forceinline__ void exp_pack(f32x16& s0, f32x16& s1, u32x4 (&pk)[4], AState& st) {
    float sum = 0.f;
#pragma unroll
    for (int r = 0; r < 16; ++r) { s0[r] = ex2(s0[r]); s1[r] = ex2(s1[r]); sum += s0[r] + s1[r]; }
    if (__any(sum > ATT_BIG)) {
        float mx = fmaxf(s0[0], s1[0]);
#pragma unroll
        for (int r = 1; r < 16; ++r) mx = fmaxf(mx, fmaxf(s0[r], s1[r]));
        mx = xhalf_max(mx);
        const float dl = fmaxf(__builtin_amdgcn_logf(fmaxf(mx, 1.0f)), 0.f), f = ex2(-dl);
        st.m += dl; st.l *= f; sum *= f;
#pragma unroll
        for (int r = 0; r < 16; ++r) { st.o0[r] *= f; st.o1[r] *= f; s0[r] *= f; s1[r] *= f; }
    }
    st.l += sum;
    pk[0] = (u32x4){pkbf(s0[0], s0[1]), pkbf(s0[2], s0[3]), pkbf(s0[4], s0[5]), pkbf(s0[6], s0[7])};
    pk[1] = (u32x4){pkbf(s0[8], s0[9]), pkbf(s0[10], s0[11]), pkbf(s0[12], s0[13]), pkbf(s0[14], s0[15])};
    pk[2] = (u32x4){pkbf(s1[0], s1[1]), pkbf(s1[2], s1[3]), pkbf(s1[4], s1[5]), pkbf(s1[6], s1[7])};
    pk[3] = (u32x4){pkbf(s1[8], s1[9]), pkbf(s1[10], s1[11]), pkbf(s1[12], s1[13]), pkbf(s1[14], s1[15])};
}

template <int KS0, int NKS, bool WINDOW, int MODE>
__device__ __forceinline__ void run_tiles(LAS unsigned char* lds, int t0, int t1, const u16* Kg, const u16* Vtg, const bf16x8 (&qr)[4], float c31,
                                          int q0w, unsigned mask, int qb, AState& A, int wave, int lane, int r32, int hi) {
    LAS unsigned char* Kr = lds + ATT_K; LAS unsigned char* Vr = lds + ATT_V; const LAS float* lut1 = (const LAS float*)(lds + ATT_LUT) + 96;
    const u16* ksrc = Kg + (size_t)lane * PW + wave * 8;
    const u16* vsrc = Vtg + (size_t)lane * PW + wave * 8;
    const unsigned kdst = (unsigned)(uintptr_t)Kr + wave * 1024, vdst = (unsigned)(uintptr_t)Vr + wave * ATT_VCH;
#define TCL(t) ((t) < t0 ? t0 : ((t) > t1 ? t1 : (t)))
#define DMA_K(tn) glds16(ksrc + (size_t)TCL(tn) * 64 * PW, (unsigned)__builtin_amdgcn_readfirstlane(kdst + ((tn) & 3) * 8192))
#define DMA_V(tn) glds16(vsrc + (size_t)TCL(tn) * 64 * PW, (unsigned)__builtin_amdgcn_readfirstlane(vdst + ((tn) & 3) * ATT_VSLOT))
#define KS_(t) (Kr + ((t) & 3) * 8192)
#define VS_(t) (Vr + ((t) & 3) * ATT_VSLOT)
#define WAIT_BAR4() asm volatile("s_waitcnt vmcnt(4) lgkmcnt(0)\n\ts_barrier" ::: "memory")
#define T_ACTIVE(t) (!((q0w + 31 - (t) * 64) < 0 || (WINDOW && (q0w - ((t) * 64 + 63)) >= 512)))
#define T_LUTMODE(t) (((q0w - ((t) * 64 + 63)) < 128) || (WINDOW && (q0w + 31 - (t) * 64) >= 512))
    auto tile_sel = [&](int t) -> int { if (MODE == 1) { const int blk = t >> 2; return blk < qb ? (int)((mask >> blk) & 1u) : 1; } if (MODE == 2) return (int)((mask >> t) & 1u); return 1; };
    asm volatile("s_waitcnt vmcnt(0)" ::: "memory");
#pragma unroll
    for (int j = 0; j < 4; ++j) { DMA_K(t0 + j); DMA_V(t0 + j - 2); }
    WAIT_BAR4();
    f32x16 sn0, sn1, sc0, sc1; u32x4 pk[4];
#pragma unroll
    for (int r = 0; r < 16; ++r) { sn0[r] = 0.f; sn1[r] = 0.f; }
#pragma unroll
    for (int i = 0; i < 4; ++i) pk[i] = (u32x4){0u, 0u, 0u, 0u};
    bool act_n = T_ACTIVE(t0), act_c = false, act_p = false;
    if (act_n) qk_block<KS0, NKS>(KS_(t0), qr, r32, hi, sn0, sn1);
    asm volatile("s_waitcnt lgkmcnt(0)\n\ts_barrier" ::: "memory");
    for (int c = t0; c <= t1 + 1; ++c) {
        act_p = act_c; act_c = act_n; sc0 = sn0; sc1 = sn1;
        DMA_K(c + 4); DMA_V(c + 2);
        act_n = (c + 1 <= t1) && T_ACTIVE(c + 1);
        const bool lm_c = T_LUTMODE(c);
        const int dbase = q0w + r32 - c * 64 - 4 * hi;
        const float selc = tile_sel(c) ? 0.f : NEGF;
        if (act_p) pv_block(VS_(c - 1), pk, lane, A);
        if (act_c) {
            const float cc = selc - A.m;
            if (lm_c) lut_add(sc0, sc1, lut1, dbase, cc); else if (__any(cc != 0.f)) const_add(sc0, sc1, cc);
        }
        if (act_n) qk_block<KS0, NKS>(KS_(c + 1), qr, r32, hi, sn0, sn1);
        if (act_c) exp_pack(sc0, sc1, pk, A);
        WAIT_BAR4();
    }
    asm volatile("s_waitcnt vmcnt(0) lgkmcnt(0)\n\ts_barrier" ::: "memory");
#undef TCL
#undef DMA_K
#undef DMA_V
#undef KS_
#undef VS_
#undef WAIT_BAR4
#undef T_ACTIVE
#undef T_LUTMODE
}

__device__ __forceinline__ void build_lut(LAS unsigned char* lds, const float* rel_bias, int head, bool window, int tid) {
    LAS float* lut = (LAS float*)(lds + ATT_LUT);
    for (int i = tid; i < 704; i += 512) {
        const int d = i - 96; float v; const float c31 = rel_bias[31 * 16 + head];
        if (d < 0) v = NEGF;
        else if (d >= 512) v = window ? NEGF : 0.f;
        else { int bk;
            if (d < 16) bk = d; else if (d >= 128) bk = 31; else { bk = 16 + (int)(log2f((float)d * (1.0f / 16.0f)) * (16.0f / 3.0f)); bk = bk > 31 ? 31 : bk; }
            v = (rel_bias[bk * 16 + head] - c31) * LOG2E; }
        lut[i] = v;
    }
}
__device__ __forceinline__ void load_q(bf16x8 (&qr)[4], const u16* qrow, int hi) {
#pragma unroll
    for (int ks = 0; ks < 4; ++ks) qr[ks] = *(const bf16x8*)(qrow + ks * 16 + hi * 8);
}
__device__ __forceinline__ void store_o(u16* dst, const f32x16& v0, const f32x16& v1, int hi) {
#pragma unroll
    for (int g = 0; g < 4; ++g) {
        u32x2 a; a.x = pkbf(v0[4 * g], v0[4 * g + 1]); a.y = pkbf(v0[4 * g + 2], v0[4 * g + 3]); *(u32x2*)(dst + 8 * g + 4 * hi) = a;
        u32x2 b; b.x = pkbf(v1[4 * g], v1[4 * g + 1]); b.y = pkbf(v1[4 * g + 2], v1[4 * g + 3]); *(u32x2*)(dst + 32 + 8 * g + 4 * hi) = b;
    }
}

struct Ctx { LAS unsigned char* lds; int tid, lane, wave, r32, hi, G, bx; u16* proj; u16* obuf; u16* vt; };

__device__ __forceinline__ void moba_unit(const Ctx& C0, KParamsPtr P, int b, int h, int qb) {
    Ctx C = C0; C.lane = lane_opaque(); C.tid = C.wave * 64 + C.lane; C.r32 = C.lane & 31; C.hi = C.lane >> 5;
    const int q0w = __builtin_amdgcn_readfirstlane(qb * 256 + C.wave * 32); const int qpos = q0w + C.r32; const size_t tok = (size_t)b * SEQ + qpos;
    build_lut(C.lds, P->rel_bias, h, false, C.tid);
    const u16* qrow = C.proj + tok * PW + C_MQ + h * 64;
    bf16x8 qr[4]; load_q(qr, qrow, C.hi);
    unsigned mask = 0;
    if (qb > 0) {
        float g[7];
#pragma unroll
        for (int j = 0; j < 7; ++j) g[j] = 0.f;
        const float* km = (const float*)(P->ws + WS_KMEAN) + (size_t)((b * 4 + h) * 8) * 64;
#pragma unroll
        for (int dc = 0; dc < 8; ++dc) {
            const u32x4 qv = *(const u32x4*)(qrow + dc * 8);
            float qf[8]; qf[0] = bf2f(qv.x & 0xffffu); qf[1] = bf2f(qv.x >> 16); qf[2] = bf2f(qv.y & 0xffffu); qf[3] = bf2f(qv.y >> 16);
            qf[4] = bf2f(qv.z & 0xffffu); qf[5] = bf2f(qv.z >> 16); qf[6] = bf2f(qv.w & 0xffffu); qf[7] = bf2f(qv.w >> 16);
#pragma unroll
            for (int j = 0; j < 7; ++j) if (j < qb) { const float* kmj = km + j * 64 + dc * 8;
#pragma unroll
                for (int e = 0; e < 8; ++e) g[j] = fmaf(qf[e], kmj[e], g[j]); }
        }
#pragma unroll
        for (int j = 0; j < 7; ++j) if (j < qb) { int rank = 0;
#pragma unroll
            for (int i = 0; i < 7; ++i) if (i != j && i < qb) rank += (g[i] > g[j] || (g[i] == g[j] && i < j)) ? 1 : 0;
            if (rank < 3) mask |= 1u << j; }
    }
    AState A; astate_init(A);
    const float c31 = P->rel_bias[31 * 16 + h] * LOG2E;
    run_tiles<0, 4, false, 1>(C.lds, 0, 4 * qb + 3, C.proj + (size_t)b * SEQ * PW + C_MK + h * 64, C.proj + (size_t)b * SEQ * PW + C_MV + h * 64, qr, c31, q0w, mask, qb, A, C.wave, C.lane, C.r32, C.hi);
    const float inv = rcpf_(xhalf_sum(A.l));
    A.o0 *= inv; A.o1 *= inv;
    { const int l2 = lane_opaque(); const size_t tok2 = (size_t)b * SEQ + q0w + (l2 & 31);
      store_o(C.obuf + tok2 * DM + h * 64, A.o0, A.o1, l2 >> 5); }
}

__device__ __forceinline__ void diff_unit(const Ctx& C0, KParamsPtr P, int layer, int b, int h, int qb) {
    Ctx C = C0; C.lane = lane_opaque(); C.tid = C.wave * 64 + C.lane; C.r32 = C.lane & 31; C.hi = C.lane >> 5;
    const int q0w = __builtin_amdgcn_readfirstlane(qb * 256 + C.wave * 32); const int qpos = q0w + C.r32; const size_t tok = (size_t)b * SEQ + qpos;
    build_lut(C.lds, P->rel_bias, 4 + h, false, C.tid);
    bf16x8 qr[4]; load_q(qr, C.proj + tok * PW + C_DQ + h * 64, C.hi);
    AState A; astate_init(A);
    const float c31 = P->rel_bias[31 * 16 + 4 + h] * LOG2E;
    const u16* Kg = C.proj + (size_t)b * SEQ * PW + C_DK + h * 64; const u16* Vg = C.proj + (size_t)b * SEQ * PW + C_DV + h * 64;
    run_tiles<0, 2, false, 0>(C.lds, 0, 4 * qb + 3, Kg, Vg, qr, c31, q0w, 0u, 0, A, C.wave, C.lane, C.r32, C.hi);
    LAS float* park = (LAS float*)(C.lds + ATT_PARK) + C.tid;
    { const float i0 = rcpf_(xhalf_sum(A.l));
#pragma unroll
      for (int r = 0; r < 16; ++r) { park[r * 512] = A.o0[r] * i0; park[(16 + r) * 512] = A.o1[r] * i0; } }
    astate_init(A);
    run_tiles<2, 2, false, 0>(C.lds, 0, 4 * qb + 3, Kg, Vg, qr, c31, q0w, 0u, 0, A, C.wave, C.lane, C.r32, C.hi);
    const float* lp = P->diff_lambda + (size_t)layer * 128; float d01 = 0.f, d23 = 0.f;
    for (int i = 0; i < 32; ++i) { d01 = fmaf(lp[i], lp[32 + i], d01); d23 = fmaf(lp[64 + i], lp[96 + i], d23); }
    const float li = P->lam_init[layer]; const float lam = expf(d01) - expf(d23) + li;
    const float i1 = lam * rcpf_(xhalf_sum(A.l));
    float ss = 0.f;
#pragma unroll
    for (int r = 0; r < 16; ++r) { A.o0[r] = park[r * 512] - A.o0[r] * i1; A.o1[r] = park[(16 + r) * 512] - A.o1[r] * i1; ss += A.o0[r] * A.o0[r] + A.o1[r] * A.o1[r]; }
    ss = xhalf_sum(ss);
    const float rstd = (1.0f / sqrtf(ss * (1.0f / 64.0f) + 1e-6f)) * (1.0f - li);
    const float* sg = P->diff_subln + (size_t)layer * 64;
#pragma unroll
    for (int r = 0; r < 16; ++r) { const int d = crow(r, C.hi); A.o0[r] *= rstd * sg[d]; A.o1[r] *= rstd * sg[32 + d]; }
    { const int l2 = lane_opaque(); const size_t tok2 = (size_t)b * SEQ + q0w + (l2 & 31);
      store_o(C.obuf + tok2 * DM + 256 + h * 64, A.o0, A.o1, l2 >> 5); }
}

__device__ __forceinline__ void nsa_unit(const Ctx& C0, KParamsPtr P, int b, int hq, int qb) {
    Ctx C = C0; C.lane = lane_opaque(); C.tid = C.wave * 64 + C.lane; C.r32 = C.lane & 31; C.hi = C.lane >> 5;
    const int g = hq >> 2;
    const int q0w = __builtin_amdgcn_readfirstlane(qb * 256 + C.wave * 32); const int qpos = q0w + C.r32; const size_t tok = (size_t)b * SEQ + qpos;
    build_lut(C.lds, P->rel_bias, 8 + hq, false, C.tid);
    bf16x8 qr[4]; load_q(qr, C.proj + tok * PW + C_NQ + hq * 64, C.hi);
    const u16* gl = C.proj + tok * PW + C_NG + hq * 3;
    const float g1 = sigmoid_f(bf2f(gl[1])), g2 = sigmoid_f(bf2f(gl[2]));
    const unsigned mask = ((const unsigned*)(P->ws + WS_SEL))[(size_t)(b * 2 + g) * SEQ + qpos];
    const float c31 = P->rel_bias[31 * 16 + 8 + hq] * LOG2E;
    AState A; astate_init(A);
    run_tiles<0, 4, false, 2>(C.lds, 0, 4 * qb + 3, C.proj + (size_t)b * SEQ * PW + C_NKS + g * 64, C.proj + (size_t)b * SEQ * PW + C_NVS + g * 64, qr, c31, q0w, mask, qb, A, C.wave, C.lane, C.r32, C.hi);
    LAS float* park = (LAS float*)(C.lds + ATT_PARK) + C.tid;
    { const float f = g1 * rcpf_(xhalf_sum(A.l));
#pragma unroll
      for (int r = 0; r < 16; ++r) { park[r * 512] = A.o0[r] * f; park[(16 + r) * 512] = A.o1[r] * f; } }
    if (C.tid < 96) ((LAS float*)(C.lds + ATT_LUT))[608 + C.tid] = NEGF;
    astate_init(A);
    const int tw0 = 4 * qb - 8 < 0 ? 0 : 4 * qb - 8;
    run_tiles<0, 4, true, 0>(C.lds, tw0, 4 * qb + 3, C.proj + (size_t)b * SEQ * PW + C_NKW + g * 64, C.proj + (size_t)b * SEQ * PW + C_NVW + g * 64, qr, c31, q0w, 0u, qb, A, C.wave, C.lane, C.r32, C.hi);
    { const float f = g2 * rcpf_(xhalf_sum(A.l));
#pragma unroll
      for (int r = 0; r < 16; ++r) { A.o0[r] = A.o0[r] * f + park[r * 512]; A.o1[r] = A.o1[r] * f + park[(16 + r) * 512]; } }
    const int l2 = lane_opaque(); const int hi2 = l2 >> 5;
    u16* dst = C.obuf + ((size_t)b * SEQ + q0w + (l2 & 31)) * DM + 512 + hq * 64;
#pragma unroll
    for (int gg = 0; gg < 4; ++gg) {
        const u32x2 a = *(const u32x2*)(dst + 8 * gg + 4 * hi2), bq = *(const u32x2*)(dst + 32 + 8 * gg + 4 * hi2);
        A.o0[4 * gg] += bf2f(a.x & 0xffffu); A.o0[4 * gg + 1] += bf2f(a.x >> 16); A.o0[4 * gg + 2] += bf2f(a.y & 0xffffu); A.o0[4 * gg + 3] += bf2f(a.y >> 16);
        A.o1[4 * gg] += bf2f(bq.x & 0xffffu); A.o1[4 * gg + 1] += bf2f(bq.x >> 16); A.o1[4 * gg + 2] += bf2f(bq.y & 0xffffu); A.o1[4 * gg + 3] += bf2f(bq.y >> 16);
    }
    store_o(dst, A.o0, A.o1, hi2);
}

__device__ __forceinline__ void cmp_unit(const Ctx& C0, KParamsPtr P, int b, int g, int qblk) {
    Ctx C = C0; C.lane = lane_opaque(); C.tid = C.wave * 64 + C.lane; C.r32 = C.lane & 31; C.hi = C.lane >> 5;
    LAS unsigned char* lds = C.lds; const int tid = C.tid, r32 = C.r32, hi = C.hi;
    const u16* kc = (const u16*)(P->ws + WS_KCMP) + (size_t)(b * 2 + g) * 128 * 64;
    const u16* vc = (const u16*)(P->ws + WS_VCMPT) + (size_t)(b * 2 + g) * 64 * 128;
#pragma unroll
    for (int i = 0; i < 2; ++i) { const int e = tid + 512 * i;
        { const int row = e >> 3, ch = e & 7; *(LAS u32x4*)(lds + CMP_K + row * 144 + ch * 16) = *(const u32x4*)(kc + row * 64 + ch * 8); }
        { const int row = e >> 4, ch = e & 15; *(LAS u32x4*)(lds + CMP_V + row * 272 + ch * 16) = *(const u32x4*)(vc + row * 128 + ch * 8); } }
    const int q0w = __builtin_amdgcn_readfirstlane(qblk * 256 + C.wave * 32); const int qpos = q0w + r32; const size_t tok = (size_t)b * SEQ + qpos;
    const int nmax = (qpos - 31) >> 4;
    __syncthreads();
    float qa[16], qh[16];
#pragma unroll
    for (int i = 0; i < 16; ++i) { qa[i] = 0.f; qh[i] = 0.f; }
    const LAS unsigned char* kp = lds + CMP_K + r32 * 144 + hi * 16;
    const LAS unsigned char* vp = lds + CMP_V + r32 * 272 + hi * 16;
    bf16x8 qn[4]; load_q(qn, C.proj + tok * PW + C_NQ + g * 4 * 64, hi);
    for (int rh = 0; rh < 4; ++rh) {
        const int hq = g * 4 + rh;
        bf16x8 qr[4];
#pragma unroll
        for (int ks = 0; ks < 4; ++ks) qr[ks] = qn[ks];
        load_q(qn, C.proj + tok * PW + C_NQ + (g * 4 + (rh < 3 ? rh + 1 : rh)) * 64, hi);
        const float g0 = sigmoid_f(bf2f(C.proj[tok * PW + C_NG + hq * 3]));
        f32x16 s[4];
#pragma unroll
        for (int kb = 0; kb < 4; ++kb) {
#pragma unroll
            for (int r = 0; r < 16; ++r) s[kb][r] = 0.f;
#pragma unroll
            for (int ks = 0; ks < 4; ++ks) { const bf16x8 a = *(const LAS bf16x8*)(kp + kb * 32 * 144 + ks * 32); s[kb] = __builtin_amdgcn_mfma_f32_32x32x16_bf16(a, qr[ks], s[kb], 0, 0, 0); }
        }
        float mx = NEGF;
#pragma unroll
        for (int kb = 0; kb < 4; ++kb)
#pragma unroll
            for (int r = 0; r < 16; ++r) { const int n = 32 * kb + crow(r, hi); const float v = (n <= nmax) ? s[kb][r] : NEGF; s[kb][r] = v; mx = fmaxf(mx, v); }
        mx = xhalf_max(mx);
        float sum = 0.f;
#pragma unroll
        for (int kb = 0; kb < 4; ++kb)
#pragma unroll
            for (int r = 0; r < 16; ++r) { const int n = 32 * kb + crow(r, hi); const float pv = (n <= nmax) ? ex2(s[kb][r] - mx) : 0.f; s[kb][r] = pv; sum += pv; }
        sum = xhalf_sum(sum);
        const float inv = nmax >= 0 ? rcpf_(sum) : 0.f;
        f32x16 o0, o1;
#pragma unroll
        for (int r = 0; r < 16; ++r) { o0[r] = 0.f; o1[r] = 0.f; }
#pragma unroll
        for (int kb = 0; kb < 4; ++kb) {
#pragma unroll
            for (int r = 0; r < 16; ++r) s[kb][r] *= inv;
#pragma unroll
            for (int g4 = 0; g4 < 4; ++g4) { const float h = 0.5f * s[kb][4 * g4 + 3]; qh[kb * 4 + g4] += h; qa[kb * 4 + g4] += (s[kb][4 * g4] + s[kb][4 * g4 + 1]) + (s[kb][4 * g4 + 2] + h); }
#pragma unroll
            for (int c = 0; c < 2; ++c) {
                const u32x4 pk = (u32x4){pkbf(s[kb][8 * c], s[kb][8 * c + 1]), pkbf(s[kb][8 * c + 2], s[kb][8 * c + 3]), pkbf(s[kb][8 * c + 4], s[kb][8 * c + 5]), pkbf(s[kb][8 * c + 6], s[kb][8 * c + 7])};
                const bf16x8 pb = __builtin_bit_cast(bf16x8, pk);
                const bf16x8 v0 = *(const LAS bf16x8*)(vp + (kb * 2 + c) * 32);
                const bf16x8 v1 = *(const LAS bf16x8*)(vp + 32 * 272 + (kb * 2 + c) * 32);
                o0 = __builtin_amdgcn_mfma_f32_32x32x16_bf16(v0, pb, o0, 0, 0, 0);
                o1 = __builtin_amdgcn_mfma_f32_32x32x16_bf16(v1, pb, o1, 0, 0, 0);
            }
            __builtin_amdgcn_sched_barrier(0);
        }
        o0 *= g0; o1 *= g0;
        store_o(C.obuf + tok * DM + 512 + hq * 64, o0, o1, hi);
    }
    LAS float* Aq = (LAS float*)(lds + CMP_A) + (C.wave * 32 + r32) * 33; LAS float* Hq = (LAS float*)(lds + CMP_H) + (C.wave * 32 + r32) * 33;
#pragma unroll
    for (int kb = 0; kb < 4; ++kb)
#pragma unroll
        for (int g4 = 0; g4 < 4; ++g4) { const int j = 8 * kb + 2 * g4 + hi; Aq[j] = qa[kb * 4 + g4]; Hq[j] = qh[kb * 4 + g4]; }
    __syncthreads();
    const int cur = q0w >> 6;
    unsigned bits = 0;
    if (cur < 16) bits = (2u << cur) - 1u;
    else {
        float sc[32];
#pragma unroll
        for (int i = 0; i < 32; ++i) { const float imp = Aq[i] + (i > 0 ? Hq[i - 1] : 0.f); sc[i] = (i > cur) ? -3.0e38f : ((i == 0 || i > cur - 2) ? 1e4f : imp); }
#pragma unroll
        for (int e = 0; e < 16; ++e) {
            const float sj = hi ? sc[16 + e] : sc[e]; int rank = 0;
#pragma unroll
            for (int i = 0; i < 32; ++i) { const bool lt = (i < e) || (hi && i < 16 + e);
                rank += (sc[i] > sj || (sc[i] == sj && lt)) ? 1 : 0; }
            const int j = hi * 16 + e;
            if (j <= cur && rank < 16) bits |= 1u << j; }
        { auto rr = __builtin_amdgcn_permlane32_swap(bits, bits, false, false); bits = rr[0] | rr[1]; }
    }
    if (hi == 0) ((unsigned*)(P->ws + WS_SEL))[(size_t)(b * 2 + g) * SEQ + qpos] = bits;
    __syncthreads();
}

__device__ __forceinline__ void prep_vk(const Ctx& C, KParamsPtr P, int b0) {
    const int G = C.G - b0, bxr = C.bx - b0, tid = C.tid, lane = C.lane;
    if (bxr < 0) return;
    const int gw = bxr * 8 + C.wave, NGW = G * 8;
    for (int it = gw; it < NB * 4 * 8; it += NGW) {
        const int blk = it & 7, h = (it >> 3) & 3, b = it >> 5;
        const u16* kp = C.proj + ((size_t)b * SEQ + blk * 256) * PW + C_MK + h * 64 + lane; float s = 0.f;
        for (int k = 0; k < 256; k += 8) { float t[8];
#pragma unroll
            for (int e = 0; e < 8; ++e) t[e] = bf2f(kp[(size_t)(k + e) * PW]);
            s += ((t[0] + t[1]) + (t[2] + t[3])) + ((t[4] + t[5]) + (t[6] + t[7])); }
        ((float*)(P->ws + WS_KMEAN))[(size_t)it * 64 + lane] = s * (1.0f / 256.0f);
    }
}
__device__ __forceinline__ void prep_a(const Ctx& C, KParamsPtr P, int layer) {
    const int G = C.G, lane = C.lane;
    const int gw = C.bx * 8 + C.wave, NGW = G * 8;
    u16* acmp = (u16*)(P->ws + WS_XN);
    for (int it = gw; it < 2 * 4096; it += NGW) {
        const int i = it >> 12, row = it & 4095, n = row & 127, bg = row >> 7, b = bg >> 1, g = bg & 1;
        u16* dst = acmp + (size_t)it * 2048; const float* pe = P->cmp_pe + (size_t)(layer * 2 + i) * 2048;
        const int col = (i == 0 ? C_NKC : C_NVC) + g * 64;
#pragma unroll
        for (int pass = 0; pass < 4; ++pass) { const int l = pass * 8 + (lane >> 3), d0 = (lane & 7) * 8;
            unsigned z0 = 0u; asm volatile("" : "+v"(z0)); u32x4 o = (u32x4){z0, z0, z0, z0};
            if (n < 127) { const u32x4 v = *(const u32x4*)(C.proj + ((size_t)b * SEQ + 16 * n + l) * PW + col + d0); const f32x4 e0 = *(const f32x4*)(pe + l * 64 + d0), e1 = *(const f32x4*)(pe + l * 64 + d0 + 4);
                o.x = pkbf(bf2f(v.x & 0xffffu) + e0.x, bf2f(v.x >> 16) + e0.y); o.y = pkbf(bf2f(v.y & 0xffffu) + e0.z, bf2f(v.y >> 16) + e0.w);
                o.z = pkbf(bf2f(v.z & 0xffffu) + e1.x, bf2f(v.z >> 16) + e1.y); o.w = pkbf(bf2f(v.w & 0xffffu) + e1.z, bf2f(v.w >> 16) + e1.w); }
            *(u32x4*)(dst + l * 64 + d0) = o; }
    }
}
__device__ __forceinline__ void prep_c(const Ctx& C, KParamsPtr P, int layer, int it0) {
    const int i = it0 >> 12, row0 = it0 & 4095, lane = lane_opaque(), tid = C.wave * 64 + lane, r32 = lane & 31, hi = lane >> 5;
    const float* w2 = P->cmp_w2 + (size_t)(layer * 2 + i) * 256 * 64;
    for (int e = tid; e < 256 * 64; e += 512) { const int k = e >> 6, c = e & 63; *(LAS u16*)(C.lds + c * 528 + k * 2) = (u16)(pkbf(w2[e], 0.f) & 0xffffu); }
    __syncthreads();
    const int wrow = row0 + C.wave * 32;
    const u16* hrow = (const u16*)(P->ws + WS_HID) + ((size_t)i * 4096 + wrow + r32) * 256 + hi * 8;
    f32x16 d0, d1;
#pragma unroll
    for (int r = 0; r < 16; ++r) { d0[r] = 0.f; d1[r] = 0.f; }
#pragma unroll 4
    for (int ks = 0; ks < 16; ++ks) {
        const bf16x8 a = *(const bf16x8*)(hrow + ks * 16);
        const bf16x8 b0 = *(const LAS bf16x8*)(C.lds + r32 * 528 + (ks * 16 + hi * 8) * 2);
        const bf16x8 b1 = *(const LAS bf16x8*)(C.lds + (32 + r32) * 528 + (ks * 16 + hi * 8) * 2);
        d0 = __builtin_amdgcn_mfma_f32_32x32x16_bf16(a, b0, d0, 0, 0, 0);
        d1 = __builtin_amdgcn_mfma_f32_32x32x16_bf16(a, b1, d1, 0, 0, 0);
    }
#pragma unroll
    for (int r = 0; r < 16; ++r) { const int row = wrow + crow(r, hi);
        const unsigned v0 = pkbf(d0[r], 0.f) & 0xffffu, v1 = pkbf(d1[r], 0.f) & 0xffffu;
        if (i == 0) { u16* o = (u16*)(P->ws + WS_KCMP) + (size_t)row * 64; o[r32] = (u16)v0; o[32 + r32] = (u16)v1; }
        else { const int bg = row >> 7, n = row & 127; u16* o = (u16*)(P->ws + WS_VCMPT) + (size_t)bg * 64 * 128 + (n & ~15) + pperm(n & 15); o[(size_t)r32 * 128] = (u16)v0; o[(size_t)(32 + r32) * 128] = (u16)v1; }
    }
}

__device__ __forceinline__ void convert_weights(const Ctx& C, KParamsPtr P, int layer) {
    LAS float* scr = (LAS float*)(C.lds + C.wave * 16384);
    const int gw = C.bx * 8 + C.wave, NGW = C.G * 8, lane = C.lane;
    constexpr int I_G = 16 * 88, I_D = 44 * 32, I_IN = 16 * 96, I_O = 16 * 32, I_W1 = 32 * 8;
    constexpr int NIT = 4 * I_G + 2 * I_D + I_IN + I_O + 2 * I_W1;
    unsigned char* ws = P->ws;
    for (int it = gw; it < NIT; it += NGW) {
        int r = it;
        if (r < 4 * I_G) { const int which = r / I_G; r -= which * I_G; const int kb = r / 88, nb = r % 88, n0 = nb * 32;
            const float* W = (which == 0 ? P->ffn1_gate : which == 1 ? P->ffn1_up : which == 2 ? P->ffn2_gate : P->ffn2_up) + (size_t)layer * DM * DFF;
            u16* WT = (u16*)(ws + (which < 2 ? WS_GU1 : WS_GU2));
            tr_item(W, DM, DFF, WT, kb, n0, (n0 >> 7) * 256 + (which & 1) * 128 + (n0 & 127), scr, lane, 1.0f, (which < 2 ? P->norm_ffn1 : P->norm_ffn2) + (size_t)layer * DM); continue; }
        r -= 4 * I_G;
        if (r < 2 * I_D) { const int which = r / I_D; r -= which * I_D; const int kb = r / 32, nb = r % 32;
            const float* W = (which == 0 ? P->ffn1_down : P->ffn2_down) + (size_t)layer * DFF * DM;
            tr_item(W, DFF, DM, (u16*)(ws + (which == 0 ? WS_DN1 : WS_DN2)), kb, nb * 32, nb * 32, scr, lane); continue; }
        r -= 2 * I_D;
        if (r < I_IN) { const int kb = r / 96, nb = r % 96, n0 = nb * 32;
            const float cs = (n0 < C_MK || (n0 >= C_NQ && n0 < C_NKC)) ? 0.125f * LOG2E : (n0 >= C_DQ && n0 < C_DK) ? 0.17677669529663687f * LOG2E : 1.0f;
            tr_item(P->w_in + (size_t)layer * DM * INW, DM, INW, (u16*)(ws + WS_WIN), kb, n0, n0, scr, lane, cs, P->norm_mix + (size_t)layer * DM); continue; }
        r -= I_IN;
        if (r < I_O) { const int kb = r / 32, nb = r % 32; tr_item(P->w_out + (size_t)layer * DM * DM, DM, DM, (u16*)(ws + WS_WOUT), kb, nb * 32, nb * 32, scr, lane); continue; }
        r -= I_O;
        { const int i = r / I_W1; r -= i * I_W1; const int kb = r / 8, nb = r % 8;
            tr_item(P->cmp_w1 + (size_t)(layer * 2 + i) * 2048 * 256, 2048, 256, (u16*)(ws + WS_W1) + (size_t)i * 256 * 2048, kb, nb * 32, nb * 32, scr, lane); }
    }
}
__device__ __forceinline__ void norm_phase(const Ctx& C, const float* src32, const u16* src16, const float* g, u16* dst16, float* dst32, u16* xb0) {
    const int gw = C.bx * 8 + C.wave, NGW = C.G * 8;
    for (int m = gw; m < MTOK; m += NGW) norm_row(src32 ? src32 + (size_t)m * DM : nullptr, src16 ? src16 + (size_t)m * DM : nullptr, g, dst16 ? dst16 + (size_t)m * DM : nullptr, dst32 ? dst32 + (size_t)m * DM : nullptr, xb0 ? xb0 + (size_t)m * DM : nullptr, C.lane);
}

#define XB_TMO      128
#define XB_XCNT(j)  (256  + 64 * (j))
#define XB_XSUB(j)  (1280 + 64 * (j))
#define XB_XGEN(j)  (2304 + 64 * (j))
#define XB_TOP      3328
#define XB_TOPGEN   3392
#define XCD_BAR_WORDS 3456
#define XB_SPIN_CAP (1u << 18)

__device__ __forceinline__ unsigned xb_ld(unsigned* p)              { return __hip_atomic_load(p, __ATOMIC_RELAXED, __HIP_MEMORY_SCOPE_AGENT); }
__device__ __forceinline__ unsigned xb_add(unsigned* p, unsigned v) { return __hip_atomic_fetch_add(p, v, __ATOMIC_RELAXED, __HIP_MEMORY_SCOPE_AGENT); }
__device__ __forceinline__ unsigned xb_xcc_id() { return (unsigned)__builtin_amdgcn_s_getreg((3 << 11) | 20) & 0xFu; }
#define XB_SPIN(cond, bar) do { unsigned _sp = 0; while (cond) { __builtin_amdgcn_s_sleep(1); \
    if ((++_sp & 255u) == 0u) { if (xb_ld(&(bar)[XB_TMO])) break; if (_sp > XB_SPIN_CAP) { atomicAdd(&(bar)[XB_TMO], 1u); break; } } } } while (0)

struct XcdBarrier {
    unsigned* bar; unsigned x;
    volatile LAS unsigned* st;
};

__device__ __forceinline__ XcdBarrier xcd_barrier_post(unsigned* bar, volatile LAS unsigned* st) {
    XcdBarrier b; b.bar = bar; b.x = xb_xcc_id(); b.st = st;
    if (threadIdx.x == 0) (void)xb_add(&bar[XB_XCNT(b.x)], 1u);
    return b;
}
__device__ __forceinline__ void xcd_barrier_complete(unsigned* bar, unsigned x, unsigned& nloc, unsigned& nx) {
    const unsigned G = gridDim.x * gridDim.y * gridDim.z;
    unsigned sum, cnt, mine, sp = 0u;
    for (;;) {
        sum = 0u; cnt = 0u; mine = 0u;
#pragma unroll
        for (unsigned j = 0; j < 16; ++j) { const unsigned c = xb_ld(&bar[XB_XCNT(j)]); sum += c; cnt += (c > 0u) ? 1u : 0u; mine = (j == x) ? c : mine; }
        if (sum == G) break;
        __builtin_amdgcn_s_sleep(1);
        if ((++sp & 255u) == 0u) { if (xb_ld(&bar[XB_TMO])) break; if (sp > XB_SPIN_CAP) { atomicAdd(&bar[XB_TMO], 1u); break; } }
    }
    nloc = mine > 0u ? mine : 1u; nx = cnt > 0u ? cnt : 1u;
}

__device__ __forceinline__ void xcd_barrier(const XcdBarrier& b) {
    asm volatile("s_waitcnt vmcnt(0)" ::: "memory");
    __syncthreads();
    if (threadIdx.x == 0) {
        unsigned* bar = b.bar;
        __builtin_amdgcn_s_waitcnt(0);
        unsigned nloc = b.st[0], nx = b.st[1];
        if (nloc == 0u) { xcd_barrier_complete(bar, b.x, nloc, nx); b.st[0] = nloc; b.st[1] = nx; }
        const unsigned old = xb_add(&bar[XB_XSUB(b.x)], 1u);
        const unsigned gen = old / nloc;
        if (old + 1u == (gen + 1u) * nloc) {
            __builtin_amdgcn_fence(__ATOMIC_RELEASE, "agent");
            asm volatile("s_waitcnt vmcnt(0)" ::: "memory");
            const unsigned og = xb_add(&bar[XB_TOP], 1u);
            const unsigned tg = og / nx;
            if (og + 1u == (tg + 1u) * nx) xb_add(&bar[XB_TOPGEN], 1u);
            else XB_SPIN(xb_ld(&bar[XB_TOPGEN]) == tg, bar);
            __builtin_amdgcn_fence(__ATOMIC_ACQUIRE, "agent");
            xb_add(&bar[XB_XGEN(b.x)], 1u);
            asm volatile("s_waitcnt vmcnt(0)" ::: "memory");
        } else {
            XB_SPIN(xb_ld(&bar[XB_XGEN(b.x)]) == gen, bar);
            __builtin_amdgcn_fence(__ATOMIC_ACQUIRE, "agent");
            asm volatile("s_waitcnt vmcnt(0)" ::: "memory");
        }
    }
    __syncthreads();
}


__device__ __forceinline__ void fill_rtab(const Ctx& C, const pg8::StaticOrder& S, const float* SS, LAS float* rtab) {
    LAS int* pml = (LAS int*)(rtab + 11 * 256);
    int nu = 0; { pg8::Unit u_; for (int i_ = 0; i_ < 11 && S.next(i_, u_); ++i_) { if (C.tid == 0) pml[i_] = u_.pm; nu = i_ + 1; } }
    __syncthreads();
    const int tot = nu * 256; float rsv[6];
#pragma unroll
    for (int k = 0; k < 6; ++k) { const int e = C.tid + 512 * k; rsv[k] = e < tot ? pg8::row_rstd(SS, pml[e >> 8] * 256 + (e & 255)) : 0.f; }
#pragma unroll
    for (int k = 0; k < 6; ++k) { const int e = C.tid + 512 * k; if (e < tot) rtab[e] = rsv[k]; }
    __syncthreads();
}
__device__ __forceinline__ void x0_phase(const Ctx& C, const float* src, u16* xb, float* ss) {
    const int gw = C.bx * 8 + C.wave, NGW = C.G * 8, lane = C.lane;
    for (int m = gw; m < MTOK; m += NGW) {
        const f32x4* xr = (const f32x4*)(src + (size_t)m * DM) + lane; float s = 0.f;
#pragma unroll
        for (int j = 0; j < 4; ++j) { const f32x4 v = xr[64 * j]; s += (v.x * v.x + v.y * v.y) + (v.z * v.z + v.w * v.w);
            u32x2 o; o.x = pkbf(v.x, v.y); o.y = pkbf(v.z, v.w); *((u32x2*)(xb + (size_t)m * DM) + lane + 64 * j) = o; }
        s = wave_sum(s, lane);
        if (lane < 16) ss[(size_t)m * 16 + lane] = lane == 0 ? s : 0.f;
    }
}
__device__ __forceinline__ void unit_publish(unsigned* flag, int tid) {
    asm volatile("s_waitcnt vmcnt(0)" ::: "memory"); __syncthreads();
    if (tid == 0) { __builtin_amdgcn_fence(__ATOMIC_RELEASE, "agent"); asm volatile("s_waitcnt vmcnt(0)" ::: "memory"); __hip_atomic_store(flag, 1u, __ATOMIC_RELAXED, __HIP_MEMORY_SCOPE_AGENT); }
}
__device__ __forceinline__ void unit_wait(unsigned* f0, unsigned* f1, int tid) {
    if (tid == 0) { unsigned sp = 0;
        while ((__hip_atomic_load(f0, __ATOMIC_RELAXED, __HIP_MEMORY_SCOPE_AGENT) == 0u || __hip_atomic_load(f1, __ATOMIC_RELAXED, __HIP_MEMORY_SCOPE_AGENT) == 0u) && ++sp < (1u << 24)) __builtin_amdgcn_s_sleep(8);
        __builtin_amdgcn_fence(__ATOMIC_ACQUIRE, "agent"); asm volatile("s_waitcnt vmcnt(0)" ::: "memory"); }
    __syncthreads();
}
struct OneUnit { int pm;
    __device__ __forceinline__ bool next(int i, pg8::Unit& u) const { if (i) return false; u.pm = pm; u.pn = 0; return true; }
    __device__ __forceinline__ void a_ready(const pg8::Unit&) const {}
    __device__ __forceinline__ void done(const pg8::Unit&) const {} };
__global__ void __launch_bounds__(512, 2) hybrid_fwd(Params P0) {
    extern __shared__ __attribute__((aligned(16))) unsigned char lds_raw[];
    const KParamsPtr kp0 = (KParamsPtr)__builtin_amdgcn_kernarg_segment_ptr();
    cg::grid_group grid = cg::this_grid();
    { volatile LAS unsigned* misc = (volatile LAS unsigned*)((LAS unsigned char*)lds_raw + MISC_OFF); if (threadIdx.x < 2) misc[threadIdx.x] = 0u; }
    __syncthreads();
    XcdBarrier bar = xcd_barrier_post((unsigned*)(P0.ws + WS_CTL) + 1024, (volatile LAS unsigned*)((LAS unsigned char*)lds_raw + MISC_OFF));
    const int ph_lo = P0.ph_lo, ph_hi = P0.ph_hi; const int wave_s = __builtin_amdgcn_readfirstlane(threadIdx.x >> 6);
    bool redone = false; (void)redone;
    for (int ph = ph_lo; ph < ph_hi; ++ph) {
        KParamsPtr kpl = kp0; asm volatile("" : "+s"(kpl));
        const KParamsPtr P = kpl; unsigned char* ws = P->ws;
        u16* XN = (u16*)(ws + WS_XN); u16* HB = (u16*)(ws + WS_PROJ);
        int G = gridDim.x, bx = blockIdx.x; asm volatile("" : "+s"(G), "+s"(bx));
        Ctx C; C.G = G; C.bx = bx; C.lds = (LAS unsigned char*)lds_raw; C.wave = wave_s; C.lane = lane_opaque(); C.tid = wave_s * 64 + C.lane; C.r32 = C.lane & 31; C.hi = C.lane >> 5;
        C.proj = (u16*)(ws + WS_PROJ); C.obuf = (u16*)(ws + WS_XN); C.vt = (u16*)(ws + WS_VT);
        const int layer = ph / NPH_L, s = ph % NPH_L;
        if (ph != NPH - 1 && (s == 7 || s == 3 || s == 11 || s == 8 || s == 9)) continue;
        float* SS = (float*)(ws + WS_SS);
        u16* XB = (u16*)(ws + WS_XB);
        if (ph == NPH - 1) { norm_phase(C, nullptr, XB, P->final_norm, nullptr, P->out, nullptr); }
        else switch (s) {
        case 0: { convert_weights(C, P, layer); if (layer == 0) { __syncthreads(); x0_phase(C, P->x, XB, SS); } } break;
#ifndef NO_GEMM
#ifndef NO_G1
        case 1: case 12: {
            pg8::Gemm g{XB, (const u16*)(ws + (s == 1 ? WS_GU1 : WS_GU2)), MTOK, 2 * DFF, DM}; pg8::StaticOrder S; S.init(MTOK, 2 * DFF, G, bx);
            LAS float* rtab = (LAS float*)(C.lds + RTAB_OFF); fill_rtab(C, S, SS, rtab);
            pg8::EpiSwiGLU E{HB, DFF, rtab, 0};
            pg8::gemm_phase<pg8::EpiSwiGLU, pg8::StaticOrder, true, true>(C.lds, g, S, E, C.wave); } break;
#endif
#ifndef NO_G2
        case 2: case 13: case 10: {
            const u16* A = (s == 10) ? (const u16*)XN : (const u16*)HB; const u16* Bt = (const u16*)(ws + (s == 2 ? WS_DN1 : s == 13 ? WS_DN2 : WS_WOUT));
            pg8::Gemm g{A, Bt, MTOK, DM, s == 10 ? DM : DFF}; pg8::StaticOrder S; S.init(MTOK, DM, G, bx);
            pg8::EpiResid E{XB, DM, s == 10 ? 1.0f : 0.5f, SS};
            pg8::gemm_phase<pg8::EpiResid, pg8::StaticOrder, false, true>(C.lds, g, S, E, C.wave); } break;
#endif
#ifndef NO_G4
        case 4: {
            pg8::Gemm g{XB, (const u16*)(ws + WS_WIN), MTOK, PW, DM}; pg8::StaticOrder S; S.init(MTOK, PW, G, bx);
            LAS float* rtab = (LAS float*)(C.lds + RTAB_OFF); fill_rtab(C, S, SS, rtab);
            pg8::EpiBf16<0> E{C.proj, PW, rtab, 0};
            pg8::gemm_phase<pg8::EpiBf16<0>, pg8::StaticOrder, true, true>(C.lds, g, S, E, C.wave); } break;
#endif
#endif
#ifndef NO_PREP
        case 5: prep_a(C, P, layer); prep_vk(C, P, 0); break;
#endif
#if !defined(NO_GEMM) && !defined(NO_G6)
        case 6: {
            unsigned* ctl = (unsigned*)(ws + WS_CTL); unsigned* qctr = ctl + 8192 + 64 * ph + (redone ? 32 : 0); unsigned* fcomp = ctl + 16384 + 64 * ph; unsigned* fcmp = ctl + 24576 + 256 * (ph / NPH_L);
            volatile LAS unsigned* qslot = (volatile LAS unsigned*)(C.lds + MISC_OFF + 16);
            for (;;) {
                if (C.tid == 0) *qslot = __hip_atomic_fetch_add(qctr, 1u, __ATOMIC_RELAXED, __HIP_MEMORY_SCOPE_AGENT);
                __syncthreads();
                const unsigned u = *qslot;
                __syncthreads();
                if (u >= 32u + 512u + 256u + 1024u + 512u) break;
                if (u < 32u) { const int i = (int)u >> 4, tile = (int)u & 15;
                    pg8::Gemm g{(const u16*)XN + (size_t)i * 4096 * 2048, (const u16*)(ws + WS_W1) + (size_t)i * 256 * 2048, 4096, 256, 2048}; OneUnit S{tile};
                    pg8::EpiBf16<1> E{(u16*)(ws + WS_HID) + (size_t)i * 4096 * 256, 256, nullptr, 0};
                    pg8::gemm_phase<pg8::EpiBf16<1>, OneUnit, true, true>(C.lds, g, S, E, C.wave);
                    __builtin_amdgcn_fence(__ATOMIC_RELEASE, "agent"); __syncthreads(); __builtin_amdgcn_fence(__ATOMIC_ACQUIRE, "agent");
                    prep_c(C, P, layer, i * 4096 + tile * 256);
                    unit_publish(fcomp + u, C.tid);
                    __syncthreads();
                } else if (u < 544u || u >= 1824u) { const unsigned v = u < 544u ? u - 32u : u - 1824u + 512u; const int qb = 7 - (int)(v >> 7), w = (int)(v & 127);
                    if (w < 64) {
#ifndef NO_DIFF
                        diff_unit(C, P, layer, w >> 2, w & 3, qb);
#endif
                    } else {
#ifndef NO_MOBA
                        moba_unit(C, P, (w - 64) >> 2, w & 3, qb);
#endif
                    }
                } else if (u < 800u) { const int c = (int)u - 544, qblk = 7 - (c >> 5), bg = c & 31;
                    unit_wait(fcomp + (bg >> 1), fcomp + 16 + (bg >> 1), C.tid);
#ifndef NO_CMP
                    cmp_unit(C, P, bg >> 1, bg & 1, qblk);
#endif
                    unit_publish(fcmp + bg * 8 + qblk, C.tid);
                    __syncthreads();
                } else { const int v = (int)u - 800, qb = 7 - (v >> 7), b = (v & 127) >> 3, hq = v & 7; unsigned* f = fcmp + (b * 2 + (hq >> 2)) * 8 + qb;
                    unit_wait(f, f, C.tid);
#ifndef NO_ATT2
                    nsa_unit(C, P, b, hq, qb);
#endif
                }
            } } break;
#endif
        default: break;
        }
        if (ph + 1 < ph_hi) { if (ph == ph_lo) grid.sync(); else xcd_barrier(bar); }
#ifdef PROBE_LO
        if (ph != NPH - 1 && s == PROBE_HI) { if (!redone) { ph -= (PROBE_HI - PROBE_LO + 1); redone = true; } else redone = false; }
#endif
#ifdef PROBE_SYNC
        if (ph + 1 < ph_hi) xcd_barrier(bar);
#endif
    }
}

#ifndef COOP
#define COOP 1
#endif
extern "C" void kernel_launch(void* const* d_in, const int* in_sizes, int n_in, void* d_out, int out_size, void* d_ws, size_t ws_size, hipStream_t stream) {
    static int grid = 0;
    if (grid == 0) {
        if (n_in != 19 || out_size != MTOK * DM || ws_size < WS_END) { fprintf(stderr, "kernel_launch: unexpected shapes (n_in %d out %d ws %zu)\n", n_in, out_size, ws_size); grid = -1; return; }
        int dev = 0, cus = 0, per_cu = 0;
        (void)hipGetDevice(&dev); (void)hipDeviceGetAttribute(&cus, hipDeviceAttributeMultiprocessorCount, dev);
        if (hipFuncSetAttribute((const void*)hybrid_fwd, hipFuncAttributeMaxDynamicSharedMemorySize, LDS_BYTES) != hipSuccess) { fprintf(stderr, "kernel_launch: hipFuncSetAttribute failed\n"); grid = -1; return; }
        if (hipOccupancyMaxActiveBlocksPerMultiprocessor(&per_cu, (const void*)hybrid_fwd, 512, LDS_BYTES) != hipSuccess || per_cu < 1) { fprintf(stderr, "kernel_launch: occupancy query says %d\n", per_cu); per_cu = 1; }
        (void)hipGetLastError();
        grid = cus * per_cu;
    }
    if (grid < 0) return;
    Params p{};
    p.x = (const float*)d_in[0]; p.rel_bias = (const float*)d_in[1]; p.norm_ffn1 = (const float*)d_in[2]; p.ffn1_gate = (const float*)d_in[3]; p.ffn1_up = (const float*)d_in[4]; p.ffn1_down = (const float*)d_in[5];
    p.norm_mix = (const float*)d_in[6]; p.w_in = (const float*)d_in[7]; p.diff_lambda = (const float*)d_in[8]; p.diff_subln = (const float*)d_in[9]; p.cmp_pe = (const float*)d_in[10]; p.cmp_w1 = (const float*)d_in[11];
    p.cmp_w2 = (const float*)d_in[12]; p.w_out = (const float*)d_in[13]; p.norm_ffn2 = (const float*)d_in[14]; p.ffn2_gate = (const float*)d_in[15]; p.ffn2_up = (const float*)d_in[16]; p.ffn2_down = (const float*)d_in[17];
    p.final_norm = (const float*)d_in[18]; p.out = (float*)d_out; p.ws = (unsigned char*)d_ws;
    for (int l = 0; l < 4; ++l) p.lam_init[l] = (float)(0.8 - 0.6 * exp(-0.3 * (double)l));
#if COOP
    if (hipMemsetAsync((char*)d_ws + WS_CTL, 0, CTL_ZERO_BYTES, stream) != hipSuccess) { fprintf(stderr, "kernel_launch: memset of barrier words failed\n"); return; }
    p.ph_lo = 0; p.ph_hi = NPH;
    void* args[] = {&p};
    hipError_t e = hipLaunchCooperativeKernel((const void*)hybrid_fwd, dim3(grid), dim3(512), args, LDS_BYTES, stream);
    if (e != hipSuccess) fprintf(stderr, "cooperative launch failed: %s (grid %d)\n", hipGetErrorString(e), grid);
#else
    for (int ph = 0; ph < NPH; ++ph) { p.ph_lo = ph; p.ph_hi = ph + 1; hipLaunchKernelGGL(hybrid_fwd, dim3(grid), dim3(512), LDS_BYTES, stream, p); }
#endif
}
```

```cpp
#include <hip/hip_runtime.h>
#include <hip/hip_cooperative_groups.h>
#include <cstdio>
#include <cstdint>
#include <cmath>
namespace cg = cooperative_groups;
#define COOP 1
namespace pg8 {
#define PG8_LAS __attribute__((address_space(3)))
typedef unsigned short bf16_t;
typedef short bf16x8 __attribute__((ext_vector_type(8)));
typedef float f32x4 __attribute__((ext_vector_type(4)));
typedef unsigned u32x4 __attribute__((ext_vector_type(4)));
constexpr int BM = 256, BK = 64, HALF = 128, HTB = HALF * BK * 2  , STAGE_BYTES = 8 * HTB, NXCD = 8, WGM = 8;

__host__ __device__ __forceinline__ int lds_byte(int r, int c) { const int st = (r >> 4) * 2 + (c >> 5), rr = r & 15, cc = c & 31, ob = rr * 64 + cc * 2; return st * 1024 + (ob ^ (((ob >> 9) & 1) << 5)); }
__host__ __device__ __forceinline__ void stage_rc(int b, int& R, int& C) { const int st = b / 1024, sb = b % 1024, swz = sb ^ (((sb >> 9) & 1) << 5); R = (st >> 1) * 16 + swz / 64; C = (st & 1) * 32 + (swz % 64) / 2; }
__host__ __device__ __forceinline__ int perm32(int rho) { const int n = rho >> 4, i = rho & 15; return 8 * (i >> 2) + 4 * n + (i & 3); }

struct Unit { int pm, pn; };
struct Gemm { const bf16_t* A; const bf16_t* Bt; int M, N, K; };

struct StaticOrder {
    int nM, nN, nwg, G, c;
    __host__ __device__ void init(int M, int N, int G_, int c_) { nM = M / BM; nN = N / BM; nwg = nM * nN; G = G_; c = c_; }
    __host__ __device__ bool next(int i, Unit& u) const {
        const long L = (long)i * G + c; if (L >= nwg) return false;
        int wgid = (int)L; { const int q = nwg / NXCD, r = nwg % NXCD, xcd = wgid % NXCD, off = wgid / NXCD; wgid = (xcd < r ? xcd * (q + 1) : r * (q + 1) + (xcd - r) * q) + off; }
        const int nig = WGM * nN, gid = wgid / nig, fm = gid * WGM, gsz = (nM - fm) < WGM ? (nM - fm) : WGM;
        u.pm = fm + ((wgid % nig) % gsz); u.pn = (wgid % nig) / gsz; return true;
    }
    __device__ __forceinline__ void a_ready(const Unit&) const {}
    __device__ __forceinline__ void done(const Unit&) const {}
};

__device__ __forceinline__ unsigned cvt_pk_bf16(float lo, float hi) { unsigned r; asm volatile("v_cvt_pk_bf16_f32 %0, %1, %2" : "=v"(r) : "v"(lo), "v"(hi)); return r; }

__device__ __forceinline__ float ex2(float x) { return __builtin_amdgcn_exp2f(x); }
__device__ __forceinline__ float rcpf_(float x) { return __builtin_amdgcn_rcpf(x); }
__device__ __forceinline__ float silu_f(float x) { return x * rcpf_(1.0f + ex2(-1.4426950408889634f * x)); }
__device__ __forceinline__ float gelu_tanh_f(float x) { const float y2 = 2.0f * 0.7978845608028654f * (x + 0.044715f * x * x * x); return x * (1.0f - rcpf_(1.0f + ex2(1.4426950408889634f * y2))); }

__device__ __forceinline__ float row_rstd(const float* ss, int row) {
    const f32x4* p = (const f32x4*)(ss + (size_t)row * 16); const f32x4 a = p[0], b = p[1], c = p[2], d = p[3];
    const float s = ((a[0] + a[1]) + (a[2] + a[3])) + ((b[0] + b[1]) + (b[2] + b[3])) + ((c[0] + c[1]) + (c[2] + c[3])) + ((d[0] + d[1]) + (d[2] + d[3]));
    return 1.0f / sqrtf(s * (1.0f / 1024.0f) + 1e-6f);
}

struct EpiSwiGLU {
    static constexpr bool PERM = true, AFTER_DRAIN = false;
    bf16_t* O; int ldc; const PG8_LAS float* rtab; mutable int ui;
    __device__ __forceinline__ void operator()(const f32x4 (&acc)[2][2][4][2], const Unit& u, int wr, int wc, int fr, int fq) const {
        const int row0 = u.pm * BM + wr * 64 + fr; const int col0 = u.pn * HALF + wc * 32 + 8 * fq;
#pragma unroll
        for (int ai = 0; ai < 2; ++ai)
#pragma unroll
            for (int m = 0; m < 4; ++m) { bf16_t* rowp = O + (size_t)(row0 + ai * HALF + m * 16) * ldc + col0;
                const float rs = rtab[ui * 256 + wr * 64 + fr + ai * HALF + m * 16];
                const f32x4 g0 = acc[ai][0][m][0] * rs, g1 = acc[ai][0][m][1] * rs, u0 = acc[ai][1][m][0] * rs, u1 = acc[ai][1][m][1] * rs;
                u32x4 w; w.x = cvt_pk_bf16(silu_f(g0[0]) * u0[0], silu_f(g0[1]) * u0[1]); w.y = cvt_pk_bf16(silu_f(g0[2]) * u0[2], silu_f(g0[3]) * u0[3]);
                w.z = cvt_pk_bf16(silu_f(g1[0]) * u1[0], silu_f(g1[1]) * u1[1]); w.w = cvt_pk_bf16(silu_f(g1[2]) * u1[2], silu_f(g1[3]) * u1[3]);
                *(u32x4*)rowp = w; asm volatile("" ::: "memory"); }
        ++ui;
    }
};
template <int ACT> struct EpiBf16 {
    static constexpr bool PERM = true, AFTER_DRAIN = false;
    bf16_t* O; int ldc; const PG8_LAS float* rtab; mutable int ui;
    __device__ __forceinline__ void operator()(const f32x4 (&acc)[2][2][4][2], const Unit& u, int wr, int wc, int fr, int fq) const {
        const int row0 = u.pm * BM + wr * 64 + fr; const int col0 = u.pn * BM + wc * 32 + 8 * fq;
#pragma unroll
        for (int ai = 0; ai < 2; ++ai)
#pragma unroll
            for (int m = 0; m < 4; ++m) { bf16_t* rowp = O + (size_t)(row0 + ai * HALF + m * 16) * ldc + col0;
                const float rs = rtab ? rtab[ui * 256 + wr * 64 + fr + ai * HALF + m * 16] : 1.0f;
#pragma unroll
                for (int bj = 0; bj < 2; ++bj) { f32x4 v0 = acc[ai][bj][m][0] * rs, v1 = acc[ai][bj][m][1] * rs;
                    if (ACT == 1) { v0 = (f32x4){gelu_tanh_f(v0[0]), gelu_tanh_f(v0[1]), gelu_tanh_f(v0[2]), gelu_tanh_f(v0[3])}; v1 = (f32x4){gelu_tanh_f(v1[0]), gelu_tanh_f(v1[1]), gelu_tanh_f(v1[2]), gelu_tanh_f(v1[3])}; }
                    u32x4 w; w.x = cvt_pk_bf16(v0[0], v0[1]); w.y = cvt_pk_bf16(v0[2], v0[3]); w.z = cvt_pk_bf16(v1[0], v1[1]); w.w = cvt_pk_bf16(v1[2], v1[3]);
                    *(u32x4*)(rowp + bj * HALF) = w; } asm volatile("" ::: "memory"); }
        ++ui;
    }
};
struct EpiResid {
    static constexpr bool PERM = true, AFTER_DRAIN = false;
    bf16_t* xb; int ldc; float alpha; float* ss;
    __device__ __forceinline__ void operator()(const f32x4 (&acc)[2][2][4][2], const Unit& u, int wr, int wc, int fr, int fq) const {
        const int row0 = u.pm * BM + wr * 64 + fr; const int col0 = u.pn * BM + wc * 32 + 8 * fq; const int lane = fq * 16 + fr;
#pragma unroll
        for (int ai = 0; ai < 2; ++ai) {
            u32x4 pre[4][2];
#pragma unroll
            for (int m = 0; m < 4; ++m)
#pragma unroll
                for (int bj = 0; bj < 2; ++bj) pre[m][bj] = *(const u32x4*)(xb + (size_t)(row0 + ai * HALF + m * 16) * ldc + col0 + bj * HALF);
#pragma unroll
            for (int m = 0; m < 4; ++m) { const int row = row0 + ai * HALF + m * 16; bf16_t* rowp = xb + (size_t)row * ldc + col0; float sq = 0.f;
#pragma unroll
                for (int bj = 0; bj < 2; ++bj) { const u32x4 p = pre[m][bj]; const f32x4 a0 = acc[ai][bj][m][0] * alpha, a1 = acc[ai][bj][m][1] * alpha;
                    const float x0 = __uint_as_float(p.x << 16) + a0[0], x1 = __uint_as_float(p.x & 0xffff0000u) + a0[1], x2 = __uint_as_float(p.y << 16) + a0[2], x3 = __uint_as_float(p.y & 0xffff0000u) + a0[3];
                    const float x4 = __uint_as_float(p.z << 16) + a1[0], x5 = __uint_as_float(p.z & 0xffff0000u) + a1[1], x6 = __uint_as_float(p.w << 16) + a1[2], x7 = __uint_as_float(p.w & 0xffff0000u) + a1[3];
                    sq += ((x0 * x0 + x1 * x1) + (x2 * x2 + x3 * x3)) + ((x4 * x4 + x5 * x5) + (x6 * x6 + x7 * x7));
                    u32x4 w; w.x = cvt_pk_bf16(x0, x1); w.y = cvt_pk_bf16(x2, x3); w.z = cvt_pk_bf16(x4, x5); w.w = cvt_pk_bf16(x6, x7);
                    *(u32x4*)(rowp + bj * HALF) = w; }
                sq += __int_as_float(__builtin_amdgcn_ds_bpermute((lane ^ 16) << 2, __float_as_int(sq)));
                sq += __int_as_float(__builtin_amdgcn_ds_bpermute((lane ^ 32) << 2, __float_as_int(sq)));
                if (fq == 0) ss[(size_t)row * 16 + u.pn * 4 + wc] = sq; }
            asm volatile("" ::: "memory");
        }
    }
};
template <class Epi, class Sched, bool ALIGN_EPI = false, bool SP2 = false>
__device__ __forceinline__ void gemm_phase(PG8_LAS unsigned char* lds, const Gemm g, const Sched& S, const Epi& E, const int wave_in) {
    int tid_l; asm volatile("v_mbcnt_lo_u32_b32 %0, -1, 0\n\tv_mbcnt_hi_u32_b32 %0, -1, %0" : "=v"(tid_l)); tid_l += wave_in * 64;
    const int tid = tid_l, wid = __builtin_amdgcn_readfirstlane(tid >> 6), lane = tid & 63, wr = wid >> 2, wc = wid & 3, fr = lane & 15, fq = lane >> 4;
    const int K = g.K, nt = K / BK;
    unsigned voffA[2], voffB[2];
#pragma unroll
    for (int i = 0; i < 2; ++i) { int R, C; stage_rc(tid * 16 + i * 8192, R, C); const int Rb = Epi::PERM ? ((R & ~31) + perm32(R & 31)) : R;
        voffA[i] = (unsigned)(R * K + C) * 2u; voffB[i] = (unsigned)(Rb * K + C) * 2u; }
    const size_t kstep = (size_t)(BK * 2);
    const size_t hstep = (size_t)HALF * K * 2;
    const size_t tstep = 2 * hstep;
    const unsigned ldsw = (unsigned)wid * 1024u;
    const int aoff = lds_byte(wr * 64 + fr, fq * 8), boff = lds_byte(wc * 32 + fr, fq * 8);
#define PG8_SA(b, h) (((b) * 2 + (h)) * HTB)
#define PG8_SB(b, h) ((4 + (b) * 2 + (h)) * HTB)
#define PG8_STAGE(bufoff, gbase, voff) do { _Pragma("unroll") for (int _i = 0; _i < 2; ++_i) \
        __builtin_amdgcn_global_load_lds((const unsigned*)((const char*)(gbase) + (voff)[_i]), (PG8_LAS unsigned*)(lds + (bufoff) + ldsw + _i * 8192), 16, 0, 0); } while (0)
#define PG8_LDA(dst, b, h) do { _Pragma("unroll") for (int m = 0; m < 4; ++m) _Pragma("unroll") for (int k = 0; k < 2; ++k) dst[m][k] = *(const PG8_LAS bf16x8*)(lds + PG8_SA(b, h) + aoff + m * 2048 + k * 1024); } while (0)
#define PG8_LDB(dst, b, h) do { _Pragma("unroll") for (int n = 0; n < 2; ++n) _Pragma("unroll") for (int k = 0; k < 2; ++k) dst[n][k] = *(const PG8_LAS bf16x8*)(lds + PG8_SB(b, h) + boff + n * 2048 + k * 1024); } while (0)
#define PG8_MMA(ai, bj, At, Bt) do { __builtin_amdgcn_s_setprio(1); _Pragma("unroll") for (int m = 0; m < 4; ++m) _Pragma("unroll") for (int n = 0; n < 2; ++n) _Pragma("unroll") for (int k = 0; k < 2; ++k) \
        acc[ai][bj][m][n] = __builtin_amdgcn_mfma_f32_16x16x32_bf16(Bt[n][k], At[m][k], acc[ai][bj][m][n], 0, 0, 0); __builtin_amdgcn_s_setprio(0); } while (0)
#define PG8_WAIT_V(n) asm volatile("s_waitcnt vmcnt(" #n ")" ::: "memory")
#define PG8_WAIT_L(n) asm volatile("s_waitcnt lgkmcnt(" #n ")" ::: "memory")
#define PG8_BAR __builtin_amdgcn_s_barrier()
#define PG8_SCHED __builtin_amdgcn_sched_barrier(0)
    Unit cur, nxt; int ui = 0;
    if (!S.next(0, cur)) return;
    f32x4 acc[2][2][4][2];
#pragma unroll
    for (int a = 0; a < 2; ++a)
#pragma unroll
        for (int b = 0; b < 2; ++b)
#pragma unroll
            for (int m = 0; m < 4; ++m)
#pragma unroll
                for (int n = 0; n < 2; ++n) acc[a][b][m][n] = (f32x4){0.f, 0.f, 0.f, 0.f};
    bf16x8 At[4][2], B0[2][2], B1[2][2];
    const char* cA = (const char*)g.A + (size_t)cur.pm * tstep; const char* cB = (const char*)g.Bt + (size_t)cur.pn * tstep;
    S.a_ready(cur);
    if constexpr (SP2) {
        PG8_STAGE(PG8_SB(0, 0), cB, voffB); PG8_STAGE(PG8_SB(0, 1), cB + hstep, voffB); PG8_STAGE(PG8_SA(0, 0), cA, voffA); PG8_STAGE(PG8_SA(0, 1), cA + hstep, voffA);
        if (wr == 1) PG8_BAR;
        PG8_WAIT_V(2); PG8_BAR;
        PG8_STAGE(PG8_SB(1, 0), cB + kstep, voffB); PG8_STAGE(PG8_SA(1, 0), cA + kstep, voffA); PG8_STAGE(PG8_SB(1, 1), cB + hstep + kstep, voffB);
        PG8_WAIT_V(6); PG8_BAR;
    } else {
        PG8_STAGE(PG8_SB(0, 0), cB, voffB); PG8_STAGE(PG8_SA(0, 0), cA, voffA); PG8_STAGE(PG8_SB(0, 1), cB + hstep, voffB); PG8_STAGE(PG8_SA(0, 1), cA + hstep, voffA);
        if (wr == 1) PG8_BAR;
        PG8_WAIT_V(4); PG8_BAR;
        PG8_STAGE(PG8_SB(1, 0), cB + kstep, voffB); PG8_STAGE(PG8_SA(1, 0), cA + kstep, voffA); PG8_STAGE(PG8_SB(1, 1), cB + hstep + kstep, voffB);
        PG8_WAIT_V(6); PG8_BAR;
    }
    for (;;) {
        const bool has_next = S.next(ui + 1, nxt);
        const char* nA = has_next ? (const char*)g.A + (size_t)nxt.pm * tstep : cA; const char* nB = has_next ? (const char*)g.Bt + (size_t)nxt.pn * tstep : cB;
        for (int t = 0; t < nt; t += 2) {
            const bool last = (t == nt - 2);
            const char* a1 = cA + (size_t)(t + 1) * kstep;
            const char* a2 = last ? nA : cA + (size_t)(t + 2) * kstep; const char* b2 = last ? nB : cB + (size_t)(t + 2) * kstep;
            const char* a3 = a2 + kstep; const char* b3 = b2 + kstep;
            if (last && has_next) S.a_ready(nxt);
            if constexpr (SP2) {
            PG8_LDB(B0, 0, 0); PG8_LDB(B1, 0, 1); PG8_SCHED; PG8_LDA(At, 0, 0); PG8_STAGE(PG8_SA(1, 1), a1 + hstep, voffA);
            PG8_WAIT_V(8); PG8_WAIT_L(0); PG8_BAR; PG8_MMA(0, 0, At, B0); PG8_MMA(0, 1, At, B1); PG8_BAR; PG8_SCHED;
            PG8_LDA(At, 0, 1); PG8_STAGE(PG8_SB(0, 0), b2, voffB); PG8_STAGE(PG8_SB(0, 1), b2 + hstep, voffB); PG8_STAGE(PG8_SA(0, 0), a2, voffA);
            PG8_WAIT_V(8); PG8_WAIT_L(0); PG8_BAR; PG8_MMA(1, 0, At, B0); PG8_MMA(1, 1, At, B1); PG8_BAR; PG8_SCHED;
            PG8_LDB(B0, 1, 0); PG8_LDB(B1, 1, 1); PG8_SCHED; PG8_LDA(At, 1, 0); PG8_STAGE(PG8_SA(0, 1), a2 + hstep, voffA);
            PG8_WAIT_V(8); PG8_WAIT_L(0); PG8_BAR; PG8_MMA(0, 0, At, B0); PG8_MMA(0, 1, At, B1); PG8_BAR; PG8_SCHED;
            PG8_LDA(At, 1, 1); PG8_STAGE(PG8_SB(1, 0), b3, voffB); PG8_STAGE(PG8_SB(1, 1), b3 + hstep, voffB); PG8_STAGE(PG8_SA(1, 0), a3, voffA);
            PG8_WAIT_V(8); PG8_WAIT_L(0); PG8_BAR; PG8_MMA(1, 0, At, B0); PG8_MMA(1, 1, At, B1); PG8_BAR; PG8_SCHED;
            } else {
            PG8_LDB(B0, 0, 0); PG8_SCHED; PG8_LDA(At, 0, 0); PG8_STAGE(PG8_SA(1, 1), a1 + hstep, voffA);
            PG8_WAIT_L(8); PG8_BAR; PG8_WAIT_L(0); PG8_MMA(0, 0, At, B0); PG8_BAR; PG8_SCHED;
            PG8_LDB(B1, 0, 1); PG8_STAGE(PG8_SB(0, 0), b2, voffB);
            PG8_BAR; PG8_WAIT_L(0); PG8_MMA(0, 1, At, B1); PG8_BAR;
            PG8_LDA(At, 0, 1); PG8_STAGE(PG8_SA(0, 0), a2, voffA);
            PG8_BAR; PG8_WAIT_L(0); PG8_MMA(1, 0, At, B0); PG8_BAR; PG8_SCHED;
            PG8_STAGE(PG8_SB(0, 1), b2 + hstep, voffB);
            PG8_WAIT_V(6); PG8_BAR; PG8_MMA(1, 1, At, B1); PG8_BAR;
            PG8_LDB(B0, 1, 0); PG8_SCHED; PG8_LDA(At, 1, 0); PG8_STAGE(PG8_SA(0, 1), a2 + hstep, voffA);
            PG8_WAIT_L(8); PG8_BAR; PG8_WAIT_L(0); PG8_MMA(0, 0, At, B0); PG8_BAR; PG8_SCHED;
            PG8_LDB(B1, 1, 1); PG8_STAGE(PG8_SB(1, 0), b3, voffB);
            PG8_BAR; PG8_WAIT_L(0); PG8_MMA(0, 1, At, B1); PG8_BAR;
            PG8_LDA(At, 1, 1); PG8_STAGE(PG8_SA(1, 0), a3, voffA);
            PG8_BAR; PG8_WAIT_L(0); PG8_MMA(1, 0, At, B0); PG8_BAR; PG8_SCHED;
            PG8_STAGE(PG8_SB(1, 1), b3 + hstep, voffB);
            PG8_WAIT_V(6); PG8_BAR; PG8_MMA(1, 1, At, B1); PG8_BAR;
            }
        }
        if constexpr (ALIGN_EPI) { if (wr == 0) PG8_BAR; }
        if constexpr (!Epi::AFTER_DRAIN) { E(acc, cur, wr, wc, fr, fq); S.done(cur); }
        if (!has_next) break;
#pragma unroll
        for (int a = 0; a < 2; ++a)
#pragma unroll
            for (int b = 0; b < 2; ++b)
#pragma unroll
                for (int m = 0; m < 4; ++m)
#pragma unroll
                    for (int n = 0; n < 2; ++n) acc[a][b][m][n] = (f32x4){0.f, 0.f, 0.f, 0.f};
        cur = nxt; cA = nA; cB = nB; ++ui;
        if constexpr (ALIGN_EPI) { if (wr == 1) PG8_BAR; }
    }
    PG8_WAIT_V(0);
    if constexpr (!ALIGN_EPI) { if (wr == 0) PG8_BAR; }
    PG8_BAR;
    if constexpr (Epi::AFTER_DRAIN) { E.fused(acc, cur, wr, wc, fr, fq, lds, wid, lane); S.done(cur); }
#undef PG8_SA
#undef PG8_SB
#undef PG8_STAGE
#undef PG8_LDA
#undef PG8_LDB
#undef PG8_MMA
#undef PG8_WAIT_V
#undef PG8_WAIT_L
#undef PG8_BAR
#undef PG8_SCHED
}
}

#define LAS __attribute__((address_space(3)))
using pg8::ex2; using pg8::rcpf_;
typedef unsigned short u16;
typedef short bf16x8 __attribute__((ext_vector_type(8)));
typedef float f32x4 __attribute__((ext_vector_type(4)));
typedef float f32x16 __attribute__((ext_vector_type(16)));
typedef unsigned u32x4 __attribute__((ext_vector_type(4)));
typedef unsigned u32x2 __attribute__((ext_vector_type(2)));

constexpr int DM = 1024, NB = 16, SEQ = 2048, MTOK = NB * SEQ, DEPTH = 4, DFF = 2816, INW = 2840, PW = 3072;
constexpr int C_MQ = 0, C_MK = 256, C_MV = 512, C_DQ = 768, C_DK = 1024, C_DV = 1280, C_NQ = 1536, C_NKC = 2048, C_NVC = 2176, C_NKS = 2304, C_NVS = 2432, C_NKW = 2560, C_NVW = 2688, C_NG = 2816;
constexpr int NVH = 12;
constexpr float LOG2E = 1.4426950408889634f, NEGF = -1e30f;
constexpr int NPH_L = 14, NPH = NPH_L * DEPTH + 1;
constexpr size_t MiB = 1u << 20;
constexpr size_t WS_GU1 = 1 * MiB, WS_DN1 = 12 * MiB, WS_GU2 = WS_DN1 + 5 * MiB + MiB / 2, WS_DN2 = WS_GU2 + 11 * MiB, WS_WIN = 34 * MiB, WS_WOUT = 40 * MiB, WS_W1 = 42 * MiB;
constexpr size_t WS_PROJ = 44 * MiB, WS_XN = 236 * MiB, WS_VT = 300 * MiB, WS_HID = 348 * MiB, WS_KCMP = 352 * MiB, WS_VCMPT = WS_KCMP + MiB / 2, WS_KMEAN = 353 * MiB, WS_SEL = WS_KMEAN + MiB / 4, WS_XB = 354 * MiB, WS_SS = 418 * MiB, WS_END = 420 * MiB;
static_assert(WS_DN2 + 5 * MiB + MiB / 2 == WS_WIN, "ws map");
constexpr int LDS_BYTES = 147456, MISC_OFF = 147456 - 64, RTAB_OFF = 131072;
constexpr size_t WS_CTL = 0, CTL_ZERO_BYTES = 262144;
constexpr int ATT_K = 0, ATT_V = 32768, ATT_LUT = 32768 + 4 * 8704, ATT_PARK = ATT_LUT + 2816;
constexpr int CMP_K = 0, CMP_V = 18432, CMP_A = 36864, CMP_H = CMP_A + 256 * 33 * 4;

struct Params {
    const float* x; const float* rel_bias; const float* norm_ffn1; const float* ffn1_gate; const float* ffn1_up; const float* ffn1_down;
    const float* norm_mix; const float* w_in; const float* diff_lambda; const float* diff_subln; const float* cmp_pe; const float* cmp_w1; const float* cmp_w2;
    const float* w_out; const float* norm_ffn2; const float* ffn2_gate; const float* ffn2_up; const float* ffn2_down; const float* final_norm;
    float* out; unsigned char* ws;
    float lam_init[4];
    int ph_lo, ph_hi;
};
typedef const __attribute__((address_space(4))) Params* KParamsPtr;

__device__ __forceinline__ float bf2f(unsigned v) { return __uint_as_float(v << 16); }
typedef float f32x2_t __attribute__((ext_vector_type(2))); typedef __bf16 bf16x2_t __attribute__((ext_vector_type(2)));
__device__ __forceinline__ unsigned pkbf(float lo, float hi) { f32x2_t v = {lo, hi}; bf16x2_t b = __builtin_convertvector(v, bf16x2_t); return __builtin_bit_cast(unsigned, b); }
__device__ __forceinline__ int lane_opaque() { int l; asm volatile("v_mbcnt_lo_u32_b32 %0, -1, 0\n\tv_mbcnt_hi_u32_b32 %0, -1, %0" : "=v"(l)); return l; }
__device__ __forceinline__ float wave_sum(float v, int lane) {
#pragma unroll
    for (int o = 1; o < 64; o <<= 1) v += __int_as_float(__builtin_amdgcn_ds_bpermute((lane ^ o) << 2, __float_as_int(v)));
    return v;
}
__device__ __forceinline__ float xhalf_max(float v) { auto rr = __builtin_amdgcn_permlane32_swap(__float_as_uint(v), __float_as_uint(v), false, false); return fmaxf(__uint_as_float(rr[0]), __uint_as_float(rr[1])); }
__device__ __forceinline__ float xhalf_sum(float v) { auto rr = __builtin_amdgcn_permlane32_swap(__float_as_uint(v), __float_as_uint(v), false, false); return __uint_as_float(rr[0]) + __uint_as_float(rr[1]); }
__device__ __forceinline__ float sigmoid_f(float x) { return rcpf_(1.0f + ex2(-LOG2E * x)); }
__device__ __forceinline__ int crow(int r, int hi) { return (r & 3) + 8 * (r >> 2) + 4 * hi; }
__device__ __forceinline__ int kperm(int p) { const int h = p >> 3, j = p & 7; return 8 * (j >> 2) + 4 * h + (j & 3); }
__device__ __forceinline__ int pperm(int k) { return ((k >> 2) & 1) * 8 + (k >> 3) * 4 + (k & 3); }

__device__ __forceinline__ void tr_item(const float* W, int K, int N, u16* WT, int kb, int n0, int dst_row0, LAS float* scr, int lane, float cs = 1.0f, const float* gk = nullptr) {
    const int k0 = 64 * kb; const int n = n0 + (lane & 31); const bool ok = n < N;
    float wv[32];
#pragma unroll
    for (int i = 0; i < 32; ++i) { const int kk = 2 * i + (lane >> 5); wv[i] = ok ? W[(size_t)(k0 + kk) * N + n] : 0.f; }
#pragma unroll
    for (int i = 0; i < 32; ++i) { const int kk = 2 * i + (lane >> 5); scr[kk * 33 + (lane & 31)] = wv[i] * (gk ? gk[k0 + kk] * cs : cs); }
    asm volatile("s_waitcnt lgkmcnt(0)" ::: "memory");
    const int c = lane & 7;
#pragma unroll
    for (int j = 0; j < 4; ++j) { const int nn = (lane >> 3) + 8 * j; const LAS float* s = scr + (8 * c) * 33 + nn;
        u32x4 o; o.x = pkbf(s[0 * 33], s[1 * 33]); o.y = pkbf(s[2 * 33], s[3 * 33]); o.z = pkbf(s[4 * 33], s[5 * 33]); o.w = pkbf(s[6 * 33], s[7 * 33]);
        *(u32x4*)(WT + (size_t)(dst_row0 + nn) * K + k0 + 8 * c) = o; }
    asm volatile("s_waitcnt lgkmcnt(0)" ::: "memory");
}

__device__ __forceinline__ void norm_row(const float* xrow, const u16* xrow16, const float* g, u16* dst16, float* dst32, u16* xb0, int lane) {
    float v[16];
    if (xrow) { const f32x4* xr = (const f32x4*)xrow + 4 * lane;
#pragma unroll
        for (int j = 0; j < 4; ++j) { const f32x4 t = xr[j]; v[4 * j] = t.x; v[4 * j + 1] = t.y; v[4 * j + 2] = t.z; v[4 * j + 3] = t.w; }
        if (xb0) { u32x4 o0, o1; o0.x = pkbf(v[0], v[1]); o0.y = pkbf(v[2], v[3]); o0.z = pkbf(v[4], v[5]); o0.w = pkbf(v[6], v[7]); o1.x = pkbf(v[8], v[9]); o1.y = pkbf(v[10], v[11]); o1.z = pkbf(v[12], v[13]); o1.w = pkbf(v[14], v[15]);
            ((u32x4*)xb0)[2 * lane] = o0; ((u32x4*)xb0)[2 * lane + 1] = o1; }
    } else { const u32x4 p0 = ((const u32x4*)xrow16)[2 * lane], p1 = ((const u32x4*)xrow16)[2 * lane + 1];
        v[0] = bf2f(p0.x & 0xffffu); v[1] = bf2f(p0.x >> 16); v[2] = bf2f(p0.y & 0xffffu); v[3] = bf2f(p0.y >> 16); v[4] = bf2f(p0.z & 0xffffu); v[5] = bf2f(p0.z >> 16); v[6] = bf2f(p0.w & 0xffffu); v[7] = bf2f(p0.w >> 16);
        v[8] = bf2f(p1.x & 0xffffu); v[9] = bf2f(p1.x >> 16); v[10] = bf2f(p1.y & 0xffffu); v[11] = bf2f(p1.y >> 16); v[12] = bf2f(p1.z & 0xffffu); v[13] = bf2f(p1.z >> 16); v[14] = bf2f(p1.w & 0xffffu); v[15] = bf2f(p1.w >> 16); }
    float s = 0.f;
#pragma unroll
    for (int j = 0; j < 16; ++j) s = fmaf(v[j], v[j], s);
    const float rstd = 1.0f / sqrtf(wave_sum(s, lane) * (1.0f / 1024.0f) + 1e-6f);
    const f32x4* gr = (const f32x4*)g + 4 * lane;
#pragma unroll
    for (int j = 0; j < 4; ++j) { const f32x4 gg = gr[j]; v[4 * j] *= rstd * gg.x; v[4 * j + 1] *= rstd * gg.y; v[4 * j + 2] *= rstd * gg.z; v[4 * j + 3] *= rstd * gg.w; }
    if (dst16) { u32x4 o0, o1; o0.x = pkbf(v[0], v[1]); o0.y = pkbf(v[2], v[3]); o0.z = pkbf(v[4], v[5]); o0.w = pkbf(v[6], v[7]); o1.x = pkbf(v[8], v[9]); o1.y = pkbf(v[10], v[11]); o1.z = pkbf(v[12], v[13]); o1.w = pkbf(v[14], v[15]);
        ((u32x4*)dst16)[2 * lane] = o0; ((u32x4*)dst16)[2 * lane + 1] = o1; }
    else {
#pragma unroll
        for (int j = 0; j < 4; ++j) ((f32x4*)dst32)[4 * lane + j] = (f32x4){v[4 * j], v[4 * j + 1], v[4 * j + 2], v[4 * j + 3]}; }
}

struct AState { f32x16 o0, o1; float m, l; };
__device__ __forceinline__ void astate_init(AState& s) {
#pragma unroll
    for (int r = 0; r < 16; ++r) { s.o0[r] = 0.f; s.o1[r] = 0.f; }
    s.m = 0.f; s.l = 0.f;
}
constexpr float ATT_THR = 8.0f;
constexpr int ATT_SLOT = 9216, ATT_NSLOT = 3;
template <int KS0, int NKS>
__device__ __forceinline__ void qk_block(const LAS unsigned char* Ks, const bf16x8 (&qr)[4], int r32, int hi, f32x16& s0, f32x16& s1) {
    f32x16 ci;
#pragma unroll
    for (int r = 0; r < 16; ++r) ci[r] = 0.f;
    const LAS unsigned char* kp = Ks + hi * 1024 + r32 * 16;
#pragma unroll
    for (int ks = 0; ks < NKS; ++ks) {
        const bf16x8 a0 = *(const LAS bf16x8*)(kp + (KS0 + ks) * 2048);
        const bf16x8 a1 = *(const LAS bf16x8*)(kp + (KS0 + ks) * 2048 + 512);
        s0 = __builtin_amdgcn_mfma_f32_32x32x16_bf16(a0, qr[KS0 + ks], ks == 0 ? ci : s0, 0, 0, 0);
        s1 = __builtin_amdgcn_mfma_f32_32x32x16_bf16(a1, qr[KS0 + ks], ks == 0 ? ci : s1, 0, 0, 0);
    }
    __builtin_amdgcn_sched_group_barrier(0x100, 2 * NKS, 0); __builtin_amdgcn_sched_group_barrier(0x008, 2 * NKS, 0);
}
constexpr int ATT_VCH = 1088, ATT_VSLOT = 8 * ATT_VCH;
typedef short v4i16_t __attribute__((ext_vector_type(4)));
__device__ __forceinline__ void pv_block(const LAS unsigned char* Vs, const u32x4 (&pk)[4], int lane, AState& st) {
    const int p = lane & 3, q = (lane & 15) >> 2, dsel = (lane >> 4) & 1, hi = lane >> 5;
    const LAS unsigned char* vp = Vs + (2 * dsel + (p >> 1)) * ATT_VCH + (4 * hi + q) * 16 + (p & 1) * 8;
#pragma unroll
    for (int c = 0; c < 4; ++c) {
        const v4i16_t a0 = __builtin_amdgcn_ds_read_tr16_b64_v4i16((LAS v4i16_t*)(vp + c * 256));
        const v4i16_t a1 = __builtin_amdgcn_ds_read_tr16_b64_v4i16((LAS v4i16_t*)(vp + c * 256 + 128));
        const v4i16_t b0 = __builtin_amdgcn_ds_read_tr16_b64_v4i16((LAS v4i16_t*)(vp + 4 * ATT_VCH + c * 256));
        const v4i16_t b1 = __builtin_amdgcn_ds_read_tr16_b64_v4i16((LAS v4i16_t*)(vp + 4 * ATT_VCH + c * 256 + 128));
        const bf16x8 v0 = (bf16x8){a0[0], a0[1], a0[2], a0[3], a1[0], a1[1], a1[2], a1[3]};
        const bf16x8 v1 = (bf16x8){b0[0], b0[1], b0[2], b0[3], b1[0], b1[1], b1[2], b1[3]};
        const bf16x8 pb = __builtin_bit_cast(bf16x8, pk[c]);
        st.o0 = __builtin_amdgcn_mfma_f32_32x32x16_bf16(v0, pb, st.o0, 0, 0, 0);
        st.o1 = __builtin_amdgcn_mfma_f32_32x32x16_bf16(v1, pb, st.o1, 0, 0, 0);
    }
}
__device__ __forceinline__ void glds16(const void* gsrc, unsigned lds_dst) { unsigned keep;
    asm volatile("s_mov_b32 %0, m0\n\ts_mov_b32 m0, %2\n\ts_nop 0\n\tglobal_load_lds_dwordx4 %1, off\n\ts_mov_b32 m0, %0" : "=&s"(keep) : "v"(gsrc), "s"(lds_dst) : "memory"); }
__device__ __forceinline__ void lut_add(f32x16& s0, f32x16& s1, const LAS float* lutz, int dbase, float cc) {
    const LAS float* lp = lutz + (dbase - 59);
#pragma unroll
    for (int r = 0; r < 16; ++r) { const int ko = (r & 3) + 8 * (r >> 2);
        s0[r] += lp[59 - ko] + cc; s1[r] += lp[27 - ko] + cc; }
}
__device__ __forceinline__ void const_add(f32x16& s0, f32x16& s1, float cc) {
#pragma unroll
    for (int r = 0; r < 16; ++r) { s0[r] += cc; s1[r] += cc; }
}
__device__ __forceinline__ float row_max(const f32x16& s0, const f32x16& s1) {
    float mx = fmaxf(s0[0], s1[0]);
#pragma unroll
    for (int r = 1; r < 16; ++r) mx = fmaxf(mx, fmaxf(s0[r], s1[r]));
    return xhalf_max(mx);
}
__device__ __forceinline__ void rescale(AState& st, f32x16& s0, f32x16& s1, float mx) {
    const float dl = fmaxf(mx, 0.f); const float f = ex2(-dl); st.m += dl; st.l *= f;
#pragma unroll
    for (int r = 0; r < 16; ++r) { st.o0[r] *= f; st.o1[r] *= f; s0[r] -= dl; s1[r] -= dl; }
}
constexpr float ATT_BIG = 1024.0f;
__device__ __forceinline__ void exp_pack(f32x16& s0, f32x16& s1, u32x4 (&pk)[4], AState& st) {
    float sum = 0.f;
#pragma unroll
    for (int r = 0; r < 16; ++r) { s0[r] = ex2(s0[r]); s1[r] = ex2(s1[r]); sum += s0[r] + s1[r]; }
    if (__any(sum > ATT_BIG)) {
        float mx = fmaxf(s0[0], s1[0]);
#pragma unroll
        for (int r = 1; r < 16; ++r) mx = fmaxf(mx, fmaxf(s0[r], s1[r]));
        mx = xhalf_max(mx);
        const float dl = fmaxf(__builtin_amdgcn_logf(fmaxf(mx, 1.0f)), 0.f), f = ex2(-dl);
        st.m += dl; st.l *= f; sum *= f;
#pragma unroll
        for (int r = 0; r < 16; ++r) { st.o0[r] *= f; st.o1[r] *= f; s0[r] *= f; s1[r] *= f; }
    }
    st.l += sum;
    pk[0] = (u32x4){pkbf(s0[0], s0[1]), pkbf(s0[2], s0[3]), pkbf(s0[4], s0[5]), pkbf(s0[6], s0[7])};
    pk[1] = (u32x4){pkbf(s0[8], s0[9]), pkbf(s0[10], s0[11]), pkbf(s0[12], s0[13]), pkbf(s0[14], s0[15])};
    pk[2] = (u32x4){pkbf(s1[0], s1[1]), pkbf(s1[2], s1[3]), pkbf(s1[4], s1[5]), pkbf(s1[6], s1[7])};
    pk[3] = (u32x4){pkbf(s1[8], s1[9]), pkbf(s1[10], s1[11]), pkbf(s1[12], s1[13]), pkbf(s1[14], s1[15])};
}

template <int KS0, int NKS, bool WINDOW, int MODE>
__device__ __forceinline__ void run_tiles(LAS unsigned char* lds, int t0, int t1, const u16* Kg, const u16* Vtg, const bf16x8 (&qr)[4], float c31,
                                          int q0w, unsigned mask, int qb, AState& A, int wave, int lane, int r32, int hi) {
    LAS unsigned char* Kr = lds + ATT_K; LAS unsigned char* Vr = lds + ATT_V; const LAS float* lut1 = (const LAS float*)(lds + ATT_LUT) + 96;
    const u16* ksrc = Kg + (size_t)lane * PW + wave * 8;
    const u16* vsrc = Vtg + (size_t)lane * PW + wave * 8;
    const unsigned kdst = (unsigned)(uintptr_t)Kr + wave * 1024, vdst = (unsigned)(uintptr_t)Vr + wave * ATT_VCH;
#define TCL(t) ((t) < t0 ? t0 : ((t) > t1 ? t1 : (t)))
#define DMA_K(tn) glds16(ksrc + (size_t)TCL(tn) * 64 * PW, (unsigned)__builtin_amdgcn_readfirstlane(kdst + ((tn) & 3) * 8192))
#define DMA_V(tn) glds16(vsrc + (size_t)TCL(tn) * 64 * PW, (unsigned)__builtin_amdgcn_readfirstlane(vdst + ((tn) & 3) * ATT_VSLOT))
#define KS_(t) (Kr + ((t) & 3) * 8192)
#define VS_(t) (Vr + ((t) & 3) * ATT_VSLOT)
#define WAIT_BAR4() asm volatile("s_waitcnt vmcnt(4) lgkmcnt(0)\n\ts_barrier" ::: "memory")
#define T_ACTIVE(t) (!((q0w + 31 - (t) * 64) < 0 || (WINDOW && (q0w - ((t) * 64 + 63)) >= 512)))
#define T_LUTMODE(t) (((q0w - ((t) * 64 + 63)) < 128) || (WINDOW && (q0w + 31 - (t) * 64) >= 512))
    auto tile_sel = [&](int t) -> int { if (MODE == 1) { const int blk = t >> 2; return blk < qb ? (int)((mask >> blk) & 1u) : 1; } if (MODE == 2) return (int)((mask >> t) & 1u); return 1; };
    asm volatile("s_waitcnt vmcnt(0)" ::: "memory");
#pragma unroll
    for (int j = 0; j < 4; ++j) { DMA_K(t0 + j); DMA_V(t0 + j - 2); }
    WAIT_BAR4();
    f32x16 sn0, sn1, sc0, sc1; u32x4 pk[4];
#pragma unroll
    for (int r = 0; r < 16; ++r) { sn0[r] = 0.f; sn1[r] = 0.f; }
#pragma unroll
    for (int i = 0; i < 4; ++i) pk[i] = (u32x4){0u, 0u, 0u, 0u};
    bool act_n = T_ACTIVE(t0), act_c = false, act_p = false;
    if (act_n) qk_block<KS0, NKS>(KS_(t0), qr, r32, hi, sn0, sn1);
    asm volatile("s_waitcnt lgkmcnt(0)\n\ts_barrier" ::: "memory");
    for (int c = t0; c <= t1 + 1; ++c) {
        act_p = act_c; act_c = act_n; sc0 = sn0; sc1 = sn1;
        DMA_K(c + 4); DMA_V(c + 2);
        act_n = (c + 1 <= t1) && T_ACTIVE(c + 1);
        const bool lm_c = T_LUTMODE(c);
        const int dbase = q0w + r32 - c * 64 - 4 * hi;
        const float selc = tile_sel(c) ? 0.f : NEGF;
        if (act_p) pv_block(VS_(c - 1), pk, lane, A);
        if (act_c) {
            const float cc = selc - A.m;
            if (lm_c) lut_add(sc0, sc1, lut1, dbase, cc); else if (__any(cc != 0.f)) const_add(sc0, sc1, cc);
        }
        if (act_n) qk_block<KS0, NKS>(KS_(c + 1), qr, r32, hi, sn0, sn1);
        if (act_c) exp_pack(sc0, sc1, pk, A);
        WAIT_BAR4();
    }
    asm volatile("s_waitcnt vmcnt(0) lgkmcnt(0)\n\ts_barrier" ::: "memory");
#undef TCL
#undef DMA_K
#undef DMA_V
#undef KS_
#undef VS_
#undef WAIT_BAR4
#undef T_ACTIVE
#undef T_LUTMODE
}

__device__ __forceinline__ void build_lut(LAS unsigned char* lds, const float* rel_bias, int head, bool window, int tid) {
    LAS float* lut = (LAS float*)(lds + ATT_LUT);
    for (int i = tid; i < 704; i += 512) {
        const int d = i - 96; float v; const float c31 = rel_bias[31 * 16 + head];
        if (d < 0) v = NEGF;
        else if (d >= 512) v = window ? NEGF : 0.f;
        else { int bk;
            if (d < 16) bk = d; else if (d >= 128) bk = 31; else { bk = 16 + (int)(log2f((float)d * (1.0f / 16.0f)) * (16.0f / 3.0f)); bk = bk > 31 ? 31 : bk; }
            v = (rel_bias[bk * 16 + head] - c31) * LOG2E; }
        lut[i] = v;
    }
}
__device__ __forceinline__ void load_q(bf16x8 (&qr)[4], const u16* qrow, int hi) {
#pragma unroll
    for (int ks = 0; ks < 4; ++ks) qr[ks] = *(const bf16x8*)(qrow + ks * 16 + hi * 8);
}
__device__ __forceinline__ void store_o(u16* dst, const f32x16& v0, const f32x16& v1, int hi) {
#pragma unroll
    for (int g = 0; g < 4; ++g) {
        u32x2 a; a.x = pkbf(v0[4 * g], v0[4 * g + 1]); a.y = pkbf(v0[4 * g + 2], v0[4 * g + 3]); *(u32x2*)(dst + 8 * g + 4 * hi) = a;
        u32x2 b; b.x = pkbf(v1[4 * g], v1[4 * g + 1]); b.y = pkbf(v1[4 * g + 2], v1[4 * g + 3]); *(u32x2*)(dst + 32 + 8 * g + 4 * hi) = b;
    }
}

struct Ctx { LAS unsigned char* lds; int tid, lane, wave, r32, hi, G, bx; u16* proj; u16* obuf; u16* vt; };

__device__ __forceinline__ void moba_unit(const Ctx& C0, KParamsPtr P, int b, int h, int qb) {
    Ctx C = C0; C.lane = lane_opaque(); C.tid = C.wave * 64 + C.lane; C.r32 = C.lane & 31; C.hi = C.lane >> 5;
    const int q0w = __builtin_amdgcn_readfirstlane(qb * 256 + C.wave * 32); const int qpos = q0w + C.r32; const size_t tok = (size_t)b * SEQ + qpos;
    build_lut(C.lds, P->rel_bias, h, false, C.tid);
    const u16* qrow = C.proj + tok * PW + C_MQ + h * 64;
    bf16x8 qr[4]; load_q(qr, qrow, C.hi);
    unsigned mask = 0;
    if (qb > 0) {
        float g[7];
#pragma unroll
        for (int j = 0; j < 7; ++j) g[j] = 0.f;
        const float* km = (const float*)(P->ws + WS_KMEAN) + (size_t)((b * 4 + h) * 8) * 64;
#pragma unroll
        for (int dc = 0; dc < 8; ++dc) {
            const u32x4 qv = *(const u32x4*)(qrow + dc * 8);
            float qf[8]; qf[0] = bf2f(qv.x & 0xffffu); qf[1] = bf2f(qv.x >> 16); qf[2] = bf2f(qv.y & 0xffffu); qf[3] = bf2f(qv.y >> 16);
            qf[4] = bf2f(qv.z & 0xffffu); qf[5] = bf2f(qv.z >> 16); qf[6] = bf2f(qv.w & 0xffffu); qf[7] = bf2f(qv.w >> 16);
#pragma unroll
            for (int j = 0; j < 7; ++j) if (j < qb) { const float* kmj = km + j * 64 + dc * 8;
#pragma unroll
                for (int e = 0; e < 8; ++e) g[j] = fmaf(qf[e], kmj[e], g[j]); }
        }
#pragma unroll
        for (int j = 0; j < 7; ++j) if (j < qb) { int rank = 0;
#pragma unroll
            for (int i = 0; i < 7; ++i) if (i != j && i < qb) rank += (g[i] > g[j] || (g[i] == g[j] && i < j)) ? 1 : 0;
            if (rank < 3) mask |= 1u << j; }
    }
    AState A; astate_init(A);
    const float c31 = P->rel_bias[31 * 16 + h] * LOG2E;
    run_tiles<0, 4, false, 1>(C.lds, 0, 4 * qb + 3, C.proj + (size_t)b * SEQ * PW + C_MK + h * 64, C.proj + (size_t)b * SEQ * PW + C_MV + h * 64, qr, c31, q0w, mask, qb, A, C.wave, C.lane, C.r32, C.hi);
    const float inv = rcpf_(xhalf_sum(A.l));
    A.o0 *= inv; A.o1 *= inv;
    { const int l2 = lane_opaque(); const size_t tok2 = (size_t)b * SEQ + q0w + (l2 & 31);
      store_o(C.obuf + tok2 * DM + h * 64, A.o0, A.o1, l2 >> 5); }
}

__device__ __forceinline__ void diff_unit(const Ctx& C0, KParamsPtr P, int layer, int b, int h, int qb) {
    Ctx C = C0; C.lane = lane_opaque(); C.tid = C.wave * 64 + C.lane; C.r32 = C.lane & 31; C.hi = C.lane >> 5;
    const int q0w = __builtin_amdgcn_readfirstlane(qb * 256 + C.wave * 32); const int qpos = q0w + C.r32; const size_t tok = (size_t)b * SEQ + qpos;
    build_lut(C.lds, P->rel_bias, 4 + h, false, C.tid);
    bf16x8 qr[4]; load_q(qr, C.proj + tok * PW + C_DQ + h * 64, C.hi);
    AState A; astate_init(A);
    const float c31 = P->rel_bias[31 * 16 + 4 + h] * LOG2E;
    const u16* Kg = C.proj + (size_t)b * SEQ * PW + C_DK + h * 64; const u16* Vg = C.proj + (size_t)b * SEQ * PW + C_DV + h * 64;
    run_tiles<0, 2, false, 0>(C.lds, 0, 4 * qb + 3, Kg, Vg, qr, c31, q0w, 0u, 0, A, C.wave, C.lane, C.r32, C.hi);
    LAS float* park = (LAS float*)(C.lds + ATT_PARK) + C.tid;
    { const float i0 = rcpf_(xhalf_sum(A.l));
#pragma unroll
      for (int r = 0; r < 16; ++r) { park[r * 512] = A.o0[r] * i0; park[(16 + r) * 512] = A.o1[r] * i0; } }
    astate_init(A);
    run_tiles<2, 2, false, 0>(C.lds, 0, 4 * qb + 3, Kg, Vg, qr, c31, q0w, 0u, 0, A, C.wave, C.lane, C.r32, C.hi);
    const float* lp = P->diff_lambda + (size_t)layer * 128; float d01 = 0.f, d23 = 0.f;
    for (int i = 0; i < 32; ++i) { d01 = fmaf(lp[i], lp[32 + i], d01); d23 = fmaf(lp[64 + i], lp[96 + i], d23); }
    const float li = P->lam_init[layer]; const float lam = expf(d01) - expf(d23) + li;
    const float i1 = lam * rcpf_(xhalf_sum(A.l));
    float ss = 0.f;
#pragma unroll
    for (int r = 0; r < 16; ++r) { A.o0[r] = park[r * 512] - A.o0[r] * i1; A.o1[r] = park[(16 + r) * 512] - A.o1[r] * i1; ss += A.o0[r] * A.o0[r] + A.o1[r] * A.o1[r]; }
    ss = xhalf_sum(ss);
    const float rstd = (1.0f / sqrtf(ss * (1.0f / 64.0f) + 1e-6f)) * (1.0f - li);
    const float* sg = P->diff_subln + (size_t)layer * 64;
#pragma unroll
    for (int r = 0; r < 16; ++r) { const int d = crow(r, C.hi); A.o0[r] *= rstd * sg[d]; A.o1[r] *= rstd * sg[32 + d]; }
    { const int l2 = lane_opaque(); const size_t tok2 = (size_t)b * SEQ + q0w + (l2 & 31);
      store_o(C.obuf + tok2 * DM + 256 + h * 64, A.o0, A.o1, l2 >> 5); }
}

__device__ __forceinline__ void nsa_unit(const Ctx& C0, KParamsPtr P, int b, int hq, int qb) {
    Ctx C = C0; C.lane = lane_opaque(); C.tid = C.wave * 64 + C.lane; C.r32 = C.lane & 31; C.hi = C.lane >> 5;
    const int g = hq >> 2;
    const int q0w = __builtin_amdgcn_readfirstlane(qb * 256 + C.wave * 32); const int qpos = q0w + C.r32; const size_t tok = (size_t)b * SEQ + qpos;
    build_lut(C.lds, P->rel_bias, 8 + hq, false, C.tid);
    bf16x8 qr[4]; load_q(qr, C.proj + tok * PW + C_NQ + hq * 64, C.hi);
    const u16* gl = C.proj + tok * PW + C_NG + hq * 3;
    const float g1 = sigmoid_f(bf2f(gl[1])), g2 = sigmoid_f(bf2f(gl[2]));
    const unsigned mask = ((const unsigned*)(P->ws + WS_SEL))[(size_t)(b * 2 + g) * SEQ + qpos];
    const float c31 = P->rel_bias[31 * 16 + 8 + hq] * LOG2E;
    AState A; astate_init(A);
    run_tiles<0, 4, false, 2>(C.lds, 0, 4 * qb + 3, C.proj + (size_t)b * SEQ * PW + C_NKS + g * 64, C.proj + (size_t)b * SEQ * PW + C_NVS + g * 64, qr, c31, q0w, mask, qb, A, C.wave, C.lane, C.r32, C.hi);
    LAS float* park = (LAS float*)(C.lds + ATT_PARK) + C.tid;
    { const float f = g1 * rcpf_(xhalf_sum(A.l));
#pragma unroll
      for (int r = 0; r < 16; ++r) { park[r * 512] = A.o0[r] * f; park[(16 + r) * 512] = A.o1[r] * f; } }
    if (C.tid < 96) ((LAS float*)(C.lds + ATT_LUT))[608 + C.tid] = NEGF;
    astate_init(A);
    const int tw0 = 4 * qb - 8 < 0 ? 0 : 4 * qb - 8;
    run_tiles<0, 4, true, 0>(C.lds, tw0, 4 * qb + 3, C.proj + (size_t)b * SEQ * PW + C_NKW + g * 64, C.proj + (size_t)b * SEQ * PW + C_NVW + g * 64, qr, c31, q0w, 0u, qb, A, C.wave, C.lane, C.r32, C.hi);
    { const float f = g2 * rcpf_(xhalf_sum(A.l));
#pragma unroll
      for (int r = 0; r < 16; ++r) { A.o0[r] = A.o0[r] * f + park[r * 512]; A.o1[r] = A.o1[r] * f + park[(16 + r) * 512]; } }
    const int l2 = lane_opaque(); const int hi2 = l2 >> 5;
    u16* dst = C.obuf + ((size_t)b * SEQ + q0w + (l2 & 31)) * DM + 512 + hq * 64;
#pragma unroll
    for (int gg = 0; gg < 4; ++gg) {
        const u32x2 a = *(const u32x2*)(dst + 8 * gg + 4 * hi2), bq = *(const u32x2*)(dst + 32 + 8 * gg + 4 * hi2);
        A.o0[4 * gg] += bf2f(a.x & 0xffffu); A.o0[4 * gg + 1] += bf2f(a.x >> 16); A.o0[4 * gg + 2] += bf2f(a.y & 0xffffu); A.o0[4 * gg + 3] += bf2f(a.y >> 16);
        A.o1[4 * gg] += bf2f(bq.x & 0xffffu); A.o1[4 * gg + 1] += bf2f(bq.x >> 16); A.o1[4 * gg + 2] += bf2f(bq.y & 0xffffu); A.o1[4 * gg + 3] += bf2f(bq.y >> 16);
    }
    store_o(dst, A.o0, A.o1, hi2);
}

__device__ __forceinline__ void cmp_unit(const Ctx& C0, KParamsPtr P, int b, int g, int qblk) {
    Ctx C = C0; C.lane = lane_opaque(); C.tid = C.wave * 64 + C.lane; C.r32 = C.lane & 31; C.hi = C.lane >> 5;
    LAS unsigned char* lds = C.lds; const int tid = C.tid, r32 = C.r32, hi = C.hi;
    const u16* kc = (const u16*)(P->ws + WS_KCMP) + (size_t)(b * 2 + g) * 128 * 64;
    const u16* vc = (const u16*)(P->ws + WS_VCMPT) + (size_t)(b * 2 + g) * 64 * 128;
#pragma unroll
    for (int i = 0; i < 2; ++i) { const int e = tid + 512 * i;
        { const int row = e >> 3, ch = e & 7; *(LAS u32x4*)(lds + CMP_K + row * 144 + ch * 16) = *(const u32x4*)(kc + row * 64 + ch * 8); }
        { const int row = e >> 4, ch = e & 15; *(LAS u32x4*)(lds + CMP_V + row * 272 + ch * 16) = *(const u32x4*)(vc + row * 128 + ch * 8); } }
    const int q0w = __builtin_amdgcn_readfirstlane(qblk * 256 + C.wave * 32); const int qpos = q0w + r32; const size_t tok = (size_t)b * SEQ + qpos;
    const int nmax = (qpos - 31) >> 4;
    __syncthreads();
    float qa[16], qh[16];
#pragma unroll
    for (int i = 0; i < 16; ++i) { qa[i] = 0.f; qh[i] = 0.f; }
    const LAS unsigned char* kp = lds + CMP_K + r32 * 144 + hi * 16;
    const LAS unsigned char* vp = lds + CMP_V + r32 * 272 + hi * 16;
    bf16x8 qn[4]; load_q(qn, C.proj + tok * PW + C_NQ + g * 4 * 64, hi);
    for (int rh = 0; rh < 4; ++rh) {
        const int hq = g * 4 + rh;
        bf16x8 qr[4];
#pragma unroll
        for (int ks = 0; ks < 4; ++ks) qr[ks] = qn[ks];
        load_q(qn, C.proj + tok * PW + C_NQ + (g * 4 + (rh < 3 ? rh + 1 : rh)) * 64, hi);
        const float g0 = sigmoid_f(bf2f(C.proj[tok * PW + C_NG + hq * 3]));
        f32x16 s[4];
#pragma unroll
        for (int kb = 0; kb < 4; ++kb) {
#pragma unroll
            for (int r = 0; r < 16; ++r) s[kb][r] = 0.f;
#pragma unroll
            for (int ks = 0; ks < 4; ++ks) { const bf16x8 a = *(const LAS bf16x8*)(kp + kb * 32 * 144 + ks * 32); s[kb] = __builtin_amdgcn_mfma_f32_32x32x16_bf16(a, qr[ks], s[kb], 0, 0, 0); }
        }
        float mx = NEGF;
#pragma unroll
        for (int kb = 0; kb < 4; ++kb)
#pragma unroll
            for (int r = 0; r < 16; ++r) { const int n = 32 * kb + crow(r, hi); const float v = (n <= nmax) ? s[kb][r] : NEGF; s[kb][r] = v; mx = fmaxf(mx, v); }
        mx = xhalf_max(mx);
        float sum = 0.f;
#pragma unroll
        for (int kb = 0; kb < 4; ++kb)
#pragma unroll
            for (int r = 0; r < 16; ++r) { const int n = 32 * kb + crow(r, hi); const float pv = (n <= nmax) ? ex2(s[kb][r] - mx) : 0.f; s[kb][r] = pv; sum += pv; }
        sum = xhalf_sum(sum);
        const float inv = nmax >= 0 ? rcpf_(sum) : 0.f;
        f32x16 o0, o1;
#pragma unroll
        for (int r = 0; r < 16; ++r) { o0[r] = 0.f; o1[r] = 0.f; }
#pragma unroll
        for (int kb = 0; kb < 4; ++kb) {
#pragma unroll
            for (int r = 0; r < 16; ++r) s[kb][r] *= inv;
#pragma unroll
            for (int g4 = 0; g4 < 4; ++g4) { const float h = 0.5f * s[kb][4 * g4 + 3]; qh[kb * 4 + g4] += h; qa[kb * 4 + g4] += (s[kb][4 * g4] + s[kb][4 * g4 + 1]) + (s[kb][4 * g4 + 2] + h); }
#pragma unroll
            for (int c = 0; c < 2; ++c) {
                const u32x4 pk = (u32x4){pkbf(s[kb][8 * c], s[kb][8 * c + 1]), pkbf(s[kb][8 * c + 2], s[kb][8 * c + 3]), pkbf(s[kb][8 * c + 4], s[kb][8 * c + 5]), pkbf(s[kb][8 * c + 6], s[kb][8 * c + 7])};
                const bf16x8 pb = __builtin_bit_cast(bf16x8, pk);
                const bf16x8 v0 = *(const LAS bf16x8*)(vp + (kb * 2 + c) * 32);
                const bf16x8 v1 = *(const LAS bf16x8*)(vp + 32 * 272 + (kb * 2 + c) * 32);
                o0 = __builtin_amdgcn_mfma_f32_32x32x16_bf16(v0, pb, o0, 0, 0, 0);
                o1 = __builtin_amdgcn_mfma_f32_32x32x16_bf16(v1, pb, o1, 0, 0, 0);
            }
            __builtin_amdgcn_sched_barrier(0);
        }
        o0 *= g0; o1 *= g0;
        store_o(C.obuf + tok * DM + 512 + hq * 64, o0, o1, hi);
    }
    LAS float* Aq = (LAS float*)(lds + CMP_A) + (C.wave * 32 + r32) * 33; LAS float* Hq = (LAS float*)(lds + CMP_H) + (C.wave * 32 + r32) * 33;
#pragma unroll
    for (int kb = 0; kb < 4; ++kb)
#pragma unroll
        for (int g4 = 0; g4 < 4; ++g4) { const int j = 8 * kb + 2 * g4 + hi; Aq[j] = qa[kb * 4 + g4]; Hq[j] = qh[kb * 4 + g4]; }
    __syncthreads();
    const int cur = q0w >> 6;
    unsigned bits = 0;
    if (cur < 16) bits = (2u << cur) - 1u;
    else {
        float sc[32];
#pragma unroll
        for (int i = 0; i < 32; ++i) { const float imp = Aq[i] + (i > 0 ? Hq[i - 1] : 0.f); sc[i] = (i > cur) ? -3.0e38f : ((i == 0 || i > cur - 2) ? 1e4f : imp); }
#pragma unroll
        for (int e = 0; e < 16; ++e) {
            const float sj = hi ? sc[16 + e] : sc[e]; int rank = 0;
#pragma unroll
            for (int i = 0; i < 32; ++i) { const bool lt = (i < e) || (hi && i < 16 + e);
                rank += (sc[i] > sj || (sc[i] == sj && lt)) ? 1 : 0; }
            const int j = hi * 16 + e;
            if (j <= cur && rank < 16) bits |= 1u << j; }
        { auto rr = __builtin_amdgcn_permlane32_swap(bits, bits, false, false); bits = rr[0] | rr[1]; }
    }
    if (hi == 0) ((unsigned*)(P->ws + WS_SEL))[(size_t)(b * 2 + g) * SEQ + qpos] = bits;
    __syncthreads();
}

__device__ __forceinline__ void prep_vk(const Ctx& C, KParamsPtr P, int b0) {
    const int G = C.G - b0, bxr = C.bx - b0, tid = C.tid, lane = C.lane;
    if (bxr < 0) return;
    const int gw = bxr * 8 + C.wave, NGW = G * 8;
    for (int it = gw; it < NB * 4 * 8; it += NGW) {
        const int blk = it & 7, h = (it >> 3) & 3, b = it >> 5;
        const u16* kp = C.proj + ((size_t)b * SEQ + blk * 256) * PW + C_MK + h * 64 + lane; float s = 0.f;
        for (int k = 0; k < 256; k += 8) { float t[8];
#pragma unroll
            for (int e = 0; e < 8; ++e) t[e] = bf2f(kp[(size_t)(k + e) * PW]);
            s += ((t[0] + t[1]) + (t[2] + t[3])) + ((t[4] + t[5]) + (t[6] + t[7])); }
        ((float*)(P->ws + WS_KMEAN))[(size_t)it * 64 + lane] = s * (1.0f / 256.0f);
    }
}
__device__ __forceinline__ void prep_a(const Ctx& C, KParamsPtr P, int layer) {
    const int G = C.G, lane = C.lane;
    const int gw = C.bx * 8 + C.wave, NGW = G * 8;
    u16* acmp = (u16*)(P->ws + WS_VT);
    for (int it = gw; it < 2 * 4096; it += NGW) {
        const int i = it >> 12, row = it & 4095, n = row & 127, bg = row >> 7, b = bg >> 1, g = bg & 1;
        u16* dst = acmp + (size_t)it * 2048; const float* pe = P->cmp_pe + (size_t)(layer * 2 + i) * 2048;
        const int col = (i == 0 ? C_NKC : C_NVC) + g * 64;
#pragma unroll
        for (int pass = 0; pass < 4; ++pass) { const int l = pass * 8 + (lane >> 3), d0 = (lane & 7) * 8;
            unsigned z0 = 0u; asm volatile("" : "+v"(z0)); u32x4 o = (u32x4){z0, z0, z0, z0};
            if (n < 127) { const u32x4 v = *(const u32x4*)(C.proj + ((size_t)b * SEQ + 16 * n + l) * PW + col + d0); const f32x4 e0 = *(const f32x4*)(pe + l * 64 + d0), e1 = *(const f32x4*)(pe + l * 64 + d0 + 4);
                o.x = pkbf(bf2f(v.x & 0xffffu) + e0.x, bf2f(v.x >> 16) + e0.y); o.y = pkbf(bf2f(v.y & 0xffffu) + e0.z, bf2f(v.y >> 16) + e0.w);
                o.z = pkbf(bf2f(v.z & 0xffffu) + e1.x, bf2f(v.z >> 16) + e1.y); o.w = pkbf(bf2f(v.w & 0xffffu) + e1.z, bf2f(v.w >> 16) + e1.w); }
            *(u32x4*)(dst + l * 64 + d0) = o; }
    }
}
__device__ __forceinline__ void prep_c(const Ctx& C, KParamsPtr P, int layer, int it0) {
    const int i = it0 >> 12, row0 = it0 & 4095, lane = lane_opaque(), tid = C.wave * 64 + lane, r32 = lane & 31, hi = lane >> 5;
    const float* w2 = P->cmp_w2 + (size_t)(layer * 2 + i) * 256 * 64;
    for (int e = tid; e < 256 * 64; e += 512) { const int k = e >> 6, c = e & 63; *(LAS u16*)(C.lds + c * 528 + k * 2) = (u16)(pkbf(w2[e], 0.f) & 0xffffu); }
    __syncthreads();
    const int wrow = row0 + C.wave * 32;
    const u16* hrow = (const u16*)(P->ws + WS_HID) + ((size_t)i * 4096 + wrow + r32) * 256 + hi * 8;
    f32x16 d0, d1;
#pragma unroll
    for (int r = 0; r < 16; ++r) { d0[r] = 0.f; d1[r] = 0.f; }
#pragma unroll 4
    for (int ks = 0; ks < 16; ++ks) {
        const bf16x8 a = *(const bf16x8*)(hrow + ks * 16);
        const bf16x8 b0 = *(const LAS bf16x8*)(C.lds + r32 * 528 + (ks * 16 + hi * 8) * 2);
        const bf16x8 b1 = *(const LAS bf16x8*)(C.lds + (32 + r32) * 528 + (ks * 16 + hi * 8) * 2);
        d0 = __builtin_amdgcn_mfma_f32_32x32x16_bf16(a, b0, d0, 0, 0, 0);
        d1 = __builtin_amdgcn_mfma_f32_32x32x16_bf16(a, b1, d1, 0, 0, 0);
    }
#pragma unroll
    for (int r = 0; r < 16; ++r) { const int row = wrow + crow(r, hi);
        const unsigned v0 = pkbf(d0[r], 0.f) & 0xffffu, v1 = pkbf(d1[r], 0.f) & 0xffffu;
        if (i == 0) { u16* o = (u16*)(P->ws + WS_KCMP) + (size_t)row * 64; o[r32] = (u16)v0; o[32 + r32] = (u16)v1; }
        else { const int bg = row >> 7, n = row & 127; u16* o = (u16*)(P->ws + WS_VCMPT) + (size_t)bg * 64 * 128 + (n & ~15) + pperm(n & 15); o[(size_t)r32 * 128] = (u16)v0; o[(size_t)(32 + r32) * 128] = (u16)v1; }
    }
}

__device__ __forceinline__ void convert_weights(const Ctx& C, KParamsPtr P, int layer) {
    LAS float* scr = (LAS float*)(C.lds + C.wave * 16384);
    const int gw = C.bx * 8 + C.wave, NGW = C.G * 8, lane = C.lane;
    constexpr int I_G = 16 * 88, I_D = 44 * 32, I_IN = 16 * 96, I_O = 16 * 32, I_W1 = 32 * 8;
    constexpr int NIT = 4 * I_G + 2 * I_D + I_IN + I_O + 2 * I_W1;
    unsigned char* ws = P->ws;
    for (int it = gw; it < NIT; it += NGW) {
        int r = it;
        if (r < 4 * I_G) { const int which = r / I_G; r -= which * I_G; const int kb = r / 88, nb = r % 88, n0 = nb * 32;
            const float* W = (which == 0 ? P->ffn1_gate : which == 1 ? P->ffn1_up : which == 2 ? P->ffn2_gate : P->ffn2_up) + (size_t)layer * DM * DFF;
            u16* WT = (u16*)(ws + (which < 2 ? WS_GU1 : WS_GU2));
            tr_item(W, DM, DFF, WT, kb, n0, (n0 >> 7) * 256 + (which & 1) * 128 + (n0 & 127), scr, lane, 1.0f, (which < 2 ? P->norm_ffn1 : P->norm_ffn2) + (size_t)layer * DM); continue; }
        r -= 4 * I_G;
        if (r < 2 * I_D) { const int which = r / I_D; r -= which * I_D; const int kb = r / 32, nb = r % 32;
            const float* W = (which == 0 ? P->ffn1_down : P->ffn2_down) + (size_t)layer * DFF * DM;
            tr_item(W, DFF, DM, (u16*)(ws + (which == 0 ? WS_DN1 : WS_DN2)), kb, nb * 32, nb * 32, scr, lane); continue; }
        r -= 2 * I_D;
        if (r < I_IN) { const int kb = r / 96, nb = r % 96, n0 = nb * 32;
            const float cs = (n0 < C_MK || (n0 >= C_NQ && n0 < C_NKC)) ? 0.125f * LOG2E : (n0 >= C_DQ && n0 < C_DK) ? 0.17677669529663687f * LOG2E : 1.0f;
            tr_item(P->w_in + (size_t)layer * DM * INW, DM, INW, (u16*)(ws + WS_WIN), kb, n0, n0, scr, lane, cs, P->norm_mix + (size_t)layer * DM); continue; }
        r -= I_IN;
        if (r < I_O) { const int kb = r / 32, nb = r % 32; tr_item(P->w_out + (size_t)layer * DM * DM, DM, DM, (u16*)(ws + WS_WOUT), kb, nb * 32, nb * 32, scr, lane); continue; }
        r -= I_O;
        { const int i = r / I_W1; r -= i * I_W1; const int kb = r / 8, nb = r % 8;
            tr_item(P->cmp_w1 + (size_t)(layer * 2 + i) * 2048 * 256, 2048, 256, (u16*)(ws + WS_W1) + (size_t)i * 256 * 2048, kb, nb * 32, nb * 32, scr, lane); }
    }
}
__device__ __forceinline__ void norm_phase(const Ctx& C, const float* src32, const u16* src16, const float* g, u16* dst16, float* dst32, u16* xb0) {
    const int gw = C.bx * 8 + C.wave, NGW = C.G * 8;
    for (int m = gw; m < MTOK; m += NGW) norm_row(src32 ? src32 + (size_t)m * DM : nullptr, src16 ? src16 + (size_t)m * DM : nullptr, g, dst16 ? dst16 + (size_t)m * DM : nullptr, dst32 ? dst32 + (size_t)m * DM : nullptr, xb0 ? xb0 + (size_t)m * DM : nullptr, C.lane);
}

#define XB_TMO      128
#define XB_XCNT(j)  (256  + 64 * (j))
#define XB_XSUB(j)  (1280 + 64 * (j))
#define XB_XGEN(j)  (2304 + 64 * (j))
#define XB_TOP      3328
#define XB_TOPGEN   3392
#define XCD_BAR_WORDS 3456
#define XB_SPIN_CAP (1u << 18)

__device__ __forceinline__ unsigned xb_ld(unsigned* p)              { return __hip_atomic_load(p, __ATOMIC_RELAXED, __HIP_MEMORY_SCOPE_AGENT); }
__device__ __forceinline__ unsigned xb_add(unsigned* p, unsigned v) { return __hip_atomic_fetch_add(p, v, __ATOMIC_RELAXED, __HIP_MEMORY_SCOPE_AGENT); }
__device__ __forceinline__ unsigned xb_xcc_id() { return (unsigned)__builtin_amdgcn_s_getreg((3 << 11) | 20) & 0xFu; }
#define XB_SPIN(cond, bar) do { unsigned _sp = 0; while (cond) { __builtin_amdgcn_s_sleep(1); \
    if ((++_sp & 255u) == 0u) { if (xb_ld(&(bar)[XB_TMO])) break; if (_sp > XB_SPIN_CAP) { atomicAdd(&(bar)[XB_TMO], 1u); break; } } } } while (0)

struct XcdBarrier {
    unsigned* bar; unsigned x;
    volatile LAS unsigned* st;
};

__device__ __forceinline__ XcdBarrier xcd_barrier_post(unsigned* bar, volatile LAS unsigned* st) {
    XcdBarrier b; b.bar = bar; b.x = xb_xcc_id(); b.st = st;
    if (threadIdx.x == 0) (void)xb_add(&bar[XB_XCNT(b.x)], 1u);
    return b;
}
__device__ __forceinline__ void xcd_barrier_complete(unsigned* bar, unsigned x, unsigned& nloc, unsigned& nx) {
    const unsigned G = gridDim.x * gridDim.y * gridDim.z;
    unsigned sum, cnt, mine, sp = 0u;
    for (;;) {
        sum = 0u; cnt = 0u; mine = 0u;
#pragma unroll
        for (unsigned j = 0; j < 16; ++j) { const unsigned c = xb_ld(&bar[XB_XCNT(j)]); sum += c; cnt += (c > 0u) ? 1u : 0u; mine = (j == x) ? c : mine; }
        if (sum == G) break;
        __builtin_amdgcn_s_sleep(1);
        if ((++sp & 255u) == 0u) { if (xb_ld(&bar[XB_TMO])) break; if (sp > XB_SPIN_CAP) { atomicAdd(&bar[XB_TMO], 1u); break; } }
    }
    nloc = mine > 0u ? mine : 1u; nx = cnt > 0u ? cnt : 1u;
}

__device__ __forceinline__ void xcd_barrier(const XcdBarrier& b) {
    asm volatile("s_waitcnt vmcnt(0)" ::: "memory");
    __syncthreads();
    if (threadIdx.x == 0) {
        unsigned* bar = b.bar;
        __builtin_amdgcn_s_waitcnt(0);
        unsigned nloc = b.st[0], nx = b.st[1];
        if (nloc == 0u) { xcd_barrier_complete(bar, b.x, nloc, nx); b.st[0] = nloc; b.st[1] = nx; }
        const unsigned old = xb_add(&bar[XB_XSUB(b.x)], 1u);
        const unsigned gen = old / nloc;
        if (old + 1u == (gen + 1u) * nloc) {
            __builtin_amdgcn_fence(__ATOMIC_RELEASE, "agent");
            asm volatile("s_waitcnt vmcnt(0)" ::: "memory");
            const unsigned og = xb_add(&bar[XB_TOP], 1u);
            const unsigned tg = og / nx;
            if (og + 1u == (tg + 1u) * nx) xb_add(&bar[XB_TOPGEN], 1u);
            else XB_SPIN(xb_ld(&bar[XB_TOPGEN]) == tg, bar);
            __builtin_amdgcn_fence(__ATOMIC_ACQUIRE, "agent");
            xb_add(&bar[XB_XGEN(b.x)], 1u);
            asm volatile("s_waitcnt vmcnt(0)" ::: "memory");
        } else {
            XB_SPIN(xb_ld(&bar[XB_XGEN(b.x)]) == gen, bar);
            __builtin_amdgcn_fence(__ATOMIC_ACQUIRE, "agent");
            asm volatile("s_waitcnt vmcnt(0)" ::: "memory");
        }
    }
    __syncthreads();
}


__device__ __forceinline__ void fill_rtab(const Ctx& C, const pg8::StaticOrder& S, const float* SS, LAS float* rtab) {
    LAS int* pml = (LAS int*)(rtab + 11 * 256);
    int nu = 0; { pg8::Unit u_; for (int i_ = 0; i_ < 11 && S.next(i_, u_); ++i_) { if (C.tid == 0) pml[i_] = u_.pm; nu = i_ + 1; } }
    __syncthreads();
    const int tot = nu * 256; float rsv[6];
#pragma unroll
    for (int k = 0; k < 6; ++k) { const int e = C.tid + 512 * k; rsv[k] = e < tot ? pg8::row_rstd(SS, pml[e >> 8] * 256 + (e & 255)) : 0.f; }
#pragma unroll
    for (int k = 0; k < 6; ++k) { const int e = C.tid + 512 * k; if (e < tot) rtab[e] = rsv[k]; }
    __syncthreads();
}
__device__ __forceinline__ void x0_phase(const Ctx& C, const float* src, u16* xb, float* ss) {
    const int gw = C.bx * 8 + C.wave, NGW = C.G * 8, lane = C.lane;
    for (int m = gw; m < MTOK; m += NGW) {
        const f32x4* xr = (const f32x4*)(src + (size_t)m * DM) + lane; float s = 0.f;
#pragma unroll
        for (int j = 0; j < 4; ++j) { const f32x4 v = xr[64 * j]; s += (v.x * v.x + v.y * v.y) + (v.z * v.z + v.w * v.w);
            u32x2 o; o.x = pkbf(v.x, v.y); o.y = pkbf(v.z, v.w); *((u32x2*)(xb + (size_t)m * DM) + lane + 64 * j) = o; }
        s = wave_sum(s, lane);
        if (lane < 16) ss[(size_t)m * 16 + lane] = lane == 0 ? s : 0.f;
    }
}
__device__ __forceinline__ void unit_publish(unsigned* flag, int tid) {
    asm volatile("s_waitcnt vmcnt(0)" ::: "memory"); __syncthreads();
    if (tid == 0) { __builtin_amdgcn_fence(__ATOMIC_RELEASE, "agent"); asm volatile("s_waitcnt vmcnt(0)" ::: "memory"); __hip_atomic_store(flag, 1u, __ATOMIC_RELAXED, __HIP_MEMORY_SCOPE_AGENT); }
}
__device__ __forceinline__ void unit_wait(unsigned* f0, unsigned* f1, int tid) {
    if (tid == 0) { unsigned sp = 0;
        while ((__hip_atomic_load(f0, __ATOMIC_RELAXED, __HIP_MEMORY_SCOPE_AGENT) == 0u || __hip_atomic_load(f1, __ATOMIC_RELAXED, __HIP_MEMORY_SCOPE_AGENT) == 0u) && ++sp < (1u << 24)) __builtin_amdgcn_s_sleep(8);
        __builtin_amdgcn_fence(__ATOMIC_ACQUIRE, "agent"); asm volatile("s_waitcnt vmcnt(0)" ::: "memory"); }
    __syncthreads();
}
struct OneUnit { int pm;
    __device__ __forceinline__ bool next(int i, pg8::Unit& u) const { if (i) return false; u.pm = pm; u.pn = 0; return true; }
    __device__ __forceinline__ void a_ready(const pg8::Unit&) const {}
    __device__ __forceinline__ void done(const pg8::Unit&) const {} };
__global__ void __launch_bounds__(512, 2) hybrid_fwd(Params P0) {
    extern __shared__ __attribute__((aligned(16))) unsigned char lds_raw[];
    const KParamsPtr kp0 = (KParamsPtr)__builtin_amdgcn_kernarg_segment_ptr();
    cg::grid_group grid = cg::this_grid();
    { volatile LAS unsigned* misc = (volatile LAS unsigned*)((LAS unsigned char*)lds_raw + MISC_OFF); if (threadIdx.x < 2) misc[threadIdx.x] = 0u; }
    __syncthreads();
    XcdBarrier bar = xcd_barrier_post((unsigned*)(P0.ws + WS_CTL) + 1024, (volatile LAS unsigned*)((LAS unsigned char*)lds_raw + MISC_OFF));
    const int ph_lo = P0.ph_lo, ph_hi = P0.ph_hi; const int wave_s = __builtin_amdgcn_readfirstlane(threadIdx.x >> 6);
    bool redone = false; (void)redone;
    for (int ph = ph_lo; ph < ph_hi; ++ph) {
        KParamsPtr kpl = kp0; asm volatile("" : "+s"(kpl));
        const KParamsPtr P = kpl; unsigned char* ws = P->ws;
        u16* XN = (u16*)(ws + WS_XN); u16* HB = (u16*)(ws + WS_PROJ);
        int G = gridDim.x, bx = blockIdx.x; asm volatile("" : "+s"(G), "+s"(bx));
        Ctx C; C.G = G; C.bx = bx; C.lds = (LAS unsigned char*)lds_raw; C.wave = wave_s; C.lane = lane_opaque(); C.tid = wave_s * 64 + C.lane; C.r32 = C.lane & 31; C.hi = C.lane >> 5;
        C.proj = (u16*)(ws + WS_PROJ); C.obuf = (u16*)(ws + WS_XN); C.vt = (u16*)(ws + WS_VT);
        const int layer = ph / NPH_L, s = ph % NPH_L;
        if (ph != NPH - 1 && (s == 7 || s == 3 || s == 11 || s == 8 || s == 9)) continue;
        float* SS = (float*)(ws + WS_SS);
        u16* XB = (u16*)(ws + WS_XB);
        if (ph == NPH - 1) { norm_phase(C, nullptr, XB, P->final_norm, nullptr, P->out, nullptr); }
        else switch (s) {
        case 0: { convert_weights(C, P, layer); if (layer == 0) { __syncthreads(); x0_phase(C, P->x, XB, SS); } } break;
#ifndef NO_GEMM
#ifndef NO_G1
        case 1: case 12: {
            pg8::Gemm g{XB, (const u16*)(ws + (s == 1 ? WS_GU1 : WS_GU2)), MTOK, 2 * DFF, DM}; pg8::StaticOrder S; S.init(MTOK, 2 * DFF, G, bx);
            LAS float* rtab = (LAS float*)(C.lds + RTAB_OFF); fill_rtab(C, S, SS, rtab);
            pg8::EpiSwiGLU E{HB, DFF, rtab, 0};
            pg8::gemm_phase<pg8::EpiSwiGLU, pg8::StaticOrder, true, true>(C.lds, g, S, E, C.wave); } break;
#endif
#ifndef NO_G2
        case 2: case 13: case 10: {
            const u16* A = (s == 10) ? (const u16*)XN : (const u16*)HB; const u16* Bt = (const u16*)(ws + (s == 2 ? WS_DN1 : s == 13 ? WS_DN2 : WS_WOUT));
            pg8::Gemm g{A, Bt, MTOK, DM, s == 10 ? DM : DFF}; pg8::StaticOrder S; S.init(MTOK, DM, G, bx);
            pg8::EpiResid E{XB, DM, s == 10 ? 1.0f : 0.5f, SS};
            pg8::gemm_phase<pg8::EpiResid, pg8::StaticOrder, false, true>(C.lds, g, S, E, C.wave); } break;
#endif
#ifndef NO_G4
        case 4: {
            pg8::Gemm g{XB, (const u16*)(ws + WS_WIN), MTOK, PW, DM}; pg8::StaticOrder S; S.init(MTOK, PW, G, bx);
            LAS float* rtab = (LAS float*)(C.lds + RTAB_OFF); fill_rtab(C, S, SS, rtab);
            pg8::EpiBf16<0> E{C.proj, PW, rtab, 0};
            pg8::gemm_phase<pg8::EpiBf16<0>, pg8::StaticOrder, true, true>(C.lds, g, S, E, C.wave); } break;
#endif
#endif
#ifndef NO_PREP
        case 5: prep_a(C, P, layer); prep_vk(C, P, 0); break;
#endif
#if !defined(NO_GEMM) && !defined(NO_G6)
        case 6: {
            unsigned* ctl = (unsigned*)(ws + WS_CTL); unsigned* qctr = ctl + 8192 + 64 * ph + (redone ? 32 : 0); unsigned* fcomp = ctl + 16384 + 64 * ph; unsigned* fcmp = ctl + 24576 + 256 * (ph / NPH_L);
            volatile LAS unsigned* qslot = (volatile LAS unsigned*)(C.lds + MISC_OFF + 16);
            for (;;) {
                if (C.tid == 0) *qslot = __hip_atomic_fetch_add(qctr, 1u, __ATOMIC_RELAXED, __HIP_MEMORY_SCOPE_AGENT);
                __syncthreads();
                const unsigned u = *qslot;
                __syncthreads();
                if (u >= 32u + 512u + 256u + 1024u + 512u) break;
                if (u < 32u) { const int i = (int)u >> 4, tile = (int)u & 15;
                    pg8::Gemm g{(const u16*)(ws + WS_VT) + (size_t)i * 4096 * 2048, (const u16*)(ws + WS_W1) + (size_t)i * 256 * 2048, 4096, 256, 2048}; OneUnit S{tile};
                    pg8::EpiBf16<1> E{(u16*)(ws + WS_HID) + (size_t)i * 4096 * 256, 256, nullptr, 0};
                    pg8::gemm_phase<pg8::EpiBf16<1>, OneUnit, true, true>(C.lds, g, S, E, C.wave);
                    __builtin_amdgcn_fence(__ATOMIC_RELEASE, "agent"); __syncthreads(); __builtin_amdgcn_fence(__ATOMIC_ACQUIRE, "agent");
                    prep_c(C, P, layer, i * 4096 + tile * 256);
                    unit_publish(fcomp + u, C.tid);
                    __syncthreads();
                } else if (u < 544u || u >= 1824u) { const unsigned v = u < 544u ? u - 32u : u - 1824u + 512u; const int qb = 7 - (int)(v >> 7), w = (int)(v & 127);
                    if (w < 64) {
#ifndef NO_DIFF
                        diff_unit(C, P, layer, w >> 2, w & 3, qb);
#endif
                    } else {
#ifndef NO_MOBA
                        moba_unit(C, P, (w - 64) >> 2, w & 3, qb);
#endif
                    }
                } else if (u < 800u) { const int c = (int)u - 544, qblk = 7 - (c >> 5), bg = c & 31;
                    unit_wait(fcomp + (bg >> 1), fcomp + 16 + (bg >> 1), C.tid);
#ifndef NO_CMP
                    cmp_unit(C, P, bg >> 1, bg & 1, qblk);
#endif
                    unit_publish(fcmp + bg * 8 + qblk, C.tid);
                    __syncthreads();
                } else { const int v = (int)u - 800, qb = 7 - (v >> 7), b = (v & 127) >> 3, hq = v & 7; unsigned* f = fcmp + (b * 2 + (hq >> 2)) * 8 + qb;
                    unit_wait(f, f, C.tid);
#ifndef NO_ATT2
                    nsa_unit(C, P, b, hq, qb);
#endif
                }
            } } break;
#endif
        default: break;
        }
        if (ph + 1 < ph_hi) { if (ph == ph_lo) grid.sync(); else xcd_barrier(bar); }
#ifdef PROBE_LO
        if (ph != NPH - 1 && s == PROBE_HI) { if (!redone) { ph -= (PROBE_HI - PROBE_LO + 1); redone = true; } else redone = false; }
#endif
#ifdef PROBE_SYNC
        if (ph + 1 < ph_hi) xcd_barrier(bar);
#endif
    }
}

#ifndef COOP
#define COOP 1
#endif
extern "C" void kernel_launch(void* const* d_in, const int* in_sizes, int n_in, void* d_out, int out_size, void* d_ws, size_t ws_size, hipStream_t stream) {
    static int grid = 0;
    if (grid == 0) {
        if (n_in != 19 || out_size != MTOK * DM || ws_size < WS_END) { fprintf(stderr, "kernel_launch: unexpected shapes (n_in %d out %d ws %zu)\n", n_in, out_size, ws_size); grid = -1; return; }
        int dev = 0, cus = 0, per_cu = 0;
        (void)hipGetDevice(&dev); (void)hipDeviceGetAttribute(&cus, hipDeviceAttributeMultiprocessorCount, dev);
        if (hipFuncSetAttribute((const void*)hybrid_fwd, hipFuncAttributeMaxDynamicSharedMemorySize, LDS_BYTES) != hipSuccess) { fprintf(stderr, "kernel_launch: hipFuncSetAttribute failed\n"); grid = -1; return; }
        if (hipOccupancyMaxActiveBlocksPerMultiprocessor(&per_cu, (const void*)hybrid_fwd, 512, LDS_BYTES) != hipSuccess || per_cu < 1) { fprintf(stderr, "kernel_launch: occupancy query says %d\n", per_cu); per_cu = 1; }
        (void)hipGetLastError();
        grid = cus * per_cu;
    }
    if (grid < 0) return;
    Params p{};
    p.x = (const float*)d_in[0]; p.rel_bias = (const float*)d_in[1]; p.norm_ffn1 = (const float*)d_in[2]; p.ffn1_gate = (const float*)d_in[3]; p.ffn1_up = (const float*)d_in[4]; p.ffn1_down = (const float*)d_in[5];
    p.norm_mix = (const float*)d_in[6]; p.w_in = (const float*)d_in[7]; p.diff_lambda = (const float*)d_in[8]; p.diff_subln = (const float*)d_in[9]; p.cmp_pe = (const float*)d_in[10]; p.cmp_w1 = (const float*)d_in[11];
    p.cmp_w2 = (const float*)d_in[12]; p.w_out = (const float*)d_in[13]; p.norm_ffn2 = (const float*)d_in[14]; p.ffn2_gate = (const float*)d_in[15]; p.ffn2_up = (const float*)d_in[16]; p.ffn2_down = (const float*)d_in[17];
    p.final_norm = (const float*)d_in[18]; p.out = (float*)d_out; p.ws = (unsigned char*)d_ws;
    for (int l = 0; l < 4; ++l) p.lam_init[l] = (float)(0.8 - 0.6 * exp(-0.3 * (double)l));
#if COOP
    if (hipMemsetAsync((char*)d_ws + WS_CTL, 0, CTL_ZERO_BYTES, stream) != hipSuccess) { fprintf(stderr, "kernel_launch: memset of barrier words failed\n"); return; }
    p.ph_lo = 0; p.ph_hi = NPH;
    void* args[] = {&p};
    hipError_t e = hipLaunchCooperativeKernel((const void*)hybrid_fwd, dim3(grid), dim3(512), args, LDS_BYTES, stream);
    if (e != hipSuccess) fprintf(stderr, "cooperative launch failed: %s (grid %d)\n", hipGetErrorString(e), grid);
#else
    for (int ph = 0; ph < NPH; ++ph) { p.ph_lo = ph; p.ph_hi = ph + 1; hipLaunchKernelGGL(hybrid_fwd, dim3(grid), dim3(512), LDS_BYTES, stream, p); }
#endif
}
```

```cpp
#include <hip/hip_runtime.h>
#include <hip/hip_cooperative_groups.h>
#include <cstdio>
#include <cstdint>
#include <cmath>
namespace cg = cooperative_groups;
#define COOP 1
namespace pg8 {
#define PG8_LAS __attribute__((address_space(3)))
typedef unsigned short bf16_t;
typedef short bf16x8 __attribute__((ext_vector_type(8)));
typedef float f32x4 __attribute__((ext_vector_type(4)));
typedef unsigned u32x4 __attribute__((ext_vector_type(4)));
constexpr int BM = 256, BK = 64, HALF = 128, HTB = HALF * BK * 2  , STAGE_BYTES = 8 * HTB, NXCD = 8, WGM = 8;

__host__ __device__ __forceinline__ int lds_byte(int r, int c) { const int st = (r >> 4) * 2 + (c >> 5), rr = r & 15, cc = c & 31, ob = rr * 64 + cc * 2; return st * 1024 + (ob ^ (((ob >> 9) & 1) << 5)); }
__host__ __device__ __forceinline__ void stage_rc(int b, int& R, int& C) { const int st = b / 1024, sb = b % 1024, swz = sb ^ (((sb >> 9) & 1) << 5); R = (st >> 1) * 16 + swz / 64; C = (st & 1) * 32 + (swz % 64) / 2; }
__host__ __device__ __forceinline__ int perm32(int rho) { const int n = rho >> 4, i = rho & 15; return 8 * (i >> 2) + 4 * n + (i & 3); }

struct Unit { int pm, pn; };
struct Gemm { const bf16_t* A; const bf16_t* Bt; int M, N, K; };

struct StaticOrder {
    int nM, nN, nwg, G, c;
    __host__ __device__ void init(int M, int N, int G_, int c_) { nM = M / BM; nN = N / BM; nwg = nM * nN; G = G_; c = c_; }
    __host__ __device__ bool next(int i, Unit& u) const {
        const long L = (long)i * G + c; if (L >= nwg) return false;
        int wgid = (int)L; { const int q = nwg / NXCD, r = nwg % NXCD, xcd = wgid % NXCD, off = wgid / NXCD; wgid = (xcd < r ? xcd * (q + 1) : r * (q + 1) + (xcd - r) * q) + off; }
        const int nig = WGM * nN, gid = wgid / nig, fm = gid * WGM, gsz = (nM - fm) < WGM ? (nM - fm) : WGM;
        u.pm = fm + ((wgid % nig) % gsz); u.pn = (wgid % nig) / gsz; return true;
    }
    __device__ __forceinline__ void a_ready(const Unit&) const {}
    __device__ __forceinline__ void done(const Unit&) const {}
};

__device__ __forceinline__ unsigned cvt_pk_bf16(float lo, float hi) { unsigned r; asm volatile("v_cvt_pk_bf16_f32 %0, %1, %2" : "=v"(r) : "v"(lo), "v"(hi)); return r; }

__device__ __forceinline__ float ex2(float x) { return __builtin_amdgcn_exp2f(x); }
__device__ __forceinline__ float rcpf_(float x) { return __builtin_amdgcn_rcpf(x); }
__device__ __forceinline__ float silu_f(float x) { return x * rcpf_(1.0f + ex2(-1.4426950408889634f * x)); }
__device__ __forceinline__ float gelu_tanh_f(float x) { const float y2 = 2.0f * 0.7978845608028654f * (x + 0.044715f * x * x * x); return x * (1.0f - rcpf_(1.0f + ex2(1.4426950408889634f * y2))); }

__device__ __forceinline__ float row_rstd(const float* ss, int row) {
    const f32x4* p = (const f32x4*)(ss + (size_t)row * 16); const f32x4 a = p[0], b = p[1], c = p[2], d = p[3];
    const float s = ((a[0] + a[1]) + (a[2] + a[3])) + ((b[0] + b[1]) + (b[2] + b[3])) + ((c[0] + c[1]) + (c[2] + c[3])) + ((d[0] + d[1]) + (d[2] + d[3]));
    return 1.0f / sqrtf(s * (1.0f / 1024.0f) + 1e-6f);
}

struct EpiSwiGLU {
    static constexpr bool PERM = true, AFTER_DRAIN = false;
    bf16_t* O; int ldc; const PG8_LAS float* rtab; mutable int ui;
    __device__ __forceinline__ void operator()(const f32x4 (&acc)[2][2][4][2], const Unit& u, int wr, int wc, int fr, int fq) const {
        const int row0 = u.pm * BM + wr * 64 + fr; const int col0 = u.pn * HALF + wc * 32 + 8 * fq;
#pragma unroll
        for (int ai = 0; ai < 2; ++ai)
#pragma unroll
            for (int m = 0; m < 4; ++m) { bf16_t* rowp = O + (size_t)(row0 + ai * HALF + m * 16) * ldc + col0;
                const float rs = rtab[ui * 256 + wr * 64 + fr + ai * HALF + m * 16];
                const f32x4 g0 = acc[ai][0][m][0] * rs, g1 = acc[ai][0][m][1] * rs, u0 = acc[ai][1][m][0] * rs, u1 = acc[ai][1][m][1] * rs;
                u32x4 w; w.x = cvt_pk_bf16(silu_f(g0[0]) * u0[0], silu_f(g0[1]) * u0[1]); w.y = cvt_pk_bf16(silu_f(g0[2]) * u0[2], silu_f(g0[3]) * u0[3]);
                w.z = cvt_pk_bf16(silu_f(g1[0]) * u1[0], silu_f(g1[1]) * u1[1]); w.w = cvt_pk_bf16(silu_f(g1[2]) * u1[2], silu_f(g1[3]) * u1[3]);
                *(u32x4*)rowp = w; asm volatile("" ::: "memory"); }
        ++ui;
    }
};
template <int ACT> struct EpiBf16 {
    static constexpr bool PERM = true, AFTER_DRAIN = false;
    bf16_t* O; int ldc; const PG8_LAS float* rtab; mutable int ui;
    __device__ __forceinline__ void operator()(const f32x4 (&acc)[2][2][4][2], const Unit& u, int wr, int wc, int fr, int fq) const {
        const int row0 = u.pm * BM + wr * 64 + fr; const int col0 = u.pn * BM + wc * 32 + 8 * fq;
#pragma unroll
        for (int ai = 0; ai < 2; ++ai)
#pragma unroll
            for (int m = 0; m < 4; ++m) { bf16_t* rowp = O + (size_t)(row0 + ai * HALF + m * 16) * ldc + col0;
                const float rs = rtab ? rtab[ui * 256 + wr * 64 + fr + ai * HALF + m * 16] : 1.0f;
#pragma unroll
                for (int bj = 0; bj < 2; ++bj) { f32x4 v0 = acc[ai][bj][m][0] * rs, v1 = acc[ai][bj][m][1] * rs;
                    if (ACT == 1) { v0 = (f32x4){gelu_tanh_f(v0[0]), gelu_tanh_f(v0[1]), gelu_tanh_f(v0[2]), gelu_tanh_f(v0[3])}; v1 = (f32x4){gelu_tanh_f(v1[0]), gelu_tanh_f(v1[1]), gelu_tanh_f(v1[2]), gelu_tanh_f(v1[3])}; }
                    u32x4 w; w.x = cvt_pk_bf16(v0[0], v0[1]); w.y = cvt_pk_bf16(v0[2], v0[3]); w.z = cvt_pk_bf16(v1[0], v1[1]); w.w = cvt_pk_bf16(v1[2], v1[3]);
                    *(u32x4*)(rowp + bj * HALF) = w; } asm volatile("" ::: "memory"); }
        ++ui;
    }
};
struct EpiResid {
    static constexpr bool PERM = true, AFTER_DRAIN = false;
    bf16_t* xb; int ldc; float alpha; float* ss;
    __device__ __forceinline__ void operator()(const f32x4 (&acc)[2][2][4][2], const Unit& u, int wr, int wc, int fr, int fq) const {
        const int row0 = u.pm * BM + wr * 64 + fr; const int col0 = u.pn * BM + wc * 32 + 8 * fq; const int lane = fq * 16 + fr;
#pragma unroll
        for (int ai = 0; ai < 2; ++ai) {
            u32x4 pre[4][2];
#pragma unroll
            for (int m = 0; m < 4; ++m)
#pragma unroll
                for (int bj = 0; bj < 2; ++bj) pre[m][bj] = *(const u32x4*)(xb + (size_t)(row0 + ai * HALF + m * 16) * ldc + col0 + bj * HALF);
#pragma unroll
            for (int m = 0; m < 4; ++m) { const int row = row0 + ai * HALF + m * 16; bf16_t* rowp = xb + (size_t)row * ldc + col0; float sq = 0.f;
#pragma unroll
                for (int bj = 0; bj < 2; ++bj) { const u32x4 p = pre[m][bj]; const f32x4 a0 = acc[ai][bj][m][0] * alpha, a1 = acc[ai][bj][m][1] * alpha;
                    const float x0 = __uint_as_float(p.x << 16) + a0[0], x1 = __uint_as_float(p.x & 0xffff0000u) + a0[1], x2 = __uint_as_float(p.y << 16) + a0[2], x3 = __uint_as_float(p.y & 0xffff0000u) + a0[3];
                    const float x4 = __uint_as_float(p.z << 16) + a1[0], x5 = __uint_as_float(p.z & 0xffff0000u) + a1[1], x6 = __uint_as_float(p.w << 16) + a1[2], x7 = __uint_as_float(p.w & 0xffff0000u) + a1[3];
                    sq += ((x0 * x0 + x1 * x1) + (x2 * x2 + x3 * x3)) + ((x4 * x4 + x5 * x5) + (x6 * x6 + x7 * x7));
                    u32x4 w; w.x = cvt_pk_bf16(x0, x1); w.y = cvt_pk_bf16(x2, x3); w.z = cvt_pk_bf16(x4, x5); w.w = cvt_pk_bf16(x6, x7);
                    *(u32x4*)(rowp + bj * HALF) = w; }
                sq += __int_as_float(__builtin_amdgcn_ds_bpermute((lane ^ 16) << 2, __float_as_int(sq)));
                sq += __int_as_float(__builtin_amdgcn_ds_bpermute((lane ^ 32) << 2, __float_as_int(sq)));
                if (fq == 0) ss[(size_t)row * 16 + u.pn * 4 + wc] = sq; }
            asm volatile("" ::: "memory");
        }
    }
};
template <class Epi, class Sched, bool ALIGN_EPI = false, bool SP2 = false>
__device__ __forceinline__ void gemm_phase(PG8_LAS unsigned char* lds, const Gemm g, const Sched& S, const Epi& E, const int wave_in) {
    int tid_l; asm volatile("v_mbcnt_lo_u32_b32 %0, -1, 0\n\tv_mbcnt_hi_u32_b32 %0, -1, %0" : "=v"(tid_l)); tid_l += wave_in * 64;
    const int tid = tid_l, wid = __builtin_amdgcn_readfirstlane(tid >> 6), lane = tid & 63, wr = wid >> 2, wc = wid & 3, fr = lane & 15, fq = lane >> 4;
    const int K = g.K, nt = K / BK;
    unsigned voffA[2], voffB[2];
#pragma unroll
    for (int i = 0; i < 2; ++i) { int R, C; stage_rc(tid * 16 + i * 8192, R, C); const int Rb = Epi::PERM ? ((R & ~31) + perm32(R & 31)) : R;
        voffA[i] = (unsigned)(R * K + C) * 2u; voffB[i] = (unsigned)(Rb * K + C) * 2u; }
    const size_t kstep = (size_t)(BK * 2);
    const size_t hstep = (size_t)HALF * K * 2;
    const size_t tstep = 2 * hstep;
    const unsigned ldsw = (unsigned)wid * 1024u;
    const int aoff = lds_byte(wr * 64 + fr, fq * 8), boff = lds_byte(wc * 32 + fr, fq * 8);
#define PG8_SA(b, h) (((b) * 2 + (h)) * HTB)
#define PG8_SB(b, h) ((4 + (b) * 2 + (h)) * HTB)
#define PG8_STAGE(bufoff, gbase, voff) do { _Pragma("unroll") for (int _i = 0; _i < 2; ++_i) \
        __builtin_amdgcn_global_load_lds((const unsigned*)((const char*)(gbase) + (voff)[_i]), (PG8_LAS unsigned*)(lds + (bufoff) + ldsw + _i * 8192), 16, 0, 0); } while (0)
#define PG8_LDA(dst, b, h) do { _Pragma("unroll") for (int m = 0; m < 4; ++m) _Pragma("unroll") for (int k = 0; k < 2; ++k) dst[m][k] = *(const PG8_LAS bf16x8*)(lds + PG8_SA(b, h) + aoff + m * 2048 + k * 1024); } while (0)
#define PG8_LDB(dst, b, h) do { _Pragma("unroll") for (int n = 0; n < 2; ++n) _Pragma("unroll") for (int k = 0; k < 2; ++k) dst[n][k] = *(const PG8_LAS bf16x8*)(lds + PG8_SB(b, h) + boff + n * 2048 + k * 1024); } while (0)
#define PG8_MMA(ai, bj, At, Bt) do { __builtin_amdgcn_s_setprio(1); _Pragma("unroll") for (int m = 0; m < 4; ++m) _Pragma("unroll") for (int n = 0; n < 2; ++n) _Pragma("unroll") for (int k = 0; k < 2; ++k) \
        acc[ai][bj][m][n] = __builtin_amdgcn_mfma_f32_16x16x32_bf16(Bt[n][k], At[m][k], acc[ai][bj][m][n], 0, 0, 0); __builtin_amdgcn_s_setprio(0); } while (0)
#define PG8_WAIT_V(n) asm volatile("s_waitcnt vmcnt(" #n ")" ::: "memory")
#define PG8_WAIT_L(n) asm volatile("s_waitcnt lgkmcnt(" #n ")" ::: "memory")
#define PG8_BAR __builtin_amdgcn_s_barrier()
#define PG8_SCHED __builtin_amdgcn_sched_barrier(0)
    Unit cur, nxt; int ui = 0;
    if (!S.next(0, cur)) return;
    f32x4 acc[2][2][4][2];
#pragma unroll
    for (int a = 0; a < 2; ++a)
#pragma unroll
        for (int b = 0; b < 2; ++b)
#pragma unroll
            for (int m = 0; m < 4; ++m)
#pragma unroll
                for (int n = 0; n < 2; ++n) acc[a][b][m][n] = (f32x4){0.f, 0.f, 0.f, 0.f};
    bf16x8 At[4][2], B0[2][2], B1[2][2];
    const char* cA = (const char*)g.A + (size_t)cur.pm * tstep; const char* cB = (const char*)g.Bt + (size_t)cur.pn * tstep;
    S.a_ready(cur);
    if constexpr (SP2) {
        PG8_STAGE(PG8_SB(0, 0), cB, voffB); PG8_STAGE(PG8_SB(0, 1), cB + hstep, voffB); PG8_STAGE(PG8_SA(0, 0), cA, voffA); PG8_STAGE(PG8_SA(0, 1), cA + hstep, voffA);
        if (wr == 1) PG8_BAR;
        PG8_WAIT_V(2); PG8_BAR;
        PG8_STAGE(PG8_SB(1, 0), cB + kstep, voffB); PG8_STAGE(PG8_SA(1, 0), cA + kstep, voffA); PG8_STAGE(PG8_SB(1, 1), cB + hstep + kstep, voffB);
        PG8_WAIT_V(6); PG8_BAR;
    } else {
        PG8_STAGE(PG8_SB(0, 0), cB, voffB); PG8_STAGE(PG8_SA(0, 0), cA, voffA); PG8_STAGE(PG8_SB(0, 1), cB + hstep, voffB); PG8_STAGE(PG8_SA(0, 1), cA + hstep, voffA);
        if (wr == 1) PG8_BAR;
        PG8_WAIT_V(4); PG8_BAR;
        PG8_STAGE(PG8_SB(1, 0), cB + kstep, voffB); PG8_STAGE(PG8_SA(1, 0), cA + kstep, voffA); PG8_STAGE(PG8_SB(1, 1), cB + hstep + kstep, voffB);
        PG8_WAIT_V(6); PG8_BAR;
    }
    for (;;) {
        const bool has_next = S.next(ui + 1, nxt);
        const char* nA = has_next ? (const char*)g.A + (size_t)nxt.pm * tstep : cA; const char* nB = has_next ? (const char*)g.Bt + (size_t)nxt.pn * tstep : cB;
        for (int t = 0; t < nt; t += 2) {
            const bool last = (t == nt - 2);
            const char* a1 = cA + (size_t)(t + 1) * kstep;
            const char* a2 = last ? nA : cA + (size_t)(t + 2) * kstep; const char* b2 = last ? nB : cB + (size_t)(t + 2) * kstep;
            const char* a3 = a2 + kstep; const char* b3 = b2 + kstep;
            if (last && has_next) S.a_ready(nxt);
            if constexpr (SP2) {
            PG8_LDB(B0, 0, 0); PG8_LDB(B1, 0, 1); PG8_SCHED; PG8_LDA(At, 0, 0); PG8_STAGE(PG8_SA(1, 1), a1 + hstep, voffA);
            PG8_WAIT_V(8); PG8_WAIT_L(0); PG8_BAR; PG8_MMA(0, 0, At, B0); PG8_MMA(0, 1, At, B1); PG8_BAR; PG8_SCHED;
            PG8_LDA(At, 0, 1); PG8_STAGE(PG8_SB(0, 0), b2, voffB); PG8_STAGE(PG8_SB(0, 1), b2 + hstep, voffB); PG8_STAGE(PG8_SA(0, 0), a2, voffA);
            PG8_WAIT_V(8); PG8_WAIT_L(0); PG8_BAR; PG8_MMA(1, 0, At, B0); PG8_MMA(1, 1, At, B1); PG8_BAR; PG8_SCHED;
            PG8_LDB(B0, 1, 0); PG8_LDB(B1, 1, 1); PG8_SCHED; PG8_LDA(At, 1, 0); PG8_STAGE(PG8_SA(0, 1), a2 + hstep, voffA);
            PG8_WAIT_V(8); PG8_WAIT_L(0); PG8_BAR; PG8_MMA(0, 0, At, B0); PG8_MMA(0, 1, At, B1); PG8_BAR; PG8_SCHED;
            PG8_LDA(At, 1, 1); PG8_STAGE(PG8_SB(1, 0), b3, voffB); PG8_STAGE(PG8_SB(1, 1), b3 + hstep, voffB); PG8_STAGE(PG8_SA(1, 0), a3, voffA);
            PG8_WAIT_V(8); PG8_WAIT_L(0); PG8_BAR; PG8_MMA(1, 0, At, B0); PG8_MMA(1, 1, At, B1); PG8_BAR; PG8_SCHED;
            } else {
            PG8_LDB(B0, 0, 0); PG8_SCHED; PG8_LDA(At, 0, 0); PG8_STAGE(PG8_SA(1, 1), a1 + hstep, voffA);
            PG8_WAIT_L(8); PG8_BAR; PG8_WAIT_L(0); PG8_MMA(0, 0, At, B0); PG8_BAR; PG8_SCHED;
            PG8_LDB(B1, 0, 1); PG8_STAGE(PG8_SB(0, 0), b2, voffB);
            PG8_BAR; PG8_WAIT_L(0); PG8_MMA(0, 1, At, B1); PG8_BAR;
            PG8_LDA(At, 0, 1); PG8_STAGE(PG8_SA(0, 0), a2, voffA);
            PG8_BAR; PG8_WAIT_L(0); PG8_MMA(1, 0, At, B0); PG8_BAR; PG8_SCHED;
            PG8_STAGE(PG8_SB(0, 1), b2 + hstep, voffB);
            PG8_WAIT_V(6); PG8_BAR; PG8_MMA(1, 1, At, B1); PG8_BAR;
            PG8_LDB(B0, 1, 0); PG8_SCHED; PG8_LDA(At, 1, 0); PG8_STAGE(PG8_SA(0, 1), a2 + hstep, voffA);
            PG8_WAIT_L(8); PG8_BAR; PG8_WAIT_L(0); PG8_MMA(0, 0, At, B0); PG8_BAR; PG8_SCHED;
            PG8_LDB(B1, 1, 1); PG8_STAGE(PG8_SB(1, 0), b3, voffB);
            PG8_BAR; PG8_WAIT_L(0); PG8_MMA(0, 1, At, B1); PG8_BAR;
            PG8_LDA(At, 1, 1); PG8_STAGE(PG8_SA(1, 0), a3, voffA);
            PG8_BAR; PG8_WAIT_L(0); PG8_MMA(1, 0, At, B0); PG8_BAR; PG8_SCHED;
            PG8_STAGE(PG8_SB(1, 1), b3 + hstep, voffB);
            PG8_WAIT_V(6); PG8_BAR; PG8_MMA(1, 1, At, B1); PG8_BAR;
            }
        }
        if constexpr (ALIGN_EPI) { if (wr == 0) PG8_BAR; }
        if constexpr (!Epi::AFTER_DRAIN) { E(acc, cur, wr, wc, fr, fq); S.done(cur); }
        if (!has_next) break;
#pragma unroll
        for (int a = 0; a < 2; ++a)
#pragma unroll
            for (int b = 0; b < 2; ++b)
#pragma unroll
                for (int m = 0; m < 4; ++m)
#pragma unroll
                    for (int n = 0; n < 2; ++n) acc[a][b][m][n] = (f32x4){0.f, 0.f, 0.f, 0.f};
        cur = nxt; cA = nA; cB = nB; ++ui;
        if constexpr (ALIGN_EPI) { if (wr == 1) PG8_BAR; }
    }
    PG8_WAIT_V(0);
    if constexpr (!ALIGN_EPI) { if (wr == 0) PG8_BAR; }
    PG8_BAR;
    if constexpr (Epi::AFTER_DRAIN) { E.fused(acc, cur, wr, wc, fr, fq, lds, wid, lane); S.done(cur); }
#undef PG8_SA
#undef PG8_SB
#undef PG8_STAGE
#undef PG8_LDA
#undef PG8_LDB
#undef PG8_MMA
#undef PG8_WAIT_V
#undef PG8_WAIT_L
#undef PG8_BAR
#undef PG8_SCHED
}
}

#define LAS __attribute__((address_space(3)))
using pg8::ex2; using pg8::rcpf_;
typedef unsigned short u16;
typedef short bf16x8 __attribute__((ext_vector_type(8)));
typedef float f32x4 __attribute__((ext_vector_type(4)));
typedef float f32x16 __attribute__((ext_vector_type(16)));
typedef unsigned u32x4 __attribute__((ext_vector_type(4)));
typedef unsigned u32x2 __attribute__((ext_vector_type(2)));

constexpr int DM = 1024, NB = 16, SEQ = 2048, MTOK = NB * SEQ, DEPTH = 4, DFF = 2816, INW = 2840, PW = 3072;
constexpr int C_MQ = 0, C_MK = 256, C_MV = 512, C_DQ = 768, C_DK = 1024, C_DV = 1280, C_NQ = 1536, C_NKC = 2048, C_NVC = 2176, C_NKS = 2304, C_NVS = 2432, C_NKW = 2560, C_NVW = 2688, C_NG = 2816;
constexpr int NVH = 12;
constexpr float LOG2E = 1.4426950408889634f, NEGF = -1e30f;
constexpr int NPH_L = 14, NPH = NPH_L * DEPTH + 1;
constexpr size_t MiB = 1u << 20;
constexpr size_t WS_GU1 = 1 * MiB, WS_DN1 = 12 * MiB, WS_GU2 = WS_DN1 + 5 * MiB + MiB / 2, WS_DN2 = WS_GU2 + 11 * MiB, WS_WIN = 34 * MiB, WS_WOUT = 40 * MiB, WS_W1 = 42 * MiB;
constexpr size_t WS_PROJ = 44 * MiB, WS_XN = 236 * MiB, WS_VT = 300 * MiB, WS_HID = 348 * MiB, WS_KCMP = 352 * MiB, WS_VCMPT = WS_KCMP + MiB / 2, WS_KMEAN = 353 * MiB, WS_SEL = WS_KMEAN + MiB / 4, WS_XB = 354 * MiB, WS_SS = 418 * MiB, WS_END = 420 * MiB;
static_assert(WS_DN2 + 5 * MiB + MiB / 2 == WS_WIN, "ws map");
constexpr int LDS_BYTES = 147456, MISC_OFF = 147456 - 64, RTAB_OFF = 131072;
constexpr size_t WS_CTL = 0, CTL_ZERO_BYTES = 262144;
constexpr int ATT_K = 0, ATT_V = 32768, ATT_LUT = 32768 + 4 * 8704, ATT_PARK = ATT_LUT + 2816;
constexpr int CMP_K = 0, CMP_V = 18432, CMP_A = 36864, CMP_H = CMP_A + 256 * 33 * 4;

struct Params {
    const float* x; const float* rel_bias; const float* norm_ffn1; const float* ffn1_gate; const float* ffn1_up; const float* ffn1_down;
    const float* norm_mix; const float* w_in; const float* diff_lambda; const float* diff_subln; const float* cmp_pe; const float* cmp_w1; const float* cmp_w2;
    const float* w_out; const float* norm_ffn2; const float* ffn2_gate; const float* ffn2_up; const float* ffn2_down; const float* final_norm;
    float* out; unsigned char* ws;
    float lam_init[4];
    int ph_lo, ph_hi;
};
typedef const __attribute__((address_space(4))) Params* KParamsPtr;

__device__ __forceinline__ float bf2f(unsigned v) { return __uint_as_float(v << 16); }
typedef float f32x2_t __attribute__((ext_vector_type(2))); typedef __bf16 bf16x2_t __attribute__((ext_vector_type(2)));
__device__ __forceinline__ unsigned pkbf(float lo, float hi) { f32x2_t v = {lo, hi}; bf16x2_t b = __builtin_convertvector(v, bf16x2_t); return __builtin_bit_cast(unsigned, b); }
__device__ __forceinline__ int lane_opaque() { int l; asm volatile("v_mbcnt_lo_u32_b32 %0, -1, 0\n\tv_mbcnt_hi_u32_b32 %0, -1, %0" : "=v"(l)); return l; }
__device__ __forceinline__ float wave_sum(float v, int lane) {
#pragma unroll
    for (int o = 1; o < 64; o <<= 1) v += __int_as_float(__builtin_amdgcn_ds_bpermute((lane ^ o) << 2, __float_as_int(v)));
    return v;
}
__device__ __forceinline__ float xhalf_max(float v) { auto rr = __builtin_amdgcn_permlane32_swap(__float_as_uint(v), __float_as_uint(v), false, false); return fmaxf(__uint_as_float(rr[0]), __uint_as_float(rr[1])); }
__device__ __forceinline__ float xhalf_sum(float v) { auto rr = __builtin_amdgcn_permlane32_swap(__float_as_uint(v), __float_as_uint(v), false, false); return __uint_as_float(rr[0]) + __uint_as_float(rr[1]); }
__device__ __forceinline__ float sigmoid_f(float x) { return rcpf_(1.0f + ex2(-LOG2E * x)); }
__device__ __forceinline__ int crow(int r, int hi) { return (r & 3) + 8 * (r >> 2) + 4 * hi; }
__device__ __forceinline__ int kperm(int p) { const int h = p >> 3, j = p & 7; return 8 * (j >> 2) + 4 * h + (j & 3); }
__device__ __forceinline__ int pperm(int k) { return ((k >> 2) & 1) * 8 + (k >> 3) * 4 + (k & 3); }

__device__ __forceinline__ void tr_item(const float* W, int K, int N, u16* WT, int kb, int n0, int dst_row0, LAS float* scr, int lane, float cs = 1.0f, const float* gk = nullptr) {
    const int k0 = 64 * kb; const int n = n0 + (lane & 31); const bool ok = n < N;
    float wv[32];
#pragma unroll
    for (int i = 0; i < 32; ++i) { const int kk = 2 * i + (lane >> 5); wv[i] = ok ? W[(size_t)(k0 + kk) * N + n] : 0.f; }
#pragma unroll
    for (int i = 0; i < 32; ++i) { const int kk = 2 * i + (lane >> 5); scr[kk * 33 + (lane & 31)] = wv[i] * (gk ? gk[k0 + kk] * cs : cs); }
    asm volatile("s_waitcnt lgkmcnt(0)" ::: "memory");
    const int c = lane & 7;
#pragma unroll
    for (int j = 0; j < 4; ++j) { const int nn = (lane >> 3) + 8 * j; const LAS float* s = scr + (8 * c) * 33 + nn;
        u32x4 o; o.x = pkbf(s[0 * 33], s[1 * 33]); o.y = pkbf(s[2 * 33], s[3 * 33]); o.z = pkbf(s[4 * 33], s[5 * 33]); o.w = pkbf(s[6 * 33], s[7 * 33]);
        *(u32x4*)(WT + (size_t)(dst_row0 + nn) * K + k0 + 8 * c) = o; }
    asm volatile("s_waitcnt lgkmcnt(0)" ::: "memory");
}

__device__ __forceinline__ void norm_row(const float* xrow, const u16* xrow16, const float* g, u16* dst16, float* dst32, u16* xb0, int lane) {
    float v[16];
    if (xrow) { const f32x4* xr = (const f32x4*)xrow + 4 * lane;
#pragma unroll
        for (int j = 0; j < 4; ++j) { const f32x4 t = xr[j]; v[4 * j] = t.x; v[4 * j + 1] = t.y; v[4 * j + 2] = t.z; v[4 * j + 3] = t.w; }
        if (xb0) { u32x4 o0, o1; o0.x = pkbf(v[0], v[1]); o0.y = pkbf(v[2], v[3]); o0.z = pkbf(v[4], v[5]); o0.w = pkbf(v[6], v[7]); o1.x = pkbf(v[8], v[9]); o1.y = pkbf(v[10], v[11]); o1.z = pkbf(v[12], v[13]); o1.w = pkbf(v[14], v[15]);
            ((u32x4*)xb0)[2 * lane] = o0; ((u32x4*)xb0)[2 * lane + 1] = o1; }
    } else { const u32x4 p0 = ((const u32x4*)xrow16)[2 * lane], p1 = ((const u32x4*)xrow16)[2 * lane + 1];
        v[0] = bf2f(p0.x & 0xffffu); v[1] = bf2f(p0.x >> 16); v[2] = bf2f(p0.y & 0xffffu); v[3] = bf2f(p0.y >> 16); v[4] = bf2f(p0.z & 0xffffu); v[5] = bf2f(p0.z >> 16); v[6] = bf2f(p0.w & 0xffffu); v[7] = bf2f(p0.w >> 16);
        v[8] = bf2f(p1.x & 0xffffu); v[9] = bf2f(p1.x >> 16); v[10] = bf2f(p1.y & 0xffffu); v[11] = bf2f(p1.y >> 16); v[12] = bf2f(p1.z & 0xffffu); v[13] = bf2f(p1.z >> 16); v[14] = bf2f(p1.w & 0xffffu); v[15] = bf2f(p1.w >> 16); }
    float s = 0.f;
#pragma unroll
    for (int j = 0; j < 16; ++j) s = fmaf(v[j], v[j], s);
    const float rstd = 1.0f / sqrtf(wave_sum(s, lane) * (1.0f / 1024.0f) + 1e-6f);
    const f32x4* gr = (const f32x4*)g + 4 * lane;
#pragma unroll
    for (int j = 0; j < 4; ++j) { const f32x4 gg = gr[j]; v[4 * j] *= rstd * gg.x; v[4 * j + 1] *= rstd * gg.y; v[4 * j + 2] *= rstd * gg.z; v[4 * j + 3] *= rstd * gg.w; }
    if (dst16) { u32x4 o0, o1; o0.x = pkbf(v[0], v[1]); o0.y = pkbf(v[2], v[3]); o0.z = pkbf(v[4], v[5]); o0.w = pkbf(v[6], v[7]); o1.x = pkbf(v[8], v[9]); o1.y = pkbf(v[10], v[11]); o1.z = pkbf(v[12], v[13]); o1.w = pkbf(v[14], v[15]);
        ((u32x4*)dst16)[2 * lane] = o0; ((u32x4*)dst16)[2 * lane + 1] = o1; }
    else {
#pragma unroll
        for (int j = 0; j < 4; ++j) ((f32x4*)dst32)[4 * lane + j] = (f32x4){v[4 * j], v[4 * j + 1], v[4 * j + 2], v[4 * j + 3]}; }
}

struct AState { f32x16 o0, o1; float m, l; };
__device__ __forceinline__ void astate_init(AState& s) {
#pragma unroll
    for (int r = 0; r < 16; ++r) { s.o0[r] = 0.f; s.o1[r] = 0.f; }
    s.m = 0.f; s.l = 0.f;
}
constexpr float ATT_THR = 8.0f;
constexpr int ATT_SLOT = 9216, ATT_NSLOT = 3;
template <int KS0, int NKS>
__device__ __forceinline__ void qk_block(const LAS unsigned char* Ks, const bf16x8 (&qr)[4], int r32, int hi, f32x16& s0, f32x16& s1) {
    f32x16 ci;
#pragma unroll
    for (int r = 0; r < 16; ++r) ci[r] = 0.f;
    const LAS unsigned char* kp = Ks + hi * 1024 + r32 * 16;
#pragma unroll
    for (int ks = 0; ks < NKS; ++ks) {
        const bf16x8 a0 = *(const LAS bf16x8*)(kp + (KS0 + ks) * 2048);
        const bf16x8 a1 = *(const LAS bf16x8*)(kp + (KS0 + ks) * 2048 + 512);
        s0 = __builtin_amdgcn_mfma_f32_32x32x16_bf16(a0, qr[KS0 + ks], ks == 0 ? ci : s0, 0, 0, 0);
        s1 = __builtin_amdgcn_mfma_f32_32x32x16_bf16(a1, qr[KS0 + ks], ks == 0 ? ci : s1, 0, 0, 0);
    }
    __builtin_amdgcn_sched_group_barrier(0x100, 2 * NKS, 0); __builtin_amdgcn_sched_group_barrier(0x008, 2 * NKS, 0);
}
constexpr int ATT_VCH = 1088, ATT_VSLOT = 8 * ATT_VCH;
typedef short v4i16_t __attribute__((ext_vector_type(4)));
__device__ __forceinline__ void pv_block(const LAS unsigned char* Vs, const u32x4 (&pk)[4], int lane, AState& st) {
    const int p = lane & 3, q = (lane & 15) >> 2, dsel = (lane >> 4) & 1, hi = lane >> 5;
    const LAS unsigned char* vp = Vs + (2 * dsel + (p >> 1)) * ATT_VCH + (4 * hi + q) * 16 + (p & 1) * 8;
#pragma unroll
    for (int c = 0; c < 4; ++c) {
        const v4i16_t a0 = __builtin_amdgcn_ds_read_tr16_b64_v4i16((LAS v4i16_t*)(vp + c * 256));
        const v4i16_t a1 = __builtin_amdgcn_ds_read_tr16_b64_v4i16((LAS v4i16_t*)(vp + c * 256 + 128));
        const v4i16_t b0 = __builtin_amdgcn_ds_read_tr16_b64_v4i16((LAS v4i16_t*)(vp + 4 * ATT_VCH + c * 256));
        const v4i16_t b1 = __builtin_amdgcn_ds_read_tr16_b64_v4i16((LAS v4i16_t*)(vp + 4 * ATT_VCH + c * 256 + 128));
        const bf16x8 v0 = (bf16x8){a0[0], a0[1], a0[2], a0[3], a1[0], a1[1], a1[2], a1[3]};
        const bf16x8 v1 = (bf16x8){b0[0], b0[1], b0[2], b0[3], b1[0], b1[1], b1[2], b1[3]};
        const bf16x8 pb = __builtin_bit_cast(bf16x8, pk[c]);
        st.o0 = __builtin_amdgcn_mfma_f32_32x32x16_bf16(v0, pb, st.o0, 0, 0, 0);
        st.o1 = __builtin_amdgcn_mfma_f32_32x32x16_bf16(v1, pb, st.o1, 0, 0, 0);
    }
}
__device__ __forceinline__ void glds16(const void* gsrc, unsigned lds_dst) { unsigned keep;
    asm volatile("s_mov_b32 %0, m0\n\ts_mov_b32 m0, %2\n\ts_nop 0\n\tglobal_load_lds_dwordx4 %1, off\n\ts_mov_b32 m0, %0" : "=&s"(keep) : "v"(gsrc), "s"(lds_dst) : "memory"); }
__device__ __forceinline__ void lut_add(f32x16& s0, f32x16& s1, const LAS float* lutz, int dbase, float cc) {
    const LAS float* lp = lutz + (dbase - 59);
#pragma unroll
    for (int r = 0; r < 16; ++r) { const int ko = (r & 3) + 8 * (r >> 2);
        s0[r] += lp[59 - ko] + cc; s1[r] += lp[27 - ko] + cc; }
}
__device__ __forceinline__ void const_add(f32x16& s0, f32x16& s1, float cc) {
#pragma unroll
    for (int r = 0; r < 16; ++r) { s0[r] += cc; s1[r] += cc; }
}
__device__ __forceinline__ float row_max(const f32x16& s0, const f32x16& s1) {
    float mx = fmaxf(s0[0], s1[0]);
#pragma unroll
    for (int r = 1; r < 16; ++r) mx = fmaxf(mx, fmaxf(s0[r], s1[r]));
    return xhalf_max(mx);
}
__device__ __forceinline__ void rescale(AState& st, f32x16& s0, f32x16& s1, float mx) {
    const float dl = fmaxf(mx, 0.f); const float f = ex2(-dl); st.m += dl; st.l *= f;
#pragma unroll
    for (int r = 0; r < 16; ++r) { st.o0[r] *= f; st.o1[r] *= f; s0[r] -= dl; s1[r] -= dl; }
}
constexpr float ATT_BIG = 1024.0f;
__device__ __forceinline__ void exp_pack(f32x16& s0, f32x16& s1, u32x4 (&pk)[4], AState& st) {
    float sum = 0.f;
#pragma unroll
    for (int r = 0; r < 16; ++r) { s0[r] = ex2(s0[r]); s1[r] = ex2(s1[r]); sum += s0[r] + s1[r]; }
    if (__any(sum > ATT_BIG)) {
        float mx = fmaxf(s0[0], s1[0]);
#pragma unroll
        for (int r = 1; r < 16; ++r) mx = fmaxf(mx, fmaxf(s0[r], s1[r]));
        mx = xhalf_max(mx);
        const float dl = fmaxf(__builtin_amdgcn_logf(fmaxf(mx, 1.0f)), 0.f), f = ex2(-dl);
        st.m += dl; st.l *= f; sum *= f;
#pragma unroll
        for (int r = 0; r < 16; ++r) { st.o0[r] *= f; st.o1[r] *= f; s0[r] *= f; s1[r] *= f; }
    }
    st.l += sum;
    pk[0] = (u32x4){pkbf(s0[0], s0[1]), pkbf(s0[2], s0[3]), pkbf(s0[4], s0[5]), pkbf(s0[6], s0[7])};
    pk[1] = (u32x4){pkbf(s0[8], s0[9]), pkbf(s0[10], s0[11]), pkbf(s0[12], s0[13]), pkbf(s0[14], s0[15])};
    pk[2] = (u32x4){pkbf(s1[0], s1[1]), pkbf(s1[2], s1[3]), pkbf(s1[4], s1[5]), pkbf(s1[6], s1[7])};
    pk[3] = (u32x4){pkbf(s1[8], s1[9]), pkbf(s1[10], s1[11]), pkbf(s1[12], s1[13]), pkbf(s1[14], s1[15])};
}

template <int KS0, int NKS, bool WINDOW, int MODE>
__device__ __forceinline__ void run_tiles(LAS unsigned char* lds, int t0, int t1, const u16* Kg, const u16* Vtg, const bf16x8 (&qr)[4], float c31,
                                          int q0w, unsigned mask, int qb, AState& A, int wave, int lane, int r32, int hi) {
    LAS unsigned char* Kr = lds + ATT_K; LAS unsigned char* Vr = lds + ATT_V; const LAS float* lut1 = (const LAS float*)(lds + ATT_LUT) + 96;
    const u16* ksrc = Kg + (size_t)lane * PW + wave * 8;
    const u16* vsrc = Vtg + (size_t)lane * PW + wave * 8;
    const unsigned kdst = (unsigned)(uintptr_t)Kr + wave * 1024, vdst = (unsigned)(uintptr_t)Vr + wave * ATT_VCH;
#define TCL(t) ((t) < t0 ? t0 : ((t) > t1 ? t1 : (t)))
#define DMA_K(tn) glds16(ksrc + (size_t)TCL(tn) * 64 * PW, (unsigned)__builtin_amdgcn_readfirstlane(kdst + ((tn) & 3) * 8192))
#define DMA_V(tn) glds16(vsrc + (size_t)TCL(tn) * 64 * PW, (unsigned)__builtin_amdgcn_readfirstlane(vdst + ((tn) & 3) * ATT_VSLOT))
#define KS_(t) (Kr + ((t) & 3) * 8192)
#define VS_(t) (Vr + ((t) & 3) * ATT_VSLOT)
#define WAIT_BAR4() asm volatile("s_waitcnt vmcnt(4) lgkmcnt(0)\n\ts_barrier" ::: "memory")
#define T_ACTIVE(t) (!((q0w + 31 - (t) * 64) < 0 || (WINDOW && (q0w - ((t) * 64 + 63)) >= 512)))
#define T_LUTMODE(t) (((q0w - ((t) * 64 + 63)) < 128) || (WINDOW && (q0w + 31 - (t) * 64) >= 512))
    auto tile_sel = [&](int t) -> int { if (MODE == 1) { const int blk = t >> 2; return blk < qb ? (int)((mask >> blk) & 1u) : 1; } if (MODE == 2) return (int)((mask >> t) & 1u); return 1; };
    asm volatile("s_waitcnt vmcnt(0)" ::: "memory");
#pragma unroll
    for (int j = 0; j < 4; ++j) { DMA_K(t0 + j); DMA_V(t0 + j - 2); }
    WAIT_BAR4();
    f32x16 sn0, sn1, sc0, sc1; u32x4 pk[4];
#pragma unroll
    for (int r = 0; r < 16; ++r) { sn0[r] = 0.f; sn1[r] = 0.f; }
#pragma unroll
    for (int i = 0; i < 4; ++i) pk[i] = (u32x4){0u, 0u, 0u, 0u};
    bool act_n = T_ACTIVE(t0), act_c = false, act_p = false;
    if (act_n) qk_block<KS0, NKS>(KS_(t0), qr, r32, hi, sn0, sn1);
    asm volatile("s_waitcnt lgkmcnt(0)\n\ts_barrier" ::: "memory");
    for (int c = t0; c <= t1 + 1; ++c) {
        act_p = act_c; act_c = act_n; sc0 = sn0; sc1 = sn1;
        DMA_K(c + 4); DMA_V(c + 2);
        act_n = (c + 1 <= t1) && T_ACTIVE(c + 1);
        const bool lm_c = T_LUTMODE(c);
        const int dbase = q0w + r32 - c * 64 - 4 * hi;
        const float selc = tile_sel(c) ? 0.f : NEGF;
        if (act_p) pv_block(VS_(c - 1), pk, lane, A);
        if (act_c) {
            const float cc = selc - A.m;
            if (lm_c) lut_add(sc0, sc1, lut1, dbase, cc); else if (__any(cc != 0.f)) const_add(sc0, sc1, cc);
        }
        if (act_n) qk_block<KS0, NKS>(KS_(c + 1), qr, r32, hi, sn0, sn1);
        if (act_c) exp_pack(sc0, sc1, pk, A);
        WAIT_BAR4();
    }
    asm volatile("s_waitcnt vmcnt(0) lgkmcnt(0)\n\ts_barrier" ::: "memory");
#undef TCL
#undef DMA_K
#undef DMA_V
#undef KS_
#undef VS_
#undef WAIT_BAR4
#undef T_ACTIVE
#undef T_LUTMODE
}

__device__ __forceinline__ void build_lut(LAS unsigned char* lds, const float* rel_bias, int head, bool window, int tid) {
    LAS float* lut = (LAS float*)(lds + ATT_LUT);
    for (int i = tid; i < 704; i += 512) {
        const int d = i - 96; float v; const float c31 = rel_bias[31 * 16 + head];
        if (d < 0) v = NEGF;
        else if (d >= 512) v = window ? NEGF : 0.f;
        else { int bk;
            if (d < 16) bk = d; else if (d >= 128) bk = 31; else { bk = 16 + (int)(log2f((float)d * (1.0f / 16.0f)) * (16.0f / 3.0f)); bk = bk > 31 ? 31 : bk; }
            v = (rel_bias[bk * 16 + head] - c31) * LOG2E; }
        lut[i] = v;
    }
}
__device__ __forceinline__ void load_q(bf16x8 (&qr)[4], const u16* qrow, int hi) {
#pragma unroll
    for (int ks = 0; ks < 4; ++ks) qr[ks] = *(const bf16x8*)(qrow + ks * 16 + hi * 8);
}
__device__ __forceinline__ void store_o(u16* dst, const f32x16& v0, const f32x16& v1, int hi) {
#pragma unroll
    for (int g = 0; g < 4; ++g) {
        u32x2 a; a.x = pkbf(v0[4 * g], v0[4 * g + 1]); a.y = pkbf(v0[4 * g + 2], v0[4 * g + 3]); *(u32x2*)(dst + 8 * g + 4 * hi) = a;
        u32x2 b; b.x = pkbf(v1[4 * g], v1[4 * g + 1]); b.y = pkbf(v1[4 * g + 2], v1[4 * g + 3]); *(u32x2*)(dst + 32 + 8 * g + 4 * hi) = b;
    }
}

struct Ctx { LAS unsigned char* lds; int tid, lane, wave, r32, hi, G, bx; u16* proj; u16* obuf; u16* vt; };

__device__ __forceinline__ void moba_unit(const Ctx& C0, KParamsPtr P, int b, int h, int qb) {
    Ctx C = C0; C.lane = lane_opaque(); C.tid = C.wave * 64 + C.lane; C.r32 = C.lane & 31; C.hi = C.lane >> 5;
    const int q0w = __builtin_amdgcn_readfirstlane(qb * 256 + C.wave * 32); const int qpos = q0w + C.r32; const size_t tok = (size_t)b * SEQ + qpos;
    build_lut(C.lds, P->rel_bias, h, false, C.tid);
    const u16* qrow = C.proj + tok * PW + C_MQ + h * 64;
    bf16x8 qr[4]; load_q(qr, qrow, C.hi);
    unsigned mask = 0;
    if (qb > 0) {
        float g[7];
#pragma unroll
        for (int j = 0; j < 7; ++j) g[j] = 0.f;
        const float* km = (const float*)(P->ws + WS_KMEAN) + (size_t)((b * 4 + h) * 8) * 64;
#pragma unroll
        for (int dc = 0; dc < 8; ++dc) {
            const u32x4 qv = *(const u32x4*)(qrow + dc * 8);
            float qf[8]; qf[0] = bf2f(qv.x & 0xffffu); qf[1] = bf2f(qv.x >> 16); qf[2] = bf2f(qv.y & 0xffffu); qf[3] = bf2f(qv.y >> 16);
            qf[4] = bf2f(qv.z & 0xffffu); qf[5] = bf2f(qv.z >> 16); qf[6] = bf2f(qv.w & 0xffffu); qf[7] = bf2f(qv.w >> 16);
#pragma unroll
            for (int j = 0; j < 7; ++j) if (j < qb) { const float* kmj = km + j * 64 + dc * 8;
#pragma unroll
                for (int e = 0; e < 8; ++e) g[j] = fmaf(qf[e], kmj[e], g[j]); }
        }
#pragma unroll
        for (int j = 0; j < 7; ++j) if (j < qb) { int rank = 0;
#pragma unroll
            for (int i = 0; i < 7; ++i) if (i != j && i < qb) rank += (g[i] > g[j] || (g[i] == g[j] && i < j)) ? 1 : 0;
            if (rank < 3) mask |= 1u << j; }
    }
    AState A; astate_init(A);
    const float c31 = P->rel_bias[31 * 16 + h] * LOG2E;
    run_tiles<0, 4, false, 1>(C.lds, 0, 4 * qb + 3, C.proj + (size_t)b * SEQ * PW + C_MK + h * 64, C.proj + (size_t)b * SEQ * PW + C_MV + h * 64, qr, c31, q0w, mask, qb, A, C.wave, C.lane, C.r32, C.hi);
    const float inv = rcpf_(xhalf_sum(A.l));
    A.o0 *= inv; A.o1 *= inv;
    { const int l2 = lane_opaque(); const size_t tok2 = (size_t)b * SEQ + q0w + (l2 & 31);
      store_o(C.obuf + tok2 * DM + h * 64, A.o0, A.o1, l2 >> 5); }
}

__device__ __forceinline__ void diff_unit(const Ctx& C0, KParamsPtr P, int layer, int b, int h, int qb) {
    Ctx C = C0; C.lane = lane_opaque(); C.tid = C.wave * 64 + C.lane; C.r32 = C.lane & 31; C.hi = C.lane >> 5;
    const int q0w = __builtin_amdgcn_readfirstlane(qb * 256 + C.wave * 32); const int qpos = q0w + C.r32; const size_t tok = (size_t)b * SEQ + qpos;
    build_lut(C.lds, P->rel_bias, 4 + h, false, C.tid);
    bf16x8 qr[4]; load_q(qr, C.proj + tok * PW + C_DQ + h * 64, C.hi);
    AState A; astate_init(A);
    const float c31 = P->rel_bias[31 * 16 + 4 + h] * LOG2E;
    const u16* Kg = C.proj + (size_t)b * SEQ * PW + C_DK + h * 64; const u16* Vg = C.proj + (size_t)b * SEQ * PW + C_DV + h * 64;
    run_tiles<0, 2, false, 0>(C.lds, 0, 4 * qb + 3, Kg, Vg, qr, c31, q0w, 0u, 0, A, C.wave, C.lane, C.r32, C.hi);
    LAS float* park = (LAS float*)(C.lds + ATT_PARK) + C.tid;
    { const float i0 = rcpf_(xhalf_sum(A.l));
#pragma unroll
      for (int r = 0; r < 16; ++r) { park[r * 512] = A.o0[r] * i0; park[(16 + r) * 512] = A.o1[r] * i0; } }
    astate_init(A);
    run_tiles<2, 2, false, 0>(C.lds, 0, 4 * qb + 3, Kg, Vg, qr, c31, q0w, 0u, 0, A, C.wave, C.lane, C.r32, C.hi);
    const float* lp = P->diff_lambda + (size_t)layer * 128; float d01 = 0.f, d23 = 0.f;
    for (int i = 0; i < 32; ++i) { d01 = fmaf(lp[i], lp[32 + i], d01); d23 = fmaf(lp[64 + i], lp[96 + i], d23); }
    const float li = P->lam_init[layer]; const float lam = expf(d01) - expf(d23) + li;
    const float i1 = lam * rcpf_(xhalf_sum(A.l));
    float ss = 0.f;
#pragma unroll
    for (int r = 0; r < 16; ++r) { A.o0[r] = park[r * 512] - A.o0[r] * i1; A.o1[r] = park[(16 + r) * 512] - A.o1[r] * i1; ss += A.o0[r] * A.o0[r] + A.o1[r] * A.o1[r]; }
    ss = xhalf_sum(ss);
    const float rstd = (1.0f / sqrtf(ss * (1.0f / 64.0f) + 1e-6f)) * (1.0f - li);
    const float* sg = P->diff_subln + (size_t)layer * 64;
#pragma unroll
    for (int r = 0; r < 16; ++r) { const int d = crow(r, C.hi); A.o0[r] *= rstd * sg[d]; A.o1[r] *= rstd * sg[32 + d]; }
    { const int l2 = lane_opaque(); const size_t tok2 = (size_t)b * SEQ + q0w + (l2 & 31);
      store_o(C.obuf + tok2 * DM + 256 + h * 64, A.o0, A.o1, l2 >> 5); }
}

__device__ __forceinline__ void nsa_unit(const Ctx& C0, KParamsPtr P, int b, int hq, int qb) {
    Ctx C = C0; C.lane = lane_opaque(); C.tid = C.wave * 64 + C.lane; C.r32 = C.lane & 31; C.hi = C.lane >> 5;
    const int g = hq >> 2;
    const int q0w = __builtin_amdgcn_readfirstlane(qb * 256 + C.wave * 32); const int qpos = q0w + C.r32; const size_t tok = (size_t)b * SEQ + qpos;
    build_lut(C.lds, P->rel_bias, 8 + hq, false, C.tid);
    bf16x8 qr[4]; load_q(qr, C.proj + tok * PW + C_NQ + hq * 64, C.hi);
    const u16* gl = C.proj + tok * PW + C_NG + hq * 3;
    const float g1 = sigmoid_f(bf2f(gl[1])), g2 = sigmoid_f(bf2f(gl[2]));
    const unsigned mask = ((const unsigned*)(P->ws + WS_SEL))[(size_t)(b * 2 + g) * SEQ + qpos];
    const float c31 = P->rel_bias[31 * 16 + 8 + hq] * LOG2E;
    AState A; astate_init(A);
    run_tiles<0, 4, false, 2>(C.lds, 0, 4 * qb + 3, C.proj + (size_t)b * SEQ * PW + C_NKS + g * 64, C.proj + (size_t)b * SEQ * PW + C_NVS + g * 64, qr, c31, q0w, mask, qb, A, C.wave, C.lane, C.r32, C.hi);
    LAS float* park = (LAS float*)(C.lds + ATT_PARK) + C.tid;
    { const float f = g1 * rcpf_(xhalf_sum(A.l));
#pragma unroll
      for (int r = 0; r < 16; ++r) { park[r * 512] = A.o0[r] * f; park[(16 + r) * 512] = A.o1[r] * f; } }
    if (C.tid < 96) ((LAS float*)(C.lds + ATT_LUT))[608 + C.tid] = NEGF;
    astate_init(A);
    const int tw0 = 4 * qb - 8 < 0 ? 0 : 4 * qb - 8;
    run_tiles<0, 4, true, 0>(C.lds, tw0, 4 * qb + 3, C.proj + (size_t)b * SEQ * PW + C_NKW + g * 64, C.proj + (size_t)b * SEQ * PW + C_NVW + g * 64, qr, c31, q0w, 0u, qb, A, C.wave, C.lane, C.r32, C.hi);
    { const float f = g2 * rcpf_(xhalf_sum(A.l));
#pragma unroll
      for (int r = 0; r < 16; ++r) { A.o0[r] = A.o0[r] * f + park[r * 512]; A.o1[r] = A.o1[r] * f + park[(16 + r) * 512]; } }
    const int l2 = lane_opaque(); const int hi2 = l2 >> 5;
    u16* dst = C.obuf + ((size_t)b * SEQ + q0w + (l2 & 31)) * DM + 512 + hq * 64;
#pragma unroll
    for (int gg = 0; gg < 4; ++gg) {
        const u32x2 a = *(const u32x2*)(dst + 8 * gg + 4 * hi2), bq = *(const u32x2*)(dst + 32 + 8 * gg + 4 * hi2);
        A.o0[4 * gg] += bf2f(a.x & 0xffffu); A.o0[4 * gg + 1] += bf2f(a.x >> 16); A.o0[4 * gg + 2] += bf2f(a.y & 0xffffu); A.o0[4 * gg + 3] += bf2f(a.y >> 16);
        A.o1[4 * gg] += bf2f(bq.x & 0xffffu); A.o1[4 * gg + 1] += bf2f(bq.x >> 16); A.o1[4 * gg + 2] += bf2f(bq.y & 0xffffu); A.o1[4 * gg + 3] += bf2f(bq.y >> 16);
    }
    store_o(dst, A.o0, A.o1, hi2);
}

__device__ __forceinline__ void cmp_unit(const Ctx& C0, KParamsPtr P, int b, int g, int qblk) {
    Ctx C = C0; C.lane = lane_opaque(); C.tid = C.wave * 64 + C.lane; C.r32 = C.lane & 31; C.hi = C.lane >> 5;
    LAS unsigned char* lds = C.lds; const int tid = C.tid, r32 = C.r32, hi = C.hi;
    const u16* kc = (const u16*)(P->ws + WS_KCMP) + (size_t)(b * 2 + g) * 128 * 64;
    const u16* vc = (const u16*)(P->ws + WS_VCMPT) + (size_t)(b * 2 + g) * 64 * 128;
#pragma unroll
    for (int i = 0; i < 2; ++i) { const int e = tid + 512 * i;
        { const int row = e >> 3, ch = e & 7; *(LAS u32x4*)(lds + CMP_K + row * 144 + ch * 16) = *(const u32x4*)(kc + row * 64 + ch * 8); }
        { const int row = e >> 4, ch = e & 15; *(LAS u32x4*)(lds + CMP_V + row * 272 + ch * 16) = *(const u32x4*)(vc + row * 128 + ch * 8); } }
    const int q0w = __builtin_amdgcn_readfirstlane(qblk * 256 + C.wave * 32); const int qpos = q0w + r32; const size_t tok = (size_t)b * SEQ + qpos;
    const int nmax = (qpos - 31) >> 4;
    __syncthreads();
    float qa[16], qh[16];
#pragma unroll
    for (int i = 0; i < 16; ++i) { qa[i] = 0.f; qh[i] = 0.f; }
    const LAS unsigned char* kp = lds + CMP_K + r32 * 144 + hi * 16;
    const LAS unsigned char* vp = lds + CMP_V + r32 * 272 + hi * 16;
    bf16x8 qn[4]; load_q(qn, C.proj + tok * PW + C_NQ + g * 4 * 64, hi);
    for (int rh = 0; rh < 4; ++rh) {
        const int hq = g * 4 + rh;
        bf16x8 qr[4];
#pragma unroll
        for (int ks = 0; ks < 4; ++ks) qr[ks] = qn[ks];
        load_q(qn, C.proj + tok * PW + C_NQ + (g * 4 + (rh < 3 ? rh + 1 : rh)) * 64, hi);
        const float g0 = sigmoid_f(bf2f(C.proj[tok * PW + C_NG + hq * 3]));
        f32x16 s[4];
#pragma unroll
        for (int kb = 0; kb < 4; ++kb) {
#pragma unroll
            for (int r = 0; r < 16; ++r) s[kb][r] = 0.f;
#pragma unroll
            for (int ks = 0; ks < 4; ++ks) { const bf16x8 a = *(const LAS bf16x8*)(kp + kb * 32 * 144 + ks * 32); s[kb] = __builtin_amdgcn_mfma_f32_32x32x16_bf16(a, qr[ks], s[kb], 0, 0, 0); }
        }
        float mx = NEGF;
#pragma unroll
        for (int kb = 0; kb < 4; ++kb)
#pragma unroll
            for (int r = 0; r < 16; ++r) { const int n = 32 * kb + crow(r, hi); const float v = (n <= nmax) ? s[kb][r] : NEGF; s[kb][r] = v; mx = fmaxf(mx, v); }
        mx = xhalf_max(mx);
        float sum = 0.f;
#pragma unroll
        for (int kb = 0; kb < 4; ++kb)
#pragma unroll
            for (int r = 0; r < 16; ++r) { const int n = 32 * kb + crow(r, hi); const float pv = (n <= nmax) ? ex2(s[kb][r] - mx) : 0.f; s[kb][r] = pv; sum += pv; }
        sum = xhalf_sum(sum);
        const float inv = nmax >= 0 ? rcpf_(sum) : 0.f;
        f32x16 o0, o1;
#pragma unroll
        for (int r = 0; r < 16; ++r) { o0[r] = 0.f; o1[r] = 0.f; }
#pragma unroll
        for (int kb = 0; kb < 4; ++kb) {
#pragma unroll
            for (int r = 0; r < 16; ++r) s[kb][r] *= inv;
#pragma unroll
            for (int g4 = 0; g4 < 4; ++g4) { const float h = 0.5f * s[kb][4 * g4 + 3]; qh[kb * 4 + g4] += h; qa[kb * 4 + g4] += (s[kb][4 * g4] + s[kb][4 * g4 + 1]) + (s[kb][4 * g4 + 2] + h); }
#pragma unroll
            for (int c = 0; c < 2; ++c) {
                const u32x4 pk = (u32x4){pkbf(s[kb][8 * c], s[kb][8 * c + 1]), pkbf(s[kb][8 * c + 2], s[kb][8 * c + 3]), pkbf(s[kb][8 * c + 4], s[kb][8 * c + 5]), pkbf(s[kb][8 * c + 6], s[kb][8 * c + 7])};
                const bf16x8 pb = __builtin_bit_cast(bf16x8, pk);
                const bf16x8 v0 = *(const LAS bf16x8*)(vp + (kb * 2 + c) * 32);
                const bf16x8 v1 = *(const LAS bf16x8*)(vp + 32 * 272 + (kb * 2 + c) * 32);
                o0 = __builtin_amdgcn_mfma_f32_32x32x16_bf16(v0, pb, o0, 0, 0, 0);
                o1 = __builtin_amdgcn_mfma_f32_32x32x16_bf16(v1, pb, o1, 0, 0, 0);
            }
            __builtin_amdgcn_sched_barrier(0);
        }
        o0 *= g0; o1 *= g0;
        store_o(C.obuf + tok * DM + 512 + hq * 64, o0, o1, hi);
    }
    LAS float* Aq = (LAS float*)(lds + CMP_A) + (C.wave * 32 + r32) * 33; LAS float* Hq = (LAS float*)(lds + CMP_H) + (C.wave * 32 + r32) * 33;
#pragma unroll
    for (int kb = 0; kb < 4; ++kb)
#pragma unroll
        for (int g4 = 0; g4 < 4; ++g4) { const int j = 8 * kb + 2 * g4 + hi; Aq[j] = qa[kb * 4 + g4]; Hq[j] = qh[kb * 4 + g4]; }
    __syncthreads();
    const int cur = q0w >> 6;
    unsigned bits = 0;
    if (cur < 16) bits = (2u << cur) - 1u;
    else {
        float sc[32];
#pragma unroll
        for (int i = 0; i < 32; ++i) { const float imp = Aq[i] + (i > 0 ? Hq[i - 1] : 0.f); sc[i] = (i > cur) ? -3.0e38f : ((i == 0 || i > cur - 2) ? 1e4f : imp); }
#pragma unroll
        for (int e = 0; e < 16; ++e) {
            const float sj = hi ? sc[16 + e] : sc[e]; int rank = 0;
#pragma unroll
            for (int i = 0; i < 32; ++i) { const bool lt = (i < e) || (hi && i < 16 + e);
                rank += (sc[i] > sj || (sc[i] == sj && lt)) ? 1 : 0; }
            const int j = hi * 16 + e;
            if (j <= cur && rank < 16) bits |= 1u << j; }
        { auto rr = __builtin_amdgcn_permlane32_swap(bits, bits, false, false); bits = rr[0] | rr[1]; }
    }
    if (hi == 0) ((unsigned*)(P->ws + WS_SEL))[(size_t)(b * 2 + g) * SEQ + qpos] = bits;
    __syncthreads();
}

__device__ __forceinline__ void prep_vk(const Ctx& C, KParamsPtr P, int b0) {
    (void)b0; const int lane = C.lane, qd = C.wave & 3; LAS float* part = (LAS float*)C.lds;
    for (int base = C.bx * 2; base < NB * 4 * 8; base += C.G * 2) {
        const int it = base + (C.wave >> 2), blk = it & 7, h = (it >> 3) & 3, b = it >> 5;
        const u16* kp = C.proj + ((size_t)b * SEQ + blk * 256 + qd * 64) * PW + C_MK + h * 64 + lane; float s = 0.f;
        for (int k = 0; k < 64; k += 16) { float t[16];
#pragma unroll
            for (int e = 0; e < 16; ++e) t[e] = bf2f(kp[(size_t)(k + e) * PW]);
            s += (((t[0] + t[1]) + (t[2] + t[3])) + ((t[4] + t[5]) + (t[6] + t[7]))) + (((t[8] + t[9]) + (t[10] + t[11])) + ((t[12] + t[13]) + (t[14] + t[15]))); }
        part[C.wave * 64 + lane] = s;
        __syncthreads();
        if (qd == 0) ((float*)(P->ws + WS_KMEAN))[(size_t)it * 64 + lane] = ((part[C.wave * 64 + lane] + part[(C.wave + 1) * 64 + lane]) + (part[(C.wave + 2) * 64 + lane] + part[(C.wave + 3) * 64 + lane])) * (1.0f / 256.0f);
        __syncthreads();
    }
}
__device__ __forceinline__ void prep_a(const Ctx& C, KParamsPtr P, int layer) {
    const int G = C.G, lane = C.lane;
    const int gw = C.bx * 8 + C.wave, NGW = G * 8;
    u16* acmp = (u16*)(P->ws + WS_VT);
    for (int it = gw; it < 2 * 4096; it += NGW) {
        const int i = it >> 12, row = it & 4095, n = row & 127, bg = row >> 7, b = bg >> 1, g = bg & 1;
        u16* dst = acmp + (size_t)it * 2048; const float* pe = P->cmp_pe + (size_t)(layer * 2 + i) * 2048;
        const int col = (i == 0 ? C_NKC : C_NVC) + g * 64;
#pragma unroll
        for (int pass = 0; pass < 4; ++pass) { const int l = pass * 8 + (lane >> 3), d0 = (lane & 7) * 8;
            unsigned z0 = 0u; asm volatile("" : "+v"(z0)); u32x4 o = (u32x4){z0, z0, z0, z0};
            if (n < 127) { const u32x4 v = *(const u32x4*)(C.proj + ((size_t)b * SEQ + 16 * n + l) * PW + col + d0); const f32x4 e0 = *(const f32x4*)(pe + l * 64 + d0), e1 = *(const f32x4*)(pe + l * 64 + d0 + 4);
                o.x = pkbf(bf2f(v.x & 0xffffu) + e0.x, bf2f(v.x >> 16) + e0.y); o.y = pkbf(bf2f(v.y & 0xffffu) + e0.z, bf2f(v.y >> 16) + e0.w);
                o.z = pkbf(bf2f(v.z & 0xffffu) + e1.x, bf2f(v.z >> 16) + e1.y); o.w = pkbf(bf2f(v.w & 0xffffu) + e1.z, bf2f(v.w >> 16) + e1.w); }
            *(u32x4*)(dst + l * 64 + d0) = o; }
    }
}
__device__ __forceinline__ void prep_c(const Ctx& C, KParamsPtr P, int layer, int it0) {
    const int i = it0 >> 12, row0 = it0 & 4095, lane = lane_opaque(), tid = C.wave * 64 + lane, r32 = lane & 31, hi = lane >> 5;
    const float* w2 = P->cmp_w2 + (size_t)(layer * 2 + i) * 256 * 64;
    for (int e = tid; e < 256 * 64; e += 512) { const int k = e >> 6, c = e & 63; *(LAS u16*)(C.lds + c * 528 + k * 2) = (u16)(pkbf(w2[e], 0.f) & 0xffffu); }
    __syncthreads();
    const int wrow = row0 + C.wave * 32;
    const u16* hrow = (const u16*)(P->ws + WS_HID) + ((size_t)i * 4096 + wrow + r32) * 256 + hi * 8;
    f32x16 d0, d1;
#pragma unroll
    for (int r = 0; r < 16; ++r) { d0[r] = 0.f; d1[r] = 0.f; }
#pragma unroll 4
    for (int ks = 0; ks < 16; ++ks) {
        const bf16x8 a = *(const bf16x8*)(hrow + ks * 16);
        const bf16x8 b0 = *(const LAS bf16x8*)(C.lds + r32 * 528 + (ks * 16 + hi * 8) * 2);
        const bf16x8 b1 = *(const LAS bf16x8*)(C.lds + (32 + r32) * 528 + (ks * 16 + hi * 8) * 2);
        d0 = __builtin_amdgcn_mfma_f32_32x32x16_bf16(a, b0, d0, 0, 0, 0);
        d1 = __builtin_amdgcn_mfma_f32_32x32x16_bf16(a, b1, d1, 0, 0, 0);
    }
#pragma unroll
    for (int r = 0; r < 16; ++r) { const int row = wrow + crow(r, hi);
        const unsigned v0 = pkbf(d0[r], 0.f) & 0xffffu, v1 = pkbf(d1[r], 0.f) & 0xffffu;
        if (i == 0) { u16* o = (u16*)(P->ws + WS_KCMP) + (size_t)row * 64; o[r32] = (u16)v0; o[32 + r32] = (u16)v1; }
        else { const int bg = row >> 7, n = row & 127; u16* o = (u16*)(P->ws + WS_VCMPT) + (size_t)bg * 64 * 128 + (n & ~15) + pperm(n & 15); o[(size_t)r32 * 128] = (u16)v0; o[(size_t)(32 + r32) * 128] = (u16)v1; }
    }
}

__device__ __forceinline__ void convert_weights(const Ctx& C, KParamsPtr P, int layer) {
    LAS float* scr = (LAS float*)(C.lds + C.wave * 16384);
    const int gw = C.bx * 8 + C.wave, NGW = C.G * 8, lane = C.lane;
    constexpr int I_G = 16 * 88, I_D = 44 * 32, I_IN = 16 * 96, I_O = 16 * 32, I_W1 = 32 * 8;
    constexpr int NIT = 4 * I_G + 2 * I_D + I_IN + I_O + 2 * I_W1;
    unsigned char* ws = P->ws;
    for (int it = gw; it < NIT; it += NGW) {
        int r = it;
        if (r < 4 * I_G) { const int which = r / I_G; r -= which * I_G; const int kb = r / 88, nb = r % 88, n0 = nb * 32;
            const float* W = (which == 0 ? P->ffn1_gate : which == 1 ? P->ffn1_up : which == 2 ? P->ffn2_gate : P->ffn2_up) + (size_t)layer * DM * DFF;
            u16* WT = (u16*)(ws + (which < 2 ? WS_GU1 : WS_GU2));
            tr_item(W, DM, DFF, WT, kb, n0, (n0 >> 7) * 256 + (which & 1) * 128 + (n0 & 127), scr, lane, 1.0f, (which < 2 ? P->norm_ffn1 : P->norm_ffn2) + (size_t)layer * DM); continue; }
        r -= 4 * I_G;
        if (r < 2 * I_D) { const int which = r / I_D; r -= which * I_D; const int kb = r / 32, nb = r % 32;
            const float* W = (which == 0 ? P->ffn1_down : P->ffn2_down) + (size_t)layer * DFF * DM;
            tr_item(W, DFF, DM, (u16*)(ws + (which == 0 ? WS_DN1 : WS_DN2)), kb, nb * 32, nb * 32, scr, lane); continue; }
        r -= 2 * I_D;
        if (r < I_IN) { const int kb = r / 96, nb = r % 96, n0 = nb * 32;
            const float cs = (n0 < C_MK || (n0 >= C_NQ && n0 < C_NKC)) ? 0.125f * LOG2E : (n0 >= C_DQ && n0 < C_DK) ? 0.17677669529663687f * LOG2E : 1.0f;
            tr_item(P->w_in + (size_t)layer * DM * INW, DM, INW, (u16*)(ws + WS_WIN), kb, n0, n0, scr, lane, cs, P->norm_mix + (size_t)layer * DM); continue; }
        r -= I_IN;
        if (r < I_O) { const int kb = r / 32, nb = r % 32; tr_item(P->w_out + (size_t)layer * DM * DM, DM, DM, (u16*)(ws + WS_WOUT), kb, nb * 32, nb * 32, scr, lane); continue; }
        r -= I_O;
        { const int i = r / I_W1; r -= i * I_W1; const int kb = r / 8, nb = r % 8;
            tr_item(P->cmp_w1 + (size_t)(layer * 2 + i) * 2048 * 256, 2048, 256, (u16*)(ws + WS_W1) + (size_t)i * 256 * 2048, kb, nb * 32, nb * 32, scr, lane); }
    }
}
__device__ __forceinline__ void norm_phase(const Ctx& C, const float* src32, const u16* src16, const float* g, u16* dst16, float* dst32, u16* xb0) {
    const int gw = C.bx * 8 + C.wave, NGW = C.G * 8;
    for (int m = gw; m < MTOK; m += NGW) norm_row(src32 ? src32 + (size_t)m * DM : nullptr, src16 ? src16 + (size_t)m * DM : nullptr, g, dst16 ? dst16 + (size_t)m * DM : nullptr, dst32 ? dst32 + (size_t)m * DM : nullptr, xb0 ? xb0 + (size_t)m * DM : nullptr, C.lane);
}

#define XB_TMO      128
#define XB_XCNT(j)  (256  + 64 * (j))
#define XB_XSUB(j)  (1280 + 64 * (j))
#define XB_XGEN(j)  (2304 + 64 * (j))
#define XB_TOP      3328
#define XB_TOPGEN   3392
#define XCD_BAR_WORDS 3456
#define XB_SPIN_CAP (1u << 18)

__device__ __forceinline__ unsigned xb_ld(unsigned* p)              { return __hip_atomic_load(p, __ATOMIC_RELAXED, __HIP_MEMORY_SCOPE_AGENT); }
__device__ __forceinline__ unsigned xb_add(unsigned* p, unsigned v) { return __hip_atomic_fetch_add(p, v, __ATOMIC_RELAXED, __HIP_MEMORY_SCOPE_AGENT); }
__device__ __forceinline__ unsigned xb_xcc_id() { return (unsigned)__builtin_amdgcn_s_getreg((3 << 11) | 20) & 0xFu; }
#define XB_SPIN(cond, bar) do { unsigned _sp = 0; while (cond) { __builtin_amdgcn_s_sleep(1); \
    if ((++_sp & 255u) == 0u) { if (xb_ld(&(bar)[XB_TMO])) break; if (_sp > XB_SPIN_CAP) { atomicAdd(&(bar)[XB_TMO], 1u); break; } } } } while (0)

struct XcdBarrier {
    unsigned* bar; unsigned x;
    volatile LAS unsigned* st;
};

__device__ __forceinline__ XcdBarrier xcd_barrier_post(unsigned* bar, volatile LAS unsigned* st) {
    XcdBarrier b; b.bar = bar; b.x = xb_xcc_id(); b.st = st;
    if (threadIdx.x == 0) (void)xb_add(&bar[XB_XCNT(b.x)], 1u);
    return b;
}
__device__ __forceinline__ void xcd_barrier_complete(unsigned* bar, unsigned x, unsigned& nloc, unsigned& nx) {
    const unsigned G = gridDim.x * gridDim.y * gridDim.z;
    unsigned sum, cnt, mine, sp = 0u;
    for (;;) {
        sum = 0u; cnt = 0u; mine = 0u;
#pragma unroll
        for (unsigned j = 0; j < 16; ++j) { const unsigned c = xb_ld(&bar[XB_XCNT(j)]); sum += c; cnt += (c > 0u) ? 1u : 0u; mine = (j == x) ? c : mine; }
        if (sum == G) break;
        __builtin_amdgcn_s_sleep(1);
        if ((++sp & 255u) == 0u) { if (xb_ld(&bar[XB_TMO])) break; if (sp > XB_SPIN_CAP) { atomicAdd(&bar[XB_TMO], 1u); break; } }
    }
    nloc = mine > 0u ? mine : 1u; nx = cnt > 0u ? cnt : 1u;
}

__device__ __forceinline__ void xcd_barrier(const XcdBarrier& b) {
    asm volatile("s_waitcnt vmcnt(0)" ::: "memory");
    __syncthreads();
    if (threadIdx.x == 0) {
        unsigned* bar = b.bar;
        __builtin_amdgcn_s_waitcnt(0);
        unsigned nloc = b.st[0], nx = b.st[1];
        if (nloc == 0u) { xcd_barrier_complete(bar, b.x, nloc, nx); b.st[0] = nloc; b.st[1] = nx; }
        const unsigned old = xb_add(&bar[XB_XSUB(b.x)], 1u);
        const unsigned gen = old / nloc;
        if (old + 1u == (gen + 1u) * nloc) {
            __builtin_amdgcn_fence(__ATOMIC_RELEASE, "agent");
            asm volatile("s_waitcnt vmcnt(0)" ::: "memory");
            const unsigned og = xb_add(&bar[XB_TOP], 1u);
            const unsigned tg = og / nx;
            if (og + 1u == (tg + 1u) * nx) xb_add(&bar[XB_TOPGEN], 1u);
            else XB_SPIN(xb_ld(&bar[XB_TOPGEN]) == tg, bar);
            __builtin_amdgcn_fence(__ATOMIC_ACQUIRE, "agent");
            xb_add(&bar[XB_XGEN(b.x)], 1u);
            asm volatile("s_waitcnt vmcnt(0)" ::: "memory");
        } else {
            XB_SPIN(xb_ld(&bar[XB_XGEN(b.x)]) == gen, bar);
            __builtin_amdgcn_fence(__ATOMIC_ACQUIRE, "agent");
            asm volatile("s_waitcnt vmcnt(0)" ::: "memory");
        }
    }
    __syncthreads();
}


__device__ __forceinline__ void fill_rtab(const Ctx& C, const pg8::StaticOrder& S, const float* SS, LAS float* rtab) {
    LAS int* pml = (LAS int*)(rtab + 11 * 256);
    int nu = 0; { pg8::Unit u_; for (int i_ = 0; i_ < 11 && S.next(i_, u_); ++i_) { if (C.tid == 0) pml[i_] = u_.pm; nu = i_ + 1; } }
    __syncthreads();
    const int tot = nu * 256; float rsv[6];
#pragma unroll
    for (int k = 0; k < 6; ++k) { const int e = C.tid + 512 * k; rsv[k] = e < tot ? pg8::row_rstd(SS, pml[e >> 8] * 256 + (e & 255)) : 0.f; }
#pragma unroll
    for (int k = 0; k < 6; ++k) { const int e = C.tid + 512 * k; if (e < tot) rtab[e] = rsv[k]; }
    __syncthreads();
}
__device__ __forceinline__ void x0_phase(const Ctx& C, const float* src, u16* xb, float* ss) {
    const int gw = C.bx * 8 + C.wave, NGW = C.G * 8, lane = C.lane;
    for (int m = gw; m < MTOK; m += NGW) {
        const f32x4* xr = (const f32x4*)(src + (size_t)m * DM) + lane; float s = 0.f;
#pragma unroll
        for (int j = 0; j < 4; ++j) { const f32x4 v = xr[64 * j]; s += (v.x * v.x + v.y * v.y) + (v.z * v.z + v.w * v.w);
            u32x2 o; o.x = pkbf(v.x, v.y); o.y = pkbf(v.z, v.w); *((u32x2*)(xb + (size_t)m * DM) + lane + 64 * j) = o; }
        s = wave_sum(s, lane);
        if (lane < 16) ss[(size_t)m * 16 + lane] = lane == 0 ? s : 0.f;
    }
}
__device__ __forceinline__ void unit_publish(unsigned* flag, int tid) {
    asm volatile("s_waitcnt vmcnt(0)" ::: "memory"); __syncthreads();
    if (tid == 0) { __builtin_amdgcn_fence(__ATOMIC_RELEASE, "agent"); asm volatile("s_waitcnt vmcnt(0)" ::: "memory"); __hip_atomic_store(flag, 1u, __ATOMIC_RELAXED, __HIP_MEMORY_SCOPE_AGENT); }
}
__device__ __forceinline__ void unit_wait(unsigned* f0, unsigned* f1, int tid) {
    if (tid == 0) { unsigned sp = 0;
        while ((__hip_atomic_load(f0, __ATOMIC_RELAXED, __HIP_MEMORY_SCOPE_AGENT) == 0u || __hip_atomic_load(f1, __ATOMIC_RELAXED, __HIP_MEMORY_SCOPE_AGENT) == 0u) && ++sp < (1u << 24)) __builtin_amdgcn_s_sleep(8);
        __builtin_amdgcn_fence(__ATOMIC_ACQUIRE, "agent"); asm volatile("s_waitcnt vmcnt(0)" ::: "memory"); }
    __syncthreads();
}
struct OneUnit { int pm;
    __device__ __forceinline__ bool next(int i, pg8::Unit& u) const { if (i) return false; u.pm = pm; u.pn = 0; return true; }
    __device__ __forceinline__ void a_ready(const pg8::Unit&) const {}
    __device__ __forceinline__ void done(const pg8::Unit&) const {} };
__global__ void __launch_bounds__(512, 2) hybrid_fwd(Params P0) {
    extern __shared__ __attribute__((aligned(16))) unsigned char lds_raw[];
    const KParamsPtr kp0 = (KParamsPtr)__builtin_amdgcn_kernarg_segment_ptr();
    cg::grid_group grid = cg::this_grid();
    { volatile LAS unsigned* misc = (volatile LAS unsigned*)((LAS unsigned char*)lds_raw + MISC_OFF); if (threadIdx.x < 2) misc[threadIdx.x] = 0u; }
    __syncthreads();
    XcdBarrier bar = xcd_barrier_post((unsigned*)(P0.ws + WS_CTL) + 1024, (volatile LAS unsigned*)((LAS unsigned char*)lds_raw + MISC_OFF));
    const int ph_lo = P0.ph_lo, ph_hi = P0.ph_hi; const int wave_s = __builtin_amdgcn_readfirstlane(threadIdx.x >> 6);
    bool redone = false; (void)redone;
    for (int ph = ph_lo; ph < ph_hi; ++ph) {
        KParamsPtr kpl = kp0; asm volatile("" : "+s"(kpl));
        const KParamsPtr P = kpl; unsigned char* ws = P->ws;
        u16* XN = (u16*)(ws + WS_XN); u16* HB = (u16*)(ws + WS_PROJ);
        int G = gridDim.x, bx = blockIdx.x; asm volatile("" : "+s"(G), "+s"(bx));
        Ctx C; C.G = G; C.bx = bx; C.lds = (LAS unsigned char*)lds_raw; C.wave = wave_s; C.lane = lane_opaque(); C.tid = wave_s * 64 + C.lane; C.r32 = C.lane & 31; C.hi = C.lane >> 5;
        C.proj = (u16*)(ws + WS_PROJ); C.obuf = (u16*)(ws + WS_XN); C.vt = (u16*)(ws + WS_VT);
        const int layer = ph / NPH_L, s = ph % NPH_L;
        if (ph != NPH - 1 && (s == 7 || s == 3 || s == 11 || s == 8 || s == 9)) continue;
        float* SS = (float*)(ws + WS_SS);
        u16* XB = (u16*)(ws + WS_XB);
        if (ph == NPH - 1) { norm_phase(C, nullptr, XB, P->final_norm, nullptr, P->out, nullptr); }
        else switch (s) {
        case 0: { convert_weights(C, P, layer); if (layer == 0) { __syncthreads(); x0_phase(C, P->x, XB, SS); } } break;
#ifndef NO_GEMM
#ifndef NO_G1
        case 1: case 12: {
            pg8::Gemm g{XB, (const u16*)(ws + (s == 1 ? WS_GU1 : WS_GU2)), MTOK, 2 * DFF, DM}; pg8::StaticOrder S; S.init(MTOK, 2 * DFF, G, bx);
            LAS float* rtab = (LAS float*)(C.lds + RTAB_OFF); fill_rtab(C, S, SS, rtab);
            pg8::EpiSwiGLU E{HB, DFF, rtab, 0};
            pg8::gemm_phase<pg8::EpiSwiGLU, pg8::StaticOrder, true, true>(C.lds, g, S, E, C.wave); } break;
#endif
#ifndef NO_G2
        case 2: case 13: case 10: {
            const u16* A = (s == 10) ? (const u16*)XN : (const u16*)HB; const u16* Bt = (const u16*)(ws + (s == 2 ? WS_DN1 : s == 13 ? WS_DN2 : WS_WOUT));
            pg8::Gemm g{A, Bt, MTOK, DM, s == 10 ? DM : DFF}; pg8::StaticOrder S; S.init(MTOK, DM, G, bx);
            pg8::EpiResid E{XB, DM, s == 10 ? 1.0f : 0.5f, SS};
            pg8::gemm_phase<pg8::EpiResid, pg8::StaticOrder, false, true>(C.lds, g, S, E, C.wave); } break;
#endif
#ifndef NO_G4
        case 4: {
            pg8::Gemm g{XB, (const u16*)(ws + WS_WIN), MTOK, PW, DM}; pg8::StaticOrder S; S.init(MTOK, PW, G, bx);
            LAS float* rtab = (LAS float*)(C.lds + RTAB_OFF); fill_rtab(C, S, SS, rtab);
            pg8::EpiBf16<0> E{C.proj, PW, rtab, 0};
            pg8::gemm_phase<pg8::EpiBf16<0>, pg8::StaticOrder, true, true>(C.lds, g, S, E, C.wave); } break;
#endif
#endif
#ifndef NO_PREP
        case 5: prep_a(C, P, layer); prep_vk(C, P, 0); break;
#endif
#if !defined(NO_GEMM) && !defined(NO_G6)
        case 6: {
            unsigned* ctl = (unsigned*)(ws + WS_CTL); unsigned* qctr = ctl + 8192 + 64 * ph + (redone ? 32 : 0); unsigned* fcomp = ctl + 16384 + 64 * ph; unsigned* fcmp = ctl + 24576 + 256 * (ph / NPH_L);
            volatile LAS unsigned* qslot = (volatile LAS unsigned*)(C.lds + MISC_OFF + 16);
            for (;;) {
                if (C.tid == 0) *qslot = __hip_atomic_fetch_add(qctr, 1u, __ATOMIC_RELAXED, __HIP_MEMORY_SCOPE_AGENT);
                __syncthreads();
                const unsigned u = *qslot;
                __syncthreads();
                if (u >= 32u + 512u + 256u + 1024u + 512u) break;
                if (u < 32u) { const int i = (int)u >> 4, tile = (int)u & 15;
                    pg8::Gemm g{(const u16*)(ws + WS_VT) + (size_t)i * 4096 * 2048, (const u16*)(ws + WS_W1) + (size_t)i * 256 * 2048, 4096, 256, 2048}; OneUnit S{tile};
                    pg8::EpiBf16<1> E{(u16*)(ws + WS_HID) + (size_t)i * 4096 * 256, 256, nullptr, 0};
                    pg8::gemm_phase<pg8::EpiBf16<1>, OneUnit, true, true>(C.lds, g, S, E, C.wave);
                    __builtin_amdgcn_fence(__ATOMIC_RELEASE, "agent"); __syncthreads(); __builtin_amdgcn_fence(__ATOMIC_ACQUIRE, "agent");
                    prep_c(C, P, layer, i * 4096 + tile * 256);
                    unit_publish(fcomp + u, C.tid);
                    __syncthreads();
                } else if (u < 544u || u >= 1824u) { const unsigned v = u < 544u ? u - 32u : u - 1824u + 512u; const int qb = 7 - (int)(v >> 7), w = (int)(v & 127);
                    if (w < 64) {
#ifndef NO_DIFF
                        diff_unit(C, P, layer, w >> 2, w & 3, qb);
#endif
                    } else {
#ifndef NO_MOBA
                        moba_unit(C, P, (w - 64) >> 2, w & 3, qb);
#endif
                    }
                } else if (u < 800u) { const int c = (int)u - 544, qblk = 7 - (c >> 5), bg = c & 31;
                    unit_wait(fcomp + (bg >> 1), fcomp + 16 + (bg >> 1), C.tid);
#ifndef NO_CMP
                    cmp_unit(C, P, bg >> 1, bg & 1, qblk);
#endif
                    unit_publish(fcmp + bg * 8 + qblk, C.tid);
                    __syncthreads();
                } else { const int v = (int)u - 800, qb = 7 - (v >> 7), b = (v & 127) >> 3, hq = v & 7; unsigned* f = fcmp + (b * 2 + (hq >> 2)) * 8 + qb;
                    unit_wait(f, f, C.tid);
#ifndef NO_ATT2
                    nsa_unit(C, P, b, hq, qb);
#endif
                }
            } } break;
#endif
        default: break;
        }
        if (ph + 1 < ph_hi) { if (ph == ph_lo) grid.sync(); else xcd_barrier(bar); }
#ifdef PROBE_LO
        if (ph != NPH - 1 && s == PROBE_HI) { if (!redone) { ph -= (PROBE_HI - PROBE_LO + 1); redone = true; } else redone = false; }
#endif
#ifdef PROBE_SYNC
        if (ph + 1 < ph_hi) xcd_barrier(bar);
#endif
    }
}

#ifndef COOP
#define COOP 1
#endif
extern "C" void kernel_launch(void* const* d_in, const int* in_sizes, int n_in, void* d_out, int out_size, void* d_ws, size_t ws_size, hipStream_t stream) {
    static int grid = 0;
    if (grid == 0) {
        if (n_in != 19 || out_size != MTOK * DM || ws_size < WS_END) { fprintf(stderr, "kernel_launch: unexpected shapes (n_in %d out %d ws %zu)\n", n_in, out_size, ws_size); grid = -1; return; }
        int dev = 0, cus = 0, per_cu = 0;
        (void)hipGetDevice(&dev); (void)hipDeviceGetAttribute(&cus, hipDeviceAttributeMultiprocessorCount, dev);
        if (hipFuncSetAttribute((const void*)hybrid_fwd, hipFuncAttributeMaxDynamicSharedMemorySize, LDS_BYTES) != hipSuccess) { fprintf(stderr, "kernel_launch: hipFuncSetAttribute failed\n"); grid = -1; return; }
        if (hipOccupancyMaxActiveBlocksPerMultiprocessor(&per_cu, (const void*)hybrid_fwd, 512, LDS_BYTES) != hipSuccess || per_cu < 1) { fprintf(stderr, "kernel_launch: occupancy query says %d\n", per_cu); per_cu = 1; }
        (void)hipGetLastError();
        grid = cus * per_cu;
    }
    if (grid < 0) return;
    Params p{};
    p.x = (const float*)d_in[0]; p.rel_bias = (const float*)d_in[1]; p.norm_ffn1 = (const float*)d_in[2]; p.ffn1_gate = (const float*)d_in[3]; p.ffn1_up = (const float*)d_in[4]; p.ffn1_down = (const float*)d_in[5];
    p.norm_mix = (const float*)d_in[6]; p.w_in = (const float*)d_in[7]; p.diff_lambda = (const float*)d_in[8]; p.diff_subln = (const float*)d_in[9]; p.cmp_pe = (const float*)d_in[10]; p.cmp_w1 = (const float*)d_in[11];
    p.cmp_w2 = (const float*)d_in[12]; p.w_out = (const float*)d_in[13]; p.norm_ffn2 = (const float*)d_in[14]; p.ffn2_gate = (const float*)d_in[15]; p.ffn2_up = (const float*)d_in[16]; p.ffn2_down = (const float*)d_in[17];
    p.final_norm = (const float*)d_in[18]; p.out = (float*)d_out; p.ws = (unsigned char*)d_ws;
    for (int l = 0; l < 4; ++l) p.lam_init[l] = (float)(0.8 - 0.6 * exp(-0.3 * (double)l));
#if COOP
    if (hipMemsetAsync((char*)d_ws + WS_CTL, 0, CTL_ZERO_BYTES, stream) != hipSuccess) { fprintf(stderr, "kernel_launch: memset of barrier words failed\n"); return; }
    p.ph_lo = 0; p.ph_hi = NPH;
    void* args[] = {&p};
    hipError_t e = hipLaunchCooperativeKernel((const void*)hybrid_fwd, dim3(grid), dim3(512), args, LDS_BYTES, stream);
    if (e != hipSuccess) fprintf(stderr, "cooperative launch failed: %s (grid %d)\n", hipGetErrorString(e), grid);
#else
    for (int ph = 0; ph < NPH; ++ph) { p.ph_lo = ph; p.ph_hi = ph + 1; hipLaunchKernelGGL(hybrid_fwd, dim3(grid), dim3(512), LDS_BYTES, stream, p); }
#endif
}
```

```cpp
#include <hip/hip_runtime.h>
#include <hip/hip_cooperative_groups.h>
#include <cstdio>
#include <cstdint>
#include <cmath>
namespace cg = cooperative_groups;
#define COOP 1
namespace pg8 {
#define PG8_LAS __attribute__((address_space(3)))
typedef unsigned short bf16_t;
typedef short bf16x8 __attribute__((ext_vector_type(8)));
typedef float f32x4 __attribute__((ext_vector_type(4)));
typedef unsigned u32x4 __attribute__((ext_vector_type(4)));
constexpr int BM = 256, BK = 64, HALF = 128, HTB = HALF * BK * 2  , STAGE_BYTES = 8 * HTB, NXCD = 8, WGM = 8;

__host__ __device__ __forceinline__ int lds_byte(int r, int c) { const int st = (r >> 4) * 2 + (c >> 5), rr = r & 15, cc = c & 31, ob = rr * 64 + cc * 2; return st * 1024 + (ob ^ (((ob >> 9) & 1) << 5)); }
__host__ __device__ __forceinline__ void stage_rc(int b, int& R, int& C) { const int st = b / 1024, sb = b % 1024, swz = sb ^ (((sb >> 9) & 1) << 5); R = (st >> 1) * 16 + swz / 64; C = (st & 1) * 32 + (swz % 64) / 2; }
__host__ __device__ __forceinline__ int perm32(int rho) { const int n = rho >> 4, i = rho & 15; return 8 * (i >> 2) + 4 * n + (i & 3); }

struct Unit { int pm, pn; };
struct Gemm { const bf16_t* A; const bf16_t* Bt; int M, N, K; };

struct StaticOrder {
    int nM, nN, nwg, G, c;
    __host__ __device__ void init(int M, int N, int G_, int c_) { nM = M / BM; nN = N / BM; nwg = nM * nN; G = G_; c = c_; }
    __host__ __device__ bool next(int i, Unit& u) const {
        const long L = (long)i * G + c; if (L >= nwg) return false;
        int wgid = (int)L; { const int q = nwg / NXCD, r = nwg % NXCD, xcd = wgid % NXCD, off = wgid / NXCD; wgid = (xcd < r ? xcd * (q + 1) : r * (q + 1) + (xcd - r) * q) + off; }
        const int nig = WGM * nN, gid = wgid / nig, fm = gid * WGM, gsz = (nM - fm) < WGM ? (nM - fm) : WGM;
        u.pm = fm + ((wgid % nig) % gsz); u.pn = (wgid % nig) / gsz; return true;
    }
    __device__ __forceinline__ void a_ready(const Unit&) const {}
    __device__ __forceinline__ void done(const Unit&) const {}
};

__device__ __forceinline__ unsigned cvt_pk_bf16(float lo, float hi) { unsigned r; asm volatile("v_cvt_pk_bf16_f32 %0, %1, %2" : "=v"(r) : "v"(lo), "v"(hi)); return r; }

__device__ __forceinline__ float ex2(float x) { return __builtin_amdgcn_exp2f(x); }
__device__ __forceinline__ float rcpf_(float x) { return __builtin_amdgcn_rcpf(x); }
__device__ __forceinline__ float silu_f(float x) { return x * rcpf_(1.0f + ex2(-1.4426950408889634f * x)); }
__device__ __forceinline__ float gelu_tanh_f(float x) { const float y2 = 2.0f * 0.7978845608028654f * (x + 0.044715f * x * x * x); return x * (1.0f - rcpf_(1.0f + ex2(1.4426950408889634f * y2))); }

__device__ __forceinline__ float row_rstd(const float* ss, int row) {
    const f32x4* p = (const f32x4*)(ss + (size_t)row * 16); const f32x4 a = p[0], b = p[1], c = p[2], d = p[3];
    const float s = ((a[0] + a[1]) + (a[2] + a[3])) + ((b[0] + b[1]) + (b[2] + b[3])) + ((c[0] + c[1]) + (c[2] + c[3])) + ((d[0] + d[1]) + (d[2] + d[3]));
    return 1.0f / sqrtf(s * (1.0f / 1024.0f) + 1e-6f);
}

struct EpiSwiGLU {
    static constexpr bool PERM = true, AFTER_DRAIN = false;
    bf16_t* O; int ldc; const PG8_LAS float* rtab; mutable int ui;
    __device__ __forceinline__ void operator()(const f32x4 (&acc)[2][2][4][2], const Unit& u, int wr, int wc, int fr, int fq) const {
        const int row0 = u.pm * BM + wr * 64 + fr; const int col0 = u.pn * HALF + wc * 32 + 8 * fq;
#pragma unroll
        for (int ai = 0; ai < 2; ++ai)
#pragma unroll
            for (int m = 0; m < 4; ++m) { bf16_t* rowp = O + (size_t)(row0 + ai * HALF + m * 16) * ldc + col0;
                const float rs = rtab[ui * 256 + wr * 64 + fr + ai * HALF + m * 16];
                const f32x4 g0 = acc[ai][0][m][0] * rs, g1 = acc[ai][0][m][1] * rs, u0 = acc[ai][1][m][0] * rs, u1 = acc[ai][1][m][1] * rs;
                u32x4 w; w.x = cvt_pk_bf16(silu_f(g0[0]) * u0[0], silu_f(g0[1]) * u0[1]); w.y = cvt_pk_bf16(silu_f(g0[2]) * u0[2], silu_f(g0[3]) * u0[3]);
                w.z = cvt_pk_bf16(silu_f(g1[0]) * u1[0], silu_f(g1[1]) * u1[1]); w.w = cvt_pk_bf16(silu_f(g1[2]) * u1[2], silu_f(g1[3]) * u1[3]);
                *(u32x4*)rowp = w; asm volatile("" ::: "memory"); }
        ++ui;
    }
};
template <int ACT> struct EpiBf16 {
    static constexpr bool PERM = true, AFTER_DRAIN = false;
    bf16_t* O; int ldc; const PG8_LAS float* rtab; mutable int ui;
    __device__ __forceinline__ void operator()(const f32x4 (&acc)[2][2][4][2], const Unit& u, int wr, int wc, int fr, int fq) const {
        const int row0 = u.pm * BM + wr * 64 + fr; const int col0 = u.pn * BM + wc * 32 + 8 * fq;
#pragma unroll
        for (int ai = 0; ai < 2; ++ai)
#pragma unroll
            for (int m = 0; m < 4; ++m) { bf16_t* rowp = O + (size_t)(row0 + ai * HALF + m * 16) * ldc + col0;
                const float rs = rtab ? rtab[ui * 256 + wr * 64 + fr + ai * HALF + m * 16] : 1.0f;
#pragma unroll
                for (int bj = 0; bj < 2; ++bj) { f32x4 v0 = acc[ai][bj][m][0] * rs, v1 = acc[ai][bj][m][1] * rs;
                    if (ACT == 1) { v0 = (f32x4){gelu_tanh_f(v0[0]), gelu_tanh_f(v0[1]), gelu_tanh_f(v0[2]), gelu_tanh_f(v0[3])}; v1 = (f32x4){gelu_tanh_f(v1[0]), gelu_tanh_f(v1[1]), gelu_tanh_f(v1[2]), gelu_tanh_f(v1[3])}; }
                    u32x4 w; w.x = cvt_pk_bf16(v0[0], v0[1]); w.y = cvt_pk_bf16(v0[2], v0[3]); w.z = cvt_pk_bf16(v1[0], v1[1]); w.w = cvt_pk_bf16(v1[2], v1[3]);
                    *(u32x4*)(rowp + bj * HALF) = w; } asm volatile("" ::: "memory"); }
        ++ui;
    }
};
struct EpiResid {
    static constexpr bool PERM = true, AFTER_DRAIN = false;
    bf16_t* xb; int ldc; float alpha; float* ss;
    __device__ __forceinline__ void operator()(const f32x4 (&acc)[2][2][4][2], const Unit& u, int wr, int wc, int fr, int fq) const {
        const int row0 = u.pm * BM + wr * 64 + fr; const int col0 = u.pn * BM + wc * 32 + 8 * fq; const int lane = fq * 16 + fr;
#pragma unroll
        for (int ai = 0; ai < 2; ++ai) {
            u32x4 pre[4][2];
#pragma unroll
            for (int m = 0; m < 4; ++m)
#pragma unroll
                for (int bj = 0; bj < 2; ++bj) pre[m][bj] = *(const u32x4*)(xb + (size_t)(row0 + ai * HALF + m * 16) * ldc + col0 + bj * HALF);
#pragma unroll
            for (int m = 0; m < 4; ++m) { const int row = row0 + ai * HALF + m * 16; bf16_t* rowp = xb + (size_t)row * ldc + col0; float sq = 0.f;
#pragma unroll
                for (int bj = 0; bj < 2; ++bj) { const u32x4 p = pre[m][bj]; const f32x4 a0 = acc[ai][bj][m][0] * alpha, a1 = acc[ai][bj][m][1] * alpha;
                    const float x0 = __uint_as_float(p.x << 16) + a0[0], x1 = __uint_as_float(p.x & 0xffff0000u) + a0[1], x2 = __uint_as_float(p.y << 16) + a0[2], x3 = __uint_as_float(p.y & 0xffff0000u) + a0[3];
                    const float x4 = __uint_as_float(p.z << 16) + a1[0], x5 = __uint_as_float(p.z & 0xffff0000u) + a1[1], x6 = __uint_as_float(p.w << 16) + a1[2], x7 = __uint_as_float(p.w & 0xffff0000u) + a1[3];
                    sq += ((x0 * x0 + x1 * x1) + (x2 * x2 + x3 * x3)) + ((x4 * x4 + x5 * x5) + (x6 * x6 + x7 * x7));
                    u32x4 w; w.x = cvt_pk_bf16(x0, x1); w.y = cvt_pk_bf16(x2, x3); w.z = cvt_pk_bf16(x4, x5); w.w = cvt_pk_bf16(x6, x7);
                    *(u32x4*)(rowp + bj * HALF) = w; }
                sq += __int_as_float(__builtin_amdgcn_ds_bpermute((lane ^ 16) << 2, __float_as_int(sq)));
                sq += __int_as_float(__builtin_amdgcn_ds_bpermute((lane ^ 32) << 2, __float_as_int(sq)));
                if (fq == 0) ss[(size_t)row * 16 + u.pn * 4 + wc] = sq; }
            asm volatile("" ::: "memory");
        }
    }
};
template <class Epi, class Sched, bool ALIGN_EPI = false, bool SP2 = false>
__device__ __forceinline__ void gemm_phase(PG8_LAS unsigned char* lds, const Gemm g, const Sched& S, const Epi& E, const int wave_in) {
    int tid_l; asm volatile("v_mbcnt_lo_u32_b32 %0, -1, 0\n\tv_mbcnt_hi_u32_b32 %0, -1, %0" : "=v"(tid_l)); tid_l += wave_in * 64;
    const int tid = tid_l, wid = __builtin_amdgcn_readfirstlane(tid >> 6), lane = tid & 63, wr = wid >> 2, wc = wid & 3, fr = lane & 15, fq = lane >> 4;
    const int K = g.K, nt = K / BK;
    unsigned voffA[2], voffB[2];
#pragma unroll
    for (int i = 0; i < 2; ++i) { int R, C; stage_rc(tid * 16 + i * 8192, R, C); const int Rb = Epi::PERM ? ((R & ~31) + perm32(R & 31)) : R;
        voffA[i] = (unsigned)(R * K + C) * 2u; voffB[i] = (unsigned)(Rb * K + C) * 2u; }
    const size_t kstep = (size_t)(BK * 2);
    const size_t hstep = (size_t)HALF * K * 2;
    const size_t tstep = 2 * hstep;
    const unsigned ldsw = (unsigned)wid * 1024u;
    const int aoff = lds_byte(wr * 64 + fr, fq * 8), boff = lds_byte(wc * 32 + fr, fq * 8);
#define PG8_SA(b, h) (((b) * 2 + (h)) * HTB)
#define PG8_SB(b, h) ((4 + (b) * 2 + (h)) * HTB)
#define PG8_STAGE(bufoff, gbase, voff) do { _Pragma("unroll") for (int _i = 0; _i < 2; ++_i) \
        __builtin_amdgcn_global_load_lds((const unsigned*)((const char*)(gbase) + (voff)[_i]), (PG8_LAS unsigned*)(lds + (bufoff) + ldsw + _i * 8192), 16, 0, 0); } while (0)
#define PG8_LDA(dst, b, h) do { _Pragma("unroll") for (int m = 0; m < 4; ++m) _Pragma("unroll") for (int k = 0; k < 2; ++k) dst[m][k] = *(const PG8_LAS bf16x8*)(lds + PG8_SA(b, h) + aoff + m * 2048 + k * 1024); } while (0)
#define PG8_LDB(dst, b, h) do { _Pragma("unroll") for (int n = 0; n < 2; ++n) _Pragma("unroll") for (int k = 0; k < 2; ++k) dst[n][k] = *(const PG8_LAS bf16x8*)(lds + PG8_SB(b, h) + boff + n * 2048 + k * 1024); } while (0)
#define PG8_MMA(ai, bj, At, Bt) do { __builtin_amdgcn_s_setprio(1); _Pragma("unroll") for (int m = 0; m < 4; ++m) _Pragma("unroll") for (int n = 0; n < 2; ++n) _Pragma("unroll") for (int k = 0; k < 2; ++k) \
        acc[ai][bj][m][n] = __builtin_amdgcn_mfma_f32_16x16x32_bf16(Bt[n][k], At[m][k], acc[ai][bj][m][n], 0, 0, 0); __builtin_amdgcn_s_setprio(0); } while (0)
#define PG8_WAIT_V(n) asm volatile("s_waitcnt vmcnt(" #n ")" ::: "memory")
#define PG8_WAIT_L(n) asm volatile("s_waitcnt lgkmcnt(" #n ")" ::: "memory")
#define PG8_BAR __builtin_amdgcn_s_barrier()
#define PG8_SCHED __builtin_amdgcn_sched_barrier(0)
    Unit cur, nxt; int ui = 0;
    if (!S.next(0, cur)) return;
    f32x4 acc[2][2][4][2];
#pragma unroll
    for (int a = 0; a < 2; ++a)
#pragma unroll
        for (int b = 0; b < 2; ++b)
#pragma unroll
            for (int m = 0; m < 4; ++m)
#pragma unroll
                for (int n = 0; n < 2; ++n) acc[a][b][m][n] = (f32x4){0.f, 0.f, 0.f, 0.f};
    bf16x8 At[4][2], B0[2][2], B1[2][2];
    const char* cA = (const char*)g.A + (size_t)cur.pm * tstep; const char* cB = (const char*)g.Bt + (size_t)cur.pn * tstep;
    S.a_ready(cur);
    if constexpr (SP2) {
        PG8_STAGE(PG8_SB(0, 0), cB, voffB); PG8_STAGE(PG8_SB(0, 1), cB + hstep, voffB); PG8_STAGE(PG8_SA(0, 0), cA, voffA); PG8_STAGE(PG8_SA(0, 1), cA + hstep, voffA);
        if (wr == 1) PG8_BAR;
        PG8_WAIT_V(2); PG8_BAR;
        PG8_STAGE(PG8_SB(1, 0), cB + kstep, voffB); PG8_STAGE(PG8_SA(1, 0), cA + kstep, voffA); PG8_STAGE(PG8_SB(1, 1), cB + hstep + kstep, voffB);
        PG8_WAIT_V(6); PG8_BAR;
    } else {
        PG8_STAGE(PG8_SB(0, 0), cB, voffB); PG8_STAGE(PG8_SA(0, 0), cA, voffA); PG8_STAGE(PG8_SB(0, 1), cB + hstep, voffB); PG8_STAGE(PG8_SA(0, 1), cA + hstep, voffA);
        if (wr == 1) PG8_BAR;
        PG8_WAIT_V(4); PG8_BAR;
        PG8_STAGE(PG8_SB(1, 0), cB + kstep, voffB); PG8_STAGE(PG8_SA(1, 0), cA + kstep, voffA); PG8_STAGE(PG8_SB(1, 1), cB + hstep + kstep, voffB);
        PG8_WAIT_V(6); PG8_BAR;
    }
    for (;;) {
        const bool has_next = S.next(ui + 1, nxt);
        const char* nA = has_next ? (const char*)g.A + (size_t)nxt.pm * tstep : cA; const char* nB = has_next ? (const char*)g.Bt + (size_t)nxt.pn * tstep : cB;
        for (int t = 0; t < nt; t += 2) {
            const bool last = (t == nt - 2);
            const char* a1 = cA + (size_t)(t + 1) * kstep;
            const char* a2 = last ? nA : cA + (size_t)(t + 2) * kstep; const char* b2 = last ? nB : cB + (size_t)(t + 2) * kstep;
            const char* a3 = a2 + kstep; const char* b3 = b2 + kstep;
            if (last && has_next) S.a_ready(nxt);
            if constexpr (SP2) {
            PG8_LDB(B0, 0, 0); PG8_LDB(B1, 0, 1); PG8_SCHED; PG8_LDA(At, 0, 0); PG8_STAGE(PG8_SA(1, 1), a1 + hstep, voffA);
            PG8_WAIT_V(8); PG8_WAIT_L(0); PG8_BAR; PG8_MMA(0, 0, At, B0); PG8_MMA(0, 1, At, B1); PG8_BAR; PG8_SCHED;
            PG8_LDA(At, 0, 1); PG8_STAGE(PG8_SB(0, 0), b2, voffB); PG8_STAGE(PG8_SB(0, 1), b2 + hstep, voffB); PG8_STAGE(PG8_SA(0, 0), a2, voffA);
            PG8_WAIT_V(8); PG8_WAIT_L(0); PG8_BAR; PG8_MMA(1, 0, At, B0); PG8_MMA(1, 1, At, B1); PG8_BAR; PG8_SCHED;
            PG8_LDB(B0, 1, 0); PG8_LDB(B1, 1, 1); PG8_SCHED; PG8_LDA(At, 1, 0); PG8_STAGE(PG8_SA(0, 1), a2 + hstep, voffA);
            PG8_WAIT_V(8); PG8_WAIT_L(0); PG8_BAR; PG8_MMA(0, 0, At, B0); PG8_MMA(0, 1, At, B1); PG8_BAR; PG8_SCHED;
            PG8_LDA(At, 1, 1); PG8_STAGE(PG8_SB(1, 0), b3, voffB); PG8_STAGE(PG8_SB(1, 1), b3 + hstep, voffB); PG8_STAGE(PG8_SA(1, 0), a3, voffA);
            PG8_WAIT_V(8); PG8_WAIT_L(0); PG8_BAR; PG8_MMA(1, 0, At, B0); PG8_MMA(1, 1, At, B1); PG8_BAR; PG8_SCHED;
            } else {
            PG8_LDB(B0, 0, 0); PG8_SCHED; PG8_LDA(At, 0, 0); PG8_STAGE(PG8_SA(1, 1), a1 + hstep, voffA);
            PG8_WAIT_L(8); PG8_BAR; PG8_WAIT_L(0); PG8_MMA(0, 0, At, B0); PG8_BAR; PG8_SCHED;
            PG8_LDB(B1, 0, 1); PG8_STAGE(PG8_SB(0, 0), b2, voffB);
            PG8_BAR; PG8_WAIT_L(0); PG8_MMA(0, 1, At, B1); PG8_BAR;
            PG8_LDA(At, 0, 1); PG8_STAGE(PG8_SA(0, 0), a2, voffA);
            PG8_BAR; PG8_WAIT_L(0); PG8_MMA(1, 0, At, B0); PG8_BAR; PG8_SCHED;
            PG8_STAGE(PG8_SB(0, 1), b2 + hstep, voffB);
            PG8_WAIT_V(6); PG8_BAR; PG8_MMA(1, 1, At, B1); PG8_BAR;
            PG8_LDB(B0, 1, 0); PG8_SCHED; PG8_LDA(At, 1, 0); PG8_STAGE(PG8_SA(0, 1), a2 + hstep, voffA);
            PG8_WAIT_L(8); PG8_BAR; PG8_WAIT_L(0); PG8_MMA(0, 0, At, B0); PG8_BAR; PG8_SCHED;
            PG8_LDB(B1, 1, 1); PG8_STAGE(PG8_SB(1, 0), b3, voffB);
            PG8_BAR; PG8_WAIT_L(0); PG8_MMA(0, 1, At, B1); PG8_BAR;
            PG8_LDA(At, 1, 1); PG8_STAGE(PG8_SA(1, 0), a3, voffA);
            PG8_BAR; PG8_WAIT_L(0); PG8_MMA(1, 0, At, B0); PG8_BAR; PG8_SCHED;
            PG8_STAGE(PG8_SB(1, 1), b3 + hstep, voffB);
            PG8_WAIT_V(6); PG8_BAR; PG8_MMA(1, 1, At, B1); PG8_BAR;
            }
        }
        if constexpr (ALIGN_EPI) { if (wr == 0) PG8_BAR; }
        if constexpr (!Epi::AFTER_DRAIN) { E(acc, cur, wr, wc, fr, fq); S.done(cur); }
        if (!has_next) break;
#pragma unroll
        for (int a = 0; a < 2; ++a)
#pragma unroll
            for (int b = 0; b < 2; ++b)
#pragma unroll
                for (int m = 0; m < 4; ++m)
#pragma unroll
                    for (int n = 0; n < 2; ++n) acc[a][b][m][n] = (f32x4){0.f, 0.f, 0.f, 0.f};
        cur = nxt; cA = nA; cB = nB; ++ui;
        if constexpr (ALIGN_EPI) { if (wr == 1) PG8_BAR; }
    }
    PG8_WAIT_V(0);
    if constexpr (!ALIGN_EPI) { if (wr == 0) PG8_BAR; }
    PG8_BAR;
    if constexpr (Epi::AFTER_DRAIN) { E.fused(acc, cur, wr, wc, fr, fq, lds, wid, lane); S.done(cur); }
#undef PG8_SA
#undef PG8_SB
#undef PG8_STAGE
#undef PG8_LDA
#undef PG8_LDB
#undef PG8_MMA
#undef PG8_WAIT_V
#undef PG8_WAIT_L
#undef PG8_BAR
#undef PG8_SCHED
}
}

#define LAS __attribute__((address_space(3)))
using pg8::ex2; using pg8::rcpf_;
typedef unsigned short u16;
typedef short bf16x8 __attribute__((ext_vector_type(8)));
typedef float f32x4 __attribute__((ext_vector_type(4)));
typedef float f32x16 __attribute__((ext_vector_type(16)));
typedef unsigned u32x4 __attribute__((ext_vector_type(4)));
typedef unsigned u32x2 __attribute__((ext_vector_type(2)));

constexpr int DM = 1024, NB = 16, SEQ = 2048, MTOK = NB * SEQ, DEPTH = 4, DFF = 2816, INW = 2840, PW = 3072;
constexpr int C_MQ = 0, C_MK = 256, C_MV = 512, C_DQ = 768, C_DK = 1024, C_DV = 1280, C_NQ = 1536, C_NKC = 2048, C_NVC = 2176, C_NKS = 2304, C_NVS = 2432, C_NKW = 2560, C_NVW = 2688, C_NG = 2816;
constexpr int NVH = 12;
constexpr float LOG2E = 1.4426950408889634f, NEGF = -1e30f;
constexpr int NPH_L = 14, NPH = NPH_L * DEPTH + 1;
constexpr size_t MiB = 1u << 20;
constexpr size_t WS_GU1 = 1 * MiB, WS_DN1 = 12 * MiB, WS_GU2 = WS_DN1 + 5 * MiB + MiB / 2, WS_DN2 = WS_GU2 + 11 * MiB, WS_WIN = 34 * MiB, WS_WOUT = 40 * MiB, WS_W1 = 42 * MiB;
constexpr size_t WS_PROJ = 44 * MiB, WS_XN = 236 * MiB, WS_VT = 300 * MiB, WS_HID = 348 * MiB, WS_KCMP = 352 * MiB, WS_VCMPT = WS_KCMP + MiB / 2, WS_KMEAN = 353 * MiB, WS_SEL = WS_KMEAN + MiB / 4, WS_XB = 354 * MiB, WS_SS = 418 * MiB, WS_END = 420 * MiB;
static_assert(WS_DN2 + 5 * MiB + MiB / 2 == WS_WIN, "ws map");
constexpr int LDS_BYTES = 147456, MISC_OFF = 147456 - 64, RTAB_OFF = 131072;
constexpr size_t WS_CTL = 0, CTL_ZERO_BYTES = 262144;
constexpr int ATT_K = 0, ATT_V = 32768, ATT_LUT = 32768 + 4 * 8704, ATT_PARK = ATT_LUT + 2816;
constexpr int CMP_K = 0, CMP_V = 18432, CMP_A = 36864, CMP_H = CMP_A + 256 * 33 * 4;

struct Params {
    const float* x; const float* rel_bias; const float* norm_ffn1; const float* ffn1_gate; const float* ffn1_up; const float* ffn1_down;
    const float* norm_mix; const float* w_in; const float* diff_lambda; const float* diff_subln; const float* cmp_pe; const float* cmp_w1; const float* cmp_w2;
    const float* w_out; const float* norm_ffn2; const float* ffn2_gate; const float* ffn2_up; const float* ffn2_down; const float* final_norm;
    float* out; unsigned char* ws;
    float lam_init[4];
    int ph_lo, ph_hi;
};
typedef const __attribute__((address_space(4))) Params* KParamsPtr;

__device__ __forceinline__ float bf2f(unsigned v) { return __uint_as_float(v << 16); }
typedef float f32x2_t __attribute__((ext_vector_type(2))); typedef __bf16 bf16x2_t __attribute__((ext_vector_type(2)));
__device__ __forceinline__ unsigned pkbf(float lo, float hi) { f32x2_t v = {lo, hi}; bf16x2_t b = __builtin_convertvector(v, bf16x2_t); return __builtin_bit_cast(unsigned, b); }
__device__ __forceinline__ int lane_opaque() { int l; asm volatile("v_mbcnt_lo_u32_b32 %0, -1, 0\n\tv_mbcnt_hi_u32_b32 %0, -1, %0" : "=v"(l)); return l; }
__device__ __forceinline__ float wave_sum(float v, int lane) {
#pragma unroll
    for (int o = 1; o < 64; o <<= 1) v += __int_as_float(__builtin_amdgcn_ds_bpermute((lane ^ o) << 2, __float_as_int(v)));
    return v;
}
__device__ __forceinline__ float xhalf_max(float v) { auto rr = __builtin_amdgcn_permlane32_swap(__float_as_uint(v), __float_as_uint(v), false, false); return fmaxf(__uint_as_float(rr[0]), __uint_as_float(rr[1])); }
__device__ __forceinline__ float xhalf_sum(float v) { auto rr = __builtin_amdgcn_permlane32_swap(__float_as_uint(v), __float_as_uint(v), false, false); return __uint_as_float(rr[0]) + __uint_as_float(rr[1]); }
__device__ __forceinline__ float sigmoid_f(float x) { return rcpf_(1.0f + ex2(-LOG2E * x)); }
__device__ __forceinline__ int crow(int r, int hi) { return (r & 3) + 8 * (r >> 2) + 4 * hi; }
__device__ __forceinline__ int kperm(int p) { const int h = p >> 3, j = p & 7; return 8 * (j >> 2) + 4 * h + (j & 3); }
__device__ __forceinline__ int pperm(int k) { return ((k >> 2) & 1) * 8 + (k >> 3) * 4 + (k & 3); }

__device__ __forceinline__ void tr_item(const float* W, int K, int N, u16* WT, int kb, int n0, int dst_row0, LAS float* scr, int lane, float cs = 1.0f, const float* gk = nullptr) {
    const int k0 = 64 * kb; const int n = n0 + (lane & 31); const bool ok = n < N;
    float wv[32];
#pragma unroll
    for (int i = 0; i < 32; ++i) { const int kk = 2 * i + (lane >> 5); wv[i] = ok ? W[(size_t)(k0 + kk) * N + n] : 0.f; }
#pragma unroll
    for (int i = 0; i < 32; ++i) { const int kk = 2 * i + (lane >> 5); scr[kk * 33 + (lane & 31)] = wv[i] * (gk ? gk[k0 + kk] * cs : cs); }
    asm volatile("s_waitcnt lgkmcnt(0)" ::: "memory");
    const int c = lane & 7;
#pragma unroll
    for (int j = 0; j < 4; ++j) { const int nn = (lane >> 3) + 8 * j; const LAS float* s = scr + (8 * c) * 33 + nn;
        u32x4 o; o.x = pkbf(s[0 * 33], s[1 * 33]); o.y = pkbf(s[2 * 33], s[3 * 33]); o.z = pkbf(s[4 * 33], s[5 * 33]); o.w = pkbf(s[6 * 33], s[7 * 33]);
        *(u32x4*)(WT + (size_t)(dst_row0 + nn) * K + k0 + 8 * c) = o; }
    asm volatile("s_waitcnt lgkmcnt(0)" ::: "memory");
}

__device__ __forceinline__ void norm_row(const float* xrow, const u16* xrow16, const float* g, u16* dst16, float* dst32, u16* xb0, int lane) {
    float v[16];
    if (xrow) { const f32x4* xr = (const f32x4*)xrow + 4 * lane;
#pragma unroll
        for (int j = 0; j < 4; ++j) { const f32x4 t = xr[j]; v[4 * j] = t.x; v[4 * j + 1] = t.y; v[4 * j + 2] = t.z; v[4 * j + 3] = t.w; }
        if (xb0) { u32x4 o0, o1; o0.x = pkbf(v[0], v[1]); o0.y = pkbf(v[2], v[3]); o0.z = pkbf(v[4], v[5]); o0.w = pkbf(v[6], v[7]); o1.x = pkbf(v[8], v[9]); o1.y = pkbf(v[10], v[11]); o1.z = pkbf(v[12], v[13]); o1.w = pkbf(v[14], v[15]);
            ((u32x4*)xb0)[2 * lane] = o0; ((u32x4*)xb0)[2 * lane + 1] = o1; }
    } else { const u32x4 p0 = ((const u32x4*)xrow16)[2 * lane], p1 = ((const u32x4*)xrow16)[2 * lane + 1];
        v[0] = bf2f(p0.x & 0xffffu); v[1] = bf2f(p0.x >> 16); v[2] = bf2f(p0.y & 0xffffu); v[3] = bf2f(p0.y >> 16); v[4] = bf2f(p0.z & 0xffffu); v[5] = bf2f(p0.z >> 16); v[6] = bf2f(p0.w & 0xffffu); v[7] = bf2f(p0.w >> 16);
        v[8] = bf2f(p1.x & 0xffffu); v[9] = bf2f(p1.x >> 16); v[10] = bf2f(p1.y & 0xffffu); v[11] = bf2f(p1.y >> 16); v[12] = bf2f(p1.z & 0xffffu); v[13] = bf2f(p1.z >> 16); v[14] = bf2f(p1.w & 0xffffu); v[15] = bf2f(p1.w >> 16); }
    float s = 0.f;
#pragma unroll
    for (int j = 0; j < 16; ++j) s = fmaf(v[j], v[j], s);
    const float rstd = 1.0f / sqrtf(wave_sum(s, lane) * (1.0f / 1024.0f) + 1e-6f);
    const f32x4* gr = (const f32x4*)g + 4 * lane;
#pragma unroll
    for (int j = 0; j < 4; ++j) { const f32x4 gg = gr[j]; v[4 * j] *= rstd * gg.x; v[4 * j + 1] *= rstd * gg.y; v[4 * j + 2] *= rstd * gg.z; v[4 * j + 3] *= rstd * gg.w; }
    if (dst16) { u32x4 o0, o1; o0.x = pkbf(v[0], v[1]); o0.y = pkbf(v[2], v[3]); o0.z = pkbf(v[4], v[5]); o0.w = pkbf(v[6], v[7]); o1.x = pkbf(v[8], v[9]); o1.y = pkbf(v[10], v[11]); o1.z = pkbf(v[12], v[13]); o1.w = pkbf(v[14], v[15]);
        ((u32x4*)dst16)[2 * lane] = o0; ((u32x4*)dst16)[2 * lane + 1] = o1; }
    else {
#pragma unroll
        for (int j = 0; j < 4; ++j) ((f32x4*)dst32)[4 * lane + j] = (f32x4){v[4 * j], v[4 * j + 1], v[4 * j + 2], v[4 * j + 3]}; }
}

struct AState { f32x16 o0, o1; float m, l; };
__device__ __forceinline__ void astate_init(AState& s) {
#pragma unroll
    for (int r = 0; r < 16; ++r) { s.o0[r] = 0.f; s.o1[r] = 0.f; }
    s.m = 0.f; s.l = 0.f;
}
constexpr float ATT_THR = 8.0f;
constexpr int ATT_SLOT = 9216, ATT_NSLOT = 3;
template <int KS0, int NKS>
__device__ __forceinline__ void qk_block(const LAS unsigned char* Ks, const bf16x8 (&qr)[4], int r32, int hi, f32x16& s0, f32x16& s1) {
    f32x16 ci;
#pragma unroll
    for (int r = 0; r < 16; ++r) ci[r] = 0.f;
    const LAS unsigned char* kp = Ks + hi * 1024 + r32 * 16;
#pragma unroll
    for (int ks = 0; ks < NKS; ++ks) {
        const bf16x8 a0 = *(const LAS bf16x8*)(kp + (KS0 + ks) * 2048);
        const bf16x8 a1 = *(const LAS bf16x8*)(kp + (KS0 + ks) * 2048 + 512);
        s0 = __builtin_amdgcn_mfma_f32_32x32x16_bf16(a0, qr[KS0 + ks], ks == 0 ? ci : s0, 0, 0, 0);
        s1 = __builtin_amdgcn_mfma_f32_32x32x16_bf16(a1, qr[KS0 + ks], ks == 0 ? ci : s1, 0, 0, 0);
    }
    __builtin_amdgcn_sched_group_barrier(0x100, 2 * NKS, 0); __builtin_amdgcn_sched_group_barrier(0x008, 2 * NKS, 0);
}
constexpr int ATT_VCH = 1088, ATT_VSLOT = 8 * ATT_VCH;
typedef short v4i16_t __attribute__((ext_vector_type(4)));
__device__ __forceinline__ void pv_block(const LAS unsigned char* Vs, const u32x4 (&pk)[4], int lane, AState& st) {
    const int p = lane & 3, q = (lane & 15) >> 2, dsel = (lane >> 4) & 1, hi = lane >> 5;
    const LAS unsigned char* vp = Vs + (2 * dsel + (p >> 1)) * ATT_VCH + (4 * hi + q) * 16 + (p & 1) * 8;
#pragma unroll
    for (int c = 0; c < 4; ++c) {
        const v4i16_t a0 = __builtin_amdgcn_ds_read_tr16_b64_v4i16((LAS v4i16_t*)(vp + c * 256));
        const v4i16_t a1 = __builtin_amdgcn_ds_read_tr16_b64_v4i16((LAS v4i16_t*)(vp + c * 256 + 128));
        const v4i16_t b0 = __builtin_amdgcn_ds_read_tr16_b64_v4i16((LAS v4i16_t*)(vp + 4 * ATT_VCH + c * 256));
        const v4i16_t b1 = __builtin_amdgcn_ds_read_tr16_b64_v4i16((LAS v4i16_t*)(vp + 4 * ATT_VCH + c * 256 + 128));
        const bf16x8 v0 = (bf16x8){a0[0], a0[1], a0[2], a0[3], a1[0], a1[1], a1[2], a1[3]};
        const bf16x8 v1 = (bf16x8){b0[0], b0[1], b0[2], b0[3], b1[0], b1[1], b1[2], b1[3]};
        const bf16x8 pb = __builtin_bit_cast(bf16x8, pk[c]);
        st.o0 = __builtin_amdgcn_mfma_f32_32x32x16_bf16(v0, pb, st.o0, 0, 0, 0);
        st.o1 = __builtin_amdgcn_mfma_f32_32x32x16_bf16(v1, pb, st.o1, 0, 0, 0);
    }
}
__device__ __forceinline__ void glds16(const void* gsrc, unsigned lds_dst) { unsigned keep;
    asm volatile("s_mov_b32 %0, m0\n\ts_mov_b32 m0, %2\n\ts_nop 0\n\tglobal_load_lds_dwordx4 %1, off\n\ts_mov_b32 m0, %0" : "=&s"(keep) : "v"(gsrc), "s"(lds_dst) : "memory"); }
__device__ __forceinline__ void lut_add(f32x16& s0, f32x16& s1, const LAS float* lutz, int dbase, float cc) {
    const LAS float* lp = lutz + (dbase - 59);
#pragma unroll
    for (int r = 0; r < 16; ++r) { const int ko = (r & 3) + 8 * (r >> 2);
        s0[r] += lp[59 - ko] + cc; s1[r] += lp[27 - ko] + cc; }
}
__device__ __forceinline__ void const_add(f32x16& s0, f32x16& s1, float cc) {
#pragma unroll
    for (int r = 0; r < 16; ++r) { s0[r] += cc; s1[r] += cc; }
}
__device__ __forceinline__ float row_max(const f32x16& s0, const f32x16& s1) {
    float mx = fmaxf(s0[0], s1[0]);
#pragma unroll
    for (int r = 1; r < 16; ++r) mx = fmaxf(mx, fmaxf(s0[r], s1[r]));
    return xhalf_max(mx);
}
__device__ __forceinline__ void rescale(AState& st, f32x16& s0, f32x16& s1, float mx) {
    const float dl = fmaxf(mx, 0.f); const float f = ex2(-dl); st.m += dl; st.l *= f;
#pragma unroll
    for (int r = 0; r < 16; ++r) { st.o0[r] *= f; st.o1[r] *= f; s0[r] -= dl; s1[r] -= dl; }
}
constexpr float ATT_BIG = 1024.0f;
__device__ __forceinline__ void exp_pack(f32x16& s0, f32x16& s1, u32x4 (&pk)[4], AState& st) {
    float sum = 0.f;
#pragma unroll
    for (int r = 0; r < 16; ++r) { s0[r] = ex2(s0[r]); s1[r] = ex2(s1[r]); sum += s0[r] + s1[r]; }
    if (__any(sum > ATT_BIG)) {
        float mx = fmaxf(s0[0], s1[0]);
#pragma unroll
        for (int r = 1; r < 16; ++r) mx = fmaxf(mx, fmaxf(s0[r], s1[r]));
        mx = xhalf_max(mx);
        const float dl = fmaxf(__builtin_amdgcn_logf(fmaxf(mx, 1.0f)), 0.f), f = ex2(-dl);
        st.m += dl; st.l *= f; sum *= f;
#pragma unroll
        for (int r = 0; r < 16; ++r) { st.o0[r] *= f; st.o1[r] *= f; s0[r] *= f; s1[r] *= f; }
    }
    st.l += sum;
    pk[0] = (u32x4){pkbf(s0[0], s0[1]), pkbf(s0[2], s0[3]), pkbf(s0[4], s0[5]), pkbf(s0[6], s0[7])};
    pk[1] = (u32x4){pkbf(s0[8], s0[9]), pkbf(s0[10], s0[11]), pkbf(s0[12], s0[13]), pkbf(s0[14], s0[15])};
    pk[2] = (u32x4){pkbf(s1[0], s1[1]), pkbf(s1[2], s1[3]), pkbf(s1[4], s1[5]), pkbf(s1[6], s1[7])};
    pk[3] = (u32x4){pkbf(s1[8], s1[9]), pkbf(s1[10], s1[11]), pkbf(s1[12], s1[13]), pkbf(s1[14], s1[15])};
}

template <int KS0, int NKS, bool WINDOW, int MODE>
__device__ __forceinline__ void run_tiles(LAS unsigned char* lds, int t0, int t1, const u16* Kg, const u16* Vtg, const bf16x8 (&qr)[4], float c31,
                                          int q0w, unsigned mask, int qb, AState& A, int wave, int lane, int r32, int hi) {
    LAS unsigned char* Kr = lds + ATT_K; LAS unsigned char* Vr = lds + ATT_V; const LAS float* lut1 = (const LAS float*)(lds + ATT_LUT) + 96;
    const u16* ksrc = Kg + (size_t)lane * PW + wave * 8;
    const u16* vsrc = Vtg + (size_t)lane * PW + wave * 8;
    const unsigned kdst = (unsigned)(uintptr_t)Kr + wave * 1024, vdst = (unsigned)(uintptr_t)Vr + wave * ATT_VCH;
#define TCL(t) ((t) < t0 ? t0 : ((t) > t1 ? t1 : (t)))
#define DMA_K(tn) glds16(ksrc + (size_t)TCL(tn) * 64 * PW, (unsigned)__builtin_amdgcn_readfirstlane(kdst + ((tn) & 3) * 8192))
#define DMA_V(tn) glds16(vsrc + (size_t)TCL(tn) * 64 * PW, (unsigned)__builtin_amdgcn_readfirstlane(vdst + ((tn) & 3) * ATT_VSLOT))
#define KS_(t) (Kr + ((t) & 3) * 8192)
#define VS_(t) (Vr + ((t) & 3) * ATT_VSLOT)
#define WAIT_BAR4() asm volatile("s_waitcnt vmcnt(4) lgkmcnt(0)\n\ts_barrier" ::: "memory")
#define T_ACTIVE(t) (!((q0w + 31 - (t) * 64) < 0 || (WINDOW && (q0w - ((t) * 64 + 63)) >= 512)))
#define T_LUTMODE(t) (((q0w - ((t) * 64 + 63)) < 128) || (WINDOW && (q0w + 31 - (t) * 64) >= 512))
    auto tile_sel = [&](int t) -> int { if (MODE == 1) { const int blk = t >> 2; return blk < qb ? (int)((mask >> blk) & 1u) : 1; } if (MODE == 2) return (int)((mask >> t) & 1u); return 1; };
    asm volatile("s_waitcnt vmcnt(0)" ::: "memory");
#pragma unroll
    for (int j = 0; j < 4; ++j) { DMA_K(t0 + j); DMA_V(t0 + j - 2); }
    WAIT_BAR4();
    f32x16 sn0, sn1, sc0, sc1; u32x4 pk[4];
#pragma unroll
    for (int r = 0; r < 16; ++r) { sn0[r] = 0.f; sn1[r] = 0.f; }
#pragma unroll
    for (int i = 0; i < 4; ++i) pk[i] = (u32x4){0u, 0u, 0u, 0u};
    bool act_n = T_ACTIVE(t0), act_c = false, act_p = false;
    if (act_n) qk_block<KS0, NKS>(KS_(t0), qr, r32, hi, sn0, sn1);
    asm volatile("s_waitcnt lgkmcnt(0)\n\ts_barrier" ::: "memory");
    for (int c = t0; c <= t1 + 1; ++c) {
        act_p = act_c; act_c = act_n; sc0 = sn0; sc1 = sn1;
        DMA_K(c + 4); DMA_V(c + 2);
        act_n = (c + 1 <= t1) && T_ACTIVE(c + 1);
        const bool lm_c = T_LUTMODE(c);
        const int dbase = q0w + r32 - c * 64 - 4 * hi;
        const float selc = tile_sel(c) ? 0.f : NEGF;
        if (act_p) pv_block(VS_(c - 1), pk, lane, A);
        if (act_c) {
            const float cc = selc - A.m;
            if (lm_c) lut_add(sc0, sc1, lut1, dbase, cc); else if (__any(cc != 0.f)) const_add(sc0, sc1, cc);
        }
        if (act_n) qk_block<KS0, NKS>(KS_(c + 1), qr, r32, hi, sn0, sn1);
        if (act_c) exp_pack(sc0, sc1, pk, A);
        WAIT_BAR4();
    }
    asm volatile("s_waitcnt vmcnt(0) lgkmcnt(0)\n\ts_barrier" ::: "memory");
#undef TCL
#undef DMA_K
#undef DMA_V
#undef KS_
#undef VS_
#undef WAIT_BAR4
#undef T_ACTIVE
#undef T_LUTMODE
}

__device__ __forceinline__ void build_lut(LAS unsigned char* lds, const float* rel_bias, int head, bool window, int tid) {
    LAS float* lut = (LAS float*)(lds + ATT_LUT);
    for (int i = tid; i < 704; i += 512) {
        const int d = i - 96; float v; const float c31 = rel_bias[31 * 16 + head];
        if (d < 0) v = NEGF;
        else if (d >= 512) v = window ? NEGF : 0.f;
        else { int bk;
            if (d < 16) bk = d; else if (d >= 128) bk = 31; else { bk = 16 + (int)(log2f((float)d * (1.0f / 16.0f)) * (16.0f / 3.0f)); bk = bk > 31 ? 31 : bk; }
            v = (rel_bias[bk * 16 + head] - c31) * LOG2E; }
        lut[i] = v;
    }
}
__device__ __forceinline__ void load_q(bf16x8 (&qr)[4], const u16* qrow, int hi) {
#pragma unroll
    for (int ks = 0; ks < 4; ++ks) qr[ks] = *(const bf16x8*)(qrow + ks * 16 + hi * 8);
}
__device__ __forceinline__ void store_o(u16* dst, const f32x16& v0, const f32x16& v1, int hi) {
#pragma unroll
    for (int g = 0; g < 4; ++g) {
        u32x2 a; a.x = pkbf(v0[4 * g], v0[4 * g + 1]); a.y = pkbf(v0[4 * g + 2], v0[4 * g + 3]); *(u32x2*)(dst + 8 * g + 4 * hi) = a;
        u32x2 b; b.x = pkbf(v1[4 * g], v1[4 * g + 1]); b.y = pkbf(v1[4 * g + 2], v1[4 * g + 3]); *(u32x2*)(dst + 32 + 8 * g + 4 * hi) = b;
    }
}

struct Ctx { LAS unsigned char* lds; int tid, lane, wave, r32, hi, G, bx; u16* proj; u16* obuf; u16* vt; };

__device__ __forceinline__ void moba_unit(const Ctx& C0, KParamsPtr P, int b, int h, int qb) {
    Ctx C = C0; C.lane = lane_opaque(); C.tid = C.wave * 64 + C.lane; C.r32 = C.lane & 31; C.hi = C.lane >> 5;
    const int q0w = __builtin_amdgcn_readfirstlane(qb * 256 + C.wave * 32); const int qpos = q0w + C.r32; const size_t tok = (size_t)b * SEQ + qpos;
    build_lut(C.lds, P->rel_bias, h, false, C.tid);
    const u16* qrow = C.proj + tok * PW + C_MQ + h * 64;
    bf16x8 qr[4]; load_q(qr, qrow, C.hi);
    unsigned mask = 0;
    if (qb > 0) {
        float g[7];
#pragma unroll
        for (int j = 0; j < 7; ++j) g[j] = 0.f;
        const float* km = (const float*)(P->ws + WS_KMEAN) + (size_t)((b * 4 + h) * 8) * 64;
#pragma unroll
        for (int dc = 0; dc < 8; ++dc) {
            const u32x4 qv = *(const u32x4*)(qrow + dc * 8);
            float qf[8]; qf[0] = bf2f(qv.x & 0xffffu); qf[1] = bf2f(qv.x >> 16); qf[2] = bf2f(qv.y & 0xffffu); qf[3] = bf2f(qv.y >> 16);
            qf[4] = bf2f(qv.z & 0xffffu); qf[5] = bf2f(qv.z >> 16); qf[6] = bf2f(qv.w & 0xffffu); qf[7] = bf2f(qv.w >> 16);
#pragma unroll
            for (int j = 0; j < 7; ++j) if (j < qb) { const float* kmj = km + j * 64 + dc * 8;
#pragma unroll
                for (int e = 0; e < 8; ++e) g[j] = fmaf(qf[e], kmj[e], g[j]); }
        }
#pragma unroll
        for (int j = 0; j < 7; ++j) if (j < qb) { int rank = 0;
#pragma unroll
            for (int i = 0; i < 7; ++i) if (i != j && i < qb) rank += (g[i] > g[j] || (g[i] == g[j] && i < j)) ? 1 : 0;
            if (rank < 3) mask |= 1u << j; }
    }
    AState A; astate_init(A);
    const float c31 = P->rel_bias[31 * 16 + h] * LOG2E;
    run_tiles<0, 4, false, 1>(C.lds, 0, 4 * qb + 3, C.proj + (size_t)b * SEQ * PW + C_MK + h * 64, C.proj + (size_t)b * SEQ * PW + C_MV + h * 64, qr, c31, q0w, mask, qb, A, C.wave, C.lane, C.r32, C.hi);
    const float inv = rcpf_(xhalf_sum(A.l));
    A.o0 *= inv; A.o1 *= inv;
    { const int l2 = lane_opaque(); const size_t tok2 = (size_t)b * SEQ + q0w + (l2 & 31);
      store_o(C.obuf + tok2 * DM + h * 64, A.o0, A.o1, l2 >> 5); }
}

__device__ __forceinline__ void diff_unit(const Ctx& C0, KParamsPtr P, int layer, int b, int h, int qb) {
    Ctx C = C0; C.lane = lane_opaque(); C.tid = C.wave * 64 + C.lane; C.r32 = C.lane & 31; C.hi = C.lane >> 5;
    const int q0w = __builtin_amdgcn_readfirstlane(qb * 256 + C.wave * 32); const int qpos = q0w + C.r32; const size_t tok = (size_t)b * SEQ + qpos;
    build_lut(C.lds, P->rel_bias, 4 + h, false, C.tid);
    bf16x8 qr[4]; load_q(qr, C.proj + tok * PW + C_DQ + h * 64, C.hi);
    AState A; astate_init(A);
    const float c31 = P->rel_bias[31 * 16 + 4 + h] * LOG2E;
    const u16* Kg = C.proj + (size_t)b * SEQ * PW + C_DK + h * 64; const u16* Vg = C.proj + (size_t)b * SEQ * PW + C_DV + h * 64;
    run_tiles<0, 2, false, 0>(C.lds, 0, 4 * qb + 3, Kg, Vg, qr, c31, q0w, 0u, 0, A, C.wave, C.lane, C.r32, C.hi);
    LAS float* park = (LAS float*)(C.lds + ATT_PARK) + C.tid;
    { const float i0 = rcpf_(xhalf_sum(A.l));
#pragma unroll
      for (int r = 0; r < 16; ++r) { park[r * 512] = A.o0[r] * i0; park[(16 + r) * 512] = A.o1[r] * i0; } }
    astate_init(A);
    run_tiles<2, 2, false, 0>(C.lds, 0, 4 * qb + 3, Kg, Vg, qr, c31, q0w, 0u, 0, A, C.wave, C.lane, C.r32, C.hi);
    const float* lp = P->diff_lambda + (size_t)layer * 128; float d01 = 0.f, d23 = 0.f;
    for (int i = 0; i < 32; ++i) { d01 = fmaf(lp[i], lp[32 + i], d01); d23 = fmaf(lp[64 + i], lp[96 + i], d23); }
    const float li = P->lam_init[layer]; const float lam = expf(d01) - expf(d23) + li;
    const float i1 = lam * rcpf_(xhalf_sum(A.l));
    float ss = 0.f;
#pragma unroll
    for (int r = 0; r < 16; ++r) { A.o0[r] = park[r * 512] - A.o0[r] * i1; A.o1[r] = park[(16 + r) * 512] - A.o1[r] * i1; ss += A.o0[r] * A.o0[r] + A.o1[r] * A.o1[r]; }
    ss = xhalf_sum(ss);
    const float rstd = (1.0f / sqrtf(ss * (1.0f / 64.0f) + 1e-6f)) * (1.0f - li);
    const float* sg = P->diff_subln + (size_t)layer * 64;
#pragma unroll
    for (int r = 0; r < 16; ++r) { const int d = crow(r, C.hi); A.o0[r] *= rstd * sg[d]; A.o1[r] *= rstd * sg[32 + d]; }
    { const int l2 = lane_opaque(); const size_t tok2 = (size_t)b * SEQ + q0w + (l2 & 31);
      store_o(C.obuf + tok2 * DM + 256 + h * 64, A.o0, A.o1, l2 >> 5); }
}

__device__ __forceinline__ void nsa_unit(const Ctx& C0, KParamsPtr P, int b, int hq, int qb) {
    Ctx C = C0; C.lane = lane_opaque(); C.tid = C.wave * 64 + C.lane; C.r32 = C.lane & 31; C.hi = C.lane >> 5;
    const int g = hq >> 2;
    const int q0w = __builtin_amdgcn_readfirstlane(qb * 256 + C.wave * 32); const int qpos = q0w + C.r32; const size_t tok = (size_t)b * SEQ + qpos;
    build_lut(C.lds, P->rel_bias, 8 + hq, false, C.tid);
    bf16x8 qr[4]; load_q(qr, C.proj + tok * PW + C_NQ + hq * 64, C.hi);
    const u16* gl = C.proj + tok * PW + C_NG + hq * 3;
    const float g1 = sigmoid_f(bf2f(gl[1])), g2 = sigmoid_f(bf2f(gl[2]));
    const unsigned mask = ((const unsigned*)(P->ws + WS_SEL))[(size_t)(b * 2 + g) * SEQ + qpos];
    const float c31 = P->rel_bias[31 * 16 + 8 + hq] * LOG2E;
    AState A; astate_init(A);
    run_tiles<0, 4, false, 2>(C.lds, 0, 4 * qb + 3, C.proj + (size_t)b * SEQ * PW + C_NKS + g * 64, C.proj + (size_t)b * SEQ * PW + C_NVS + g * 64, qr, c31, q0w, mask, qb, A, C.wave, C.lane, C.r32, C.hi);
    LAS float* park = (LAS float*)(C.lds + ATT_PARK) + C.tid;
    { const float f = g1 * rcpf_(xhalf_sum(A.l));
#pragma unroll
      for (int r = 0; r < 16; ++r) { park[r * 512] = A.o0[r] * f; park[(16 + r) * 512] = A.o1[r] * f; } }
    if (C.tid < 96) ((LAS float*)(C.lds + ATT_LUT))[608 + C.tid] = NEGF;
    astate_init(A);
    const int tw0 = 4 * qb - 8 < 0 ? 0 : 4 * qb - 8;
    run_tiles<0, 4, true, 0>(C.lds, tw0, 4 * qb + 3, C.proj + (size_t)b * SEQ * PW + C_NKW + g * 64, C.proj + (size_t)b * SEQ * PW + C_NVW + g * 64, qr, c31, q0w, 0u, qb, A, C.wave, C.lane, C.r32, C.hi);
    { const float f = g2 * rcpf_(xhalf_sum(A.l));
#pragma unroll
      for (int r = 0; r < 16; ++r) { A.o0[r] = A.o0[r] * f + park[r * 512]; A.o1[r] = A.o1[r] * f + park[(16 + r) * 512]; } }
    const int l2 = lane_opaque(); const int hi2 = l2 >> 5;
    u16* dst = C.obuf + ((size_t)b * SEQ + q0w + (l2 & 31)) * DM + 512 + hq * 64;
#pragma unroll
    for (int gg = 0; gg < 4; ++gg) {
        const u32x2 a = *(const u32x2*)(dst + 8 * gg + 4 * hi2), bq = *(const u32x2*)(dst + 32 + 8 * gg + 4 * hi2);
        A.o0[4 * gg] += bf2f(a.x & 0xffffu); A.o0[4 * gg + 1] += bf2f(a.x >> 16); A.o0[4 * gg + 2] += bf2f(a.y & 0xffffu); A.o0[4 * gg + 3] += bf2f(a.y >> 16);
        A.o1[4 * gg] += bf2f(bq.x & 0xffffu); A.o1[4 * gg + 1] += bf2f(bq.x >> 16); A.o1[4 * gg + 2] += bf2f(bq.y & 0xffffu); A.o1[4 * gg + 3] += bf2f(bq.y >> 16);
    }
    store_o(dst, A.o0, A.o1, hi2);
}

__device__ __forceinline__ void cmp_unit(const Ctx& C0, KParamsPtr P, int b, int g, int qblk) {
    Ctx C = C0; C.lane = lane_opaque(); C.tid = C.wave * 64 + C.lane; C.r32 = C.lane & 31; C.hi = C.lane >> 5;
    LAS unsigned char* lds = C.lds; const int tid = C.tid, r32 = C.r32, hi = C.hi;
    const u16* kc = (const u16*)(P->ws + WS_KCMP) + (size_t)(b * 2 + g) * 128 * 64;
    const u16* vc = (const u16*)(P->ws + WS_VCMPT) + (size_t)(b * 2 + g) * 64 * 128;
#pragma unroll
    for (int i = 0; i < 2; ++i) { const int e = tid + 512 * i;
        { const int row = e >> 3, ch = e & 7; *(LAS u32x4*)(lds + CMP_K + row * 144 + ch * 16) = *(const u32x4*)(kc + row * 64 + ch * 8); }
        { const int row = e >> 4, ch = e & 15; *(LAS u32x4*)(lds + CMP_V + row * 272 + ch * 16) = *(const u32x4*)(vc + row * 128 + ch * 8); } }
    const int q0w = __builtin_amdgcn_readfirstlane(qblk * 256 + C.wave * 32); const int qpos = q0w + r32; const size_t tok = (size_t)b * SEQ + qpos;
    const int nmax = (qpos - 31) >> 4;
    __syncthreads();
    float qa[16], qh[16];
#pragma unroll
    for (int i = 0; i < 16; ++i) { qa[i] = 0.f; qh[i] = 0.f; }
    const LAS unsigned char* kp = lds + CMP_K + r32 * 144 + hi * 16;
    const LAS unsigned char* vp = lds + CMP_V + r32 * 272 + hi * 16;
    bf16x8 qn[4]; load_q(qn, C.proj + tok * PW + C_NQ + g * 4 * 64, hi);
    float gsig[4];
#pragma unroll
    for (int rh = 0; rh < 4; ++rh) gsig[rh] = bf2f(C.proj[tok * PW + C_NG + (g * 4 + rh) * 3]);
    const int nkb = (qblk >> 1) + 1;
#pragma unroll
    for (int rh = 0; rh < 4; ++rh) {
        const int hq = g * 4 + rh;
        bf16x8 qr[4];
#pragma unroll
        for (int ks = 0; ks < 4; ++ks) qr[ks] = qn[ks];
        load_q(qn, C.proj + tok * PW + C_NQ + (g * 4 + (rh < 3 ? rh + 1 : rh)) * 64, hi);
        const float g0 = sigmoid_f(gsig[rh]);
        f32x16 s[4];
#pragma unroll
        for (int kb = 0; kb < 4; ++kb) {
#pragma unroll
            for (int r = 0; r < 16; ++r) s[kb][r] = 0.f;
            if (kb < nkb) {
#pragma unroll
                for (int ks = 0; ks < 4; ++ks) { const bf16x8 a = *(const LAS bf16x8*)(kp + kb * 32 * 144 + ks * 32); s[kb] = __builtin_amdgcn_mfma_f32_32x32x16_bf16(a, qr[ks], s[kb], 0, 0, 0); }
            }
        }
        float mx = NEGF;
#pragma unroll
        for (int kb = 0; kb < 4; ++kb) if (kb < nkb) {
#pragma unroll
            for (int r = 0; r < 16; ++r) { const int n = 32 * kb + crow(r, hi); const float v = (n <= nmax) ? s[kb][r] : NEGF; s[kb][r] = v; mx = fmaxf(mx, v); } }
        mx = xhalf_max(mx);
        float sum = 0.f;
#pragma unroll
        for (int kb = 0; kb < 4; ++kb) if (kb < nkb) {
#pragma unroll
            for (int r = 0; r < 16; ++r) { const int n = 32 * kb + crow(r, hi); const float pv = (n <= nmax) ? ex2(s[kb][r] - mx) : 0.f; s[kb][r] = pv; sum += pv; } }
        sum = xhalf_sum(sum);
        const float inv = nmax >= 0 ? rcpf_(sum) : 0.f;
        f32x16 o0, o1;
#pragma unroll
        for (int r = 0; r < 16; ++r) { o0[r] = 0.f; o1[r] = 0.f; }
#pragma unroll
        for (int kb = 0; kb < 4; ++kb) if (kb < nkb) {
#pragma unroll
            for (int r = 0; r < 16; ++r) s[kb][r] *= inv;
#pragma unroll
            for (int g4 = 0; g4 < 4; ++g4) { const float h = 0.5f * s[kb][4 * g4 + 3]; qh[kb * 4 + g4] += h; qa[kb * 4 + g4] += (s[kb][4 * g4] + s[kb][4 * g4 + 1]) + (s[kb][4 * g4 + 2] + h); }
#pragma unroll
            for (int c = 0; c < 2; ++c) {
                const u32x4 pk = (u32x4){pkbf(s[kb][8 * c], s[kb][8 * c + 1]), pkbf(s[kb][8 * c + 2], s[kb][8 * c + 3]), pkbf(s[kb][8 * c + 4], s[kb][8 * c + 5]), pkbf(s[kb][8 * c + 6], s[kb][8 * c + 7])};
                const bf16x8 pb = __builtin_bit_cast(bf16x8, pk);
                const bf16x8 v0 = *(const LAS bf16x8*)(vp + (kb * 2 + c) * 32);
                const bf16x8 v1 = *(const LAS bf16x8*)(vp + 32 * 272 + (kb * 2 + c) * 32);
                o0 = __builtin_amdgcn_mfma_f32_32x32x16_bf16(v0, pb, o0, 0, 0, 0);
                o1 = __builtin_amdgcn_mfma_f32_32x32x16_bf16(v1, pb, o1, 0, 0, 0);
            }
            __builtin_amdgcn_sched_barrier(0);
        }
        o0 *= g0; o1 *= g0;
        store_o(C.obuf + tok * DM + 512 + hq * 64, o0, o1, hi);
    }
    LAS float* Aq = (LAS float*)(lds + CMP_A) + (C.wave * 32 + r32) * 33; LAS float* Hq = (LAS float*)(lds + CMP_H) + (C.wave * 32 + r32) * 33;
#pragma unroll
    for (int kb = 0; kb < 4; ++kb)
#pragma unroll
        for (int g4 = 0; g4 < 4; ++g4) { const int j = 8 * kb + 2 * g4 + hi; Aq[j] = qa[kb * 4 + g4]; Hq[j] = qh[kb * 4 + g4]; }
    __syncthreads();
    const int cur = q0w >> 6;
    unsigned bits = 0;
    if (cur < 16) bits = (2u << cur) - 1u;
    else {
        float sc[32];
#pragma unroll
        for (int i = 0; i < 32; ++i) { const float imp = Aq[i] + (i > 0 ? Hq[i - 1] : 0.f); sc[i] = (i > cur) ? -3.0e38f : ((i == 0 || i > cur - 2) ? 1e4f : imp); }
#pragma unroll
        for (int e = 0; e < 16; ++e) {
            const float sj = hi ? sc[16 + e] : sc[e]; int rank = 0;
#pragma unroll
            for (int i = 0; i < 32; ++i) { const bool lt = (i < e) || (hi && i < 16 + e);
                rank += (sc[i] > sj || (sc[i] == sj && lt)) ? 1 : 0; }
            const int j = hi * 16 + e;
            if (j <= cur && rank < 16) bits |= 1u << j; }
        { auto rr = __builtin_amdgcn_permlane32_swap(bits, bits, false, false); bits = rr[0] | rr[1]; }
    }
    if (hi == 0) ((unsigned*)(P->ws + WS_SEL))[(size_t)(b * 2 + g) * SEQ + qpos] = bits;
    __syncthreads();
}

__device__ __forceinline__ void prep_vk(const Ctx& C, KParamsPtr P, int b0) {
    (void)b0; const int lane = C.lane, qd = C.wave & 3; LAS float* part = (LAS float*)C.lds;
    for (int base = C.bx * 2; base < NB * 4 * 8; base += C.G * 2) {
        const int it = base + (C.wave >> 2), blk = it & 7, h = (it >> 3) & 3, b = it >> 5;
        const u16* kp = C.proj + ((size_t)b * SEQ + blk * 256 + qd * 64) * PW + C_MK + h * 64 + lane; float s = 0.f;
        for (int k = 0; k < 64; k += 16) { float t[16];
#pragma unroll
            for (int e = 0; e < 16; ++e) t[e] = bf2f(kp[(size_t)(k + e) * PW]);
            s += (((t[0] + t[1]) + (t[2] + t[3])) + ((t[4] + t[5]) + (t[6] + t[7]))) + (((t[8] + t[9]) + (t[10] + t[11])) + ((t[12] + t[13]) + (t[14] + t[15]))); }
        part[C.wave * 64 + lane] = s;
        __syncthreads();
        if (qd == 0) ((float*)(P->ws + WS_KMEAN))[(size_t)it * 64 + lane] = ((part[C.wave * 64 + lane] + part[(C.wave + 1) * 64 + lane]) + (part[(C.wave + 2) * 64 + lane] + part[(C.wave + 3) * 64 + lane])) * (1.0f / 256.0f);
        __syncthreads();
    }
}
__device__ __forceinline__ void prep_a(const Ctx& C, KParamsPtr P, int layer) {
    const int G = C.G, lane = C.lane;
    const int gw = C.bx * 8 + C.wave, NGW = G * 8;
    u16* acmp = (u16*)(P->ws + WS_VT);
    for (int it = gw; it < 2 * 4096; it += NGW) {
        const int i = it >> 12, row = it & 4095, n = row & 127, bg = row >> 7, b = bg >> 1, g = bg & 1;
        u16* dst = acmp + (size_t)it * 2048; const float* pe = P->cmp_pe + (size_t)(layer * 2 + i) * 2048;
        const int col = (i == 0 ? C_NKC : C_NVC) + g * 64;
#pragma unroll
        for (int pass = 0; pass < 4; ++pass) { const int l = pass * 8 + (lane >> 3), d0 = (lane & 7) * 8;
            unsigned z0 = 0u; asm volatile("" : "+v"(z0)); u32x4 o = (u32x4){z0, z0, z0, z0};
            if (n < 127) { const u32x4 v = *(const u32x4*)(C.proj + ((size_t)b * SEQ + 16 * n + l) * PW + col + d0); const f32x4 e0 = *(const f32x4*)(pe + l * 64 + d0), e1 = *(const f32x4*)(pe + l * 64 + d0 + 4);
                o.x = pkbf(bf2f(v.x & 0xffffu) + e0.x, bf2f(v.x >> 16) + e0.y); o.y = pkbf(bf2f(v.y & 0xffffu) + e0.z, bf2f(v.y >> 16) + e0.w);
                o.z = pkbf(bf2f(v.z & 0xffffu) + e1.x, bf2f(v.z >> 16) + e1.y); o.w = pkbf(bf2f(v.w & 0xffffu) + e1.z, bf2f(v.w >> 16) + e1.w); }
            *(u32x4*)(dst + l * 64 + d0) = o; }
    }
}
__device__ __forceinline__ void prep_c(const Ctx& C, KParamsPtr P, int layer, int it0) {
    const int i = it0 >> 12, row0 = it0 & 4095, lane = lane_opaque(), tid = C.wave * 64 + lane, r32 = lane & 31, hi = lane >> 5;
    const float* w2 = P->cmp_w2 + (size_t)(layer * 2 + i) * 256 * 64;
    for (int e = tid; e < 256 * 64; e += 512) { const int k = e >> 6, c = e & 63; *(LAS u16*)(C.lds + c * 528 + k * 2) = (u16)(pkbf(w2[e], 0.f) & 0xffffu); }
    __syncthreads();
    const int wrow = row0 + C.wave * 32;
    const u16* hrow = (const u16*)(P->ws + WS_HID) + ((size_t)i * 4096 + wrow + r32) * 256 + hi * 8;
    f32x16 d0, d1;
#pragma unroll
    for (int r = 0; r < 16; ++r) { d0[r] = 0.f; d1[r] = 0.f; }
#pragma unroll 4
    for (int ks = 0; ks < 16; ++ks) {
        const bf16x8 a = *(const bf16x8*)(hrow + ks * 16);
        const bf16x8 b0 = *(const LAS bf16x8*)(C.lds + r32 * 528 + (ks * 16 + hi * 8) * 2);
        const bf16x8 b1 = *(const LAS bf16x8*)(C.lds + (32 + r32) * 528 + (ks * 16 + hi * 8) * 2);
        d0 = __builtin_amdgcn_mfma_f32_32x32x16_bf16(a, b0, d0, 0, 0, 0);
        d1 = __builtin_amdgcn_mfma_f32_32x32x16_bf16(a, b1, d1, 0, 0, 0);
    }
#pragma unroll
    for (int r = 0; r < 16; ++r) { const int row = wrow + crow(r, hi);
        const unsigned v0 = pkbf(d0[r], 0.f) & 0xffffu, v1 = pkbf(d1[r], 0.f) & 0xffffu;
        if (i == 0) { u16* o = (u16*)(P->ws + WS_KCMP) + (size_t)row * 64; o[r32] = (u16)v0; o[32 + r32] = (u16)v1; }
        else { const int bg = row >> 7, n = row & 127; u16* o = (u16*)(P->ws + WS_VCMPT) + (size_t)bg * 64 * 128 + (n & ~15) + pperm(n & 15); o[(size_t)r32 * 128] = (u16)v0; o[(size_t)(32 + r32) * 128] = (u16)v1; }
    }
}

__device__ __forceinline__ void convert_weights(const Ctx& C, KParamsPtr P, int layer) {
    LAS float* scr = (LAS float*)(C.lds + C.wave * 16384);
    const int gw = C.bx * 8 + C.wave, NGW = C.G * 8, lane = C.lane;
    constexpr int I_G = 16 * 88, I_D = 44 * 32, I_IN = 16 * 96, I_O = 16 * 32, I_W1 = 32 * 8;
    constexpr int NIT = 4 * I_G + 2 * I_D + I_IN + I_O + 2 * I_W1;
    unsigned char* ws = P->ws;
    for (int it = gw; it < NIT; it += NGW) {
        int r = it;
        if (r < 4 * I_G) { const int which = r / I_G; r -= which * I_G; const int kb = r / 88, nb = r % 88, n0 = nb * 32;
            const float* W = (which == 0 ? P->ffn1_gate : which == 1 ? P->ffn1_up : which == 2 ? P->ffn2_gate : P->ffn2_up) + (size_t)layer * DM * DFF;
            u16* WT = (u16*)(ws + (which < 2 ? WS_GU1 : WS_GU2));
            tr_item(W, DM, DFF, WT, kb, n0, (n0 >> 7) * 256 + (which & 1) * 128 + (n0 & 127), scr, lane, 1.0f, (which < 2 ? P->norm_ffn1 : P->norm_ffn2) + (size_t)layer * DM); continue; }
        r -= 4 * I_G;
        if (r < 2 * I_D) { const int which = r / I_D; r -= which * I_D; const int kb = r / 32, nb = r % 32;
            const float* W = (which == 0 ? P->ffn1_down : P->ffn2_down) + (size_t)layer * DFF * DM;
            tr_item(W, DFF, DM, (u16*)(ws + (which == 0 ? WS_DN1 : WS_DN2)), kb, nb * 32, nb * 32, scr, lane); continue; }
        r -= 2 * I_D;
        if (r < I_IN) { const int kb = r / 96, nb = r % 96, n0 = nb * 32;
            const float cs = (n0 < C_MK || (n0 >= C_NQ && n0 < C_NKC)) ? 0.125f * LOG2E : (n0 >= C_DQ && n0 < C_DK) ? 0.17677669529663687f * LOG2E : 1.0f;
            tr_item(P->w_in + (size_t)layer * DM * INW, DM, INW, (u16*)(ws + WS_WIN), kb, n0, n0, scr, lane, cs, P->norm_mix + (size_t)layer * DM); continue; }
        r -= I_IN;
        if (r < I_O) { const int kb = r / 32, nb = r % 32; tr_item(P->w_out + (size_t)layer * DM * DM, DM, DM, (u16*)(ws + WS_WOUT), kb, nb * 32, nb * 32, scr, lane); continue; }
        r -= I_O;
        { const int i = r / I_W1; r -= i * I_W1; const int kb = r / 8, nb = r % 8;
            tr_item(P->cmp_w1 + (size_t)(layer * 2 + i) * 2048 * 256, 2048, 256, (u16*)(ws + WS_W1) + (size_t)i * 256 * 2048, kb, nb * 32, nb * 32, scr, lane); }
    }
}
__device__ __forceinline__ void norm_phase(const Ctx& C, const float* src32, const u16* src16, const float* g, u16* dst16, float* dst32, u16* xb0) {
    const int gw = C.bx * 8 + C.wave, NGW = C.G * 8;
    for (int m = gw; m < MTOK; m += NGW) norm_row(src32 ? src32 + (size_t)m * DM : nullptr, src16 ? src16 + (size_t)m * DM : nullptr, g, dst16 ? dst16 + (size_t)m * DM : nullptr, dst32 ? dst32 + (size_t)m * DM : nullptr, xb0 ? xb0 + (size_t)m * DM : nullptr, C.lane);
}

#define XB_TMO      128
#define XB_XCNT(j)  (256  + 64 * (j))
#define XB_XSUB(j)  (1280 + 64 * (j))
#define XB_XGEN(j)  (2304 + 64 * (j))
#define XB_TOP      3328
#define XB_TOPGEN   3392
#define XCD_BAR_WORDS 3456
#define XB_SPIN_CAP (1u << 18)

__device__ __forceinline__ unsigned xb_ld(unsigned* p)              { return __hip_atomic_load(p, __ATOMIC_RELAXED, __HIP_MEMORY_SCOPE_AGENT); }
__device__ __forceinline__ unsigned xb_add(unsigned* p, unsigned v) { return __hip_atomic_fetch_add(p, v, __ATOMIC_RELAXED, __HIP_MEMORY_SCOPE_AGENT); }
__device__ __forceinline__ unsigned xb_xcc_id() { return (unsigned)__builtin_amdgcn_s_getreg((3 << 11) | 20) & 0xFu; }
#define XB_SPIN(cond, bar) do { unsigned _sp = 0; while (cond) { __builtin_amdgcn_s_sleep(1); \
    if ((++_sp & 255u) == 0u) { if (xb_ld(&(bar)[XB_TMO])) break; if (_sp > XB_SPIN_CAP) { atomicAdd(&(bar)[XB_TMO], 1u); break; } } } } while (0)

struct XcdBarrier {
    unsigned* bar; unsigned x;
    volatile LAS unsigned* st;
};

__device__ __forceinline__ XcdBarrier xcd_barrier_post(unsigned* bar, volatile LAS unsigned* st) {
    XcdBarrier b; b.bar = bar; b.x = xb_xcc_id(); b.st = st;
    if (threadIdx.x == 0) (void)xb_add(&bar[XB_XCNT(b.x)], 1u);
    return b;
}
__device__ __forceinline__ void xcd_barrier_complete(unsigned* bar, unsigned x, unsigned& nloc, unsigned& nx) {
    const unsigned G = gridDim.x * gridDim.y * gridDim.z;
    unsigned sum, cnt, mine, sp = 0u;
    for (;;) {
        sum = 0u; cnt = 0u; mine = 0u;
#pragma unroll
        for (unsigned j = 0; j < 16; ++j) { const unsigned c = xb_ld(&bar[XB_XCNT(j)]); sum += c; cnt += (c > 0u) ? 1u : 0u; mine = (j == x) ? c : mine; }
        if (sum == G) break;
        __builtin_amdgcn_s_sleep(1);
        if ((++sp & 255u) == 0u) { if (xb_ld(&bar[XB_TMO])) break; if (sp > XB_SPIN_CAP) { atomicAdd(&bar[XB_TMO], 1u); break; } }
    }
    nloc = mine > 0u ? mine : 1u; nx = cnt > 0u ? cnt : 1u;
}

__device__ __forceinline__ void xcd_barrier(const XcdBarrier& b) {
    asm volatile("s_waitcnt vmcnt(0)" ::: "memory");
    __syncthreads();
    if (threadIdx.x == 0) {
        unsigned* bar = b.bar;
        __builtin_amdgcn_s_waitcnt(0);
        unsigned nloc = b.st[0], nx = b.st[1];
        if (nloc == 0u) { xcd_barrier_complete(bar, b.x, nloc, nx); b.st[0] = nloc; b.st[1] = nx; }
        const unsigned old = xb_add(&bar[XB_XSUB(b.x)], 1u);
        const unsigned gen = old / nloc;
        if (old + 1u == (gen + 1u) * nloc) {
            __builtin_amdgcn_fence(__ATOMIC_RELEASE, "agent");
            asm volatile("s_waitcnt vmcnt(0)" ::: "memory");
            const unsigned og = xb_add(&bar[XB_TOP], 1u);
            const unsigned tg = og / nx;
            if (og + 1u == (tg + 1u) * nx) xb_add(&bar[XB_TOPGEN], 1u);
            else XB_SPIN(xb_ld(&bar[XB_TOPGEN]) == tg, bar);
            __builtin_amdgcn_fence(__ATOMIC_ACQUIRE, "agent");
            xb_add(&bar[XB_XGEN(b.x)], 1u);
            asm volatile("s_waitcnt vmcnt(0)" ::: "memory");
        } else {
            XB_SPIN(xb_ld(&bar[XB_XGEN(b.x)]) == gen, bar);
            __builtin_amdgcn_fence(__ATOMIC_ACQUIRE, "agent");
            asm volatile("s_waitcnt vmcnt(0)" ::: "memory");
        }
    }
    __syncthreads();
}


__device__ __forceinline__ void fill_rtab(const Ctx& C, const pg8::StaticOrder& S, const float* SS, LAS float* rtab) {
    LAS int* pml = (LAS int*)(rtab + 11 * 256);
    int nu = 0; { pg8::Unit u_; for (int i_ = 0; i_ < 11 && S.next(i_, u_); ++i_) { if (C.tid == 0) pml[i_] = u_.pm; nu = i_ + 1; } }
    __syncthreads();
    const int tot = nu * 256; float rsv[6];
#pragma unroll
    for (int k = 0; k < 6; ++k) { const int e = C.tid + 512 * k; rsv[k] = e < tot ? pg8::row_rstd(SS, pml[e >> 8] * 256 + (e & 255)) : 0.f; }
#pragma unroll
    for (int k = 0; k < 6; ++k) { const int e = C.tid + 512 * k; if (e < tot) rtab[e] = rsv[k]; }
    __syncthreads();
}
__device__ __forceinline__ void x0_phase(const Ctx& C, const float* src, u16* xb, float* ss) {
    const int gw = C.bx * 8 + C.wave, NGW = C.G * 8, lane = C.lane;
    for (int m = gw; m < MTOK; m += NGW) {
        const f32x4* xr = (const f32x4*)(src + (size_t)m * DM) + lane; float s = 0.f;
#pragma unroll
        for (int j = 0; j < 4; ++j) { const f32x4 v = xr[64 * j]; s += (v.x * v.x + v.y * v.y) + (v.z * v.z + v.w * v.w);
            u32x2 o; o.x = pkbf(v.x, v.y); o.y = pkbf(v.z, v.w); *((u32x2*)(xb + (size_t)m * DM) + lane + 64 * j) = o; }
        s = wave_sum(s, lane);
        if (lane < 16) ss[(size_t)m * 16 + lane] = lane == 0 ? s : 0.f;
    }
}
__device__ __forceinline__ void unit_publish(unsigned* flag, int tid) {
    asm volatile("s_waitcnt vmcnt(0)" ::: "memory"); __syncthreads();
    if (tid == 0) { __builtin_amdgcn_fence(__ATOMIC_RELEASE, "agent"); asm volatile("s_waitcnt vmcnt(0)" ::: "memory"); __hip_atomic_store(flag, 1u, __ATOMIC_RELAXED, __HIP_MEMORY_SCOPE_AGENT); }
}
__device__ __forceinline__ void unit_wait(unsigned* f0, unsigned* f1, int tid) {
    if (tid == 0) { unsigned sp = 0;
        while ((__hip_atomic_load(f0, __ATOMIC_RELAXED, __HIP_MEMORY_SCOPE_AGENT) == 0u || __hip_atomic_load(f1, __ATOMIC_RELAXED, __HIP_MEMORY_SCOPE_AGENT) == 0u) && ++sp < (1u << 24)) __builtin_amdgcn_s_sleep(8);
        __builtin_amdgcn_fence(__ATOMIC_ACQUIRE, "agent"); asm volatile("s_waitcnt vmcnt(0)" ::: "memory"); }
    __syncthreads();
}
struct OneUnit { int pm;
    __device__ __forceinline__ bool next(int i, pg8::Unit& u) const { if (i) return false; u.pm = pm; u.pn = 0; return true; }
    __device__ __forceinline__ void a_ready(const pg8::Unit&) const {}
    __device__ __forceinline__ void done(const pg8::Unit&) const {} };
__global__ void __launch_bounds__(512, 2) hybrid_fwd(Params P0) {
    extern __shared__ __attribute__((aligned(16))) unsigned char lds_raw[];
    const KParamsPtr kp0 = (KParamsPtr)__builtin_amdgcn_kernarg_segment_ptr();
    cg::grid_group grid = cg::this_grid();
    { volatile LAS unsigned* misc = (volatile LAS unsigned*)((LAS unsigned char*)lds_raw + MISC_OFF); if (threadIdx.x < 2) misc[threadIdx.x] = 0u; }
    __syncthreads();
    XcdBarrier bar = xcd_barrier_post((unsigned*)(P0.ws + WS_CTL) + 1024, (volatile LAS unsigned*)((LAS unsigned char*)lds_raw + MISC_OFF));
    const int ph_lo = P0.ph_lo, ph_hi = P0.ph_hi; const int wave_s = __builtin_amdgcn_readfirstlane(threadIdx.x >> 6);
    bool redone = false; (void)redone;
    for (int ph = ph_lo; ph < ph_hi; ++ph) {
        KParamsPtr kpl = kp0; asm volatile("" : "+s"(kpl));
        const KParamsPtr P = kpl; unsigned char* ws = P->ws;
        u16* XN = (u16*)(ws + WS_XN); u16* HB = (u16*)(ws + WS_PROJ);
        int G = gridDim.x, bx = blockIdx.x; asm volatile("" : "+s"(G), "+s"(bx));
        Ctx C; C.G = G; C.bx = bx; C.lds = (LAS unsigned char*)lds_raw; C.wave = wave_s; C.lane = lane_opaque(); C.tid = wave_s * 64 + C.lane; C.r32 = C.lane & 31; C.hi = C.lane >> 5;
        C.proj = (u16*)(ws + WS_PROJ); C.obuf = (u16*)(ws + WS_XN); C.vt = (u16*)(ws + WS_VT);
        const int layer = ph / NPH_L, s = ph % NPH_L;
        if (ph != NPH - 1 && (s == 7 || s == 3 || s == 11 || s == 8 || s == 9)) continue;
        float* SS = (float*)(ws + WS_SS);
        u16* XB = (u16*)(ws + WS_XB);
        if (ph == NPH - 1) { norm_phase(C, nullptr, XB, P->final_norm, nullptr, P->out, nullptr); }
        else switch (s) {
        case 0: { convert_weights(C, P, layer); if (layer == 0) { __syncthreads(); x0_phase(C, P->x, XB, SS); } } break;
#ifndef NO_GEMM
#ifndef NO_G1
        case 1: case 12: {
            pg8::Gemm g{XB, (const u16*)(ws + (s == 1 ? WS_GU1 : WS_GU2)), MTOK, 2 * DFF, DM}; pg8::StaticOrder S; S.init(MTOK, 2 * DFF, G, bx);
            LAS float* rtab = (LAS float*)(C.lds + RTAB_OFF); fill_rtab(C, S, SS, rtab);
            pg8::EpiSwiGLU E{HB, DFF, rtab, 0};
            pg8::gemm_phase<pg8::EpiSwiGLU, pg8::StaticOrder, true, true>(C.lds, g, S, E, C.wave); } break;
#endif
#ifndef NO_G2
        case 2: case 13: case 10: {
            const u16* A = (s == 10) ? (const u16*)XN : (const u16*)HB; const u16* Bt = (const u16*)(ws + (s == 2 ? WS_DN1 : s == 13 ? WS_DN2 : WS_WOUT));
            pg8::Gemm g{A, Bt, MTOK, DM, s == 10 ? DM : DFF}; pg8::StaticOrder S; S.init(MTOK, DM, G, bx);
            pg8::EpiResid E{XB, DM, s == 10 ? 1.0f : 0.5f, SS};
            pg8::gemm_phase<pg8::EpiResid, pg8::StaticOrder, false, true>(C.lds, g, S, E, C.wave); } break;
#endif
#ifndef NO_G4
        case 4: {
            pg8::Gemm g{XB, (const u16*)(ws + WS_WIN), MTOK, PW, DM}; pg8::StaticOrder S; S.init(MTOK, PW, G, bx);
            LAS float* rtab = (LAS float*)(C.lds + RTAB_OFF); fill_rtab(C, S, SS, rtab);
            pg8::EpiBf16<0> E{C.proj, PW, rtab, 0};
            pg8::gemm_phase<pg8::EpiBf16<0>, pg8::StaticOrder, true, true>(C.lds, g, S, E, C.wave); } break;
#endif
#endif
#ifndef NO_PREP
        case 5: prep_a(C, P, layer); prep_vk(C, P, 0); break;
#endif
#if !defined(NO_GEMM) && !defined(NO_G6)
        case 6: {
            unsigned* ctl = (unsigned*)(ws + WS_CTL); unsigned* qctr = ctl + 8192 + 64 * ph + (redone ? 32 : 0); unsigned* fcomp = ctl + 16384 + 64 * ph; unsigned* fcmp = ctl + 24576 + 256 * (ph / NPH_L);
            volatile LAS unsigned* qslot = (volatile LAS unsigned*)(C.lds + MISC_OFF + 16);
            for (;;) {
                if (C.tid == 0) *qslot = __hip_atomic_fetch_add(qctr, 1u, __ATOMIC_RELAXED, __HIP_MEMORY_SCOPE_AGENT);
                __syncthreads();
                const unsigned u = *qslot;
                __syncthreads();
                if (u >= 32u + 512u + 256u + 1024u + 512u) break;
                if (u < 32u) { const int i = (int)u >> 4, tile = (int)u & 15;
                    pg8::Gemm g{(const u16*)(ws + WS_VT) + (size_t)i * 4096 * 2048, (const u16*)(ws + WS_W1) + (size_t)i * 256 * 2048, 4096, 256, 2048}; OneUnit S{tile};
                    pg8::EpiBf16<1> E{(u16*)(ws + WS_HID) + (size_t)i * 4096 * 256, 256, nullptr, 0};
                    pg8::gemm_phase<pg8::EpiBf16<1>, OneUnit, true, true>(C.lds, g, S, E, C.wave);
                    __builtin_amdgcn_fence(__ATOMIC_RELEASE, "agent"); __syncthreads(); __builtin_amdgcn_fence(__ATOMIC_ACQUIRE, "agent");
                    prep_c(C, P, layer, i * 4096 + tile * 256);
                    unit_publish(fcomp + u, C.tid);
                    __syncthreads();
                } else if (u < 544u || u >= 1824u) { const unsigned v = u < 544u ? u - 32u : u - 1824u + 512u; const int qb = 7 - (int)(v >> 7), w = (int)(v & 127);
                    if (w < 64) {
#ifndef NO_DIFF
                        diff_unit(C, P, layer, w >> 2, w & 3, qb);
#endif
                    } else {
#ifndef NO_MOBA
                        moba_unit(C, P, (w - 64) >> 2, w & 3, qb);
#endif
                    }
                } else if (u < 800u) { const int c = (int)u - 544, qblk = 7 - (c >> 5), bg = c & 31;
                    unit_wait(fcomp + (bg >> 1), fcomp + 16 + (bg >> 1), C.tid);
#ifndef NO_CMP
                    cmp_unit(C, P, bg >> 1, bg & 1, qblk);
#endif
                    unit_publish(fcmp + bg * 8 + qblk, C.tid);
                    __syncthreads();
                } else { const int v = (int)u - 800, qb = 7 - (v >> 7), b = (v & 127) >> 3, hq = v & 7; unsigned* f = fcmp + (b * 2 + (hq >> 2)) * 8 + qb;
                    unit_wait(f, f, C.tid);
#ifndef NO_ATT2
                    nsa_unit(C, P, b, hq, qb);
#endif
                }
            } } break;
#endif
        default: break;
        }
        if (ph + 1 < ph_hi) { if (ph == ph_lo) grid.sync(); else xcd_barrier(bar); }
#ifdef PROBE_LO
        if (ph != NPH - 1 && s == PROBE_HI) { if (!redone) { ph -= (PROBE_HI - PROBE_LO + 1); redone = true; } else redone = false; }
#endif
#ifdef PROBE_SYNC
        if (ph + 1 < ph_hi) xcd_barrier(bar);
#endif
    }
}

#ifndef COOP
#define COOP 1
#endif
extern "C" void kernel_launch(void* const* d_in, const int* in_sizes, int n_in, void* d_out, int out_size, void* d_ws, size_t ws_size, hipStream_t stream) {
    static int grid = 0;
    if (grid == 0) {
        if (n_in != 19 || out_size != MTOK * DM || ws_size < WS_END) { fprintf(stderr, "kernel_launch: unexpected shapes (n_in %d out %d ws %zu)\n", n_in, out_size, ws_size); grid = -1; return; }
        int dev = 0, cus = 0, per_cu = 0;
        (void)hipGetDevice(&dev); (void)hipDeviceGetAttribute(&cus, hipDeviceAttributeMultiprocessorCount, dev);
        if (hipFuncSetAttribute((const void*)hybrid_fwd, hipFuncAttributeMaxDynamicSharedMemorySize, LDS_BYTES) != hipSuccess) { fprintf(stderr, "kernel_launch: hipFuncSetAttribute failed\n"); grid = -1; return; }
        if (hipOccupancyMaxActiveBlocksPerMultiprocessor(&per_cu, (const void*)hybrid_fwd, 512, LDS_BYTES) != hipSuccess || per_cu < 1) { fprintf(stderr, "kernel_launch: occupancy query says %d\n", per_cu); per_cu = 1; }
        (void)hipGetLastError();
        grid = cus * per_cu;
    }
    if (grid < 0) return;
    Params p{};
    p.x = (const float*)d_in[0]; p.rel_bias = (const float*)d_in[1]; p.norm_ffn1 = (const float*)d_in[2]; p.ffn1_gate = (const float*)d_in[3]; p.ffn1_up = (const float*)d_in[4]; p.ffn1_down = (const float*)d_in[5];
    p.norm_mix = (const float*)d_in[6]; p.w_in = (const float*)d_in[7]; p.diff_lambda = (const float*)d_in[8]; p.diff_subln = (const float*)d_in[9]; p.cmp_pe = (const float*)d_in[10]; p.cmp_w1 = (const float*)d_in[11];
    p.cmp_w2 = (const float*)d_in[12]; p.w_out = (const float*)d_in[13]; p.norm_ffn2 = (const float*)d_in[14]; p.ffn2_gate = (const float*)d_in[15]; p.ffn2_up = (const float*)d_in[16]; p.ffn2_down = (const float*)d_in[17];
    p.final_norm = (const float*)d_in[18]; p.out = (float*)d_out; p.ws = (unsigned char*)d_ws;
    for (int l = 0; l < 4; ++l) p.lam_init[l] = (float)(0.8 - 0.6 * exp(-0.3 * (double)l));
#if COOP
    if (hipMemsetAsync((char*)d_ws + WS_CTL, 0, CTL_ZERO_BYTES, stream) != hipSuccess) { fprintf(stderr, "kernel_launch: memset of barrier words failed\n"); return; }
    p.ph_lo = 0; p.ph_hi = NPH;
    void* args[] = {&p};
    hipError_t e = hipLaunchCooperativeKernel((const void*)hybrid_fwd, dim3(grid), dim3(512), args, LDS_BYTES, stream);
    if (e != hipSuccess) fprintf(stderr, "cooperative launch failed: %s (grid %d)\n", hipGetErrorString(e), grid);
#else
    for (int ph = 0; ph < NPH; ++ph) { p.ph_lo = ph; p.ph_hi = ph + 1; hipLaunchKernelGGL(hybrid_fwd, dim3(grid), dim3(512), LDS_BYTES, stream, p); }
#endif
}
```

```cpp
#include <hip/hip_runtime.h>
#include <hip/hip_cooperative_groups.h>
#include <cstdio>
#include <cstdint>
#include <cmath>
namespace cg = cooperative_groups;
#define COOP 1
namespace pg8 {
#define PG8_LAS __attribute__((address_space(3)))
typedef unsigned short bf16_t;
typedef short bf16x8 __attribute__((ext_vector_type(8)));
typedef float f32x4 __attribute__((ext_vector_type(4)));
typedef unsigned u32x4 __attribute__((ext_vector_type(4)));
constexpr int BM = 256, BK = 64, HALF = 128, HTB = HALF * BK * 2  , STAGE_BYTES = 8 * HTB, NXCD = 8, WGM = 8;

__host__ __device__ __forceinline__ int lds_byte(int r, int c) { const int st = (r >> 4) * 2 + (c >> 5), rr = r & 15, cc = c & 31, ob = rr * 64 + cc * 2; return st * 1024 + (ob ^ (((ob >> 9) & 1) << 5)); }
__host__ __device__ __forceinline__ void stage_rc(int b, int& R, int& C) { const int st = b / 1024, sb = b % 1024, swz = sb ^ (((sb >> 9) & 1) << 5); R = (st >> 1) * 16 + swz / 64; C = (st & 1) * 32 + (swz % 64) / 2; }
__host__ __device__ __forceinline__ int perm32(int rho) { const int n = rho >> 4, i = rho & 15; return 8 * (i >> 2) + 4 * n + (i & 3); }

struct Unit { int pm, pn; };
struct Gemm { const bf16_t* A; const bf16_t* Bt; int M, N, K; };

struct StaticOrder {
    int nM, nN, nwg, G, c;
    __host__ __device__ void init(int M, int N, int G_, int c_) { nM = M / BM; nN = N / BM; nwg = nM * nN; G = G_; c = c_; }
    __host__ __device__ bool next(int i, Unit& u) const {
        const long L = (long)i * G + c; if (L >= nwg) return false;
        int wgid = (int)L; { const int q = nwg / NXCD, r = nwg % NXCD, xcd = wgid % NXCD, off = wgid / NXCD; wgid = (xcd < r ? xcd * (q + 1) : r * (q + 1) + (xcd - r) * q) + off; }
        const int nig = WGM * nN, gid = wgid / nig, fm = gid * WGM, gsz = (nM - fm) < WGM ? (nM - fm) : WGM;
        u.pm = fm + ((wgid % nig) % gsz); u.pn = (wgid % nig) / gsz; return true;
    }
    __device__ __forceinline__ void a_ready(const Unit&) const {}
    __device__ __forceinline__ void done(const Unit&) const {}
};

__device__ __forceinline__ unsigned cvt_pk_bf16(float lo, float hi) { unsigned r; asm volatile("v_cvt_pk_bf16_f32 %0, %1, %2" : "=v"(r) : "v"(lo), "v"(hi)); return r; }

__device__ __forceinline__ float ex2(float x) { return __builtin_amdgcn_exp2f(x); }
__device__ __forceinline__ float rcpf_(float x) { return __builtin_amdgcn_rcpf(x); }
__device__ __forceinline__ float silu_f(float x) { return x * rcpf_(1.0f + ex2(-1.4426950408889634f * x)); }
__device__ __forceinline__ float gelu_tanh_f(float x) { const float y2 = 2.0f * 0.7978845608028654f * (x + 0.044715f * x * x * x); return x * (1.0f - rcpf_(1.0f + ex2(1.4426950408889634f * y2))); }

__device__ __forceinline__ float row_rstd(const float* ss, int row) {
    const f32x4* p = (const f32x4*)(ss + (size_t)row * 16); const f32x4 a = p[0], b = p[1], c = p[2], d = p[3];
    const float s = ((a[0] + a[1]) + (a[2] + a[3])) + ((b[0] + b[1]) + (b[2] + b[3])) + ((c[0] + c[1]) + (c[2] + c[3])) + ((d[0] + d[1]) + (d[2] + d[3]));
    return 1.0f / sqrtf(s * (1.0f / 1024.0f) + 1e-6f);
}

struct EpiSwiGLU {
    static constexpr bool PERM = true, AFTER_DRAIN = false;
    bf16_t* O; int ldc; const PG8_LAS float* rtab; mutable int ui;
    __device__ __forceinline__ void operator()(const f32x4 (&acc)[2][2][4][2], const Unit& u, int wr, int wc, int fr, int fq) const {
        const int row0 = u.pm * BM + wr * 64 + fr; const int col0 = u.pn * HALF + wc * 32 + 8 * fq;
#pragma unroll
        for (int ai = 0; ai < 2; ++ai)
#pragma unroll
            for (int m = 0; m < 4; ++m) { bf16_t* rowp = O + (size_t)(row0 + ai * HALF + m * 16) * ldc + col0;
                const float rs = rtab[ui * 256 + wr * 64 + fr + ai * HALF + m * 16];
                const f32x4 g0 = acc[ai][0][m][0] * rs, g1 = acc[ai][0][m][1] * rs, u0 = acc[ai][1][m][0] * rs, u1 = acc[ai][1][m][1] * rs;
                u32x4 w; w.x = cvt_pk_bf16(silu_f(g0[0]) * u0[0], silu_f(g0[1]) * u0[1]); w.y = cvt_pk_bf16(silu_f(g0[2]) * u0[2], silu_f(g0[3]) * u0[3]);
                w.z = cvt_pk_bf16(silu_f(g1[0]) * u1[0], silu_f(g1[1]) * u1[1]); w.w = cvt_pk_bf16(silu_f(g1[2]) * u1[2], silu_f(g1[3]) * u1[3]);
                *(u32x4*)rowp = w; asm volatile("" ::: "memory"); }
        ++ui;
    }
};
template <int ACT> struct EpiBf16 {
    static constexpr bool PERM = true, AFTER_DRAIN = false;
    bf16_t* O; int ldc; const PG8_LAS float* rtab; mutable int ui;
    __device__ __forceinline__ void operator()(const f32x4 (&acc)[2][2][4][2], const Unit& u, int wr, int wc, int fr, int fq) const {
        const int row0 = u.pm * BM + wr * 64 + fr; const int col0 = u.pn * BM + wc * 32 + 8 * fq;
#pragma unroll
        for (int ai = 0; ai < 2; ++ai)
#pragma unroll
            for (int m = 0; m < 4; ++m) { bf16_t* rowp = O + (size_t)(row0 + ai * HALF + m * 16) * ldc + col0;
                const float rs = rtab ? rtab[ui * 256 + wr * 64 + fr + ai * HALF + m * 16] : 1.0f;
#pragma unroll
                for (int bj = 0; bj < 2; ++bj) { f32x4 v0 = acc[ai][bj][m][0] * rs, v1 = acc[ai][bj][m][1] * rs;
                    if (ACT == 1) { v0 = (f32x4){gelu_tanh_f(v0[0]), gelu_tanh_f(v0[1]), gelu_tanh_f(v0[2]), gelu_tanh_f(v0[3])}; v1 = (f32x4){gelu_tanh_f(v1[0]), gelu_tanh_f(v1[1]), gelu_tanh_f(v1[2]), gelu_tanh_f(v1[3])}; }
                    u32x4 w; w.x = cvt_pk_bf16(v0[0], v0[1]); w.y = cvt_pk_bf16(v0[2], v0[3]); w.z = cvt_pk_bf16(v1[0], v1[1]); w.w = cvt_pk_bf16(v1[2], v1[3]);
                    *(u32x4*)(rowp + bj * HALF) = w; } asm volatile("" ::: "memory"); }
        ++ui;
    }
};
struct EpiResid {
    static constexpr bool PERM = true, AFTER_DRAIN = false;
    bf16_t* xb; int ldc; float alpha; float* ss;
    __device__ __forceinline__ void operator()(const f32x4 (&acc)[2][2][4][2], const Unit& u, int wr, int wc, int fr, int fq) const {
        const int row0 = u.pm * BM + wr * 64 + fr; const int col0 = u.pn * BM + wc * 32 + 8 * fq; const int lane = fq * 16 + fr;
#pragma unroll
        for (int ai = 0; ai < 2; ++ai) {
            u32x4 pre[4][2];
#pragma unroll
            for (int m = 0; m < 4; ++m)
#pragma unroll
                for (int bj = 0; bj < 2; ++bj) pre[m][bj] = *(const u32x4*)(xb + (size_t)(row0 + ai * HALF + m * 16) * ldc + col0 + bj * HALF);
#pragma unroll
            for (int m = 0; m < 4; ++m) { const int row = row0 + ai * HALF + m * 16; bf16_t* rowp = xb + (size_t)row * ldc + col0; float sq = 0.f;
#pragma unroll
                for (int bj = 0; bj < 2; ++bj) { const u32x4 p = pre[m][bj]; const f32x4 a0 = acc[ai][bj][m][0] * alpha, a1 = acc[ai][bj][m][1] * alpha;
                    const float x0 = __uint_as_float(p.x << 16) + a0[0], x1 = __uint_as_float(p.x & 0xffff0000u) + a0[1], x2 = __uint_as_float(p.y << 16) + a0[2], x3 = __uint_as_float(p.y & 0xffff0000u) + a0[3];
                    const float x4 = __uint_as_float(p.z << 16) + a1[0], x5 = __uint_as_float(p.z & 0xffff0000u) + a1[1], x6 = __uint_as_float(p.w << 16) + a1[2], x7 = __uint_as_float(p.w & 0xffff0000u) + a1[3];
                    sq += ((x0 * x0 + x1 * x1) + (x2 * x2 + x3 * x3)) + ((x4 * x4 + x5 * x5) + (x6 * x6 + x7 * x7));
                    u32x4 w; w.x = cvt_pk_bf16(x0, x1); w.y = cvt_pk_bf16(x2, x3); w.z = cvt_pk_bf16(x4, x5); w.w = cvt_pk_bf16(x6, x7);
                    *(u32x4*)(rowp + bj * HALF) = w; }
                sq += __int_as_float(__builtin_amdgcn_ds_bpermute((lane ^ 16) << 2, __float_as_int(sq)));
                sq += __int_as_float(__builtin_amdgcn_ds_bpermute((lane ^ 32) << 2, __float_as_int(sq)));
                if (fq == 0) ss[(size_t)row * 16 + u.pn * 4 + wc] = sq; }
            asm volatile("" ::: "memory");
        }
    }
};
template <class Epi, class Sched, bool ALIGN_EPI = false, bool SP2 = false>
__device__ __forceinline__ void gemm_phase(PG8_LAS unsigned char* lds, const Gemm g, const Sched& S, const Epi& E, const int wave_in) {
    int tid_l; asm volatile("v_mbcnt_lo_u32_b32 %0, -1, 0\n\tv_mbcnt_hi_u32_b32 %0, -1, %0" : "=v"(tid_l)); tid_l += wave_in * 64;
    const int tid = tid_l, wid = __builtin_amdgcn_readfirstlane(tid >> 6), lane = tid & 63, wr = wid >> 2, wc = wid & 3, fr = lane & 15, fq = lane >> 4;
    const int K = g.K, nt = K / BK;
    unsigned voffA[2], voffB[2];
#pragma unroll
    for (int i = 0; i < 2; ++i) { int R, C; stage_rc(tid * 16 + i * 8192, R, C); const int Rb = Epi::PERM ? ((R & ~31) + perm32(R & 31)) : R;
        voffA[i] = (unsigned)(R * K + C) * 2u; voffB[i] = (unsigned)(Rb * K + C) * 2u; }
    const size_t kstep = (size_t)(BK * 2);
    const size_t hstep = (size_t)HALF * K * 2;
    const size_t tstep = 2 * hstep;
    const unsigned ldsw = (unsigned)wid * 1024u;
    const int aoff = lds_byte(wr * 64 + fr, fq * 8), boff = lds_byte(wc * 32 + fr, fq * 8);
#define PG8_SA(b, h) (((b) * 2 + (h)) * HTB)
#define PG8_SB(b, h) ((4 + (b) * 2 + (h)) * HTB)
#define PG8_STAGE(bufoff, gbase, voff) do { _Pragma("unroll") for (int _i = 0; _i < 2; ++_i) \
        __builtin_amdgcn_global_load_lds((const unsigned*)((const char*)(gbase) + (voff)[_i]), (PG8_LAS unsigned*)(lds + (bufoff) + ldsw + _i * 8192), 16, 0, 0); } while (0)
#define PG8_LDA(dst, b, h) do { _Pragma("unroll") for (int m = 0; m < 4; ++m) _Pragma("unroll") for (int k = 0; k < 2; ++k) dst[m][k] = *(const PG8_LAS bf16x8*)(lds + PG8_SA(b, h) + aoff + m * 2048 + k * 1024); } while (0)
#define PG8_LDB(dst, b, h) do { _Pragma("unroll") for (int n = 0; n < 2; ++n) _Pragma("unroll") for (int k = 0; k < 2; ++k) dst[n][k] = *(const PG8_LAS bf16x8*)(lds + PG8_SB(b, h) + boff + n * 2048 + k * 1024); } while (0)
#define PG8_MMA(ai, bj, At, Bt) do { __builtin_amdgcn_s_setprio(1); _Pragma("unroll") for (int m = 0; m < 4; ++m) _Pragma("unroll") for (int n = 0; n < 2; ++n) _Pragma("unroll") for (int k = 0; k < 2; ++k) \
        acc[ai][bj][m][n] = __builtin_amdgcn_mfma_f32_16x16x32_bf16(Bt[n][k], At[m][k], acc[ai][bj][m][n], 0, 0, 0); __builtin_amdgcn_s_setprio(0); } while (0)
#define PG8_WAIT_V(n) asm volatile("s_waitcnt vmcnt(" #n ")" ::: "memory")
#define PG8_WAIT_L(n) asm volatile("s_waitcnt lgkmcnt(" #n ")" ::: "memory")
#define PG8_BAR __builtin_amdgcn_s_barrier()
#define PG8_SCHED __builtin_amdgcn_sched_barrier(0)
    Unit cur, nxt; int ui = 0;
    if (!S.next(0, cur)) return;
    f32x4 acc[2][2][4][2];
#pragma unroll
    for (int a = 0; a < 2; ++a)
#pragma unroll
        for (int b = 0; b < 2; ++b)
#pragma unroll
            for (int m = 0; m < 4; ++m)
#pragma unroll
                for (int n = 0; n < 2; ++n) acc[a][b][m][n] = (f32x4){0.f, 0.f, 0.f, 0.f};
    bf16x8 At[4][2], B0[2][2], B1[2][2];
    const char* cA = (const char*)g.A + (size_t)cur.pm * tstep; const char* cB = (const char*)g.Bt + (size_t)cur.pn * tstep;
    S.a_ready(cur);
    if constexpr (SP2) {
        PG8_STAGE(PG8_SB(0, 0), cB, voffB); PG8_STAGE(PG8_SB(0, 1), cB + hstep, voffB); PG8_STAGE(PG8_SA(0, 0), cA, voffA); PG8_STAGE(PG8_SA(0, 1), cA + hstep, voffA);
        if (wr == 1) PG8_BAR;
        PG8_WAIT_V(2); PG8_BAR;
        PG8_STAGE(PG8_SB(1, 0), cB + kstep, voffB); PG8_STAGE(PG8_SA(1, 0), cA + kstep, voffA); PG8_STAGE(PG8_SB(1, 1), cB + hstep + kstep, voffB);
        PG8_WAIT_V(6); PG8_BAR;
    } else {
        PG8_STAGE(PG8_SB(0, 0), cB, voffB); PG8_STAGE(PG8_SA(0, 0), cA, voffA); PG8_STAGE(PG8_SB(0, 1), cB + hstep, voffB); PG8_STAGE(PG8_SA(0, 1), cA + hstep, voffA);
        if (wr == 1) PG8_BAR;
        PG8_WAIT_V(4); PG8_BAR;
        PG8_STAGE(PG8_SB(1, 0), cB + kstep, voffB); PG8_STAGE(PG8_SA(1, 0), cA + kstep, voffA); PG8_STAGE(PG8_SB(1, 1), cB + hstep + kstep, voffB);
        PG8_WAIT_V(6); PG8_BAR;
    }
    for (;;) {
        const bool has_next = S.next(ui + 1, nxt);
        const char* nA = has_next ? (const char*)g.A + (size_t)nxt.pm * tstep : cA; const char* nB = has_next ? (const char*)g.Bt + (size_t)nxt.pn * tstep : cB;
        for (int t = 0; t < nt; t += 2) {
            const bool last = (t == nt - 2);
            const char* a1 = cA + (size_t)(t + 1) * kstep;
            const char* a2 = last ? nA : cA + (size_t)(t + 2) * kstep; const char* b2 = last ? nB : cB + (size_t)(t + 2) * kstep;
            const char* a3 = a2 + kstep; const char* b3 = b2 + kstep;
            if (last && has_next) S.a_ready(nxt);
            if constexpr (SP2) {
            PG8_LDB(B0, 0, 0); PG8_LDB(B1, 0, 1); PG8_SCHED; PG8_LDA(At, 0, 0); PG8_STAGE(PG8_SA(1, 1), a1 + hstep, voffA);
            PG8_WAIT_V(8); PG8_WAIT_L(0); PG8_BAR; PG8_MMA(0, 0, At, B0); PG8_MMA(0, 1, At, B1); PG8_BAR; PG8_SCHED;
            PG8_LDA(At, 0, 1); PG8_STAGE(PG8_SB(0, 0), b2, voffB); PG8_STAGE(PG8_SB(0, 1), b2 + hstep, voffB); PG8_STAGE(PG8_SA(0, 0), a2, voffA);
            PG8_WAIT_V(8); PG8_WAIT_L(0); PG8_BAR; PG8_MMA(1, 0, At, B0); PG8_MMA(1, 1, At, B1); PG8_BAR; PG8_SCHED;
            PG8_LDB(B0, 1, 0); PG8_LDB(B1, 1, 1); PG8_SCHED; PG8_LDA(At, 1, 0); PG8_STAGE(PG8_SA(0, 1), a2 + hstep, voffA);
            PG8_WAIT_V(8); PG8_WAIT_L(0); PG8_BAR; PG8_MMA(0, 0, At, B0); PG8_MMA(0, 1, At, B1); PG8_BAR; PG8_SCHED;
            PG8_LDA(At, 1, 1); PG8_STAGE(PG8_SB(1, 0), b3, voffB); PG8_STAGE(PG8_SB(1, 1), b3 + hstep, voffB); PG8_STAGE(PG8_SA(1, 0), a3, voffA);
            PG8_WAIT_V(8); PG8_WAIT_L(0); PG8_BAR; PG8_MMA(1, 0, At, B0); PG8_MMA(1, 1, At, B1); PG8_BAR; PG8_SCHED;
            } else {
            PG8_LDB(B0, 0, 0); PG8_SCHED; PG8_LDA(At, 0, 0); PG8_STAGE(PG8_SA(1, 1), a1 + hstep, voffA);
            PG8_WAIT_L(8); PG8_BAR; PG8_WAIT_L(0); PG8_MMA(0, 0, At, B0); PG8_BAR; PG8_SCHED;
            PG8_LDB(B1, 0, 1); PG8_STAGE(PG8_SB(0, 0), b2, voffB);
            PG8_BAR; PG8_WAIT_L(0); PG8_MMA(0, 1, At, B1); PG8_BAR;
            PG8_LDA(At, 0, 1); PG8_STAGE(PG8_SA(0, 0), a2, voffA);
            PG8_BAR; PG8_WAIT_L(0); PG8_MMA(1, 0, At, B0); PG8_BAR; PG8_SCHED;
            PG8_STAGE(PG8_SB(0, 1), b2 + hstep, voffB);
            PG8_WAIT_V(6); PG8_BAR; PG8_MMA(1, 1, At, B1); PG8_BAR;
            PG8_LDB(B0, 1, 0); PG8_SCHED; PG8_LDA(At, 1, 0); PG8_STAGE(PG8_SA(0, 1), a2 + hstep, voffA);
            PG8_WAIT_L(8); PG8_BAR; PG8_WAIT_L(0); PG8_MMA(0, 0, At, B0); PG8_BAR; PG8_SCHED;
            PG8_LDB(B1, 1, 1); PG8_STAGE(PG8_SB(1, 0), b3, voffB);
            PG8_BAR; PG8_WAIT_L(0); PG8_MMA(0, 1, At, B1); PG8_BAR;
            PG8_LDA(At, 1, 1); PG8_STAGE(PG8_SA(1, 0), a3, voffA);
            PG8_BAR; PG8_WAIT_L(0); PG8_MMA(1, 0, At, B0); PG8_BAR; PG8_SCHED;
            PG8_STAGE(PG8_SB(1, 1), b3 + hstep, voffB);
            PG8_WAIT_V(6); PG8_BAR; PG8_MMA(1, 1, At, B1); PG8_BAR;
            }
        }
        if constexpr (ALIGN_EPI) { if (wr == 0) PG8_BAR; }
        if constexpr (!Epi::AFTER_DRAIN) { E(acc, cur, wr, wc, fr, fq); S.done(cur); }
        if (!has_next) break;
#pragma unroll
        for (int a = 0; a < 2; ++a)
#pragma unroll
            for (int b = 0; b < 2; ++b)
#pragma unroll
                for (int m = 0; m < 4; ++m)
#pragma unroll
                    for (int n = 0; n < 2; ++n) acc[a][b][m][n] = (f32x4){0.f, 0.f, 0.f, 0.f};
        cur = nxt; cA = nA; cB = nB; ++ui;
        if constexpr (ALIGN_EPI) { if (wr == 1) PG8_BAR; }
    }
    PG8_WAIT_V(0);
    if constexpr (!ALIGN_EPI) { if (wr == 0) PG8_BAR; }
    PG8_BAR;
    if constexpr (Epi::AFTER_DRAIN) { E.fused(acc, cur, wr, wc, fr, fq, lds, wid, lane); S.done(cur); }
#undef PG8_SA
#undef PG8_SB
#undef PG8_STAGE
#undef PG8_LDA
#undef PG8_LDB
#undef PG8_MMA
#undef PG8_WAIT_V
#undef PG8_WAIT_L
#undef PG8_BAR
#undef PG8_SCHED
}
}

#define LAS __attribute__((address_space(3)))
using pg8::ex2; using pg8::rcpf_;
typedef unsigned short u16;
typedef short bf16x8 __attribute__((ext_vector_type(8)));
typedef float f32x4 __attribute__((ext_vector_type(4)));
typedef float f32x16 __attribute__((ext_vector_type(16)));
typedef unsigned u32x4 __attribute__((ext_vector_type(4)));
typedef unsigned u32x2 __attribute__((ext_vector_type(2)));

constexpr int DM = 1024, NB = 16, SEQ = 2048, MTOK = NB * SEQ, DEPTH = 4, DFF = 2816, INW = 2840, PW = 3072;
constexpr int C_MQ = 0, C_MK = 256, C_MV = 512, C_DQ = 768, C_DK = 1024, C_DV = 1280, C_NQ = 1536, C_NKC = 2048, C_NVC = 2176, C_NKS = 2304, C_NVS = 2432, C_NKW = 2560, C_NVW = 2688, C_NG = 2816;
constexpr int NVH = 12;
constexpr float LOG2E = 1.4426950408889634f, NEGF = -1e30f;
constexpr int NPH_L = 14, NPH = NPH_L * DEPTH + 1;
constexpr size_t MiB = 1u << 20;
constexpr size_t WS_GU1 = 1 * MiB, WS_DN1 = 12 * MiB, WS_GU2 = WS_DN1 + 5 * MiB + MiB / 2, WS_DN2 = WS_GU2 + 11 * MiB, WS_WIN = 34 * MiB, WS_WOUT = 40 * MiB, WS_W1 = 42 * MiB;
constexpr size_t WS_PROJ = 44 * MiB, WS_XN = 236 * MiB, WS_VT = 300 * MiB, WS_HID = 348 * MiB, WS_KCMP = 352 * MiB, WS_VCMPT = WS_KCMP + MiB / 2, WS_KMEAN = 353 * MiB, WS_SEL = WS_KMEAN + MiB / 4, WS_XB = 354 * MiB, WS_SS = 418 * MiB, WS_END = 420 * MiB;
static_assert(WS_DN2 + 5 * MiB + MiB / 2 == WS_WIN, "ws map");
constexpr int LDS_BYTES = 147456, MISC_OFF = 147456 - 64, RTAB_OFF = 131072;
constexpr size_t WS_CTL = 0, CTL_ZERO_BYTES = 262144;
constexpr int ATT_K = 0, ATT_V = 32768, ATT_LUT = 32768 + 4 * 8704, ATT_PARK = ATT_LUT + 2816;
constexpr int CMP_K = 0, CMP_V = 18432, CMP_A = 36864, CMP_H = CMP_A + 256 * 33 * 4;

struct Params {
    const float* x; const float* rel_bias; const float* norm_ffn1; const float* ffn1_gate; const float* ffn1_up; const float* ffn1_down;
    const float* norm_mix; const float* w_in; const float* diff_lambda; const float* diff_subln; const float* cmp_pe; const float* cmp_w1; const float* cmp_w2;
    const float* w_out; const float* norm_ffn2; const float* ffn2_gate; const float* ffn2_up; const float* ffn2_down; const float* final_norm;
    float* out; unsigned char* ws;
    float lam_init[4];
    int ph_lo, ph_hi;
};
typedef const __attribute__((address_space(4))) Params* KParamsPtr;

__device__ __forceinline__ float bf2f(unsigned v) { return __uint_as_float(v << 16); }
typedef float f32x2_t __attribute__((ext_vector_type(2))); typedef __bf16 bf16x2_t __attribute__((ext_vector_type(2)));
__device__ __forceinline__ unsigned pkbf(float lo, float hi) { f32x2_t v = {lo, hi}; bf16x2_t b = __builtin_convertvector(v, bf16x2_t); return __builtin_bit_cast(unsigned, b); }
__device__ __forceinline__ int lane_opaque() { int l; asm volatile("v_mbcnt_lo_u32_b32 %0, -1, 0\n\tv_mbcnt_hi_u32_b32 %0, -1, %0" : "=v"(l)); return l; }
__device__ __forceinline__ float wave_sum(float v, int lane) {
#pragma unroll
    for (int o = 1; o < 64; o <<= 1) v += __int_as_float(__builtin_amdgcn_ds_bpermute((lane ^ o) << 2, __float_as_int(v)));
    return v;
}
__device__ __forceinline__ float xhalf_max(float v) { auto rr = __builtin_amdgcn_permlane32_swap(__float_as_uint(v), __float_as_uint(v), false, false); return fmaxf(__uint_as_float(rr[0]), __uint_as_float(rr[1])); }
__device__ __forceinline__ float xhalf_sum(float v) { auto rr = __builtin_amdgcn_permlane32_swap(__float_as_uint(v), __float_as_uint(v), false, false); return __uint_as_float(rr[0]) + __uint_as_float(rr[1]); }
__device__ __forceinline__ float sigmoid_f(float x) { return rcpf_(1.0f + ex2(-LOG2E * x)); }
__device__ __forceinline__ int crow(int r, int hi) { return (r & 3) + 8 * (r >> 2) + 4 * hi; }
__device__ __forceinline__ int kperm(int p) { const int h = p >> 3, j = p & 7; return 8 * (j >> 2) + 4 * h + (j & 3); }
__device__ __forceinline__ int pperm(int k) { return ((k >> 2) & 1) * 8 + (k >> 3) * 4 + (k & 3); }

__device__ __forceinline__ void tr_item(const float* W, int K, int N, u16* WT, int kb, int n0, int dst_row0, LAS float* scr, int lane, float cs = 1.0f, const float* gk = nullptr) {
    const int k0 = 64 * kb; const int n = n0 + (lane & 31); const bool ok = n < N;
    float wv[32];
#pragma unroll
    for (int i = 0; i < 32; ++i) { const int kk = 2 * i + (lane >> 5); wv[i] = ok ? W[(size_t)(k0 + kk) * N + n] : 0.f; }
#pragma unroll
    for (int i = 0; i < 32; ++i) { const int kk = 2 * i + (lane >> 5); scr[kk * 33 + (lane & 31)] = wv[i] * (gk ? gk[k0 + kk] * cs : cs); }
    asm volatile("s_waitcnt lgkmcnt(0)" ::: "memory");
    const int c = lane & 7;
#pragma unroll
    for (int j = 0; j < 4; ++j) { const int nn = (lane >> 3) + 8 * j; const LAS float* s = scr + (8 * c) * 33 + nn;
        u32x4 o; o.x = pkbf(s[0 * 33], s[1 * 33]); o.y = pkbf(s[2 * 33], s[3 * 33]); o.z = pkbf(s[4 * 33], s[5 * 33]); o.w = pkbf(s[6 * 33], s[7 * 33]);
        *(u32x4*)(WT + (size_t)(dst_row0 + nn) * K + k0 + 8 * c) = o; }
    asm volatile("s_waitcnt lgkmcnt(0)" ::: "memory");
}

__device__ __forceinline__ void norm_row(const float* xrow, const u16* xrow16, const float* g, u16* dst16, float* dst32, u16* xb0, int lane) {
    float v[16];
    if (xrow) { const f32x4* xr = (const f32x4*)xrow + 4 * lane;
#pragma unroll
        for (int j = 0; j < 4; ++j) { const f32x4 t = xr[j]; v[4 * j] = t.x; v[4 * j + 1] = t.y; v[4 * j + 2] = t.z; v[4 * j + 3] = t.w; }
        if (xb0) { u32x4 o0, o1; o0.x = pkbf(v[0], v[1]); o0.y = pkbf(v[2], v[3]); o0.z = pkbf(v[4], v[5]); o0.w = pkbf(v[6], v[7]); o1.x = pkbf(v[8], v[9]); o1.y = pkbf(v[10], v[11]); o1.z = pkbf(v[12], v[13]); o1.w = pkbf(v[14], v[15]);
            ((u32x4*)xb0)[2 * lane] = o0; ((u32x4*)xb0)[2 * lane + 1] = o1; }
    } else { const u32x4 p0 = ((const u32x4*)xrow16)[2 * lane], p1 = ((const u32x4*)xrow16)[2 * lane + 1];
        v[0] = bf2f(p0.x & 0xffffu); v[1] = bf2f(p0.x >> 16); v[2] = bf2f(p0.y & 0xffffu); v[3] = bf2f(p0.y >> 16); v[4] = bf2f(p0.z & 0xffffu); v[5] = bf2f(p0.z >> 16); v[6] = bf2f(p0.w & 0xffffu); v[7] = bf2f(p0.w >> 16);
        v[8] = bf2f(p1.x & 0xffffu); v[9] = bf2f(p1.x >> 16); v[10] = bf2f(p1.y & 0xffffu); v[11] = bf2f(p1.y >> 16); v[12] = bf2f(p1.z & 0xffffu); v[13] = bf2f(p1.z >> 16); v[14] = bf2f(p1.w & 0xffffu); v[15] = bf2f(p1.w >> 16); }
    float s = 0.f;
#pragma unroll
    for (int j = 0; j < 16; ++j) s = fmaf(v[j], v[j], s);
    const float rstd = 1.0f / sqrtf(wave_sum(s, lane) * (1.0f / 1024.0f) + 1e-6f);
    const f32x4* gr = (const f32x4*)g + 4 * lane;
#pragma unroll
    for (int j = 0; j < 4; ++j) { const f32x4 gg = gr[j]; v[4 * j] *= rstd * gg.x; v[4 * j + 1] *= rstd * gg.y; v[4 * j + 2] *= rstd * gg.z; v[4 * j + 3] *= rstd * gg.w; }
    if (dst16) { u32x4 o0, o1; o0.x = pkbf(v[0], v[1]); o0.y = pkbf(v[2], v[3]); o0.z = pkbf(v[4], v[5]); o0.w = pkbf(v[6], v[7]); o1.x = pkbf(v[8], v[9]); o1.y = pkbf(v[10], v[11]); o1.z = pkbf(v[12], v[13]); o1.w = pkbf(v[14], v[15]);
        ((u32x4*)dst16)[2 * lane] = o0; ((u32x4*)dst16)[2 * lane + 1] = o1; }
    else {
#pragma unroll
        for (int j = 0; j < 4; ++j) ((f32x4*)dst32)[4 * lane + j] = (f32x4){v[4 * j], v[4 * j + 1], v[4 * j + 2], v[4 * j + 3]}; }
}

struct AState { f32x16 o0, o1; float m, l; };
__device__ __forceinline__ void astate_init(AState& s) {
#pragma unroll
    for (int r = 0; r < 16; ++r) { s.o0[r] = 0.f; s.o1[r] = 0.f; }
    s.m = 0.f; s.l = 0.f;
}
constexpr float ATT_THR = 8.0f;
constexpr int ATT_SLOT = 9216, ATT_NSLOT = 3;
template <int KS0, int NKS>
__device__ __forceinline__ void qk_block(const LAS unsigned char* Ks, const bf16x8 (&qr)[4], int r32, int hi, f32x16& s0, f32x16& s1) {
    f32x16 ci;
#pragma unroll
    for (int r = 0; r < 16; ++r) ci[r] = 0.f;
    const LAS unsigned char* kp = Ks + hi * 1024 + r32 * 16;
#pragma unroll
    for (int ks = 0; ks < NKS; ++ks) {
        const bf16x8 a0 = *(const LAS bf16x8*)(kp + (KS0 + ks) * 2048);
        const bf16x8 a1 = *(const LAS bf16x8*)(kp + (KS0 + ks) * 2048 + 512);
        s0 = __builtin_amdgcn_mfma_f32_32x32x16_bf16(a0, qr[KS0 + ks], ks == 0 ? ci : s0, 0, 0, 0);
        s1 = __builtin_amdgcn_mfma_f32_32x32x16_bf16(a1, qr[KS0 + ks], ks == 0 ? ci : s1, 0, 0, 0);
    }
    __builtin_amdgcn_sched_group_barrier(0x100, 2 * NKS, 0); __builtin_amdgcn_sched_group_barrier(0x008, 2 * NKS, 0);
}
constexpr int ATT_VCH = 1088, ATT_VSLOT = 8 * ATT_VCH;
typedef short v4i16_t __attribute__((ext_vector_type(4)));
__device__ __forceinline__ void pv_block(const LAS unsigned char* Vs, const u32x4 (&pk)[4], int lane, AState& st) {
    const int p = lane & 3, q = (lane & 15) >> 2, dsel = (lane >> 4) & 1, hi = lane >> 5;
    const LAS unsigned char* vp = Vs + (2 * dsel + (p >> 1)) * ATT_VCH + (4 * hi + q) * 16 + (p & 1) * 8;
#pragma unroll
    for (int c = 0; c < 4; ++c) {
        const v4i16_t a0 = __builtin_amdgcn_ds_read_tr16_b64_v4i16((LAS v4i16_t*)(vp + c * 256));
        const v4i16_t a1 = __builtin_amdgcn_ds_read_tr16_b64_v4i16((LAS v4i16_t*)(vp + c * 256 + 128));
        const v4i16_t b0 = __builtin_amdgcn_ds_read_tr16_b64_v4i16((LAS v4i16_t*)(vp + 4 * ATT_VCH + c * 256));
        const v4i16_t b1 = __builtin_amdgcn_ds_read_tr16_b64_v4i16((LAS v4i16_t*)(vp + 4 * ATT_VCH + c * 256 + 128));
        const bf16x8 v0 = (bf16x8){a0[0], a0[1], a0[2], a0[3], a1[0], a1[1], a1[2], a1[3]};
        const bf16x8 v1 = (bf16x8){b0[0], b0[1], b0[2], b0[3], b1[0], b1[1], b1[2], b1[3]};
        const bf16x8 pb = __builtin_bit_cast(bf16x8, pk[c]);
        st.o0 = __builtin_amdgcn_mfma_f32_32x32x16_bf16(v0, pb, st.o0, 0, 0, 0);
        st.o1 = __builtin_amdgcn_mfma_f32_32x32x16_bf16(v1, pb, st.o1, 0, 0, 0);
    }
}
__device__ __forceinline__ void glds16(const void* gsrc, unsigned lds_dst) { unsigned keep;
    asm volatile("s_mov_b32 %0, m0\n\ts_mov_b32 m0, %2\n\ts_nop 0\n\tglobal_load_lds_dwordx4 %1, off\n\ts_mov_b32 m0, %0" : "=&s"(keep) : "v"(gsrc), "s"(lds_dst) : "memory"); }
__device__ __forceinline__ void lut_add(f32x16& s0, f32x16& s1, const LAS float* lutz, int dbase, float cc) {
    const LAS float* lp = lutz + (dbase - 59);
#pragma unroll
    for (int r = 0; r < 16; ++r) { const int ko = (r & 3) + 8 * (r >> 2);
        s0[r] += lp[59 - ko] + cc; s1[r] += lp[27 - ko] + cc; }
}
__device__ __forceinline__ void const_add(f32x16& s0, f32x16& s1, float cc) {
#pragma unroll
    for (int r = 0; r < 16; ++r) { s0[r] += cc; s1[r] += cc; }
}
__device__ __forceinline__ float row_max(const f32x16& s0, const f32x16& s1) {
    float mx = fmaxf(s0[0], s1[0]);
#pragma unroll
    for (int r = 1; r < 16; ++r) mx = fmaxf(mx, fmaxf(s0[r], s1[r]));
    return xhalf_max(mx);
}
__device__ __forceinline__ void rescale(AState& st, f32x16& s0, f32x16& s1, float mx) {
    const float dl = fmaxf(mx, 0.f); const float f = ex2(-dl); st.m += dl; st.l *= f;
#pragma unroll
    for (int r = 0; r < 16; ++r) { st.o0[r] *= f; st.o1[r] *= f; s0[r] -= dl; s1[r] -= dl; }
}
constexpr float ATT_BIG = 1024.0f;
__device__ __forceinline__ void exp_pack(f32x16& s0, f32x16& s1, u32x4 (&pk)[4], AState& st) {
    float sum = 0.f;
#pragma unroll
    for (int r = 0; r < 16; ++r) { s0[r] = ex2(s0[r]); s1[r] = ex2(s1[r]); sum += s0[r] + s1[r]; }
    if (__any(sum > ATT_BIG)) {
        float mx = fmaxf(s0[0], s1[0]);
#pragma unroll
        for (int r = 1; r < 16; ++r) mx = fmaxf(mx, fmaxf(s0[r], s1[r]));
        mx = xhalf_max(mx);
        const float dl = fmaxf(__builtin_amdgcn_logf(fmaxf(mx, 1.0f)), 0.f), f = ex2(-dl);
        st.m += dl; st.l *= f; sum *= f;
#pragma unroll
        for (int r = 0; r < 16; ++r) { st.o0[r] *= f; st.o1[r] *= f; s0[r] *= f; s1[r] *= f; }
    }
    st.l += sum;
    pk[0] = (u32x4){pkbf(s0[0], s0[1]), pkbf(s0[2], s0[3]), pkbf(s0[4], s0[5]), pkbf(s0[6], s0[7])};
    pk[1] = (u32x4){pkbf(s0[8], s0[9]), pkbf(s0[10], s0[11]), pkbf(s0[12], s0[13]), pkbf(s0[14], s0[15])};
    pk[2] = (u32x4){pkbf(s1[0], s1[1]), pkbf(s1[2], s1[3]), pkbf(s1[4], s1[5]), pkbf(s1[6], s1[7])};
    pk[3] = (u32x4){pkbf(s1[8], s1[9]), pkbf(s1[10], s1[11]), pkbf(s1[12], s1[13]), pkbf(s1[14], s1[15])};
}

template <int KS0, int NKS, bool WINDOW, int MODE>
__device__ __forceinline__ void run_tiles(LAS unsigned char* lds, int t0, int t1, const u16* Kg, const u16* Vtg, const bf16x8 (&qr)[4], float c31,
                                          int q0w, unsigned mask, int qb, AState& A, int wave, int lane, int r32, int hi) {
    LAS unsigned char* Kr = lds + ATT_K; LAS unsigned char* Vr = lds + ATT_V; const LAS float* lut1 = (const LAS float*)(lds + ATT_LUT) + 96;
    const u16* ksrc = Kg + (size_t)lane * PW + wave * 8;
    const u16* vsrc = Vtg + (size_t)lane * PW + wave * 8;
    const unsigned kdst = (unsigned)(uintptr_t)Kr + wave * 1024, vdst = (unsigned)(uintptr_t)Vr + wave * ATT_VCH;
#define TCL(t) ((t) < t0 ? t0 : ((t) > t1 ? t1 : (t)))
#define DMA_K(tn) glds16(ksrc + (size_t)TCL(tn) * 64 * PW, (unsigned)__builtin_amdgcn_readfirstlane(kdst + ((tn) & 3) * 8192))
#define DMA_V(tn) glds16(vsrc + (size_t)TCL(tn) * 64 * PW, (unsigned)__builtin_amdgcn_readfirstlane(vdst + ((tn) & 3) * ATT_VSLOT))
#define KS_(t) (Kr + ((t) & 3) * 8192)
#define VS_(t) (Vr + ((t) & 3) * ATT_VSLOT)
#define WAIT_BAR4() asm volatile("s_waitcnt vmcnt(4) lgkmcnt(0)\n\ts_barrier" ::: "memory")
#define T_ACTIVE(t) (!((q0w + 31 - (t) * 64) < 0 || (WINDOW && (q0w - ((t) * 64 + 63)) >= 512)))
#define T_LUTMODE(t) (((q0w - ((t) * 64 + 63)) < 128) || (WINDOW && (q0w + 31 - (t) * 64) >= 512))
    auto tile_sel = [&](int t) -> int { if (MODE == 1) { const int blk = t >> 2; return blk < qb ? (int)((mask >> blk) & 1u) : 1; } if (MODE == 2) return (int)((mask >> t) & 1u); return 1; };
    asm volatile("s_waitcnt vmcnt(0)" ::: "memory");
#pragma unroll
    for (int j = 0; j < 4; ++j) { DMA_K(t0 + j); DMA_V(t0 + j - 2); }
    WAIT_BAR4();
    f32x16 sn0, sn1, sc0, sc1; u32x4 pk[4];
#pragma unroll
    for (int r = 0; r < 16; ++r) { sn0[r] = 0.f; sn1[r] = 0.f; }
#pragma unroll
    for (int i = 0; i < 4; ++i) pk[i] = (u32x4){0u, 0u, 0u, 0u};
    bool act_n = T_ACTIVE(t0), act_c = false, act_p = false;
    if (act_n) qk_block<KS0, NKS>(KS_(t0), qr, r32, hi, sn0, sn1);
    asm volatile("s_waitcnt lgkmcnt(0)\n\ts_barrier" ::: "memory");
    for (int c = t0; c <= t1 + 1; ++c) {
        act_p = act_c; act_c = act_n; sc0 = sn0; sc1 = sn1;
        DMA_K(c + 4); DMA_V(c + 2);
        act_n = (c + 1 <= t1) && T_ACTIVE(c + 1);
        const bool lm_c = T_LUTMODE(c);
        const int dbase = q0w + r32 - c * 64 - 4 * hi;
        const float selc = tile_sel(c) ? 0.f : NEGF;
        if (act_p) pv_block(VS_(c - 1), pk, lane, A);
        if (act_c) {
            const float cc = selc - A.m;
            if (lm_c) lut_add(sc0, sc1, lut1, dbase, cc); else if (__any(cc != 0.f)) const_add(sc0, sc1, cc);
        }
        if (act_n) qk_block<KS0, NKS>(KS_(c + 1), qr, r32, hi, sn0, sn1);
        if (act_c) exp_pack(sc0, sc1, pk, A);
        WAIT_BAR4();
    }
    asm volatile("s_waitcnt vmcnt(0) lgkmcnt(0)\n\ts_barrier" ::: "memory");
#undef TCL
#undef DMA_K
#undef DMA_V
#undef KS_
#undef VS_
#undef WAIT_BAR4
#undef T_ACTIVE
#undef T_LUTMODE
}

__device__ __forceinline__ void build_lut(LAS unsigned char* lds, const float* rel_bias, int head, bool window, int tid) {
    LAS float* lut = (LAS float*)(lds + ATT_LUT);
    for (int i = tid; i < 704; i += 512) {
        const int d = i - 96; float v; const float c31 = rel_bias[31 * 16 + head];
        if (d < 0) v = NEGF;
        else if (d >= 512) v = window ? NEGF : 0.f;
        else { int bk;
            if (d < 16) bk = d; else if (d >= 128) bk = 31; else { bk = 16 + (int)(log2f((float)d * (1.0f / 16.0f)) * (16.0f / 3.0f)); bk = bk > 31 ? 31 : bk; }
            v = (rel_bias[bk * 16 + head] - c31) * LOG2E; }
        lut[i] = v;
    }
}
__device__ __forceinline__ void load_q(bf16x8 (&qr)[4], const u16* qrow, int hi) {
#pragma unroll
    for (int ks = 0; ks < 4; ++ks) qr[ks] = *(const bf16x8*)(qrow + ks * 16 + hi * 8);
}
__device__ __forceinline__ void store_o(u16* dst, const f32x16& v0, const f32x16& v1, int hi) {
#pragma unroll
    for (int p = 0; p < 2; ++p) {
        { const unsigned ax = pkbf(v0[8 * p], v0[8 * p + 1]), ay = pkbf(v0[8 * p + 2], v0[8 * p + 3]), bx = pkbf(v0[8 * p + 4], v0[8 * p + 5]), by = pkbf(v0[8 * p + 6], v0[8 * p + 7]);
          auto rx = __builtin_amdgcn_permlane32_swap(ax, bx, false, false); auto ry = __builtin_amdgcn_permlane32_swap(ay, by, false, false);
          *(u32x4*)(dst + 16 * p + 8 * hi) = (u32x4){rx[0], ry[0], rx[1], ry[1]}; }
        { const unsigned ax = pkbf(v1[8 * p], v1[8 * p + 1]), ay = pkbf(v1[8 * p + 2], v1[8 * p + 3]), bx = pkbf(v1[8 * p + 4], v1[8 * p + 5]), by = pkbf(v1[8 * p + 6], v1[8 * p + 7]);
          auto rx = __builtin_amdgcn_permlane32_swap(ax, bx, false, false); auto ry = __builtin_amdgcn_permlane32_swap(ay, by, false, false);
          *(u32x4*)(dst + 32 + 16 * p + 8 * hi) = (u32x4){rx[0], ry[0], rx[1], ry[1]}; }
    }
}

struct Ctx { LAS unsigned char* lds; int tid, lane, wave, r32, hi, G, bx; u16* proj; u16* obuf; u16* vt; };

__device__ __forceinline__ void moba_unit(const Ctx& C0, KParamsPtr P, int b, int h, int qb) {
    Ctx C = C0; C.lane = lane_opaque(); C.tid = C.wave * 64 + C.lane; C.r32 = C.lane & 31; C.hi = C.lane >> 5;
    const int q0w = __builtin_amdgcn_readfirstlane(qb * 256 + C.wave * 32); const int qpos = q0w + C.r32; const size_t tok = (size_t)b * SEQ + qpos;
    build_lut(C.lds, P->rel_bias, h, false, C.tid);
    const u16* qrow = C.proj + tok * PW + C_MQ + h * 64;
    bf16x8 qr[4]; load_q(qr, qrow, C.hi);
    unsigned mask = 0;
    if (qb > 0) {
        float g[7];
#pragma unroll
        for (int j = 0; j < 7; ++j) g[j] = 0.f;
        const float* km = (const float*)(P->ws + WS_KMEAN) + (size_t)((b * 4 + h) * 8) * 64;
#pragma unroll
        for (int dc = 0; dc < 8; ++dc) {
            const u32x4 qv = *(const u32x4*)(qrow + dc * 8);
            float qf[8]; qf[0] = bf2f(qv.x & 0xffffu); qf[1] = bf2f(qv.x >> 16); qf[2] = bf2f(qv.y & 0xffffu); qf[3] = bf2f(qv.y >> 16);
            qf[4] = bf2f(qv.z & 0xffffu); qf[5] = bf2f(qv.z >> 16); qf[6] = bf2f(qv.w & 0xffffu); qf[7] = bf2f(qv.w >> 16);
#pragma unroll
            for (int j = 0; j < 7; ++j) if (j < qb) { const float* kmj = km + j * 64 + dc * 8;
#pragma unroll
                for (int e = 0; e < 8; ++e) g[j] = fmaf(qf[e], kmj[e], g[j]); }
        }
#pragma unroll
        for (int j = 0; j < 7; ++j) if (j < qb) { int rank = 0;
#pragma unroll
            for (int i = 0; i < 7; ++i) if (i != j && i < qb) rank += (g[i] > g[j] || (g[i] == g[j] && i < j)) ? 1 : 0;
            if (rank < 3) mask |= 1u << j; }
    }
    AState A; astate_init(A);
    const float c31 = P->rel_bias[31 * 16 + h] * LOG2E;
    run_tiles<0, 4, false, 1>(C.lds, 0, 4 * qb + 3, C.proj + (size_t)b * SEQ * PW + C_MK + h * 64, C.proj + (size_t)b * SEQ * PW + C_MV + h * 64, qr, c31, q0w, mask, qb, A, C.wave, C.lane, C.r32, C.hi);
    const float inv = rcpf_(xhalf_sum(A.l));
    A.o0 *= inv; A.o1 *= inv;
    { const int l2 = lane_opaque(); const size_t tok2 = (size_t)b * SEQ + q0w + (l2 & 31);
      store_o(C.obuf + tok2 * DM + h * 64, A.o0, A.o1, l2 >> 5); }
}

__device__ __forceinline__ void diff_unit(const Ctx& C0, KParamsPtr P, int layer, int b, int h, int qb) {
    Ctx C = C0; C.lane = lane_opaque(); C.tid = C.wave * 64 + C.lane; C.r32 = C.lane & 31; C.hi = C.lane >> 5;
    const int q0w = __builtin_amdgcn_readfirstlane(qb * 256 + C.wave * 32); const int qpos = q0w + C.r32; const size_t tok = (size_t)b * SEQ + qpos;
    build_lut(C.lds, P->rel_bias, 4 + h, false, C.tid);
    bf16x8 qr[4]; load_q(qr, C.proj + tok * PW + C_DQ + h * 64, C.hi);
    AState A; astate_init(A);
    const float c31 = P->rel_bias[31 * 16 + 4 + h] * LOG2E;
    const u16* Kg = C.proj + (size_t)b * SEQ * PW + C_DK + h * 64; const u16* Vg = C.proj + (size_t)b * SEQ * PW + C_DV + h * 64;
    run_tiles<0, 2, false, 0>(C.lds, 0, 4 * qb + 3, Kg, Vg, qr, c31, q0w, 0u, 0, A, C.wave, C.lane, C.r32, C.hi);
    LAS float* park = (LAS float*)(C.lds + ATT_PARK) + C.tid;
    { const float i0 = rcpf_(xhalf_sum(A.l));
#pragma unroll
      for (int r = 0; r < 16; ++r) { park[r * 512] = A.o0[r] * i0; park[(16 + r) * 512] = A.o1[r] * i0; } }
    astate_init(A);
    run_tiles<2, 2, false, 0>(C.lds, 0, 4 * qb + 3, Kg, Vg, qr, c31, q0w, 0u, 0, A, C.wave, C.lane, C.r32, C.hi);
    const float* lp = P->diff_lambda + (size_t)layer * 128; float d01 = 0.f, d23 = 0.f;
    for (int i = 0; i < 32; ++i) { d01 = fmaf(lp[i], lp[32 + i], d01); d23 = fmaf(lp[64 + i], lp[96 + i], d23); }
    const float li = P->lam_init[layer]; const float lam = expf(d01) - expf(d23) + li;
    const float i1 = lam * rcpf_(xhalf_sum(A.l));
    float ss = 0.f;
#pragma unroll
    for (int r = 0; r < 16; ++r) { A.o0[r] = park[r * 512] - A.o0[r] * i1; A.o1[r] = park[(16 + r) * 512] - A.o1[r] * i1; ss += A.o0[r] * A.o0[r] + A.o1[r] * A.o1[r]; }
    ss = xhalf_sum(ss);
    const float rstd = (1.0f / sqrtf(ss * (1.0f / 64.0f) + 1e-6f)) * (1.0f - li);
    const float* sg = P->diff_subln + (size_t)layer * 64;
#pragma unroll
    for (int r = 0; r < 16; ++r) { const int d = crow(r, C.hi); A.o0[r] *= rstd * sg[d]; A.o1[r] *= rstd * sg[32 + d]; }
    { const int l2 = lane_opaque(); const size_t tok2 = (size_t)b * SEQ + q0w + (l2 & 31);
      store_o(C.obuf + tok2 * DM + 256 + h * 64, A.o0, A.o1, l2 >> 5); }
}

__device__ __forceinline__ void nsa_unit(const Ctx& C0, KParamsPtr P, int b, int hq, int qb) {
    Ctx C = C0; C.lane = lane_opaque(); C.tid = C.wave * 64 + C.lane; C.r32 = C.lane & 31; C.hi = C.lane >> 5;
    const int g = hq >> 2;
    const int q0w = __builtin_amdgcn_readfirstlane(qb * 256 + C.wave * 32); const int qpos = q0w + C.r32; const size_t tok = (size_t)b * SEQ + qpos;
    build_lut(C.lds, P->rel_bias, 8 + hq, false, C.tid);
    bf16x8 qr[4]; load_q(qr, C.proj + tok * PW + C_NQ + hq * 64, C.hi);
    const u16* gl = C.proj + tok * PW + C_NG + hq * 3;
    const float g1 = sigmoid_f(bf2f(gl[1])), g2 = sigmoid_f(bf2f(gl[2]));
    const unsigned mask = ((const unsigned*)(P->ws + WS_SEL))[(size_t)(b * 2 + g) * SEQ + qpos];
    const float c31 = P->rel_bias[31 * 16 + 8 + hq] * LOG2E;
    AState A; astate_init(A);
    run_tiles<0, 4, false, 2>(C.lds, 0, 4 * qb + 3, C.proj + (size_t)b * SEQ * PW + C_NKS + g * 64, C.proj + (size_t)b * SEQ * PW + C_NVS + g * 64, qr, c31, q0w, mask, qb, A, C.wave, C.lane, C.r32, C.hi);
    LAS float* park = (LAS float*)(C.lds + ATT_PARK) + C.tid;
    { const float f = g1 * rcpf_(xhalf_sum(A.l));
#pragma unroll
      for (int r = 0; r < 16; ++r) { park[r * 512] = A.o0[r] * f; park[(16 + r) * 512] = A.o1[r] * f; } }
    if (C.tid < 96) ((LAS float*)(C.lds + ATT_LUT))[608 + C.tid] = NEGF;
    astate_init(A);
    const int tw0 = 4 * qb - 8 < 0 ? 0 : 4 * qb - 8;
    run_tiles<0, 4, true, 0>(C.lds, tw0, 4 * qb + 3, C.proj + (size_t)b * SEQ * PW + C_NKW + g * 64, C.proj + (size_t)b * SEQ * PW + C_NVW + g * 64, qr, c31, q0w, 0u, qb, A, C.wave, C.lane, C.r32, C.hi);
    { const float f = g2 * rcpf_(xhalf_sum(A.l));
#pragma unroll
      for (int r = 0; r < 16; ++r) { A.o0[r] = A.o0[r] * f + park[r * 512]; A.o1[r] = A.o1[r] * f + park[(16 + r) * 512]; } }
    const int l2 = lane_opaque(); const int hi2 = l2 >> 5;
    u16* dst = C.obuf + ((size_t)b * SEQ + q0w + (l2 & 31)) * DM + 512 + hq * 64;
#pragma unroll
    for (int gg = 0; gg < 4; ++gg) {
        const u32x2 a = *(const u32x2*)(dst + 8 * gg + 4 * hi2), bq = *(const u32x2*)(dst + 32 + 8 * gg + 4 * hi2);
        A.o0[4 * gg] += bf2f(a.x & 0xffffu); A.o0[4 * gg + 1] += bf2f(a.x >> 16); A.o0[4 * gg + 2] += bf2f(a.y & 0xffffu); A.o0[4 * gg + 3] += bf2f(a.y >> 16);
        A.o1[4 * gg] += bf2f(bq.x & 0xffffu); A.o1[4 * gg + 1] += bf2f(bq.x >> 16); A.o1[4 * gg + 2] += bf2f(bq.y & 0xffffu); A.o1[4 * gg + 3] += bf2f(bq.y >> 16);
    }
    store_o(dst, A.o0, A.o1, hi2);
}

__device__ __forceinline__ void cmp_unit(const Ctx& C0, KParamsPtr P, int b, int g, int qblk) {
    Ctx C = C0; C.lane = lane_opaque(); C.tid = C.wave * 64 + C.lane; C.r32 = C.lane & 31; C.hi = C.lane >> 5;
    LAS unsigned char* lds = C.lds; const int tid = C.tid, r32 = C.r32, hi = C.hi;
    const u16* kc = (const u16*)(P->ws + WS_KCMP) + (size_t)(b * 2 + g) * 128 * 64;
    const u16* vc = (const u16*)(P->ws + WS_VCMPT) + (size_t)(b * 2 + g) * 64 * 128;
#pragma unroll
    for (int i = 0; i < 2; ++i) { const int e = tid + 512 * i;
        { const int row = e >> 3, ch = e & 7; *(LAS u32x4*)(lds + CMP_K + row * 144 + ch * 16) = *(const u32x4*)(kc + row * 64 + ch * 8); }
        { const int row = e >> 4, ch = e & 15; *(LAS u32x4*)(lds + CMP_V + row * 272 + ch * 16) = *(const u32x4*)(vc + row * 128 + ch * 8); } }
    const int q0w = __builtin_amdgcn_readfirstlane(qblk * 256 + C.wave * 32); const int qpos = q0w + r32; const size_t tok = (size_t)b * SEQ + qpos;
    const int nmax = (qpos - 31) >> 4;
    __syncthreads();
    float qa[16], qh[16];
#pragma unroll
    for (int i = 0; i < 16; ++i) { qa[i] = 0.f; qh[i] = 0.f; }
    const LAS unsigned char* kp = lds + CMP_K + r32 * 144 + hi * 16;
    const LAS unsigned char* vp = lds + CMP_V + r32 * 272 + hi * 16;
    bf16x8 qn[4]; load_q(qn, C.proj + tok * PW + C_NQ + g * 4 * 64, hi);
    for (int rh = 0; rh < 4; ++rh) {
        const int hq = g * 4 + rh;
        bf16x8 qr[4];
#pragma unroll
        for (int ks = 0; ks < 4; ++ks) qr[ks] = qn[ks];
        load_q(qn, C.proj + tok * PW + C_NQ + (g * 4 + (rh < 3 ? rh + 1 : rh)) * 64, hi);
        const float g0 = sigmoid_f(bf2f(C.proj[tok * PW + C_NG + hq * 3]));
        f32x16 s[4];
#pragma unroll
        for (int kb = 0; kb < 4; ++kb) {
#pragma unroll
            for (int r = 0; r < 16; ++r) s[kb][r] = 0.f;
#pragma unroll
            for (int ks = 0; ks < 4; ++ks) { const bf16x8 a = *(const LAS bf16x8*)(kp + kb * 32 * 144 + ks * 32); s[kb] = __builtin_amdgcn_mfma_f32_32x32x16_bf16(a, qr[ks], s[kb], 0, 0, 0); }
        }
        float mx = NEGF;
#pragma unroll
        for (int kb = 0; kb < 4; ++kb)
#pragma unroll
            for (int r = 0; r < 16; ++r) { const int n = 32 * kb + crow(r, hi); const float v = (n <= nmax) ? s[kb][r] : NEGF; s[kb][r] = v; mx = fmaxf(mx, v); }
        mx = xhalf_max(mx);
        float sum = 0.f;
#pragma unroll
        for (int kb = 0; kb < 4; ++kb)
#pragma unroll
            for (int r = 0; r < 16; ++r) { const int n = 32 * kb + crow(r, hi); const float pv = (n <= nmax) ? ex2(s[kb][r] - mx) : 0.f; s[kb][r] = pv; sum += pv; }
        sum = xhalf_sum(sum);
        const float inv = nmax >= 0 ? rcpf_(sum) : 0.f;
        f32x16 o0, o1;
#pragma unroll
        for (int r = 0; r < 16; ++r) { o0[r] = 0.f; o1[r] = 0.f; }
#pragma unroll
        for (int kb = 0; kb < 4; ++kb) {
#pragma unroll
            for (int r = 0; r < 16; ++r) s[kb][r] *= inv;
#pragma unroll
            for (int g4 = 0; g4 < 4; ++g4) { const float h = 0.5f * s[kb][4 * g4 + 3]; qh[kb * 4 + g4] += h; qa[kb * 4 + g4] += (s[kb][4 * g4] + s[kb][4 * g4 + 1]) + (s[kb][4 * g4 + 2] + h); }
#pragma unroll
            for (int c = 0; c < 2; ++c) {
                const u32x4 pk = (u32x4){pkbf(s[kb][8 * c], s[kb][8 * c + 1]), pkbf(s[kb][8 * c + 2], s[kb][8 * c + 3]), pkbf(s[kb][8 * c + 4], s[kb][8 * c + 5]), pkbf(s[kb][8 * c + 6], s[kb][8 * c + 7])};
                const bf16x8 pb = __builtin_bit_cast(bf16x8, pk);
                const bf16x8 v0 = *(const LAS bf16x8*)(vp + (kb * 2 + c) * 32);
                const bf16x8 v1 = *(const LAS bf16x8*)(vp + 32 * 272 + (kb * 2 + c) * 32);
                o0 = __builtin_amdgcn_mfma_f32_32x32x16_bf16(v0, pb, o0, 0, 0, 0);
                o1 = __builtin_amdgcn_mfma_f32_32x32x16_bf16(v1, pb, o1, 0, 0, 0);
            }
            __builtin_amdgcn_sched_barrier(0);
        }
        o0 *= g0; o1 *= g0;
        store_o(C.obuf + tok * DM + 512 + hq * 64, o0, o1, hi);
    }
    LAS float* Aq = (LAS float*)(lds + CMP_A) + (C.wave * 32 + r32) * 33; LAS float* Hq = (LAS float*)(lds + CMP_H) + (C.wave * 32 + r32) * 33;
#pragma unroll
    for (int kb = 0; kb < 4; ++kb)
#pragma unroll
        for (int g4 = 0; g4 < 4; ++g4) { const int j = 8 * kb + 2 * g4 + hi; Aq[j] = qa[kb * 4 + g4]; Hq[j] = qh[kb * 4 + g4]; }
    __syncthreads();
    const int cur = q0w >> 6;
    unsigned bits = 0;
    if (cur < 16) bits = (2u << cur) - 1u;
    else {
        float sc[32];
#pragma unroll
        for (int i = 0; i < 32; ++i) { const float imp = Aq[i] + (i > 0 ? Hq[i - 1] : 0.f); sc[i] = (i > cur) ? -3.0e38f : ((i == 0 || i > cur - 2) ? 1e4f : imp); }
#pragma unroll
        for (int e = 0; e < 16; ++e) {
            const float sj = hi ? sc[16 + e] : sc[e]; int rank = 0;
#pragma unroll
            for (int i = 0; i < 32; ++i) { const bool lt = (i < e) || (hi && i < 16 + e);
                rank += (sc[i] > sj || (sc[i] == sj && lt)) ? 1 : 0; }
            const int j = hi * 16 + e;
            if (j <= cur && rank < 16) bits |= 1u << j; }
        { auto rr = __builtin_amdgcn_permlane32_swap(bits, bits, false, false); bits = rr[0] | rr[1]; }
    }
    if (hi == 0) ((unsigned*)(P->ws + WS_SEL))[(size_t)(b * 2 + g) * SEQ + qpos] = bits;
    __syncthreads();
}

__device__ __forceinline__ void prep_vk(const Ctx& C, KParamsPtr P, int b0) {
    (void)b0; const int lane = C.lane, qd = C.wave & 3; LAS float* part = (LAS float*)C.lds;
    for (int base = C.bx * 2; base < NB * 4 * 8; base += C.G * 2) {
        const int it = base + (C.wave >> 2), blk = it & 7, h = (it >> 3) & 3, b = it >> 5;
        const u16* kp = C.proj + ((size_t)b * SEQ + blk * 256 + qd * 64) * PW + C_MK + h * 64 + lane; float s = 0.f;
        for (int k = 0; k < 64; k += 16) { float t[16];
#pragma unroll
            for (int e = 0; e < 16; ++e) t[e] = bf2f(kp[(size_t)(k + e) * PW]);
            s += (((t[0] + t[1]) + (t[2] + t[3])) + ((t[4] + t[5]) + (t[6] + t[7]))) + (((t[8] + t[9]) + (t[10] + t[11])) + ((t[12] + t[13]) + (t[14] + t[15]))); }
        part[C.wave * 64 + lane] = s;
        __syncthreads();
        if (qd == 0) ((float*)(P->ws + WS_KMEAN))[(size_t)it * 64 + lane] = ((part[C.wave * 64 + lane] + part[(C.wave + 1) * 64 + lane]) + (part[(C.wave + 2) * 64 + lane] + part[(C.wave + 3) * 64 + lane])) * (1.0f / 256.0f);
        __syncthreads();
    }
}
__device__ __forceinline__ void prep_a(const Ctx& C, KParamsPtr P, int layer) {
    const int G = C.G, lane = C.lane;
    const int gw = C.bx * 8 + C.wave, NGW = G * 8;
    u16* acmp = (u16*)(P->ws + WS_VT);
    for (int it = gw; it < 2 * 4096; it += NGW) {
        const int i = it >> 12, row = it & 4095, n = row & 127, bg = row >> 7, b = bg >> 1, g = bg & 1;
        u16* dst = acmp + (size_t)it * 2048; const float* pe = P->cmp_pe + (size_t)(layer * 2 + i) * 2048;
        const int col = (i == 0 ? C_NKC : C_NVC) + g * 64;
#pragma unroll
        for (int pass = 0; pass < 4; ++pass) { const int l = pass * 8 + (lane >> 3), d0 = (lane & 7) * 8;
            unsigned z0 = 0u; asm volatile("" : "+v"(z0)); u32x4 o = (u32x4){z0, z0, z0, z0};
            if (n < 127) { const u32x4 v = *(const u32x4*)(C.proj + ((size_t)b * SEQ + 16 * n + l) * PW + col + d0); const f32x4 e0 = *(const f32x4*)(pe + l * 64 + d0), e1 = *(const f32x4*)(pe + l * 64 + d0 + 4);
                o.x = pkbf(bf2f(v.x & 0xffffu) + e0.x, bf2f(v.x >> 16) + e0.y); o.y = pkbf(bf2f(v.y & 0xffffu) + e0.z, bf2f(v.y >> 16) + e0.w);
                o.z = pkbf(bf2f(v.z & 0xffffu) + e1.x, bf2f(v.z >> 16) + e1.y); o.w = pkbf(bf2f(v.w & 0xffffu) + e1.z, bf2f(v.w >> 16) + e1.w); }
            *(u32x4*)(dst + l * 64 + d0) = o; }
    }
}
__device__ __forceinline__ void prep_c(const Ctx& C, KParamsPtr P, int layer, int it0) {
    const int i = it0 >> 12, row0 = it0 & 4095, lane = lane_opaque(), tid = C.wave * 64 + lane, r32 = lane & 31, hi = lane >> 5;
    const float* w2 = P->cmp_w2 + (size_t)(layer * 2 + i) * 256 * 64;
    for (int e = tid; e < 256 * 64; e += 512) { const int k = e >> 6, c = e & 63; *(LAS u16*)(C.lds + c * 528 + k * 2) = (u16)(pkbf(w2[e], 0.f) & 0xffffu); }
    __syncthreads();
    const int wrow = row0 + C.wave * 32;
    const u16* hrow = (const u16*)(P->ws + WS_HID) + ((size_t)i * 4096 + wrow + r32) * 256 + hi * 8;
    f32x16 d0, d1;
#pragma unroll
    for (int r = 0; r < 16; ++r) { d0[r] = 0.f; d1[r] = 0.f; }
#pragma unroll 4
    for (int ks = 0; ks < 16; ++ks) {
        const bf16x8 a = *(const bf16x8*)(hrow + ks * 16);
        const bf16x8 b0 = *(const LAS bf16x8*)(C.lds + r32 * 528 + (ks * 16 + hi * 8) * 2);
        const bf16x8 b1 = *(const LAS bf16x8*)(C.lds + (32 + r32) * 528 + (ks * 16 + hi * 8) * 2);
        d0 = __builtin_amdgcn_mfma_f32_32x32x16_bf16(a, b0, d0, 0, 0, 0);
        d1 = __builtin_amdgcn_mfma_f32_32x32x16_bf16(a, b1, d1, 0, 0, 0);
    }
#pragma unroll
    for (int r = 0; r < 16; ++r) { const int row = wrow + crow(r, hi);
        const unsigned v0 = pkbf(d0[r], 0.f) & 0xffffu, v1 = pkbf(d1[r], 0.f) & 0xffffu;
        if (i == 0) { u16* o = (u16*)(P->ws + WS_KCMP) + (size_t)row * 64; o[r32] = (u16)v0; o[32 + r32] = (u16)v1; }
        else { const int bg = row >> 7, n = row & 127; u16* o = (u16*)(P->ws + WS_VCMPT) + (size_t)bg * 64 * 128 + (n & ~15) + pperm(n & 15); o[(size_t)r32 * 128] = (u16)v0; o[(size_t)(32 + r32) * 128] = (u16)v1; }
    }
}

__device__ __forceinline__ void convert_weights(const Ctx& C, KParamsPtr P, int layer) {
    LAS float* scr = (LAS float*)(C.lds + C.wave * 16384);
    const int gw = C.bx * 8 + C.wave, NGW = C.G * 8, lane = C.lane;
    constexpr int I_G = 16 * 88, I_D = 44 * 32, I_IN = 16 * 96, I_O = 16 * 32, I_W1 = 32 * 8;
    constexpr int NIT = 4 * I_G + 2 * I_D + I_IN + I_O + 2 * I_W1;
    unsigned char* ws = P->ws;
    for (int it = gw; it < NIT; it += NGW) {
        int r = it;
        if (r < 4 * I_G) { const int which = r / I_G; r -= which * I_G; const int kb = r / 88, nb = r % 88, n0 = nb * 32;
            const float* W = (which == 0 ? P->ffn1_gate : which == 1 ? P->ffn1_up : which == 2 ? P->ffn2_gate : P->ffn2_up) + (size_t)layer * DM * DFF;
            u16* WT = (u16*)(ws + (which < 2 ? WS_GU1 : WS_GU2));
            tr_item(W, DM, DFF, WT, kb, n0, (n0 >> 7) * 256 + (which & 1) * 128 + (n0 & 127), scr, lane, 1.0f, (which < 2 ? P->norm_ffn1 : P->norm_ffn2) + (size_t)layer * DM); continue; }
        r -= 4 * I_G;
        if (r < 2 * I_D) { const int which = r / I_D; r -= which * I_D; const int kb = r / 32, nb = r % 32;
            const float* W = (which == 0 ? P->ffn1_down : P->ffn2_down) + (size_t)layer * DFF * DM;
            tr_item(W, DFF, DM, (u16*)(ws + (which == 0 ? WS_DN1 : WS_DN2)), kb, nb * 32, nb * 32, scr, lane); continue; }
        r -= 2 * I_D;
        if (r < I_IN) { const int kb = r / 96, nb = r % 96, n0 = nb * 32;
            const float cs = (n0 < C_MK || (n0 >= C_NQ && n0 < C_NKC)) ? 0.125f * LOG2E : (n0 >= C_DQ && n0 < C_DK) ? 0.17677669529663687f * LOG2E : 1.0f;
            tr_item(P->w_in + (size_t)layer * DM * INW, DM, INW, (u16*)(ws + WS_WIN), kb, n0, n0, scr, lane, cs, P->norm_mix + (size_t)layer * DM); continue; }
        r -= I_IN;
        if (r < I_O) { const int kb = r / 32, nb = r % 32; tr_item(P->w_out + (size_t)layer * DM * DM, DM, DM, (u16*)(ws + WS_WOUT), kb, nb * 32, nb * 32, scr, lane); continue; }
        r -= I_O;
        { const int i = r / I_W1; r -= i * I_W1; const int kb = r / 8, nb = r % 8;
            tr_item(P->cmp_w1 + (size_t)(layer * 2 + i) * 2048 * 256, 2048, 256, (u16*)(ws + WS_W1) + (size_t)i * 256 * 2048, kb, nb * 32, nb * 32, scr, lane); }
    }
}
__device__ __forceinline__ void norm_phase(const Ctx& C, const float* src32, const u16* src16, const float* g, u16* dst16, float* dst32, u16* xb0) {
    const int gw = C.bx * 8 + C.wave, NGW = C.G * 8;
    for (int m = gw; m < MTOK; m += NGW) norm_row(src32 ? src32 + (size_t)m * DM : nullptr, src16 ? src16 + (size_t)m * DM : nullptr, g, dst16 ? dst16 + (size_t)m * DM : nullptr, dst32 ? dst32 + (size_t)m * DM : nullptr, xb0 ? xb0 + (size_t)m * DM : nullptr, C.lane);
}

#define XB_TMO      128
#define XB_XCNT(j)  (256  + 64 * (j))
#define XB_XSUB(j)  (1280 + 64 * (j))
#define XB_XGEN(j)  (2304 + 64 * (j))
#define XB_TOP      3328
#define XB_TOPGEN   3392
#define XCD_BAR_WORDS 3456
#define XB_SPIN_CAP (1u << 18)

__device__ __forceinline__ unsigned xb_ld(unsigned* p)              { return __hip_atomic_load(p, __ATOMIC_RELAXED, __HIP_MEMORY_SCOPE_AGENT); }
__device__ __forceinline__ unsigned xb_add(unsigned* p, unsigned v) { return __hip_atomic_fetch_add(p, v, __ATOMIC_RELAXED, __HIP_MEMORY_SCOPE_AGENT); }
__device__ __forceinline__ unsigned xb_xcc_id() { return (unsigned)__builtin_amdgcn_s_getreg((3 << 11) | 20) & 0xFu; }
#define XB_SPIN(cond, bar) do { unsigned _sp = 0; while (cond) { __builtin_amdgcn_s_sleep(1); \
    if ((++_sp & 255u) == 0u) { if (xb_ld(&(bar)[XB_TMO])) break; if (_sp > XB_SPIN_CAP) { atomicAdd(&(bar)[XB_TMO], 1u); break; } } } } while (0)

struct XcdBarrier {
    unsigned* bar; unsigned x;
    volatile LAS unsigned* st;
};

__device__ __forceinline__ XcdBarrier xcd_barrier_post(unsigned* bar, volatile LAS unsigned* st) {
    XcdBarrier b; b.bar = bar; b.x = xb_xcc_id(); b.st = st;
    if (threadIdx.x == 0) (void)xb_add(&bar[XB_XCNT(b.x)], 1u);
    return b;
}
__device__ __forceinline__ void xcd_barrier_complete(unsigned* bar, unsigned x, unsigned& nloc, unsigned& nx) {
    const unsigned G = gridDim.x * gridDim.y * gridDim.z;
    unsigned sum, cnt, mine, sp = 0u;
    for (;;) {
        sum = 0u; cnt = 0u; mine = 0u;
#pragma unroll
        for (unsigned j = 0; j < 16; ++j) { const unsigned c = xb_ld(&bar[XB_XCNT(j)]); sum += c; cnt += (c > 0u) ? 1u : 0u; mine = (j == x) ? c : mine; }
        if (sum == G) break;
        __builtin_amdgcn_s_sleep(1);
        if ((++sp & 255u) == 0u) { if (xb_ld(&bar[XB_TMO])) break; if (sp > XB_SPIN_CAP) { atomicAdd(&bar[XB_TMO], 1u); break; } }
    }
    nloc = mine > 0u ? mine : 1u; nx = cnt > 0u ? cnt : 1u;
}

__device__ __forceinline__ void xcd_barrier(const XcdBarrier& b) {
    asm volatile("s_waitcnt vmcnt(0)" ::: "memory");
    __syncthreads();
    if (threadIdx.x == 0) {
        unsigned* bar = b.bar;
        __builtin_amdgcn_s_waitcnt(0);
        unsigned nloc = b.st[0], nx = b.st[1];
        if (nloc == 0u) { xcd_barrier_complete(bar, b.x, nloc, nx); b.st[0] = nloc; b.st[1] = nx; }
        const unsigned old = xb_add(&bar[XB_XSUB(b.x)], 1u);
        const unsigned gen = old / nloc;
        if (old + 1u == (gen + 1u) * nloc) {
            __builtin_amdgcn_fence(__ATOMIC_RELEASE, "agent");
            asm volatile("s_waitcnt vmcnt(0)" ::: "memory");
            const unsigned og = xb_add(&bar[XB_TOP], 1u);
            const unsigned tg = og / nx;
            if (og + 1u == (tg + 1u) * nx) xb_add(&bar[XB_TOPGEN], 1u);
            else XB_SPIN(xb_ld(&bar[XB_TOPGEN]) == tg, bar);
            __builtin_amdgcn_fence(__ATOMIC_ACQUIRE, "agent");
            xb_add(&bar[XB_XGEN(b.x)], 1u);
            asm volatile("s_waitcnt vmcnt(0)" ::: "memory");
        } else {
            XB_SPIN(xb_ld(&bar[XB_XGEN(b.x)]) == gen, bar);
            __builtin_amdgcn_fence(__ATOMIC_ACQUIRE, "agent");
            asm volatile("s_waitcnt vmcnt(0)" ::: "memory");
        }
    }
    __syncthreads();
}


__device__ __forceinline__ void fill_rtab(const Ctx& C, const pg8::StaticOrder& S, const float* SS, LAS float* rtab) {
    LAS int* pml = (LAS int*)(rtab + 11 * 256);
    int nu = 0; { pg8::Unit u_; for (int i_ = 0; i_ < 11 && S.next(i_, u_); ++i_) { if (C.tid == 0) pml[i_] = u_.pm; nu = i_ + 1; } }
    __syncthreads();
    const int tot = nu * 256; float rsv[6];
#pragma unroll
    for (int k = 0; k < 6; ++k) { const int e = C.tid + 512 * k; rsv[k] = e < tot ? pg8::row_rstd(SS, pml[e >> 8] * 256 + (e & 255)) : 0.f; }
#pragma unroll
    for (int k = 0; k < 6; ++k) { const int e = C.tid + 512 * k; if (e < tot) rtab[e] = rsv[k]; }
    __syncthreads();
}
__device__ __forceinline__ void x0_phase(const Ctx& C, const float* src, u16* xb, float* ss) {
    const int gw = C.bx * 8 + C.wave, NGW = C.G * 8, lane = C.lane;
    for (int m = gw; m < MTOK; m += NGW) {
        const f32x4* xr = (const f32x4*)(src + (size_t)m * DM) + lane; float s = 0.f;
#pragma unroll
        for (int j = 0; j < 4; ++j) { const f32x4 v = xr[64 * j]; s += (v.x * v.x + v.y * v.y) + (v.z * v.z + v.w * v.w);
            u32x2 o; o.x = pkbf(v.x, v.y); o.y = pkbf(v.z, v.w); *((u32x2*)(xb + (size_t)m * DM) + lane + 64 * j) = o; }
        s = wave_sum(s, lane);
        if (lane < 16) ss[(size_t)m * 16 + lane] = lane == 0 ? s : 0.f;
    }
}
__device__ __forceinline__ void unit_publish(unsigned* flag, int tid) {
    asm volatile("s_waitcnt vmcnt(0)" ::: "memory"); __syncthreads();
    if (tid == 0) { __builtin_amdgcn_fence(__ATOMIC_RELEASE, "agent"); asm volatile("s_waitcnt vmcnt(0)" ::: "memory"); __hip_atomic_store(flag, 1u, __ATOMIC_RELAXED, __HIP_MEMORY_SCOPE_AGENT); }
}
__device__ __forceinline__ void unit_wait(unsigned* f0, unsigned* f1, int tid) {
    if (tid == 0) { unsigned sp = 0;
        while ((__hip_atomic_load(f0, __ATOMIC_RELAXED, __HIP_MEMORY_SCOPE_AGENT) == 0u || __hip_atomic_load(f1, __ATOMIC_RELAXED, __HIP_MEMORY_SCOPE_AGENT) == 0u) && ++sp < (1u << 24)) __builtin_amdgcn_s_sleep(8);
        __builtin_amdgcn_fence(__ATOMIC_ACQUIRE, "agent"); asm volatile("s_waitcnt vmcnt(0)" ::: "memory"); }
    __syncthreads();
}
struct OneUnit { int pm;
    __device__ __forceinline__ bool next(int i, pg8::Unit& u) const { if (i) return false; u.pm = pm; u.pn = 0; return true; }
    __device__ __forceinline__ void a_ready(const pg8::Unit&) const {}
    __device__ __forceinline__ void done(const pg8::Unit&) const {} };
__global__ void __launch_bounds__(512, 2) hybrid_fwd(Params P0) {
    extern __shared__ __attribute__((aligned(16))) unsigned char lds_raw[];
    const KParamsPtr kp0 = (KParamsPtr)__builtin_amdgcn_kernarg_segment_ptr();
    cg::grid_group grid = cg::this_grid();
    { volatile LAS unsigned* misc = (volatile LAS unsigned*)((LAS unsigned char*)lds_raw + MISC_OFF); if (threadIdx.x < 2) misc[threadIdx.x] = 0u; }
    __syncthreads();
    XcdBarrier bar = xcd_barrier_post((unsigned*)(P0.ws + WS_CTL) + 1024, (volatile LAS unsigned*)((LAS unsigned char*)lds_raw + MISC_OFF));
    const int ph_lo = P0.ph_lo, ph_hi = P0.ph_hi; const int wave_s = __builtin_amdgcn_readfirstlane(threadIdx.x >> 6);
    bool redone = false; (void)redone;
    for (int ph = ph_lo; ph < ph_hi; ++ph) {
        KParamsPtr kpl = kp0; asm volatile("" : "+s"(kpl));
        const KParamsPtr P = kpl; unsigned char* ws = P->ws;
        u16* XN = (u16*)(ws + WS_XN); u16* HB = (u16*)(ws + WS_PROJ);
        int G = gridDim.x, bx = blockIdx.x; asm volatile("" : "+s"(G), "+s"(bx));
        Ctx C; C.G = G; C.bx = bx; C.lds = (LAS unsigned char*)lds_raw; C.wave = wave_s; C.lane = lane_opaque(); C.tid = wave_s * 64 + C.lane; C.r32 = C.lane & 31; C.hi = C.lane >> 5;
        C.proj = (u16*)(ws + WS_PROJ); C.obuf = (u16*)(ws + WS_XN); C.vt = (u16*)(ws + WS_VT);
        const int layer = ph / NPH_L, s = ph % NPH_L;
        if (ph != NPH - 1 && (s == 7 || s == 3 || s == 11 || s == 8 || s == 9)) continue;
        float* SS = (float*)(ws + WS_SS);
        u16* XB = (u16*)(ws + WS_XB);
        if (ph == NPH - 1) { norm_phase(C, nullptr, XB, P->final_norm, nullptr, P->out, nullptr); }
        else switch (s) {
        case 0: { convert_weights(C, P, layer); if (layer == 0) { __syncthreads(); x0_phase(C, P->x, XB, SS); } } break;
#ifndef NO_GEMM
#ifndef NO_G1
        case 1: case 12: {
            pg8::Gemm g{XB, (const u16*)(ws + (s == 1 ? WS_GU1 : WS_GU2)), MTOK, 2 * DFF, DM}; pg8::StaticOrder S; S.init(MTOK, 2 * DFF, G, bx);
            LAS float* rtab = (LAS float*)(C.lds + RTAB_OFF); fill_rtab(C, S, SS, rtab);
            pg8::EpiSwiGLU E{HB, DFF, rtab, 0};
            pg8::gemm_phase<pg8::EpiSwiGLU, pg8::StaticOrder, true, true>(C.lds, g, S, E, C.wave); } break;
#endif
#ifndef NO_G2
        case 2: case 13: case 10: {
            const u16* A = (s == 10) ? (const u16*)XN : (const u16*)HB; const u16* Bt = (const u16*)(ws + (s == 2 ? WS_DN1 : s == 13 ? WS_DN2 : WS_WOUT));
            pg8::Gemm g{A, Bt, MTOK, DM, s == 10 ? DM : DFF}; pg8::StaticOrder S; S.init(MTOK, DM, G, bx);
            pg8::EpiResid E{XB, DM, s == 10 ? 1.0f : 0.5f, SS};
            pg8::gemm_phase<pg8::EpiResid, pg8::StaticOrder, false, true>(C.lds, g, S, E, C.wave); } break;
#endif
#ifndef NO_G4
        case 4: {
            pg8::Gemm g{XB, (const u16*)(ws + WS_WIN), MTOK, PW, DM}; pg8::StaticOrder S; S.init(MTOK, PW, G, bx);
            LAS float* rtab = (LAS float*)(C.lds + RTAB_OFF); fill_rtab(C, S, SS, rtab);
            pg8::EpiBf16<0> E{C.proj, PW, rtab, 0};
            pg8::gemm_phase<pg8::EpiBf16<0>, pg8::StaticOrder, true, true>(C.lds, g, S, E, C.wave); } break;
#endif
#endif
#ifndef NO_PREP
        case 5: prep_a(C, P, layer); prep_vk(C, P, 0); break;
#endif
#if !defined(NO_GEMM) && !defined(NO_G6)
        case 6: {
            unsigned* ctl = (unsigned*)(ws + WS_CTL); unsigned* qctr = ctl + 8192 + 64 * ph + (redone ? 32 : 0); unsigned* fcomp = ctl + 16384 + 64 * ph; unsigned* fcmp = ctl + 24576 + 256 * (ph / NPH_L);
            volatile LAS unsigned* qslot = (volatile LAS unsigned*)(C.lds + MISC_OFF + 16);
            for (;;) {
                if (C.tid == 0) *qslot = __hip_atomic_fetch_add(qctr, 1u, __ATOMIC_RELAXED, __HIP_MEMORY_SCOPE_AGENT);
                __syncthreads();
                const unsigned u = *qslot;
                __syncthreads();
                if (u >= 32u + 512u + 256u + 1024u + 512u) break;
                if (u < 32u) { const int i = (int)u >> 4, tile = (int)u & 15;
                    pg8::Gemm g{(const u16*)(ws + WS_VT) + (size_t)i * 4096 * 2048, (const u16*)(ws + WS_W1) + (size_t)i * 256 * 2048, 4096, 256, 2048}; OneUnit S{tile};
                    pg8::EpiBf16<1> E{(u16*)(ws + WS_HID) + (size_t)i * 4096 * 256, 256, nullptr, 0};
                    pg8::gemm_phase<pg8::EpiBf16<1>, OneUnit, true, true>(C.lds, g, S, E, C.wave);
                    __builtin_amdgcn_fence(__ATOMIC_RELEASE, "agent"); __syncthreads(); __builtin_amdgcn_fence(__ATOMIC_ACQUIRE, "agent");
                    prep_c(C, P, layer, i * 4096 + tile * 256);
                    unit_publish(fcomp + u, C.tid);
                    __syncthreads();
                } else if (u < 544u || u >= 1824u) { const unsigned v = u < 544u ? u - 32u : u - 1824u + 512u; const int qb = 7 - (int)(v >> 7), w = (int)(v & 127);
                    if (w < 64) {
#ifndef NO_DIFF
                        diff_unit(C, P, layer, w >> 2, w & 3, qb);
#endif
                    } else {
#ifndef NO_MOBA
                        moba_unit(C, P, (w - 64) >> 2, w & 3, qb);
#endif
                    }
                } else if (u < 800u) { const int c = (int)u - 544, qblk = 7 - (c >> 5), bg = c & 31;
                    unit_wait(fcomp + (bg >> 1), fcomp + 16 + (bg >> 1), C.tid);
#ifndef NO_CMP
                    cmp_unit(C, P, bg >> 1, bg & 1, qblk);
#endif
                    unit_publish(fcmp + bg * 8 + qblk, C.tid);
                    __syncthreads();
                } else { const int v = (int)u - 800, qb = 7 - (v >> 7), b = (v & 127) >> 3, hq = v & 7; unsigned* f = fcmp + (b * 2 + (hq >> 2)) * 8 + qb;
                    unit_wait(f, f, C.tid);
#ifndef NO_ATT2
                    nsa_unit(C, P, b, hq, qb);
#endif
                }
            } } break;
#endif
        default: break;
        }
        if (ph + 1 < ph_hi) { if (ph == ph_lo) grid.sync(); else xcd_barrier(bar); }
#ifdef PROBE_LO
        if (ph != NPH - 1 && s == PROBE_HI) { if (!redone) { ph -= (PROBE_HI - PROBE_LO + 1); redone = true; } else redone = false; }
#endif
#ifdef PROBE_SYNC
        if (ph + 1 < ph_hi) xcd_barrier(bar);
#endif
    }
}

#ifndef COOP
#define COOP 1
#endif
extern "C" void kernel_launch(void* const* d_in, const int* in_sizes, int n_in, void* d_out, int out_size, void* d_ws, size_t ws_size, hipStream_t stream) {
    static int grid = 0;
    if (grid == 0) {
        if (n_in != 19 || out_size != MTOK * DM || ws_size < WS_END) { fprintf(stderr, "kernel_launch: unexpected shapes (n_in %d out %d ws %zu)\n", n_in, out_size, ws_size); grid = -1; return; }
        int dev = 0, cus = 0, per_cu = 0;
        (void)hipGetDevice(&dev); (void)hipDeviceGetAttribute(&cus, hipDeviceAttributeMultiprocessorCount, dev);
        if (hipFuncSetAttribute((const void*)hybrid_fwd, hipFuncAttributeMaxDynamicSharedMemorySize, LDS_BYTES) != hipSuccess) { fprintf(stderr, "kernel_launch: hipFuncSetAttribute failed\n"); grid = -1; return; }
        if (hipOccupancyMaxActiveBlocksPerMultiprocessor(&per_cu, (const void*)hybrid_fwd, 512, LDS_BYTES) != hipSuccess || per_cu < 1) { fprintf(stderr, "kernel_launch: occupancy query says %d\n", per_cu); per_cu = 1; }
        (void)hipGetLastError();
        grid = cus * per_cu;
    }
    if (grid < 0) return;
    Params p{};
    p.x = (const float*)d_in[0]; p.rel_bias = (const float*)d_in[1]; p.norm_ffn1 = (const float*)d_in[2]; p.ffn1_gate = (const float*)d_in[3]; p.ffn1_up = (const float*)d_in[4]; p.ffn1_down = (const float*)d_in[5];
    p.norm_mix = (const float*)d_in[6]; p.w_in = (const float*)d_in[7]; p.diff_lambda = (const float*)d_in[8]; p.diff_subln = (const float*)d_in[9]; p.cmp_pe = (const float*)d_in[10]; p.cmp_w1 = (const float*)d_in[11];
    p.cmp_w2 = (const float*)d_in[12]; p.w_out = (const float*)d_in[13]; p.norm_ffn2 = (const float*)d_in[14]; p.ffn2_gate = (const float*)d_in[15]; p.ffn2_up = (const float*)d_in[16]; p.ffn2_down = (const float*)d_in[17];
    p.final_norm = (const float*)d_in[18]; p.out = (float*)d_out; p.ws = (unsigned char*)d_ws;
    for (int l = 0; l < 4; ++l) p.lam_init[l] = (float)(0.8 - 0.6 * exp(-0.3 * (double)l));
#if COOP
    if (hipMemsetAsync((char*)d_ws + WS_CTL, 0, CTL_ZERO_BYTES, stream) != hipSuccess) { fprintf(stderr, "kernel_launch: memset of barrier words failed\n"); return; }
    p.ph_lo = 0; p.ph_hi = NPH;
    void* args[] = {&p};
    hipError_t e = hipLaunchCooperativeKernel((const void*)hybrid_fwd, dim3(grid), dim3(512), args, LDS_BYTES, stream);
    if (e != hipSuccess) fprintf(stderr, "cooperative launch failed: %s (grid %d)\n", hipGetErrorString(e), grid);
#else
    for (int ph = 0; ph < NPH; ++ph) { p.ph_lo = ph; p.ph_hi = ph + 1; hipLaunchKernelGGL(hybrid_fwd, dim3(grid), dim3(512), LDS_BYTES, stream, p); }
#endif
}
```

```cpp
#include <hip/hip_runtime.h>
#include <hip/hip_cooperative_groups.h>
#include <cstdio>
#include <cstdint>
#include <cmath>
namespace cg = cooperative_groups;
#define COOP 1
namespace pg8 {
#define PG8_LAS __attribute__((address_space(3)))
typedef unsigned short bf16_t;
typedef short bf16x8 __attribute__((ext_vector_type(8)));
typedef float f32x4 __attribute__((ext_vector_type(4)));
typedef unsigned u32x4 __attribute__((ext_vector_type(4)));
constexpr int BM = 256, BK = 64, HALF = 128, HTB = HALF * BK * 2  , STAGE_BYTES = 8 * HTB, NXCD = 8, WGM = 8;

__host__ __device__ __forceinline__ int lds_byte(int r, int c) { const int st = (r >> 4) * 2 + (c >> 5), rr = r & 15, cc = c & 31, ob = rr * 64 + cc * 2; return st * 1024 + (ob ^ (((ob >> 9) & 1) << 5)); }
__host__ __device__ __forceinline__ void stage_rc(int b, int& R, int& C) { const int st = b / 1024, sb = b % 1024, swz = sb ^ (((sb >> 9) & 1) << 5); R = (st >> 1) * 16 + swz / 64; C = (st & 1) * 32 + (swz % 64) / 2; }
__host__ __device__ __forceinline__ int perm32(int rho) { const int n = rho >> 4, i = rho & 15; return 8 * (i >> 2) + 4 * n + (i & 3); }

struct Unit { int pm, pn; };
struct Gemm { const bf16_t* A; const bf16_t* Bt; int M, N, K; };

struct StaticOrder {
    int nM, nN, nwg, G, c;
    __host__ __device__ void init(int M, int N, int G_, int c_) { nM = M / BM; nN = N / BM; nwg = nM * nN; G = G_; c = c_; }
    __host__ __device__ bool next(int i, Unit& u) const {
        const long L = (long)i * G + c; if (L >= nwg) return false;
        int wgid = (int)L; { const int q = nwg / NXCD, r = nwg % NXCD, xcd = wgid % NXCD, off = wgid / NXCD; wgid = (xcd < r ? xcd * (q + 1) : r * (q + 1) + (xcd - r) * q) + off; }
        const int nig = WGM * nN, gid = wgid / nig, fm = gid * WGM, gsz = (nM - fm) < WGM ? (nM - fm) : WGM;
        u.pm = fm + ((wgid % nig) % gsz); u.pn = (wgid % nig) / gsz; return true;
    }
    __device__ __forceinline__ void a_ready(const Unit&) const {}
    __device__ __forceinline__ void done(const Unit&) const {}
};

__device__ __forceinline__ unsigned cvt_pk_bf16(float lo, float hi) { unsigned r; asm volatile("v_cvt_pk_bf16_f32 %0, %1, %2" : "=v"(r) : "v"(lo), "v"(hi)); return r; }

__device__ __forceinline__ float ex2(float x) { return __builtin_amdgcn_exp2f(x); }
__device__ __forceinline__ float rcpf_(float x) { return __builtin_amdgcn_rcpf(x); }
__device__ __forceinline__ float silu_f(float x) { return x * rcpf_(1.0f + ex2(-1.4426950408889634f * x)); }
__device__ __forceinline__ float gelu_tanh_f(float x) { const float y2 = 2.0f * 0.7978845608028654f * (x + 0.044715f * x * x * x); return x * (1.0f - rcpf_(1.0f + ex2(1.4426950408889634f * y2))); }

__device__ __forceinline__ float row_rstd(const float* ss, int row) {
    const f32x4* p = (const f32x4*)(ss + (size_t)row * 16); const f32x4 a = p[0], b = p[1], c = p[2], d = p[3];
    const float s = ((a[0] + a[1]) + (a[2] + a[3])) + ((b[0] + b[1]) + (b[2] + b[3])) + ((c[0] + c[1]) + (c[2] + c[3])) + ((d[0] + d[1]) + (d[2] + d[3]));
    return 1.0f / sqrtf(s * (1.0f / 1024.0f) + 1e-6f);
}

struct EpiSwiGLU {
    static constexpr bool PERM = true, AFTER_DRAIN = false;
    bf16_t* O; int ldc; const PG8_LAS float* rtab; mutable int ui;
    __device__ __forceinline__ void operator()(const f32x4 (&acc)[2][2][4][2], const Unit& u, int wr, int wc, int fr, int fq) const {
        const int row0 = u.pm * BM + wr * 64 + fr; const int col0 = u.pn * HALF + wc * 32 + 8 * fq;
#pragma unroll
        for (int ai = 0; ai < 2; ++ai)
#pragma unroll
            for (int m = 0; m < 4; ++m) { bf16_t* rowp = O + (size_t)(row0 + ai * HALF + m * 16) * ldc + col0;
                const float rs = rtab[ui * 256 + wr * 64 + fr + ai * HALF + m * 16];
                const f32x4 g0 = acc[ai][0][m][0] * rs, g1 = acc[ai][0][m][1] * rs, u0 = acc[ai][1][m][0] * rs, u1 = acc[ai][1][m][1] * rs;
                u32x4 w; w.x = cvt_pk_bf16(silu_f(g0[0]) * u0[0], silu_f(g0[1]) * u0[1]); w.y = cvt_pk_bf16(silu_f(g0[2]) * u0[2], silu_f(g0[3]) * u0[3]);
                w.z = cvt_pk_bf16(silu_f(g1[0]) * u1[0], silu_f(g1[1]) * u1[1]); w.w = cvt_pk_bf16(silu_f(g1[2]) * u1[2], silu_f(g1[3]) * u1[3]);
                *(u32x4*)rowp = w; asm volatile("" ::: "memory"); }
        ++ui;
    }
};
template <int ACT> struct EpiBf16 {
    static constexpr bool PERM = true, AFTER_DRAIN = false;
    bf16_t* O; int ldc; const PG8_LAS float* rtab; mutable int ui;
    __device__ __forceinline__ void operator()(const f32x4 (&acc)[2][2][4][2], const Unit& u, int wr, int wc, int fr, int fq) const {
        const int row0 = u.pm * BM + wr * 64 + fr; const int col0 = u.pn * BM + wc * 32 + 8 * fq;
#pragma unroll
        for (int ai = 0; ai < 2; ++ai)
#pragma unroll
            for (int m = 0; m < 4; ++m) { bf16_t* rowp = O + (size_t)(row0 + ai * HALF + m * 16) * ldc + col0;
                const float rs = rtab ? rtab[ui * 256 + wr * 64 + fr + ai * HALF + m * 16] : 1.0f;
#pragma unroll
                for (int bj = 0; bj < 2; ++bj) { f32x4 v0 = acc[ai][bj][m][0] * rs, v1 = acc[ai][bj][m][1] * rs;
                    if (ACT == 1) { v0 = (f32x4){gelu_tanh_f(v0[0]), gelu_tanh_f(v0[1]), gelu_tanh_f(v0[2]), gelu_tanh_f(v0[3])}; v1 = (f32x4){gelu_tanh_f(v1[0]), gelu_tanh_f(v1[1]), gelu_tanh_f(v1[2]), gelu_tanh_f(v1[3])}; }
                    u32x4 w; w.x = cvt_pk_bf16(v0[0], v0[1]); w.y = cvt_pk_bf16(v0[2], v0[3]); w.z = cvt_pk_bf16(v1[0], v1[1]); w.w = cvt_pk_bf16(v1[2], v1[3]);
                    *(u32x4*)(rowp + bj * HALF) = w; } asm volatile("" ::: "memory"); }
        ++ui;
    }
};
struct EpiResid {
    static constexpr bool PERM = true, AFTER_DRAIN = false;
    bf16_t* xb; int ldc; float alpha; float* ss;
    __device__ __forceinline__ void operator()(const f32x4 (&acc)[2][2][4][2], const Unit& u, int wr, int wc, int fr, int fq) const {
        const int row0 = u.pm * BM + wr * 64 + fr; const int col0 = u.pn * BM + wc * 32 + 8 * fq; const int lane = fq * 16 + fr;
#pragma unroll
        for (int ai = 0; ai < 2; ++ai) {
            u32x4 pre[4][2];
#pragma unroll
            for (int m = 0; m < 4; ++m)
#pragma unroll
                for (int bj = 0; bj < 2; ++bj) pre[m][bj] = *(const u32x4*)(xb + (size_t)(row0 + ai * HALF + m * 16) * ldc + col0 + bj * HALF);
#pragma unroll
            for (int m = 0; m < 4; ++m) { const int row = row0 + ai * HALF + m * 16; bf16_t* rowp = xb + (size_t)row * ldc + col0; float sq = 0.f;
#pragma unroll
                for (int bj = 0; bj < 2; ++bj) { const u32x4 p = pre[m][bj]; const f32x4 a0 = acc[ai][bj][m][0] * alpha, a1 = acc[ai][bj][m][1] * alpha;
                    const float x0 = __uint_as_float(p.x << 16) + a0[0], x1 = __uint_as_float(p.x & 0xffff0000u) + a0[1], x2 = __uint_as_float(p.y << 16) + a0[2], x3 = __uint_as_float(p.y & 0xffff0000u) + a0[3];
                    const float x4 = __uint_as_float(p.z << 16) + a1[0], x5 = __uint_as_float(p.z & 0xffff0000u) + a1[1], x6 = __uint_as_float(p.w << 16) + a1[2], x7 = __uint_as_float(p.w & 0xffff0000u) + a1[3];
                    sq += ((x0 * x0 + x1 * x1) + (x2 * x2 + x3 * x3)) + ((x4 * x4 + x5 * x5) + (x6 * x6 + x7 * x7));
                    u32x4 w; w.x = cvt_pk_bf16(x0, x1); w.y = cvt_pk_bf16(x2, x3); w.z = cvt_pk_bf16(x4, x5); w.w = cvt_pk_bf16(x6, x7);
                    *(u32x4*)(rowp + bj * HALF) = w; }
                sq += __int_as_float(__builtin_amdgcn_ds_bpermute((lane ^ 16) << 2, __float_as_int(sq)));
                sq += __int_as_float(__builtin_amdgcn_ds_bpermute((lane ^ 32) << 2, __float_as_int(sq)));
                if (fq == 0) ss[(size_t)row * 16 + u.pn * 4 + wc] = sq; }
            asm volatile("" ::: "memory");
        }
    }
};
template <class Epi, class Sched, bool ALIGN_EPI = false, bool SP2 = false>
__device__ __forceinline__ void gemm_phase(PG8_LAS unsigned char* lds, const Gemm g, const Sched& S, const Epi& E, const int wave_in) {
    int tid_l; asm volatile("v_mbcnt_lo_u32_b32 %0, -1, 0\n\tv_mbcnt_hi_u32_b32 %0, -1, %0" : "=v"(tid_l)); tid_l += wave_in * 64;
    const int tid = tid_l, wid = __builtin_amdgcn_readfirstlane(tid >> 6), lane = tid & 63, wr = wid >> 2, wc = wid & 3, fr = lane & 15, fq = lane >> 4;
    const int K = g.K, nt = K / BK;
    unsigned voffA[2], voffB[2];
#pragma unroll
    for (int i = 0; i < 2; ++i) { int R, C; stage_rc(tid * 16 + i * 8192, R, C); const int Rb = Epi::PERM ? ((R & ~31) + perm32(R & 31)) : R;
        voffA[i] = (unsigned)(R * K + C) * 2u; voffB[i] = (unsigned)(Rb * K + C) * 2u; }
    const size_t kstep = (size_t)(BK * 2);
    const size_t hstep = (size_t)HALF * K * 2;
    const size_t tstep = 2 * hstep;
    const unsigned ldsw = (unsigned)wid * 1024u;
    const int aoff = lds_byte(wr * 64 + fr, fq * 8), boff = lds_byte(wc * 32 + fr, fq * 8);
#define PG8_SA(b, h) (((b) * 2 + (h)) * HTB)
#define PG8_SB(b, h) ((4 + (b) * 2 + (h)) * HTB)
#define PG8_STAGE(bufoff, gbase, voff) do { _Pragma("unroll") for (int _i = 0; _i < 2; ++_i) \
        __builtin_amdgcn_global_load_lds((const unsigned*)((const char*)(gbase) + (voff)[_i]), (PG8_LAS unsigned*)(lds + (bufoff) + ldsw + _i * 8192), 16, 0, 0); } while (0)
#define PG8_LDA(dst, b, h) do { _Pragma("unroll") for (int m = 0; m < 4; ++m) _Pragma("unroll") for (int k = 0; k < 2; ++k) dst[m][k] = *(const PG8_LAS bf16x8*)(lds + PG8_SA(b, h) + aoff + m * 2048 + k * 1024); } while (0)
#define PG8_LDB(dst, b, h) do { _Pragma("unroll") for (int n = 0; n < 2; ++n) _Pragma("unroll") for (int k = 0; k < 2; ++k) dst[n][k] = *(const PG8_LAS bf16x8*)(lds + PG8_SB(b, h) + boff + n * 2048 + k * 1024); } while (0)
#define PG8_MMA(ai, bj, At, Bt) do { __builtin_amdgcn_s_setprio(1); _Pragma("unroll") for (int m = 0; m < 4; ++m) _Pragma("unroll") for (int n = 0; n < 2; ++n) _Pragma("unroll") for (int k = 0; k < 2; ++k) \
        acc[ai][bj][m][n] = __builtin_amdgcn_mfma_f32_16x16x32_bf16(Bt[n][k], At[m][k], acc[ai][bj][m][n], 0, 0, 0); __builtin_amdgcn_s_setprio(0); } while (0)
#define PG8_WAIT_V(n) asm volatile("s_waitcnt vmcnt(" #n ")" ::: "memory")
#define PG8_WAIT_L(n) asm volatile("s_waitcnt lgkmcnt(" #n ")" ::: "memory")
#define PG8_BAR __builtin_amdgcn_s_barrier()
#define PG8_SCHED __builtin_amdgcn_sched_barrier(0)
    Unit cur, nxt; int ui = 0;
    if (!S.next(0, cur)) return;
    f32x4 acc[2][2][4][2];
#pragma unroll
    for (int a = 0; a < 2; ++a)
#pragma unroll
        for (int b = 0; b < 2; ++b)
#pragma unroll
            for (int m = 0; m < 4; ++m)
#pragma unroll
                for (int n = 0; n < 2; ++n) acc[a][b][m][n] = (f32x4){0.f, 0.f, 0.f, 0.f};
    bf16x8 At[4][2], B0[2][2], B1[2][2];
    const char* cA = (const char*)g.A + (size_t)cur.pm * tstep; const char* cB = (const char*)g.Bt + (size_t)cur.pn * tstep;
    S.a_ready(cur);
    if constexpr (SP2) {
        PG8_STAGE(PG8_SB(0, 0), cB, voffB); PG8_STAGE(PG8_SB(0, 1), cB + hstep, voffB); PG8_STAGE(PG8_SA(0, 0), cA, voffA); PG8_STAGE(PG8_SA(0, 1), cA + hstep, voffA);
        if (wr == 1) PG8_BAR;
        PG8_WAIT_V(2); PG8_BAR;
        PG8_STAGE(PG8_SB(1, 0), cB + kstep, voffB); PG8_STAGE(PG8_SA(1, 0), cA + kstep, voffA); PG8_STAGE(PG8_SB(1, 1), cB + hstep + kstep, voffB);
        PG8_WAIT_V(6); PG8_BAR;
    } else {
        PG8_STAGE(PG8_SB(0, 0), cB, voffB); PG8_STAGE(PG8_SA(0, 0), cA, voffA); PG8_STAGE(PG8_SB(0, 1), cB + hstep, voffB); PG8_STAGE(PG8_SA(0, 1), cA + hstep, voffA);
        if (wr == 1) PG8_BAR;
        PG8_WAIT_V(4); PG8_BAR;
        PG8_STAGE(PG8_SB(1, 0), cB + kstep, voffB); PG8_STAGE(PG8_SA(1, 0), cA + kstep, voffA); PG8_STAGE(PG8_SB(1, 1), cB + hstep + kstep, voffB);
        PG8_WAIT_V(6); PG8_BAR;
    }
    for (;;) {
        const bool has_next = S.next(ui + 1, nxt);
        const char* nA = has_next ? (const char*)g.A + (size_t)nxt.pm * tstep : cA; const char* nB = has_next ? (const char*)g.Bt + (size_t)nxt.pn * tstep : cB;
        for (int t = 0; t < nt; t += 2) {
            const bool last = (t == nt - 2);
            const char* a1 = cA + (size_t)(t + 1) * kstep;
            const char* a2 = last ? nA : cA + (size_t)(t + 2) * kstep; const char* b2 = last ? nB : cB + (size_t)(t + 2) * kstep;
            const char* a3 = a2 + kstep; const char* b3 = b2 + kstep;
            if (last && has_next) S.a_ready(nxt);
            if constexpr (SP2) {
            PG8_LDB(B0, 0, 0); PG8_LDB(B1, 0, 1); PG8_SCHED; PG8_LDA(At, 0, 0); PG8_STAGE(PG8_SA(1, 1), a1 + hstep, voffA);
            PG8_WAIT_V(8); PG8_WAIT_L(0); PG8_BAR; PG8_MMA(0, 0, At, B0); PG8_MMA(0, 1, At, B1); PG8_BAR; PG8_SCHED;
            PG8_LDA(At, 0, 1); PG8_STAGE(PG8_SB(0, 0), b2, voffB); PG8_STAGE(PG8_SB(0, 1), b2 + hstep, voffB); PG8_STAGE(PG8_SA(0, 0), a2, voffA);
            PG8_WAIT_V(8); PG8_WAIT_L(0); PG8_BAR; PG8_MMA(1, 0, At, B0); PG8_MMA(1, 1, At, B1); PG8_BAR; PG8_SCHED;
            PG8_LDB(B0, 1, 0); PG8_LDB(B1, 1, 1); PG8_SCHED; PG8_LDA(At, 1, 0); PG8_STAGE(PG8_SA(0, 1), a2 + hstep, voffA);
            PG8_WAIT_V(8); PG8_WAIT_L(0); PG8_BAR; PG8_MMA(0, 0, At, B0); PG8_MMA(0, 1, At, B1); PG8_BAR; PG8_SCHED;
            PG8_LDA(At, 1, 1); PG8_STAGE(PG8_SB(1, 0), b3, voffB); PG8_STAGE(PG8_SB(1, 1), b3 + hstep, voffB); PG8_STAGE(PG8_SA(1, 0), a3, voffA);
            PG8_WAIT_V(8); PG8_WAIT_L(0); PG8_BAR; PG8_MMA(1, 0, At, B0); PG8_MMA(1, 1, At, B1); PG8_BAR; PG8_SCHED;
            } else {
            PG8_LDB(B0, 0, 0); PG8_SCHED; PG8_LDA(At, 0, 0); PG8_STAGE(PG8_SA(1, 1), a1 + hstep, voffA);
            PG8_WAIT_L(8); PG8_BAR; PG8_WAIT_L(0); PG8_MMA(0, 0, At, B0); PG8_BAR; PG8_SCHED;
            PG8_LDB(B1, 0, 1); PG8_STAGE(PG8_SB(0, 0), b2, voffB);
            PG8_BAR; PG8_WAIT_L(0); PG8_MMA(0, 1, At, B1); PG8_BAR;
            PG8_LDA(At, 0, 1); PG8_STAGE(PG8_SA(0, 0), a2, voffA);
            PG8_BAR; PG8_WAIT_L(0); PG8_MMA(1, 0, At, B0); PG8_BAR; PG8_SCHED;
            PG8_STAGE(PG8_SB(0, 1), b2 + hstep, voffB);
            PG8_WAIT_V(6); PG8_BAR; PG8_MMA(1, 1, At, B1); PG8_BAR;
            PG8_LDB(B0, 1, 0); PG8_SCHED; PG8_LDA(At, 1, 0); PG8_STAGE(PG8_SA(0, 1), a2 + hstep, voffA);
            PG8_WAIT_L(8); PG8_BAR; PG8_WAIT_L(0); PG8_MMA(0, 0, At, B0); PG8_BAR; PG8_SCHED;
            PG8_LDB(B1, 1, 1); PG8_STAGE(PG8_SB(1, 0), b3, voffB);
            PG8_BAR; PG8_WAIT_L(0); PG8_MMA(0, 1, At, B1); PG8_BAR;
            PG8_LDA(At, 1, 1); PG8_STAGE(PG8_SA(1, 0), a3, voffA);
            PG8_BAR; PG8_WAIT_L(0); PG8_MMA(1, 0, At, B0); PG8_BAR; PG8_SCHED;
            PG8_STAGE(PG8_SB(1, 1), b3 + hstep, voffB);
            PG8_WAIT_V(6); PG8_BAR; PG8_MMA(1, 1, At, B1); PG8_BAR;
            }
        }
        if constexpr (ALIGN_EPI) { if (wr == 0) PG8_BAR; }
        if constexpr (!Epi::AFTER_DRAIN) { E(acc, cur, wr, wc, fr, fq); S.done(cur); }
        if (!has_next) break;
#pragma unroll
        for (int a = 0; a < 2; ++a)
#pragma unroll
            for (int b = 0; b < 2; ++b)
#pragma unroll
                for (int m = 0; m < 4; ++m)
#pragma unroll
                    for (int n = 0; n < 2; ++n) acc[a][b][m][n] = (f32x4){0.f, 0.f, 0.f, 0.f};
        cur = nxt; cA = nA; cB = nB; ++ui;
        if constexpr (ALIGN_EPI) { if (wr == 1) PG8_BAR; }
    }
    PG8_WAIT_V(0);
    if constexpr (!ALIGN_EPI) { if (wr == 0) PG8_BAR; }
    PG8_BAR;
    if constexpr (Epi::AFTER_DRAIN) { E.fused(acc, cur, wr, wc, fr, fq, lds, wid, lane); S.done(cur); }
#undef PG8_SA
#undef PG8_SB
#undef PG8_STAGE
#undef PG8_LDA
#undef PG8_LDB
#undef PG8_MMA
#undef PG8_WAIT_V
#undef PG8_WAIT_L
#undef PG8_BAR
#undef PG8_SCHED
}
}

#define LAS __attribute__((address_space(3)))
using pg8::ex2; using pg8::rcpf_;
typedef unsigned short u16;
typedef short bf16x8 __attribute__((ext_vector_type(8)));
typedef float f32x4 __attribute__((ext_vector_type(4)));
typedef float f32x16 __attribute__((ext_vector_type(16)));
typedef unsigned u32x4 __attribute__((ext_vector_type(4)));
typedef unsigned u32x2 __attribute__((ext_vector_type(2)));

constexpr int DM = 1024, NB = 16, SEQ = 2048, MTOK = NB * SEQ, DEPTH = 4, DFF = 2816, INW = 2840, PW = 3072;
constexpr int C_MQ = 0, C_MK = 256, C_MV = 512, C_DQ = 768, C_DK = 1024, C_DV = 1280, C_NQ = 1536, C_NKC = 2048, C_NVC = 2176, C_NKS = 2304, C_NVS = 2432, C_NKW = 2560, C_NVW = 2688, C_NG = 2816;
constexpr int NVH = 12;
constexpr float LOG2E = 1.4426950408889634f, NEGF = -1e30f;
constexpr int NPH_L = 14, NPH = NPH_L * DEPTH + 1;
constexpr size_t MiB = 1u << 20;
constexpr size_t WS_GU1 = 1 * MiB, WS_DN1 = 12 * MiB, WS_GU2 = WS_DN1 + 5 * MiB + MiB / 2, WS_DN2 = WS_GU2 + 11 * MiB, WS_WIN = 34 * MiB, WS_WOUT = 40 * MiB, WS_W1 = 42 * MiB;
constexpr size_t WS_PROJ = 44 * MiB, WS_XN = 236 * MiB, WS_VT = 300 * MiB, WS_HID = 348 * MiB, WS_KCMP = 352 * MiB, WS_VCMPT = WS_KCMP + MiB / 2, WS_KMEAN = 353 * MiB, WS_SEL = WS_KMEAN + MiB / 4, WS_XB = 354 * MiB, WS_SS = 418 * MiB, WS_END = 420 * MiB;
static_assert(WS_DN2 + 5 * MiB + MiB / 2 == WS_WIN, "ws map");
constexpr int LDS_BYTES = 147456, MISC_OFF = 147456 - 64, RTAB_OFF = 131072;
constexpr size_t WS_CTL = 0, CTL_ZERO_BYTES = 262144;
constexpr int ATT_K = 0, ATT_V = 32768, ATT_LUT = 32768 + 4 * 8704, ATT_PARK = ATT_LUT + 2816;
constexpr int CMP_K = 0, CMP_V = 18432, CMP_A = 36864, CMP_H = CMP_A + 256 * 33 * 4;

struct Params {
    const float* x; const float* rel_bias; const float* norm_ffn1; const float* ffn1_gate; const float* ffn1_up; const float* ffn1_down;
    const float* norm_mix; const float* w_in; const float* diff_lambda; const float* diff_subln; const float* cmp_pe; const float* cmp_w1; const float* cmp_w2;
    const float* w_out; const float* norm_ffn2; const float* ffn2_gate; const float* ffn2_up; const float* ffn2_down; const float* final_norm;
    float* out; unsigned char* ws;
    float lam_init[4];
    int ph_lo, ph_hi;
};
typedef const __attribute__((address_space(4))) Params* KParamsPtr;

__device__ __forceinline__ float bf2f(unsigned v) { return __uint_as_float(v << 16); }
typedef float f32x2_t __attribute__((ext_vector_type(2))); typedef __bf16 bf16x2_t __attribute__((ext_vector_type(2)));
__device__ __forceinline__ unsigned pkbf(float lo, float hi) { f32x2_t v = {lo, hi}; bf16x2_t b = __builtin_convertvector(v, bf16x2_t); return __builtin_bit_cast(unsigned, b); }
__device__ __forceinline__ int lane_opaque() { int l; asm volatile("v_mbcnt_lo_u32_b32 %0, -1, 0\n\tv_mbcnt_hi_u32_b32 %0, -1, %0" : "=v"(l)); return l; }
__device__ __forceinline__ float wave_sum(float v, int lane) {
#pragma unroll
    for (int o = 1; o < 64; o <<= 1) v += __int_as_float(__builtin_amdgcn_ds_bpermute((lane ^ o) << 2, __float_as_int(v)));
    return v;
}
__device__ __forceinline__ float xhalf_max(float v) { auto rr = __builtin_amdgcn_permlane32_swap(__float_as_uint(v), __float_as_uint(v), false, false); return fmaxf(__uint_as_float(rr[0]), __uint_as_float(rr[1])); }
__device__ __forceinline__ float xhalf_sum(float v) { auto rr = __builtin_amdgcn_permlane32_swap(__float_as_uint(v), __float_as_uint(v), false, false); return __uint_as_float(rr[0]) + __uint_as_float(rr[1]); }
__device__ __forceinline__ float sigmoid_f(float x) { return rcpf_(1.0f + ex2(-LOG2E * x)); }
__device__ __forceinline__ int crow(int r, int hi) { return (r & 3) + 8 * (r >> 2) + 4 * hi; }
__device__ __forceinline__ int kperm(int p) { const int h = p >> 3, j = p & 7; return 8 * (j >> 2) + 4 * h + (j & 3); }
__device__ __forceinline__ int pperm(int k) { return ((k >> 2) & 1) * 8 + (k >> 3) * 4 + (k & 3); }

__device__ __forceinline__ void tr_item(const float* W, int K, int N, u16* WT, int kb, int n0, int dst_row0, LAS float* scr, int lane, float cs = 1.0f, const float* gk = nullptr) {
    const int k0 = 64 * kb; const int n = n0 + (lane & 31); const bool ok = n < N;
    float wv[32];
#pragma unroll
    for (int i = 0; i < 32; ++i) { const int kk = 2 * i + (lane >> 5); wv[i] = ok ? W[(size_t)(k0 + kk) * N + n] : 0.f; }
#pragma unroll
    for (int i = 0; i < 32; ++i) { const int kk = 2 * i + (lane >> 5); scr[kk * 33 + (lane & 31)] = wv[i] * (gk ? gk[k0 + kk] * cs : cs); }
    asm volatile("s_waitcnt lgkmcnt(0)" ::: "memory");
    const int c = lane & 7;
#pragma unroll
    for (int j = 0; j < 4; ++j) { const int nn = (lane >> 3) + 8 * j; const LAS float* s = scr + (8 * c) * 33 + nn;
        u32x4 o; o.x = pkbf(s[0 * 33], s[1 * 33]); o.y = pkbf(s[2 * 33], s[3 * 33]); o.z = pkbf(s[4 * 33], s[5 * 33]); o.w = pkbf(s[6 * 33], s[7 * 33]);
        *(u32x4*)(WT + (size_t)(dst_row0 + nn) * K + k0 + 8 * c) = o; }
    asm volatile("s_waitcnt lgkmcnt(0)" ::: "memory");
}

__device__ __forceinline__ void norm_row(const float* xrow, const u16* xrow16, const float* g, u16* dst16, float* dst32, u16* xb0, int lane) {
    float v[16];
    if (xrow) { const f32x4* xr = (const f32x4*)xrow + 4 * lane;
#pragma unroll
        for (int j = 0; j < 4; ++j) { const f32x4 t = xr[j]; v[4 * j] = t.x; v[4 * j + 1] = t.y; v[4 * j + 2] = t.z; v[4 * j + 3] = t.w; }
        if (xb0) { u32x4 o0, o1; o0.x = pkbf(v[0], v[1]); o0.y = pkbf(v[2], v[3]); o0.z = pkbf(v[4], v[5]); o0.w = pkbf(v[6], v[7]); o1.x = pkbf(v[8], v[9]); o1.y = pkbf(v[10], v[11]); o1.z = pkbf(v[12], v[13]); o1.w = pkbf(v[14], v[15]);
            ((u32x4*)xb0)[2 * lane] = o0; ((u32x4*)xb0)[2 * lane + 1] = o1; }
    } else { const u32x4 p0 = ((const u32x4*)xrow16)[2 * lane], p1 = ((const u32x4*)xrow16)[2 * lane + 1];
        v[0] = bf2f(p0.x & 0xffffu); v[1] = bf2f(p0.x >> 16); v[2] = bf2f(p0.y & 0xffffu); v[3] = bf2f(p0.y >> 16); v[4] = bf2f(p0.z & 0xffffu); v[5] = bf2f(p0.z >> 16); v[6] = bf2f(p0.w & 0xffffu); v[7] = bf2f(p0.w >> 16);
        v[8] = bf2f(p1.x & 0xffffu); v[9] = bf2f(p1.x >> 16); v[10] = bf2f(p1.y & 0xffffu); v[11] = bf2f(p1.y >> 16); v[12] = bf2f(p1.z & 0xffffu); v[13] = bf2f(p1.z >> 16); v[14] = bf2f(p1.w & 0xffffu); v[15] = bf2f(p1.w >> 16); }
    float s = 0.f;
#pragma unroll
    for (int j = 0; j < 16; ++j) s = fmaf(v[j], v[j], s);
    const float rstd = 1.0f / sqrtf(wave_sum(s, lane) * (1.0f / 1024.0f) + 1e-6f);
    const f32x4* gr = (const f32x4*)g + 4 * lane;
#pragma unroll
    for (int j = 0; j < 4; ++j) { const f32x4 gg = gr[j]; v[4 * j] *= rstd * gg.x; v[4 * j + 1] *= rstd * gg.y; v[4 * j + 2] *= rstd * gg.z; v[4 * j + 3] *= rstd * gg.w; }
    if (dst16) { u32x4 o0, o1; o0.x = pkbf(v[0], v[1]); o0.y = pkbf(v[2], v[3]); o0.z = pkbf(v[4], v[5]); o0.w = pkbf(v[6], v[7]); o1.x = pkbf(v[8], v[9]); o1.y = pkbf(v[10], v[11]); o1.z = pkbf(v[12], v[13]); o1.w = pkbf(v[14], v[15]);
        ((u32x4*)dst16)[2 * lane] = o0; ((u32x4*)dst16)[2 * lane + 1] = o1; }
    else {
#pragma unroll
        for (int j = 0; j < 4; ++j) ((f32x4*)dst32)[4 * lane + j] = (f32x4){v[4 * j], v[4 * j + 1], v[4 * j + 2], v[4 * j + 3]}; }
}

struct AState { f32x16 o0, o1; float m, l; };
__device__ __forceinline__ void astate_init(AState& s) {
#pragma unroll
    for (int r = 0; r < 16; ++r) { s.o0[r] = 0.f; s.o1[r] = 0.f; }
    s.m = 0.f; s.l = 0.f;
}
constexpr float ATT_THR = 8.0f;
constexpr int ATT_SLOT = 9216, ATT_NSLOT = 3;
template <int KS0, int NKS>
__device__ __forceinline__ void qk_block(const LAS unsigned char* Ks, const bf16x8 (&qr)[4], int r32, int hi, f32x16& s0, f32x16& s1) {
    f32x16 ci;
#pragma unroll
    for (int r = 0; r < 16; ++r) ci[r] = 0.f;
    const LAS unsigned char* kp = Ks + hi * 1024 + r32 * 16;
#pragma unroll
    for (int ks = 0; ks < NKS; ++ks) {
        const bf16x8 a0 = *(const LAS bf16x8*)(kp + (KS0 + ks) * 2048);
        const bf16x8 a1 = *(const LAS bf16x8*)(kp + (KS0 + ks) * 2048 + 512);
        s0 = __builtin_amdgcn_mfma_f32_32x32x16_bf16(a0, qr[KS0 + ks], ks == 0 ? ci : s0, 0, 0, 0);
        s1 = __builtin_amdgcn_mfma_f32_32x32x16_bf16(a1, qr[KS0 + ks], ks == 0 ? ci : s1, 0, 0, 0);
    }
    __builtin_amdgcn_sched_group_barrier(0x100, 2 * NKS, 0); __builtin_amdgcn_sched_group_barrier(0x008, 2 * NKS, 0);
}
constexpr int ATT_VCH = 1088, ATT_VSLOT = 8 * ATT_VCH;
typedef short v4i16_t __attribute__((ext_vector_type(4)));
__device__ __forceinline__ void pv_block(const LAS unsigned char* Vs, const u32x4 (&pk)[4], int lane, AState& st) {
    const int p = lane & 3, q = (lane & 15) >> 2, dsel = (lane >> 4) & 1, hi = lane >> 5;
    const LAS unsigned char* vp = Vs + (2 * dsel + (p >> 1)) * ATT_VCH + (4 * hi + q) * 16 + (p & 1) * 8;
#pragma unroll
    for (int c = 0; c < 4; ++c) {
        const v4i16_t a0 = __builtin_amdgcn_ds_read_tr16_b64_v4i16((LAS v4i16_t*)(vp + c * 256));
        const v4i16_t a1 = __builtin_amdgcn_ds_read_tr16_b64_v4i16((LAS v4i16_t*)(vp + c * 256 + 128));
        const v4i16_t b0 = __builtin_amdgcn_ds_read_tr16_b64_v4i16((LAS v4i16_t*)(vp + 4 * ATT_VCH + c * 256));
        const v4i16_t b1 = __builtin_amdgcn_ds_read_tr16_b64_v4i16((LAS v4i16_t*)(vp + 4 * ATT_VCH + c * 256 + 128));
        const bf16x8 v0 = (bf16x8){a0[0], a0[1], a0[2], a0[3], a1[0], a1[1], a1[2], a1[3]};
        const bf16x8 v1 = (bf16x8){b0[0], b0[1], b0[2], b0[3], b1[0], b1[1], b1[2], b1[3]};
        const bf16x8 pb = __builtin_bit_cast(bf16x8, pk[c]);
        st.o0 = __builtin_amdgcn_mfma_f32_32x32x16_bf16(v0, pb, st.o0, 0, 0, 0);
        st.o1 = __builtin_amdgcn_mfma_f32_32x32x16_bf16(v1, pb, st.o1, 0, 0, 0);
    }
}
__device__ __forceinline__ void glds16(const void* gsrc, unsigned lds_dst) { unsigned keep;
    asm volatile("s_mov_b32 %0, m0\n\ts_mov_b32 m0, %2\n\ts_nop 0\n\tglobal_load_lds_dwordx4 %1, off\n\ts_mov_b32 m0, %0" : "=&s"(keep) : "v"(gsrc), "s"(lds_dst) : "memory"); }
__device__ __forceinline__ void lut_add(f32x16& s0, f32x16& s1, const LAS float* lutz, int dbase, float cc) {
    const LAS float* lp = lutz + (dbase - 59);
#pragma unroll
    for (int r = 0; r < 16; ++r) { const int ko = (r & 3) + 8 * (r >> 2);
        s0[r] += lp[59 - ko] + cc; s1[r] += lp[27 - ko] + cc; }
}
__device__ __forceinline__ void const_add(f32x16& s0, f32x16& s1, float cc) {
#pragma unroll
    for (int r = 0; r < 16; ++r) { s0[r] += cc; s1[r] += cc; }
}
__device__ __forceinline__ float row_max(const f32x16& s0, const f32x16& s1) {
    float mx = fmaxf(s0[0], s1[0]);
#pragma unroll
    for (int r = 1; r < 16; ++r) mx = fmaxf(mx, fmaxf(s0[r], s1[r]));
    return xhalf_max(mx);
}
__device__ __forceinline__ void rescale(AState& st, f32x16& s0, f32x16& s1, float mx) {
    const float dl = fmaxf(mx, 0.f); const float f = ex2(-dl); st.m += dl; st.l *= f;
#pragma unroll
    for (int r = 0; r < 16; ++r) { st.o0[r] *= f; st.o1[r] *= f; s0[r] -= dl; s1[r] -= dl; }
}
constexpr float ATT_BIG = 1024.0f;
__device__ __forceinline__ void exp_pack(f32x16& s0, f32x16& s1, u32x4 (&pk)[4], AState& st) {
    float sum = 0.f;
#pragma unroll
    for (int r = 0; r < 16; ++r) { s0[r] = ex2(s0[r]); s1[r] = ex2(s1[r]); sum += s0[r] + s1[r]; }
    if (__any(sum > ATT_BIG)) {
        float mx = fmaxf(s0[0], s1[0]);
#pragma unroll
        for (int r = 1; r < 16; ++r) mx = fmaxf(mx, fmaxf(s0[r], s1[r]));
        mx = xhalf_max(mx);
        const float dl = fmaxf(__builtin_amdgcn_logf(fmaxf(mx, 1.0f)), 0.f), f = ex2(-dl);
        st.m += dl; st.l *= f; sum *= f;
#pragma unroll
        for (int r = 0; r < 16; ++r) { st.o0[r] *= f; st.o1[r] *= f; s0[r] *= f; s1[r] *= f; }
    }
    st.l += sum;
    pk[0] = (u32x4){pkbf(s0[0], s0[1]), pkbf(s0[2], s0[3]), pkbf(s0[4], s0[5]), pkbf(s0[6], s0[7])};
    pk[1] = (u32x4){pkbf(s0[8], s0[9]), pkbf(s0[10], s0[11]), pkbf(s0[12], s0[13]), pkbf(s0[14], s0[15])};
    pk[2] = (u32x4){pkbf(s1[0], s1[1]), pkbf(s1[2], s1[3]), pkbf(s1[4], s1[5]), pkbf(s1[6], s1[7])};
    pk[3] = (u32x4){pkbf(s1[8], s1[9]), pkbf(s1[10], s1[11]), pkbf(s1[12], s1[13]), pkbf(s1[14], s1[15])};
}

template <int KS0, int NKS, bool WINDOW, int MODE>
__device__ __forceinline__ void run_tiles(LAS unsigned char* lds, int t0, int t1, const u16* Kg, const u16* Vtg, const bf16x8 (&qr)[4], float c31,
                                          int q0w, unsigned mask, int qb, AState& A, int wave, int lane, int r32, int hi) {
    LAS unsigned char* Kr = lds + ATT_K; LAS unsigned char* Vr = lds + ATT_V; const LAS float* lut1 = (const LAS float*)(lds + ATT_LUT) + 96;
    const u16* ksrc = Kg + (size_t)lane * PW + wave * 8;
    const u16* vsrc = Vtg + (size_t)lane * PW + wave * 8;
    const unsigned kdst = (unsigned)(uintptr_t)Kr + wave * 1024, vdst = (unsigned)(uintptr_t)Vr + wave * ATT_VCH;
#define TCL(t) ((t) < t0 ? t0 : ((t) > t1 ? t1 : (t)))
#define DMA_K(tn) glds16(ksrc + (size_t)TCL(tn) * 64 * PW, (unsigned)__builtin_amdgcn_readfirstlane(kdst + ((tn) & 3) * 8192))
#define DMA_V(tn) glds16(vsrc + (size_t)TCL(tn) * 64 * PW, (unsigned)__builtin_amdgcn_readfirstlane(vdst + ((tn) & 3) * ATT_VSLOT))
#define KS_(t) (Kr + ((t) & 3) * 8192)
#define VS_(t) (Vr + ((t) & 3) * ATT_VSLOT)
#define WAIT_BAR4() asm volatile("s_waitcnt vmcnt(4) lgkmcnt(0)\n\ts_barrier" ::: "memory")
#define T_ACTIVE(t) (!((q0w + 31 - (t) * 64) < 0 || (WINDOW && (q0w - ((t) * 64 + 63)) >= 512)))
#define T_LUTMODE(t) (((q0w - ((t) * 64 + 63)) < 128) || (WINDOW && (q0w + 31 - (t) * 64) >= 512))
    auto tile_sel = [&](int t) -> int { if (MODE == 1) { const int blk = t >> 2; return blk < qb ? (int)((mask >> blk) & 1u) : 1; } if (MODE == 2) return (int)((mask >> t) & 1u); return 1; };
    asm volatile("s_waitcnt vmcnt(0)" ::: "memory");
#pragma unroll
    for (int j = 0; j < 4; ++j) { DMA_K(t0 + j); DMA_V(t0 + j - 2); }
    WAIT_BAR4();
    f32x16 sn0, sn1, sc0, sc1; u32x4 pk[4];
#pragma unroll
    for (int r = 0; r < 16; ++r) { sn0[r] = 0.f; sn1[r] = 0.f; }
#pragma unroll
    for (int i = 0; i < 4; ++i) pk[i] = (u32x4){0u, 0u, 0u, 0u};
    bool act_n = T_ACTIVE(t0), act_c = false, act_p = false;
    if (act_n) qk_block<KS0, NKS>(KS_(t0), qr, r32, hi, sn0, sn1);
    asm volatile("s_waitcnt lgkmcnt(0)\n\ts_barrier" ::: "memory");
    for (int c = t0; c <= t1 + 1; ++c) {
        act_p = act_c; act_c = act_n; sc0 = sn0; sc1 = sn1;
        DMA_K(c + 4); DMA_V(c + 2);
        act_n = (c + 1 <= t1) && T_ACTIVE(c + 1);
        const bool lm_c = T_LUTMODE(c);
        const int dbase = q0w + r32 - c * 64 - 4 * hi;
        const float selc = tile_sel(c) ? 0.f : NEGF;
        if (act_p) pv_block(VS_(c - 1), pk, lane, A);
        if (act_c) {
            const float cc = selc - A.m;
            if (lm_c) lut_add(sc0, sc1, lut1, dbase, cc); else if (__any(cc != 0.f)) const_add(sc0, sc1, cc);
        }
        if (act_n) qk_block<KS0, NKS>(KS_(c + 1), qr, r32, hi, sn0, sn1);
        if (act_c) exp_pack(sc0, sc1, pk, A);
        WAIT_BAR4();
    }
    asm volatile("s_waitcnt vmcnt(0) lgkmcnt(0)\n\ts_barrier" ::: "memory");
#undef TCL
#undef DMA_K
#undef DMA_V
#undef KS_
#undef VS_
#undef WAIT_BAR4
#undef T_ACTIVE
#undef T_LUTMODE
}

__device__ __forceinline__ void build_lut(LAS unsigned char* lds, const float* rel_bias, int head, bool window, int tid) {
    LAS float* lut = (LAS float*)(lds + ATT_LUT);
    for (int i = tid; i < 704; i += 512) {
        const int d = i - 96; float v; const float c31 = rel_bias[31 * 16 + head];
        if (d < 0) v = NEGF;
        else if (d >= 512) v = window ? NEGF : 0.f;
        else { int bk;
            if (d < 16) bk = d; else if (d >= 128) bk = 31; else { bk = 16 + (int)(log2f((float)d * (1.0f / 16.0f)) * (16.0f / 3.0f)); bk = bk > 31 ? 31 : bk; }
            v = (rel_bias[bk * 16 + head] - c31) * LOG2E; }
        lut[i] = v;
    }
}
__device__ __forceinline__ void load_q(bf16x8 (&qr)[4], const u16* qrow, int hi) {
#pragma unroll
    for (int ks = 0; ks < 4; ++ks) qr[ks] = *(const bf16x8*)(qrow + ks * 16 + hi * 8);
}
__device__ __forceinline__ void store_o(u16* dst, const f32x16& v0, const f32x16& v1, int hi) {
#pragma unroll
    for (int p = 0; p < 2; ++p) {
        { const unsigned ax = pkbf(v0[8 * p], v0[8 * p + 1]), ay = pkbf(v0[8 * p + 2], v0[8 * p + 3]), bx = pkbf(v0[8 * p + 4], v0[8 * p + 5]), by = pkbf(v0[8 * p + 6], v0[8 * p + 7]);
          auto rx = __builtin_amdgcn_permlane32_swap(ax, bx, false, false); auto ry = __builtin_amdgcn_permlane32_swap(ay, by, false, false);
          *(u32x4*)(dst + 16 * p + 8 * hi) = (u32x4){rx[0], ry[0], rx[1], ry[1]}; }
        { const unsigned ax = pkbf(v1[8 * p], v1[8 * p + 1]), ay = pkbf(v1[8 * p + 2], v1[8 * p + 3]), bx = pkbf(v1[8 * p + 4], v1[8 * p + 5]), by = pkbf(v1[8 * p + 6], v1[8 * p + 7]);
          auto rx = __builtin_amdgcn_permlane32_swap(ax, bx, false, false); auto ry = __builtin_amdgcn_permlane32_swap(ay, by, false, false);
          *(u32x4*)(dst + 32 + 16 * p + 8 * hi) = (u32x4){rx[0], ry[0], rx[1], ry[1]}; }
    }
}

struct Ctx { LAS unsigned char* lds; int tid, lane, wave, r32, hi, G, bx; u16* proj; u16* obuf; u16* vt; };

__device__ __forceinline__ void moba_unit(const Ctx& C0, KParamsPtr P, int b, int h, int qb) {
    Ctx C = C0; C.lane = lane_opaque(); C.tid = C.wave * 64 + C.lane; C.r32 = C.lane & 31; C.hi = C.lane >> 5;
    const int q0w = __builtin_amdgcn_readfirstlane(qb * 256 + C.wave * 32); const int qpos = q0w + C.r32; const size_t tok = (size_t)b * SEQ + qpos;
    build_lut(C.lds, P->rel_bias, h, false, C.tid);
    const u16* qrow = C.proj + tok * PW + C_MQ + h * 64;
    bf16x8 qr[4]; load_q(qr, qrow, C.hi);
    unsigned mask = 0;
    if (qb > 0) {
        float g[7];
#pragma unroll
        for (int j = 0; j < 7; ++j) g[j] = 0.f;
        const float* km = (const float*)(P->ws + WS_KMEAN) + (size_t)((b * 4 + h) * 8) * 64;
#pragma unroll
        for (int dc = 0; dc < 8; ++dc) {
            const u32x4 qv = *(const u32x4*)(qrow + dc * 8);
            float qf[8]; qf[0] = bf2f(qv.x & 0xffffu); qf[1] = bf2f(qv.x >> 16); qf[2] = bf2f(qv.y & 0xffffu); qf[3] = bf2f(qv.y >> 16);
            qf[4] = bf2f(qv.z & 0xffffu); qf[5] = bf2f(qv.z >> 16); qf[6] = bf2f(qv.w & 0xffffu); qf[7] = bf2f(qv.w >> 16);
#pragma unroll
            for (int j = 0; j < 7; ++j) if (j < qb) { const float* kmj = km + j * 64 + dc * 8;
#pragma unroll
                for (int e = 0; e < 8; ++e) g[j] = fmaf(qf[e], kmj[e], g[j]); }
        }
#pragma unroll
        for (int j = 0; j < 7; ++j) if (j < qb) { int rank = 0;
#pragma unroll
            for (int i = 0; i < 7; ++i) if (i != j && i < qb) rank += (g[i] > g[j] || (g[i] == g[j] && i < j)) ? 1 : 0;
            if (rank < 3) mask |= 1u << j; }
    }
    AState A; astate_init(A);
    const float c31 = P->rel_bias[31 * 16 + h] * LOG2E;
    run_tiles<0, 4, false, 1>(C.lds, 0, 4 * qb + 3, C.proj + (size_t)b * SEQ * PW + C_MK + h * 64, C.proj + (size_t)b * SEQ * PW + C_MV + h * 64, qr, c31, q0w, mask, qb, A, C.wave, C.lane, C.r32, C.hi);
    const float inv = rcpf_(xhalf_sum(A.l));
    A.o0 *= inv; A.o1 *= inv;
    { const int l2 = lane_opaque(); const size_t tok2 = (size_t)b * SEQ + q0w + (l2 & 31);
      store_o(C.obuf + tok2 * DM + h * 64, A.o0, A.o1, l2 >> 5); }
}

__device__ __forceinline__ void diff_unit(const Ctx& C0, KParamsPtr P, int layer, int b, int h, int qb) {
    Ctx C = C0; C.lane = lane_opaque(); C.tid = C.wave * 64 + C.lane; C.r32 = C.lane & 31; C.hi = C.lane >> 5;
    const int q0w = __builtin_amdgcn_readfirstlane(qb * 256 + C.wave * 32); const int qpos = q0w + C.r32; const size_t tok = (size_t)b * SEQ + qpos;
    build_lut(C.lds, P->rel_bias, 4 + h, false, C.tid);
    bf16x8 qr[4]; load_q(qr, C.proj + tok * PW + C_DQ + h * 64, C.hi);
    AState A; astate_init(A);
    const float c31 = P->rel_bias[31 * 16 + 4 + h] * LOG2E;
    const u16* Kg = C.proj + (size_t)b * SEQ * PW + C_DK + h * 64; const u16* Vg = C.proj + (size_t)b * SEQ * PW + C_DV + h * 64;
    run_tiles<0, 2, false, 0>(C.lds, 0, 4 * qb + 3, Kg, Vg, qr, c31, q0w, 0u, 0, A, C.wave, C.lane, C.r32, C.hi);
    LAS float* park = (LAS float*)(C.lds + ATT_PARK) + C.tid;
    { const float i0 = rcpf_(xhalf_sum(A.l));
#pragma unroll
      for (int r = 0; r < 16; ++r) { park[r * 512] = A.o0[r] * i0; park[(16 + r) * 512] = A.o1[r] * i0; } }
    astate_init(A);
    run_tiles<2, 2, false, 0>(C.lds, 0, 4 * qb + 3, Kg, Vg, qr, c31, q0w, 0u, 0, A, C.wave, C.lane, C.r32, C.hi);
    const float* lp = P->diff_lambda + (size_t)layer * 128; float d01 = 0.f, d23 = 0.f;
    for (int i = 0; i < 32; ++i) { d01 = fmaf(lp[i], lp[32 + i], d01); d23 = fmaf(lp[64 + i], lp[96 + i], d23); }
    const float li = P->lam_init[layer]; const float lam = expf(d01) - expf(d23) + li;
    const float i1 = lam * rcpf_(xhalf_sum(A.l));
    float ss = 0.f;
#pragma unroll
    for (int r = 0; r < 16; ++r) { A.o0[r] = park[r * 512] - A.o0[r] * i1; A.o1[r] = park[(16 + r) * 512] - A.o1[r] * i1; ss += A.o0[r] * A.o0[r] + A.o1[r] * A.o1[r]; }
    ss = xhalf_sum(ss);
    const float rstd = (1.0f / sqrtf(ss * (1.0f / 64.0f) + 1e-6f)) * (1.0f - li);
    const float* sg = P->diff_subln + (size_t)layer * 64;
#pragma unroll
    for (int r = 0; r < 16; ++r) { const int d = crow(r, C.hi); A.o0[r] *= rstd * sg[d]; A.o1[r] *= rstd * sg[32 + d]; }
    { const int l2 = lane_opaque(); const size_t tok2 = (size_t)b * SEQ + q0w + (l2 & 31);
      store_o(C.obuf + tok2 * DM + 256 + h * 64, A.o0, A.o1, l2 >> 5); }
}

__device__ __forceinline__ void nsa_unit(const Ctx& C0, KParamsPtr P, int b, int hq, int qb) {
    Ctx C = C0; C.lane = lane_opaque(); C.tid = C.wave * 64 + C.lane; C.r32 = C.lane & 31; C.hi = C.lane >> 5;
    const int g = hq >> 2;
    const int q0w = __builtin_amdgcn_readfirstlane(qb * 256 + C.wave * 32); const int qpos = q0w + C.r32; const size_t tok = (size_t)b * SEQ + qpos;
    build_lut(C.lds, P->rel_bias, 8 + hq, false, C.tid);
    bf16x8 qr[4]; load_q(qr, C.proj + tok * PW + C_NQ + hq * 64, C.hi);
    const u16* gl = C.proj + tok * PW + C_NG + hq * 3;
    const float g1 = sigmoid_f(bf2f(gl[1])), g2 = sigmoid_f(bf2f(gl[2]));
    const unsigned mask = ((const unsigned*)(P->ws + WS_SEL))[(size_t)(b * 2 + g) * SEQ + qpos];
    const float c31 = P->rel_bias[31 * 16 + 8 + hq] * LOG2E;
    u32x2 pc0[4], pc1[4];
    { const u16* src = C.obuf + tok * DM + 512 + hq * 64;
#pragma unroll
      for (int gg = 0; gg < 4; ++gg) { pc0[gg] = *(const u32x2*)(src + 8 * gg + 4 * C.hi); pc1[gg] = *(const u32x2*)(src + 32 + 8 * gg + 4 * C.hi); } }
    AState A; astate_init(A);
    run_tiles<0, 4, false, 2>(C.lds, 0, 4 * qb + 3, C.proj + (size_t)b * SEQ * PW + C_NKS + g * 64, C.proj + (size_t)b * SEQ * PW + C_NVS + g * 64, qr, c31, q0w, mask, qb, A, C.wave, C.lane, C.r32, C.hi);
    LAS float* park = (LAS float*)(C.lds + ATT_PARK) + C.tid;
    { const float f = g1 * rcpf_(xhalf_sum(A.l));
#pragma unroll
      for (int gg = 0; gg < 4; ++gg) {
          park[(4 * gg) * 512] = A.o0[4 * gg] * f + bf2f(pc0[gg].x & 0xffffu); park[(4 * gg + 1) * 512] = A.o0[4 * gg + 1] * f + bf2f(pc0[gg].x >> 16);
          park[(4 * gg + 2) * 512] = A.o0[4 * gg + 2] * f + bf2f(pc0[gg].y & 0xffffu); park[(4 * gg + 3) * 512] = A.o0[4 * gg + 3] * f + bf2f(pc0[gg].y >> 16);
          park[(16 + 4 * gg) * 512] = A.o1[4 * gg] * f + bf2f(pc1[gg].x & 0xffffu); park[(16 + 4 * gg + 1) * 512] = A.o1[4 * gg + 1] * f + bf2f(pc1[gg].x >> 16);
          park[(16 + 4 * gg + 2) * 512] = A.o1[4 * gg + 2] * f + bf2f(pc1[gg].y & 0xffffu); park[(16 + 4 * gg + 3) * 512] = A.o1[4 * gg + 3] * f + bf2f(pc1[gg].y >> 16); } }
    if (C.tid < 96) ((LAS float*)(C.lds + ATT_LUT))[608 + C.tid] = NEGF;
    astate_init(A);
    const int tw0 = 4 * qb - 8 < 0 ? 0 : 4 * qb - 8;
    run_tiles<0, 4, true, 0>(C.lds, tw0, 4 * qb + 3, C.proj + (size_t)b * SEQ * PW + C_NKW + g * 64, C.proj + (size_t)b * SEQ * PW + C_NVW + g * 64, qr, c31, q0w, 0u, qb, A, C.wave, C.lane, C.r32, C.hi);
    { const float f = g2 * rcpf_(xhalf_sum(A.l));
#pragma unroll
      for (int r = 0; r < 16; ++r) { A.o0[r] = A.o0[r] * f + park[r * 512]; A.o1[r] = A.o1[r] * f + park[(16 + r) * 512]; } }
    const int l2 = lane_opaque(); const int hi2 = l2 >> 5;
    u16* dst = C.obuf + ((size_t)b * SEQ + q0w + (l2 & 31)) * DM + 512 + hq * 64;
    store_o(dst, A.o0, A.o1, hi2);
}

__device__ __forceinline__ void cmp_unit(const Ctx& C0, KParamsPtr P, int b, int g, int qblk) {
    Ctx C = C0; C.lane = lane_opaque(); C.tid = C.wave * 64 + C.lane; C.r32 = C.lane & 31; C.hi = C.lane >> 5;
    LAS unsigned char* lds = C.lds; const int tid = C.tid, r32 = C.r32, hi = C.hi;
    const u16* kc = (const u16*)(P->ws + WS_KCMP) + (size_t)(b * 2 + g) * 128 * 64;
    const u16* vc = (const u16*)(P->ws + WS_VCMPT) + (size_t)(b * 2 + g) * 64 * 128;
#pragma unroll
    for (int i = 0; i < 2; ++i) { const int e = tid + 512 * i;
        { const int row = e >> 3, ch = e & 7; *(LAS u32x4*)(lds + CMP_K + row * 144 + ch * 16) = *(const u32x4*)(kc + row * 64 + ch * 8); }
        { const int row = e >> 4, ch = e & 15; *(LAS u32x4*)(lds + CMP_V + row * 272 + ch * 16) = *(const u32x4*)(vc + row * 128 + ch * 8); } }
    const int q0w = __builtin_amdgcn_readfirstlane(qblk * 256 + C.wave * 32); const int qpos = q0w + r32; const size_t tok = (size_t)b * SEQ + qpos;
    const int nmax = (qpos - 31) >> 4;
    __syncthreads();
    float qa[16], qh[16];
#pragma unroll
    for (int i = 0; i < 16; ++i) { qa[i] = 0.f; qh[i] = 0.f; }
    const LAS unsigned char* kp = lds + CMP_K + r32 * 144 + hi * 16;
    const LAS unsigned char* vp = lds + CMP_V + r32 * 272 + hi * 16;
    bf16x8 qn[4]; load_q(qn, C.proj + tok * PW + C_NQ + g * 4 * 64, hi);
    for (int rh = 0; rh < 4; ++rh) {
        const int hq = g * 4 + rh;
        bf16x8 qr[4];
#pragma unroll
        for (int ks = 0; ks < 4; ++ks) qr[ks] = qn[ks];
        load_q(qn, C.proj + tok * PW + C_NQ + (g * 4 + (rh < 3 ? rh + 1 : rh)) * 64, hi);
        const float g0 = sigmoid_f(bf2f(C.proj[tok * PW + C_NG + hq * 3]));
        f32x16 s[4];
#pragma unroll
        for (int kb = 0; kb < 4; ++kb) {
#pragma unroll
            for (int r = 0; r < 16; ++r) s[kb][r] = 0.f;
#pragma unroll
            for (int ks = 0; ks < 4; ++ks) { const bf16x8 a = *(const LAS bf16x8*)(kp + kb * 32 * 144 + ks * 32); s[kb] = __builtin_amdgcn_mfma_f32_32x32x16_bf16(a, qr[ks], s[kb], 0, 0, 0); }
        }
        float mx = NEGF;
#pragma unroll
        for (int kb = 0; kb < 4; ++kb)
#pragma unroll
            for (int r = 0; r < 16; ++r) { const int n = 32 * kb + crow(r, hi); const float v = (n <= nmax) ? s[kb][r] : NEGF; s[kb][r] = v; mx = fmaxf(mx, v); }
        mx = xhalf_max(mx);
        float sum = 0.f;
#pragma unroll
        for (int kb = 0; kb < 4; ++kb)
#pragma unroll
            for (int r = 0; r < 16; ++r) { const int n = 32 * kb + crow(r, hi); const float pv = (n <= nmax) ? ex2(s[kb][r] - mx) : 0.f; s[kb][r] = pv; sum += pv; }
        sum = xhalf_sum(sum);
        const float inv = nmax >= 0 ? rcpf_(sum) : 0.f;
        f32x16 o0, o1;
#pragma unroll
        for (int r = 0; r < 16; ++r) { o0[r] = 0.f; o1[r] = 0.f; }
#pragma unroll
        for (int kb = 0; kb < 4; ++kb) {
#pragma unroll
            for (int r = 0; r < 16; ++r) s[kb][r] *= inv;
#pragma unroll
            for (int g4 = 0; g4 < 4; ++g4) { const float h = 0.5f * s[kb][4 * g4 + 3]; qh[kb * 4 + g4] += h; qa[kb * 4 + g4] += (s[kb][4 * g4] + s[kb][4 * g4 + 1]) + (s[kb][4 * g4 + 2] + h); }
#pragma unroll
            for (int c = 0; c < 2; ++c) {
                const u32x4 pk = (u32x4){pkbf(s[kb][8 * c], s[kb][8 * c + 1]), pkbf(s[kb][8 * c + 2], s[kb][8 * c + 3]), pkbf(s[kb][8 * c + 4], s[kb][8 * c + 5]), pkbf(s[kb][8 * c + 6], s[kb][8 * c + 7])};
                const bf16x8 pb = __builtin_bit_cast(bf16x8, pk);
                const bf16x8 v0 = *(const LAS bf16x8*)(vp + (kb * 2 + c) * 32);
                const bf16x8 v1 = *(const LAS bf16x8*)(vp + 32 * 272 + (kb * 2 + c) * 32);
                o0 = __builtin_amdgcn_mfma_f32_32x32x16_bf16(v0, pb, o0, 0, 0, 0);
                o1 = __builtin_amdgcn_mfma_f32_32x32x16_bf16(v1, pb, o1, 0, 0, 0);
            }
            __builtin_amdgcn_sched_barrier(0);
        }
        o0 *= g0; o1 *= g0;
        store_o(C.obuf + tok * DM + 512 + hq * 64, o0, o1, hi);
    }
    LAS float* Aq = (LAS float*)(lds + CMP_A) + (C.wave * 32 + r32) * 33; LAS float* Hq = (LAS float*)(lds + CMP_H) + (C.wave * 32 + r32) * 33;
#pragma unroll
    for (int kb = 0; kb < 4; ++kb)
#pragma unroll
        for (int g4 = 0; g4 < 4; ++g4) { const int j = 8 * kb + 2 * g4 + hi; Aq[j] = qa[kb * 4 + g4]; Hq[j] = qh[kb * 4 + g4]; }
    __syncthreads();
    const int cur = q0w >> 6;
    unsigned bits = 0;
    if (cur < 16) bits = (2u << cur) - 1u;
    else {
        float sc[32];
#pragma unroll
        for (int i = 0; i < 32; ++i) { const float imp = Aq[i] + (i > 0 ? Hq[i - 1] : 0.f); sc[i] = (i > cur) ? -3.0e38f : ((i == 0 || i > cur - 2) ? 1e4f : imp); }
#pragma unroll
        for (int e = 0; e < 16; ++e) {
            const float sj = hi ? sc[16 + e] : sc[e]; int rank = 0;
#pragma unroll
            for (int i = 0; i < 32; ++i) { const bool lt = (i < e) || (hi && i < 16 + e);
                rank += (sc[i] > sj || (sc[i] == sj && lt)) ? 1 : 0; }
            const int j = hi * 16 + e;
            if (j <= cur && rank < 16) bits |= 1u << j; }
        { auto rr = __builtin_amdgcn_permlane32_swap(bits, bits, false, false); bits = rr[0] | rr[1]; }
    }
    if (hi == 0) ((unsigned*)(P->ws + WS_SEL))[(size_t)(b * 2 + g) * SEQ + qpos] = bits;
    __syncthreads();
}

__device__ __forceinline__ void prep_vk(const Ctx& C, KParamsPtr P, int b0) {
    (void)b0; const int lane = C.lane, qd = C.wave & 3; LAS float* part = (LAS float*)C.lds;
    for (int base = C.bx * 2; base < NB * 4 * 8; base += C.G * 2) {
        const int it = base + (C.wave >> 2), blk = it & 7, h = (it >> 3) & 3, b = it >> 5;
        const u16* kp = C.proj + ((size_t)b * SEQ + blk * 256 + qd * 64) * PW + C_MK + h * 64 + lane; float s = 0.f;
        for (int k = 0; k < 64; k += 16) { float t[16];
#pragma unroll
            for (int e = 0; e < 16; ++e) t[e] = bf2f(kp[(size_t)(k + e) * PW]);
            s += (((t[0] + t[1]) + (t[2] + t[3])) + ((t[4] + t[5]) + (t[6] + t[7]))) + (((t[8] + t[9]) + (t[10] + t[11])) + ((t[12] + t[13]) + (t[14] + t[15]))); }
        part[C.wave * 64 + lane] = s;
        __syncthreads();
        if (qd == 0) ((float*)(P->ws + WS_KMEAN))[(size_t)it * 64 + lane] = ((part[C.wave * 64 + lane] + part[(C.wave + 1) * 64 + lane]) + (part[(C.wave + 2) * 64 + lane] + part[(C.wave + 3) * 64 + lane])) * (1.0f / 256.0f);
        __syncthreads();
    }
}
__device__ __forceinline__ void prep_a(const Ctx& C, KParamsPtr P, int layer) {
    const int G = C.G, lane = C.lane;
    const int gw = C.bx * 8 + C.wave, NGW = G * 8;
    u16* acmp = (u16*)(P->ws + WS_VT);
    for (int it = gw; it < 2 * 4096; it += NGW) {
        const int i = it >> 12, row = it & 4095, n = row & 127, bg = row >> 7, b = bg >> 1, g = bg & 1;
        u16* dst = acmp + (size_t)it * 2048; const float* pe = P->cmp_pe + (size_t)(layer * 2 + i) * 2048;
        const int col = (i == 0 ? C_NKC : C_NVC) + g * 64;
#pragma unroll
        for (int pass = 0; pass < 4; ++pass) { const int l = pass * 8 + (lane >> 3), d0 = (lane & 7) * 8;
            unsigned z0 = 0u; asm volatile("" : "+v"(z0)); u32x4 o = (u32x4){z0, z0, z0, z0};
            if (n < 127) { const u32x4 v = *(const u32x4*)(C.proj + ((size_t)b * SEQ + 16 * n + l) * PW + col + d0); const f32x4 e0 = *(const f32x4*)(pe + l * 64 + d0), e1 = *(const f32x4*)(pe + l * 64 + d0 + 4);
                o.x = pkbf(bf2f(v.x & 0xffffu) + e0.x, bf2f(v.x >> 16) + e0.y); o.y = pkbf(bf2f(v.y & 0xffffu) + e0.z, bf2f(v.y >> 16) + e0.w);
                o.z = pkbf(bf2f(v.z & 0xffffu) + e1.x, bf2f(v.z >> 16) + e1.y); o.w = pkbf(bf2f(v.w & 0xffffu) + e1.z, bf2f(v.w >> 16) + e1.w); }
            *(u32x4*)(dst + l * 64 + d0) = o; }
    }
}
__device__ __forceinline__ void prep_c(const Ctx& C, KParamsPtr P, int layer, int it0) {
    const int i = it0 >> 12, row0 = it0 & 4095, lane = lane_opaque(), tid = C.wave * 64 + lane, r32 = lane & 31, hi = lane >> 5;
    const float* w2 = P->cmp_w2 + (size_t)(layer * 2 + i) * 256 * 64;
    for (int e = tid; e < 256 * 64; e += 512) { const int k = e >> 6, c = e & 63; *(LAS u16*)(C.lds + c * 528 + k * 2) = (u16)(pkbf(w2[e], 0.f) & 0xffffu); }
    __syncthreads();
    const int wrow = row0 + C.wave * 32;
    const u16* hrow = (const u16*)(P->ws + WS_HID) + ((size_t)i * 4096 + wrow + r32) * 256 + hi * 8;
    f32x16 d0, d1;
#pragma unroll
    for (int r = 0; r < 16; ++r) { d0[r] = 0.f; d1[r] = 0.f; }
#pragma unroll 4
    for (int ks = 0; ks < 16; ++ks) {
        const bf16x8 a = *(const bf16x8*)(hrow + ks * 16);
        const bf16x8 b0 = *(const LAS bf16x8*)(C.lds + r32 * 528 + (ks * 16 + hi * 8) * 2);
        const bf16x8 b1 = *(const LAS bf16x8*)(C.lds + (32 + r32) * 528 + (ks * 16 + hi * 8) * 2);
        d0 = __builtin_amdgcn_mfma_f32_32x32x16_bf16(a, b0, d0, 0, 0, 0);
        d1 = __builtin_amdgcn_mfma_f32_32x32x16_bf16(a, b1, d1, 0, 0, 0);
    }
#pragma unroll
    for (int r = 0; r < 16; ++r) { const int row = wrow + crow(r, hi);
        const unsigned v0 = pkbf(d0[r], 0.f) & 0xffffu, v1 = pkbf(d1[r], 0.f) & 0xffffu;
        if (i == 0) { u16* o = (u16*)(P->ws + WS_KCMP) + (size_t)row * 64; o[r32] = (u16)v0; o[32 + r32] = (u16)v1; }
        else { const int bg = row >> 7, n = row & 127; u16* o = (u16*)(P->ws + WS_VCMPT) + (size_t)bg * 64 * 128 + (n & ~15) + pperm(n & 15); o[(size_t)r32 * 128] = (u16)v0; o[(size_t)(32 + r32) * 128] = (u16)v1; }
    }
}

__device__ __forceinline__ void convert_weights(const Ctx& C, KParamsPtr P, int layer) {
    LAS float* scr = (LAS float*)(C.lds + C.wave * 16384);
    const int gw = C.bx * 8 + C.wave, NGW = C.G * 8, lane = C.lane;
    constexpr int I_G = 16 * 88, I_D = 44 * 32, I_IN = 16 * 96, I_O = 16 * 32, I_W1 = 32 * 8;
    constexpr int NIT = 4 * I_G + 2 * I_D + I_IN + I_O + 2 * I_W1;
    unsigned char* ws = P->ws;
    for (int it = gw; it < NIT; it += NGW) {
        int r = it;
        if (r < 4 * I_G) { const int which = r / I_G; r -= which * I_G; const int kb = r / 88, nb = r % 88, n0 = nb * 32;
            const float* W = (which == 0 ? P->ffn1_gate : which == 1 ? P->ffn1_up : which == 2 ? P->ffn2_gate : P->ffn2_up) + (size_t)layer * DM * DFF;
            u16* WT = (u16*)(ws + (which < 2 ? WS_GU1 : WS_GU2));
            tr_item(W, DM, DFF, WT, kb, n0, (n0 >> 7) * 256 + (which & 1) * 128 + (n0 & 127), scr, lane, 1.0f, (which < 2 ? P->norm_ffn1 : P->norm_ffn2) + (size_t)layer * DM); continue; }
        r -= 4 * I_G;
        if (r < 2 * I_D) { const int which = r / I_D; r -= which * I_D; const int kb = r / 32, nb = r % 32;
            const float* W = (which == 0 ? P->ffn1_down : P->ffn2_down) + (size_t)layer * DFF * DM;
            tr_item(W, DFF, DM, (u16*)(ws + (which == 0 ? WS_DN1 : WS_DN2)), kb, nb * 32, nb * 32, scr, lane); continue; }
        r -= 2 * I_D;
        if (r < I_IN) { const int kb = r / 96, nb = r % 96, n0 = nb * 32;
            const float cs = (n0 < C_MK || (n0 >= C_NQ && n0 < C_NKC)) ? 0.125f * LOG2E : (n0 >= C_DQ && n0 < C_DK) ? 0.17677669529663687f * LOG2E : 1.0f;
            tr_item(P->w_in + (size_t)layer * DM * INW, DM, INW, (u16*)(ws + WS_WIN), kb, n0, n0, scr, lane, cs, P->norm_mix + (size_t)layer * DM); continue; }
        r -= I_IN;
        if (r < I_O) { const int kb = r / 32, nb = r % 32; tr_item(P->w_out + (size_t)layer * DM * DM, DM, DM, (u16*)(ws + WS_WOUT), kb, nb * 32, nb * 32, scr, lane); continue; }
        r -= I_O;
        { const int i = r / I_W1; r -= i * I_W1; const int kb = r / 8, nb = r % 8;
            tr_item(P->cmp_w1 + (size_t)(layer * 2 + i) * 2048 * 256, 2048, 256, (u16*)(ws + WS_W1) + (size_t)i * 256 * 2048, kb, nb * 32, nb * 32, scr, lane); }
    }
}
__device__ __forceinline__ void norm_phase(const Ctx& C, const float* src32, const u16* src16, const float* g, u16* dst16, float* dst32, u16* xb0) {
    const int gw = C.bx * 8 + C.wave, NGW = C.G * 8;
    for (int m = gw; m < MTOK; m += NGW) norm_row(src32 ? src32 + (size_t)m * DM : nullptr, src16 ? src16 + (size_t)m * DM : nullptr, g, dst16 ? dst16 + (size_t)m * DM : nullptr, dst32 ? dst32 + (size_t)m * DM : nullptr, xb0 ? xb0 + (size_t)m * DM : nullptr, C.lane);
}

#define XB_TMO      128
#define XB_XCNT(j)  (256  + 64 * (j))
#define XB_XSUB(j)  (1280 + 64 * (j))
#define XB_XGEN(j)  (2304 + 64 * (j))
#define XB_TOP      3328
#define XB_TOPGEN   3392
#define XCD_BAR_WORDS 3456
#define XB_SPIN_CAP (1u << 18)

__device__ __forceinline__ unsigned xb_ld(unsigned* p)              { return __hip_atomic_load(p, __ATOMIC_RELAXED, __HIP_MEMORY_SCOPE_AGENT); }
__device__ __forceinline__ unsigned xb_add(unsigned* p, unsigned v) { return __hip_atomic_fetch_add(p, v, __ATOMIC_RELAXED, __HIP_MEMORY_SCOPE_AGENT); }
__device__ __forceinline__ unsigned xb_xcc_id() { return (unsigned)__builtin_amdgcn_s_getreg((3 << 11) | 20) & 0xFu; }
#define XB_SPIN(cond, bar) do { unsigned _sp = 0; while (cond) { __builtin_amdgcn_s_sleep(1); \
    if ((++_sp & 255u) == 0u) { if (xb_ld(&(bar)[XB_TMO])) break; if (_sp > XB_SPIN_CAP) { atomicAdd(&(bar)[XB_TMO], 1u); break; } } } } while (0)

struct XcdBarrier {
    unsigned* bar; unsigned x;
    volatile LAS unsigned* st;
};

__device__ __forceinline__ XcdBarrier xcd_barrier_post(unsigned* bar, volatile LAS unsigned* st) {
    XcdBarrier b; b.bar = bar; b.x = xb_xcc_id(); b.st = st;
    if (threadIdx.x == 0) (void)xb_add(&bar[XB_XCNT(b.x)], 1u);
    return b;
}
__device__ __forceinline__ void xcd_barrier_complete(unsigned* bar, unsigned x, unsigned& nloc, unsigned& nx) {
    const unsigned G = gridDim.x * gridDim.y * gridDim.z;
    unsigned sum, cnt, mine, sp = 0u;
    for (;;) {
        sum = 0u; cnt = 0u; mine = 0u;
#pragma unroll
        for (unsigned j = 0; j < 16; ++j) { const unsigned c = xb_ld(&bar[XB_XCNT(j)]); sum += c; cnt += (c > 0u) ? 1u : 0u; mine = (j == x) ? c : mine; }
        if (sum == G) break;
        __builtin_amdgcn_s_sleep(1);
        if ((++sp & 255u) == 0u) { if (xb_ld(&bar[XB_TMO])) break; if (sp > XB_SPIN_CAP) { atomicAdd(&bar[XB_TMO], 1u); break; } }
    }
    nloc = mine > 0u ? mine : 1u; nx = cnt > 0u ? cnt : 1u;
}

__device__ __forceinline__ void xcd_barrier(const XcdBarrier& b) {
    asm volatile("s_waitcnt vmcnt(0)" ::: "memory");
    __syncthreads();
    if (threadIdx.x == 0) {
        unsigned* bar = b.bar;
        __builtin_amdgcn_s_waitcnt(0);
        unsigned nloc = b.st[0], nx = b.st[1];
        if (nloc == 0u) { xcd_barrier_complete(bar, b.x, nloc, nx); b.st[0] = nloc; b.st[1] = nx; }
        const unsigned old = xb_add(&bar[XB_XSUB(b.x)], 1u);
        const unsigned gen = old / nloc;
        if (old + 1u == (gen + 1u) * nloc) {
            __builtin_amdgcn_fence(__ATOMIC_RELEASE, "agent");
            asm volatile("s_waitcnt vmcnt(0)" ::: "memory");
            const unsigned og = xb_add(&bar[XB_TOP], 1u);
            const unsigned tg = og / nx;
            if (og + 1u == (tg + 1u) * nx) xb_add(&bar[XB_TOPGEN], 1u);
            else XB_SPIN(xb_ld(&bar[XB_TOPGEN]) == tg, bar);
            __builtin_amdgcn_fence(__ATOMIC_ACQUIRE, "agent");
            xb_add(&bar[XB_XGEN(b.x)], 1u);
            asm volatile("s_waitcnt vmcnt(0)" ::: "memory");
        } else {
            XB_SPIN(xb_ld(&bar[XB_XGEN(b.x)]) == gen, bar);
            __builtin_amdgcn_fence(__ATOMIC_ACQUIRE, "agent");
            asm volatile("s_waitcnt vmcnt(0)" ::: "memory");
        }
    }
    __syncthreads();
}


__device__ __forceinline__ void fill_rtab(const Ctx& C, const pg8::StaticOrder& S, const float* SS, LAS float* rtab) {
    LAS int* pml = (LAS int*)(rtab + 11 * 256);
    int nu = 0; { pg8::Unit u_; for (int i_ = 0; i_ < 11 && S.next(i_, u_); ++i_) { if (C.tid == 0) pml[i_] = u_.pm; nu = i_ + 1; } }
    __syncthreads();
    const int tot = nu * 256; float rsv[6];
#pragma unroll
    for (int k = 0; k < 6; ++k) { const int e = C.tid + 512 * k; rsv[k] = e < tot ? pg8::row_rstd(SS, pml[e >> 8] * 256 + (e & 255)) : 0.f; }
#pragma unroll
    for (int k = 0; k < 6; ++k) { const int e = C.tid + 512 * k; if (e < tot) rtab[e] = rsv[k]; }
    __syncthreads();
}
__device__ __forceinline__ void x0_phase(const Ctx& C, const float* src, u16* xb, float* ss) {
    const int gw = C.bx * 8 + C.wave, NGW = C.G * 8, lane = C.lane;
    for (int m = gw; m < MTOK; m += NGW) {
        const f32x4* xr = (const f32x4*)(src + (size_t)m * DM) + lane; float s = 0.f;
#pragma unroll
        for (int j = 0; j < 4; ++j) { const f32x4 v = xr[64 * j]; s += (v.x * v.x + v.y * v.y) + (v.z * v.z + v.w * v.w);
            u32x2 o; o.x = pkbf(v.x, v.y); o.y = pkbf(v.z, v.w); *((u32x2*)(xb + (size_t)m * DM) + lane + 64 * j) = o; }
        s = wave_sum(s, lane);
        if (lane < 16) ss[(size_t)m * 16 + lane] = lane == 0 ? s : 0.f;
    }
}
__device__ __forceinline__ void unit_publish(unsigned* flag, int tid) {
    asm volatile("s_waitcnt vmcnt(0)" ::: "memory"); __syncthreads();
    if (tid == 0) { __builtin_amdgcn_fence(__ATOMIC_RELEASE, "agent"); asm volatile("s_waitcnt vmcnt(0)" ::: "memory"); __hip_atomic_store(flag, 1u, __ATOMIC_RELAXED, __HIP_MEMORY_SCOPE_AGENT); }
}
__device__ __forceinline__ void unit_wait(unsigned* f0, unsigned* f1, int tid) {
    if (tid == 0) { unsigned sp = 0;
        while ((__hip_atomic_load(f0, __ATOMIC_RELAXED, __HIP_MEMORY_SCOPE_AGENT) == 0u || __hip_atomic_load(f1, __ATOMIC_RELAXED, __HIP_MEMORY_SCOPE_AGENT) == 0u) && ++sp < (1u << 24)) __builtin_amdgcn_s_sleep(8);
        __builtin_amdgcn_fence(__ATOMIC_ACQUIRE, "agent"); asm volatile("s_waitcnt vmcnt(0)" ::: "memory"); }
    __syncthreads();
}
struct OneUnit { int pm;
    __device__ __forceinline__ bool next(int i, pg8::Unit& u) const { if (i) return false; u.pm = pm; u.pn = 0; return true; }
    __device__ __forceinline__ void a_ready(const pg8::Unit&) const {}
    __device__ __forceinline__ void done(const pg8::Unit&) const {} };
__global__ void __launch_bounds__(512, 2) hybrid_fwd(Params P0) {
    extern __shared__ __attribute__((aligned(16))) unsigned char lds_raw[];
    const KParamsPtr kp0 = (KParamsPtr)__builtin_amdgcn_kernarg_segment_ptr();
    cg::grid_group grid = cg::this_grid();
    { volatile LAS unsigned* misc = (volatile LAS unsigned*)((LAS unsigned char*)lds_raw + MISC_OFF); if (threadIdx.x < 2) misc[threadIdx.x] = 0u; }
    __syncthreads();
    XcdBarrier bar = xcd_barrier_post((unsigned*)(P0.ws + WS_CTL) + 1024, (volatile LAS unsigned*)((LAS unsigned char*)lds_raw + MISC_OFF));
    const int ph_lo = P0.ph_lo, ph_hi = P0.ph_hi; const int wave_s = __builtin_amdgcn_readfirstlane(threadIdx.x >> 6);
    bool redone = false; (void)redone;
    for (int ph = ph_lo; ph < ph_hi; ++ph) {
        KParamsPtr kpl = kp0; asm volatile("" : "+s"(kpl));
        const KParamsPtr P = kpl; unsigned char* ws = P->ws;
        u16* XN = (u16*)(ws + WS_XN); u16* HB = (u16*)(ws + WS_PROJ);
        int G = gridDim.x, bx = blockIdx.x; asm volatile("" : "+s"(G), "+s"(bx));
        Ctx C; C.G = G; C.bx = bx; C.lds = (LAS unsigned char*)lds_raw; C.wave = wave_s; C.lane = lane_opaque(); C.tid = wave_s * 64 + C.lane; C.r32 = C.lane & 31; C.hi = C.lane >> 5;
        C.proj = (u16*)(ws + WS_PROJ); C.obuf = (u16*)(ws + WS_XN); C.vt = (u16*)(ws + WS_VT);
        const int layer = ph / NPH_L, s = ph % NPH_L;
        if (ph != NPH - 1 && (s == 7 || s == 3 || s == 11 || s == 8 || s == 9)) continue;
        float* SS = (float*)(ws + WS_SS);
        u16* XB = (u16*)(ws + WS_XB);
        if (ph == NPH - 1) { norm_phase(C, nullptr, XB, P->final_norm, nullptr, P->out, nullptr); }
        else switch (s) {
        case 0: { convert_weights(C, P, layer); if (layer == 0) { __syncthreads(); x0_phase(C, P->x, XB, SS); } } break;
#ifndef NO_GEMM
#ifndef NO_G1
        case 1: case 12: {
            pg8::Gemm g{XB, (const u16*)(ws + (s == 1 ? WS_GU1 : WS_GU2)), MTOK, 2 * DFF, DM}; pg8::StaticOrder S; S.init(MTOK, 2 * DFF, G, bx);
            LAS float* rtab = (LAS float*)(C.lds + RTAB_OFF); fill_rtab(C, S, SS, rtab);
            pg8::EpiSwiGLU E{HB, DFF, rtab, 0};
            pg8::gemm_phase<pg8::EpiSwiGLU, pg8::StaticOrder, true, true>(C.lds, g, S, E, C.wave); } break;
#endif
#ifndef NO_G2
        case 2: case 13: case 10: {
            const u16* A = (s == 10) ? (const u16*)XN : (const u16*)HB; const u16* Bt = (const u16*)(ws + (s == 2 ? WS_DN1 : s == 13 ? WS_DN2 : WS_WOUT));
            pg8::Gemm g{A, Bt, MTOK, DM, s == 10 ? DM : DFF}; pg8::StaticOrder S; S.init(MTOK, DM, G, bx);
            pg8::EpiResid E{XB, DM, s == 10 ? 1.0f : 0.5f, SS};
            pg8::gemm_phase<pg8::EpiResid, pg8::StaticOrder, false, true>(C.lds, g, S, E, C.wave); } break;
#endif
#ifndef NO_G4
        case 4: {
            pg8::Gemm g{XB, (const u16*)(ws + WS_WIN), MTOK, PW, DM}; pg8::StaticOrder S; S.init(MTOK, PW, G, bx);
            LAS float* rtab = (LAS float*)(C.lds + RTAB_OFF); fill_rtab(C, S, SS, rtab);
            pg8::EpiBf16<0> E{C.proj, PW, rtab, 0};
            pg8::gemm_phase<pg8::EpiBf16<0>, pg8::StaticOrder, true, true>(C.lds, g, S, E, C.wave); } break;
#endif
#endif
#ifndef NO_PREP
        case 5: prep_a(C, P, layer); prep_vk(C, P, 0); break;
#endif
#if !defined(NO_GEMM) && !defined(NO_G6)
        case 6: {
            unsigned* ctl = (unsigned*)(ws + WS_CTL); unsigned* qctr = ctl + 8192 + 64 * ph + (redone ? 32 : 0); unsigned* fcomp = ctl + 16384 + 64 * ph; unsigned* fcmp = ctl + 24576 + 256 * (ph / NPH_L);
            volatile LAS unsigned* qslot = (volatile LAS unsigned*)(C.lds + MISC_OFF + 16);
            for (;;) {
                if (C.tid == 0) *qslot = __hip_atomic_fetch_add(qctr, 1u, __ATOMIC_RELAXED, __HIP_MEMORY_SCOPE_AGENT);
                __syncthreads();
                const unsigned u = *qslot;
                __syncthreads();
                if (u >= 32u + 512u + 256u + 1024u + 512u) break;
                if (u < 32u) { const int i = (int)u >> 4, tile = (int)u & 15;
                    pg8::Gemm g{(const u16*)(ws + WS_VT) + (size_t)i * 4096 * 2048, (const u16*)(ws + WS_W1) + (size_t)i * 256 * 2048, 4096, 256, 2048}; OneUnit S{tile};
                    pg8::EpiBf16<1> E{(u16*)(ws + WS_HID) + (size_t)i * 4096 * 256, 256, nullptr, 0};
                    pg8::gemm_phase<pg8::EpiBf16<1>, OneUnit, true, true>(C.lds, g, S, E, C.wave);
                    __builtin_amdgcn_fence(__ATOMIC_RELEASE, "agent"); __syncthreads(); __builtin_amdgcn_fence(__ATOMIC_ACQUIRE, "agent");
                    prep_c(C, P, layer, i * 4096 + tile * 256);
                    unit_publish(fcomp + u, C.tid);
                    __syncthreads();
                } else if (u < 544u || u >= 1824u) { const unsigned v = u < 544u ? u - 32u : u - 1824u + 512u; const int qb = 7 - (int)(v >> 7), w = (int)(v & 127);
                    if (w < 64) {
#ifndef NO_DIFF
                        diff_unit(C, P, layer, w >> 2, w & 3, qb);
#endif
                    } else {
#ifndef NO_MOBA
                        moba_unit(C, P, (w - 64) >> 2, w & 3, qb);
#endif
                    }
                } else if (u < 800u) { const int c = (int)u - 544, qblk = 7 - (c >> 5), bg = c & 31;
                    unit_wait(fcomp + (bg >> 1), fcomp + 16 + (bg >> 1), C.tid);
#ifndef NO_CMP
                    cmp_unit(C, P, bg >> 1, bg & 1, qblk);
#endif
                    unit_publish(fcmp + bg * 8 + qblk, C.tid);
                    __syncthreads();
                } else { const int v = (int)u - 800, qb = 7 - (v >> 7), b = (v & 127) >> 3, hq = v & 7; unsigned* f = fcmp + (b * 2 + (hq >> 2)) * 8 + qb;
                    unit_wait(f, f, C.tid);
#ifndef NO_ATT2
                    nsa_unit(C, P, b, hq, qb);
#endif
                }
            } } break;
#endif
        default: break;
        }
        if (ph + 1 < ph_hi) { if (ph == ph_lo) grid.sync(); else xcd_barrier(bar); }
#ifdef PROBE_LO
        if (ph != NPH - 1 && s == PROBE_HI) { if (!redone) { ph -= (PROBE_HI - PROBE_LO + 1); redone = true; } else redone = false; }
#endif
#ifdef PROBE_SYNC
        if (ph + 1 < ph_hi) xcd_barrier(bar);
#endif
    }
}

#ifndef COOP
#define COOP 1
#endif
extern "C" void kernel_launch(void* const* d_in, const int* in_sizes, int n_in, void* d_out, int out_size, void* d_ws, size_t ws_size, hipStream_t stream) {
    static int grid = 0;
    if (grid == 0) {
        if (n_in != 19 || out_size != MTOK * DM || ws_size < WS_END) { fprintf(stderr, "kernel_launch: unexpected shapes (n_in %d out %d ws %zu)\n", n_in, out_size, ws_size); grid = -1; return; }
        int dev = 0, cus = 0, per_cu = 0;
        (void)hipGetDevice(&dev); (void)hipDeviceGetAttribute(&cus, hipDeviceAttributeMultiprocessorCount, dev);
        if (hipFuncSetAttribute((const void*)hybrid_fwd, hipFuncAttributeMaxDynamicSharedMemorySize, LDS_BYTES) != hipSuccess) { fprintf(stderr, "kernel_launch: hipFuncSetAttribute failed\n"); grid = -1; return; }
        if (hipOccupancyMaxActiveBlocksPerMultiprocessor(&per_cu, (const void*)hybrid_fwd, 512, LDS_BYTES) != hipSuccess || per_cu < 1) { fprintf(stderr, "kernel_launch: occupancy query says %d\n", per_cu); per_cu = 1; }
        (void)hipGetLastError();
        grid = cus * per_cu;
    }
    if (grid < 0) return;
    Params p{};
    p.x = (const float*)d_in[0]; p.rel_bias = (const float*)d_in[1]; p.norm_ffn1 = (const float*)d_in[2]; p.ffn1_gate = (const float*)d_in[3]; p.ffn1_up = (const float*)d_in[4]; p.ffn1_down = (const float*)d_in[5];
    p.norm_mix = (const float*)d_in[6]; p.w_in = (const float*)d_in[7]; p.diff_lambda = (const float*)d_in[8]; p.diff_subln = (const float*)d_in[9]; p.cmp_pe = (const float*)d_in[10]; p.cmp_w1 = (const float*)d_in[11];
    p.cmp_w2 = (const float*)d_in[12]; p.w_out = (const float*)d_in[13]; p.norm_ffn2 = (const float*)d_in[14]; p.ffn2_gate = (const float*)d_in[15]; p.ffn2_up = (const float*)d_in[16]; p.ffn2_down = (const float*)d_in[17];
    p.final_norm = (const float*)d_in[18]; p.out = (float*)d_out; p.ws = (unsigned char*)d_ws;
    for (int l = 0; l < 4; ++l) p.lam_init[l] = (float)(0.8 - 0.6 * exp(-0.3 * (double)l));
#if COOP
    if (hipMemsetAsync((char*)d_ws + WS_CTL, 0, CTL_ZERO_BYTES, stream) != hipSuccess) { fprintf(stderr, "kernel_launch: memset of barrier words failed\n"); return; }
    p.ph_lo = 0; p.ph_hi = NPH;
    void* args[] = {&p};
    hipError_t e = hipLaunchCooperativeKernel((const void*)hybrid_fwd, dim3(grid), dim3(512), args, LDS_BYTES, stream);
    if (e != hipSuccess) fprintf(stderr, "cooperative launch failed: %s (grid %d)\n", hipGetErrorString(e), grid);
#else
    for (int ph = 0; ph < NPH; ++ph) { p.ph_lo = ph; p.ph_hi = ph + 1; hipLaunchKernelGGL(hybrid_fwd, dim3(grid), dim3(512), LDS_BYTES, stream, p); }
#endif
}
```
